# Optimizing an MI355X kernel written in HIP

```python
import math
import jax, jax.numpy as jnp
from jax import lax
import numpy as np


D_MODEL = 1024
BATCH = 4
SEQ = 8192
DEPTH = 4

N_MIXERS = 2
N_A = (DEPTH + 1) // 2
N_B = DEPTH // 2
A_HEADS = 16
A_QK_DIM = 64
A_V_DIM = 64
A_KV_RANK = 256
IDX_HEADS = 8
IDX_DIM = 64
TOPK_MAX = 256
A_SPLITS = [A_HEADS * A_QK_DIM,
            A_HEADS * A_QK_DIM + A_KV_RANK,
            A_HEADS * A_QK_DIM + A_KV_RANK + IDX_HEADS * IDX_DIM,
            A_HEADS * A_QK_DIM + A_KV_RANK + IDX_HEADS * IDX_DIM + IDX_DIM]
A_IN = A_SPLITS[-1] + IDX_HEADS
B_HEADS = 8
B_HEAD_DIM = 64
B_QK = 2 * B_HEADS * B_HEAD_DIM
B_IN = 3 * B_QK
REL_BUCKETS = 32
REL_MAX_DIST = 128
BIAS_HEADS = A_HEADS
D_FF = 4 * D_MODEL
Q_BLOCK = 128
LN_EPS = 1e-5
NEG = -1e30
DN_ALPHA = (2 * DEPTH) ** 0.25
DN_BETA = (8 * DEPTH) ** -0.25

kernel_name = "hybrid_dsa_diffattn_deepnorm_adaln"


def _layer_norm(x, g, b):
    xf = x.astype(jnp.float32)
    mu = jnp.mean(xf, -1, keepdims=True)
    var = jnp.mean(jnp.square(xf - mu), -1, keepdims=True)
    return ((xf - mu) * lax.rsqrt(var + LN_EPS)).astype(x.dtype) * g + b


def _rms_norm(x, g):
    xf = x.astype(jnp.float32)
    return (xf * lax.rsqrt(jnp.mean(xf * xf, -1, keepdims=True) + LN_EPS)).astype(x.dtype) * g


def _rel_bucket(dist):
    n = jnp.maximum(dist, 0)
    max_exact = REL_BUCKETS // 2
    nf = jnp.maximum(n, 1).astype(jnp.float32)
    large = max_exact + (jnp.log(nf / max_exact) / math.log(REL_MAX_DIST / max_exact)
                         * (REL_BUCKETS - max_exact)).astype(jnp.int32)
    large = jnp.minimum(large, REL_BUCKETS - 1)
    return jnp.where(n < max_exact, n, large)


def _to_blocks(a):
    B, S = a.shape[:2]
    return jnp.moveaxis(a.reshape(B, S // Q_BLOCK, Q_BLOCK, *a.shape[2:]), 1, 0)


def _from_blocks(a):
    nb, B, Q = a.shape[:3]
    return jnp.moveaxis(a, 0, 1).reshape(B, nb * Q, *a.shape[3:])


def _dsa_mixer(h, w_in, kv_norm, w_uk, w_uv, w_o, rel_bias):
    B, S, _ = h.shape
    topk = min(TOPK_MAX, S // 4)
    proj = h @ w_in
    q, ckv, iq, ik, iw = jnp.split(proj, A_SPLITS, axis=-1)
    q = q.reshape(B, S, A_HEADS, A_QK_DIM)
    ckv = _rms_norm(ckv, kv_norm)
    iq = iq.reshape(B, S, IDX_HEADS, IDX_DIM)
    iw = iw * (IDX_HEADS ** -0.5 * IDX_DIM ** -0.5)
    pos = jnp.arange(S, dtype=jnp.int32)

    def block(args):
        qb, iqb, iwb, tpos = args
        idx_logits = jnp.einsum('bqhd,bsd->bhqs', iqb, ik).astype(jnp.float32)
        score = jnp.einsum('bhqs,bqh->bqs', jax.nn.relu(idx_logits), iwb.astype(jnp.float32))
        causal = pos[None, :] <= tpos[:, None]
        score = jnp.where(causal[None], score, -jnp.inf)
        _, sel = lax.top_k(score, topk)
        valid = sel <= tpos[None, :, None]
        kv_sel = jax.vmap(lambda cb, ib: cb[ib])(ckv, sel)
        q_lat = jnp.einsum('bqhd,hdr->bqhr', qb, w_uk) * (A_QK_DIM ** -0.5)
        logits = jnp.einsum('bqhr,bqkr->bhqk', q_lat, kv_sel).astype(jnp.float32)
        bias = rel_bias[_rel_bucket(tpos[None, :, None] - sel)]
        logits = logits + jnp.transpose(bias, (0, 3, 1, 2))
        logits = jnp.where(valid[:, None], logits, NEG)
        p = jax.nn.softmax(logits, axis=-1).astype(h.dtype)
        o_lat = jnp.einsum('bhqk,bqkr->bqhr', p, kv_sel)
        return jnp.einsum('bqhr,hrd->bqhd', o_lat, w_uv)

    o = lax.map(block, (_to_blocks(q), _to_blocks(iq), _to_blocks(iw),
                        pos.reshape(S // Q_BLOCK, Q_BLOCK)))
    o = _from_blocks(o)
    return o.reshape(B, S, A_HEADS * A_V_DIM) @ w_o


def _diff_mixer(h, w_in, lam, subln_g, w_o, rel_bias, layer_idx):
    B, S, _ = h.shape
    lam_init = 0.8 - 0.6 * math.exp(-0.3 * layer_idx)
    proj = h @ w_in
    q, k, v = jnp.split(proj, 3, axis=-1)
    q = q.reshape(B, S, B_HEADS, 2, B_HEAD_DIM) * (B_HEAD_DIM ** -0.5)
    k = k.reshape(B, S, B_HEADS, 2, B_HEAD_DIM)
    v = v.reshape(B, S, B_HEADS, 2 * B_HEAD_DIM)
    lam_f = lam.astype(jnp.float32)
    lam_full = (jnp.exp(jnp.sum(lam_f[0] * lam_f[1])) - jnp.exp(jnp.sum(lam_f[2] * lam_f[3]))
                + lam_init)
    pos = jnp.arange(S, dtype=jnp.int32)

    def block(args):
        qb, tpos = args
        logits = jnp.einsum('bqhmd,bshmd->bhmqs', qb, k).astype(jnp.float32)
        bias = rel_bias[_rel_bucket(tpos[:, None] - pos[None, :])]
        bias = jnp.transpose(bias.reshape(Q_BLOCK, S, B_HEADS, 2), (2, 3, 0, 1))
        causal = pos[None, :] <= tpos[:, None]
        logits = jnp.where(causal, logits + bias, NEG)
        p = jax.nn.softmax(logits, axis=-1)
        a = p[:, :, 0] - lam_full * p[:, :, 1]
        return jnp.einsum('bhqs,bshe->bqhe', a.astype(h.dtype), v)

    o = _from_blocks(lax.map(block, (_to_blocks(q), pos.reshape(S // Q_BLOCK, Q_BLOCK))))
    o = _rms_norm(o, subln_g) * (1.0 - lam_init)
    return o.reshape(B, S, B_HEADS * 2 * B_HEAD_DIM) @ w_o


def _sqrelu_mlp(h, w1, w2):
    return jnp.square(jax.nn.relu(h @ w1)) @ w2


def setup_inputs(seed: int = 0) -> dict:
    key = jax.random.key(seed)
    ks = jax.random.split(key, 20)
    nrm = lambda k, shape, s: jax.random.normal(k, shape, jnp.float32) * s
    D = D_MODEL
    b_w_in = nrm(ks[10], (N_B, D, B_IN), D ** -0.5)
    b_w_in = b_w_in.at[..., 2 * B_QK:].multiply(DN_BETA)
    return {
        'x': nrm(ks[0], (BATCH, SEQ, D), 1.0),
        'c': nrm(ks[1], (BATCH, D), 1.0),
        'rel_bias': nrm(ks[2], (REL_BUCKETS, BIAS_HEADS), 0.5),
        'ada_w': nrm(ks[3], (DEPTH, D, 6 * D), 0.1 * D ** -0.5),
        'ada_b': nrm(ks[4], (DEPTH, 6 * D), 0.01),
        'ln_g': 1.0 + nrm(ks[5], (DEPTH, 2, D), 0.02),
        'ln_b': nrm(ks[6], (DEPTH, 2, D), 0.02),
        'a_w_in': nrm(ks[7], (N_A, D, A_IN), D ** -0.5),
        'a_kv_norm': 1.0 + nrm(ks[8], (N_A, A_KV_RANK), 0.02),
        'a_w_uk': nrm(ks[9], (N_A, A_HEADS, A_QK_DIM, A_KV_RANK), A_KV_RANK ** -0.5),
        'a_w_uv': nrm(ks[11], (N_A, A_HEADS, A_KV_RANK, A_V_DIM), DN_BETA * A_KV_RANK ** -0.5),
        'a_w_o': nrm(ks[12], (N_A, A_HEADS * A_V_DIM, D), DN_BETA * (A_HEADS * A_V_DIM) ** -0.5),
        'b_w_in': b_w_in,
        'b_lambda': nrm(ks[13], (N_B, 4, B_HEAD_DIM), 0.1),
        'b_subln': 1.0 + nrm(ks[14], (N_B, 2 * B_HEAD_DIM), 0.02),
        'b_w_o': nrm(ks[15], (N_B, B_QK, D), DN_BETA * B_QK ** -0.5),
        'mlp_w1': nrm(ks[16], (DEPTH, D, D_FF), D ** -0.5),
        'mlp_w2': nrm(ks[17], (DEPTH, D_FF, D), DN_BETA * D_FF ** -0.5),
    }


def reference(x, c, rel_bias, ada_w, ada_b, ln_g, ln_b,
              a_w_in, a_kv_norm, a_w_uk, a_w_uv, a_w_o,
              b_w_in, b_lambda, b_subln, b_w_o,
              mlp_w1, mlp_w2):
    mod = jnp.einsum('bd,lde->lbe', jax.nn.silu(c), ada_w) + ada_b[:, None]
    for i in range(DEPTH):
        sh_t, sc_t, g_t, sh_c, sc_c, g_c = [m[:, None] for m in jnp.split(mod[i], 6, axis=-1)]
        h = x * (1.0 + sc_t) + sh_t
        j = i // N_MIXERS
        if i % N_MIXERS == 0:
            y = _dsa_mixer(h, a_w_in[j], a_kv_norm[j], a_w_uk[j], a_w_uv[j], a_w_o[j], rel_bias)
        else:
            y = _diff_mixer(h, b_w_in[j], b_lambda[j], b_subln[j], b_w_o[j], rel_bias, i)
        x = _layer_norm(DN_ALPHA * x + (1.0 + g_t) * y, ln_g[i, 0], ln_b[i, 0])
        h = x * (1.0 + sc_c) + sh_c
        y = _sqrelu_mlp(h, mlp_w1[i], mlp_w2[i])
        x = _layer_norm(DN_ALPHA * x + (1.0 + g_c) * y, ln_g[i, 1], ln_b[i, 1])
    return x
```

```cpp
#include <hip/hip_runtime.h>
#include <hip/hip_cooperative_groups.h>
#include <stdint.h>
#include <stdio.h>
namespace cg = cooperative_groups;

typedef unsigned short u16;
typedef short bf16x8 __attribute__((ext_vector_type(8)));
typedef short s16x4 __attribute__((ext_vector_type(4)));
typedef float f32x16 __attribute__((ext_vector_type(16)));
typedef float f32x4 __attribute__((ext_vector_type(4)));
typedef float f32x2 __attribute__((ext_vector_type(2)));
typedef __bf16 bf16x2_t __attribute__((ext_vector_type(2)));
typedef unsigned u32x4 __attribute__((ext_vector_type(4)));
typedef unsigned u32x2 __attribute__((ext_vector_type(2)));
typedef __attribute__((address_space(3))) s16x4* lds_s16x4_ptr;

#define DI __device__ __forceinline__

constexpr int D = 1024, NBATCH = 4, S = 8192, T = NBATCH * S;
constexpr int A_INP = 1920;
constexpr float DN_ALPHA = 1.6817928305074292f;
constexpr float LOG2E = 1.4426950408889634f;
constexpr float LN_EPS = 1e-5f;
constexpr float NEGF = -1e30f;
constexpr int TOPK = 256;
constexpr int CAP = 448;
constexpr int LDS_BYTES = 72 * 1024;

constexpr size_t MB = 1024 * 1024;
constexpr size_t W_AIN = 0;
constexpr size_t W_UK = W_AIN + (size_t)2 * 1920 * 1024 * 2;
constexpr size_t W_UV = W_UK + (size_t)2 * 16 * 256 * 64 * 2;
constexpr size_t W_AO = W_UV + (size_t)2 * 16 * 256 * 64 * 2;
constexpr size_t W_BIN = W_AO + (size_t)2 * 1024 * 1024 * 2;
constexpr size_t W_BO = W_BIN + (size_t)2 * 3072 * 1024 * 2;
constexpr size_t W_W1 = W_BO + (size_t)2 * 1024 * 1024 * 2;
constexpr size_t W_W2 = W_W1 + (size_t)4 * 4096 * 1024 * 2;
constexpr size_t WS_MOD = W_W2 + (size_t)4 * 4096 * 1024 * 2;
constexpr size_t WS_H = WS_MOD + 1 * MB;
constexpr size_t WS_BIG = WS_H + 64 * MB;
constexpr size_t B_Q = 0;
constexpr size_t B_IQ = 64 * MB;
constexpr size_t B_IK = 96 * MB;
constexpr size_t B_IW = 100 * MB;
constexpr size_t B_CKVRAW = 104 * MB;
constexpr size_t B_CKVN = 136 * MB;
constexpr size_t B_SEL = 152 * MB;
constexpr size_t B_K = 64 * MB;
constexpr size_t B_VT = 128 * MB;
constexpr size_t B_O = 192 * MB;

struct Params {
  const float *x, *c, *rel_bias, *ada_w, *ada_b, *ln_g, *ln_b, *a_w_in, *a_kv_norm, *a_w_uk, *a_w_uv, *a_w_o, *b_w_in,
      *b_lambda, *b_subln, *b_w_o, *mlp_w1, *mlp_w2;
  float* out;
  char* ws;
};

DI int opq_tid() {
  int t = threadIdx.x;
  asm volatile("" : "+v"(t));
  return t;
}
DI unsigned pk2(float lo, float hi) {
  f32x2 v = {lo, hi};
  bf16x2_t b = __builtin_convertvector(v, bf16x2_t);
  return __builtin_bit_cast(unsigned, b);
}
DI u16 f2bf(float x) { return (u16)(pk2(x, 0.f) & 0xffffu); }
DI float wave_sum(float v) {
#pragma unroll
  for (int o = 32; o >= 1; o >>= 1) v += __shfl_xor(v, o);
  return v;
}
DI f32x16 mfma32(bf16x8 a, bf16x8 b, f32x16 c) { return __builtin_amdgcn_mfma_f32_32x32x16_bf16(a, b, c, 0, 0, 0); }
DI f32x4 mfma16(bf16x8 a, bf16x8 b, f32x4 c) { return __builtin_amdgcn_mfma_f32_16x16x32_bf16(a, b, c, 0, 0, 0); }
DI int pi_row(int r) { return (r & ~12) | ((r & 4) << 1) | ((r & 8) >> 1); }

DI int rel_bucket(int n) {
  if (n < 16) return n;
  float nf = (float)n;
  int large = 16 + (int)(logf(nf / 16.f) / 2.0794415416798357f * 16.f);
  return large < 31 ? large : 31;
}

DI void tconv_phase(const float* __restrict__ src, u16* __restrict__ dst, int batch, int R, int C, int Cpad, char* smem,
                    int bid, int nb) {
  float* tile = (float*)smem;
  const int tid = opq_tid();
  const int tr = R / 64, tc = Cpad / 64;
  const int ntiles = batch * tr * tc;
  for (int it = bid; it < ntiles; it += nb) {
    const int bi = it / (tr * tc);
    const int rem = it - bi * (tr * tc);
    const int ri = rem / tc, ci = rem - ri * tc;
    const float* s = src + (size_t)bi * R * C;
    u16* d = dst + (size_t)bi * Cpad * R;
    __syncthreads();
#pragma unroll 4
    for (int k = 0; k < 16; k++) {
      const int r = (tid >> 6) + 4 * k;
      const int cc = ci * 64 + (tid & 63);
      float v = (cc < C) ? s[(size_t)(ri * 64 + r) * C + cc] : 0.f;
      tile[r * 65 + (tid & 63)] = v;
    }
    __syncthreads();
#pragma unroll 4
    for (int k = 0; k < 16; k++) {
      const int cl = (tid >> 6) + 4 * k;
      const int rl = tid & 63;
      d[(size_t)(ci * 64 + cl) * R + ri * 64 + rl] = f2bf(tile[rl * 65 + cl]);
    }
  }
}

DI void mod_phase(const Params& p, float* mod, char* smem, int bid, int nb) {
  float* sc = (float*)smem;
  float* red = sc + 4096;
  const int tid = opq_tid(), lane = tid & 63, w = tid >> 6;
  __syncthreads();
  for (int i = tid; i < 4096; i += 256) {
    float v = p.c[i];
    sc[i] = v / (1.f + expf(-v));
  }
  __syncthreads();
  for (int it = bid; it < 4 * 96; it += nb) {
    const int l = it / 96, e0 = (it - l * 96) * 64;
    const float* wp = p.ada_w + ((size_t)l * 1024 + w * 256) * 6144 + e0 + lane;
    float a0 = 0, a1 = 0, a2 = 0, a3 = 0;
#pragma unroll 8
    for (int d = 0; d < 256; d++) {
      float wv = wp[(size_t)d * 6144];
      int dd = w * 256 + d;
      a0 += sc[dd] * wv;
      a1 += sc[1024 + dd] * wv;
      a2 += sc[2048 + dd] * wv;
      a3 += sc[3072 + dd] * wv;
    }
    red[(w * 4 + 0) * 64 + lane] = a0;
    red[(w * 4 + 1) * 64 + lane] = a1;
    red[(w * 4 + 2) * 64 + lane] = a2;
    red[(w * 4 + 3) * 64 + lane] = a3;
    __syncthreads();
    {
      const int b = w;
      float s = red[(0 * 4 + b) * 64 + lane] + red[(1 * 4 + b) * 64 + lane] + red[(2 * 4 + b) * 64 + lane] +
                red[(3 * 4 + b) * 64 + lane] + p.ada_b[l * 6144 + e0 + lane];
      mod[((size_t)l * 4 + b) * 6144 + e0 + lane] = s;
    }
    __syncthreads();
  }
}

DI void h0_phase(const float* __restrict__ x, const float* __restrict__ mod0, u16* __restrict__ h, int bid, int nb) {
  const size_t n8 = (size_t)T * 1024 / 8;
  for (size_t i = (size_t)bid * 256 + opq_tid(); i < n8; i += (size_t)nb * 256) {
    const size_t e = i * 8;
    const int t = (int)(e >> 10), d = (int)(e & 1023), b = t >> 13;
    const float* m = mod0 + (size_t)b * 6144;
    f32x4 v0 = *(const f32x4*)(x + e), v1 = *(const f32x4*)(x + e + 4);
    f32x4 sh0 = *(const f32x4*)(m + d), sh1 = *(const f32x4*)(m + d + 4);
    f32x4 sc0 = *(const f32x4*)(m + 1024 + d), sc1 = *(const f32x4*)(m + 1024 + d + 4);
    v0 = v0 * (1.f + sc0) + sh0;
    v1 = v1 * (1.f + sc1) + sh1;
    u32x4 o;
    o[0] = pk2(v0[0], v0[1]);
    o[1] = pk2(v0[2], v0[3]);
    o[2] = pk2(v1[0], v1[1]);
    o[3] = pk2(v1[2], v1[3]);
    *(u32x4*)(h + e) = o;
  }
}

DI void ln_phase(float* z, const float* __restrict__ g, const float* __restrict__ bt, const float* modn, int sh_off,
                 u16* __restrict__ h, int bid, int nb) {
  const int tid = opq_tid(), lane = tid & 63, w = tid >> 6;
  for (int row = bid * 4 + w; row < T; row += nb * 4) {
    f32x4* zp = (f32x4*)(z + (size_t)row * 1024);
    f32x4 v[4];
#pragma unroll
    for (int c = 0; c < 4; c++) v[c] = zp[c * 64 + lane];
    float s = 0;
#pragma unroll
    for (int c = 0; c < 4; c++) s += v[c][0] + v[c][1] + v[c][2] + v[c][3];
    const float mu = wave_sum(s) * (1.f / 1024.f);
    float q = 0;
#pragma unroll
    for (int c = 0; c < 4; c++) {
      v[c] = v[c] - mu;
      q += v[c][0] * v[c][0] + v[c][1] * v[c][1] + v[c][2] * v[c][2] + v[c][3] * v[c][3];
    }
    const float rstd = rsqrtf(wave_sum(q) * (1.f / 1024.f) + LN_EPS);
    const int b = row >> 13;
#pragma unroll
    for (int c = 0; c < 4; c++) {
      const int d = c * 256 + lane * 4;
      f32x4 y = v[c] * rstd * *(const f32x4*)(g + d) + *(const f32x4*)(bt + d);
      zp[c * 64 + lane] = y;
      if (modn) {
        const float* m = modn + (size_t)b * 6144 + sh_off;
        f32x4 hv = y * (1.f + *(const f32x4*)(m + 1024 + d)) + *(const f32x4*)(m + d);
        u32x2 o;
        o[0] = pk2(hv[0], hv[1]);
        o[1] = pk2(hv[2], hv[3]);
        *(u32x2*)(h + (size_t)row * 1024 + d) = o;
      }
    }
  }
}

enum { EPI_AIN = 0, EPI_BIN = 1, EPI_RES = 2, EPI_SQRELU = 3 };
struct EpiArgs {
  u16 *o0, *o1, *o2;
  float *f0, *f1;
  const float* xin;
  const float* g;
};

template <int EPI>
DI void gemm_phase(const u16* __restrict__ A, const u16* __restrict__ Bt, int M, int N, int K, const EpiArgs& ea,
                   char* smem, int bid, int nb) {
  u16* As = (u16*)smem;
  u16* Bs = As + 128 * 72;
  const int tid = opq_tid(), lane = tid & 63, w = tid >> 6, wm = w >> 1, wn = w & 1, l31 = lane & 31, lh = lane >> 5;
  const int ntn = N / 128, ntm = M / 128, nt = ntn * ntm, nk = K / 64;
  const int lr = tid >> 3, lc = (tid & 7) * 8;
  for (int tile = bid; tile < nt; tile += nb) {
    const int tm = tile / ntn, tn = tile - tm * ntn;
    const int m0 = tm * 128, n0 = tn * 128;
    f32x16 acc[2][2];
#pragma unroll
    for (int i = 0; i < 2; i++)
#pragma unroll
      for (int j = 0; j < 2; j++)
#pragma unroll
        for (int r = 0; r < 16; r++) acc[i][j][r] = 0.f;
    u32x4 ra[4], rb[4];
    const u16* ap = A + (size_t)(m0 + lr) * K + lc;
    const u16* bp = Bt + (size_t)(n0 + lr) * K + lc;
#pragma unroll
    for (int i = 0; i < 4; i++) {
      ra[i] = *(const u32x4*)(ap + (size_t)i * 32 * K);
      rb[i] = *(const u32x4*)(bp + (size_t)i * 32 * K);
    }
    __syncthreads();
#pragma unroll
    for (int i = 0; i < 4; i++) {
      *(u32x4*)&As[(lr + 32 * i) * 72 + lc] = ra[i];
      *(u32x4*)&Bs[(lr + 32 * i) * 72 + lc] = rb[i];
    }
    __syncthreads();
    for (int kt = 0; kt < nk; kt++) {
      if (kt + 1 < nk) {
#pragma unroll
        for (int i = 0; i < 4; i++) {
          ra[i] = *(const u32x4*)(ap + (size_t)i * 32 * K + (kt + 1) * 64);
          rb[i] = *(const u32x4*)(bp + (size_t)i * 32 * K + (kt + 1) * 64);
        }
      }
#pragma unroll
      for (int ks = 0; ks < 4; ks++) {
        bf16x8 a0 = *(const bf16x8*)&As[(wm * 64 + l31) * 72 + ks * 16 + lh * 8];
        bf16x8 a1 = *(const bf16x8*)&As[(wm * 64 + 32 + l31) * 72 + ks * 16 + lh * 8];
        bf16x8 b0 = *(const bf16x8*)&Bs[(wn * 64 + l31) * 72 + ks * 16 + lh * 8];
        bf16x8 b1 = *(const bf16x8*)&Bs[(wn * 64 + 32 + l31) * 72 + ks * 16 + lh * 8];
        acc[0][0] = mfma32(a0, b0, acc[0][0]);
        acc[0][1] = mfma32(a0, b1, acc[0][1]);
        acc[1][0] = mfma32(a1, b0, acc[1][0]);
        acc[1][1] = mfma32(a1, b1, acc[1][1]);
      }
      __syncthreads();
      if (kt + 1 < nk) {
#pragma unroll
        for (int i = 0; i < 4; i++) {
          *(u32x4*)&As[(lr + 32 * i) * 72 + lc] = ra[i];
          *(u32x4*)&Bs[(lr + 32 * i) * 72 + lc] = rb[i];
        }
        __syncthreads();
      }
    }
    const int bidx = m0 >> 13;
#pragma unroll
    for (int i = 0; i < 2; i++) {
#pragma unroll
      for (int j = 0; j < 2; j++) {
        const int col = n0 + wn * 64 + 32 * j + l31;
#pragma unroll
        for (int r4 = 0; r4 < 4; r4++) {
          const int row0 = m0 + wm * 64 + 32 * i + 8 * r4 + 4 * lh;
          float v[4];
#pragma unroll
          for (int q = 0; q < 4; q++) v[q] = acc[i][j][4 * r4 + q];
          if (EPI == EPI_AIN) {
            if (col < 1024) {
#pragma unroll
              for (int q = 0; q < 4; q++) ea.o0[(size_t)(row0 + q) * 1024 + col] = f2bf(v[q]);
            } else if (col < 1280) {
#pragma unroll
              for (int q = 0; q < 4; q++) ea.f0[(size_t)(row0 + q) * 256 + (col - 1024)] = v[q];
            } else if (col < 1792) {
#pragma unroll
              for (int q = 0; q < 4; q++) ea.o1[(size_t)(row0 + q) * 512 + (col - 1280)] = f2bf(v[q]);
            } else if (col < 1856) {
#pragma unroll
              for (int q = 0; q < 4; q++) ea.o2[(size_t)(row0 + q) * 64 + (col - 1792)] = f2bf(v[q]);
            } else if (col < 1864) {
#pragma unroll
              for (int q = 0; q < 4; q++) ea.f1[(size_t)(row0 + q) * 8 + (col - 1856)] = v[q] * 0.044194173824159216f;
            }
          } else if (EPI == EPI_BIN) {
            if (col < 1024) {
#pragma unroll
              for (int q = 0; q < 4; q++) ea.o0[(size_t)(row0 + q) * 1024 + col] = f2bf(v[q] * (0.125f * LOG2E));
            } else if (col < 2048) {
#pragma unroll
              for (int q = 0; q < 4; q++) ea.o1[(size_t)(row0 + q) * 1024 + (col - 1024)] = f2bf(v[q]);
            } else {
              const int cv = col - 2048;
              u32x2 o;
              o[0] = pk2(v[0], v[1]);
              o[1] = pk2(v[2], v[3]);
              *(u32x2*)(ea.o2 + ((size_t)bidx * 1024 + cv) * 8192 + (row0 & 8191)) = o;
            }
          } else if (EPI == EPI_RES) {
            const float gg = 1.f + ea.g[(size_t)bidx * 6144 + col];
#pragma unroll
            for (int q = 0; q < 4; q++) {
              const size_t o = (size_t)(row0 + q) * 1024 + col;
              ea.f0[o] = DN_ALPHA * ea.xin[o] + gg * v[q];
            }
          } else {
#pragma unroll
            for (int q = 0; q < 4; q++) {
              float r = v[q] > 0.f ? v[q] : 0.f;
              ea.o0[(size_t)(row0 + q) * 4096 + col] = f2bf(r * r);
            }
          }
        }
      }
    }
  }
}

DI void ckvnorm_phase(const float* __restrict__ raw, const float* __restrict__ g, u16* __restrict__ outp, int bid,
                      int nb) {
  const int tid = opq_tid(), lane = tid & 63, w = tid >> 6;
  const f32x4 gg = *(const f32x4*)(g + lane * 4);
  for (int row = bid * 4 + w; row < T; row += nb * 4) {
    f32x4 v = *(const f32x4*)(raw + (size_t)row * 256 + lane * 4);
    float ss = v[0] * v[0] + v[1] * v[1] + v[2] * v[2] + v[3] * v[3];
    ss = wave_sum(ss);
    const float r = rsqrtf(ss * (1.f / 256.f) + LN_EPS);
    u32x2 o;
    o[0] = pk2(v[0] * r * gg[0], v[1] * r * gg[1]);
    o[1] = pk2(v[2] * r * gg[2], v[3] * r * gg[3]);
    *(u32x2*)(outp + (size_t)row * 256 + lane * 4) = o;
  }
}

DI unsigned mono_key(float s) {
  unsigned u = __float_as_uint(s);
  return (u & 0x80000000u) ? ~u : (u | 0x80000000u);
}
DI float mono_inv(unsigned k) {
  unsigned u = (k & 0x80000000u) ? (k & 0x7fffffffu) : ~k;
  return __uint_as_float(u);
}
DI int wcount(bool f) { return __popcll(__ballot(f)); }

DI float compact_topk(float* vals, u16* idxs, int n, int lane) {
  constexpr int NPL = CAP / 64;
  unsigned key[NPL];
  unsigned ix[NPL];
  float vv[NPL];
#pragma unroll
  for (int j = 0; j < NPL; j++) {
    const int e = j * 64 + lane;
    const bool in = e < n;
    vv[j] = in ? vals[e] : 0.f;
    ix[j] = in ? idxs[e] : 0xffffu;
    key[j] = in ? mono_key(vv[j]) : 0u;
  }
  unsigned Tk = 0;
  for (int bit = 31; bit >= 0; bit--) {
    const unsigned cand = Tk | (1u << bit);
    int c = 0;
#pragma unroll
    for (int j = 0; j < NPL; j++) c += wcount(key[j] >= cand);
    if (c >= TOPK) Tk = cand;
  }
  int cgt = 0;
#pragma unroll
  for (int j = 0; j < NPL; j++) cgt += wcount(key[j] > Tk);
  const int need = TOPK - cgt;
  unsigned I = 0;
  for (int bit = 13; bit >= 0; bit--) {
    const unsigned cand = I | (1u << bit);
    int c = 0;
#pragma unroll
    for (int j = 0; j < NPL; j++) c += wcount(key[j] == Tk && ix[j] < cand);
    if (c < need) I = cand;
  }
  __builtin_amdgcn_wave_barrier();
  int base = 0;
  const unsigned long long lt = (1ull << lane) - 1ull;
#pragma unroll
  for (int j = 0; j < NPL; j++) {
    const bool keep = (key[j] > Tk) || (key[j] == Tk && ix[j] <= I);
    const unsigned long long m = __ballot(keep);
    if (keep) {
      const int pos = base + __popcll(m & lt);
      vals[pos] = vv[j];
      idxs[pos] = (u16)ix[j];
    }
    base += __popcll(m);
  }
  return mono_inv(Tk);
}

DI void indexer_phase(const u16* __restrict__ iq, const u16* __restrict__ ik, const float* __restrict__ iw,
                      u16* __restrict__ sel, char* smem, int bid, int nb) {
  u16* IKs = (u16*)smem;
  char* wbase = smem + 64 * 72 * 2;
  constexpr int WBYTES = 4 * CAP * 4 + 4 * CAP * 2 + 64;
  const int tid = opq_tid(), lane = tid & 63, w = tid >> 6, l31 = lane & 31, u = lane >> 5;
  float* vals = (float*)(wbase + w * WBYTES);
  u16* idxs = (u16*)(wbase + w * WBYTES + 4 * CAP * 4);
  int* cnt = (int*)(wbase + w * WBYTES + 4 * CAP * 4 + 4 * CAP * 2);
  const int nitems = NBATCH * (S / 16);
  const int nrounds = (nitems + nb - 1) / nb;
  for (int rd = 0; rd < nrounds; rd++) {
    const int it = rd * nb + ((rd & 1) ? (nb - 1 - bid) : bid);
    if (it >= nitems) continue;
    const int b = it & 3, qg = (S / 16 - 1) - (it >> 2);
    const int t0 = qg * 16;
    const size_t tb = (size_t)b * S;
    bf16x8 aq[4];
    {
      const int g = l31 >> 3, up = (l31 >> 2) & 1, j = l31 & 3;
      const int ql = 2 * up + (g >> 1), hd = 4 * (g & 1) + j;
      const u16* qp = iq + (tb + t0 + 4 * w + ql) * 512 + hd * 64 + u * 8;
#pragma unroll
      for (int ks = 0; ks < 4; ks++) aq[ks] = *(const bf16x8*)(qp + ks * 16);
    }
    float wq[2][8];
#pragma unroll
    for (int qq = 0; qq < 2; qq++) {
      const float* wp = iw + (tb + t0 + 4 * w + 2 * u + qq) * 8;
      f32x4 w0 = *(const f32x4*)wp, w1 = *(const f32x4*)(wp + 4);
#pragma unroll
      for (int h = 0; h < 4; h++) {
        wq[qq][h] = w0[h];
        wq[qq][4 + h] = w1[h];
      }
    }
    float thr[2] = {-INFINITY, -INFINITY};
    __syncthreads();
    if (lane < 4) cnt[lane] = 0;
    const int nkt = t0 / 64 + 1;
    u32x4 rk[2];
    const u16* kp = ik + tb * 64;
#pragma unroll
    for (int i = 0; i < 2; i++) rk[i] = *(const u32x4*)(kp + (size_t)(tid + 256 * i) * 8);
#pragma unroll
    for (int i = 0; i < 2; i++) {
      const int id = tid + 256 * i;
      *(u32x4*)&IKs[(id >> 3) * 72 + (id & 7) * 8] = rk[i];
    }
    __syncthreads();
    for (int kt = 0; kt < nkt; kt++) {
      if (kt + 1 < nkt) {
#pragma unroll
        for (int i = 0; i < 2; i++) rk[i] = *(const u32x4*)(kp + (size_t)(kt + 1) * 64 * 64 + (size_t)(tid + 256 * i) * 8);
      }
#pragma unroll
      for (int cb = 0; cb < 2; cb++) {
        f32x16 acc;
#pragma unroll
        for (int r = 0; r < 16; r++) acc[r] = 0.f;
#pragma unroll
        for (int ks = 0; ks < 4; ks++) {
          bf16x8 bf = *(const bf16x8*)&IKs[(32 * cb + l31) * 72 + ks * 16 + u * 8];
          acc = mfma32(aq[ks], bf, acc);
        }
        const int key = kt * 64 + 32 * cb + l31;
#pragma unroll
        for (int qq = 0; qq < 2; qq++) {
          float s = 0.f;
#pragma unroll
          for (int h = 0; h < 8; h++) s += wq[qq][h] * fmaxf(acc[8 * qq + h], 0.f);
          s += 0.0f;
          const int tq = t0 + 4 * w + 2 * u + qq;
          if (key <= tq && s > thr[qq]) {
            const int qs = 2 * u + qq;
            const int pos = atomicAdd(&cnt[qs], 1);
            vals[qs * CAP + pos] = s;
            idxs[qs * CAP + pos] = (u16)key;
          }
        }
      }
      __builtin_amdgcn_wave_barrier();
#pragma unroll 1
      for (int qs = 0; qs < 4; qs++) {
        const int n = cnt[qs];
        if (n > CAP - 64) {
          const float tv = compact_topk(vals + qs * CAP, idxs + qs * CAP, n, lane);
          if (lane == 0) cnt[qs] = TOPK;
          if ((qs >> 1) == u) {
            if (qs & 1) thr[1] = tv; else thr[0] = tv;
          }
        }
      }
      __syncthreads();
      if (kt + 1 < nkt) {
#pragma unroll
        for (int i = 0; i < 2; i++) {
          const int id = tid + 256 * i;
          *(u32x4*)&IKs[(id >> 3) * 72 + (id & 7) * 8] = rk[i];
        }
        __syncthreads();
      }
    }
#pragma unroll 1
    for (int qs = 0; qs < 4; qs++) {
      int n = cnt[qs];
      if (n > TOPK) {
        compact_topk(vals + qs * CAP, idxs + qs * CAP, n, lane);
        n = TOPK;
      }
      __builtin_amdgcn_wave_barrier();
      u16* sp = sel + (tb + t0 + 4 * w + qs) * 256;
#pragma unroll
      for (int j = 0; j < 4; j++) {
        const int e = j * 64 + lane;
        sp[e] = (e < n) ? idxs[qs * CAP + e] : (u16)0xffffu;
      }
    }
  }
}

DI void sparse_phase(const u16* __restrict__ q, const u16* __restrict__ ckvn, const u16* __restrict__ sel,
                     const u16* __restrict__ wuk, const u16* __restrict__ wuv, const float* __restrict__ rel_bias,
                     u16* scratch, u16* __restrict__ o, char* smem, int bid, int nb) {
  constexpr int GS = 264;
  const int tid = opq_tid(), lane = tid & 63, w = tid >> 6, l15 = lane & 15, g = lane >> 4;
  u16* G = (u16*)smem + (size_t)w * 32 * GS;
  int* lut = (int*)(smem + 4 * 32 * GS * 2);
  float* rb = (float*)(lut + 128);
  __syncthreads();
  if (tid < 128) lut[tid] = rel_bucket(tid);
  for (int i = tid; i < 512; i += 256) rb[i] = rel_bias[i] * LOG2E;
  __syncthreads();
  u16* ql = scratch + (size_t)bid * (16 * 16 * 256);
  const int nitems = NBATCH * (S / 16);
  for (int it = bid; it < nitems; it += nb) {
    const int b = it & 3, qg = it >> 2;
    const int t0 = qg * 16;
    const size_t tb = (size_t)b * S;
    for (int hh = 0; hh < 4; hh++) {
      const int h = 4 * w + hh;
      bf16x8 bq[2];
#pragma unroll
      for (int ks = 0; ks < 2; ks++) bq[ks] = *(const bf16x8*)(q + (tb + t0 + l15) * 1024 + h * 64 + ks * 32 + g * 8);
#pragma unroll 4
      for (int rt = 0; rt < 16; rt++) {
        f32x4 acc = {0.f, 0.f, 0.f, 0.f};
#pragma unroll
        for (int ks = 0; ks < 2; ks++) {
          bf16x8 a = *(const bf16x8*)(wuk + ((size_t)h * 256 + rt * 16 + l15) * 64 + ks * 32 + g * 8);
          acc = mfma16(a, bq[ks], acc);
        }
        u32x2 ov;
        ov[0] = pk2(acc[0] * (0.125f * LOG2E), acc[1] * (0.125f * LOG2E));
        ov[1] = pk2(acc[2] * (0.125f * LOG2E), acc[3] * (0.125f * LOG2E));
        *(u32x2*)(ql + ((size_t)l15 * 16 + h) * 256 + rt * 16 + 4 * g) = ov;
      }
    }
    __syncthreads();
#pragma unroll 1
    for (int qi = 0; qi < 4; qi++) {
      const int qloc = 4 * w + qi;
      const int t = t0 + qloc;
      const u16* sp = sel + (tb + t) * 256;
      bf16x8 qb[8];
#pragma unroll
      for (int ks = 0; ks < 8; ks++) qb[ks] = *(const bf16x8*)(ql + ((size_t)qloc * 16 + l15) * 256 + ks * 32 + g * 8);
      float m_run = NEGF, l_run = 0.f;
      f32x4 O[16];
#pragma unroll
      for (int rt = 0; rt < 16; rt++) O[rt] = (f32x4){0.f, 0.f, 0.f, 0.f};
#pragma unroll 1
      for (int ch = 0; ch < 8; ch++) {
        __syncthreads();
#pragma unroll
        for (int hf = 0; hf < 2; hf++) {
          u32x4 gr[8];
#pragma unroll
          for (int i = 0; i < 8; i++) {
            const int pidx = lane + 64 * (i + 8 * hf);
            const int kk = pidx >> 5, c16 = pidx & 31;
            int idx = sp[ch * 32 + kk];
            if (idx == 0xffff) idx = 0;
            gr[i] = *(const u32x4*)(ckvn + (tb + idx) * 256 + c16 * 8);
          }
#pragma unroll
          for (int i = 0; i < 8; i++) {
            const int pidx = lane + 64 * (i + 8 * hf);
            const int kk = pidx >> 5, c16 = pidx & 31;
            *(u32x4*)&G[kk * GS + c16 * 8] = gr[i];
          }
        }
        __syncthreads();
        float lg[2][4];
#pragma unroll
        for (int kbk = 0; kbk < 2; kbk++) {
          f32x4 acc = {0.f, 0.f, 0.f, 0.f};
#pragma unroll
          for (int ks = 0; ks < 8; ks++) {
            bf16x8 a = *(const bf16x8*)&G[(16 * kbk + l15) * GS + ks * 32 + g * 8];
            acc = mfma16(a, qb[ks], acc);
          }
          const s16x4 kid4 = *(const s16x4*)(sp + ch * 32 + 16 * kbk + 4 * g);
#pragma unroll
          for (int i = 0; i < 4; i++) {
            const int kid = (int)(u16)kid4[i];
            float v = NEGF;
            if (kid != 0xffff) {
              int n = t - kid;
              n = n < 0 ? 0 : n;
              const int bk = n < 128 ? lut[n] : 31;
              v = acc[i] + rb[bk * 16 + l15];
            }
            lg[kbk][i] = v;
          }
        }
        float mx = fmaxf(fmaxf(fmaxf(lg[0][0], lg[0][1]), fmaxf(lg[0][2], lg[0][3])),
                         fmaxf(fmaxf(lg[1][0], lg[1][1]), fmaxf(lg[1][2], lg[1][3])));
        mx = fmaxf(mx, __shfl_xor(mx, 16));
        mx = fmaxf(mx, __shfl_xor(mx, 32));
        const float m_new = fmaxf(m_run, mx);
        const float scl = __builtin_amdgcn_exp2f(m_run - m_new);
        m_run = m_new;
        float ps = 0.f;
        float pe[8];
#pragma unroll
        for (int kbk = 0; kbk < 2; kbk++)
#pragma unroll
          for (int i = 0; i < 4; i++) {
            const float pv = __builtin_amdgcn_exp2f(lg[kbk][i] - m_new);
            pe[kbk * 4 + i] = pv;
            ps += pv;
          }
        l_run = l_run * scl + ps;
        u32x4 pw;
        pw[0] = pk2(pe[0], pe[1]);
        pw[1] = pk2(pe[2], pe[3]);
        pw[2] = pk2(pe[4], pe[5]);
        pw[3] = pk2(pe[6], pe[7]);
        const bf16x8 pB = __builtin_bit_cast(bf16x8, pw);
#pragma unroll
        for (int rt = 0; rt < 16; rt++) O[rt] = O[rt] * scl;
        const int q4 = l15 >> 2, p4 = l15 & 3;
#pragma unroll
        for (int rt = 0; rt < 16; rt++) {
          const s16x4 lo = __builtin_amdgcn_ds_read_tr16_b64_v4i16((lds_s16x4_ptr)(&G[(4 * g + q4) * GS + rt * 16 + 4 * p4]));
          const s16x4 hi = __builtin_amdgcn_ds_read_tr16_b64_v4i16((lds_s16x4_ptr)(&G[(16 + 4 * g + q4) * GS + rt * 16 + 4 * p4]));
          const bf16x8 a = (bf16x8){lo[0], lo[1], lo[2], lo[3], hi[0], hi[1], hi[2], hi[3]};
          O[rt] = mfma16(a, pB, O[rt]);
        }
      }
      float lt = l_run;
      lt += __shfl_xor(lt, 16);
      lt += __shfl_xor(lt, 32);
      const float inv = 1.f / lt;
#pragma unroll
      for (int rt = 0; rt < 16; rt++) {
        u32x2 ov;
        ov[0] = pk2(O[rt][0] * inv, O[rt][1] * inv);
        ov[1] = pk2(O[rt][2] * inv, O[rt][3] * inv);
        *(u32x2*)(ql + ((size_t)qloc * 16 + l15) * 256 + rt * 16 + 4 * g) = ov;
      }
    }
    __syncthreads();
    for (int hh = 0; hh < 4; hh++) {
      const int h = 4 * w + hh;
      bf16x8 bo[8];
#pragma unroll
      for (int ks = 0; ks < 8; ks++) bo[ks] = *(const bf16x8*)(ql + ((size_t)l15 * 16 + h) * 256 + ks * 32 + g * 8);
#pragma unroll
      for (int et = 0; et < 4; et++) {
        f32x4 acc = {0.f, 0.f, 0.f, 0.f};
#pragma unroll
        for (int ks = 0; ks < 8; ks++) {
          bf16x8 a = *(const bf16x8*)(wuv + ((size_t)h * 64 + et * 16 + l15) * 256 + ks * 32 + g * 8);
          acc = mfma16(a, bo[ks], acc);
        }
        u32x2 ov;
        ov[0] = pk2(acc[0], acc[1]);
        ov[1] = pk2(acc[2], acc[3]);
        *(u32x2*)(o + (tb + t0 + l15) * 1024 + h * 64 + et * 16 + 4 * g) = ov;
      }
    }
    __syncthreads();
  }
}

DI void diffattn_phase(const u16* __restrict__ q, const u16* __restrict__ k, const u16* __restrict__ vT,
                       u16* __restrict__ o, const float* __restrict__ rel_bias, const float* __restrict__ lam,
                       const float* __restrict__ subln, int layer_idx, char* smem, int bid, int nb) {
  constexpr int KS = 136, VS = 72;
  u16* Ks = (u16*)smem;
  u16* Vs = Ks + 64 * KS;
  float* exch = (float*)smem;
  float* btab = (float*)(smem + 36 * 1024);
  int* lut = (int*)(smem + 36 * 1024 + 1040);
  float* misc = (float*)(smem + 36 * 1024 + 1040 + 512);
  const int tid = opq_tid(), lane = tid & 63, w = tid >> 6, l31 = lane & 31, lh = lane >> 5;
  const int qsub = w >> 1, m = w & 1;
  const float lam_init = 0.8f - 0.6f * expf(-0.3f * (float)layer_idx);
  __syncthreads();
  if (tid < 128) lut[tid] = rel_bucket(tid);
  if (w == 0) {
    float p1 = lam[lane] * lam[64 + lane], p2 = lam[128 + lane] * lam[192 + lane];
    p1 = wave_sum(p1);
    p2 = wave_sum(p2);
    if (lane == 0) misc[0] = expf(p1) - expf(p2) + lam_init;
  }
  __syncthreads();
  const float lam_full = misc[0];
  const int nitems = NBATCH * 8 * (S / 64);
  const int nrounds = (nitems + nb - 1) / nb;
  const int prow = pi_row(l31);
  for (int rd = 0; rd < nrounds; rd++) {
    const int it = rd * nb + ((rd & 1) ? (nb - 1 - bid) : bid);
    if (it >= nitems) continue;
    const int bh = it & 31, qb = (S / 64 - 1) - (it >> 5);
    const int b = bh >> 3, h = bh & 7;
    const int q0 = qb * 64, tq0 = q0 + 32 * qsub, t = tq0 + l31;
    const size_t tb = (size_t)b * S;
    __syncthreads();
    for (int i = tid; i < 258; i += 256) {
      const int n = i >> 1, mm = i & 1;
      const int bk = n < 128 ? lut[n] : 31;
      btab[i] = rel_bias[bk * 16 + 2 * h + mm] * LOG2E;
    }
    bf16x8 qf[4];
#pragma unroll
    for (int ks = 0; ks < 4; ks++) qf[ks] = *(const bf16x8*)(q + (tb + t) * 1024 + h * 128 + m * 64 + ks * 16 + lh * 8);
    f32x16 O[4];
#pragma unroll
    for (int et = 0; et < 4; et++)
#pragma unroll
      for (int r = 0; r < 16; r++) O[et][r] = 0.f;
    float m_run = NEGF, l_run = 0.f;
    const int nkt = qb + 1;
    u32x4 rk[4], rv[4];
    const u16* kp = k + tb * 1024 + h * 128;
    const u16* vp = vT + ((size_t)(b * 8 + h) * 128) * 8192;
#pragma unroll
    for (int i = 0; i < 4; i++) {
      const int id = tid + 256 * i;
      rk[i] = *(const u32x4*)(kp + (size_t)(id >> 4) * 1024 + (id & 15) * 8);
      rv[i] = *(const u32x4*)(vp + (size_t)(id >> 3) * 8192 + (id & 7) * 8);
    }
#pragma unroll
    for (int i = 0; i < 4; i++) {
      const int id = tid + 256 * i;
      *(u32x4*)&Ks[(id >> 4) * KS + (id & 15) * 8] = rk[i];
      *(u32x4*)&Vs[(id >> 3) * VS + (id & 7) * 8] = rv[i];
    }
    __syncthreads();
    const float cfar = btab[256 + m];
    for (int kt = 0; kt < nkt; kt++) {
      if (kt + 1 < nkt) {
#pragma unroll
        for (int i = 0; i < 4; i++) {
          const int id = tid + 256 * i;
          rk[i] = *(const u32x4*)(kp + (size_t)((kt + 1) * 64 + (id >> 4)) * 1024 + (id & 15) * 8);
          rv[i] = *(const u32x4*)(vp + (size_t)(id >> 3) * 8192 + (kt + 1) * 64 + (id & 7) * 8);
        }
      }
      const int s_tile = kt * 64;
      const int nblk = (s_tile + 32 <= tq0 + 31) ? 2 : 1;
#pragma unroll 1
      for (int kb = 0; kb < nblk; kb++) {
        f32x16 acc;
#pragma unroll
        for (int r = 0; r < 16; r++) acc[r] = 0.f;
#pragma unroll
        for (int ks = 0; ks < 4; ks++) {
          bf16x8 a = *(const bf16x8*)&Ks[(32 * kb + prow) * KS + m * 64 + ks * 16 + lh * 8];
          acc = mfma32(a, qf[ks], acc);
        }
        const int s0 = s_tile + 32 * kb;
        const bool nearb = (tq0 - (s0 + 31)) < 128;
        if (nearb) {
#pragma unroll
          for (int r = 0; r < 16; r++) {
            const int key = s0 + 16 * (r >> 3) + 8 * lh + (r & 7);
            const int n = t - key;
            const int nc = n < 0 ? 0 : (n > 128 ? 128 : n);
            const float bv = btab[nc * 2 + m];
            acc[r] = (n < 0) ? NEGF : acc[r] + bv;
          }
        } else {
#pragma unroll
          for (int r = 0; r < 16; r++) acc[r] += cfar;
        }
        float mx = acc[0];
#pragma unroll
        for (int r = 1; r < 16; r++) mx = fmaxf(mx, acc[r]);
        mx = fmaxf(mx, __shfl_xor(mx, 32));
        const float m_new = fmaxf(m_run, mx);
        const float scl = __builtin_amdgcn_exp2f(m_run - m_new);
        m_run = m_new;
        float ps = 0.f;
#pragma unroll
        for (int r = 0; r < 16; r++) {
          const float pv = __builtin_amdgcn_exp2f(acc[r] - m_new);
          acc[r] = pv;
          ps += pv;
        }
        l_run = l_run * scl + ps;
        if (__ballot(scl != 1.f)) {
#pragma unroll
          for (int et = 0; et < 4; et++)
#pragma unroll
            for (int r = 0; r < 16; r++) O[et][r] *= scl;
        }
#pragma unroll
        for (int s2 = 0; s2 < 2; s2++) {
          u32x4 pw;
          pw[0] = pk2(acc[8 * s2 + 0], acc[8 * s2 + 1]);
          pw[1] = pk2(acc[8 * s2 + 2], acc[8 * s2 + 3]);
          pw[2] = pk2(acc[8 * s2 + 4], acc[8 * s2 + 5]);
          pw[3] = pk2(acc[8 * s2 + 6], acc[8 * s2 + 7]);
          const bf16x8 pB = __builtin_bit_cast(bf16x8, pw);
#pragma unroll
          for (int et = 0; et < 4; et++) {
            bf16x8 a = *(const bf16x8*)&Vs[(32 * et + l31) * VS + 32 * kb + 16 * s2 + 8 * lh];
            O[et] = mfma32(a, pB, O[et]);
          }
        }
      }
      __syncthreads();
      if (kt + 1 < nkt) {
#pragma unroll
        for (int i = 0; i < 4; i++) {
          const int id = tid + 256 * i;
          *(u32x4*)&Ks[(id >> 4) * KS + (id & 15) * 8] = rk[i];
          *(u32x4*)&Vs[(id >> 3) * VS + (id & 7) * 8] = rv[i];
        }
        __syncthreads();
      }
    }
    float lt = l_run + __shfl_xor(l_run, 32);
    const float inv = 1.f / lt;
    if (m == 1) {
#pragma unroll
      for (int et = 0; et < 4; et++)
#pragma unroll
        for (int r = 0; r < 16; r++) {
          const int e = 32 * et + (r & 3) + 8 * (r >> 2) + 4 * lh;
          exch[(qsub * 128 + e) * 32 + l31] = O[et][r] * inv;
        }
    }
    __syncthreads();
    if (m == 0) {
      float ss = 0.f;
#pragma unroll
      for (int et = 0; et < 4; et++)
#pragma unroll
        for (int r = 0; r < 16; r++) {
          const int e = 32 * et + (r & 3) + 8 * (r >> 2) + 4 * lh;
          const float v = O[et][r] * inv - lam_full * exch[(qsub * 128 + e) * 32 + l31];
          O[et][r] = v;
          ss += v * v;
        }
      ss += __shfl_xor(ss, 32);
      const float rs = rsqrtf(ss * (1.f / 128.f) + LN_EPS);
      const float osc = 1.f - lam_init;
#pragma unroll
      for (int et = 0; et < 4; et++)
#pragma unroll
        for (int r4 = 0; r4 < 4; r4++) {
          const int e = 32 * et + 8 * r4 + 4 * lh;
          const f32x4 gv = *(const f32x4*)(subln + e);
          u32x2 ov;
          ov[0] = pk2(O[et][4 * r4 + 0] * rs * gv[0] * osc, O[et][4 * r4 + 1] * rs * gv[1] * osc);
          ov[1] = pk2(O[et][4 * r4 + 2] * rs * gv[2] * osc, O[et][4 * r4 + 3] * rs * gv[3] * osc);
          *(u32x2*)(o + (tb + t) * 1024 + h * 128 + e) = ov;
        }
    }
  }
}

__global__ void __launch_bounds__(256, 2) hybrid_fwd(Params p) {
  __shared__ __attribute__((aligned(16))) char smem[LDS_BYTES];
  cg::grid_group grid = cg::this_grid();
  const int bid = blockIdx.x, nb = gridDim.x;
  char* ws = p.ws;
  u16* w_ain = (u16*)(ws + W_AIN);
  u16* w_uk = (u16*)(ws + W_UK);
  u16* w_uv = (u16*)(ws + W_UV);
  u16* w_ao = (u16*)(ws + W_AO);
  u16* w_bin = (u16*)(ws + W_BIN);
  u16* w_bo = (u16*)(ws + W_BO);
  u16* w_w1 = (u16*)(ws + W_W1);
  u16* w_w2 = (u16*)(ws + W_W2);
  float* mod = (float*)(ws + WS_MOD);
  u16* hbuf = (u16*)(ws + WS_H);
  char* big = ws + WS_BIG;
  u16* qbuf = (u16*)(big + B_Q);
  u16* iqbuf = (u16*)(big + B_IQ);
  u16* ikbuf = (u16*)(big + B_IK);
  float* iwbuf = (float*)(big + B_IW);
  float* ckvraw = (float*)(big + B_CKVRAW);
  u16* ckvn = (u16*)(big + B_CKVN);
  u16* selbuf = (u16*)(big + B_SEL);
  u16* kbuf = (u16*)(big + B_K);
  u16* vtbuf = (u16*)(big + B_VT);
  u16* obuf = (u16*)(big + B_O);
  u16* hid = (u16*)big;

  tconv_phase(p.a_w_in, w_ain, 2, 1024, 1864, A_INP, smem, bid, nb);
  tconv_phase(p.a_w_uk, w_uk, 32, 64, 256, 256, smem, bid, nb);
  tconv_phase(p.a_w_uv, w_uv, 32, 256, 64, 64, smem, bid, nb);
  tconv_phase(p.a_w_o, w_ao, 2, 1024, 1024, 1024, smem, bid, nb);
  tconv_phase(p.b_w_in, w_bin, 2, 1024, 3072, 3072, smem, bid, nb);
  tconv_phase(p.b_w_o, w_bo, 2, 1024, 1024, 1024, smem, bid, nb);
  tconv_phase(p.mlp_w1, w_w1, 4, 1024, 4096, 4096, smem, bid, nb);
  tconv_phase(p.mlp_w2, w_w2, 4, 4096, 1024, 1024, smem, bid, nb);
  mod_phase(p, mod, smem, bid, nb);
  grid.sync();
  h0_phase(p.x, mod, hbuf, bid, nb);
  grid.sync();

#pragma unroll 1
  for (int sl = 0; sl < 8; sl++) {
    const int i = sl >> 1, j = i >> 1;
    const float* modi = mod + (size_t)i * 4 * 6144;
    const u16* Ares;
    const u16* Wres;
    int Kres, goff;
    if ((sl & 1) == 0) {
      if ((i & 1) == 0) {
        EpiArgs ea{};
        ea.o0 = qbuf; ea.f0 = ckvraw; ea.o1 = iqbuf; ea.o2 = ikbuf; ea.f1 = iwbuf;
        gemm_phase<EPI_AIN>(hbuf, w_ain + (size_t)j * A_INP * 1024, T, A_INP, 1024, ea, smem, bid, nb);
        grid.sync();
        ckvnorm_phase(ckvraw, p.a_kv_norm + j * 256, ckvn, bid, nb);
#ifndef NO_IDX
        indexer_phase(iqbuf, ikbuf, iwbuf, selbuf, smem, bid, nb);
#endif
        grid.sync();
#ifndef NO_SPARSE
        sparse_phase(qbuf, ckvn, selbuf, w_uk + (size_t)j * 16 * 256 * 64, w_uv + (size_t)j * 16 * 256 * 64, p.rel_bias,
                     hbuf, obuf, smem, bid, nb);
#endif
        grid.sync();
        Wres = w_ao + (size_t)j * 1024 * 1024;
      } else {
        EpiArgs ea{};
        ea.o0 = qbuf; ea.o1 = kbuf; ea.o2 = vtbuf;
        gemm_phase<EPI_BIN>(hbuf, w_bin + (size_t)j * 3072 * 1024, T, 3072, 1024, ea, smem, bid, nb);
        grid.sync();
#ifndef NO_DIFF
        diffattn_phase(qbuf, kbuf, vtbuf, obuf, p.rel_bias, p.b_lambda + j * 256, p.b_subln + j * 128, i, smem, bid, nb);
#endif
        grid.sync();
        Wres = w_bo + (size_t)j * 1024 * 1024;
      }
      Ares = obuf; Kres = 1024; goff = 2 * 1024;
    } else {
      EpiArgs ea{};
      ea.o0 = hid;
      gemm_phase<EPI_SQRELU>(hbuf, w_w1 + (size_t)i * 4096 * 1024, T, 4096, 1024, ea, smem, bid, nb);
      grid.sync();
      Ares = hid; Wres = w_w2 + (size_t)i * 4096 * 1024; Kres = 4096; goff = 5 * 1024;
    }
    {
      EpiArgs ea{};
      ea.f0 = p.out;
      ea.xin = (sl == 0) ? p.x : (const float*)p.out;
      ea.g = modi + goff;
      gemm_phase<EPI_RES>(Ares, Wres, T, 1024, Kres, ea, smem, bid, nb);
    }
    grid.sync();
    {
      const float* modn = ((sl & 1) == 0) ? modi : (i < 3 ? modi + 4 * 6144 : (const float*)nullptr);
      const int sh_off = ((sl & 1) == 0) ? 3 * 1024 : 0;
      ln_phase(p.out, p.ln_g + (size_t)(i * 2 + (sl & 1)) * 1024, p.ln_b + (size_t)(i * 2 + (sl & 1)) * 1024, modn, sh_off,
               hbuf, bid, nb);
    }
    grid.sync();
  }
}

extern "C" void kernel_launch(void* const* d_in, const int* in_sizes, int n_in, void* d_out, int out_size, void* d_ws,
                              size_t ws_size, hipStream_t stream) {
  static int grid_blocks = 0;
  if (!grid_blocks) {
    int dev = 0, cus = 0, per_cu = 0;
    hipGetDevice(&dev);
    hipDeviceGetAttribute(&cus, hipDeviceAttributeMultiprocessorCount, dev);
    hipOccupancyMaxActiveBlocksPerMultiprocessor(&per_cu, hybrid_fwd, 256, 0);
    if (per_cu < 1) per_cu = 1;
    if (per_cu > 2) per_cu = 2;
    grid_blocks = cus * per_cu;
    if (grid_blocks > 512) grid_blocks = 512;
  }
  Params p{};
  p.x = (const float*)d_in[0];
  p.c = (const float*)d_in[1];
  p.rel_bias = (const float*)d_in[2];
  p.ada_w = (const float*)d_in[3];
  p.ada_b = (const float*)d_in[4];
  p.ln_g = (const float*)d_in[5];
  p.ln_b = (const float*)d_in[6];
  p.a_w_in = (const float*)d_in[7];
  p.a_kv_norm = (const float*)d_in[8];
  p.a_w_uk = (const float*)d_in[9];
  p.a_w_uv = (const float*)d_in[10];
  p.a_w_o = (const float*)d_in[11];
  p.b_w_in = (const float*)d_in[12];
  p.b_lambda = (const float*)d_in[13];
  p.b_subln = (const float*)d_in[14];
  p.b_w_o = (const float*)d_in[15];
  p.mlp_w1 = (const float*)d_in[16];
  p.mlp_w2 = (const float*)d_in[17];
  p.out = (float*)d_out;
  p.ws = (char*)d_ws;
  void* args[] = {&p};
  hipError_t e = hipLaunchCooperativeKernel((void*)hybrid_fwd, dim3(grid_blocks), dim3(256), args, 0, stream);
  if (e != hipSuccess) fprintf(stderr, "cooperative launch failed: %s (grid %d)\n", hipGetErrorString(e), grid_blocks);
}
```

```cpp
#include <hip/hip_runtime.h>
#include <hip/hip_cooperative_groups.h>
#include <stdint.h>
#include <stdio.h>
namespace cg = cooperative_groups;

typedef unsigned short u16;
typedef short bf16x8 __attribute__((ext_vector_type(8)));
typedef short s16x4 __attribute__((ext_vector_type(4)));
typedef float f32x16 __attribute__((ext_vector_type(16)));
typedef float f32x4 __attribute__((ext_vector_type(4)));
typedef float f32x2 __attribute__((ext_vector_type(2)));
typedef __bf16 bf16x2_t __attribute__((ext_vector_type(2)));
typedef unsigned u32x4 __attribute__((ext_vector_type(4)));
typedef unsigned u32x2 __attribute__((ext_vector_type(2)));
typedef __attribute__((address_space(3))) s16x4* lds_s16x4_ptr;

#define DI __device__ __forceinline__
#ifndef PROBE_DUP
#define PROBE_DUP 0
#endif

constexpr int D = 1024, NBATCH = 4, S = 8192, T = NBATCH * S;
constexpr int A_INP = 1920;
constexpr float DN_ALPHA = 1.6817928305074292f;
constexpr float LOG2E = 1.4426950408889634f;
constexpr float LN_EPS = 1e-5f;
constexpr float NEGF = -1e30f;
constexpr int TOPK = 256;
constexpr int CAP = 704;
constexpr int LDS_BYTES = 72 * 1024;

constexpr size_t MB = 1024 * 1024;
constexpr size_t W_AIN = 0;
constexpr size_t W_UK = W_AIN + (size_t)2 * 1920 * 1024 * 2;
constexpr size_t W_UV = W_UK + (size_t)2 * 16 * 256 * 64 * 2;
constexpr size_t W_AO = W_UV + (size_t)2 * 16 * 256 * 64 * 2;
constexpr size_t W_BIN = W_AO + (size_t)2 * 1024 * 1024 * 2;
constexpr size_t W_BO = W_BIN + (size_t)2 * 3072 * 1024 * 2;
constexpr size_t W_W1 = W_BO + (size_t)2 * 1024 * 1024 * 2;
constexpr size_t W_W2 = W_W1 + (size_t)4 * 4096 * 1024 * 2;
constexpr size_t WS_MOD = W_W2 + (size_t)4 * 4096 * 1024 * 2;
constexpr size_t WS_H = WS_MOD + 1 * MB;
constexpr size_t WS_BIG = WS_H + 64 * MB;
constexpr size_t B_Q = 0;
constexpr size_t B_IQ = 64 * MB;
constexpr size_t B_IK = 96 * MB;
constexpr size_t B_IW = 100 * MB;
constexpr size_t B_CKVRAW = 104 * MB;
constexpr size_t B_CKVN = 136 * MB;
constexpr size_t B_SEL = 152 * MB;
constexpr size_t B_K = 64 * MB;
constexpr size_t B_VT = 128 * MB;
constexpr size_t B_O = 192 * MB;

struct Params {
  const float *x, *c, *rel_bias, *ada_w, *ada_b, *ln_g, *ln_b, *a_w_in, *a_kv_norm, *a_w_uk, *a_w_uv, *a_w_o, *b_w_in,
      *b_lambda, *b_subln, *b_w_o, *mlp_w1, *mlp_w2;
  float* out;
  char* ws;
};

DI int opq_tid() {
  int t = threadIdx.x;
  asm volatile("" : "+v"(t));
  return t;
}
DI unsigned pk2(float lo, float hi) {
  f32x2 v = {lo, hi};
  bf16x2_t b = __builtin_convertvector(v, bf16x2_t);
  return __builtin_bit_cast(unsigned, b);
}
DI u16 f2bf(float x) { return (u16)(pk2(x, 0.f) & 0xffffu); }
DI float wave_sum(float v) {
#pragma unroll
  for (int o = 32; o >= 1; o >>= 1) v += __shfl_xor(v, o);
  return v;
}
DI f32x16 mfma32(bf16x8 a, bf16x8 b, f32x16 c) { return __builtin_amdgcn_mfma_f32_32x32x16_bf16(a, b, c, 0, 0, 0); }
DI f32x4 mfma16(bf16x8 a, bf16x8 b, f32x4 c) { return __builtin_amdgcn_mfma_f32_16x16x32_bf16(a, b, c, 0, 0, 0); }
DI int pi_row(int r) { return (r & ~12) | ((r & 4) << 1) | ((r & 8) >> 1); }

DI int rel_bucket(int n) {
  if (n < 16) return n;
  float nf = (float)n;
  int large = 16 + (int)(logf(nf / 16.f) / 2.0794415416798357f * 16.f);
  return large < 31 ? large : 31;
}

DI void tconv_phase(const float* __restrict__ src, u16* __restrict__ dst, int batch, int R, int C, int Cpad, char* smem,
                    int bid, int nb) {
  float* tile = (float*)smem;
  const int tid = opq_tid();
  const int tr = R / 64, tc = Cpad / 64;
  const int ntiles = batch * tr * tc;
  for (int it = bid; it < ntiles; it += nb) {
    const int bi = it / (tr * tc);
    const int rem = it - bi * (tr * tc);
    const int ri = rem / tc, ci = rem - ri * tc;
    const float* s = src + (size_t)bi * R * C;
    u16* d = dst + (size_t)bi * Cpad * R;
    __syncthreads();
#pragma unroll 4
    for (int k = 0; k < 16; k++) {
      const int r = (tid >> 6) + 4 * k;
      const int cc = ci * 64 + (tid & 63);
      float v = (cc < C) ? s[(size_t)(ri * 64 + r) * C + cc] : 0.f;
      tile[r * 65 + (tid & 63)] = v;
    }
    __syncthreads();
#pragma unroll 4
    for (int k = 0; k < 16; k++) {
      const int cl = (tid >> 6) + 4 * k;
      const int rl = tid & 63;
      d[(size_t)(ci * 64 + cl) * R + ri * 64 + rl] = f2bf(tile[rl * 65 + cl]);
    }
  }
}

DI void mod_phase(const Params& p, float* mod, char* smem, int bid, int nb) {
  float* sc = (float*)smem;
  float* red = sc + 4096;
  const int tid = opq_tid(), lane = tid & 63, w = tid >> 6;
  __syncthreads();
  for (int i = tid; i < 4096; i += 256) {
    float v = p.c[i];
    sc[i] = v / (1.f + expf(-v));
  }
  __syncthreads();
  for (int it = bid; it < 4 * 96; it += nb) {
    const int l = it / 96, e0 = (it - l * 96) * 64;
    const float* wp = p.ada_w + ((size_t)l * 1024 + w * 256) * 6144 + e0 + lane;
    float a0 = 0, a1 = 0, a2 = 0, a3 = 0;
#pragma unroll 8
    for (int d = 0; d < 256; d++) {
      float wv = wp[(size_t)d * 6144];
      int dd = w * 256 + d;
      a0 += sc[dd] * wv;
      a1 += sc[1024 + dd] * wv;
      a2 += sc[2048 + dd] * wv;
      a3 += sc[3072 + dd] * wv;
    }
    red[(w * 4 + 0) * 64 + lane] = a0;
    red[(w * 4 + 1) * 64 + lane] = a1;
    red[(w * 4 + 2) * 64 + lane] = a2;
    red[(w * 4 + 3) * 64 + lane] = a3;
    __syncthreads();
    {
      const int b = w;
      float s = red[(0 * 4 + b) * 64 + lane] + red[(1 * 4 + b) * 64 + lane] + red[(2 * 4 + b) * 64 + lane] +
                red[(3 * 4 + b) * 64 + lane] + p.ada_b[l * 6144 + e0 + lane];
      mod[((size_t)l * 4 + b) * 6144 + e0 + lane] = s;
    }
    __syncthreads();
  }
}

DI void h0_phase(const float* __restrict__ x, const float* __restrict__ mod0, u16* __restrict__ h, int bid, int nb) {
  const size_t n8 = (size_t)T * 1024 / 8;
  for (size_t i = (size_t)bid * 256 + opq_tid(); i < n8; i += (size_t)nb * 256) {
    const size_t e = i * 8;
    const int t = (int)(e >> 10), d = (int)(e & 1023), b = t >> 13;
    const float* m = mod0 + (size_t)b * 6144;
    f32x4 v0 = *(const f32x4*)(x + e), v1 = *(const f32x4*)(x + e + 4);
    f32x4 sh0 = *(const f32x4*)(m + d), sh1 = *(const f32x4*)(m + d + 4);
    f32x4 sc0 = *(const f32x4*)(m + 1024 + d), sc1 = *(const f32x4*)(m + 1024 + d + 4);
    v0 = v0 * (1.f + sc0) + sh0;
    v1 = v1 * (1.f + sc1) + sh1;
    u32x4 o;
    o[0] = pk2(v0[0], v0[1]);
    o[1] = pk2(v0[2], v0[3]);
    o[2] = pk2(v1[0], v1[1]);
    o[3] = pk2(v1[2], v1[3]);
    *(u32x4*)(h + e) = o;
  }
}

DI void ln_phase(float* z, const float* __restrict__ g, const float* __restrict__ bt, const float* modn, int sh_off,
                 u16* __restrict__ h, int bid, int nb) {
  const int tid = opq_tid(), lane = tid & 63, w = tid >> 6;
  for (int row = bid * 4 + w; row < T; row += nb * 4) {
    f32x4* zp = (f32x4*)(z + (size_t)row * 1024);
    f32x4 v[4];
#pragma unroll
    for (int c = 0; c < 4; c++) v[c] = zp[c * 64 + lane];
    float s = 0;
#pragma unroll
    for (int c = 0; c < 4; c++) s += v[c][0] + v[c][1] + v[c][2] + v[c][3];
    const float mu = wave_sum(s) * (1.f / 1024.f);
    float q = 0;
#pragma unroll
    for (int c = 0; c < 4; c++) {
      v[c] = v[c] - mu;
      q += v[c][0] * v[c][0] + v[c][1] * v[c][1] + v[c][2] * v[c][2] + v[c][3] * v[c][3];
    }
    const float rstd = rsqrtf(wave_sum(q) * (1.f / 1024.f) + LN_EPS);
    const int b = row >> 13;
#pragma unroll
    for (int c = 0; c < 4; c++) {
      const int d = c * 256 + lane * 4;
      f32x4 y = v[c] * rstd * *(const f32x4*)(g + d) + *(const f32x4*)(bt + d);
      zp[c * 64 + lane] = y;
      if (modn) {
        const float* m = modn + (size_t)b * 6144 + sh_off;
        f32x4 hv = y * (1.f + *(const f32x4*)(m + 1024 + d)) + *(const f32x4*)(m + d);
        u32x2 o;
        o[0] = pk2(hv[0], hv[1]);
        o[1] = pk2(hv[2], hv[3]);
        *(u32x2*)(h + (size_t)row * 1024 + d) = o;
      }
    }
  }
}

enum { EPI_AIN = 0, EPI_BIN = 1, EPI_RES = 2, EPI_SQRELU = 3 };
struct EpiArgs {
  u16 *o0, *o1, *o2;
  float *f0, *f1;
  const float* xin;
  const float* g;
};

template <int EPI>
DI void gemm_phase(const u16* __restrict__ A, const u16* __restrict__ Bt, int M, int N, int K, const EpiArgs& ea,
                   char* smem, int bid, int nb) {
  u16* As = (u16*)smem;
  u16* Bs = As + 128 * 72;
  const int tid = opq_tid(), lane = tid & 63, w = tid >> 6, wm = w >> 1, wn = w & 1, l31 = lane & 31, lh = lane >> 5;
  const int ntn = N / 128, ntm = M / 128, nt = ntn * ntm, nk = K / 64;
  const int lr = tid >> 3, lc = (tid & 7) * 8;
  for (int tile = bid; tile < nt; tile += nb) {
    const int tm = tile / ntn, tn = tile - tm * ntn;
    const int m0 = tm * 128, n0 = tn * 128;
    f32x16 acc[2][2];
#pragma unroll
    for (int i = 0; i < 2; i++)
#pragma unroll
      for (int j = 0; j < 2; j++)
#pragma unroll
        for (int r = 0; r < 16; r++) acc[i][j][r] = 0.f;
    u32x4 ra[4], rb[4];
    const u16* ap = A + (size_t)(m0 + lr) * K + lc;
    const u16* bp = Bt + (size_t)(n0 + lr) * K + lc;
#pragma unroll
    for (int i = 0; i < 4; i++) {
      ra[i] = *(const u32x4*)(ap + (size_t)i * 32 * K);
      rb[i] = *(const u32x4*)(bp + (size_t)i * 32 * K);
    }
    __syncthreads();
#pragma unroll
    for (int i = 0; i < 4; i++) {
      *(u32x4*)&As[(lr + 32 * i) * 72 + lc] = ra[i];
      *(u32x4*)&Bs[(lr + 32 * i) * 72 + lc] = rb[i];
    }
    __syncthreads();
    for (int kt = 0; kt < nk; kt++) {
      if (kt + 1 < nk) {
#pragma unroll
        for (int i = 0; i < 4; i++) {
          ra[i] = *(const u32x4*)(ap + (size_t)i * 32 * K + (kt + 1) * 64);
          rb[i] = *(const u32x4*)(bp + (size_t)i * 32 * K + (kt + 1) * 64);
        }
      }
#pragma unroll
      for (int ks = 0; ks < 4; ks++) {
        bf16x8 a0 = *(const bf16x8*)&As[(wm * 64 + l31) * 72 + ks * 16 + lh * 8];
        bf16x8 a1 = *(const bf16x8*)&As[(wm * 64 + 32 + l31) * 72 + ks * 16 + lh * 8];
        bf16x8 b0 = *(const bf16x8*)&Bs[(wn * 64 + l31) * 72 + ks * 16 + lh * 8];
        bf16x8 b1 = *(const bf16x8*)&Bs[(wn * 64 + 32 + l31) * 72 + ks * 16 + lh * 8];
        acc[0][0] = mfma32(a0, b0, acc[0][0]);
        acc[0][1] = mfma32(a0, b1, acc[0][1]);
        acc[1][0] = mfma32(a1, b0, acc[1][0]);
        acc[1][1] = mfma32(a1, b1, acc[1][1]);
      }
      __syncthreads();
      if (kt + 1 < nk) {
#pragma unroll
        for (int i = 0; i < 4; i++) {
          *(u32x4*)&As[(lr + 32 * i) * 72 + lc] = ra[i];
          *(u32x4*)&Bs[(lr + 32 * i) * 72 + lc] = rb[i];
        }
        __syncthreads();
      }
    }
    const int bidx = m0 >> 13;
#pragma unroll
    for (int i = 0; i < 2; i++) {
#pragma unroll
      for (int j = 0; j < 2; j++) {
        const int col = n0 + wn * 64 + 32 * j + l31;
#pragma unroll
        for (int r4 = 0; r4 < 4; r4++) {
          const int row0 = m0 + wm * 64 + 32 * i + 8 * r4 + 4 * lh;
          float v[4];
#pragma unroll
          for (int q = 0; q < 4; q++) v[q] = acc[i][j][4 * r4 + q];
          if (EPI == EPI_AIN) {
            if (col < 1024) {
#pragma unroll
              for (int q = 0; q < 4; q++) ea.o0[(size_t)(row0 + q) * 1024 + col] = f2bf(v[q]);
            } else if (col < 1280) {
#pragma unroll
              for (int q = 0; q < 4; q++) ea.f0[(size_t)(row0 + q) * 256 + (col - 1024)] = v[q];
            } else if (col < 1792) {
#pragma unroll
              for (int q = 0; q < 4; q++) ea.o1[(size_t)(row0 + q) * 512 + (col - 1280)] = f2bf(v[q]);
            } else if (col < 1856) {
#pragma unroll
              for (int q = 0; q < 4; q++) ea.o2[(size_t)(row0 + q) * 64 + (col - 1792)] = f2bf(v[q]);
            } else if (col < 1864) {
#pragma unroll
              for (int q = 0; q < 4; q++) ea.f1[(size_t)(row0 + q) * 8 + (col - 1856)] = v[q] * 0.044194173824159216f;
            }
          } else if (EPI == EPI_BIN) {
            if (col < 1024) {
#pragma unroll
              for (int q = 0; q < 4; q++) ea.o0[(size_t)(row0 + q) * 1024 + col] = f2bf(v[q] * (0.125f * LOG2E));
            } else if (col < 2048) {
#pragma unroll
              for (int q = 0; q < 4; q++) ea.o1[(size_t)(row0 + q) * 1024 + (col - 1024)] = f2bf(v[q]);
            } else {
              const int cv = col - 2048;
              u32x2 o;
              o[0] = pk2(v[0], v[1]);
              o[1] = pk2(v[2], v[3]);
              *(u32x2*)(ea.o2 + ((size_t)bidx * 1024 + cv) * 8192 + (row0 & 8191)) = o;
            }
          } else if (EPI == EPI_RES) {
            const float gg = 1.f + ea.g[(size_t)bidx * 6144 + col];
#pragma unroll
            for (int q = 0; q < 4; q++) {
              const size_t o = (size_t)(row0 + q) * 1024 + col;
              ea.f0[o] = DN_ALPHA * ea.xin[o] + gg * v[q];
            }
          } else {
#pragma unroll
            for (int q = 0; q < 4; q++) {
              float r = v[q] > 0.f ? v[q] : 0.f;
              ea.o0[(size_t)(row0 + q) * 4096 + col] = f2bf(r * r);
            }
          }
        }
      }
    }
  }
}

DI void ckvnorm_phase(const float* __restrict__ raw, const float* __restrict__ g, u16* __restrict__ outp, int bid,
                      int nb) {
  const int tid = opq_tid(), lane = tid & 63, w = tid >> 6;
  const f32x4 gg = *(const f32x4*)(g + lane * 4);
  for (int row = bid * 4 + w; row < T; row += nb * 4) {
    f32x4 v = *(const f32x4*)(raw + (size_t)row * 256 + lane * 4);
    float ss = v[0] * v[0] + v[1] * v[1] + v[2] * v[2] + v[3] * v[3];
    ss = wave_sum(ss);
    const float r = rsqrtf(ss * (1.f / 256.f) + LN_EPS);
    u32x2 o;
    o[0] = pk2(v[0] * r * gg[0], v[1] * r * gg[1]);
    o[1] = pk2(v[2] * r * gg[2], v[3] * r * gg[3]);
    *(u32x2*)(outp + (size_t)row * 256 + lane * 4) = o;
  }
}

DI unsigned mono_key(float s) {
  unsigned u = __float_as_uint(s);
  return (u & 0x80000000u) ? ~u : (u | 0x80000000u);
}
DI float mono_inv(unsigned k) {
  unsigned u = (k & 0x80000000u) ? (k & 0x7fffffffu) : ~k;
  return __uint_as_float(u);
}
DI int wcount(bool f) { return __popcll(__ballot(f)); }

template <bool EXACT>
DI void compact4(float* vals, u16* idxs, int* cnt, int lane, float* thr_out) {
  constexpr int NPL = CAP / 64;
  unsigned key[4][NPL];
  int n[4];
#pragma unroll
  for (int q = 0; q < 4; q++) n[q] = cnt[q];
#pragma unroll
  for (int q = 0; q < 4; q++)
#pragma unroll
    for (int j = 0; j < NPL; j++) {
      const int e = j * 64 + lane;
      key[q][j] = (e < n[q]) ? mono_key(vals[q * CAP + e]) : 0u;
    }
  unsigned Tk[4] = {0u, 0u, 0u, 0u};
  constexpr int LOWBIT = EXACT ? 0 : 16;
#pragma unroll 1
  for (int bit = 31; bit >= LOWBIT; bit--) {
#pragma unroll
    for (int q = 0; q < 4; q++) {
      const unsigned cand = Tk[q] | (1u << bit);
      int c = 0;
#pragma unroll
      for (int j = 0; j < NPL; j++) c += wcount(key[q][j] >= cand);
      Tk[q] = (c >= TOPK) ? cand : Tk[q];
    }
  }
  unsigned I[4] = {0xffffu, 0xffffu, 0xffffu, 0xffffu};
  if (EXACT) {
    unsigned ix[4][NPL];
    int need[4];
#pragma unroll
    for (int q = 0; q < 4; q++) {
      int cgt = 0;
#pragma unroll
      for (int j = 0; j < NPL; j++) {
        const int e = j * 64 + lane;
        ix[q][j] = (e < n[q]) ? (unsigned)idxs[q * CAP + e] : 0xffffu;
        cgt += wcount(key[q][j] > Tk[q]);
      }
      need[q] = TOPK - cgt;
      I[q] = 0u;
    }
#pragma unroll 1
    for (int bit = 13; bit >= 0; bit--) {
#pragma unroll
      for (int q = 0; q < 4; q++) {
        const unsigned cand = I[q] | (1u << bit);
        int c = 0;
#pragma unroll
        for (int j = 0; j < NPL; j++) c += wcount(key[q][j] == Tk[q] && ix[q][j] < cand);
        I[q] = (c < need[q]) ? cand : I[q];
      }
    }
  }
  const unsigned long long lt = (1ull << lane) - 1ull;
#pragma unroll
  for (int q = 0; q < 4; q++) {
    if (n[q] > TOPK) {
      int base = 0;
#pragma unroll
      for (int j = 0; j < NPL; j++) {
        const int e = j * 64 + lane;
        const bool in = e < n[q];
        const float v = in ? vals[q * CAP + e] : 0.f;
        const unsigned ixv = in ? (unsigned)idxs[q * CAP + e] : 0xffffu;
        const bool keep = (key[q][j] > Tk[q]) || (key[q][j] == Tk[q] && ixv <= I[q]);
        const unsigned long long m = __ballot(keep);
        if (keep) {
          const int pos = base + __popcll(m & lt);
          vals[q * CAP + pos] = v;
          idxs[q * CAP + pos] = (u16)ixv;
        }
        base += __popcll(m);
      }
      if (lane == 0) cnt[q] = base;
      thr_out[q] = mono_inv(Tk[q]);
    }
  }
}

DI void indexer_phase(const u16* __restrict__ iq, const u16* __restrict__ ik, const float* __restrict__ iw,
                      u16* __restrict__ sel, char* smem, int bid, int nb) {
  constexpr int WBYTES = 4 * CAP * 4 + 4 * CAP * 2 + 64;
  const int tid = opq_tid(), lane = tid & 63, w = tid >> 6, l31 = lane & 31, u = lane >> 5;
  float* vals = (float*)(smem + w * WBYTES);
  u16* idxs = (u16*)(smem + w * WBYTES + 4 * CAP * 4);
  int* cnt = (int*)(smem + w * WBYTES + 4 * CAP * 4 + 4 * CAP * 2);
  const int nitems = NBATCH * (S / 16);
  const int nrounds = (nitems + nb - 1) / nb;
  __syncthreads();
  for (int rd = 0; rd < nrounds; rd++) {
    const int it = rd * nb + ((rd & 1) ? (nb - 1 - bid) : bid);
    if (it >= nitems) continue;
    const int b = it & 3, qg = (S / 16 - 1) - (it >> 2);
    const int t0 = qg * 16;
    const int tw = t0 + 4 * w;
    const size_t tb = (size_t)b * S;
    bf16x8 aq[4];
    {
      const int g = l31 >> 3, up = (l31 >> 2) & 1, j = l31 & 3;
      const int ql = 2 * up + (g >> 1), hd = 4 * (g & 1) + j;
      const u16* qp = iq + (tb + tw + ql) * 512 + hd * 64 + u * 8;
#pragma unroll
      for (int ks = 0; ks < 4; ks++) aq[ks] = *(const bf16x8*)(qp + ks * 16);
    }
    float wq[2][8];
#pragma unroll
    for (int qq = 0; qq < 2; qq++) {
      const float* wp = iw + (tb + tw + 2 * u + qq) * 8;
      f32x4 w0 = *(const f32x4*)wp, w1 = *(const f32x4*)(wp + 4);
#pragma unroll
      for (int h = 0; h < 4; h++) {
        wq[qq][h] = w0[h];
        wq[qq][4 + h] = w1[h];
      }
    }
    float thr[2] = {-INFINITY, -INFINITY};
    __builtin_amdgcn_wave_barrier();
    if (lane < 4) cnt[lane] = 0;
    __builtin_amdgcn_wave_barrier();
    const int nkb = (tw + 3) / 32 + 1;
    const u16* kp = ik + (tb + l31) * 64 + u * 8;
    bf16x8 bcur[4], bnext[4];
#pragma unroll
    for (int ks = 0; ks < 4; ks++) bcur[ks] = *(const bf16x8*)(kp + ks * 16);
#pragma unroll 1
    for (int kb = 0; kb < nkb; kb++) {
      if (kb + 1 < nkb) {
#pragma unroll
        for (int ks = 0; ks < 4; ks++) bnext[ks] = *(const bf16x8*)(kp + (size_t)(kb + 1) * 32 * 64 + ks * 16);
      }
      f32x16 acc;
#pragma unroll
      for (int r = 0; r < 16; r++) acc[r] = 0.f;
#pragma unroll
      for (int ks = 0; ks < 4; ks++) acc = mfma32(aq[ks], bcur[ks], acc);
      const int key = kb * 32 + l31;
#pragma unroll
      for (int qq = 0; qq < 2; qq++) {
        float s = 0.f;
#pragma unroll
        for (int h = 0; h < 8; h++) s += wq[qq][h] * fmaxf(acc[8 * qq + h], 0.f);
        s += 0.0f;
        const int tq = tw + 2 * u + qq;
        if (key <= tq && s >= thr[qq]) {
          const int qs = 2 * u + qq;
          const int pos = atomicAdd(&cnt[qs], 1);
          vals[qs * CAP + pos] = s;
          idxs[qs * CAP + pos] = (u16)key;
        }
      }
      __builtin_amdgcn_wave_barrier();
      const int c0 = cnt[0], c1 = cnt[1], c2 = cnt[2], c3 = cnt[3];
      if (c0 > CAP - 32 || c1 > CAP - 32 || c2 > CAP - 32 || c3 > CAP - 32) {
        float to[4] = {0.f, 0.f, 0.f, 0.f};
        compact4<false>(vals, idxs, cnt, lane, to);
        __builtin_amdgcn_wave_barrier();
        const int d0 = cnt[0], d1 = cnt[1], d2 = cnt[2], d3 = cnt[3];
        if (d0 > CAP - 128 || d1 > CAP - 128 || d2 > CAP - 128 || d3 > CAP - 128) {
          compact4<true>(vals, idxs, cnt, lane, to);
          __builtin_amdgcn_wave_barrier();
        }
        if (c0 > TOPK && u == 0) thr[0] = to[0];
        if (c1 > TOPK && u == 0) thr[1] = to[1];
        if (c2 > TOPK && u == 1) thr[0] = to[2];
        if (c3 > TOPK && u == 1) thr[1] = to[3];
      }
#pragma unroll
      for (int ks = 0; ks < 4; ks++) bcur[ks] = bnext[ks];
    }
    {
      const int c0 = cnt[0], c1 = cnt[1], c2 = cnt[2], c3 = cnt[3];
      if (c0 > TOPK || c1 > TOPK || c2 > TOPK || c3 > TOPK) {
        float to[4];
        compact4<true>(vals, idxs, cnt, lane, to);
        __builtin_amdgcn_wave_barrier();
      }
    }
#pragma unroll 1
    for (int qs = 0; qs < 4; qs++) {
      const int n = cnt[qs];
      u16* sp = sel + (tb + tw + qs) * 256;
#pragma unroll
      for (int j = 0; j < 4; j++) {
        const int e = j * 64 + lane;
        sp[e] = (e < n) ? idxs[qs * CAP + e] : (u16)0xffffu;
      }
    }
  }
}

DI void sparse_phase(const u16* __restrict__ q, const u16* __restrict__ ckvn, const u16* __restrict__ sel,
                     const u16* __restrict__ wuk, const u16* __restrict__ wuv, const float* __restrict__ rel_bias,
                     u16* scratch, u16* __restrict__ o, char* smem, int bid, int nb) {
  constexpr int GS = 264;
  const int tid = opq_tid(), lane = tid & 63, w = tid >> 6, l15 = lane & 15, g = lane >> 4;
  u16* G = (u16*)smem + (size_t)w * 32 * GS;
  int* lut = (int*)(smem + 4 * 32 * GS * 2);
  float* rb = (float*)(lut + 128);
  __syncthreads();
  if (tid < 128) lut[tid] = rel_bucket(tid);
  for (int i = tid; i < 512; i += 256) rb[i] = rel_bias[i] * LOG2E;
  __syncthreads();
  u16* ql = scratch + (size_t)bid * (16 * 16 * 256);
  const int nitems = NBATCH * (S / 16);
  for (int it = bid; it < nitems; it += nb) {
    const int b = it & 3, qg = it >> 2;
    const int t0 = qg * 16;
    const size_t tb = (size_t)b * S;
    for (int hh = 0; hh < 4; hh++) {
      const int h = 4 * w + hh;
      bf16x8 bq[2];
#pragma unroll
      for (int ks = 0; ks < 2; ks++) bq[ks] = *(const bf16x8*)(q + (tb + t0 + l15) * 1024 + h * 64 + ks * 32 + g * 8);
#pragma unroll 4
      for (int rt = 0; rt < 16; rt++) {
        f32x4 acc = {0.f, 0.f, 0.f, 0.f};
#pragma unroll
        for (int ks = 0; ks < 2; ks++) {
          bf16x8 a = *(const bf16x8*)(wuk + ((size_t)h * 256 + rt * 16 + l15) * 64 + ks * 32 + g * 8);
          acc = mfma16(a, bq[ks], acc);
        }
        u32x2 ov;
        ov[0] = pk2(acc[0] * (0.125f * LOG2E), acc[1] * (0.125f * LOG2E));
        ov[1] = pk2(acc[2] * (0.125f * LOG2E), acc[3] * (0.125f * LOG2E));
        *(u32x2*)(ql + ((size_t)l15 * 16 + h) * 256 + rt * 16 + 4 * g) = ov;
      }
    }
    __syncthreads();
#pragma unroll 1
    for (int qi = 0; qi < 4; qi++) {
      const int qloc = 4 * w + qi;
      const int t = t0 + qloc;
      const u16* sp = sel + (tb + t) * 256;
      bf16x8 qb[8];
#pragma unroll
      for (int ks = 0; ks < 8; ks++) qb[ks] = *(const bf16x8*)(ql + ((size_t)qloc * 16 + l15) * 256 + ks * 32 + g * 8);
      float m_run = NEGF, l_run = 0.f;
      f32x4 O[16];
#pragma unroll
      for (int rt = 0; rt < 16; rt++) O[rt] = (f32x4){0.f, 0.f, 0.f, 0.f};
#pragma unroll 1
      for (int ch = 0; ch < 8; ch++) {
        __syncthreads();
#pragma unroll
        for (int hf = 0; hf < 2; hf++) {
          u32x4 gr[8];
#pragma unroll
          for (int i = 0; i < 8; i++) {
            const int pidx = lane + 64 * (i + 8 * hf);
            const int kk = pidx >> 5, c16 = pidx & 31;
            int idx = sp[ch * 32 + kk];
            if (idx == 0xffff) idx = 0;
            gr[i] = *(const u32x4*)(ckvn + (tb + idx) * 256 + c16 * 8);
          }
#pragma unroll
          for (int i = 0; i < 8; i++) {
            const int pidx = lane + 64 * (i + 8 * hf);
            const int kk = pidx >> 5, c16 = pidx & 31;
            *(u32x4*)&G[kk * GS + c16 * 8] = gr[i];
          }
        }
        __syncthreads();
        float lg[2][4];
#pragma unroll
        for (int kbk = 0; kbk < 2; kbk++) {
          f32x4 acc = {0.f, 0.f, 0.f, 0.f};
#pragma unroll
          for (int ks = 0; ks < 8; ks++) {
            bf16x8 a = *(const bf16x8*)&G[(16 * kbk + l15) * GS + ks * 32 + g * 8];
            acc = mfma16(a, qb[ks], acc);
          }
          const s16x4 kid4 = *(const s16x4*)(sp + ch * 32 + 16 * kbk + 4 * g);
#pragma unroll
          for (int i = 0; i < 4; i++) {
            const int kid = (int)(u16)kid4[i];
            float v = NEGF;
            if (kid != 0xffff) {
              int n = t - kid;
              n = n < 0 ? 0 : n;
              const int bk = n < 128 ? lut[n] : 31;
              v = acc[i] + rb[bk * 16 + l15];
            }
            lg[kbk][i] = v;
          }
        }
        float mx = fmaxf(fmaxf(fmaxf(lg[0][0], lg[0][1]), fmaxf(lg[0][2], lg[0][3])),
                         fmaxf(fmaxf(lg[1][0], lg[1][1]), fmaxf(lg[1][2], lg[1][3])));
        mx = fmaxf(mx, __shfl_xor(mx, 16));
        mx = fmaxf(mx, __shfl_xor(mx, 32));
        const float m_new = fmaxf(m_run, mx);
        const float scl = __builtin_amdgcn_exp2f(m_run - m_new);
        m_run = m_new;
        float ps = 0.f;
        float pe[8];
#pragma unroll
        for (int kbk = 0; kbk < 2; kbk++)
#pragma unroll
          for (int i = 0; i < 4; i++) {
            const float pv = __builtin_amdgcn_exp2f(lg[kbk][i] - m_new);
            pe[kbk * 4 + i] = pv;
            ps += pv;
          }
        l_run = l_run * scl + ps;
        u32x4 pw;
        pw[0] = pk2(pe[0], pe[1]);
        pw[1] = pk2(pe[2], pe[3]);
        pw[2] = pk2(pe[4], pe[5]);
        pw[3] = pk2(pe[6], pe[7]);
        const bf16x8 pB = __builtin_bit_cast(bf16x8, pw);
#pragma unroll
        for (int rt = 0; rt < 16; rt++) O[rt] = O[rt] * scl;
        const int q4 = l15 >> 2, p4 = l15 & 3;
#pragma unroll
        for (int rt = 0; rt < 16; rt++) {
          const s16x4 lo = __builtin_amdgcn_ds_read_tr16_b64_v4i16((lds_s16x4_ptr)(&G[(4 * g + q4) * GS + rt * 16 + 4 * p4]));
          const s16x4 hi = __builtin_amdgcn_ds_read_tr16_b64_v4i16((lds_s16x4_ptr)(&G[(16 + 4 * g + q4) * GS + rt * 16 + 4 * p4]));
          const bf16x8 a = (bf16x8){lo[0], lo[1], lo[2], lo[3], hi[0], hi[1], hi[2], hi[3]};
          O[rt] = mfma16(a, pB, O[rt]);
        }
      }
      float lt = l_run;
      lt += __shfl_xor(lt, 16);
      lt += __shfl_xor(lt, 32);
      const float inv = 1.f / lt;
#pragma unroll
      for (int rt = 0; rt < 16; rt++) {
        u32x2 ov;
        ov[0] = pk2(O[rt][0] * inv, O[rt][1] * inv);
        ov[1] = pk2(O[rt][2] * inv, O[rt][3] * inv);
        *(u32x2*)(ql + ((size_t)qloc * 16 + l15) * 256 + rt * 16 + 4 * g) = ov;
      }
    }
    __syncthreads();
    for (int hh = 0; hh < 4; hh++) {
      const int h = 4 * w + hh;
      bf16x8 bo[8];
#pragma unroll
      for (int ks = 0; ks < 8; ks++) bo[ks] = *(const bf16x8*)(ql + ((size_t)l15 * 16 + h) * 256 + ks * 32 + g * 8);
#pragma unroll
      for (int et = 0; et < 4; et++) {
        f32x4 acc = {0.f, 0.f, 0.f, 0.f};
#pragma unroll
        for (int ks = 0; ks < 8; ks++) {
          bf16x8 a = *(const bf16x8*)(wuv + ((size_t)h * 64 + et * 16 + l15) * 256 + ks * 32 + g * 8);
          acc = mfma16(a, bo[ks], acc);
        }
        u32x2 ov;
        ov[0] = pk2(acc[0], acc[1]);
        ov[1] = pk2(acc[2], acc[3]);
        *(u32x2*)(o + (tb + t0 + l15) * 1024 + h * 64 + et * 16 + 4 * g) = ov;
      }
    }
    __syncthreads();
  }
}

DI void diffattn_phase(const u16* __restrict__ q, const u16* __restrict__ k, const u16* __restrict__ vT,
                       u16* __restrict__ o, const float* __restrict__ rel_bias, const float* __restrict__ lam,
                       const float* __restrict__ subln, int layer_idx, char* smem, int bid, int nb) {
  constexpr int KS = 136, VS = 72;
  u16* Ks = (u16*)smem;
  u16* Vs = Ks + 64 * KS;
  float* exch = (float*)smem;
  float* btab = (float*)(smem + 36 * 1024);
  int* lut = (int*)(smem + 36 * 1024 + 1040);
  float* misc = (float*)(smem + 36 * 1024 + 1040 + 512);
  const int tid = opq_tid(), lane = tid & 63, w = tid >> 6, l31 = lane & 31, lh = lane >> 5;
  const int qsub = w >> 1, m = w & 1;
  const float lam_init = 0.8f - 0.6f * expf(-0.3f * (float)layer_idx);
  __syncthreads();
  if (tid < 128) lut[tid] = rel_bucket(tid);
  if (w == 0) {
    float p1 = lam[lane] * lam[64 + lane], p2 = lam[128 + lane] * lam[192 + lane];
    p1 = wave_sum(p1);
    p2 = wave_sum(p2);
    if (lane == 0) misc[0] = expf(p1) - expf(p2) + lam_init;
  }
  __syncthreads();
  const float lam_full = misc[0];
  const int nitems = NBATCH * 8 * (S / 64);
  const int nrounds = (nitems + nb - 1) / nb;
  const int prow = pi_row(l31);
  for (int rd = 0; rd < nrounds; rd++) {
    const int it = rd * nb + ((rd & 1) ? (nb - 1 - bid) : bid);
    if (it >= nitems) continue;
    const int bh = it & 31, qb = (S / 64 - 1) - (it >> 5);
    const int b = bh >> 3, h = bh & 7;
    const int q0 = qb * 64, tq0 = q0 + 32 * qsub, t = tq0 + l31;
    const size_t tb = (size_t)b * S;
    __syncthreads();
    for (int i = tid; i < 258; i += 256) {
      const int n = i >> 1, mm = i & 1;
      const int bk = n < 128 ? lut[n] : 31;
      btab[i] = rel_bias[bk * 16 + 2 * h + mm] * LOG2E;
    }
    bf16x8 qf[4];
#pragma unroll
    for (int ks = 0; ks < 4; ks++) qf[ks] = *(const bf16x8*)(q + (tb + t) * 1024 + h * 128 + m * 64 + ks * 16 + lh * 8);
    f32x16 O[4];
#pragma unroll
    for (int et = 0; et < 4; et++)
#pragma unroll
      for (int r = 0; r < 16; r++) O[et][r] = 0.f;
    float m_run = NEGF, l_run = 0.f;
    const int nkt = qb + 1;
    u32x4 rk[4], rv[4];
    const u16* kp = k + tb * 1024 + h * 128;
    const u16* vp = vT + ((size_t)(b * 8 + h) * 128) * 8192;
#pragma unroll
    for (int i = 0; i < 4; i++) {
      const int id = tid + 256 * i;
      rk[i] = *(const u32x4*)(kp + (size_t)(id >> 4) * 1024 + (id & 15) * 8);
      rv[i] = *(const u32x4*)(vp + (size_t)(id >> 3) * 8192 + (id & 7) * 8);
    }
#pragma unroll
    for (int i = 0; i < 4; i++) {
      const int id = tid + 256 * i;
      *(u32x4*)&Ks[(id >> 4) * KS + (id & 15) * 8] = rk[i];
      *(u32x4*)&Vs[(id >> 3) * VS + (id & 7) * 8] = rv[i];
    }
    __syncthreads();
    const float cfar = btab[256 + m];
    for (int kt = 0; kt < nkt; kt++) {
      if (kt + 1 < nkt) {
#pragma unroll
        for (int i = 0; i < 4; i++) {
          const int id = tid + 256 * i;
          rk[i] = *(const u32x4*)(kp + (size_t)((kt + 1) * 64 + (id >> 4)) * 1024 + (id & 15) * 8);
          rv[i] = *(const u32x4*)(vp + (size_t)(id >> 3) * 8192 + (kt + 1) * 64 + (id & 7) * 8);
        }
      }
      const int s_tile = kt * 64;
      const int nblk = (s_tile + 32 <= tq0 + 31) ? 2 : 1;
#pragma unroll 1
      for (int kb = 0; kb < nblk; kb++) {
        f32x16 acc;
#pragma unroll
        for (int r = 0; r < 16; r++) acc[r] = 0.f;
#pragma unroll
        for (int ks = 0; ks < 4; ks++) {
          bf16x8 a = *(const bf16x8*)&Ks[(32 * kb + prow) * KS + m * 64 + ks * 16 + lh * 8];
          acc = mfma32(a, qf[ks], acc);
        }
        const int s0 = s_tile + 32 * kb;
        const bool nearb = (tq0 - (s0 + 31)) < 128;
        if (nearb) {
#pragma unroll
          for (int r = 0; r < 16; r++) {
            const int key = s0 + 16 * (r >> 3) + 8 * lh + (r & 7);
            const int n = t - key;
            const int nc = n < 0 ? 0 : (n > 128 ? 128 : n);
            const float bv = btab[nc * 2 + m];
            acc[r] = (n < 0) ? NEGF : acc[r] + bv;
          }
        } else {
#pragma unroll
          for (int r = 0; r < 16; r++) acc[r] += cfar;
        }
        float mx = acc[0];
#pragma unroll
        for (int r = 1; r < 16; r++) mx = fmaxf(mx, acc[r]);
        mx = fmaxf(mx, __shfl_xor(mx, 32));
        const float m_new = fmaxf(m_run, mx);
        const float scl = __builtin_amdgcn_exp2f(m_run - m_new);
        m_run = m_new;
        float ps = 0.f;
#pragma unroll
        for (int r = 0; r < 16; r++) {
          const float pv = __builtin_amdgcn_exp2f(acc[r] - m_new);
          acc[r] = pv;
          ps += pv;
        }
        l_run = l_run * scl + ps;
        if (__ballot(scl != 1.f)) {
#pragma unroll
          for (int et = 0; et < 4; et++)
#pragma unroll
            for (int r = 0; r < 16; r++) O[et][r] *= scl;
        }
#pragma unroll
        for (int s2 = 0; s2 < 2; s2++) {
          u32x4 pw;
          pw[0] = pk2(acc[8 * s2 + 0], acc[8 * s2 + 1]);
          pw[1] = pk2(acc[8 * s2 + 2], acc[8 * s2 + 3]);
          pw[2] = pk2(acc[8 * s2 + 4], acc[8 * s2 + 5]);
          pw[3] = pk2(acc[8 * s2 + 6], acc[8 * s2 + 7]);
          const bf16x8 pB = __builtin_bit_cast(bf16x8, pw);
#pragma unroll
          for (int et = 0; et < 4; et++) {
            bf16x8 a = *(const bf16x8*)&Vs[(32 * et + l31) * VS + 32 * kb + 16 * s2 + 8 * lh];
            O[et] = mfma32(a, pB, O[et]);
          }
        }
      }
      __syncthreads();
      if (kt + 1 < nkt) {
#pragma unroll
        for (int i = 0; i < 4; i++) {
          const int id = tid + 256 * i;
          *(u32x4*)&Ks[(id >> 4) * KS + (id & 15) * 8] = rk[i];
          *(u32x4*)&Vs[(id >> 3) * VS + (id & 7) * 8] = rv[i];
        }
        __syncthreads();
      }
    }
    float lt = l_run + __shfl_xor(l_run, 32);
    const float inv = 1.f / lt;
    if (m == 1) {
#pragma unroll
      for (int et = 0; et < 4; et++)
#pragma unroll
        for (int r = 0; r < 16; r++) {
          const int e = 32 * et + (r & 3) + 8 * (r >> 2) + 4 * lh;
          exch[(qsub * 128 + e) * 32 + l31] = O[et][r] * inv;
        }
    }
    __syncthreads();
    if (m == 0) {
      float ss = 0.f;
#pragma unroll
      for (int et = 0; et < 4; et++)
#pragma unroll
        for (int r = 0; r < 16; r++) {
          const int e = 32 * et + (r & 3) + 8 * (r >> 2) + 4 * lh;
          const float v = O[et][r] * inv - lam_full * exch[(qsub * 128 + e) * 32 + l31];
          O[et][r] = v;
          ss += v * v;
        }
      ss += __shfl_xor(ss, 32);
      const float rs = rsqrtf(ss * (1.f / 128.f) + LN_EPS);
      const float osc = 1.f - lam_init;
#pragma unroll
      for (int et = 0; et < 4; et++)
#pragma unroll
        for (int r4 = 0; r4 < 4; r4++) {
          const int e = 32 * et + 8 * r4 + 4 * lh;
          const f32x4 gv = *(const f32x4*)(subln + e);
          u32x2 ov;
          ov[0] = pk2(O[et][4 * r4 + 0] * rs * gv[0] * osc, O[et][4 * r4 + 1] * rs * gv[1] * osc);
          ov[1] = pk2(O[et][4 * r4 + 2] * rs * gv[2] * osc, O[et][4 * r4 + 3] * rs * gv[3] * osc);
          *(u32x2*)(o + (tb + t) * 1024 + h * 128 + e) = ov;
        }
    }
  }
}

__global__ void __launch_bounds__(256, 2) hybrid_fwd(Params p) {
  __shared__ __attribute__((aligned(16))) char smem[LDS_BYTES];
  cg::grid_group grid = cg::this_grid();
  const int bid = blockIdx.x, nb = gridDim.x;
  char* ws = p.ws;
  u16* w_ain = (u16*)(ws + W_AIN);
  u16* w_uk = (u16*)(ws + W_UK);
  u16* w_uv = (u16*)(ws + W_UV);
  u16* w_ao = (u16*)(ws + W_AO);
  u16* w_bin = (u16*)(ws + W_BIN);
  u16* w_bo = (u16*)(ws + W_BO);
  u16* w_w1 = (u16*)(ws + W_W1);
  u16* w_w2 = (u16*)(ws + W_W2);
  float* mod = (float*)(ws + WS_MOD);
  u16* hbuf = (u16*)(ws + WS_H);
  char* big = ws + WS_BIG;
  u16* qbuf = (u16*)(big + B_Q);
  u16* iqbuf = (u16*)(big + B_IQ);
  u16* ikbuf = (u16*)(big + B_IK);
  float* iwbuf = (float*)(big + B_IW);
  float* ckvraw = (float*)(big + B_CKVRAW);
  u16* ckvn = (u16*)(big + B_CKVN);
  u16* selbuf = (u16*)(big + B_SEL);
  u16* kbuf = (u16*)(big + B_K);
  u16* vtbuf = (u16*)(big + B_VT);
  u16* obuf = (u16*)(big + B_O);
  u16* hid = (u16*)big;

  tconv_phase(p.a_w_in, w_ain, 2, 1024, 1864, A_INP, smem, bid, nb);
  tconv_phase(p.a_w_uk, w_uk, 32, 64, 256, 256, smem, bid, nb);
  tconv_phase(p.a_w_uv, w_uv, 32, 256, 64, 64, smem, bid, nb);
  tconv_phase(p.a_w_o, w_ao, 2, 1024, 1024, 1024, smem, bid, nb);
  tconv_phase(p.b_w_in, w_bin, 2, 1024, 3072, 3072, smem, bid, nb);
  tconv_phase(p.b_w_o, w_bo, 2, 1024, 1024, 1024, smem, bid, nb);
  tconv_phase(p.mlp_w1, w_w1, 4, 1024, 4096, 4096, smem, bid, nb);
  tconv_phase(p.mlp_w2, w_w2, 4, 4096, 1024, 1024, smem, bid, nb);
  mod_phase(p, mod, smem, bid, nb);
  grid.sync();
  h0_phase(p.x, mod, hbuf, bid, nb);
  grid.sync();

#pragma unroll 1
  for (int sl = 0; sl < 8; sl++) {
    const int i = sl >> 1, j = i >> 1;
    const float* modi = mod + (size_t)i * 4 * 6144;
    const u16* Ares;
    const u16* Wres;
    int Kres, goff;
    if ((sl & 1) == 0) {
      if ((i & 1) == 0) {
        EpiArgs ea{};
        ea.o0 = qbuf; ea.f0 = ckvraw; ea.o1 = iqbuf; ea.o2 = ikbuf; ea.f1 = iwbuf;
        for (int rep = 0; rep < (PROBE_DUP == 4 ? 2 : 1); rep++) gemm_phase<EPI_AIN>(hbuf, w_ain + (size_t)j * A_INP * 1024, T, A_INP, 1024, ea, smem, bid, nb);
        grid.sync();
        ckvnorm_phase(ckvraw, p.a_kv_norm + j * 256, ckvn, bid, nb);
        for (int rep = 0; rep < (PROBE_DUP == 2 ? 2 : 1); rep++) indexer_phase(iqbuf, ikbuf, iwbuf, selbuf, smem, bid, nb);
        grid.sync();
        for (int rep = 0; rep < (PROBE_DUP == 3 ? 2 : 1); rep++) sparse_phase(qbuf, ckvn, selbuf, w_uk + (size_t)j * 16 * 256 * 64, w_uv + (size_t)j * 16 * 256 * 64, p.rel_bias,
                     hbuf, obuf, smem, bid, nb);
        grid.sync();
        Wres = w_ao + (size_t)j * 1024 * 1024;
      } else {
        EpiArgs ea{};
        ea.o0 = qbuf; ea.o1 = kbuf; ea.o2 = vtbuf;
        for (int rep = 0; rep < (PROBE_DUP == 4 ? 2 : 1); rep++) gemm_phase<EPI_BIN>(hbuf, w_bin + (size_t)j * 3072 * 1024, T, 3072, 1024, ea, smem, bid, nb);
        grid.sync();
        for (int rep = 0; rep < (PROBE_DUP == 1 ? 2 : 1); rep++) diffattn_phase(qbuf, kbuf, vtbuf, obuf, p.rel_bias, p.b_lambda + j * 256, p.b_subln + j * 128, i, smem, bid, nb);
        grid.sync();
        Wres = w_bo + (size_t)j * 1024 * 1024;
      }
      Ares = obuf; Kres = 1024; goff = 2 * 1024;
    } else {
      EpiArgs ea{};
      ea.o0 = hid;
      for (int rep = 0; rep < (PROBE_DUP == 4 ? 2 : 1); rep++) gemm_phase<EPI_SQRELU>(hbuf, w_w1 + (size_t)i * 4096 * 1024, T, 4096, 1024, ea, smem, bid, nb);
      grid.sync();
      Ares = hid; Wres = w_w2 + (size_t)i * 4096 * 1024; Kres = 4096; goff = 5 * 1024;
    }
    {
      EpiArgs ea{};
      ea.f0 = p.out;
      ea.xin = (sl == 0) ? p.x : (const float*)p.out;
      ea.g = modi + goff;
      gemm_phase<EPI_RES>(Ares, Wres, T, 1024, Kres, ea, smem, bid, nb);
    }
    grid.sync();
    {
      const float* modn = ((sl & 1) == 0) ? modi : (i < 3 ? modi + 4 * 6144 : (const float*)nullptr);
      const int sh_off = ((sl & 1) == 0) ? 3 * 1024 : 0;
      ln_phase(p.out, p.ln_g + (size_t)(i * 2 + (sl & 1)) * 1024, p.ln_b + (size_t)(i * 2 + (sl & 1)) * 1024, modn, sh_off,
               hbuf, bid, nb);
    }
    grid.sync();
  }
}

extern "C" void kernel_launch(void* const* d_in, const int* in_sizes, int n_in, void* d_out, int out_size, void* d_ws,
                              size_t ws_size, hipStream_t stream) {
  static int grid_blocks = 0;
  if (!grid_blocks) {
    int dev = 0, cus = 0, per_cu = 0;
    hipGetDevice(&dev);
    hipDeviceGetAttribute(&cus, hipDeviceAttributeMultiprocessorCount, dev);
    hipOccupancyMaxActiveBlocksPerMultiprocessor(&per_cu, hybrid_fwd, 256, 0);
    if (per_cu < 1) per_cu = 1;
    if (per_cu > 2) per_cu = 2;
    grid_blocks = cus * per_cu;
    if (grid_blocks > 512) grid_blocks = 512;
  }
  Params p{};
  p.x = (const float*)d_in[0];
  p.c = (const float*)d_in[1];
  p.rel_bias = (const float*)d_in[2];
  p.ada_w = (const float*)d_in[3];
  p.ada_b = (const float*)d_in[4];
  p.ln_g = (const float*)d_in[5];
  p.ln_b = (const float*)d_in[6];
  p.a_w_in = (const float*)d_in[7];
  p.a_kv_norm = (const float*)d_in[8];
  p.a_w_uk = (const float*)d_in[9];
  p.a_w_uv = (const float*)d_in[10];
  p.a_w_o = (const float*)d_in[11];
  p.b_w_in = (const float*)d_in[12];
  p.b_lambda = (const float*)d_in[13];
  p.b_subln = (const float*)d_in[14];
  p.b_w_o = (const float*)d_in[15];
  p.mlp_w1 = (const float*)d_in[16];
  p.mlp_w2 = (const float*)d_in[17];
  p.out = (float*)d_out;
  p.ws = (char*)d_ws;
  void* args[] = {&p};
  hipError_t e = hipLaunchCooperativeKernel((void*)hybrid_fwd, dim3(grid_blocks), dim3(256), args, 0, stream);
  if (e != hipSuccess) fprintf(stderr, "cooperative launch failed: %s (grid %d)\n", hipGetErrorString(e), grid_blocks);
}
```

```cpp
#include <hip/hip_runtime.h>
#include <hip/hip_cooperative_groups.h>
#include <stdint.h>
#include <stdio.h>
namespace cg = cooperative_groups;

typedef unsigned short u16;
typedef short bf16x8 __attribute__((ext_vector_type(8)));
typedef short s16x4 __attribute__((ext_vector_type(4)));
typedef float f32x16 __attribute__((ext_vector_type(16)));
typedef float f32x4 __attribute__((ext_vector_type(4)));
typedef float f32x2 __attribute__((ext_vector_type(2)));
typedef __bf16 bf16x2_t __attribute__((ext_vector_type(2)));
typedef unsigned u32x4 __attribute__((ext_vector_type(4)));
typedef unsigned u32x2 __attribute__((ext_vector_type(2)));
typedef __attribute__((address_space(3))) s16x4* lds_s16x4_ptr;

#define DI __device__ __forceinline__
#ifndef PROBE_DUP
#define PROBE_DUP 0
#endif

constexpr int D = 1024, NBATCH = 4, S = 8192, T = NBATCH * S;
constexpr int A_INP = 1920;
constexpr float DN_ALPHA = 1.6817928305074292f;
constexpr float LOG2E = 1.4426950408889634f;
constexpr float LN_EPS = 1e-5f;
constexpr float NEGF = -1e30f;
constexpr int TOPK = 256;
constexpr int CAP = 704;
constexpr int LDS_BYTES = 72 * 1024;

constexpr size_t MB = 1024 * 1024;
constexpr size_t W_AIN = 0;
constexpr size_t W_UK = W_AIN + (size_t)2 * 1920 * 1024 * 2;
constexpr size_t W_UV = W_UK + (size_t)2 * 16 * 256 * 64 * 2;
constexpr size_t W_AO = W_UV + (size_t)2 * 16 * 256 * 64 * 2;
constexpr size_t W_BIN = W_AO + (size_t)2 * 1024 * 1024 * 2;
constexpr size_t W_BO = W_BIN + (size_t)2 * 3072 * 1024 * 2;
constexpr size_t W_W1 = W_BO + (size_t)2 * 1024 * 1024 * 2;
constexpr size_t W_W2 = W_W1 + (size_t)4 * 4096 * 1024 * 2;
constexpr size_t WS_MOD = W_W2 + (size_t)4 * 4096 * 1024 * 2;
constexpr size_t WS_H = WS_MOD + 1 * MB;
constexpr size_t WS_BIG = WS_H + 64 * MB;
constexpr size_t B_Q = 0;
constexpr size_t B_IQ = 64 * MB;
constexpr size_t B_IK = 96 * MB;
constexpr size_t B_IW = 100 * MB;
constexpr size_t B_CKVRAW = 104 * MB;
constexpr size_t B_CKVN = 136 * MB;
constexpr size_t B_SEL = 152 * MB;
constexpr size_t B_K = 64 * MB;
constexpr size_t B_VT = 128 * MB;
constexpr size_t B_O = 192 * MB;

struct Params {
  const float *x, *c, *rel_bias, *ada_w, *ada_b, *ln_g, *ln_b, *a_w_in, *a_kv_norm, *a_w_uk, *a_w_uv, *a_w_o, *b_w_in,
      *b_lambda, *b_subln, *b_w_o, *mlp_w1, *mlp_w2;
  float* out;
  char* ws;
};

DI int opq_tid() {
  int t = threadIdx.x;
  asm volatile("" : "+v"(t));
  return t;
}
DI unsigned pk2(float lo, float hi) {
  f32x2 v = {lo, hi};
  bf16x2_t b = __builtin_convertvector(v, bf16x2_t);
  return __builtin_bit_cast(unsigned, b);
}
DI u16 f2bf(float x) { return (u16)(pk2(x, 0.f) & 0xffffu); }
DI float wave_sum(float v) {
#pragma unroll
  for (int o = 32; o >= 1; o >>= 1) v += __shfl_xor(v, o);
  return v;
}
DI f32x16 mfma32(bf16x8 a, bf16x8 b, f32x16 c) { return __builtin_amdgcn_mfma_f32_32x32x16_bf16(a, b, c, 0, 0, 0); }
DI f32x4 mfma16(bf16x8 a, bf16x8 b, f32x4 c) { return __builtin_amdgcn_mfma_f32_16x16x32_bf16(a, b, c, 0, 0, 0); }
DI int pi_row(int r) { return (r & ~12) | ((r & 4) << 1) | ((r & 8) >> 1); }

DI int rel_bucket(int n) {
  if (n < 16) return n;
  float nf = (float)n;
  int large = 16 + (int)(logf(nf / 16.f) / 2.0794415416798357f * 16.f);
  return large < 31 ? large : 31;
}

DI void tconv_phase(const float* __restrict__ src, u16* __restrict__ dst, int batch, int R, int C, int Cpad, char* smem,
                    int bid, int nb) {
  float* tile = (float*)smem;
  const int tid = opq_tid();
  const int tr = R / 64, tc = Cpad / 64;
  const int ntiles = batch * tr * tc;
  for (int it = bid; it < ntiles; it += nb) {
    const int bi = it / (tr * tc);
    const int rem = it - bi * (tr * tc);
    const int ri = rem / tc, ci = rem - ri * tc;
    const float* s = src + (size_t)bi * R * C;
    u16* d = dst + (size_t)bi * Cpad * R;
    __syncthreads();
#pragma unroll 4
    for (int k = 0; k < 16; k++) {
      const int r = (tid >> 6) + 4 * k;
      const int cc = ci * 64 + (tid & 63);
      float v = (cc < C) ? s[(size_t)(ri * 64 + r) * C + cc] : 0.f;
      tile[r * 65 + (tid & 63)] = v;
    }
    __syncthreads();
#pragma unroll 4
    for (int k = 0; k < 16; k++) {
      const int cl = (tid >> 6) + 4 * k;
      const int rl = tid & 63;
      d[(size_t)(ci * 64 + cl) * R + ri * 64 + rl] = f2bf(tile[rl * 65 + cl]);
    }
  }
}

DI void mod_phase(const Params& p, float* mod, char* smem, int bid, int nb) {
  float* sc = (float*)smem;
  float* red = sc + 4096;
  const int tid = opq_tid(), lane = tid & 63, w = __builtin_amdgcn_readfirstlane(tid >> 6);
  __syncthreads();
  for (int i = tid; i < 4096; i += 256) {
    float v = p.c[i];
    sc[i] = v / (1.f + expf(-v));
  }
  __syncthreads();
  for (int it = bid; it < 4 * 96; it += nb) {
    const int l = it / 96, e0 = (it - l * 96) * 64;
    const float* wp = p.ada_w + ((size_t)l * 1024 + w * 256) * 6144 + e0 + lane;
    float a0 = 0, a1 = 0, a2 = 0, a3 = 0;
#pragma unroll 8
    for (int d = 0; d < 256; d++) {
      float wv = wp[(size_t)d * 6144];
      int dd = w * 256 + d;
      a0 += sc[dd] * wv;
      a1 += sc[1024 + dd] * wv;
      a2 += sc[2048 + dd] * wv;
      a3 += sc[3072 + dd] * wv;
    }
    red[(w * 4 + 0) * 64 + lane] = a0;
    red[(w * 4 + 1) * 64 + lane] = a1;
    red[(w * 4 + 2) * 64 + lane] = a2;
    red[(w * 4 + 3) * 64 + lane] = a3;
    __syncthreads();
    {
      const int b = w;
      float s = red[(0 * 4 + b) * 64 + lane] + red[(1 * 4 + b) * 64 + lane] + red[(2 * 4 + b) * 64 + lane] +
                red[(3 * 4 + b) * 64 + lane] + p.ada_b[l * 6144 + e0 + lane];
      mod[((size_t)l * 4 + b) * 6144 + e0 + lane] = s;
    }
    __syncthreads();
  }
}

DI void h0_phase(const float* __restrict__ x, const float* __restrict__ mod0, u16* __restrict__ h, int bid, int nb) {
  const size_t n8 = (size_t)T * 1024 / 8;
  for (size_t i = (size_t)bid * 256 + opq_tid(); i < n8; i += (size_t)nb * 256) {
    const size_t e = i * 8;
    const int t = (int)(e >> 10), d = (int)(e & 1023), b = t >> 13;
    const float* m = mod0 + (size_t)b * 6144;
    f32x4 v0 = *(const f32x4*)(x + e), v1 = *(const f32x4*)(x + e + 4);
    f32x4 sh0 = *(const f32x4*)(m + d), sh1 = *(const f32x4*)(m + d + 4);
    f32x4 sc0 = *(const f32x4*)(m + 1024 + d), sc1 = *(const f32x4*)(m + 1024 + d + 4);
    v0 = v0 * (1.f + sc0) + sh0;
    v1 = v1 * (1.f + sc1) + sh1;
    u32x4 o;
    o[0] = pk2(v0[0], v0[1]);
    o[1] = pk2(v0[2], v0[3]);
    o[2] = pk2(v1[0], v1[1]);
    o[3] = pk2(v1[2], v1[3]);
    *(u32x4*)(h + e) = o;
  }
}

DI void ln_phase(float* z, const float* __restrict__ g, const float* __restrict__ bt, const float* modn, int sh_off,
                 u16* __restrict__ h, int bid, int nb) {
  const int tid = opq_tid(), lane = tid & 63, w = __builtin_amdgcn_readfirstlane(tid >> 6);
  for (int row = bid * 4 + w; row < T; row += nb * 4) {
    f32x4* zp = (f32x4*)(z + (size_t)row * 1024);
    f32x4 v[4];
#pragma unroll
    for (int c = 0; c < 4; c++) v[c] = zp[c * 64 + lane];
    float s = 0;
#pragma unroll
    for (int c = 0; c < 4; c++) s += v[c][0] + v[c][1] + v[c][2] + v[c][3];
    const float mu = wave_sum(s) * (1.f / 1024.f);
    float q = 0;
#pragma unroll
    for (int c = 0; c < 4; c++) {
      v[c] = v[c] - mu;
      q += v[c][0] * v[c][0] + v[c][1] * v[c][1] + v[c][2] * v[c][2] + v[c][3] * v[c][3];
    }
    const float rstd = rsqrtf(wave_sum(q) * (1.f / 1024.f) + LN_EPS);
    const int b = row >> 13;
#pragma unroll
    for (int c = 0; c < 4; c++) {
      const int d = c * 256 + lane * 4;
      f32x4 y = v[c] * rstd * *(const f32x4*)(g + d) + *(const f32x4*)(bt + d);
      zp[c * 64 + lane] = y;
      if (modn) {
        const float* m = modn + (size_t)b * 6144 + sh_off;
        f32x4 hv = y * (1.f + *(const f32x4*)(m + 1024 + d)) + *(const f32x4*)(m + d);
        u32x2 o;
        o[0] = pk2(hv[0], hv[1]);
        o[1] = pk2(hv[2], hv[3]);
        *(u32x2*)(h + (size_t)row * 1024 + d) = o;
      }
    }
  }
}

enum { EPI_AIN = 0, EPI_BIN = 1, EPI_RES = 2, EPI_SQRELU = 3 };
struct EpiArgs {
  u16 *o0, *o1, *o2;
  float *f0, *f1;
  const float* xin;
  const float* g;
};

template <int EPI>
DI void gemm_phase(const u16* __restrict__ A, const u16* __restrict__ Bt, int M, int N, int K, const EpiArgs& ea,
                   char* smem, int bid, int nb) {
  u16* As = (u16*)smem;
  u16* Bs = As + 128 * 72;
  const int tid = opq_tid(), lane = tid & 63, w = __builtin_amdgcn_readfirstlane(tid >> 6), wm = w >> 1, wn = w & 1, l31 = lane & 31, lh = lane >> 5;
  const int ntn = N / 128, ntm = M / 128, nt = ntn * ntm, nk = K / 64;
  const int lr = tid >> 3, lc = (tid & 7) * 8;
  for (int tile = bid; tile < nt; tile += nb) {
    const int tm = tile / ntn, tn = tile - tm * ntn;
    const int m0 = tm * 128, n0 = tn * 128;
    f32x16 acc[2][2];
#pragma unroll
    for (int i = 0; i < 2; i++)
#pragma unroll
      for (int j = 0; j < 2; j++)
#pragma unroll
        for (int r = 0; r < 16; r++) acc[i][j][r] = 0.f;
    u32x4 ra[4], rb[4];
    const u16* ap = A + (size_t)(m0 + lr) * K + lc;
    const u16* bp = Bt + (size_t)(n0 + lr) * K + lc;
#pragma unroll
    for (int i = 0; i < 4; i++) {
      ra[i] = *(const u32x4*)(ap + (size_t)i * 32 * K);
      rb[i] = *(const u32x4*)(bp + (size_t)i * 32 * K);
    }
    __syncthreads();
#pragma unroll
    for (int i = 0; i < 4; i++) {
      *(u32x4*)&As[(lr + 32 * i) * 72 + lc] = ra[i];
      *(u32x4*)&Bs[(lr + 32 * i) * 72 + lc] = rb[i];
    }
    __syncthreads();
    for (int kt = 0; kt < nk; kt++) {
      if (kt + 1 < nk) {
#pragma unroll
        for (int i = 0; i < 4; i++) {
          ra[i] = *(const u32x4*)(ap + (size_t)i * 32 * K + (kt + 1) * 64);
          rb[i] = *(const u32x4*)(bp + (size_t)i * 32 * K + (kt + 1) * 64);
        }
      }
#pragma unroll
      for (int ks = 0; ks < 4; ks++) {
        bf16x8 a0 = *(const bf16x8*)&As[(wm * 64 + l31) * 72 + ks * 16 + lh * 8];
        bf16x8 a1 = *(const bf16x8*)&As[(wm * 64 + 32 + l31) * 72 + ks * 16 + lh * 8];
        bf16x8 b0 = *(const bf16x8*)&Bs[(wn * 64 + l31) * 72 + ks * 16 + lh * 8];
        bf16x8 b1 = *(const bf16x8*)&Bs[(wn * 64 + 32 + l31) * 72 + ks * 16 + lh * 8];
        acc[0][0] = mfma32(a0, b0, acc[0][0]);
        acc[0][1] = mfma32(a0, b1, acc[0][1]);
        acc[1][0] = mfma32(a1, b0, acc[1][0]);
        acc[1][1] = mfma32(a1, b1, acc[1][1]);
      }
      __syncthreads();
      if (kt + 1 < nk) {
#pragma unroll
        for (int i = 0; i < 4; i++) {
          *(u32x4*)&As[(lr + 32 * i) * 72 + lc] = ra[i];
          *(u32x4*)&Bs[(lr + 32 * i) * 72 + lc] = rb[i];
        }
        __syncthreads();
      }
    }
    const int bidx = m0 >> 13;
#pragma unroll
    for (int i = 0; i < 2; i++) {
#pragma unroll
      for (int j = 0; j < 2; j++) {
        const int col = n0 + wn * 64 + 32 * j + l31;
#pragma unroll
        for (int r4 = 0; r4 < 4; r4++) {
          const int row0 = m0 + wm * 64 + 32 * i + 8 * r4 + 4 * lh;
          float v[4];
#pragma unroll
          for (int q = 0; q < 4; q++) v[q] = acc[i][j][4 * r4 + q];
          if (EPI == EPI_AIN) {
            if (col < 1024) {
#pragma unroll
              for (int q = 0; q < 4; q++) ea.o0[(size_t)(row0 + q) * 1024 + col] = f2bf(v[q]);
            } else if (col < 1280) {
#pragma unroll
              for (int q = 0; q < 4; q++) ea.f0[(size_t)(row0 + q) * 256 + (col - 1024)] = v[q];
            } else if (col < 1792) {
#pragma unroll
              for (int q = 0; q < 4; q++) ea.o1[(size_t)(row0 + q) * 512 + (col - 1280)] = f2bf(v[q]);
            } else if (col < 1856) {
#pragma unroll
              for (int q = 0; q < 4; q++) {
                const int d = col - 1792, row = row0 + q;
                const int sidx = row & 8191;
                const size_t off = (size_t)(row >> 13) * S * 64 +
                                   ((size_t)((sidx >> 5) * 4 + (d >> 4)) * 64 + 32 * ((d >> 3) & 1) + (sidx & 31)) * 8 + (d & 7);
                ea.o2[off] = f2bf(v[q]);
              }
            } else if (col < 1864) {
#pragma unroll
              for (int q = 0; q < 4; q++) ea.f1[(size_t)(row0 + q) * 8 + (col - 1856)] = v[q] * 0.044194173824159216f;
            }
          } else if (EPI == EPI_BIN) {
            if (col < 1024) {
#pragma unroll
              for (int q = 0; q < 4; q++) ea.o0[(size_t)(row0 + q) * 1024 + col] = f2bf(v[q] * (0.125f * LOG2E));
            } else if (col < 2048) {
#pragma unroll
              for (int q = 0; q < 4; q++) ea.o1[(size_t)(row0 + q) * 1024 + (col - 1024)] = f2bf(v[q]);
            } else {
              const int cv = col - 2048;
              u32x2 o;
              o[0] = pk2(v[0], v[1]);
              o[1] = pk2(v[2], v[3]);
              *(u32x2*)(ea.o2 + ((size_t)bidx * 1024 + cv) * 8192 + (row0 & 8191)) = o;
            }
          } else if (EPI == EPI_RES) {
            const float gg = 1.f + ea.g[(size_t)bidx * 6144 + col];
#pragma unroll
            for (int q = 0; q < 4; q++) {
              const size_t o = (size_t)(row0 + q) * 1024 + col;
              ea.f0[o] = DN_ALPHA * ea.xin[o] + gg * v[q];
            }
          } else {
#pragma unroll
            for (int q = 0; q < 4; q++) {
              float r = v[q] > 0.f ? v[q] : 0.f;
              ea.o0[(size_t)(row0 + q) * 4096 + col] = f2bf(r * r);
            }
          }
        }
      }
    }
  }
}

DI void ckvnorm_phase(const float* __restrict__ raw, const float* __restrict__ g, u16* __restrict__ outp, int bid,
                      int nb) {
  const int tid = opq_tid(), lane = tid & 63, w = __builtin_amdgcn_readfirstlane(tid >> 6);
  const f32x4 gg = *(const f32x4*)(g + lane * 4);
  for (int row = bid * 4 + w; row < T; row += nb * 4) {
    f32x4 v = *(const f32x4*)(raw + (size_t)row * 256 + lane * 4);
    float ss = v[0] * v[0] + v[1] * v[1] + v[2] * v[2] + v[3] * v[3];
    ss = wave_sum(ss);
    const float r = rsqrtf(ss * (1.f / 256.f) + LN_EPS);
    u32x2 o;
    o[0] = pk2(v[0] * r * gg[0], v[1] * r * gg[1]);
    o[1] = pk2(v[2] * r * gg[2], v[3] * r * gg[3]);
    *(u32x2*)(outp + (size_t)row * 256 + lane * 4) = o;
  }
}

DI unsigned mono_key(float s) {
  unsigned u = __float_as_uint(s);
  return (u & 0x80000000u) ? ~u : (u | 0x80000000u);
}
DI float mono_inv(unsigned k) {
  unsigned u = (k & 0x80000000u) ? (k & 0x7fffffffu) : ~k;
  return __uint_as_float(u);
}
DI float relu_i(float x) {
  int i = __float_as_int(x);
  return __int_as_float(i > 0 ? i : 0);
}
DI int wcount(bool f) { return __popcll(__ballot(f)); }

template <bool EXACT>
DI void compact4(float* vals, u16* idxs, int* cnt, int lane, float* thr_out) {
  constexpr int NPL = CAP / 64;
  unsigned key[4][NPL];
  int n[4];
#pragma unroll
  for (int q = 0; q < 4; q++) n[q] = cnt[q];
#pragma unroll
  for (int q = 0; q < 4; q++)
#pragma unroll
    for (int j = 0; j < NPL; j++) {
      const int e = j * 64 + lane;
      key[q][j] = (e < n[q]) ? mono_key(vals[q * CAP + e]) : 0u;
    }
  unsigned Tk[4] = {0u, 0u, 0u, 0u};
  constexpr int LOWBIT = EXACT ? 0 : 18;
#pragma unroll 1
  for (int bit = 31; bit >= LOWBIT; bit--) {
#pragma unroll
    for (int q = 0; q < 4; q++) {
      const unsigned cand = Tk[q] | (1u << bit);
      int c = 0;
#pragma unroll
      for (int j = 0; j < NPL; j++) c += wcount(key[q][j] >= cand);
      Tk[q] = (c >= TOPK) ? cand : Tk[q];
    }
  }
  unsigned I[4] = {0xffffu, 0xffffu, 0xffffu, 0xffffu};
  if (EXACT) {
    unsigned ix[4][NPL];
    int need[4];
#pragma unroll
    for (int q = 0; q < 4; q++) {
      int cgt = 0;
#pragma unroll
      for (int j = 0; j < NPL; j++) {
        const int e = j * 64 + lane;
        ix[q][j] = (e < n[q]) ? (unsigned)idxs[q * CAP + e] : 0xffffu;
        cgt += wcount(key[q][j] > Tk[q]);
      }
      need[q] = TOPK - cgt;
      I[q] = 0u;
    }
#pragma unroll 1
    for (int bit = 13; bit >= 0; bit--) {
#pragma unroll
      for (int q = 0; q < 4; q++) {
        const unsigned cand = I[q] | (1u << bit);
        int c = 0;
#pragma unroll
        for (int j = 0; j < NPL; j++) c += wcount(key[q][j] == Tk[q] && ix[q][j] < cand);
        I[q] = (c < need[q]) ? cand : I[q];
      }
    }
  }
  const unsigned long long lt = (1ull << lane) - 1ull;
#pragma unroll
  for (int q = 0; q < 4; q++) {
    if (n[q] > TOPK) {
      int base = 0;
#pragma unroll
      for (int j = 0; j < NPL; j++) {
        const int e = j * 64 + lane;
        const bool in = e < n[q];
        const float v = in ? vals[q * CAP + e] : 0.f;
        const unsigned ixv = in ? (unsigned)idxs[q * CAP + e] : 0xffffu;
        const bool keep = (key[q][j] > Tk[q]) || (key[q][j] == Tk[q] && ixv <= I[q]);
        const unsigned long long m = __ballot(keep);
        if (keep) {
          const int pos = base + __popcll(m & lt);
          vals[q * CAP + pos] = v;
          idxs[q * CAP + pos] = (u16)ixv;
        }
        base += __popcll(m);
      }
      if (lane == 0) cnt[q] = base;
      thr_out[q] = mono_inv(Tk[q]);
    }
  }
}

DI void indexer_phase(const u16* __restrict__ iq, const u16* __restrict__ ik, const float* __restrict__ iw,
                      u16* __restrict__ sel, char* smem, int bid, int nb) {
  constexpr int WBYTES = 4 * CAP * 4 + 4 * CAP * 2 + 64;
  const int tid = opq_tid(), lane = tid & 63, w = __builtin_amdgcn_readfirstlane(tid >> 6), l31 = lane & 31, u = lane >> 5;
  float* vals = (float*)(smem + w * WBYTES);
  u16* idxs = (u16*)(smem + w * WBYTES + 4 * CAP * 4);
  int* cnt = (int*)(smem + w * WBYTES + 4 * CAP * 4 + 4 * CAP * 2);
  const int nitems = NBATCH * (S / 16);
  const int nrounds = (nitems + nb - 1) / nb;
  __syncthreads();
  for (int rd = 0; rd < nrounds; rd++) {
    const int it = rd * nb + ((rd & 1) ? (nb - 1 - bid) : bid);
    if (it >= nitems) continue;
    const int b = it & 3, qg = (S / 16 - 1) - (it >> 2);
    const int t0 = qg * 16;
    const int tw = t0 + 4 * w;
    const size_t tb = (size_t)b * S;
    bf16x8 aq[4];
    {
      const int g = l31 >> 3, up = (l31 >> 2) & 1, j = l31 & 3;
      const int ql = 2 * up + (g >> 1), hd = 4 * (g & 1) + j;
      const u16* qp = iq + (tb + tw + ql) * 512 + hd * 64 + u * 8;
#pragma unroll
      for (int ks = 0; ks < 4; ks++) aq[ks] = *(const bf16x8*)(qp + ks * 16);
    }
    float wq[2][8];
#pragma unroll
    for (int qq = 0; qq < 2; qq++) {
      const float* wp = iw + (tb + tw + 2 * u + qq) * 8;
      f32x4 w0 = *(const f32x4*)wp, w1 = *(const f32x4*)(wp + 4);
#pragma unroll
      for (int h = 0; h < 4; h++) {
        wq[qq][h] = w0[h];
        wq[qq][4 + h] = w1[h];
      }
    }
    float thr[2] = {-INFINITY, -INFINITY};
    __builtin_amdgcn_wave_barrier();
    if (lane < 4) cnt[lane] = 0;
    __builtin_amdgcn_wave_barrier();
    const int nkb = (tw + 3) / 32 + 1;
    const u16* kp = ik + tb * 64 + lane * 8;
    bf16x8 ring[4][4];
#pragma unroll
    for (int i = 0; i < 4; i++) {
      const int kbn = (i < nkb) ? i : nkb - 1;
#pragma unroll
      for (int ks = 0; ks < 4; ks++) ring[i][ks] = *(const bf16x8*)(kp + (size_t)(kbn * 4 + ks) * 512);
    }
#pragma unroll 1
    for (int kb0 = 0; kb0 < nkb; kb0 += 4) {
#pragma unroll
      for (int i = 0; i < 4; i++) {
        const int kb = kb0 + i;
        {
          f32x16 acc;
#pragma unroll
          for (int r = 0; r < 16; r++) acc[r] = 0.f;
#pragma unroll
          for (int ks = 0; ks < 4; ks++) acc = mfma32(aq[ks], ring[i][ks], acc);
          {
            const int kbn = (kb + 4 < nkb) ? kb + 4 : nkb - 1;
#pragma unroll
            for (int ks = 0; ks < 4; ks++) ring[i][ks] = *(const bf16x8*)(kp + (size_t)(kbn * 4 + ks) * 512);
          }
          const int key = kb * 32 + l31;
#pragma unroll
          for (int qq = 0; qq < 2; qq++) {
            float s0 = 0.f, s1 = 0.f;
#pragma unroll
            for (int h = 0; h < 8; h += 2) {
              s0 = fmaf(wq[qq][h], relu_i(acc[8 * qq + h]), s0);
              s1 = fmaf(wq[qq][h + 1], relu_i(acc[8 * qq + h + 1]), s1);
            }
            float s = s0 + s1;
            s += 0.0f;
            const int tq = tw + 2 * u + qq;
            if (key <= tq && s >= thr[qq]) {
              const int qs = 2 * u + qq;
              const int pos = atomicAdd(&cnt[qs], 1);
              vals[qs * CAP + pos] = s;
              idxs[qs * CAP + pos] = (u16)key;
            }
          }
        }
      }
      __builtin_amdgcn_wave_barrier();
      const int c0 = cnt[0], c1 = cnt[1], c2 = cnt[2], c3 = cnt[3];
      if (c0 > CAP - 128 || c1 > CAP - 128 || c2 > CAP - 128 || c3 > CAP - 128) {
        float to[4] = {0.f, 0.f, 0.f, 0.f};
        compact4<false>(vals, idxs, cnt, lane, to);
        __builtin_amdgcn_wave_barrier();
        const int d0 = cnt[0], d1 = cnt[1], d2 = cnt[2], d3 = cnt[3];
        if (d0 > CAP - 256 || d1 > CAP - 256 || d2 > CAP - 256 || d3 > CAP - 256) {
          compact4<true>(vals, idxs, cnt, lane, to);
          __builtin_amdgcn_wave_barrier();
        }
        if (c0 > TOPK && u == 0) thr[0] = to[0];
        if (c1 > TOPK && u == 0) thr[1] = to[1];
        if (c2 > TOPK && u == 1) thr[0] = to[2];
        if (c3 > TOPK && u == 1) thr[1] = to[3];
      }
    }
    {
      const int c0 = cnt[0], c1 = cnt[1], c2 = cnt[2], c3 = cnt[3];
      if (c0 > TOPK || c1 > TOPK || c2 > TOPK || c3 > TOPK) {
        float to[4];
        compact4<true>(vals, idxs, cnt, lane, to);
        __builtin_amdgcn_wave_barrier();
      }
    }
#pragma unroll 1
    for (int qs = 0; qs < 4; qs++) {
      const int n = cnt[qs];
      u16* sp = sel + (tb + tw + qs) * 256;
#pragma unroll
      for (int j = 0; j < 4; j++) {
        const int e = j * 64 + lane;
        sp[e] = (e < n) ? idxs[qs * CAP + e] : (u16)0xffffu;
      }
    }
  }
}

DI void sparse_phase(const u16* __restrict__ q, const u16* __restrict__ ckvn, const u16* __restrict__ sel,
                     const u16* __restrict__ wuk, const u16* __restrict__ wuv, const float* __restrict__ rel_bias,
                     u16* scratch, u16* __restrict__ o, char* smem, int bid, int nb) {
  constexpr int GS = 264;
  const int tid = opq_tid(), lane = tid & 63, w = __builtin_amdgcn_readfirstlane(tid >> 6), l15 = lane & 15, g = lane >> 4;
  u16* G = (u16*)smem + (size_t)w * 32 * GS;
  int* lut = (int*)(smem + 4 * 32 * GS * 2);
  float* rb = (float*)(lut + 128);
  __syncthreads();
  if (tid < 128) lut[tid] = rel_bucket(tid);
  for (int i = tid; i < 512; i += 256) rb[i] = rel_bias[i] * LOG2E;
  __syncthreads();
  u16* ql = scratch + (size_t)bid * (16 * 16 * 256);
  const int nitems = NBATCH * (S / 16);
  for (int it = bid; it < nitems; it += nb) {
    const int b = it & 3, qg = it >> 2;
    const int t0 = qg * 16;
    const size_t tb = (size_t)b * S;
    for (int hh = 0; hh < 4; hh++) {
      const int h = 4 * w + hh;
      bf16x8 bq[2];
#pragma unroll
      for (int ks = 0; ks < 2; ks++) bq[ks] = *(const bf16x8*)(q + (tb + t0 + l15) * 1024 + h * 64 + ks * 32 + g * 8);
#pragma unroll 4
      for (int rt = 0; rt < 16; rt++) {
        f32x4 acc = {0.f, 0.f, 0.f, 0.f};
#pragma unroll
        for (int ks = 0; ks < 2; ks++) {
          bf16x8 a = *(const bf16x8*)(wuk + ((size_t)h * 256 + rt * 16 + l15) * 64 + ks * 32 + g * 8);
          acc = mfma16(a, bq[ks], acc);
        }
        u32x2 ov;
        ov[0] = pk2(acc[0] * (0.125f * LOG2E), acc[1] * (0.125f * LOG2E));
        ov[1] = pk2(acc[2] * (0.125f * LOG2E), acc[3] * (0.125f * LOG2E));
        *(u32x2*)(ql + ((size_t)l15 * 16 + h) * 256 + rt * 16 + 4 * g) = ov;
      }
    }
    __syncthreads();
#pragma unroll 1
    for (int qi = 0; qi < 4; qi++) {
      const int qloc = 4 * w + qi;
      const int t = t0 + qloc;
      const u16* sp = sel + (tb + t) * 256;
      bf16x8 qb[8];
#pragma unroll
      for (int ks = 0; ks < 8; ks++) qb[ks] = *(const bf16x8*)(ql + ((size_t)qloc * 16 + l15) * 256 + ks * 32 + g * 8);
      float m_run = NEGF, l_run = 0.f;
      f32x4 O[16];
#pragma unroll
      for (int rt = 0; rt < 16; rt++) O[rt] = (f32x4){0.f, 0.f, 0.f, 0.f};
#pragma unroll 1
      for (int ch = 0; ch < 8; ch++) {
        __syncthreads();
#pragma unroll
        for (int hf = 0; hf < 2; hf++) {
          u32x4 gr[8];
#pragma unroll
          for (int i = 0; i < 8; i++) {
            const int pidx = lane + 64 * (i + 8 * hf);
            const int kk = pidx >> 5, c16 = pidx & 31;
            int idx = sp[ch * 32 + kk];
            if (idx == 0xffff) idx = 0;
            gr[i] = *(const u32x4*)(ckvn + (tb + idx) * 256 + c16 * 8);
          }
#pragma unroll
          for (int i = 0; i < 8; i++) {
            const int pidx = lane + 64 * (i + 8 * hf);
            const int kk = pidx >> 5, c16 = pidx & 31;
            *(u32x4*)&G[kk * GS + c16 * 8] = gr[i];
          }
        }
        __syncthreads();
        float lg[2][4];
#pragma unroll
        for (int kbk = 0; kbk < 2; kbk++) {
          f32x4 acc = {0.f, 0.f, 0.f, 0.f};
#pragma unroll
          for (int ks = 0; ks < 8; ks++) {
            bf16x8 a = *(const bf16x8*)&G[(16 * kbk + l15) * GS + ks * 32 + g * 8];
            acc = mfma16(a, qb[ks], acc);
          }
          const s16x4 kid4 = *(const s16x4*)(sp + ch * 32 + 16 * kbk + 4 * g);
#pragma unroll
          for (int i = 0; i < 4; i++) {
            const int kid = (int)(u16)kid4[i];
            float v = NEGF;
            if (kid != 0xffff) {
              int n = t - kid;
              n = n < 0 ? 0 : n;
              const int bk = n < 128 ? lut[n] : 31;
              v = acc[i] + rb[bk * 16 + l15];
            }
            lg[kbk][i] = v;
          }
        }
        float mx = fmaxf(fmaxf(fmaxf(lg[0][0], lg[0][1]), fmaxf(lg[0][2], lg[0][3])),
                         fmaxf(fmaxf(lg[1][0], lg[1][1]), fmaxf(lg[1][2], lg[1][3])));
        mx = fmaxf(mx, __shfl_xor(mx, 16));
        mx = fmaxf(mx, __shfl_xor(mx, 32));
        const float m_new = fmaxf(m_run, mx);
        const float scl = __builtin_amdgcn_exp2f(m_run - m_new);
        m_run = m_new;
        float ps = 0.f;
        float pe[8];
#pragma unroll
        for (int kbk = 0; kbk < 2; kbk++)
#pragma unroll
          for (int i = 0; i < 4; i++) {
            const float pv = __builtin_amdgcn_exp2f(lg[kbk][i] - m_new);
            pe[kbk * 4 + i] = pv;
            ps += pv;
          }
        l_run = l_run * scl + ps;
        u32x4 pw;
        pw[0] = pk2(pe[0], pe[1]);
        pw[1] = pk2(pe[2], pe[3]);
        pw[2] = pk2(pe[4], pe[5]);
        pw[3] = pk2(pe[6], pe[7]);
        const bf16x8 pB = __builtin_bit_cast(bf16x8, pw);
#pragma unroll
        for (int rt = 0; rt < 16; rt++) O[rt] = O[rt] * scl;
        const int q4 = l15 >> 2, p4 = l15 & 3;
#pragma unroll
        for (int rt = 0; rt < 16; rt++) {
          const s16x4 lo = __builtin_amdgcn_ds_read_tr16_b64_v4i16((lds_s16x4_ptr)(&G[(4 * g + q4) * GS + rt * 16 + 4 * p4]));
          const s16x4 hi = __builtin_amdgcn_ds_read_tr16_b64_v4i16((lds_s16x4_ptr)(&G[(16 + 4 * g + q4) * GS + rt * 16 + 4 * p4]));
          const bf16x8 a = (bf16x8){lo[0], lo[1], lo[2], lo[3], hi[0], hi[1], hi[2], hi[3]};
          O[rt] = mfma16(a, pB, O[rt]);
        }
      }
      float lt = l_run;
      lt += __shfl_xor(lt, 16);
      lt += __shfl_xor(lt, 32);
      const float inv = 1.f / lt;
#pragma unroll
      for (int rt = 0; rt < 16; rt++) {
        u32x2 ov;
        ov[0] = pk2(O[rt][0] * inv, O[rt][1] * inv);
        ov[1] = pk2(O[rt][2] * inv, O[rt][3] * inv);
        *(u32x2*)(ql + ((size_t)qloc * 16 + l15) * 256 + rt * 16 + 4 * g) = ov;
      }
    }
    __syncthreads();
    for (int hh = 0; hh < 4; hh++) {
      const int h = 4 * w + hh;
      bf16x8 bo[8];
#pragma unroll
      for (int ks = 0; ks < 8; ks++) bo[ks] = *(const bf16x8*)(ql + ((size_t)l15 * 16 + h) * 256 + ks * 32 + g * 8);
#pragma unroll
      for (int et = 0; et < 4; et++) {
        f32x4 acc = {0.f, 0.f, 0.f, 0.f};
#pragma unroll
        for (int ks = 0; ks < 8; ks++) {
          bf16x8 a = *(const bf16x8*)(wuv + ((size_t)h * 64 + et * 16 + l15) * 256 + ks * 32 + g * 8);
          acc = mfma16(a, bo[ks], acc);
        }
        u32x2 ov;
        ov[0] = pk2(acc[0], acc[1]);
        ov[1] = pk2(acc[2], acc[3]);
        *(u32x2*)(o + (tb + t0 + l15) * 1024 + h * 64 + et * 16 + 4 * g) = ov;
      }
    }
    __syncthreads();
  }
}

DI void diffattn_phase(const u16* __restrict__ q, const u16* __restrict__ k, const u16* __restrict__ vT,
                       u16* __restrict__ o, const float* __restrict__ rel_bias, const float* __restrict__ lam,
                       const float* __restrict__ subln, int layer_idx, char* smem, int bid, int nb) {
  constexpr int KS = 136, VS = 72;
  u16* Ks = (u16*)smem;
  u16* Vs = Ks + 64 * KS;
  float* exch = (float*)smem;
  float* btab = (float*)(smem + 36 * 1024);
  int* lut = (int*)(smem + 36 * 1024 + 1040);
  float* misc = (float*)(smem + 36 * 1024 + 1040 + 512);
  const int tid = opq_tid(), lane = tid & 63, w = __builtin_amdgcn_readfirstlane(tid >> 6), l31 = lane & 31, lh = lane >> 5;
  const int qsub = w >> 1, m = w & 1;
  const float lam_init = 0.8f - 0.6f * expf(-0.3f * (float)layer_idx);
  __syncthreads();
  if (tid < 128) lut[tid] = rel_bucket(tid);
  if (w == 0) {
    float p1 = lam[lane] * lam[64 + lane], p2 = lam[128 + lane] * lam[192 + lane];
    p1 = wave_sum(p1);
    p2 = wave_sum(p2);
    if (lane == 0) misc[0] = expf(p1) - expf(p2) + lam_init;
  }
  __syncthreads();
  const float lam_full = misc[0];
  const int nitems = NBATCH * 8 * (S / 64);
  const int nrounds = (nitems + nb - 1) / nb;
  const int prow = pi_row(l31);
  for (int rd = 0; rd < nrounds; rd++) {
    const int it = rd * nb + ((rd & 1) ? (nb - 1 - bid) : bid);
    if (it >= nitems) continue;
    const int bh = it & 31, qb = (S / 64 - 1) - (it >> 5);
    const int b = bh >> 3, h = bh & 7;
    const int q0 = qb * 64, tq0 = q0 + 32 * qsub, t = tq0 + l31;
    const size_t tb = (size_t)b * S;
    __syncthreads();
    for (int i = tid; i < 258; i += 256) {
      const int n = i >> 1, mm = i & 1;
      const int bk = n < 128 ? lut[n] : 31;
      btab[i] = rel_bias[bk * 16 + 2 * h + mm] * LOG2E;
    }
    bf16x8 qf[4];
#pragma unroll
    for (int ks = 0; ks < 4; ks++) qf[ks] = *(const bf16x8*)(q + (tb + t) * 1024 + h * 128 + m * 64 + ks * 16 + lh * 8);
    f32x16 O[4];
#pragma unroll
    for (int et = 0; et < 4; et++)
#pragma unroll
      for (int r = 0; r < 16; r++) O[et][r] = 0.f;
    float m_run = NEGF, l_run = 0.f;
    const int nkt = qb + 1;
    u32x4 rk[4], rv[4];
    const u16* kp = k + tb * 1024 + h * 128;
    const u16* vp = vT + ((size_t)(b * 8 + h) * 128) * 8192;
#pragma unroll
    for (int i = 0; i < 4; i++) {
      const int id = tid + 256 * i;
      rk[i] = *(const u32x4*)(kp + (size_t)(id >> 4) * 1024 + (id & 15) * 8);
      rv[i] = *(const u32x4*)(vp + (size_t)(id >> 3) * 8192 + (id & 7) * 8);
    }
#pragma unroll
    for (int i = 0; i < 4; i++) {
      const int id = tid + 256 * i;
      *(u32x4*)&Ks[(id >> 4) * KS + (id & 15) * 8] = rk[i];
      *(u32x4*)&Vs[(id >> 3) * VS + (id & 7) * 8] = rv[i];
    }
    __syncthreads();
    const float cfar = btab[256 + m];
    for (int kt = 0; kt < nkt; kt++) {
      if (kt + 1 < nkt) {
#pragma unroll
        for (int i = 0; i < 4; i++) {
          const int id = tid + 256 * i;
          rk[i] = *(const u32x4*)(kp + (size_t)((kt + 1) * 64 + (id >> 4)) * 1024 + (id & 15) * 8);
          rv[i] = *(const u32x4*)(vp + (size_t)(id >> 3) * 8192 + (kt + 1) * 64 + (id & 7) * 8);
        }
      }
      const int s_tile = kt * 64;
      const int nblk = (s_tile + 32 <= tq0 + 31) ? 2 : 1;
#pragma unroll 1
      for (int kb = 0; kb < nblk; kb++) {
        f32x16 acc;
#pragma unroll
        for (int r = 0; r < 16; r++) acc[r] = 0.f;
#pragma unroll
        for (int ks = 0; ks < 4; ks++) {
          bf16x8 a = *(const bf16x8*)&Ks[(32 * kb + prow) * KS + m * 64 + ks * 16 + lh * 8];
          acc = mfma32(a, qf[ks], acc);
        }
        const int s0 = s_tile + 32 * kb;
        const bool nearb = (tq0 - (s0 + 31)) < 128;
        if (nearb) {
#pragma unroll
          for (int r = 0; r < 16; r++) {
            const int key = s0 + 16 * (r >> 3) + 8 * lh + (r & 7);
            const int n = t - key;
            const int nc = n < 0 ? 0 : (n > 128 ? 128 : n);
            const float bv = btab[nc * 2 + m];
            acc[r] = (n < 0) ? NEGF : acc[r] + bv;
          }
        } else {
#pragma unroll
          for (int r = 0; r < 16; r++) acc[r] += cfar;
        }
        float mx = acc[0];
#pragma unroll
        for (int r = 1; r < 16; r++) mx = fmaxf(mx, acc[r]);
        mx = fmaxf(mx, __shfl_xor(mx, 32));
        const float m_new = fmaxf(m_run, mx);
        const float scl = __builtin_amdgcn_exp2f(m_run - m_new);
        m_run = m_new;
        float ps = 0.f;
#pragma unroll
        for (int r = 0; r < 16; r++) {
          const float pv = __builtin_amdgcn_exp2f(acc[r] - m_new);
          acc[r] = pv;
          ps += pv;
        }
        l_run = l_run * scl + ps;
        if (__ballot(scl != 1.f)) {
#pragma unroll
          for (int et = 0; et < 4; et++)
#pragma unroll
            for (int r = 0; r < 16; r++) O[et][r] *= scl;
        }
#pragma unroll
        for (int s2 = 0; s2 < 2; s2++) {
          u32x4 pw;
          pw[0] = pk2(acc[8 * s2 + 0], acc[8 * s2 + 1]);
          pw[1] = pk2(acc[8 * s2 + 2], acc[8 * s2 + 3]);
          pw[2] = pk2(acc[8 * s2 + 4], acc[8 * s2 + 5]);
          pw[3] = pk2(acc[8 * s2 + 6], acc[8 * s2 + 7]);
          const bf16x8 pB = __builtin_bit_cast(bf16x8, pw);
#pragma unroll
          for (int et = 0; et < 4; et++) {
            bf16x8 a = *(const bf16x8*)&Vs[(32 * et + l31) * VS + 32 * kb + 16 * s2 + 8 * lh];
            O[et] = mfma32(a, pB, O[et]);
          }
        }
      }
      __syncthreads();
      if (kt + 1 < nkt) {
#pragma unroll
        for (int i = 0; i < 4; i++) {
          const int id = tid + 256 * i;
          *(u32x4*)&Ks[(id >> 4) * KS + (id & 15) * 8] = rk[i];
          *(u32x4*)&Vs[(id >> 3) * VS + (id & 7) * 8] = rv[i];
        }
        __syncthreads();
      }
    }
    float lt = l_run + __shfl_xor(l_run, 32);
    const float inv = 1.f / lt;
    if (m == 1) {
#pragma unroll
      for (int et = 0; et < 4; et++)
#pragma unroll
        for (int r = 0; r < 16; r++) {
          const int e = 32 * et + (r & 3) + 8 * (r >> 2) + 4 * lh;
          exch[(qsub * 128 + e) * 32 + l31] = O[et][r] * inv;
        }
    }
    __syncthreads();
    if (m == 0) {
      float ss = 0.f;
#pragma unroll
      for (int et = 0; et < 4; et++)
#pragma unroll
        for (int r = 0; r < 16; r++) {
          const int e = 32 * et + (r & 3) + 8 * (r >> 2) + 4 * lh;
          const float v = O[et][r] * inv - lam_full * exch[(qsub * 128 + e) * 32 + l31];
          O[et][r] = v;
          ss += v * v;
        }
      ss += __shfl_xor(ss, 32);
      const float rs = rsqrtf(ss * (1.f / 128.f) + LN_EPS);
      const float osc = 1.f - lam_init;
#pragma unroll
      for (int et = 0; et < 4; et++)
#pragma unroll
        for (int r4 = 0; r4 < 4; r4++) {
          const int e = 32 * et + 8 * r4 + 4 * lh;
          const f32x4 gv = *(const f32x4*)(subln + e);
          u32x2 ov;
          ov[0] = pk2(O[et][4 * r4 + 0] * rs * gv[0] * osc, O[et][4 * r4 + 1] * rs * gv[1] * osc);
          ov[1] = pk2(O[et][4 * r4 + 2] * rs * gv[2] * osc, O[et][4 * r4 + 3] * rs * gv[3] * osc);
          *(u32x2*)(o + (tb + t) * 1024 + h * 128 + e) = ov;
        }
    }
  }
}

__global__ void __launch_bounds__(256, 2) hybrid_fwd(Params p) {
  __shared__ __attribute__((aligned(16))) char smem[LDS_BYTES];
  cg::grid_group grid = cg::this_grid();
  const int bid = blockIdx.x, nb = gridDim.x;
  char* ws = p.ws;
  u16* w_ain = (u16*)(ws + W_AIN);
  u16* w_uk = (u16*)(ws + W_UK);
  u16* w_uv = (u16*)(ws + W_UV);
  u16* w_ao = (u16*)(ws + W_AO);
  u16* w_bin = (u16*)(ws + W_BIN);
  u16* w_bo = (u16*)(ws + W_BO);
  u16* w_w1 = (u16*)(ws + W_W1);
  u16* w_w2 = (u16*)(ws + W_W2);
  float* mod = (float*)(ws + WS_MOD);
  u16* hbuf = (u16*)(ws + WS_H);
  char* big = ws + WS_BIG;
  u16* qbuf = (u16*)(big + B_Q);
  u16* iqbuf = (u16*)(big + B_IQ);
  u16* ikbuf = (u16*)(big + B_IK);
  float* iwbuf = (float*)(big + B_IW);
  float* ckvraw = (float*)(big + B_CKVRAW);
  u16* ckvn = (u16*)(big + B_CKVN);
  u16* selbuf = (u16*)(big + B_SEL);
  u16* kbuf = (u16*)(big + B_K);
  u16* vtbuf = (u16*)(big + B_VT);
  u16* obuf = (u16*)(big + B_O);
  u16* hid = (u16*)big;

  tconv_phase(p.a_w_in, w_ain, 2, 1024, 1864, A_INP, smem, bid, nb);
  tconv_phase(p.a_w_uk, w_uk, 32, 64, 256, 256, smem, bid, nb);
  tconv_phase(p.a_w_uv, w_uv, 32, 256, 64, 64, smem, bid, nb);
  tconv_phase(p.a_w_o, w_ao, 2, 1024, 1024, 1024, smem, bid, nb);
  tconv_phase(p.b_w_in, w_bin, 2, 1024, 3072, 3072, smem, bid, nb);
  tconv_phase(p.b_w_o, w_bo, 2, 1024, 1024, 1024, smem, bid, nb);
  tconv_phase(p.mlp_w1, w_w1, 4, 1024, 4096, 4096, smem, bid, nb);
  tconv_phase(p.mlp_w2, w_w2, 4, 4096, 1024, 1024, smem, bid, nb);
  mod_phase(p, mod, smem, bid, nb);
  grid.sync();
  h0_phase(p.x, mod, hbuf, bid, nb);
  grid.sync();

#pragma unroll 1
  for (int sl = 0; sl < 8; sl++) {
    const int i = sl >> 1, j = i >> 1;
    const float* modi = mod + (size_t)i * 4 * 6144;
    const u16* Ares;
    const u16* Wres;
    int Kres, goff;
    if ((sl & 1) == 0) {
      if ((i & 1) == 0) {
        EpiArgs ea{};
        ea.o0 = qbuf; ea.f0 = ckvraw; ea.o1 = iqbuf; ea.o2 = ikbuf; ea.f1 = iwbuf;
        for (int rep = 0; rep < (PROBE_DUP == 4 ? 2 : 1); rep++) gemm_phase<EPI_AIN>(hbuf, w_ain + (size_t)j * A_INP * 1024, T, A_INP, 1024, ea, smem, bid, nb);
        grid.sync();
        ckvnorm_phase(ckvraw, p.a_kv_norm + j * 256, ckvn, bid, nb);
        for (int rep = 0; rep < (PROBE_DUP == 2 ? 2 : 1); rep++) indexer_phase(iqbuf, ikbuf, iwbuf, selbuf, smem, bid, nb);
        grid.sync();
        for (int rep = 0; rep < (PROBE_DUP == 3 ? 2 : 1); rep++) sparse_phase(qbuf, ckvn, selbuf, w_uk + (size_t)j * 16 * 256 * 64, w_uv + (size_t)j * 16 * 256 * 64, p.rel_bias,
                     hbuf, obuf, smem, bid, nb);
        grid.sync();
        Wres = w_ao + (size_t)j * 1024 * 1024;
      } else {
        EpiArgs ea{};
        ea.o0 = qbuf; ea.o1 = kbuf; ea.o2 = vtbuf;
        for (int rep = 0; rep < (PROBE_DUP == 4 ? 2 : 1); rep++) gemm_phase<EPI_BIN>(hbuf, w_bin + (size_t)j * 3072 * 1024, T, 3072, 1024, ea, smem, bid, nb);
        grid.sync();
        for (int rep = 0; rep < (PROBE_DUP == 1 ? 2 : 1); rep++) diffattn_phase(qbuf, kbuf, vtbuf, obuf, p.rel_bias, p.b_lambda + j * 256, p.b_subln + j * 128, i, smem, bid, nb);
        grid.sync();
        Wres = w_bo + (size_t)j * 1024 * 1024;
      }
      Ares = obuf; Kres = 1024; goff = 2 * 1024;
    } else {
      EpiArgs ea{};
      ea.o0 = hid;
      for (int rep = 0; rep < (PROBE_DUP == 4 ? 2 : 1); rep++) gemm_phase<EPI_SQRELU>(hbuf, w_w1 + (size_t)i * 4096 * 1024, T, 4096, 1024, ea, smem, bid, nb);
      grid.sync();
      Ares = hid; Wres = w_w2 + (size_t)i * 4096 * 1024; Kres = 4096; goff = 5 * 1024;
    }
    {
      EpiArgs ea{};
      ea.f0 = p.out;
      ea.xin = (sl == 0) ? p.x : (const float*)p.out;
      ea.g = modi + goff;
      gemm_phase<EPI_RES>(Ares, Wres, T, 1024, Kres, ea, smem, bid, nb);
    }
    grid.sync();
    {
      const float* modn = ((sl & 1) == 0) ? modi : (i < 3 ? modi + 4 * 6144 : (const float*)nullptr);
      const int sh_off = ((sl & 1) == 0) ? 3 * 1024 : 0;
      ln_phase(p.out, p.ln_g + (size_t)(i * 2 + (sl & 1)) * 1024, p.ln_b + (size_t)(i * 2 + (sl & 1)) * 1024, modn, sh_off,
               hbuf, bid, nb);
    }
    grid.sync();
  }
}

extern "C" void kernel_launch(void* const* d_in, const int* in_sizes, int n_in, void* d_out, int out_size, void* d_ws,
                              size_t ws_size, hipStream_t stream) {
  static int grid_blocks = 0;
  if (!grid_blocks) {
    int dev = 0, cus = 0, per_cu = 0;
    hipGetDevice(&dev);
    hipDeviceGetAttribute(&cus, hipDeviceAttributeMultiprocessorCount, dev);
    hipOccupancyMaxActiveBlocksPerMultiprocessor(&per_cu, hybrid_fwd, 256, 0);
    if (per_cu < 1) per_cu = 1;
    if (per_cu > 2) per_cu = 2;
    grid_blocks = cus * per_cu;
    if (grid_blocks > 512) grid_blocks = 512;
  }
  Params p{};
  p.x = (const float*)d_in[0];
  p.c = (const float*)d_in[1];
  p.rel_bias = (const float*)d_in[2];
  p.ada_w = (const float*)d_in[3];
  p.ada_b = (const float*)d_in[4];
  p.ln_g = (const float*)d_in[5];
  p.ln_b = (const float*)d_in[6];
  p.a_w_in = (const float*)d_in[7];
  p.a_kv_norm = (const float*)d_in[8];
  p.a_w_uk = (const float*)d_in[9];
  p.a_w_uv = (const float*)d_in[10];
  p.a_w_o = (const float*)d_in[11];
  p.b_w_in = (const float*)d_in[12];
  p.b_lambda = (const float*)d_in[13];
  p.b_subln = (const float*)d_in[14];
  p.b_w_o = (const float*)d_in[15];
  p.mlp_w1 = (const float*)d_in[16];
  p.mlp_w2 = (const float*)d_in[17];
  p.out = (float*)d_out;
  p.ws = (char*)d_ws;
  void* args[] = {&p};
  hipError_t e = hipLaunchCooperativeKernel((void*)hybrid_fwd, dim3(grid_blocks), dim3(256), args, 0, stream);
  if (e != hipSuccess) fprintf(stderr, "cooperative launch failed: %s (grid %d)\n", hipGetErrorString(e), grid_blocks);
}
```

```cpp
#include <hip/hip_runtime.h>
#include <hip/hip_cooperative_groups.h>
#include <stdint.h>
#include <stdio.h>
namespace cg = cooperative_groups;

typedef unsigned short u16;
typedef short bf16x8 __attribute__((ext_vector_type(8)));
typedef short s16x4 __attribute__((ext_vector_type(4)));
typedef float f32x16 __attribute__((ext_vector_type(16)));
typedef float f32x4 __attribute__((ext_vector_type(4)));
typedef float f32x2 __attribute__((ext_vector_type(2)));
typedef __bf16 bf16x2_t __attribute__((ext_vector_type(2)));
typedef unsigned u32x4 __attribute__((ext_vector_type(4)));
typedef unsigned u32x2 __attribute__((ext_vector_type(2)));
typedef __attribute__((address_space(3))) s16x4* lds_s16x4_ptr;

#define DI __device__ __forceinline__
#ifndef PROBE_DUP
#define PROBE_DUP 0
#endif

constexpr int D = 1024, NBATCH = 4, S = 8192, T = NBATCH * S;
constexpr int A_INP = 1920;
constexpr float DN_ALPHA = 1.6817928305074292f;
constexpr float LOG2E = 1.4426950408889634f;
constexpr float LN_EPS = 1e-5f;
constexpr float NEGF = -1e30f;
constexpr int TOPK = 256;
constexpr int CAP = 704;
constexpr int LDS_BYTES = 72 * 1024;

constexpr size_t MB = 1024 * 1024;
constexpr size_t W_AIN = 0;
constexpr size_t W_UK = W_AIN + (size_t)2 * 1920 * 1024 * 2;
constexpr size_t W_UV = W_UK + (size_t)2 * 16 * 256 * 64 * 2;
constexpr size_t W_AO = W_UV + (size_t)2 * 16 * 256 * 64 * 2;
constexpr size_t W_BIN = W_AO + (size_t)2 * 1024 * 1024 * 2;
constexpr size_t W_BO = W_BIN + (size_t)2 * 3072 * 1024 * 2;
constexpr size_t W_W1 = W_BO + (size_t)2 * 1024 * 1024 * 2;
constexpr size_t W_W2 = W_W1 + (size_t)4 * 4096 * 1024 * 2;
constexpr size_t WS_MOD = W_W2 + (size_t)4 * 4096 * 1024 * 2;
constexpr size_t WS_H = WS_MOD + 1 * MB;
constexpr size_t WS_BIG = WS_H + 64 * MB;
constexpr size_t B_Q = 0;
constexpr size_t B_IQ = 64 * MB;
constexpr size_t B_IK = 96 * MB;
constexpr size_t B_IW = 100 * MB;
constexpr size_t B_CKVRAW = 104 * MB;
constexpr size_t B_CKVN = 136 * MB;
constexpr size_t B_SEL = 152 * MB;
constexpr size_t B_K = 64 * MB;
constexpr size_t B_VT = 128 * MB;
constexpr size_t B_O = 192 * MB;

struct Params {
  const float *x, *c, *rel_bias, *ada_w, *ada_b, *ln_g, *ln_b, *a_w_in, *a_kv_norm, *a_w_uk, *a_w_uv, *a_w_o, *b_w_in,
      *b_lambda, *b_subln, *b_w_o, *mlp_w1, *mlp_w2;
  float* out;
  char* ws;
};

DI int opq_tid() {
  int t = threadIdx.x;
  asm volatile("" : "+v"(t));
  return t;
}
DI unsigned pk2(float lo, float hi) {
  f32x2 v = {lo, hi};
  bf16x2_t b = __builtin_convertvector(v, bf16x2_t);
  return __builtin_bit_cast(unsigned, b);
}
DI u16 f2bf(float x) { return (u16)(pk2(x, 0.f) & 0xffffu); }
DI float wave_sum(float v) {
#pragma unroll
  for (int o = 32; o >= 1; o >>= 1) v += __shfl_xor(v, o);
  return v;
}
DI f32x16 mfma32(bf16x8 a, bf16x8 b, f32x16 c) { return __builtin_amdgcn_mfma_f32_32x32x16_bf16(a, b, c, 0, 0, 0); }
DI f32x4 mfma16(bf16x8 a, bf16x8 b, f32x4 c) { return __builtin_amdgcn_mfma_f32_16x16x32_bf16(a, b, c, 0, 0, 0); }
DI int pi_row(int r) { return (r & ~12) | ((r & 4) << 1) | ((r & 8) >> 1); }

DI int rel_bucket(int n) {
  if (n < 16) return n;
  float nf = (float)n;
  int large = 16 + (int)(logf(nf / 16.f) / 2.0794415416798357f * 16.f);
  return large < 31 ? large : 31;
}

DI void tconv_phase(const float* __restrict__ src, u16* __restrict__ dst, int batch, int R, int C, int Cpad, char* smem,
                    int bid, int nb) {
  float* tile = (float*)smem;
  const int tid = opq_tid();
  const int tr = R / 64, tc = Cpad / 64;
  const int ntiles = batch * tr * tc;
  for (int it = bid; it < ntiles; it += nb) {
    const int bi = it / (tr * tc);
    const int rem = it - bi * (tr * tc);
    const int ri = rem / tc, ci = rem - ri * tc;
    const float* s = src + (size_t)bi * R * C;
    u16* d = dst + (size_t)bi * Cpad * R;
    __syncthreads();
#pragma unroll 4
    for (int k = 0; k < 16; k++) {
      const int r = (tid >> 6) + 4 * k;
      const int cc = ci * 64 + (tid & 63);
      float v = (cc < C) ? s[(size_t)(ri * 64 + r) * C + cc] : 0.f;
      tile[r * 65 + (tid & 63)] = v;
    }
    __syncthreads();
#pragma unroll 4
    for (int k = 0; k < 16; k++) {
      const int cl = (tid >> 6) + 4 * k;
      const int rl = tid & 63;
      d[(size_t)(ci * 64 + cl) * R + ri * 64 + rl] = f2bf(tile[rl * 65 + cl]);
    }
  }
}

DI void mod_phase(const Params& p, float* mod, char* smem, int bid, int nb) {
  float* sc = (float*)smem;
  float* red = sc + 4096;
  const int tid = opq_tid(), lane = tid & 63, w = __builtin_amdgcn_readfirstlane(tid >> 6);
  __syncthreads();
  for (int i = tid; i < 4096; i += 256) {
    float v = p.c[i];
    sc[i] = v / (1.f + expf(-v));
  }
  __syncthreads();
  for (int it = bid; it < 4 * 96; it += nb) {
    const int l = it / 96, e0 = (it - l * 96) * 64;
    const float* wp = p.ada_w + ((size_t)l * 1024 + w * 256) * 6144 + e0 + lane;
    float a0 = 0, a1 = 0, a2 = 0, a3 = 0;
#pragma unroll 8
    for (int d = 0; d < 256; d++) {
      float wv = wp[(size_t)d * 6144];
      int dd = w * 256 + d;
      a0 += sc[dd] * wv;
      a1 += sc[1024 + dd] * wv;
      a2 += sc[2048 + dd] * wv;
      a3 += sc[3072 + dd] * wv;
    }
    red[(w * 4 + 0) * 64 + lane] = a0;
    red[(w * 4 + 1) * 64 + lane] = a1;
    red[(w * 4 + 2) * 64 + lane] = a2;
    red[(w * 4 + 3) * 64 + lane] = a3;
    __syncthreads();
    {
      const int b = w;
      float s = red[(0 * 4 + b) * 64 + lane] + red[(1 * 4 + b) * 64 + lane] + red[(2 * 4 + b) * 64 + lane] +
                red[(3 * 4 + b) * 64 + lane] + p.ada_b[l * 6144 + e0 + lane];
      mod[((size_t)l * 4 + b) * 6144 + e0 + lane] = s;
    }
    __syncthreads();
  }
}

DI void h0_phase(const float* __restrict__ x, const float* __restrict__ mod0, u16* __restrict__ h, int bid, int nb) {
  const size_t n8 = (size_t)T * 1024 / 8;
  for (size_t i = (size_t)bid * 256 + opq_tid(); i < n8; i += (size_t)nb * 256) {
    const size_t e = i * 8;
    const int t = (int)(e >> 10), d = (int)(e & 1023), b = t >> 13;
    const float* m = mod0 + (size_t)b * 6144;
    f32x4 v0 = *(const f32x4*)(x + e), v1 = *(const f32x4*)(x + e + 4);
    f32x4 sh0 = *(const f32x4*)(m + d), sh1 = *(const f32x4*)(m + d + 4);
    f32x4 sc0 = *(const f32x4*)(m + 1024 + d), sc1 = *(const f32x4*)(m + 1024 + d + 4);
    v0 = v0 * (1.f + sc0) + sh0;
    v1 = v1 * (1.f + sc1) + sh1;
    u32x4 o;
    o[0] = pk2(v0[0], v0[1]);
    o[1] = pk2(v0[2], v0[3]);
    o[2] = pk2(v1[0], v1[1]);
    o[3] = pk2(v1[2], v1[3]);
    *(u32x4*)(h + e) = o;
  }
}

DI void ln_phase(float* z, const float* __restrict__ g, const float* __restrict__ bt, const float* modn, int sh_off,
                 u16* __restrict__ h, int bid, int nb) {
  const int tid = opq_tid(), lane = tid & 63, w = __builtin_amdgcn_readfirstlane(tid >> 6);
  for (int row = bid * 4 + w; row < T; row += nb * 4) {
    f32x4* zp = (f32x4*)(z + (size_t)row * 1024);
    f32x4 v[4];
#pragma unroll
    for (int c = 0; c < 4; c++) v[c] = zp[c * 64 + lane];
    float s = 0;
#pragma unroll
    for (int c = 0; c < 4; c++) s += v[c][0] + v[c][1] + v[c][2] + v[c][3];
    const float mu = wave_sum(s) * (1.f / 1024.f);
    float q = 0;
#pragma unroll
    for (int c = 0; c < 4; c++) {
      v[c] = v[c] - mu;
      q += v[c][0] * v[c][0] + v[c][1] * v[c][1] + v[c][2] * v[c][2] + v[c][3] * v[c][3];
    }
    const float rstd = rsqrtf(wave_sum(q) * (1.f / 1024.f) + LN_EPS);
    const int b = row >> 13;
#pragma unroll
    for (int c = 0; c < 4; c++) {
      const int d = c * 256 + lane * 4;
      f32x4 y = v[c] * rstd * *(const f32x4*)(g + d) + *(const f32x4*)(bt + d);
      zp[c * 64 + lane] = y;
      if (modn) {
        const float* m = modn + (size_t)b * 6144 + sh_off;
        f32x4 hv = y * (1.f + *(const f32x4*)(m + 1024 + d)) + *(const f32x4*)(m + d);
        u32x2 o;
        o[0] = pk2(hv[0], hv[1]);
        o[1] = pk2(hv[2], hv[3]);
        *(u32x2*)(h + (size_t)row * 1024 + d) = o;
      }
    }
  }
}

enum { EPI_AIN = 0, EPI_BIN = 1, EPI_RES = 2, EPI_SQRELU = 3 };
struct EpiArgs {
  u16 *o0, *o1, *o2;
  float *f0, *f1;
  const float* xin;
  const float* g;
};

template <int EPI>
DI void gemm_phase(const u16* __restrict__ A, const u16* __restrict__ Bt, int M, int N, int K, const EpiArgs& ea,
                   char* smem, int bid, int nb) {
  constexpr int MI = 4, BM = 64 * MI;
  u16* As = (u16*)smem;
  u16* Bs = As + BM * 72;
  const int tid = opq_tid(), lane = tid & 63, w = __builtin_amdgcn_readfirstlane(tid >> 6), wm = w >> 1, wn = w & 1, l31 = lane & 31, lh = lane >> 5;
  const int ntn = N / 128, ntm = M / BM, nt = ntn * ntm, nk = K / 64;
  const int lr = tid >> 3, lc = (tid & 7) * 8;
  const int xcd = bid & 7, nbx = nb >> 3, cntx = (ntm >> 3) * ntn;
  (void)nt;
  for (int sq = bid >> 3; sq < cntx; sq += nbx) {
    const int tmx = sq / ntn, tn = sq - tmx * ntn;
    const int tm = tmx * 8 + xcd;
    const int m0 = tm * BM, n0 = tn * 128;
    f32x16 acc[MI][2];
#pragma unroll
    for (int i = 0; i < MI; i++)
#pragma unroll
      for (int j = 0; j < 2; j++)
#pragma unroll
        for (int r = 0; r < 16; r++) acc[i][j][r] = 0.f;
    u32x4 ra[2 * MI], rb[4];
    const u16* ap = A + (size_t)(m0 + lr) * K + lc;
    const u16* bp = Bt + (size_t)(n0 + lr) * K + lc;
#pragma unroll
    for (int i = 0; i < 2 * MI; i++) ra[i] = *(const u32x4*)(ap + (size_t)i * 32 * K);
#pragma unroll
    for (int i = 0; i < 4; i++) rb[i] = *(const u32x4*)(bp + (size_t)i * 32 * K);
    __syncthreads();
#pragma unroll
    for (int i = 0; i < 2 * MI; i++) *(u32x4*)&As[(lr + 32 * i) * 72 + lc] = ra[i];
#pragma unroll
    for (int i = 0; i < 4; i++) *(u32x4*)&Bs[(lr + 32 * i) * 72 + lc] = rb[i];
    __syncthreads();
    for (int kt = 0; kt < nk; kt++) {
      if (kt + 1 < nk) {
#pragma unroll
        for (int i = 0; i < 2 * MI; i++) ra[i] = *(const u32x4*)(ap + (size_t)i * 32 * K + (kt + 1) * 64);
#pragma unroll
        for (int i = 0; i < 4; i++) rb[i] = *(const u32x4*)(bp + (size_t)i * 32 * K + (kt + 1) * 64);
      }
#pragma unroll
      for (int ks = 0; ks < 4; ks++) {
        bf16x8 af[MI], b0, b1;
#pragma unroll
        for (int i = 0; i < MI; i++) af[i] = *(const bf16x8*)&As[(wm * 32 * MI + 32 * i + l31) * 72 + ks * 16 + lh * 8];
        b0 = *(const bf16x8*)&Bs[(wn * 64 + l31) * 72 + ks * 16 + lh * 8];
        b1 = *(const bf16x8*)&Bs[(wn * 64 + 32 + l31) * 72 + ks * 16 + lh * 8];
#pragma unroll
        for (int i = 0; i < MI; i++) {
          acc[i][0] = mfma32(af[i], b0, acc[i][0]);
          acc[i][1] = mfma32(af[i], b1, acc[i][1]);
        }
      }
      __syncthreads();
      if (kt + 1 < nk) {
#pragma unroll
        for (int i = 0; i < 2 * MI; i++) *(u32x4*)&As[(lr + 32 * i) * 72 + lc] = ra[i];
#pragma unroll
        for (int i = 0; i < 4; i++) *(u32x4*)&Bs[(lr + 32 * i) * 72 + lc] = rb[i];
        __syncthreads();
      }
    }
    const int bidx = m0 >> 13;
#pragma unroll
    for (int i = 0; i < MI; i++) {
#pragma unroll
      for (int j = 0; j < 2; j++) {
        const int col = n0 + wn * 64 + 32 * j + l31;
#pragma unroll
        for (int r4 = 0; r4 < 4; r4++) {
          const int row0 = m0 + wm * 32 * MI + 32 * i + 8 * r4 + 4 * lh;
          float v[4];
#pragma unroll
          for (int q = 0; q < 4; q++) v[q] = acc[i][j][4 * r4 + q];
          if (EPI == EPI_AIN) {
            if (col < 1024) {
#pragma unroll
              for (int q = 0; q < 4; q++) ea.o0[(size_t)(row0 + q) * 1024 + col] = f2bf(v[q]);
            } else if (col < 1280) {
#pragma unroll
              for (int q = 0; q < 4; q++) ea.f0[(size_t)(row0 + q) * 256 + (col - 1024)] = v[q];
            } else if (col < 1792) {
#pragma unroll
              for (int q = 0; q < 4; q++) ea.o1[(size_t)(row0 + q) * 512 + (col - 1280)] = f2bf(v[q]);
            } else if (col < 1856) {
#pragma unroll
              for (int q = 0; q < 4; q++) {
                const int d = col - 1792, row = row0 + q;
                const int sidx = row & 8191;
                const size_t off = (size_t)(row >> 13) * S * 64 +
                                   ((size_t)((sidx >> 5) * 4 + (d >> 4)) * 64 + 32 * ((d >> 3) & 1) + (sidx & 31)) * 8 + (d & 7);
                ea.o2[off] = f2bf(v[q]);
              }
            } else if (col < 1864) {
#pragma unroll
              for (int q = 0; q < 4; q++) ea.f1[(size_t)(row0 + q) * 8 + (col - 1856)] = v[q] * 0.044194173824159216f;
            }
          } else if (EPI == EPI_BIN) {
            if (col < 1024) {
#pragma unroll
              for (int q = 0; q < 4; q++) ea.o0[(size_t)(row0 + q) * 1024 + col] = f2bf(v[q] * (0.125f * LOG2E));
            } else if (col < 2048) {
#pragma unroll
              for (int q = 0; q < 4; q++) ea.o1[(size_t)(row0 + q) * 1024 + (col - 1024)] = f2bf(v[q]);
            } else {
              const int cv = col - 2048;
              u32x2 o;
              o[0] = pk2(v[0], v[1]);
              o[1] = pk2(v[2], v[3]);
              *(u32x2*)(ea.o2 + ((size_t)bidx * 1024 + cv) * 8192 + (row0 & 8191)) = o;
            }
          } else if (EPI == EPI_RES) {
            const float gg = 1.f + ea.g[(size_t)bidx * 6144 + col];
#pragma unroll
            for (int q = 0; q < 4; q++) {
              const size_t o = (size_t)(row0 + q) * 1024 + col;
              ea.f0[o] = DN_ALPHA * ea.xin[o] + gg * v[q];
            }
          } else {
#pragma unroll
            for (int q = 0; q < 4; q++) {
              float r = v[q] > 0.f ? v[q] : 0.f;
              ea.o0[(size_t)(row0 + q) * 4096 + col] = f2bf(r * r);
            }
          }
        }
      }
    }
  }
}

DI void ckvnorm_phase(const float* __restrict__ raw, const float* __restrict__ g, u16* __restrict__ outp, int bid,
                      int nb) {
  const int tid = opq_tid(), lane = tid & 63, w = __builtin_amdgcn_readfirstlane(tid >> 6);
  const f32x4 gg = *(const f32x4*)(g + lane * 4);
  for (int row = bid * 4 + w; row < T; row += nb * 4) {
    f32x4 v = *(const f32x4*)(raw + (size_t)row * 256 + lane * 4);
    float ss = v[0] * v[0] + v[1] * v[1] + v[2] * v[2] + v[3] * v[3];
    ss = wave_sum(ss);
    const float r = rsqrtf(ss * (1.f / 256.f) + LN_EPS);
    u32x2 o;
    o[0] = pk2(v[0] * r * gg[0], v[1] * r * gg[1]);
    o[1] = pk2(v[2] * r * gg[2], v[3] * r * gg[3]);
    *(u32x2*)(outp + (size_t)row * 256 + lane * 4) = o;
  }
}

DI unsigned mono_key(float s) {
  unsigned u = __float_as_uint(s);
  return (u & 0x80000000u) ? ~u : (u | 0x80000000u);
}
DI float mono_inv(unsigned k) {
  unsigned u = (k & 0x80000000u) ? (k & 0x7fffffffu) : ~k;
  return __uint_as_float(u);
}
DI float relu_i(float x) {
  int i = __float_as_int(x);
  return __int_as_float(i > 0 ? i : 0);
}
DI int wcount(bool f) { return __popcll(__ballot(f)); }

template <bool EXACT>
DI void compact4(float* vals, u16* idxs, int* cnt, int lane, float* thr_out) {
  constexpr int NPL = CAP / 64;
  unsigned key[4][NPL];
  int n[4];
#pragma unroll
  for (int q = 0; q < 4; q++) n[q] = cnt[q];
#pragma unroll
  for (int q = 0; q < 4; q++)
#pragma unroll
    for (int j = 0; j < NPL; j++) {
      const int e = j * 64 + lane;
      key[q][j] = (e < n[q]) ? mono_key(vals[q * CAP + e]) : 0u;
    }
  unsigned Tk[4] = {0u, 0u, 0u, 0u};
  constexpr int LOWBIT = EXACT ? 0 : 18;
#pragma unroll 1
  for (int bit = 31; bit >= LOWBIT; bit--) {
#pragma unroll
    for (int q = 0; q < 4; q++) {
      const unsigned cand = Tk[q] | (1u << bit);
      int c = 0;
#pragma unroll
      for (int j = 0; j < NPL; j++) c += wcount(key[q][j] >= cand);
      Tk[q] = (c >= TOPK) ? cand : Tk[q];
    }
  }
  unsigned I[4] = {0xffffu, 0xffffu, 0xffffu, 0xffffu};
  if (EXACT) {
    unsigned ix[4][NPL];
    int need[4];
#pragma unroll
    for (int q = 0; q < 4; q++) {
      int cgt = 0;
#pragma unroll
      for (int j = 0; j < NPL; j++) {
        const int e = j * 64 + lane;
        ix[q][j] = (e < n[q]) ? (unsigned)idxs[q * CAP + e] : 0xffffu;
        cgt += wcount(key[q][j] > Tk[q]);
      }
      need[q] = TOPK - cgt;
      I[q] = 0u;
    }
#pragma unroll 1
    for (int bit = 13; bit >= 0; bit--) {
#pragma unroll
      for (int q = 0; q < 4; q++) {
        const unsigned cand = I[q] | (1u << bit);
        int c = 0;
#pragma unroll
        for (int j = 0; j < NPL; j++) c += wcount(key[q][j] == Tk[q] && ix[q][j] < cand);
        I[q] = (c < need[q]) ? cand : I[q];
      }
    }
  }
  const unsigned long long lt = (1ull << lane) - 1ull;
#pragma unroll
  for (int q = 0; q < 4; q++) {
    if (n[q] > TOPK) {
      int base = 0;
#pragma unroll
      for (int j = 0; j < NPL; j++) {
        const int e = j * 64 + lane;
        const bool in = e < n[q];
        const float v = in ? vals[q * CAP + e] : 0.f;
        const unsigned ixv = in ? (unsigned)idxs[q * CAP + e] : 0xffffu;
        const bool keep = (key[q][j] > Tk[q]) || (key[q][j] == Tk[q] && ixv <= I[q]);
        const unsigned long long m = __ballot(keep);
        if (keep) {
          const int pos = base + __popcll(m & lt);
          vals[q * CAP + pos] = v;
          idxs[q * CAP + pos] = (u16)ixv;
        }
        base += __popcll(m);
      }
      if (lane == 0) cnt[q] = base;
      thr_out[q] = mono_inv(Tk[q]);
    }
  }
}

DI void indexer_phase(const u16* __restrict__ iq, const u16* __restrict__ ik, const float* __restrict__ iw,
                      u16* __restrict__ sel, char* smem, int bid, int nb) {
  constexpr int WBYTES = 4 * CAP * 4 + 4 * CAP * 2 + 64;
  const int tid = opq_tid(), lane = tid & 63, w = __builtin_amdgcn_readfirstlane(tid >> 6), l31 = lane & 31, u = lane >> 5;
  float* vals = (float*)(smem + w * WBYTES);
  u16* idxs = (u16*)(smem + w * WBYTES + 4 * CAP * 4);
  int* cnt = (int*)(smem + w * WBYTES + 4 * CAP * 4 + 4 * CAP * 2);
  const int nitems = NBATCH * (S / 16);
  const int nrounds = (nitems + nb - 1) / nb;
  __syncthreads();
  for (int rd = 0; rd < nrounds; rd++) {
    const int it = rd * nb + ((rd & 1) ? (nb - 1 - bid) : bid);
    if (it >= nitems) continue;
    const int b = it & 3, qg = (S / 16 - 1) - (it >> 2);
    const int t0 = qg * 16;
    const int tw = t0 + 4 * w;
    const size_t tb = (size_t)b * S;
    bf16x8 aq[4];
    {
      const int g = l31 >> 3, up = (l31 >> 2) & 1, j = l31 & 3;
      const int ql = 2 * up + (g >> 1), hd = 4 * (g & 1) + j;
      const u16* qp = iq + (tb + tw + ql) * 512 + hd * 64 + u * 8;
#pragma unroll
      for (int ks = 0; ks < 4; ks++) aq[ks] = *(const bf16x8*)(qp + ks * 16);
    }
    float wq[2][8];
#pragma unroll
    for (int qq = 0; qq < 2; qq++) {
      const float* wp = iw + (tb + tw + 2 * u + qq) * 8;
      f32x4 w0 = *(const f32x4*)wp, w1 = *(const f32x4*)(wp + 4);
#pragma unroll
      for (int h = 0; h < 4; h++) {
        wq[qq][h] = w0[h];
        wq[qq][4 + h] = w1[h];
      }
    }
    float thr[2] = {-INFINITY, -INFINITY};
    __builtin_amdgcn_wave_barrier();
    if (lane < 4) cnt[lane] = 0;
    __builtin_amdgcn_wave_barrier();
    const int nkb = (tw + 3) / 32 + 1;
    const u16* kp = ik + tb * 64 + lane * 8;
    bf16x8 ring[4][4];
#pragma unroll
    for (int i = 0; i < 4; i++) {
      const int kbn = (i < nkb) ? i : nkb - 1;
#pragma unroll
      for (int ks = 0; ks < 4; ks++) ring[i][ks] = *(const bf16x8*)(kp + (size_t)(kbn * 4 + ks) * 512);
    }
#pragma unroll 1
    for (int kb0 = 0; kb0 < nkb; kb0 += 4) {
#pragma unroll
      for (int i = 0; i < 4; i++) {
        const int kb = kb0 + i;
        {
          f32x16 acc;
#pragma unroll
          for (int r = 0; r < 16; r++) acc[r] = 0.f;
#pragma unroll
          for (int ks = 0; ks < 4; ks++) acc = mfma32(aq[ks], ring[i][ks], acc);
          {
            const int kbn = (kb + 4 < nkb) ? kb + 4 : nkb - 1;
#pragma unroll
            for (int ks = 0; ks < 4; ks++) ring[i][ks] = *(const bf16x8*)(kp + (size_t)(kbn * 4 + ks) * 512);
          }
          const int key = kb * 32 + l31;
#pragma unroll
          for (int qq = 0; qq < 2; qq++) {
            float s0 = 0.f, s1 = 0.f;
#pragma unroll
            for (int h = 0; h < 8; h += 2) {
              s0 = fmaf(wq[qq][h], relu_i(acc[8 * qq + h]), s0);
              s1 = fmaf(wq[qq][h + 1], relu_i(acc[8 * qq + h + 1]), s1);
            }
            float s = s0 + s1;
            s += 0.0f;
            const int tq = tw + 2 * u + qq;
            if (key <= tq && s >= thr[qq]) {
              const int qs = 2 * u + qq;
              const int pos = atomicAdd(&cnt[qs], 1);
              vals[qs * CAP + pos] = s;
              idxs[qs * CAP + pos] = (u16)key;
            }
          }
        }
      }
      __builtin_amdgcn_wave_barrier();
      const int c0 = cnt[0], c1 = cnt[1], c2 = cnt[2], c3 = cnt[3];
      if (c0 > CAP - 128 || c1 > CAP - 128 || c2 > CAP - 128 || c3 > CAP - 128) {
        float to[4] = {0.f, 0.f, 0.f, 0.f};
        compact4<false>(vals, idxs, cnt, lane, to);
        __builtin_amdgcn_wave_barrier();
        const int d0 = cnt[0], d1 = cnt[1], d2 = cnt[2], d3 = cnt[3];
        if (d0 > CAP - 256 || d1 > CAP - 256 || d2 > CAP - 256 || d3 > CAP - 256) {
          compact4<true>(vals, idxs, cnt, lane, to);
          __builtin_amdgcn_wave_barrier();
        }
        if (c0 > TOPK && u == 0) thr[0] = to[0];
        if (c1 > TOPK && u == 0) thr[1] = to[1];
        if (c2 > TOPK && u == 1) thr[0] = to[2];
        if (c3 > TOPK && u == 1) thr[1] = to[3];
      }
    }
    {
      const int c0 = cnt[0], c1 = cnt[1], c2 = cnt[2], c3 = cnt[3];
      if (c0 > TOPK || c1 > TOPK || c2 > TOPK || c3 > TOPK) {
        float to[4];
        compact4<true>(vals, idxs, cnt, lane, to);
        __builtin_amdgcn_wave_barrier();
      }
    }
#pragma unroll 1
    for (int qs = 0; qs < 4; qs++) {
      const int n = cnt[qs];
      u16* sp = sel + (tb + tw + qs) * 256;
#pragma unroll
      for (int j = 0; j < 4; j++) {
        const int e = j * 64 + lane;
        sp[e] = (e < n) ? idxs[qs * CAP + e] : (u16)0xffffu;
      }
    }
  }
}

DI void sparse_phase(const u16* __restrict__ q, const u16* __restrict__ ckvn, const u16* __restrict__ sel,
                     const u16* __restrict__ wuk, const u16* __restrict__ wuv, const float* __restrict__ rel_bias,
                     u16* scratch, u16* __restrict__ o, char* smem, int bid, int nb) {
  constexpr int GS = 264;
  const int tid = opq_tid(), lane = tid & 63, w = __builtin_amdgcn_readfirstlane(tid >> 6), l15 = lane & 15, g = lane >> 4;
  u16* G = (u16*)smem + (size_t)w * 32 * GS;
  int* lut = (int*)(smem + 4 * 32 * GS * 2);
  float* rb = (float*)(lut + 128);
  __syncthreads();
  if (tid < 128) lut[tid] = rel_bucket(tid);
  for (int i = tid; i < 512; i += 256) rb[i] = rel_bias[i] * LOG2E;
  __syncthreads();
  u16* ql = scratch + (size_t)bid * (16 * 16 * 256);
  const int nitems = NBATCH * (S / 16);
  for (int it = bid; it < nitems; it += nb) {
    const int b = it & 3, qg = it >> 2;
    const int t0 = qg * 16;
    const size_t tb = (size_t)b * S;
    for (int hh = 0; hh < 4; hh++) {
      const int h = 4 * w + hh;
      bf16x8 bq[2];
#pragma unroll
      for (int ks = 0; ks < 2; ks++) bq[ks] = *(const bf16x8*)(q + (tb + t0 + l15) * 1024 + h * 64 + ks * 32 + g * 8);
#pragma unroll 4
      for (int rt = 0; rt < 16; rt++) {
        f32x4 acc = {0.f, 0.f, 0.f, 0.f};
#pragma unroll
        for (int ks = 0; ks < 2; ks++) {
          bf16x8 a = *(const bf16x8*)(wuk + ((size_t)h * 256 + rt * 16 + l15) * 64 + ks * 32 + g * 8);
          acc = mfma16(a, bq[ks], acc);
        }
        u32x2 ov;
        ov[0] = pk2(acc[0] * (0.125f * LOG2E), acc[1] * (0.125f * LOG2E));
        ov[1] = pk2(acc[2] * (0.125f * LOG2E), acc[3] * (0.125f * LOG2E));
        *(u32x2*)(ql + ((size_t)l15 * 16 + h) * 256 + rt * 16 + 4 * g) = ov;
      }
    }
    __syncthreads();
#pragma unroll 1
    for (int qi = 0; qi < 4; qi++) {
      const int qloc = 4 * w + qi;
      const int t = t0 + qloc;
      const u16* sp = sel + (tb + t) * 256;
      bf16x8 qb[8];
#pragma unroll
      for (int ks = 0; ks < 8; ks++) qb[ks] = *(const bf16x8*)(ql + ((size_t)qloc * 16 + l15) * 256 + ks * 32 + g * 8);
      float m_run = NEGF, l_run = 0.f;
      f32x4 O[16];
#pragma unroll
      for (int rt = 0; rt < 16; rt++) O[rt] = (f32x4){0.f, 0.f, 0.f, 0.f};
#pragma unroll 1
      for (int ch = 0; ch < 8; ch++) {
        __syncthreads();
#pragma unroll
        for (int hf = 0; hf < 2; hf++) {
          u32x4 gr[8];
#pragma unroll
          for (int i = 0; i < 8; i++) {
            const int pidx = lane + 64 * (i + 8 * hf);
            const int kk = pidx >> 5, c16 = pidx & 31;
            int idx = sp[ch * 32 + kk];
            if (idx == 0xffff) idx = 0;
            gr[i] = *(const u32x4*)(ckvn + (tb + idx) * 256 + c16 * 8);
          }
#pragma unroll
          for (int i = 0; i < 8; i++) {
            const int pidx = lane + 64 * (i + 8 * hf);
            const int kk = pidx >> 5, c16 = pidx & 31;
            *(u32x4*)&G[kk * GS + c16 * 8] = gr[i];
          }
        }
        __syncthreads();
        float lg[2][4];
#pragma unroll
        for (int kbk = 0; kbk < 2; kbk++) {
          f32x4 acc = {0.f, 0.f, 0.f, 0.f};
#pragma unroll
          for (int ks = 0; ks < 8; ks++) {
            bf16x8 a = *(const bf16x8*)&G[(16 * kbk + l15) * GS + ks * 32 + g * 8];
            acc = mfma16(a, qb[ks], acc);
          }
          const s16x4 kid4 = *(const s16x4*)(sp + ch * 32 + 16 * kbk + 4 * g);
#pragma unroll
          for (int i = 0; i < 4; i++) {
            const int kid = (int)(u16)kid4[i];
            float v = NEGF;
            if (kid != 0xffff) {
              int n = t - kid;
              n = n < 0 ? 0 : n;
              const int bk = n < 128 ? lut[n] : 31;
              v = acc[i] + rb[bk * 16 + l15];
            }
            lg[kbk][i] = v;
          }
        }
        float mx = fmaxf(fmaxf(fmaxf(lg[0][0], lg[0][1]), fmaxf(lg[0][2], lg[0][3])),
                         fmaxf(fmaxf(lg[1][0], lg[1][1]), fmaxf(lg[1][2], lg[1][3])));
        mx = fmaxf(mx, __shfl_xor(mx, 16));
        mx = fmaxf(mx, __shfl_xor(mx, 32));
        const float m_new = fmaxf(m_run, mx);
        const float scl = __builtin_amdgcn_exp2f(m_run - m_new);
        m_run = m_new;
        float ps = 0.f;
        float pe[8];
#pragma unroll
        for (int kbk = 0; kbk < 2; kbk++)
#pragma unroll
          for (int i = 0; i < 4; i++) {
            const float pv = __builtin_amdgcn_exp2f(lg[kbk][i] - m_new);
            pe[kbk * 4 + i] = pv;
            ps += pv;
          }
        l_run = l_run * scl + ps;
        u32x4 pw;
        pw[0] = pk2(pe[0], pe[1]);
        pw[1] = pk2(pe[2], pe[3]);
        pw[2] = pk2(pe[4], pe[5]);
        pw[3] = pk2(pe[6], pe[7]);
        const bf16x8 pB = __builtin_bit_cast(bf16x8, pw);
#pragma unroll
        for (int rt = 0; rt < 16; rt++) O[rt] = O[rt] * scl;
        const int q4 = l15 >> 2, p4 = l15 & 3;
#pragma unroll
        for (int rt = 0; rt < 16; rt++) {
          const s16x4 lo = __builtin_amdgcn_ds_read_tr16_b64_v4i16((lds_s16x4_ptr)(&G[(4 * g + q4) * GS + rt * 16 + 4 * p4]));
          const s16x4 hi = __builtin_amdgcn_ds_read_tr16_b64_v4i16((lds_s16x4_ptr)(&G[(16 + 4 * g + q4) * GS + rt * 16 + 4 * p4]));
          const bf16x8 a = (bf16x8){lo[0], lo[1], lo[2], lo[3], hi[0], hi[1], hi[2], hi[3]};
          O[rt] = mfma16(a, pB, O[rt]);
        }
      }
      float lt = l_run;
      lt += __shfl_xor(lt, 16);
      lt += __shfl_xor(lt, 32);
      const float inv = 1.f / lt;
#pragma unroll
      for (int rt = 0; rt < 16; rt++) {
        u32x2 ov;
        ov[0] = pk2(O[rt][0] * inv, O[rt][1] * inv);
        ov[1] = pk2(O[rt][2] * inv, O[rt][3] * inv);
        *(u32x2*)(ql + ((size_t)qloc * 16 + l15) * 256 + rt * 16 + 4 * g) = ov;
      }
    }
    __syncthreads();
    for (int hh = 0; hh < 4; hh++) {
      const int h = 4 * w + hh;
      bf16x8 bo[8];
#pragma unroll
      for (int ks = 0; ks < 8; ks++) bo[ks] = *(const bf16x8*)(ql + ((size_t)l15 * 16 + h) * 256 + ks * 32 + g * 8);
#pragma unroll
      for (int et = 0; et < 4; et++) {
        f32x4 acc = {0.f, 0.f, 0.f, 0.f};
#pragma unroll
        for (int ks = 0; ks < 8; ks++) {
          bf16x8 a = *(const bf16x8*)(wuv + ((size_t)h * 64 + et * 16 + l15) * 256 + ks * 32 + g * 8);
          acc = mfma16(a, bo[ks], acc);
        }
        u32x2 ov;
        ov[0] = pk2(acc[0], acc[1]);
        ov[1] = pk2(acc[2], acc[3]);
        *(u32x2*)(o + (tb + t0 + l15) * 1024 + h * 64 + et * 16 + 4 * g) = ov;
      }
    }
    __syncthreads();
  }
}

DI void diffattn_phase(const u16* __restrict__ q, const u16* __restrict__ k, const u16* __restrict__ vT,
                       u16* __restrict__ o, const float* __restrict__ rel_bias, const float* __restrict__ lam,
                       const float* __restrict__ subln, int layer_idx, char* smem, int bid, int nb) {
  constexpr int KS = 136, VS = 72;
  u16* Ks = (u16*)smem;
  u16* Vs = Ks + 64 * KS;
  float* exch = (float*)smem;
  float* btab = (float*)(smem + 36 * 1024);
  int* lut = (int*)(smem + 36 * 1024 + 1040);
  float* misc = (float*)(smem + 36 * 1024 + 1040 + 512);
  const int tid = opq_tid(), lane = tid & 63, w = __builtin_amdgcn_readfirstlane(tid >> 6), l31 = lane & 31, lh = lane >> 5;
  const int qsub = w >> 1, m = w & 1;
  const float lam_init = 0.8f - 0.6f * expf(-0.3f * (float)layer_idx);
  __syncthreads();
  if (tid < 128) lut[tid] = rel_bucket(tid);
  if (w == 0) {
    float p1 = lam[lane] * lam[64 + lane], p2 = lam[128 + lane] * lam[192 + lane];
    p1 = wave_sum(p1);
    p2 = wave_sum(p2);
    if (lane == 0) misc[0] = expf(p1) - expf(p2) + lam_init;
  }
  __syncthreads();
  const float lam_full = misc[0];
  const int nitems = NBATCH * 8 * (S / 64);
  const int nrounds = (nitems + nb - 1) / nb;
  const int prow = pi_row(l31);
  for (int rd = 0; rd < nrounds; rd++) {
    const int it = rd * nb + ((rd & 1) ? (nb - 1 - bid) : bid);
    if (it >= nitems) continue;
    const int bh = it & 31, qb = (S / 64 - 1) - (it >> 5);
    const int b = bh >> 3, h = bh & 7;
    const int q0 = qb * 64, tq0 = q0 + 32 * qsub, t = tq0 + l31;
    const size_t tb = (size_t)b * S;
    __syncthreads();
    for (int i = tid; i < 258; i += 256) {
      const int n = i >> 1, mm = i & 1;
      const int bk = n < 128 ? lut[n] : 31;
      btab[i] = rel_bias[bk * 16 + 2 * h + mm] * LOG2E;
    }
    bf16x8 qf[4];
#pragma unroll
    for (int ks = 0; ks < 4; ks++) qf[ks] = *(const bf16x8*)(q + (tb + t) * 1024 + h * 128 + m * 64 + ks * 16 + lh * 8);
    f32x16 O[4];
#pragma unroll
    for (int et = 0; et < 4; et++)
#pragma unroll
      for (int r = 0; r < 16; r++) O[et][r] = 0.f;
    float m_run = NEGF, l_run = 0.f;
    const int nkt = qb + 1;
    u32x4 rk[4], rv[4];
    const u16* kp = k + tb * 1024 + h * 128;
    const u16* vp = vT + ((size_t)(b * 8 + h) * 128) * 8192;
#pragma unroll
    for (int i = 0; i < 4; i++) {
      const int id = tid + 256 * i;
      rk[i] = *(const u32x4*)(kp + (size_t)(id >> 4) * 1024 + (id & 15) * 8);
      rv[i] = *(const u32x4*)(vp + (size_t)(id >> 3) * 8192 + (id & 7) * 8);
    }
#pragma unroll
    for (int i = 0; i < 4; i++) {
      const int id = tid + 256 * i;
      *(u32x4*)&Ks[(id >> 4) * KS + (id & 15) * 8] = rk[i];
      *(u32x4*)&Vs[(id >> 3) * VS + (id & 7) * 8] = rv[i];
    }
    __syncthreads();
    const float cfar = btab[256 + m];
    for (int kt = 0; kt < nkt; kt++) {
      if (kt + 1 < nkt) {
#pragma unroll
        for (int i = 0; i < 4; i++) {
          const int id = tid + 256 * i;
          rk[i] = *(const u32x4*)(kp + (size_t)((kt + 1) * 64 + (id >> 4)) * 1024 + (id & 15) * 8);
          rv[i] = *(const u32x4*)(vp + (size_t)(id >> 3) * 8192 + (kt + 1) * 64 + (id & 7) * 8);
        }
      }
      const int s_tile = kt * 64;
      const int nblk = (s_tile + 32 <= tq0 + 31) ? 2 : 1;
#pragma unroll 1
      for (int kb = 0; kb < nblk; kb++) {
        f32x16 acc;
#pragma unroll
        for (int r = 0; r < 16; r++) acc[r] = 0.f;
#pragma unroll
        for (int ks = 0; ks < 4; ks++) {
          bf16x8 a = *(const bf16x8*)&Ks[(32 * kb + prow) * KS + m * 64 + ks * 16 + lh * 8];
          acc = mfma32(a, qf[ks], acc);
        }
        const int s0 = s_tile + 32 * kb;
        const bool nearb = (tq0 - (s0 + 31)) < 128;
        if (nearb) {
#pragma unroll
          for (int r = 0; r < 16; r++) {
            const int key = s0 + 16 * (r >> 3) + 8 * lh + (r & 7);
            const int n = t - key;
            const int nc = n < 0 ? 0 : (n > 128 ? 128 : n);
            const float bv = btab[nc * 2 + m];
            acc[r] = (n < 0) ? NEGF : acc[r] + bv;
          }
        } else {
#pragma unroll
          for (int r = 0; r < 16; r++) acc[r] += cfar;
        }
        float mx = acc[0];
#pragma unroll
        for (int r = 1; r < 16; r++) mx = fmaxf(mx, acc[r]);
        mx = fmaxf(mx, __shfl_xor(mx, 32));
        const float m_new = fmaxf(m_run, mx);
        const float scl = __builtin_amdgcn_exp2f(m_run - m_new);
        m_run = m_new;
        float ps = 0.f;
#pragma unroll
        for (int r = 0; r < 16; r++) {
          const float pv = __builtin_amdgcn_exp2f(acc[r] - m_new);
          acc[r] = pv;
          ps += pv;
        }
        l_run = l_run * scl + ps;
        if (__ballot(scl != 1.f)) {
#pragma unroll
          for (int et = 0; et < 4; et++)
#pragma unroll
            for (int r = 0; r < 16; r++) O[et][r] *= scl;
        }
#pragma unroll
        for (int s2 = 0; s2 < 2; s2++) {
          u32x4 pw;
          pw[0] = pk2(acc[8 * s2 + 0], acc[8 * s2 + 1]);
          pw[1] = pk2(acc[8 * s2 + 2], acc[8 * s2 + 3]);
          pw[2] = pk2(acc[8 * s2 + 4], acc[8 * s2 + 5]);
          pw[3] = pk2(acc[8 * s2 + 6], acc[8 * s2 + 7]);
          const bf16x8 pB = __builtin_bit_cast(bf16x8, pw);
#pragma unroll
          for (int et = 0; et < 4; et++) {
            bf16x8 a = *(const bf16x8*)&Vs[(32 * et + l31) * VS + 32 * kb + 16 * s2 + 8 * lh];
            O[et] = mfma32(a, pB, O[et]);
          }
        }
      }
      __syncthreads();
      if (kt + 1 < nkt) {
#pragma unroll
        for (int i = 0; i < 4; i++) {
          const int id = tid + 256 * i;
          *(u32x4*)&Ks[(id >> 4) * KS + (id & 15) * 8] = rk[i];
          *(u32x4*)&Vs[(id >> 3) * VS + (id & 7) * 8] = rv[i];
        }
        __syncthreads();
      }
    }
    float lt = l_run + __shfl_xor(l_run, 32);
    const float inv = 1.f / lt;
    if (m == 1) {
#pragma unroll
      for (int et = 0; et < 4; et++)
#pragma unroll
        for (int r = 0; r < 16; r++) {
          const int e = 32 * et + (r & 3) + 8 * (r >> 2) + 4 * lh;
          exch[(qsub * 128 + e) * 32 + l31] = O[et][r] * inv;
        }
    }
    __syncthreads();
    if (m == 0) {
      float ss = 0.f;
#pragma unroll
      for (int et = 0; et < 4; et++)
#pragma unroll
        for (int r = 0; r < 16; r++) {
          const int e = 32 * et + (r & 3) + 8 * (r >> 2) + 4 * lh;
          const float v = O[et][r] * inv - lam_full * exch[(qsub * 128 + e) * 32 + l31];
          O[et][r] = v;
          ss += v * v;
        }
      ss += __shfl_xor(ss, 32);
      const float rs = rsqrtf(ss * (1.f / 128.f) + LN_EPS);
      const float osc = 1.f - lam_init;
#pragma unroll
      for (int et = 0; et < 4; et++)
#pragma unroll
        for (int r4 = 0; r4 < 4; r4++) {
          const int e = 32 * et + 8 * r4 + 4 * lh;
          const f32x4 gv = *(const f32x4*)(subln + e);
          u32x2 ov;
          ov[0] = pk2(O[et][4 * r4 + 0] * rs * gv[0] * osc, O[et][4 * r4 + 1] * rs * gv[1] * osc);
          ov[1] = pk2(O[et][4 * r4 + 2] * rs * gv[2] * osc, O[et][4 * r4 + 3] * rs * gv[3] * osc);
          *(u32x2*)(o + (tb + t) * 1024 + h * 128 + e) = ov;
        }
    }
  }
}

__global__ void __launch_bounds__(256, 2) hybrid_fwd(Params p) {
  __shared__ __attribute__((aligned(16))) char smem[LDS_BYTES];
  cg::grid_group grid = cg::this_grid();
  const int bid = blockIdx.x, nb = gridDim.x;
  char* ws = p.ws;
  u16* w_ain = (u16*)(ws + W_AIN);
  u16* w_uk = (u16*)(ws + W_UK);
  u16* w_uv = (u16*)(ws + W_UV);
  u16* w_ao = (u16*)(ws + W_AO);
  u16* w_bin = (u16*)(ws + W_BIN);
  u16* w_bo = (u16*)(ws + W_BO);
  u16* w_w1 = (u16*)(ws + W_W1);
  u16* w_w2 = (u16*)(ws + W_W2);
  float* mod = (float*)(ws + WS_MOD);
  u16* hbuf = (u16*)(ws + WS_H);
  char* big = ws + WS_BIG;
  u16* qbuf = (u16*)(big + B_Q);
  u16* iqbuf = (u16*)(big + B_IQ);
  u16* ikbuf = (u16*)(big + B_IK);
  float* iwbuf = (float*)(big + B_IW);
  float* ckvraw = (float*)(big + B_CKVRAW);
  u16* ckvn = (u16*)(big + B_CKVN);
  u16* selbuf = (u16*)(big + B_SEL);
  u16* kbuf = (u16*)(big + B_K);
  u16* vtbuf = (u16*)(big + B_VT);
  u16* obuf = (u16*)(big + B_O);
  u16* hid = (u16*)big;

  tconv_phase(p.a_w_in, w_ain, 2, 1024, 1864, A_INP, smem, bid, nb);
  tconv_phase(p.a_w_uk, w_uk, 32, 64, 256, 256, smem, bid, nb);
  tconv_phase(p.a_w_uv, w_uv, 32, 256, 64, 64, smem, bid, nb);
  tconv_phase(p.a_w_o, w_ao, 2, 1024, 1024, 1024, smem, bid, nb);
  tconv_phase(p.b_w_in, w_bin, 2, 1024, 3072, 3072, smem, bid, nb);
  tconv_phase(p.b_w_o, w_bo, 2, 1024, 1024, 1024, smem, bid, nb);
  tconv_phase(p.mlp_w1, w_w1, 4, 1024, 4096, 4096, smem, bid, nb);
  tconv_phase(p.mlp_w2, w_w2, 4, 4096, 1024, 1024, smem, bid, nb);
  mod_phase(p, mod, smem, bid, nb);
  grid.sync();
  h0_phase(p.x, mod, hbuf, bid, nb);
  grid.sync();

#pragma unroll 1
  for (int sl = 0; sl < 8; sl++) {
    const int i = sl >> 1, j = i >> 1;
    const float* modi = mod + (size_t)i * 4 * 6144;
    const u16* Ares;
    const u16* Wres;
    int Kres, goff;
    if ((sl & 1) == 0) {
      if ((i & 1) == 0) {
        EpiArgs ea{};
        ea.o0 = qbuf; ea.f0 = ckvraw; ea.o1 = iqbuf; ea.o2 = ikbuf; ea.f1 = iwbuf;
        for (int rep = 0; rep < (PROBE_DUP == 4 ? 2 : 1); rep++) gemm_phase<EPI_AIN>(hbuf, w_ain + (size_t)j * A_INP * 1024, T, A_INP, 1024, ea, smem, bid, nb);
        grid.sync();
        ckvnorm_phase(ckvraw, p.a_kv_norm + j * 256, ckvn, bid, nb);
        for (int rep = 0; rep < (PROBE_DUP == 2 ? 2 : 1); rep++) indexer_phase(iqbuf, ikbuf, iwbuf, selbuf, smem, bid, nb);
        grid.sync();
        for (int rep = 0; rep < (PROBE_DUP == 3 ? 2 : 1); rep++) sparse_phase(qbuf, ckvn, selbuf, w_uk + (size_t)j * 16 * 256 * 64, w_uv + (size_t)j * 16 * 256 * 64, p.rel_bias,
                     hbuf, obuf, smem, bid, nb);
        grid.sync();
        Wres = w_ao + (size_t)j * 1024 * 1024;
      } else {
        EpiArgs ea{};
        ea.o0 = qbuf; ea.o1 = kbuf; ea.o2 = vtbuf;
        for (int rep = 0; rep < (PROBE_DUP == 4 ? 2 : 1); rep++) gemm_phase<EPI_BIN>(hbuf, w_bin + (size_t)j * 3072 * 1024, T, 3072, 1024, ea, smem, bid, nb);
        grid.sync();
        for (int rep = 0; rep < (PROBE_DUP == 1 ? 2 : 1); rep++) diffattn_phase(qbuf, kbuf, vtbuf, obuf, p.rel_bias, p.b_lambda + j * 256, p.b_subln + j * 128, i, smem, bid, nb);
        grid.sync();
        Wres = w_bo + (size_t)j * 1024 * 1024;
      }
      Ares = obuf; Kres = 1024; goff = 2 * 1024;
    } else {
      EpiArgs ea{};
      ea.o0 = hid;
      for (int rep = 0; rep < (PROBE_DUP == 4 ? 2 : 1); rep++) gemm_phase<EPI_SQRELU>(hbuf, w_w1 + (size_t)i * 4096 * 1024, T, 4096, 1024, ea, smem, bid, nb);
      grid.sync();
      Ares = hid; Wres = w_w2 + (size_t)i * 4096 * 1024; Kres = 4096; goff = 5 * 1024;
    }
    {
      EpiArgs ea{};
      ea.f0 = p.out;
      ea.xin = (sl == 0) ? p.x : (const float*)p.out;
      ea.g = modi + goff;
      gemm_phase<EPI_RES>(Ares, Wres, T, 1024, Kres, ea, smem, bid, nb);
    }
    grid.sync();
    {
      const float* modn = ((sl & 1) == 0) ? modi : (i < 3 ? modi + 4 * 6144 : (const float*)nullptr);
      const int sh_off = ((sl & 1) == 0) ? 3 * 1024 : 0;
      ln_phase(p.out, p.ln_g + (size_t)(i * 2 + (sl & 1)) * 1024, p.ln_b + (size_t)(i * 2 + (sl & 1)) * 1024, modn, sh_off,
               hbuf, bid, nb);
    }
    grid.sync();
  }
}

extern "C" void kernel_launch(void* const* d_in, const int* in_sizes, int n_in, void* d_out, int out_size, void* d_ws,
                              size_t ws_size, hipStream_t stream) {
  static int grid_blocks = 0;
  if (!grid_blocks) {
    int dev = 0, cus = 0, per_cu = 0;
    hipGetDevice(&dev);
    hipDeviceGetAttribute(&cus, hipDeviceAttributeMultiprocessorCount, dev);
    hipOccupancyMaxActiveBlocksPerMultiprocessor(&per_cu, hybrid_fwd, 256, 0);
    if (per_cu < 1) per_cu = 1;
    if (per_cu > 2) per_cu = 2;
    grid_blocks = cus * per_cu;
    if (grid_blocks > 512) grid_blocks = 512;
  }
  Params p{};
  p.x = (const float*)d_in[0];
  p.c = (const float*)d_in[1];
  p.rel_bias = (const float*)d_in[2];
  p.ada_w = (const float*)d_in[3];
  p.ada_b = (const float*)d_in[4];
  p.ln_g = (const float*)d_in[5];
  p.ln_b = (const float*)d_in[6];
  p.a_w_in = (const float*)d_in[7];
  p.a_kv_norm = (const float*)d_in[8];
  p.a_w_uk = (const float*)d_in[9];
  p.a_w_uv = (const float*)d_in[10];
  p.a_w_o = (const float*)d_in[11];
  p.b_w_in = (const float*)d_in[12];
  p.b_lambda = (const float*)d_in[13];
  p.b_subln = (const float*)d_in[14];
  p.b_w_o = (const float*)d_in[15];
  p.mlp_w1 = (const float*)d_in[16];
  p.mlp_w2 = (const float*)d_in[17];
  p.out = (float*)d_out;
  p.ws = (char*)d_ws;
  void* args[] = {&p};
  hipError_t e = hipLaunchCooperativeKernel((void*)hybrid_fwd, dim3(grid_blocks), dim3(256), args, 0, stream);
  if (e != hipSuccess) fprintf(stderr, "cooperative launch failed: %s (grid %d)\n", hipGetErrorString(e), grid_blocks);
}
```

```cpp
#include <hip/hip_runtime.h>
#include <hip/hip_cooperative_groups.h>
#include <stdint.h>
#include <stdio.h>
namespace cg = cooperative_groups;

typedef unsigned short u16;
typedef short bf16x8 __attribute__((ext_vector_type(8)));
typedef short s16x4 __attribute__((ext_vector_type(4)));
typedef float f32x16 __attribute__((ext_vector_type(16)));
typedef float f32x4 __attribute__((ext_vector_type(4)));
typedef float f32x2 __attribute__((ext_vector_type(2)));
typedef __bf16 bf16x2_t __attribute__((ext_vector_type(2)));
typedef unsigned u32x4 __attribute__((ext_vector_type(4)));
typedef unsigned u32x2 __attribute__((ext_vector_type(2)));
typedef __attribute__((address_space(3))) s16x4* lds_s16x4_ptr;

#define DI __device__ __forceinline__
#ifndef PROBE_DUP
#define PROBE_DUP 0
#endif

constexpr int D = 1024, NBATCH = 4, S = 8192, T = NBATCH * S;
constexpr int A_INP = 1920;
constexpr float DN_ALPHA = 1.6817928305074292f;
constexpr float LOG2E = 1.4426950408889634f;
constexpr float LN_EPS = 1e-5f;
constexpr float NEGF = -1e30f;
constexpr int TOPK = 256;
constexpr int CAP = 704;
constexpr int LDS_BYTES = 72 * 1024;

constexpr size_t MB = 1024 * 1024;
constexpr size_t W_AIN = 0;
constexpr size_t W_UK = W_AIN + (size_t)2 * 1920 * 1024 * 2;
constexpr size_t W_UV = W_UK + (size_t)2 * 16 * 256 * 64 * 2;
constexpr size_t W_AO = W_UV + (size_t)2 * 16 * 256 * 64 * 2;
constexpr size_t W_BIN = W_AO + (size_t)2 * 1024 * 1024 * 2;
constexpr size_t W_BO = W_BIN + (size_t)2 * 3072 * 1024 * 2;
constexpr size_t W_W1 = W_BO + (size_t)2 * 1024 * 1024 * 2;
constexpr size_t W_W2 = W_W1 + (size_t)4 * 4096 * 1024 * 2;
constexpr size_t WS_MOD = W_W2 + (size_t)4 * 4096 * 1024 * 2;
constexpr size_t WS_H = WS_MOD + 1 * MB;
constexpr size_t WS_BIG = WS_H + 64 * MB;
constexpr size_t B_Q = 0;
constexpr size_t B_IQ = 64 * MB;
constexpr size_t B_IK = 96 * MB;
constexpr size_t B_IW = 100 * MB;
constexpr size_t B_CKVRAW = 104 * MB;
constexpr size_t B_CKVN = 136 * MB;
constexpr size_t B_SEL = 152 * MB;
constexpr size_t B_K = 64 * MB;
constexpr size_t B_VT = 128 * MB;
constexpr size_t B_O = 192 * MB;

struct Params {
  const float *x, *c, *rel_bias, *ada_w, *ada_b, *ln_g, *ln_b, *a_w_in, *a_kv_norm, *a_w_uk, *a_w_uv, *a_w_o, *b_w_in,
      *b_lambda, *b_subln, *b_w_o, *mlp_w1, *mlp_w2;
  float* out;
  char* ws;
};

DI int opq_tid() {
  int t = threadIdx.x;
  asm volatile("" : "+v"(t));
  return t;
}
DI unsigned pk2(float lo, float hi) {
  f32x2 v = {lo, hi};
  bf16x2_t b = __builtin_convertvector(v, bf16x2_t);
  return __builtin_bit_cast(unsigned, b);
}
DI u16 f2bf(float x) { return (u16)(pk2(x, 0.f) & 0xffffu); }
DI float wave_sum(float v) {
#pragma unroll
  for (int o = 32; o >= 1; o >>= 1) v += __shfl_xor(v, o);
  return v;
}
DI f32x16 mfma32(bf16x8 a, bf16x8 b, f32x16 c) { return __builtin_amdgcn_mfma_f32_32x32x16_bf16(a, b, c, 0, 0, 0); }
DI f32x4 mfma16(bf16x8 a, bf16x8 b, f32x4 c) { return __builtin_amdgcn_mfma_f32_16x16x32_bf16(a, b, c, 0, 0, 0); }
DI int pi_row(int r) { return (r & ~12) | ((r & 4) << 1) | ((r & 8) >> 1); }

DI int rel_bucket(int n) {
  if (n < 16) return n;
  float nf = (float)n;
  int large = 16 + (int)(logf(nf / 16.f) / 2.0794415416798357f * 16.f);
  return large < 31 ? large : 31;
}

DI void tconv_phase(const float* __restrict__ src, u16* __restrict__ dst, int batch, int R, int C, int Cpad, char* smem,
                    int bid, int nb) {
  float* tile = (float*)smem;
  const int tid = opq_tid();
  const int tr = R / 64, tc = Cpad / 64;
  const int ntiles = batch * tr * tc;
  for (int it = bid; it < ntiles; it += nb) {
    const int bi = it / (tr * tc);
    const int rem = it - bi * (tr * tc);
    const int ri = rem / tc, ci = rem - ri * tc;
    const float* s = src + (size_t)bi * R * C;
    u16* d = dst + (size_t)bi * Cpad * R;
    __syncthreads();
#pragma unroll 4
    for (int k = 0; k < 16; k++) {
      const int r = (tid >> 6) + 4 * k;
      const int cc = ci * 64 + (tid & 63);
      float v = (cc < C) ? s[(size_t)(ri * 64 + r) * C + cc] : 0.f;
      tile[r * 65 + (tid & 63)] = v;
    }
    __syncthreads();
#pragma unroll 4
    for (int k = 0; k < 16; k++) {
      const int cl = (tid >> 6) + 4 * k;
      const int rl = tid & 63;
      d[(size_t)(ci * 64 + cl) * R + ri * 64 + rl] = f2bf(tile[rl * 65 + cl]);
    }
  }
}

DI void mod_phase(const Params& p, float* mod, char* smem, int bid, int nb) {
  float* sc = (float*)smem;
  float* red = sc + 4096;
  const int tid = opq_tid(), lane = tid & 63, w = __builtin_amdgcn_readfirstlane(tid >> 6);
  __syncthreads();
  for (int i = tid; i < 4096; i += 256) {
    float v = p.c[i];
    sc[i] = v / (1.f + expf(-v));
  }
  __syncthreads();
  for (int it = bid; it < 4 * 96; it += nb) {
    const int l = it / 96, e0 = (it - l * 96) * 64;
    const float* wp = p.ada_w + ((size_t)l * 1024 + w * 256) * 6144 + e0 + lane;
    float a0 = 0, a1 = 0, a2 = 0, a3 = 0;
#pragma unroll 8
    for (int d = 0; d < 256; d++) {
      float wv = wp[(size_t)d * 6144];
      int dd = w * 256 + d;
      a0 += sc[dd] * wv;
      a1 += sc[1024 + dd] * wv;
      a2 += sc[2048 + dd] * wv;
      a3 += sc[3072 + dd] * wv;
    }
    red[(w * 4 + 0) * 64 + lane] = a0;
    red[(w * 4 + 1) * 64 + lane] = a1;
    red[(w * 4 + 2) * 64 + lane] = a2;
    red[(w * 4 + 3) * 64 + lane] = a3;
    __syncthreads();
    {
      const int b = w;
      float s = red[(0 * 4 + b) * 64 + lane] + red[(1 * 4 + b) * 64 + lane] + red[(2 * 4 + b) * 64 + lane] +
                red[(3 * 4 + b) * 64 + lane] + p.ada_b[l * 6144 + e0 + lane];
      mod[((size_t)l * 4 + b) * 6144 + e0 + lane] = s;
    }
    __syncthreads();
  }
}

DI void h0_phase(const float* __restrict__ x, const float* __restrict__ mod0, u16* __restrict__ h, int bid, int nb) {
  const size_t n8 = (size_t)T * 1024 / 8;
  for (size_t i = (size_t)bid * 256 + opq_tid(); i < n8; i += (size_t)nb * 256) {
    const size_t e = i * 8;
    const int t = (int)(e >> 10), d = (int)(e & 1023), b = t >> 13;
    const float* m = mod0 + (size_t)b * 6144;
    f32x4 v0 = *(const f32x4*)(x + e), v1 = *(const f32x4*)(x + e + 4);
    f32x4 sh0 = *(const f32x4*)(m + d), sh1 = *(const f32x4*)(m + d + 4);
    f32x4 sc0 = *(const f32x4*)(m + 1024 + d), sc1 = *(const f32x4*)(m + 1024 + d + 4);
    v0 = v0 * (1.f + sc0) + sh0;
    v1 = v1 * (1.f + sc1) + sh1;
    u32x4 o;
    o[0] = pk2(v0[0], v0[1]);
    o[1] = pk2(v0[2], v0[3]);
    o[2] = pk2(v1[0], v1[1]);
    o[3] = pk2(v1[2], v1[3]);
    *(u32x4*)(h + e) = o;
  }
}

DI void ln_phase(float* z, const float* __restrict__ g, const float* __restrict__ bt, const float* modn, int sh_off,
                 u16* __restrict__ h, int bid, int nb) {
  const int tid = opq_tid(), lane = tid & 63, w = __builtin_amdgcn_readfirstlane(tid >> 6);
  for (int row = bid * 4 + w; row < T; row += nb * 4) {
    f32x4* zp = (f32x4*)(z + (size_t)row * 1024);
    f32x4 v[4];
#pragma unroll
    for (int c = 0; c < 4; c++) v[c] = zp[c * 64 + lane];
    float s = 0;
#pragma unroll
    for (int c = 0; c < 4; c++) s += v[c][0] + v[c][1] + v[c][2] + v[c][3];
    const float mu = wave_sum(s) * (1.f / 1024.f);
    float q = 0;
#pragma unroll
    for (int c = 0; c < 4; c++) {
      v[c] = v[c] - mu;
      q += v[c][0] * v[c][0] + v[c][1] * v[c][1] + v[c][2] * v[c][2] + v[c][3] * v[c][3];
    }
    const float rstd = rsqrtf(wave_sum(q) * (1.f / 1024.f) + LN_EPS);
    const int b = row >> 13;
#pragma unroll
    for (int c = 0; c < 4; c++) {
      const int d = c * 256 + lane * 4;
      f32x4 y = v[c] * rstd * *(const f32x4*)(g + d) + *(const f32x4*)(bt + d);
      zp[c * 64 + lane] = y;
      if (modn) {
        const float* m = modn + (size_t)b * 6144 + sh_off;
        f32x4 hv = y * (1.f + *(const f32x4*)(m + 1024 + d)) + *(const f32x4*)(m + d);
        u32x2 o;
        o[0] = pk2(hv[0], hv[1]);
        o[1] = pk2(hv[2], hv[3]);
        *(u32x2*)(h + (size_t)row * 1024 + d) = o;
      }
    }
  }
}

enum { EPI_AIN = 0, EPI_BIN = 1, EPI_RES = 2, EPI_SQRELU = 3 };
struct EpiArgs {
  u16 *o0, *o1, *o2;
  float *f0, *f1;
  const float* xin;
  const float* g;
};

template <int EPI>
DI void gemm_phase(const u16* __restrict__ A, const u16* __restrict__ Bt, int M, int N, int K, const EpiArgs& ea,
                   char* smem, int bid, int nb) {
  constexpr int MI = 4, BM = 64 * MI;
  u16* As = (u16*)smem;
  u16* Bs = As + BM * 72;
  const int tid = opq_tid(), lane = tid & 63, w = __builtin_amdgcn_readfirstlane(tid >> 6), wm = w >> 1, wn = w & 1, l31 = lane & 31, lh = lane >> 5;
  const int ntn = N / 128, ntm = M / BM, nt = ntn * ntm, nk = K / 64;
  const int lr = tid >> 3, lc = (tid & 7) * 8;
  const int xcd = bid & 7, nbx = nb >> 3, cntx = (ntm >> 3) * ntn;
  (void)nt;
  for (int sq = bid >> 3; sq < cntx; sq += nbx) {
    const int tmx = sq / ntn, tn = sq - tmx * ntn;
    const int tm = tmx * 8 + xcd;
    const int m0 = tm * BM, n0 = tn * 128;
    f32x16 acc[MI][2];
#pragma unroll
    for (int i = 0; i < MI; i++)
#pragma unroll
      for (int j = 0; j < 2; j++)
#pragma unroll
        for (int r = 0; r < 16; r++) acc[i][j][r] = 0.f;
    u32x4 ra[2 * MI], rb[4];
    const u16* ap = A + (size_t)(m0 + lr) * K + lc;
    const u16* bp = Bt + (size_t)(n0 + lr) * K + lc;
#pragma unroll
    for (int i = 0; i < 2 * MI; i++) ra[i] = *(const u32x4*)(ap + (size_t)i * 32 * K);
#pragma unroll
    for (int i = 0; i < 4; i++) rb[i] = *(const u32x4*)(bp + (size_t)i * 32 * K);
    __syncthreads();
#pragma unroll
    for (int i = 0; i < 2 * MI; i++) *(u32x4*)&As[(lr + 32 * i) * 72 + lc] = ra[i];
#pragma unroll
    for (int i = 0; i < 4; i++) *(u32x4*)&Bs[(lr + 32 * i) * 72 + lc] = rb[i];
    __syncthreads();
    for (int kt = 0; kt < nk; kt++) {
      if (kt + 1 < nk) {
#pragma unroll
        for (int i = 0; i < 2 * MI; i++) ra[i] = *(const u32x4*)(ap + (size_t)i * 32 * K + (kt + 1) * 64);
#pragma unroll
        for (int i = 0; i < 4; i++) rb[i] = *(const u32x4*)(bp + (size_t)i * 32 * K + (kt + 1) * 64);
      }
#pragma unroll
      for (int ks = 0; ks < 4; ks++) {
        bf16x8 af[MI], b0, b1;
#pragma unroll
        for (int i = 0; i < MI; i++) af[i] = *(const bf16x8*)&As[(wm * 32 * MI + 32 * i + l31) * 72 + ks * 16 + lh * 8];
        b0 = *(const bf16x8*)&Bs[(wn * 64 + l31) * 72 + ks * 16 + lh * 8];
        b1 = *(const bf16x8*)&Bs[(wn * 64 + 32 + l31) * 72 + ks * 16 + lh * 8];
#pragma unroll
        for (int i = 0; i < MI; i++) {
          acc[i][0] = mfma32(b0, af[i], acc[i][0]);
          acc[i][1] = mfma32(b1, af[i], acc[i][1]);
        }
      }
      __syncthreads();
      if (kt + 1 < nk) {
#pragma unroll
        for (int i = 0; i < 2 * MI; i++) *(u32x4*)&As[(lr + 32 * i) * 72 + lc] = ra[i];
#pragma unroll
        for (int i = 0; i < 4; i++) *(u32x4*)&Bs[(lr + 32 * i) * 72 + lc] = rb[i];
        __syncthreads();
      }
    }
    const int bidx = m0 >> 13;
#pragma unroll
    for (int i = 0; i < MI; i++) {
      const int row = m0 + wm * 32 * MI + 32 * i + l31;
#pragma unroll
      for (int j = 0; j < 2; j++) {
#pragma unroll
        for (int r4 = 0; r4 < 4; r4++) {
          const int col = n0 + wn * 64 + 32 * j + 8 * r4 + 4 * lh;
          float v[4];
#pragma unroll
          for (int q = 0; q < 4; q++) v[q] = acc[i][j][4 * r4 + q];
          if (EPI == EPI_AIN) {
            if (col < 1024) {
              u32x2 o;
              o[0] = pk2(v[0], v[1]);
              o[1] = pk2(v[2], v[3]);
              *(u32x2*)(ea.o0 + (size_t)row * 1024 + col) = o;
            } else if (col < 1280) {
              *(f32x4*)(ea.f0 + (size_t)row * 256 + (col - 1024)) = (f32x4){v[0], v[1], v[2], v[3]};
            } else if (col < 1792) {
              u32x2 o;
              o[0] = pk2(v[0], v[1]);
              o[1] = pk2(v[2], v[3]);
              *(u32x2*)(ea.o1 + (size_t)row * 512 + (col - 1280)) = o;
            } else if (col < 1856) {
              const int d = col - 1792;
              const int sidx = row & 8191;
              const size_t off = (size_t)(row >> 13) * S * 64 +
                                 ((size_t)((sidx >> 5) * 4 + (d >> 4)) * 64 + 32 * ((d >> 3) & 1) + (sidx & 31)) * 8 + (d & 7);
              u32x2 o;
              o[0] = pk2(v[0], v[1]);
              o[1] = pk2(v[2], v[3]);
              *(u32x2*)(ea.o2 + off) = o;
            } else if (col < 1864) {
              const float sc = 0.044194173824159216f;
              *(f32x4*)(ea.f1 + (size_t)row * 8 + (col - 1856)) = (f32x4){v[0] * sc, v[1] * sc, v[2] * sc, v[3] * sc};
            }
          } else if (EPI == EPI_BIN) {
            if (col < 1024) {
              const float sc = 0.125f * LOG2E;
              u32x2 o;
              o[0] = pk2(v[0] * sc, v[1] * sc);
              o[1] = pk2(v[2] * sc, v[3] * sc);
              *(u32x2*)(ea.o0 + (size_t)row * 1024 + col) = o;
            } else if (col < 2048) {
              u32x2 o;
              o[0] = pk2(v[0], v[1]);
              o[1] = pk2(v[2], v[3]);
              *(u32x2*)(ea.o1 + (size_t)row * 1024 + (col - 1024)) = o;
            } else {
              const int cv = col - 2048;
#pragma unroll
              for (int q = 0; q < 4; q++) ea.o2[((size_t)bidx * 1024 + cv + q) * 8192 + (row & 8191)] = f2bf(v[q]);
            }
          } else if (EPI == EPI_RES) {
            const f32x4 gg = *(const f32x4*)(ea.g + (size_t)bidx * 6144 + col);
            const size_t o = (size_t)row * 1024 + col;
            const f32x4 xv = *(const f32x4*)(ea.xin + o);
            f32x4 r;
#pragma unroll
            for (int q = 0; q < 4; q++) r[q] = DN_ALPHA * xv[q] + (1.f + gg[q]) * v[q];
            *(f32x4*)(ea.f0 + o) = r;
          } else {
            float r[4];
#pragma unroll
            for (int q = 0; q < 4; q++) {
              r[q] = v[q] > 0.f ? v[q] : 0.f;
              r[q] = r[q] * r[q];
            }
            u32x2 o;
            o[0] = pk2(r[0], r[1]);
            o[1] = pk2(r[2], r[3]);
            *(u32x2*)(ea.o0 + (size_t)row * 4096 + col) = o;
          }
        }
      }
    }
  }
}

DI void ckvnorm_phase(const float* __restrict__ raw, const float* __restrict__ g, u16* __restrict__ outp, int bid,
                      int nb) {
  const int tid = opq_tid(), lane = tid & 63, w = __builtin_amdgcn_readfirstlane(tid >> 6);
  const f32x4 gg = *(const f32x4*)(g + lane * 4);
  for (int row = bid * 4 + w; row < T; row += nb * 4) {
    f32x4 v = *(const f32x4*)(raw + (size_t)row * 256 + lane * 4);
    float ss = v[0] * v[0] + v[1] * v[1] + v[2] * v[2] + v[3] * v[3];
    ss = wave_sum(ss);
    const float r = rsqrtf(ss * (1.f / 256.f) + LN_EPS);
    u32x2 o;
    o[0] = pk2(v[0] * r * gg[0], v[1] * r * gg[1]);
    o[1] = pk2(v[2] * r * gg[2], v[3] * r * gg[3]);
    *(u32x2*)(outp + (size_t)row * 256 + lane * 4) = o;
  }
}

DI unsigned mono_key(float s) {
  unsigned u = __float_as_uint(s);
  return (u & 0x80000000u) ? ~u : (u | 0x80000000u);
}
DI float mono_inv(unsigned k) {
  unsigned u = (k & 0x80000000u) ? (k & 0x7fffffffu) : ~k;
  return __uint_as_float(u);
}
DI float relu_i(float x) {
  int i = __float_as_int(x);
  return __int_as_float(i > 0 ? i : 0);
}
DI int wcount(bool f) { return __popcll(__ballot(f)); }

template <bool EXACT>
DI void compact4(float* vals, u16* idxs, int* cnt, int lane, float* thr_out) {
  constexpr int NPL = CAP / 64;
  unsigned key[4][NPL];
  int n[4];
#pragma unroll
  for (int q = 0; q < 4; q++) n[q] = cnt[q];
#pragma unroll
  for (int q = 0; q < 4; q++)
#pragma unroll
    for (int j = 0; j < NPL; j++) {
      const int e = j * 64 + lane;
      key[q][j] = (e < n[q]) ? mono_key(vals[q * CAP + e]) : 0u;
    }
  unsigned Tk[4] = {0u, 0u, 0u, 0u};
  constexpr int LOWBIT = EXACT ? 0 : 18;
#pragma unroll 1
  for (int bit = 31; bit >= LOWBIT; bit--) {
#pragma unroll
    for (int q = 0; q < 4; q++) {
      const unsigned cand = Tk[q] | (1u << bit);
      int c = 0;
#pragma unroll
      for (int j = 0; j < NPL; j++) c += wcount(key[q][j] >= cand);
      Tk[q] = (c >= TOPK) ? cand : Tk[q];
    }
  }
  unsigned I[4] = {0xffffu, 0xffffu, 0xffffu, 0xffffu};
  if (EXACT) {
    unsigned ix[4][NPL];
    int need[4];
#pragma unroll
    for (int q = 0; q < 4; q++) {
      int cgt = 0;
#pragma unroll
      for (int j = 0; j < NPL; j++) {
        const int e = j * 64 + lane;
        ix[q][j] = (e < n[q]) ? (unsigned)idxs[q * CAP + e] : 0xffffu;
        cgt += wcount(key[q][j] > Tk[q]);
      }
      need[q] = TOPK - cgt;
      I[q] = 0u;
    }
#pragma unroll 1
    for (int bit = 13; bit >= 0; bit--) {
#pragma unroll
      for (int q = 0; q < 4; q++) {
        const unsigned cand = I[q] | (1u << bit);
        int c = 0;
#pragma unroll
        for (int j = 0; j < NPL; j++) c += wcount(key[q][j] == Tk[q] && ix[q][j] < cand);
        I[q] = (c < need[q]) ? cand : I[q];
      }
    }
  }
  const unsigned long long lt = (1ull << lane) - 1ull;
#pragma unroll
  for (int q = 0; q < 4; q++) {
    if (n[q] > TOPK) {
      int base = 0;
#pragma unroll
      for (int j = 0; j < NPL; j++) {
        const int e = j * 64 + lane;
        const bool in = e < n[q];
        const float v = in ? vals[q * CAP + e] : 0.f;
        const unsigned ixv = in ? (unsigned)idxs[q * CAP + e] : 0xffffu;
        const bool keep = (key[q][j] > Tk[q]) || (key[q][j] == Tk[q] && ixv <= I[q]);
        const unsigned long long m = __ballot(keep);
        if (keep) {
          const int pos = base + __popcll(m & lt);
          vals[q * CAP + pos] = v;
          idxs[q * CAP + pos] = (u16)ixv;
        }
        base += __popcll(m);
      }
      if (lane == 0) cnt[q] = base;
      thr_out[q] = mono_inv(Tk[q]);
    }
  }
}

DI void indexer_phase(const u16* __restrict__ iq, const u16* __restrict__ ik, const float* __restrict__ iw,
                      u16* __restrict__ sel, char* smem, int bid, int nb) {
  constexpr int WBYTES = 4 * CAP * 4 + 4 * CAP * 2 + 64;
  const int tid = opq_tid(), lane = tid & 63, w = __builtin_amdgcn_readfirstlane(tid >> 6), l31 = lane & 31, u = lane >> 5;
  float* vals = (float*)(smem + w * WBYTES);
  u16* idxs = (u16*)(smem + w * WBYTES + 4 * CAP * 4);
  int* cnt = (int*)(smem + w * WBYTES + 4 * CAP * 4 + 4 * CAP * 2);
  const int nitems = NBATCH * (S / 16);
  const int nrounds = (nitems + nb - 1) / nb;
  __syncthreads();
  for (int rd = 0; rd < nrounds; rd++) {
    const int it = rd * nb + ((rd & 1) ? (nb - 1 - bid) : bid);
    if (it >= nitems) continue;
    const int b = it & 3, qg = (S / 16 - 1) - (it >> 2);
    const int t0 = qg * 16;
    const int tw = t0 + 4 * w;
    const size_t tb = (size_t)b * S;
    bf16x8 aq[4];
    {
      const int g = l31 >> 3, up = (l31 >> 2) & 1, j = l31 & 3;
      const int ql = 2 * up + (g >> 1), hd = 4 * (g & 1) + j;
      const u16* qp = iq + (tb + tw + ql) * 512 + hd * 64 + u * 8;
#pragma unroll
      for (int ks = 0; ks < 4; ks++) aq[ks] = *(const bf16x8*)(qp + ks * 16);
    }
    float wq[2][8];
#pragma unroll
    for (int qq = 0; qq < 2; qq++) {
      const float* wp = iw + (tb + tw + 2 * u + qq) * 8;
      f32x4 w0 = *(const f32x4*)wp, w1 = *(const f32x4*)(wp + 4);
#pragma unroll
      for (int h = 0; h < 4; h++) {
        wq[qq][h] = w0[h];
        wq[qq][4 + h] = w1[h];
      }
    }
    float thr[2] = {-INFINITY, -INFINITY};
    __builtin_amdgcn_wave_barrier();
    if (lane < 4) cnt[lane] = 0;
    __builtin_amdgcn_wave_barrier();
    const int nkb = (tw + 3) / 32 + 1;
    const u16* kp = ik + tb * 64 + lane * 8;
    bf16x8 ring[4][4];
#pragma unroll
    for (int i = 0; i < 4; i++) {
      const int kbn = (i < nkb) ? i : nkb - 1;
#pragma unroll
      for (int ks = 0; ks < 4; ks++) ring[i][ks] = *(const bf16x8*)(kp + (size_t)(kbn * 4 + ks) * 512);
    }
#pragma unroll 1
    for (int kb0 = 0; kb0 < nkb; kb0 += 4) {
#pragma unroll
      for (int i = 0; i < 4; i++) {
        const int kb = kb0 + i;
        {
          f32x16 acc;
#pragma unroll
          for (int r = 0; r < 16; r++) acc[r] = 0.f;
#pragma unroll
          for (int ks = 0; ks < 4; ks++) acc = mfma32(aq[ks], ring[i][ks], acc);
          {
            const int kbn = (kb + 4 < nkb) ? kb + 4 : nkb - 1;
#pragma unroll
            for (int ks = 0; ks < 4; ks++) ring[i][ks] = *(const bf16x8*)(kp + (size_t)(kbn * 4 + ks) * 512);
          }
          const int key = kb * 32 + l31;
#pragma unroll
          for (int qq = 0; qq < 2; qq++) {
            float s0 = 0.f, s1 = 0.f;
#pragma unroll
            for (int h = 0; h < 8; h += 2) {
              s0 = fmaf(wq[qq][h], relu_i(acc[8 * qq + h]), s0);
              s1 = fmaf(wq[qq][h + 1], relu_i(acc[8 * qq + h + 1]), s1);
            }
            float s = s0 + s1;
            s += 0.0f;
            const int tq = tw + 2 * u + qq;
            if (key <= tq && s >= thr[qq]) {
              const int qs = 2 * u + qq;
              const int pos = atomicAdd(&cnt[qs], 1);
              vals[qs * CAP + pos] = s;
              idxs[qs * CAP + pos] = (u16)key;
            }
          }
        }
      }
      __builtin_amdgcn_wave_barrier();
      const int c0 = cnt[0], c1 = cnt[1], c2 = cnt[2], c3 = cnt[3];
      if (c0 > CAP - 128 || c1 > CAP - 128 || c2 > CAP - 128 || c3 > CAP - 128) {
        float to[4] = {0.f, 0.f, 0.f, 0.f};
        compact4<false>(vals, idxs, cnt, lane, to);
        __builtin_amdgcn_wave_barrier();
        const int d0 = cnt[0], d1 = cnt[1], d2 = cnt[2], d3 = cnt[3];
        if (d0 > CAP - 256 || d1 > CAP - 256 || d2 > CAP - 256 || d3 > CAP - 256) {
          compact4<true>(vals, idxs, cnt, lane, to);
          __builtin_amdgcn_wave_barrier();
        }
        if (c0 > TOPK && u == 0) thr[0] = to[0];
        if (c1 > TOPK && u == 0) thr[1] = to[1];
        if (c2 > TOPK && u == 1) thr[0] = to[2];
        if (c3 > TOPK && u == 1) thr[1] = to[3];
      }
    }
    {
      const int c0 = cnt[0], c1 = cnt[1], c2 = cnt[2], c3 = cnt[3];
      if (c0 > TOPK || c1 > TOPK || c2 > TOPK || c3 > TOPK) {
        float to[4];
        compact4<true>(vals, idxs, cnt, lane, to);
        __builtin_amdgcn_wave_barrier();
      }
    }
#pragma unroll 1
    for (int qs = 0; qs < 4; qs++) {
      const int n = cnt[qs];
      u16* sp = sel + (tb + tw + qs) * 256;
#pragma unroll
      for (int j = 0; j < 4; j++) {
        const int e = j * 64 + lane;
        sp[e] = (e < n) ? idxs[qs * CAP + e] : (u16)0xffffu;
      }
    }
  }
}

DI void sparse_phase(const u16* __restrict__ q, const u16* __restrict__ ckvn, const u16* __restrict__ sel,
                     const u16* __restrict__ wuk, const u16* __restrict__ wuv, const float* __restrict__ rel_bias,
                     u16* scratch, u16* __restrict__ o, char* smem, int bid, int nb) {
  constexpr int GS = 264;
  const int tid = opq_tid(), lane = tid & 63, w = __builtin_amdgcn_readfirstlane(tid >> 6), l15 = lane & 15, g = lane >> 4;
  u16* G = (u16*)smem + (size_t)w * 32 * GS;
  int* lut = (int*)(smem + 4 * 32 * GS * 2);
  float* rb = (float*)(lut + 128);
  __syncthreads();
  if (tid < 128) lut[tid] = rel_bucket(tid);
  for (int i = tid; i < 512; i += 256) rb[i] = rel_bias[i] * LOG2E;
  __syncthreads();
  u16* ql = scratch + (size_t)bid * (16 * 16 * 256);
  const int nitems = NBATCH * (S / 16);
  for (int it = bid; it < nitems; it += nb) {
    const int b = it & 3, qg = it >> 2;
    const int t0 = qg * 16;
    const size_t tb = (size_t)b * S;
    for (int hh = 0; hh < 4; hh++) {
      const int h = 4 * w + hh;
      bf16x8 bq[2];
#pragma unroll
      for (int ks = 0; ks < 2; ks++) bq[ks] = *(const bf16x8*)(q + (tb + t0 + l15) * 1024 + h * 64 + ks * 32 + g * 8);
#pragma unroll 4
      for (int rt = 0; rt < 16; rt++) {
        f32x4 acc = {0.f, 0.f, 0.f, 0.f};
#pragma unroll
        for (int ks = 0; ks < 2; ks++) {
          bf16x8 a = *(const bf16x8*)(wuk + ((size_t)h * 256 + rt * 16 + l15) * 64 + ks * 32 + g * 8);
          acc = mfma16(a, bq[ks], acc);
        }
        u32x2 ov;
        ov[0] = pk2(acc[0] * (0.125f * LOG2E), acc[1] * (0.125f * LOG2E));
        ov[1] = pk2(acc[2] * (0.125f * LOG2E), acc[3] * (0.125f * LOG2E));
        *(u32x2*)(ql + ((size_t)l15 * 16 + h) * 256 + rt * 16 + 4 * g) = ov;
      }
    }
    __syncthreads();
#pragma unroll 1
    for (int qi = 0; qi < 4; qi++) {
      const int qloc = 4 * w + qi;
      const int t = t0 + qloc;
      const u16* sp = sel + (tb + t) * 256;
      bf16x8 qb[8];
#pragma unroll
      for (int ks = 0; ks < 8; ks++) qb[ks] = *(const bf16x8*)(ql + ((size_t)qloc * 16 + l15) * 256 + ks * 32 + g * 8);
      float m_run = NEGF, l_run = 0.f;
      f32x4 O[16];
#pragma unroll
      for (int rt = 0; rt < 16; rt++) O[rt] = (f32x4){0.f, 0.f, 0.f, 0.f};
#pragma unroll 1
      for (int ch = 0; ch < 8; ch++) {
        __syncthreads();
#pragma unroll
        for (int hf = 0; hf < 2; hf++) {
          u32x4 gr[8];
#pragma unroll
          for (int i = 0; i < 8; i++) {
            const int pidx = lane + 64 * (i + 8 * hf);
            const int kk = pidx >> 5, c16 = pidx & 31;
            int idx = sp[ch * 32 + kk];
            if (idx == 0xffff) idx = 0;
            gr[i] = *(const u32x4*)(ckvn + (tb + idx) * 256 + c16 * 8);
          }
#pragma unroll
          for (int i = 0; i < 8; i++) {
            const int pidx = lane + 64 * (i + 8 * hf);
            const int kk = pidx >> 5, c16 = pidx & 31;
            *(u32x4*)&G[kk * GS + c16 * 8] = gr[i];
          }
        }
        __syncthreads();
        float lg[2][4];
#pragma unroll
        for (int kbk = 0; kbk < 2; kbk++) {
          f32x4 acc = {0.f, 0.f, 0.f, 0.f};
#pragma unroll
          for (int ks = 0; ks < 8; ks++) {
            bf16x8 a = *(const bf16x8*)&G[(16 * kbk + l15) * GS + ks * 32 + g * 8];
            acc = mfma16(a, qb[ks], acc);
          }
          const s16x4 kid4 = *(const s16x4*)(sp + ch * 32 + 16 * kbk + 4 * g);
#pragma unroll
          for (int i = 0; i < 4; i++) {
            const int kid = (int)(u16)kid4[i];
            float v = NEGF;
            if (kid != 0xffff) {
              int n = t - kid;
              n = n < 0 ? 0 : n;
              const int bk = n < 128 ? lut[n] : 31;
              v = acc[i] + rb[bk * 16 + l15];
            }
            lg[kbk][i] = v;
          }
        }
        float mx = fmaxf(fmaxf(fmaxf(lg[0][0], lg[0][1]), fmaxf(lg[0][2], lg[0][3])),
                         fmaxf(fmaxf(lg[1][0], lg[1][1]), fmaxf(lg[1][2], lg[1][3])));
        mx = fmaxf(mx, __shfl_xor(mx, 16));
        mx = fmaxf(mx, __shfl_xor(mx, 32));
        const float m_new = fmaxf(m_run, mx);
        const float scl = __builtin_amdgcn_exp2f(m_run - m_new);
        m_run = m_new;
        float ps = 0.f;
        float pe[8];
#pragma unroll
        for (int kbk = 0; kbk < 2; kbk++)
#pragma unroll
          for (int i = 0; i < 4; i++) {
            const float pv = __builtin_amdgcn_exp2f(lg[kbk][i] - m_new);
            pe[kbk * 4 + i] = pv;
            ps += pv;
          }
        l_run = l_run * scl + ps;
        u32x4 pw;
        pw[0] = pk2(pe[0], pe[1]);
        pw[1] = pk2(pe[2], pe[3]);
        pw[2] = pk2(pe[4], pe[5]);
        pw[3] = pk2(pe[6], pe[7]);
        const bf16x8 pB = __builtin_bit_cast(bf16x8, pw);
#pragma unroll
        for (int rt = 0; rt < 16; rt++) O[rt] = O[rt] * scl;
        const int q4 = l15 >> 2, p4 = l15 & 3;
#pragma unroll
        for (int rt = 0; rt < 16; rt++) {
          const s16x4 lo = __builtin_amdgcn_ds_read_tr16_b64_v4i16((lds_s16x4_ptr)(&G[(4 * g + q4) * GS + rt * 16 + 4 * p4]));
          const s16x4 hi = __builtin_amdgcn_ds_read_tr16_b64_v4i16((lds_s16x4_ptr)(&G[(16 + 4 * g + q4) * GS + rt * 16 + 4 * p4]));
          const bf16x8 a = (bf16x8){lo[0], lo[1], lo[2], lo[3], hi[0], hi[1], hi[2], hi[3]};
          O[rt] = mfma16(a, pB, O[rt]);
        }
      }
      float lt = l_run;
      lt += __shfl_xor(lt, 16);
      lt += __shfl_xor(lt, 32);
      const float inv = 1.f / lt;
#pragma unroll
      for (int rt = 0; rt < 16; rt++) {
        u32x2 ov;
        ov[0] = pk2(O[rt][0] * inv, O[rt][1] * inv);
        ov[1] = pk2(O[rt][2] * inv, O[rt][3] * inv);
        *(u32x2*)(ql + ((size_t)qloc * 16 + l15) * 256 + rt * 16 + 4 * g) = ov;
      }
    }
    __syncthreads();
    for (int hh = 0; hh < 4; hh++) {
      const int h = 4 * w + hh;
      bf16x8 bo[8];
#pragma unroll
      for (int ks = 0; ks < 8; ks++) bo[ks] = *(const bf16x8*)(ql + ((size_t)l15 * 16 + h) * 256 + ks * 32 + g * 8);
#pragma unroll
      for (int et = 0; et < 4; et++) {
        f32x4 acc = {0.f, 0.f, 0.f, 0.f};
#pragma unroll
        for (int ks = 0; ks < 8; ks++) {
          bf16x8 a = *(const bf16x8*)(wuv + ((size_t)h * 64 + et * 16 + l15) * 256 + ks * 32 + g * 8);
          acc = mfma16(a, bo[ks], acc);
        }
        u32x2 ov;
        ov[0] = pk2(acc[0], acc[1]);
        ov[1] = pk2(acc[2], acc[3]);
        *(u32x2*)(o + (tb + t0 + l15) * 1024 + h * 64 + et * 16 + 4 * g) = ov;
      }
    }
    __syncthreads();
  }
}

DI void diffattn_phase(const u16* __restrict__ q, const u16* __restrict__ k, const u16* __restrict__ vT,
                       u16* __restrict__ o, const float* __restrict__ rel_bias, const float* __restrict__ lam,
                       const float* __restrict__ subln, int layer_idx, char* smem, int bid, int nb) {
  constexpr int KS = 136, VS = 72;
  u16* Ks = (u16*)smem;
  u16* Vs = Ks + 64 * KS;
  float* exch = (float*)smem;
  float* btab = (float*)(smem + 36 * 1024);
  int* lut = (int*)(smem + 36 * 1024 + 1040);
  float* misc = (float*)(smem + 36 * 1024 + 1040 + 512);
  const int tid = opq_tid(), lane = tid & 63, w = __builtin_amdgcn_readfirstlane(tid >> 6), l31 = lane & 31, lh = lane >> 5;
  const int qsub = w >> 1, m = w & 1;
  const float lam_init = 0.8f - 0.6f * expf(-0.3f * (float)layer_idx);
  __syncthreads();
  if (tid < 128) lut[tid] = rel_bucket(tid);
  if (w == 0) {
    float p1 = lam[lane] * lam[64 + lane], p2 = lam[128 + lane] * lam[192 + lane];
    p1 = wave_sum(p1);
    p2 = wave_sum(p2);
    if (lane == 0) misc[0] = expf(p1) - expf(p2) + lam_init;
  }
  __syncthreads();
  const float lam_full = misc[0];
  const int nitems = NBATCH * 8 * (S / 64);
  const int nrounds = (nitems + nb - 1) / nb;
  const int prow = pi_row(l31);
  for (int rd = 0; rd < nrounds; rd++) {
    const int it = rd * nb + ((rd & 1) ? (nb - 1 - bid) : bid);
    if (it >= nitems) continue;
    const int bh = it & 31, qb = (S / 64 - 1) - (it >> 5);
    const int b = bh >> 3, h = bh & 7;
    const int q0 = qb * 64, tq0 = q0 + 32 * qsub, t = tq0 + l31;
    const size_t tb = (size_t)b * S;
    __syncthreads();
    for (int i = tid; i < 258; i += 256) {
      const int n = i >> 1, mm = i & 1;
      const int bk = n < 128 ? lut[n] : 31;
      btab[i] = rel_bias[bk * 16 + 2 * h + mm] * LOG2E;
    }
    bf16x8 qf[4];
#pragma unroll
    for (int ks = 0; ks < 4; ks++) qf[ks] = *(const bf16x8*)(q + (tb + t) * 1024 + h * 128 + m * 64 + ks * 16 + lh * 8);
    f32x16 O[4];
#pragma unroll
    for (int et = 0; et < 4; et++)
#pragma unroll
      for (int r = 0; r < 16; r++) O[et][r] = 0.f;
    float m_run = NEGF, l_run = 0.f;
    const int nkt = qb + 1;
    u32x4 rk[4], rv[4];
    const u16* kp = k + tb * 1024 + h * 128;
    const u16* vp = vT + ((size_t)(b * 8 + h) * 128) * 8192;
#pragma unroll
    for (int i = 0; i < 4; i++) {
      const int id = tid + 256 * i;
      rk[i] = *(const u32x4*)(kp + (size_t)(id >> 4) * 1024 + (id & 15) * 8);
      rv[i] = *(const u32x4*)(vp + (size_t)(id >> 3) * 8192 + (id & 7) * 8);
    }
#pragma unroll
    for (int i = 0; i < 4; i++) {
      const int id = tid + 256 * i;
      *(u32x4*)&Ks[(id >> 4) * KS + (id & 15) * 8] = rk[i];
      *(u32x4*)&Vs[(id >> 3) * VS + (id & 7) * 8] = rv[i];
    }
    __syncthreads();
    const float cfar = btab[256 + m];
    for (int kt = 0; kt < nkt; kt++) {
      if (kt + 1 < nkt) {
#pragma unroll
        for (int i = 0; i < 4; i++) {
          const int id = tid + 256 * i;
          rk[i] = *(const u32x4*)(kp + (size_t)((kt + 1) * 64 + (id >> 4)) * 1024 + (id & 15) * 8);
          rv[i] = *(const u32x4*)(vp + (size_t)(id >> 3) * 8192 + (kt + 1) * 64 + (id & 7) * 8);
        }
      }
      const int s_tile = kt * 64;
      const int nblk = (s_tile + 32 <= tq0 + 31) ? 2 : 1;
#pragma unroll 1
      for (int kb = 0; kb < nblk; kb++) {
        f32x16 acc;
#pragma unroll
        for (int r = 0; r < 16; r++) acc[r] = 0.f;
#pragma unroll
        for (int ks = 0; ks < 4; ks++) {
          bf16x8 a = *(const bf16x8*)&Ks[(32 * kb + prow) * KS + m * 64 + ks * 16 + lh * 8];
          acc = mfma32(a, qf[ks], acc);
        }
        const int s0 = s_tile + 32 * kb;
        const bool nearb = (tq0 - (s0 + 31)) < 128;
        if (nearb) {
#pragma unroll
          for (int r = 0; r < 16; r++) {
            const int key = s0 + 16 * (r >> 3) + 8 * lh + (r & 7);
            const int n = t - key;
            const int nc = n < 0 ? 0 : (n > 128 ? 128 : n);
            const float bv = btab[nc * 2 + m];
            acc[r] = (n < 0) ? NEGF : acc[r] + bv;
          }
        } else {
#pragma unroll
          for (int r = 0; r < 16; r++) acc[r] += cfar;
        }
        float mx = acc[0];
#pragma unroll
        for (int r = 1; r < 16; r++) mx = fmaxf(mx, acc[r]);
        mx = fmaxf(mx, __shfl_xor(mx, 32));
        const float m_new = fmaxf(m_run, mx);
        const float scl = __builtin_amdgcn_exp2f(m_run - m_new);
        m_run = m_new;
        float ps = 0.f;
#pragma unroll
        for (int r = 0; r < 16; r++) {
          const float pv = __builtin_amdgcn_exp2f(acc[r] - m_new);
          acc[r] = pv;
          ps += pv;
        }
        l_run = l_run * scl + ps;
        if (__ballot(scl != 1.f)) {
#pragma unroll
          for (int et = 0; et < 4; et++)
#pragma unroll
            for (int r = 0; r < 16; r++) O[et][r] *= scl;
        }
#pragma unroll
        for (int s2 = 0; s2 < 2; s2++) {
          u32x4 pw;
          pw[0] = pk2(acc[8 * s2 + 0], acc[8 * s2 + 1]);
          pw[1] = pk2(acc[8 * s2 + 2], acc[8 * s2 + 3]);
          pw[2] = pk2(acc[8 * s2 + 4], acc[8 * s2 + 5]);
          pw[3] = pk2(acc[8 * s2 + 6], acc[8 * s2 + 7]);
          const bf16x8 pB = __builtin_bit_cast(bf16x8, pw);
#pragma unroll
          for (int et = 0; et < 4; et++) {
            bf16x8 a = *(const bf16x8*)&Vs[(32 * et + l31) * VS + 32 * kb + 16 * s2 + 8 * lh];
            O[et] = mfma32(a, pB, O[et]);
          }
        }
      }
      __syncthreads();
      if (kt + 1 < nkt) {
#pragma unroll
        for (int i = 0; i < 4; i++) {
          const int id = tid + 256 * i;
          *(u32x4*)&Ks[(id >> 4) * KS + (id & 15) * 8] = rk[i];
          *(u32x4*)&Vs[(id >> 3) * VS + (id & 7) * 8] = rv[i];
        }
        __syncthreads();
      }
    }
    float lt = l_run + __shfl_xor(l_run, 32);
    const float inv = 1.f / lt;
    if (m == 1) {
#pragma unroll
      for (int et = 0; et < 4; et++)
#pragma unroll
        for (int r = 0; r < 16; r++) {
          const int e = 32 * et + (r & 3) + 8 * (r >> 2) + 4 * lh;
          exch[(qsub * 128 + e) * 32 + l31] = O[et][r] * inv;
        }
    }
    __syncthreads();
    if (m == 0) {
      float ss = 0.f;
#pragma unroll
      for (int et = 0; et < 4; et++)
#pragma unroll
        for (int r = 0; r < 16; r++) {
          const int e = 32 * et + (r & 3) + 8 * (r >> 2) + 4 * lh;
          const float v = O[et][r] * inv - lam_full * exch[(qsub * 128 + e) * 32 + l31];
          O[et][r] = v;
          ss += v * v;
        }
      ss += __shfl_xor(ss, 32);
      const float rs = rsqrtf(ss * (1.f / 128.f) + LN_EPS);
      const float osc = 1.f - lam_init;
#pragma unroll
      for (int et = 0; et < 4; et++)
#pragma unroll
        for (int r4 = 0; r4 < 4; r4++) {
          const int e = 32 * et + 8 * r4 + 4 * lh;
          const f32x4 gv = *(const f32x4*)(subln + e);
          u32x2 ov;
          ov[0] = pk2(O[et][4 * r4 + 0] * rs * gv[0] * osc, O[et][4 * r4 + 1] * rs * gv[1] * osc);
          ov[1] = pk2(O[et][4 * r4 + 2] * rs * gv[2] * osc, O[et][4 * r4 + 3] * rs * gv[3] * osc);
          *(u32x2*)(o + (tb + t) * 1024 + h * 128 + e) = ov;
        }
    }
  }
}

__global__ void __launch_bounds__(256, 2) hybrid_fwd(Params p) {
  __shared__ __attribute__((aligned(16))) char smem[LDS_BYTES];
  cg::grid_group grid = cg::this_grid();
  const int bid = blockIdx.x, nb = gridDim.x;
  char* ws = p.ws;
  u16* w_ain = (u16*)(ws + W_AIN);
  u16* w_uk = (u16*)(ws + W_UK);
  u16* w_uv = (u16*)(ws + W_UV);
  u16* w_ao = (u16*)(ws + W_AO);
  u16* w_bin = (u16*)(ws + W_BIN);
  u16* w_bo = (u16*)(ws + W_BO);
  u16* w_w1 = (u16*)(ws + W_W1);
  u16* w_w2 = (u16*)(ws + W_W2);
  float* mod = (float*)(ws + WS_MOD);
  u16* hbuf = (u16*)(ws + WS_H);
  char* big = ws + WS_BIG;
  u16* qbuf = (u16*)(big + B_Q);
  u16* iqbuf = (u16*)(big + B_IQ);
  u16* ikbuf = (u16*)(big + B_IK);
  float* iwbuf = (float*)(big + B_IW);
  float* ckvraw = (float*)(big + B_CKVRAW);
  u16* ckvn = (u16*)(big + B_CKVN);
  u16* selbuf = (u16*)(big + B_SEL);
  u16* kbuf = (u16*)(big + B_K);
  u16* vtbuf = (u16*)(big + B_VT);
  u16* obuf = (u16*)(big + B_O);
  u16* hid = (u16*)big;

  tconv_phase(p.a_w_in, w_ain, 2, 1024, 1864, A_INP, smem, bid, nb);
  tconv_phase(p.a_w_uk, w_uk, 32, 64, 256, 256, smem, bid, nb);
  tconv_phase(p.a_w_uv, w_uv, 32, 256, 64, 64, smem, bid, nb);
  tconv_phase(p.a_w_o, w_ao, 2, 1024, 1024, 1024, smem, bid, nb);
  tconv_phase(p.b_w_in, w_bin, 2, 1024, 3072, 3072, smem, bid, nb);
  tconv_phase(p.b_w_o, w_bo, 2, 1024, 1024, 1024, smem, bid, nb);
  tconv_phase(p.mlp_w1, w_w1, 4, 1024, 4096, 4096, smem, bid, nb);
  tconv_phase(p.mlp_w2, w_w2, 4, 4096, 1024, 1024, smem, bid, nb);
  mod_phase(p, mod, smem, bid, nb);
  grid.sync();
  h0_phase(p.x, mod, hbuf, bid, nb);
  grid.sync();

#pragma unroll 1
  for (int sl = 0; sl < 8; sl++) {
    const int i = sl >> 1, j = i >> 1;
    const float* modi = mod + (size_t)i * 4 * 6144;
    const u16* Ares;
    const u16* Wres;
    int Kres, goff;
    if ((sl & 1) == 0) {
      if ((i & 1) == 0) {
        EpiArgs ea{};
        ea.o0 = qbuf; ea.f0 = ckvraw; ea.o1 = iqbuf; ea.o2 = ikbuf; ea.f1 = iwbuf;
        for (int rep = 0; rep < (PROBE_DUP == 4 ? 2 : 1); rep++) gemm_phase<EPI_AIN>(hbuf, w_ain + (size_t)j * A_INP * 1024, T, A_INP, 1024, ea, smem, bid, nb);
        grid.sync();
        ckvnorm_phase(ckvraw, p.a_kv_norm + j * 256, ckvn, bid, nb);
        for (int rep = 0; rep < (PROBE_DUP == 2 ? 2 : 1); rep++) indexer_phase(iqbuf, ikbuf, iwbuf, selbuf, smem, bid, nb);
        grid.sync();
        for (int rep = 0; rep < (PROBE_DUP == 3 ? 2 : 1); rep++) sparse_phase(qbuf, ckvn, selbuf, w_uk + (size_t)j * 16 * 256 * 64, w_uv + (size_t)j * 16 * 256 * 64, p.rel_bias,
                     hbuf, obuf, smem, bid, nb);
        grid.sync();
        Wres = w_ao + (size_t)j * 1024 * 1024;
      } else {
        EpiArgs ea{};
        ea.o0 = qbuf; ea.o1 = kbuf; ea.o2 = vtbuf;
        for (int rep = 0; rep < (PROBE_DUP == 4 ? 2 : 1); rep++) gemm_phase<EPI_BIN>(hbuf, w_bin + (size_t)j * 3072 * 1024, T, 3072, 1024, ea, smem, bid, nb);
        grid.sync();
        for (int rep = 0; rep < (PROBE_DUP == 1 ? 2 : 1); rep++) diffattn_phase(qbuf, kbuf, vtbuf, obuf, p.rel_bias, p.b_lambda + j * 256, p.b_subln + j * 128, i, smem, bid, nb);
        grid.sync();
        Wres = w_bo + (size_t)j * 1024 * 1024;
      }
      Ares = obuf; Kres = 1024; goff = 2 * 1024;
    } else {
      EpiArgs ea{};
      ea.o0 = hid;
      for (int rep = 0; rep < (PROBE_DUP == 4 ? 2 : 1); rep++) gemm_phase<EPI_SQRELU>(hbuf, w_w1 + (size_t)i * 4096 * 1024, T, 4096, 1024, ea, smem, bid, nb);
      grid.sync();
      Ares = hid; Wres = w_w2 + (size_t)i * 4096 * 1024; Kres = 4096; goff = 5 * 1024;
    }
    {
      EpiArgs ea{};
      ea.f0 = p.out;
      ea.xin = (sl == 0) ? p.x : (const float*)p.out;
      ea.g = modi + goff;
      gemm_phase<EPI_RES>(Ares, Wres, T, 1024, Kres, ea, smem, bid, nb);
    }
    grid.sync();
    {
      const float* modn = ((sl & 1) == 0) ? modi : (i < 3 ? modi + 4 * 6144 : (const float*)nullptr);
      const int sh_off = ((sl & 1) == 0) ? 3 * 1024 : 0;
      ln_phase(p.out, p.ln_g + (size_t)(i * 2 + (sl & 1)) * 1024, p.ln_b + (size_t)(i * 2 + (sl & 1)) * 1024, modn, sh_off,
               hbuf, bid, nb);
    }
    grid.sync();
  }
}

extern "C" void kernel_launch(void* const* d_in, const int* in_sizes, int n_in, void* d_out, int out_size, void* d_ws,
                              size_t ws_size, hipStream_t stream) {
  static int grid_blocks = 0;
  if (!grid_blocks) {
    int dev = 0, cus = 0, per_cu = 0;
    hipGetDevice(&dev);
    hipDeviceGetAttribute(&cus, hipDeviceAttributeMultiprocessorCount, dev);
    hipOccupancyMaxActiveBlocksPerMultiprocessor(&per_cu, hybrid_fwd, 256, 0);
    if (per_cu < 1) per_cu = 1;
    if (per_cu > 2) per_cu = 2;
    grid_blocks = cus * per_cu;
    if (grid_blocks > 512) grid_blocks = 512;
  }
  Params p{};
  p.x = (const float*)d_in[0];
  p.c = (const float*)d_in[1];
  p.rel_bias = (const float*)d_in[2];
  p.ada_w = (const float*)d_in[3];
  p.ada_b = (const float*)d_in[4];
  p.ln_g = (const float*)d_in[5];
  p.ln_b = (const float*)d_in[6];
  p.a_w_in = (const float*)d_in[7];
  p.a_kv_norm = (const float*)d_in[8];
  p.a_w_uk = (const float*)d_in[9];
  p.a_w_uv = (const float*)d_in[10];
  p.a_w_o = (const float*)d_in[11];
  p.b_w_in = (const float*)d_in[12];
  p.b_lambda = (const float*)d_in[13];
  p.b_subln = (const float*)d_in[14];
  p.b_w_o = (const float*)d_in[15];
  p.mlp_w1 = (const float*)d_in[16];
  p.mlp_w2 = (const float*)d_in[17];
  p.out = (float*)d_out;
  p.ws = (char*)d_ws;
  void* args[] = {&p};
  hipError_t e = hipLaunchCooperativeKernel((void*)hybrid_fwd, dim3(grid_blocks), dim3(256), args, 0, stream);
  if (e != hipSuccess) fprintf(stderr, "cooperative launch failed: %s (grid %d)\n", hipGetErrorString(e), grid_blocks);
}
```

```cpp
#include <hip/hip_runtime.h>
#include <hip/hip_cooperative_groups.h>
#include <stdint.h>
#include <stdio.h>
namespace cg = cooperative_groups;

typedef unsigned short u16;
typedef short bf16x8 __attribute__((ext_vector_type(8)));
typedef short s16x4 __attribute__((ext_vector_type(4)));
typedef float f32x16 __attribute__((ext_vector_type(16)));
typedef float f32x4 __attribute__((ext_vector_type(4)));
typedef float f32x2 __attribute__((ext_vector_type(2)));
typedef __bf16 bf16x2_t __attribute__((ext_vector_type(2)));
typedef unsigned u32x4 __attribute__((ext_vector_type(4)));
typedef unsigned u32x2 __attribute__((ext_vector_type(2)));
typedef __attribute__((address_space(3))) s16x4* lds_s16x4_ptr;

#define DI __device__ __forceinline__
#ifndef PROBE_DUP
#define PROBE_DUP 0
#endif

constexpr int D = 1024, NBATCH = 4, S = 8192, T = NBATCH * S;
constexpr int A_INP = 1920;
constexpr float DN_ALPHA = 1.6817928305074292f;
constexpr float LOG2E = 1.4426950408889634f;
constexpr float LN_EPS = 1e-5f;
constexpr float NEGF = -1e30f;
constexpr int TOPK = 256;
constexpr int CAP = 704;
constexpr int LDS_BYTES = 72 * 1024;

constexpr size_t MB = 1024 * 1024;
constexpr size_t W_AIN = 0;
constexpr size_t W_UK = W_AIN + (size_t)2 * 1920 * 1024 * 2;
constexpr size_t W_UV = W_UK + (size_t)2 * 16 * 256 * 64 * 2;
constexpr size_t W_AO = W_UV + (size_t)2 * 16 * 256 * 64 * 2;
constexpr size_t W_BIN = W_AO + (size_t)2 * 1024 * 1024 * 2;
constexpr size_t W_BO = W_BIN + (size_t)2 * 3072 * 1024 * 2;
constexpr size_t W_W1 = W_BO + (size_t)2 * 1024 * 1024 * 2;
constexpr size_t W_W2 = W_W1 + (size_t)4 * 4096 * 1024 * 2;
constexpr size_t WS_MOD = W_W2 + (size_t)4 * 4096 * 1024 * 2;
constexpr size_t WS_H = WS_MOD + 1 * MB;
constexpr size_t WS_BIG = WS_H + 64 * MB;
constexpr size_t WS_BAR = WS_BIG + 256 * MB;
constexpr size_t B_Q = 0;
constexpr size_t B_IQ = 64 * MB;
constexpr size_t B_IK = 96 * MB;
constexpr size_t B_IW = 100 * MB;
constexpr size_t B_CKVRAW = 104 * MB;
constexpr size_t B_CKVN = 136 * MB;
constexpr size_t B_SEL = 152 * MB;
constexpr size_t B_K = 64 * MB;
constexpr size_t B_VT = 128 * MB;
constexpr size_t B_O = 192 * MB;

struct Params {
  const float *x, *c, *rel_bias, *ada_w, *ada_b, *ln_g, *ln_b, *a_w_in, *a_kv_norm, *a_w_uk, *a_w_uv, *a_w_o, *b_w_in,
      *b_lambda, *b_subln, *b_w_o, *mlp_w1, *mlp_w2;
  float* out;
  char* ws;
};

DI int opq_tid() {
  int t = threadIdx.x;
  asm volatile("" : "+v"(t));
  return t;
}
DI unsigned pk2(float lo, float hi) {
  f32x2 v = {lo, hi};
  bf16x2_t b = __builtin_convertvector(v, bf16x2_t);
  return __builtin_bit_cast(unsigned, b);
}
DI u16 f2bf(float x) { return (u16)(pk2(x, 0.f) & 0xffffu); }
DI float wave_sum(float v) {
#pragma unroll
  for (int o = 32; o >= 1; o >>= 1) v += __shfl_xor(v, o);
  return v;
}
DI f32x16 mfma32(bf16x8 a, bf16x8 b, f32x16 c) { return __builtin_amdgcn_mfma_f32_32x32x16_bf16(a, b, c, 0, 0, 0); }
DI f32x4 mfma16(bf16x8 a, bf16x8 b, f32x4 c) { return __builtin_amdgcn_mfma_f32_16x16x32_bf16(a, b, c, 0, 0, 0); }
DI int pi_row(int r) { return (r & ~12) | ((r & 4) << 1) | ((r & 8) >> 1); }

DI int rel_bucket(int n) {
  if (n < 16) return n;
  float nf = (float)n;
  int large = 16 + (int)(logf(nf / 16.f) / 2.0794415416798357f * 16.f);
  return large < 31 ? large : 31;
}

DI void tconv_phase(const float* __restrict__ src, u16* __restrict__ dst, int batch, int R, int C, int Cpad, char* smem,
                    int bid, int nb) {
  float* tile = (float*)smem;
  const int tid = opq_tid();
  const int tr = R / 64, tc = Cpad / 64;
  const int ntiles = batch * tr * tc;
  for (int it = bid; it < ntiles; it += nb) {
    const int bi = it / (tr * tc);
    const int rem = it - bi * (tr * tc);
    const int ri = rem / tc, ci = rem - ri * tc;
    const float* s = src + (size_t)bi * R * C;
    u16* d = dst + (size_t)bi * Cpad * R;
    __syncthreads();
#pragma unroll 4
    for (int k = 0; k < 16; k++) {
      const int r = (tid >> 6) + 4 * k;
      const int cc = ci * 64 + (tid & 63);
      float v = (cc < C) ? s[(size_t)(ri * 64 + r) * C + cc] : 0.f;
      tile[r * 65 + (tid & 63)] = v;
    }
    __syncthreads();
#pragma unroll 4
    for (int k = 0; k < 16; k++) {
      const int cl = (tid >> 6) + 4 * k;
      const int rl = tid & 63;
      d[(size_t)(ci * 64 + cl) * R + ri * 64 + rl] = f2bf(tile[rl * 65 + cl]);
    }
  }
}

DI void mod_phase(const Params& p, float* mod, char* smem, int bid, int nb) {
  float* sc = (float*)smem;
  float* red = sc + 4096;
  const int tid = opq_tid(), lane = tid & 63, w = __builtin_amdgcn_readfirstlane(tid >> 6);
  __syncthreads();
  for (int i = tid; i < 4096; i += 256) {
    float v = p.c[i];
    sc[i] = v / (1.f + expf(-v));
  }
  __syncthreads();
  for (int it = bid; it < 4 * 96; it += nb) {
    const int l = it / 96, e0 = (it - l * 96) * 64;
    const float* wp = p.ada_w + ((size_t)l * 1024 + w * 256) * 6144 + e0 + lane;
    float a0 = 0, a1 = 0, a2 = 0, a3 = 0;
#pragma unroll 8
    for (int d = 0; d < 256; d++) {
      float wv = wp[(size_t)d * 6144];
      int dd = w * 256 + d;
      a0 += sc[dd] * wv;
      a1 += sc[1024 + dd] * wv;
      a2 += sc[2048 + dd] * wv;
      a3 += sc[3072 + dd] * wv;
    }
    red[(w * 4 + 0) * 64 + lane] = a0;
    red[(w * 4 + 1) * 64 + lane] = a1;
    red[(w * 4 + 2) * 64 + lane] = a2;
    red[(w * 4 + 3) * 64 + lane] = a3;
    __syncthreads();
    {
      const int b = w;
      float s = red[(0 * 4 + b) * 64 + lane] + red[(1 * 4 + b) * 64 + lane] + red[(2 * 4 + b) * 64 + lane] +
                red[(3 * 4 + b) * 64 + lane] + p.ada_b[l * 6144 + e0 + lane];
      mod[((size_t)l * 4 + b) * 6144 + e0 + lane] = s;
    }
    __syncthreads();
  }
}

DI void h0_phase(const float* __restrict__ x, const float* __restrict__ mod0, u16* __restrict__ h, int bid, int nb) {
  const size_t n8 = (size_t)T * 1024 / 8;
  for (size_t i = (size_t)bid * 256 + opq_tid(); i < n8; i += (size_t)nb * 256) {
    const size_t e = i * 8;
    const int t = (int)(e >> 10), d = (int)(e & 1023), b = t >> 13;
    const float* m = mod0 + (size_t)b * 6144;
    f32x4 v0 = *(const f32x4*)(x + e), v1 = *(const f32x4*)(x + e + 4);
    f32x4 sh0 = *(const f32x4*)(m + d), sh1 = *(const f32x4*)(m + d + 4);
    f32x4 sc0 = *(const f32x4*)(m + 1024 + d), sc1 = *(const f32x4*)(m + 1024 + d + 4);
    v0 = v0 * (1.f + sc0) + sh0;
    v1 = v1 * (1.f + sc1) + sh1;
    u32x4 o;
    o[0] = pk2(v0[0], v0[1]);
    o[1] = pk2(v0[2], v0[3]);
    o[2] = pk2(v1[0], v1[1]);
    o[3] = pk2(v1[2], v1[3]);
    *(u32x4*)(h + e) = o;
  }
}

DI void ln_phase(float* z, const float* __restrict__ g, const float* __restrict__ bt, const float* modn, int sh_off,
                 u16* __restrict__ h, int bid, int nb) {
  const int tid = opq_tid(), lane = tid & 63, w = __builtin_amdgcn_readfirstlane(tid >> 6);
  for (int row = bid * 4 + w; row < T; row += nb * 4) {
    f32x4* zp = (f32x4*)(z + (size_t)row * 1024);
    f32x4 v[4];
#pragma unroll
    for (int c = 0; c < 4; c++) v[c] = zp[c * 64 + lane];
    float s = 0;
#pragma unroll
    for (int c = 0; c < 4; c++) s += v[c][0] + v[c][1] + v[c][2] + v[c][3];
    const float mu = wave_sum(s) * (1.f / 1024.f);
    float q = 0;
#pragma unroll
    for (int c = 0; c < 4; c++) {
      v[c] = v[c] - mu;
      q += v[c][0] * v[c][0] + v[c][1] * v[c][1] + v[c][2] * v[c][2] + v[c][3] * v[c][3];
    }
    const float rstd = rsqrtf(wave_sum(q) * (1.f / 1024.f) + LN_EPS);
    const int b = row >> 13;
#pragma unroll
    for (int c = 0; c < 4; c++) {
      const int d = c * 256 + lane * 4;
      f32x4 y = v[c] * rstd * *(const f32x4*)(g + d) + *(const f32x4*)(bt + d);
      zp[c * 64 + lane] = y;
      if (modn) {
        const float* m = modn + (size_t)b * 6144 + sh_off;
        f32x4 hv = y * (1.f + *(const f32x4*)(m + 1024 + d)) + *(const f32x4*)(m + d);
        u32x2 o;
        o[0] = pk2(hv[0], hv[1]);
        o[1] = pk2(hv[2], hv[3]);
        *(u32x2*)(h + (size_t)row * 1024 + d) = o;
      }
    }
  }
}

enum { EPI_AIN = 0, EPI_BIN = 1, EPI_RES = 2, EPI_SQRELU = 3 };
struct EpiArgs {
  u16 *o0, *o1, *o2;
  float *f0, *f1;
  const float* xin;
  const float* g;
};

template <int EPI>
DI void gemm_phase(const u16* __restrict__ A, const u16* __restrict__ Bt, int M, int N, int K, const EpiArgs& ea,
                   char* smem, int bid, int nb) {
  constexpr int MI = 4, BM = 64 * MI;
  u16* As = (u16*)smem;
  u16* Bs = As + BM * 72;
  const int tid = opq_tid(), lane = tid & 63, w = __builtin_amdgcn_readfirstlane(tid >> 6), wm = w >> 1, wn = w & 1, l31 = lane & 31, lh = lane >> 5;
  const int ntn = N / 128, ntm = M / BM, nt = ntn * ntm, nk = K / 64;
  const int lr = tid >> 3, lc = (tid & 7) * 8;
  const int xcd = bid & 7, nbx = nb >> 3, cntx = (ntm >> 3) * ntn;
  (void)nt;
  for (int sq = bid >> 3; sq < cntx; sq += nbx) {
    const int tmx = sq / ntn, tn = sq - tmx * ntn;
    const int tm = tmx * 8 + xcd;
    const int m0 = tm * BM, n0 = tn * 128;
    f32x16 acc[MI][2];
#pragma unroll
    for (int i = 0; i < MI; i++)
#pragma unroll
      for (int j = 0; j < 2; j++)
#pragma unroll
        for (int r = 0; r < 16; r++) acc[i][j][r] = 0.f;
    u32x4 ra[2 * MI], rb[4];
    const u16* ap = A + (size_t)(m0 + lr) * K + lc;
    const u16* bp = Bt + (size_t)(n0 + lr) * K + lc;
#pragma unroll
    for (int i = 0; i < 2 * MI; i++) ra[i] = *(const u32x4*)(ap + (size_t)i * 32 * K);
#pragma unroll
    for (int i = 0; i < 4; i++) rb[i] = *(const u32x4*)(bp + (size_t)i * 32 * K);
    __syncthreads();
#pragma unroll
    for (int i = 0; i < 2 * MI; i++) *(u32x4*)&As[(lr + 32 * i) * 72 + lc] = ra[i];
#pragma unroll
    for (int i = 0; i < 4; i++) *(u32x4*)&Bs[(lr + 32 * i) * 72 + lc] = rb[i];
    __syncthreads();
    for (int kt = 0; kt < nk; kt++) {
      if (kt + 1 < nk) {
#pragma unroll
        for (int i = 0; i < 2 * MI; i++) ra[i] = *(const u32x4*)(ap + (size_t)i * 32 * K + (kt + 1) * 64);
#pragma unroll
        for (int i = 0; i < 4; i++) rb[i] = *(const u32x4*)(bp + (size_t)i * 32 * K + (kt + 1) * 64);
      }
#pragma unroll
      for (int ks = 0; ks < 4; ks++) {
        bf16x8 af[MI], b0, b1;
#pragma unroll
        for (int i = 0; i < MI; i++) af[i] = *(const bf16x8*)&As[(wm * 32 * MI + 32 * i + l31) * 72 + ks * 16 + lh * 8];
        b0 = *(const bf16x8*)&Bs[(wn * 64 + l31) * 72 + ks * 16 + lh * 8];
        b1 = *(const bf16x8*)&Bs[(wn * 64 + 32 + l31) * 72 + ks * 16 + lh * 8];
#pragma unroll
        for (int i = 0; i < MI; i++) {
          acc[i][0] = mfma32(b0, af[i], acc[i][0]);
          acc[i][1] = mfma32(b1, af[i], acc[i][1]);
        }
      }
      __syncthreads();
      if (kt + 1 < nk) {
#pragma unroll
        for (int i = 0; i < 2 * MI; i++) *(u32x4*)&As[(lr + 32 * i) * 72 + lc] = ra[i];
#pragma unroll
        for (int i = 0; i < 4; i++) *(u32x4*)&Bs[(lr + 32 * i) * 72 + lc] = rb[i];
        __syncthreads();
      }
    }
    const int bidx = m0 >> 13;
#pragma unroll
    for (int i = 0; i < MI; i++) {
      const int row = m0 + wm * 32 * MI + 32 * i + l31;
#pragma unroll
      for (int j = 0; j < 2; j++) {
#pragma unroll
        for (int r4 = 0; r4 < 4; r4++) {
          const int col = n0 + wn * 64 + 32 * j + 8 * r4 + 4 * lh;
          float v[4];
#pragma unroll
          for (int q = 0; q < 4; q++) v[q] = acc[i][j][4 * r4 + q];
          if (EPI == EPI_AIN) {
            if (col < 1024) {
              u32x2 o;
              o[0] = pk2(v[0], v[1]);
              o[1] = pk2(v[2], v[3]);
              *(u32x2*)(ea.o0 + (size_t)row * 1024 + col) = o;
            } else if (col < 1280) {
              *(f32x4*)(ea.f0 + (size_t)row * 256 + (col - 1024)) = (f32x4){v[0], v[1], v[2], v[3]};
            } else if (col < 1792) {
              u32x2 o;
              o[0] = pk2(v[0], v[1]);
              o[1] = pk2(v[2], v[3]);
              *(u32x2*)(ea.o1 + (size_t)row * 512 + (col - 1280)) = o;
            } else if (col < 1856) {
              const int d = col - 1792;
              const int sidx = row & 8191;
              const size_t off = (size_t)(row >> 13) * S * 64 +
                                 ((size_t)((sidx >> 5) * 4 + (d >> 4)) * 64 + 32 * ((d >> 3) & 1) + (sidx & 31)) * 8 + (d & 7);
              u32x2 o;
              o[0] = pk2(v[0], v[1]);
              o[1] = pk2(v[2], v[3]);
              *(u32x2*)(ea.o2 + off) = o;
            } else if (col < 1864) {
              const float sc = 0.044194173824159216f;
              *(f32x4*)(ea.f1 + (size_t)row * 8 + (col - 1856)) = (f32x4){v[0] * sc, v[1] * sc, v[2] * sc, v[3] * sc};
            }
          } else if (EPI == EPI_BIN) {
            if (col < 1024) {
              const float sc = 0.125f * LOG2E;
              u32x2 o;
              o[0] = pk2(v[0] * sc, v[1] * sc);
              o[1] = pk2(v[2] * sc, v[3] * sc);
              *(u32x2*)(ea.o0 + (size_t)row * 1024 + col) = o;
            } else if (col < 2048) {
              u32x2 o;
              o[0] = pk2(v[0], v[1]);
              o[1] = pk2(v[2], v[3]);
              *(u32x2*)(ea.o1 + (size_t)row * 1024 + (col - 1024)) = o;
            } else {
              const int cv = col - 2048;
#pragma unroll
              for (int q = 0; q < 4; q++) ea.o2[((size_t)bidx * 1024 + cv + q) * 8192 + (row & 8191)] = f2bf(v[q]);
            }
          } else if (EPI == EPI_RES) {
            const f32x4 gg = *(const f32x4*)(ea.g + (size_t)bidx * 6144 + col);
            const size_t o = (size_t)row * 1024 + col;
            const f32x4 xv = *(const f32x4*)(ea.xin + o);
            f32x4 r;
#pragma unroll
            for (int q = 0; q < 4; q++) r[q] = DN_ALPHA * xv[q] + (1.f + gg[q]) * v[q];
            *(f32x4*)(ea.f0 + o) = r;
          } else {
            float r[4];
#pragma unroll
            for (int q = 0; q < 4; q++) {
              r[q] = v[q] > 0.f ? v[q] : 0.f;
              r[q] = r[q] * r[q];
            }
            u32x2 o;
            o[0] = pk2(r[0], r[1]);
            o[1] = pk2(r[2], r[3]);
            *(u32x2*)(ea.o0 + (size_t)row * 4096 + col) = o;
          }
        }
      }
    }
  }
}

DI void ckvnorm_phase(const float* __restrict__ raw, const float* __restrict__ g, u16* __restrict__ outp, int bid,
                      int nb) {
  const int tid = opq_tid(), lane = tid & 63, w = __builtin_amdgcn_readfirstlane(tid >> 6);
  const f32x4 gg = *(const f32x4*)(g + lane * 4);
  for (int row = bid * 4 + w; row < T; row += nb * 4) {
    f32x4 v = *(const f32x4*)(raw + (size_t)row * 256 + lane * 4);
    float ss = v[0] * v[0] + v[1] * v[1] + v[2] * v[2] + v[3] * v[3];
    ss = wave_sum(ss);
    const float r = rsqrtf(ss * (1.f / 256.f) + LN_EPS);
    u32x2 o;
    o[0] = pk2(v[0] * r * gg[0], v[1] * r * gg[1]);
    o[1] = pk2(v[2] * r * gg[2], v[3] * r * gg[3]);
    *(u32x2*)(outp + (size_t)row * 256 + lane * 4) = o;
  }
}

DI unsigned mono_key(float s) {
  unsigned u = __float_as_uint(s);
  return (u & 0x80000000u) ? ~u : (u | 0x80000000u);
}
DI float mono_inv(unsigned k) {
  unsigned u = (k & 0x80000000u) ? (k & 0x7fffffffu) : ~k;
  return __uint_as_float(u);
}
DI float relu_i(float x) {
  int i = __float_as_int(x);
  return __int_as_float(i > 0 ? i : 0);
}
DI int wcount(bool f) { return __popcll(__ballot(f)); }

template <bool EXACT>
DI void compact4(float* vals, u16* idxs, int* cnt, int lane, float* thr_out) {
  constexpr int NPL = CAP / 64;
  unsigned key[4][NPL];
  int n[4];
#pragma unroll
  for (int q = 0; q < 4; q++) n[q] = cnt[q];
#pragma unroll
  for (int q = 0; q < 4; q++)
#pragma unroll
    for (int j = 0; j < NPL; j++) {
      const int e = j * 64 + lane;
      key[q][j] = (e < n[q]) ? mono_key(vals[q * CAP + e]) : 0u;
    }
  unsigned Tk[4] = {0u, 0u, 0u, 0u};
  constexpr int LOWBIT = EXACT ? 0 : 18;
#pragma unroll 1
  for (int bit = 31; bit >= LOWBIT; bit--) {
#pragma unroll
    for (int q = 0; q < 4; q++) {
      const unsigned cand = Tk[q] | (1u << bit);
      int c = 0;
#pragma unroll
      for (int j = 0; j < NPL; j++) c += wcount(key[q][j] >= cand);
      Tk[q] = (c >= TOPK) ? cand : Tk[q];
    }
  }
  unsigned I[4] = {0xffffu, 0xffffu, 0xffffu, 0xffffu};
  if (EXACT) {
    unsigned ix[4][NPL];
    int need[4];
#pragma unroll
    for (int q = 0; q < 4; q++) {
      int cgt = 0;
#pragma unroll
      for (int j = 0; j < NPL; j++) {
        const int e = j * 64 + lane;
        ix[q][j] = (e < n[q]) ? (unsigned)idxs[q * CAP + e] : 0xffffu;
        cgt += wcount(key[q][j] > Tk[q]);
      }
      need[q] = TOPK - cgt;
      I[q] = 0u;
    }
#pragma unroll 1
    for (int bit = 13; bit >= 0; bit--) {
#pragma unroll
      for (int q = 0; q < 4; q++) {
        const unsigned cand = I[q] | (1u << bit);
        int c = 0;
#pragma unroll
        for (int j = 0; j < NPL; j++) c += wcount(key[q][j] == Tk[q] && ix[q][j] < cand);
        I[q] = (c < need[q]) ? cand : I[q];
      }
    }
  }
  const unsigned long long lt = (1ull << lane) - 1ull;
#pragma unroll
  for (int q = 0; q < 4; q++) {
    if (n[q] > TOPK) {
      int base = 0;
#pragma unroll
      for (int j = 0; j < NPL; j++) {
        const int e = j * 64 + lane;
        const bool in = e < n[q];
        const float v = in ? vals[q * CAP + e] : 0.f;
        const unsigned ixv = in ? (unsigned)idxs[q * CAP + e] : 0xffffu;
        const bool keep = (key[q][j] > Tk[q]) || (key[q][j] == Tk[q] && ixv <= I[q]);
        const unsigned long long m = __ballot(keep);
        if (keep) {
          const int pos = base + __popcll(m & lt);
          vals[q * CAP + pos] = v;
          idxs[q * CAP + pos] = (u16)ixv;
        }
        base += __popcll(m);
      }
      if (lane == 0) cnt[q] = base;
      thr_out[q] = mono_inv(Tk[q]);
    }
  }
}

DI void indexer_phase(const u16* __restrict__ iq, const u16* __restrict__ ik, const float* __restrict__ iw,
                      u16* __restrict__ sel, char* smem, int bid, int nb) {
  constexpr int WBYTES = 4 * CAP * 4 + 4 * CAP * 2 + 64;
  const int tid = opq_tid(), lane = tid & 63, w = __builtin_amdgcn_readfirstlane(tid >> 6), l31 = lane & 31, u = lane >> 5;
  float* vals = (float*)(smem + w * WBYTES);
  u16* idxs = (u16*)(smem + w * WBYTES + 4 * CAP * 4);
  int* cnt = (int*)(smem + w * WBYTES + 4 * CAP * 4 + 4 * CAP * 2);
  const int nitems = NBATCH * (S / 16);
  const int nrounds = (nitems + nb - 1) / nb;
  __syncthreads();
  for (int rd = 0; rd < nrounds; rd++) {
    const int it = rd * nb + ((rd & 1) ? (nb - 1 - bid) : bid);
    if (it >= nitems) continue;
    const int b = it & 3, qg = (S / 16 - 1) - (it >> 2);
    const int t0 = qg * 16;
    const int tw = t0 + 4 * w;
    const size_t tb = (size_t)b * S;
    bf16x8 aq[4];
    {
      const int g = l31 >> 3, up = (l31 >> 2) & 1, j = l31 & 3;
      const int ql = 2 * up + (g >> 1), hd = 4 * (g & 1) + j;
      const u16* qp = iq + (tb + tw + ql) * 512 + hd * 64 + u * 8;
#pragma unroll
      for (int ks = 0; ks < 4; ks++) aq[ks] = *(const bf16x8*)(qp + ks * 16);
    }
    float wq[2][8];
#pragma unroll
    for (int qq = 0; qq < 2; qq++) {
      const float* wp = iw + (tb + tw + 2 * u + qq) * 8;
      f32x4 w0 = *(const f32x4*)wp, w1 = *(const f32x4*)(wp + 4);
#pragma unroll
      for (int h = 0; h < 4; h++) {
        wq[qq][h] = w0[h];
        wq[qq][4 + h] = w1[h];
      }
    }
    float thr[2] = {-INFINITY, -INFINITY};
    __builtin_amdgcn_wave_barrier();
    if (lane < 4) cnt[lane] = 0;
    __builtin_amdgcn_wave_barrier();
    const int nkb = (tw + 3) / 32 + 1;
    const u16* kp = ik + tb * 64 + lane * 8;
    bf16x8 ring[4][4];
#pragma unroll
    for (int i = 0; i < 4; i++) {
      const int kbn = (i < nkb) ? i : nkb - 1;
#pragma unroll
      for (int ks = 0; ks < 4; ks++) ring[i][ks] = *(const bf16x8*)(kp + (size_t)(kbn * 4 + ks) * 512);
    }
#pragma unroll 1
    for (int kb0 = 0; kb0 < nkb; kb0 += 4) {
#pragma unroll
      for (int i = 0; i < 4; i++) {
        const int kb = kb0 + i;
        {
          f32x16 acc;
#pragma unroll
          for (int r = 0; r < 16; r++) acc[r] = 0.f;
#pragma unroll
          for (int ks = 0; ks < 4; ks++) acc = mfma32(aq[ks], ring[i][ks], acc);
          {
            const int kbn = (kb + 4 < nkb) ? kb + 4 : nkb - 1;
#pragma unroll
            for (int ks = 0; ks < 4; ks++) ring[i][ks] = *(const bf16x8*)(kp + (size_t)(kbn * 4 + ks) * 512);
          }
          const int key = kb * 32 + l31;
#pragma unroll
          for (int qq = 0; qq < 2; qq++) {
            float s0 = 0.f, s1 = 0.f;
#pragma unroll
            for (int h = 0; h < 8; h += 2) {
              s0 = fmaf(wq[qq][h], relu_i(acc[8 * qq + h]), s0);
              s1 = fmaf(wq[qq][h + 1], relu_i(acc[8 * qq + h + 1]), s1);
            }
            float s = s0 + s1;
            s += 0.0f;
            const int tq = tw + 2 * u + qq;
            if (key <= tq && s >= thr[qq]) {
              const int qs = 2 * u + qq;
              const int pos = atomicAdd(&cnt[qs], 1);
              vals[qs * CAP + pos] = s;
              idxs[qs * CAP + pos] = (u16)key;
            }
          }
        }
      }
      __builtin_amdgcn_wave_barrier();
      const int c0 = cnt[0], c1 = cnt[1], c2 = cnt[2], c3 = cnt[3];
      if (c0 > CAP - 128 || c1 > CAP - 128 || c2 > CAP - 128 || c3 > CAP - 128) {
        float to[4] = {0.f, 0.f, 0.f, 0.f};
        compact4<false>(vals, idxs, cnt, lane, to);
        __builtin_amdgcn_wave_barrier();
        const int d0 = cnt[0], d1 = cnt[1], d2 = cnt[2], d3 = cnt[3];
        if (d0 > CAP - 256 || d1 > CAP - 256 || d2 > CAP - 256 || d3 > CAP - 256) {
          compact4<true>(vals, idxs, cnt, lane, to);
          __builtin_amdgcn_wave_barrier();
        }
        if (c0 > TOPK && u == 0) thr[0] = to[0];
        if (c1 > TOPK && u == 0) thr[1] = to[1];
        if (c2 > TOPK && u == 1) thr[0] = to[2];
        if (c3 > TOPK && u == 1) thr[1] = to[3];
      }
    }
    {
      const int c0 = cnt[0], c1 = cnt[1], c2 = cnt[2], c3 = cnt[3];
      if (c0 > TOPK || c1 > TOPK || c2 > TOPK || c3 > TOPK) {
        float to[4];
        compact4<true>(vals, idxs, cnt, lane, to);
        __builtin_amdgcn_wave_barrier();
      }
    }
#pragma unroll 1
    for (int qs = 0; qs < 4; qs++) {
      const int n = cnt[qs];
      u16* sp = sel + (tb + tw + qs) * 256;
#pragma unroll
      for (int j = 0; j < 4; j++) {
        const int e = j * 64 + lane;
        sp[e] = (e < n) ? idxs[qs * CAP + e] : (u16)0xffffu;
      }
    }
  }
}

DI void sparse_phase(const u16* __restrict__ q, const u16* __restrict__ ckvn, const u16* __restrict__ sel,
                     const u16* __restrict__ wuk, const u16* __restrict__ wuv, const float* __restrict__ rel_bias,
                     u16* scratch, u16* __restrict__ o, char* smem, int bid, int nb) {
  constexpr int GS = 264;
  const int tid = opq_tid(), lane = tid & 63, w = __builtin_amdgcn_readfirstlane(tid >> 6), l15 = lane & 15, g = lane >> 4;
  u16* G = (u16*)smem + (size_t)w * 32 * GS;
  int* lut = (int*)(smem + 4 * 32 * GS * 2);
  float* rb = (float*)(lut + 128);
  __syncthreads();
  if (tid < 128) lut[tid] = rel_bucket(tid);
  for (int i = tid; i < 512; i += 256) rb[i] = rel_bias[i] * LOG2E;
  __syncthreads();
  u16* ql = scratch + (size_t)bid * (16 * 16 * 256);
  const int nitems = NBATCH * (S / 16);
  for (int it = bid; it < nitems; it += nb) {
    const int b = it & 3, qg = it >> 2;
    const int t0 = qg * 16;
    const size_t tb = (size_t)b * S;
    for (int hh = 0; hh < 4; hh++) {
      const int h = 4 * w + hh;
      bf16x8 bq[2];
#pragma unroll
      for (int ks = 0; ks < 2; ks++) bq[ks] = *(const bf16x8*)(q + (tb + t0 + l15) * 1024 + h * 64 + ks * 32 + g * 8);
#pragma unroll 4
      for (int rt = 0; rt < 16; rt++) {
        f32x4 acc = {0.f, 0.f, 0.f, 0.f};
#pragma unroll
        for (int ks = 0; ks < 2; ks++) {
          bf16x8 a = *(const bf16x8*)(wuk + ((size_t)h * 256 + rt * 16 + l15) * 64 + ks * 32 + g * 8);
          acc = mfma16(a, bq[ks], acc);
        }
        u32x2 ov;
        ov[0] = pk2(acc[0] * (0.125f * LOG2E), acc[1] * (0.125f * LOG2E));
        ov[1] = pk2(acc[2] * (0.125f * LOG2E), acc[3] * (0.125f * LOG2E));
        *(u32x2*)(ql + ((size_t)l15 * 16 + h) * 256 + rt * 16 + 4 * g) = ov;
      }
    }
    __syncthreads();
#pragma unroll 1
    for (int qi = 0; qi < 4; qi++) {
      const int qloc = 4 * w + qi;
      const int t = t0 + qloc;
      const u16* sp = sel + (tb + t) * 256;
      bf16x8 qb[8];
#pragma unroll
      for (int ks = 0; ks < 8; ks++) qb[ks] = *(const bf16x8*)(ql + ((size_t)qloc * 16 + l15) * 256 + ks * 32 + g * 8);
      float m_run = NEGF, l_run = 0.f;
      f32x4 O[16];
#pragma unroll
      for (int rt = 0; rt < 16; rt++) O[rt] = (f32x4){0.f, 0.f, 0.f, 0.f};
#pragma unroll 1
      for (int ch = 0; ch < 8; ch++) {
        __syncthreads();
#pragma unroll
        for (int hf = 0; hf < 2; hf++) {
          u32x4 gr[8];
#pragma unroll
          for (int i = 0; i < 8; i++) {
            const int pidx = lane + 64 * (i + 8 * hf);
            const int kk = pidx >> 5, c16 = pidx & 31;
            int idx = sp[ch * 32 + kk];
            if (idx == 0xffff) idx = 0;
            gr[i] = *(const u32x4*)(ckvn + (tb + idx) * 256 + c16 * 8);
          }
#pragma unroll
          for (int i = 0; i < 8; i++) {
            const int pidx = lane + 64 * (i + 8 * hf);
            const int kk = pidx >> 5, c16 = pidx & 31;
            *(u32x4*)&G[kk * GS + c16 * 8] = gr[i];
          }
        }
        __syncthreads();
        float lg[2][4];
#pragma unroll
        for (int kbk = 0; kbk < 2; kbk++) {
          f32x4 acc = {0.f, 0.f, 0.f, 0.f};
#pragma unroll
          for (int ks = 0; ks < 8; ks++) {
            bf16x8 a = *(const bf16x8*)&G[(16 * kbk + l15) * GS + ks * 32 + g * 8];
            acc = mfma16(a, qb[ks], acc);
          }
          const s16x4 kid4 = *(const s16x4*)(sp + ch * 32 + 16 * kbk + 4 * g);
#pragma unroll
          for (int i = 0; i < 4; i++) {
            const int kid = (int)(u16)kid4[i];
            float v = NEGF;
            if (kid != 0xffff) {
              int n = t - kid;
              n = n < 0 ? 0 : n;
              const int bk = n < 128 ? lut[n] : 31;
              v = acc[i] + rb[bk * 16 + l15];
            }
            lg[kbk][i] = v;
          }
        }
        float mx = fmaxf(fmaxf(fmaxf(lg[0][0], lg[0][1]), fmaxf(lg[0][2], lg[0][3])),
                         fmaxf(fmaxf(lg[1][0], lg[1][1]), fmaxf(lg[1][2], lg[1][3])));
        mx = fmaxf(mx, __shfl_xor(mx, 16));
        mx = fmaxf(mx, __shfl_xor(mx, 32));
        const float m_new = fmaxf(m_run, mx);
        const float scl = __builtin_amdgcn_exp2f(m_run - m_new);
        m_run = m_new;
        float ps = 0.f;
        float pe[8];
#pragma unroll
        for (int kbk = 0; kbk < 2; kbk++)
#pragma unroll
          for (int i = 0; i < 4; i++) {
            const float pv = __builtin_amdgcn_exp2f(lg[kbk][i] - m_new);
            pe[kbk * 4 + i] = pv;
            ps += pv;
          }
        l_run = l_run * scl + ps;
        u32x4 pw;
        pw[0] = pk2(pe[0], pe[1]);
        pw[1] = pk2(pe[2], pe[3]);
        pw[2] = pk2(pe[4], pe[5]);
        pw[3] = pk2(pe[6], pe[7]);
        const bf16x8 pB = __builtin_bit_cast(bf16x8, pw);
#pragma unroll
        for (int rt = 0; rt < 16; rt++) O[rt] = O[rt] * scl;
        const int q4 = l15 >> 2, p4 = l15 & 3;
#pragma unroll
        for (int rt = 0; rt < 16; rt++) {
          const s16x4 lo = __builtin_amdgcn_ds_read_tr16_b64_v4i16((lds_s16x4_ptr)(&G[(4 * g + q4) * GS + rt * 16 + 4 * p4]));
          const s16x4 hi = __builtin_amdgcn_ds_read_tr16_b64_v4i16((lds_s16x4_ptr)(&G[(16 + 4 * g + q4) * GS + rt * 16 + 4 * p4]));
          const bf16x8 a = (bf16x8){lo[0], lo[1], lo[2], lo[3], hi[0], hi[1], hi[2], hi[3]};
          O[rt] = mfma16(a, pB, O[rt]);
        }
      }
      float lt = l_run;
      lt += __shfl_xor(lt, 16);
      lt += __shfl_xor(lt, 32);
      const float inv = 1.f / lt;
#pragma unroll
      for (int rt = 0; rt < 16; rt++) {
        u32x2 ov;
        ov[0] = pk2(O[rt][0] * inv, O[rt][1] * inv);
        ov[1] = pk2(O[rt][2] * inv, O[rt][3] * inv);
        *(u32x2*)(ql + ((size_t)qloc * 16 + l15) * 256 + rt * 16 + 4 * g) = ov;
      }
    }
    __syncthreads();
    for (int hh = 0; hh < 4; hh++) {
      const int h = 4 * w + hh;
      bf16x8 bo[8];
#pragma unroll
      for (int ks = 0; ks < 8; ks++) bo[ks] = *(const bf16x8*)(ql + ((size_t)l15 * 16 + h) * 256 + ks * 32 + g * 8);
#pragma unroll
      for (int et = 0; et < 4; et++) {
        f32x4 acc = {0.f, 0.f, 0.f, 0.f};
#pragma unroll
        for (int ks = 0; ks < 8; ks++) {
          bf16x8 a = *(const bf16x8*)(wuv + ((size_t)h * 64 + et * 16 + l15) * 256 + ks * 32 + g * 8);
          acc = mfma16(a, bo[ks], acc);
        }
        u32x2 ov;
        ov[0] = pk2(acc[0], acc[1]);
        ov[1] = pk2(acc[2], acc[3]);
        *(u32x2*)(o + (tb + t0 + l15) * 1024 + h * 64 + et * 16 + 4 * g) = ov;
      }
    }
    __syncthreads();
  }
}

DI void diffattn_phase(const u16* __restrict__ q, const u16* __restrict__ k, const u16* __restrict__ vT,
                       u16* __restrict__ o, const float* __restrict__ rel_bias, const float* __restrict__ lam,
                       const float* __restrict__ subln, int layer_idx, char* smem, int bid, int nb) {
  constexpr int KS = 136, VS = 72;
  u16* Ks = (u16*)smem;
  u16* Vs = Ks + 64 * KS;
  float* exch = (float*)smem;
  float* btab = (float*)(smem + 36 * 1024);
  int* lut = (int*)(smem + 36 * 1024 + 1040);
  float* misc = (float*)(smem + 36 * 1024 + 1040 + 512);
  const int tid = opq_tid(), lane = tid & 63, w = __builtin_amdgcn_readfirstlane(tid >> 6), l31 = lane & 31, lh = lane >> 5;
  const int qsub = w >> 1, m = w & 1;
  const float lam_init = 0.8f - 0.6f * expf(-0.3f * (float)layer_idx);
  __syncthreads();
  if (tid < 128) lut[tid] = rel_bucket(tid);
  if (w == 0) {
    float p1 = lam[lane] * lam[64 + lane], p2 = lam[128 + lane] * lam[192 + lane];
    p1 = wave_sum(p1);
    p2 = wave_sum(p2);
    if (lane == 0) misc[0] = expf(p1) - expf(p2) + lam_init;
  }
  __syncthreads();
  const float lam_full = misc[0];
  const int nitems = NBATCH * 8 * (S / 64);
  const int nrounds = (nitems + nb - 1) / nb;
  const int prow = pi_row(l31);
  for (int rd = 0; rd < nrounds; rd++) {
    const int it = rd * nb + ((rd & 1) ? (nb - 1 - bid) : bid);
    if (it >= nitems) continue;
    const int bh = it & 31, qb = (S / 64 - 1) - (it >> 5);
    const int b = bh >> 3, h = bh & 7;
    const int q0 = qb * 64, tq0 = q0 + 32 * qsub, t = tq0 + l31;
    const size_t tb = (size_t)b * S;
    __syncthreads();
    for (int i = tid; i < 258; i += 256) {
      const int n = i >> 1, mm = i & 1;
      const int bk = n < 128 ? lut[n] : 31;
      btab[i] = rel_bias[bk * 16 + 2 * h + mm] * LOG2E;
    }
    bf16x8 qf[4];
#pragma unroll
    for (int ks = 0; ks < 4; ks++) qf[ks] = *(const bf16x8*)(q + (tb + t) * 1024 + h * 128 + m * 64 + ks * 16 + lh * 8);
    f32x16 O[4];
#pragma unroll
    for (int et = 0; et < 4; et++)
#pragma unroll
      for (int r = 0; r < 16; r++) O[et][r] = 0.f;
    float m_run = NEGF, l_run = 0.f;
    const int nkt = qb + 1;
    u32x4 rk[4], rv[4];
    const u16* kp = k + tb * 1024 + h * 128;
    const u16* vp = vT + ((size_t)(b * 8 + h) * 128) * 8192;
#pragma unroll
    for (int i = 0; i < 4; i++) {
      const int id = tid + 256 * i;
      rk[i] = *(const u32x4*)(kp + (size_t)(id >> 4) * 1024 + (id & 15) * 8);
      rv[i] = *(const u32x4*)(vp + (size_t)(id >> 3) * 8192 + (id & 7) * 8);
    }
#pragma unroll
    for (int i = 0; i < 4; i++) {
      const int id = tid + 256 * i;
      *(u32x4*)&Ks[(id >> 4) * KS + (id & 15) * 8] = rk[i];
      *(u32x4*)&Vs[(id >> 3) * VS + (id & 7) * 8] = rv[i];
    }
    __syncthreads();
    const float cfar = btab[256 + m];
    for (int kt = 0; kt < nkt; kt++) {
      if (kt + 1 < nkt) {
#pragma unroll
        for (int i = 0; i < 4; i++) {
          const int id = tid + 256 * i;
          rk[i] = *(const u32x4*)(kp + (size_t)((kt + 1) * 64 + (id >> 4)) * 1024 + (id & 15) * 8);
          rv[i] = *(const u32x4*)(vp + (size_t)(id >> 3) * 8192 + (kt + 1) * 64 + (id & 7) * 8);
        }
      }
      const int s_tile = kt * 64;
      const int nblk = (s_tile + 32 <= tq0 + 31) ? 2 : 1;
#pragma unroll 1
      for (int kb = 0; kb < nblk; kb++) {
        f32x16 acc;
#pragma unroll
        for (int r = 0; r < 16; r++) acc[r] = 0.f;
#pragma unroll
        for (int ks = 0; ks < 4; ks++) {
          bf16x8 a = *(const bf16x8*)&Ks[(32 * kb + prow) * KS + m * 64 + ks * 16 + lh * 8];
          acc = mfma32(a, qf[ks], acc);
        }
        const int s0 = s_tile + 32 * kb;
        const bool nearb = (tq0 - (s0 + 31)) < 128;
        if (nearb) {
#pragma unroll
          for (int r = 0; r < 16; r++) {
            const int key = s0 + 16 * (r >> 3) + 8 * lh + (r & 7);
            const int n = t - key;
            const int nc = n < 0 ? 0 : (n > 128 ? 128 : n);
            const float bv = btab[nc * 2 + m];
            acc[r] = (n < 0) ? NEGF : acc[r] + bv;
          }
        } else {
#pragma unroll
          for (int r = 0; r < 16; r++) acc[r] += cfar;
        }
        float mx = acc[0];
#pragma unroll
        for (int r = 1; r < 16; r++) mx = fmaxf(mx, acc[r]);
        mx = fmaxf(mx, __shfl_xor(mx, 32));
        const float m_new = fmaxf(m_run, mx);
        const float scl = __builtin_amdgcn_exp2f(m_run - m_new);
        m_run = m_new;
        float ps = 0.f;
#pragma unroll
        for (int r = 0; r < 16; r++) {
          const float pv = __builtin_amdgcn_exp2f(acc[r] - m_new);
          acc[r] = pv;
          ps += pv;
        }
        l_run = l_run * scl + ps;
        if (__ballot(scl != 1.f)) {
#pragma unroll
          for (int et = 0; et < 4; et++)
#pragma unroll
            for (int r = 0; r < 16; r++) O[et][r] *= scl;
        }
#pragma unroll
        for (int s2 = 0; s2 < 2; s2++) {
          u32x4 pw;
          pw[0] = pk2(acc[8 * s2 + 0], acc[8 * s2 + 1]);
          pw[1] = pk2(acc[8 * s2 + 2], acc[8 * s2 + 3]);
          pw[2] = pk2(acc[8 * s2 + 4], acc[8 * s2 + 5]);
          pw[3] = pk2(acc[8 * s2 + 6], acc[8 * s2 + 7]);
          const bf16x8 pB = __builtin_bit_cast(bf16x8, pw);
#pragma unroll
          for (int et = 0; et < 4; et++) {
            bf16x8 a = *(const bf16x8*)&Vs[(32 * et + l31) * VS + 32 * kb + 16 * s2 + 8 * lh];
            O[et] = mfma32(a, pB, O[et]);
          }
        }
      }
      __syncthreads();
      if (kt + 1 < nkt) {
#pragma unroll
        for (int i = 0; i < 4; i++) {
          const int id = tid + 256 * i;
          *(u32x4*)&Ks[(id >> 4) * KS + (id & 15) * 8] = rk[i];
          *(u32x4*)&Vs[(id >> 3) * VS + (id & 7) * 8] = rv[i];
        }
        __syncthreads();
      }
    }
    float lt = l_run + __shfl_xor(l_run, 32);
    const float inv = 1.f / lt;
    if (m == 1) {
#pragma unroll
      for (int et = 0; et < 4; et++)
#pragma unroll
        for (int r = 0; r < 16; r++) {
          const int e = 32 * et + (r & 3) + 8 * (r >> 2) + 4 * lh;
          exch[(qsub * 128 + e) * 32 + l31] = O[et][r] * inv;
        }
    }
    __syncthreads();
    if (m == 0) {
      float ss = 0.f;
#pragma unroll
      for (int et = 0; et < 4; et++)
#pragma unroll
        for (int r = 0; r < 16; r++) {
          const int e = 32 * et + (r & 3) + 8 * (r >> 2) + 4 * lh;
          const float v = O[et][r] * inv - lam_full * exch[(qsub * 128 + e) * 32 + l31];
          O[et][r] = v;
          ss += v * v;
        }
      ss += __shfl_xor(ss, 32);
      const float rs = rsqrtf(ss * (1.f / 128.f) + LN_EPS);
      const float osc = 1.f - lam_init;
#pragma unroll
      for (int et = 0; et < 4; et++)
#pragma unroll
        for (int r4 = 0; r4 < 4; r4++) {
          const int e = 32 * et + 8 * r4 + 4 * lh;
          const f32x4 gv = *(const f32x4*)(subln + e);
          u32x2 ov;
          ov[0] = pk2(O[et][4 * r4 + 0] * rs * gv[0] * osc, O[et][4 * r4 + 1] * rs * gv[1] * osc);
          ov[1] = pk2(O[et][4 * r4 + 2] * rs * gv[2] * osc, O[et][4 * r4 + 3] * rs * gv[3] * osc);
          *(u32x2*)(o + (tb + t) * 1024 + h * 128 + e) = ov;
        }
    }
  }
}

DI void gbar(unsigned* bar, unsigned nb, unsigned& gen) {
  asm volatile("s_waitcnt vmcnt(0)" ::: "memory");
  __syncthreads();
  if (threadIdx.x == 0) {
    __builtin_amdgcn_fence(__ATOMIC_RELEASE, "agent");
    asm volatile("s_waitcnt vmcnt(0)" ::: "memory");
    const unsigned old = __hip_atomic_fetch_add(&bar[0], 1u, __ATOMIC_RELAXED, __HIP_MEMORY_SCOPE_AGENT);
    if (old + 1u == (gen + 1u) * nb) {
      __hip_atomic_fetch_add(&bar[64], 1u, __ATOMIC_RELAXED, __HIP_MEMORY_SCOPE_AGENT);
    } else {
      unsigned sp = 0;
      while (__hip_atomic_load(&bar[64], __ATOMIC_RELAXED, __HIP_MEMORY_SCOPE_AGENT) == gen) {
        __builtin_amdgcn_s_sleep(1);
        if (++sp > (1u << 24)) break;
      }
    }
    __builtin_amdgcn_fence(__ATOMIC_ACQUIRE, "agent");
    asm volatile("s_waitcnt vmcnt(0)" ::: "memory");
  }
  __syncthreads();
  gen++;
}

__global__ void __launch_bounds__(256, 2) hybrid_fwd(Params p) {
  __shared__ __attribute__((aligned(16))) char smem[LDS_BYTES];
  cg::grid_group grid = cg::this_grid();
  const int bid = blockIdx.x, nb = gridDim.x;
  char* ws = p.ws;
  u16* w_ain = (u16*)(ws + W_AIN);
  u16* w_uk = (u16*)(ws + W_UK);
  u16* w_uv = (u16*)(ws + W_UV);
  u16* w_ao = (u16*)(ws + W_AO);
  u16* w_bin = (u16*)(ws + W_BIN);
  u16* w_bo = (u16*)(ws + W_BO);
  u16* w_w1 = (u16*)(ws + W_W1);
  u16* w_w2 = (u16*)(ws + W_W2);
  float* mod = (float*)(ws + WS_MOD);
  u16* hbuf = (u16*)(ws + WS_H);
  char* big = ws + WS_BIG;
  u16* qbuf = (u16*)(big + B_Q);
  u16* iqbuf = (u16*)(big + B_IQ);
  u16* ikbuf = (u16*)(big + B_IK);
  float* iwbuf = (float*)(big + B_IW);
  float* ckvraw = (float*)(big + B_CKVRAW);
  u16* ckvn = (u16*)(big + B_CKVN);
  u16* selbuf = (u16*)(big + B_SEL);
  u16* kbuf = (u16*)(big + B_K);
  u16* vtbuf = (u16*)(big + B_VT);
  u16* obuf = (u16*)(big + B_O);
  u16* hid = (u16*)big;
  unsigned* bar = (unsigned*)(ws + WS_BAR);
  unsigned gen = 0;

  tconv_phase(p.a_w_in, w_ain, 2, 1024, 1864, A_INP, smem, bid, nb);
  tconv_phase(p.a_w_uk, w_uk, 32, 64, 256, 256, smem, bid, nb);
  tconv_phase(p.a_w_uv, w_uv, 32, 256, 64, 64, smem, bid, nb);
  tconv_phase(p.a_w_o, w_ao, 2, 1024, 1024, 1024, smem, bid, nb);
  tconv_phase(p.b_w_in, w_bin, 2, 1024, 3072, 3072, smem, bid, nb);
  tconv_phase(p.b_w_o, w_bo, 2, 1024, 1024, 1024, smem, bid, nb);
  tconv_phase(p.mlp_w1, w_w1, 4, 1024, 4096, 4096, smem, bid, nb);
  tconv_phase(p.mlp_w2, w_w2, 4, 4096, 1024, 1024, smem, bid, nb);
  mod_phase(p, mod, smem, bid, nb);
  grid.sync();
  h0_phase(p.x, mod, hbuf, bid, nb);
  gbar(bar, nb, gen);

#pragma unroll 1
  for (int sl = 0; sl < 8; sl++) {
    const int i = sl >> 1, j = i >> 1;
    const float* modi = mod + (size_t)i * 4 * 6144;
    const u16* Ares;
    const u16* Wres;
    int Kres, goff;
    if ((sl & 1) == 0) {
      if ((i & 1) == 0) {
        EpiArgs ea{};
        ea.o0 = qbuf; ea.f0 = ckvraw; ea.o1 = iqbuf; ea.o2 = ikbuf; ea.f1 = iwbuf;
        for (int rep = 0; rep < (PROBE_DUP == 4 ? 2 : 1); rep++) gemm_phase<EPI_AIN>(hbuf, w_ain + (size_t)j * A_INP * 1024, T, A_INP, 1024, ea, smem, bid, nb);
        gbar(bar, nb, gen);
        ckvnorm_phase(ckvraw, p.a_kv_norm + j * 256, ckvn, bid, nb);
        for (int rep = 0; rep < (PROBE_DUP == 2 ? 2 : 1); rep++) indexer_phase(iqbuf, ikbuf, iwbuf, selbuf, smem, bid, nb);
        gbar(bar, nb, gen);
        for (int rep = 0; rep < (PROBE_DUP == 3 ? 2 : 1); rep++) sparse_phase(qbuf, ckvn, selbuf, w_uk + (size_t)j * 16 * 256 * 64, w_uv + (size_t)j * 16 * 256 * 64, p.rel_bias,
                     hbuf, obuf, smem, bid, nb);
        gbar(bar, nb, gen);
        Wres = w_ao + (size_t)j * 1024 * 1024;
      } else {
        EpiArgs ea{};
        ea.o0 = qbuf; ea.o1 = kbuf; ea.o2 = vtbuf;
        for (int rep = 0; rep < (PROBE_DUP == 4 ? 2 : 1); rep++) gemm_phase<EPI_BIN>(hbuf, w_bin + (size_t)j * 3072 * 1024, T, 3072, 1024, ea, smem, bid, nb);
        gbar(bar, nb, gen);
        for (int rep = 0; rep < (PROBE_DUP == 1 ? 2 : 1); rep++) diffattn_phase(qbuf, kbuf, vtbuf, obuf, p.rel_bias, p.b_lambda + j * 256, p.b_subln + j * 128, i, smem, bid, nb);
        gbar(bar, nb, gen);
        Wres = w_bo + (size_t)j * 1024 * 1024;
      }
      Ares = obuf; Kres = 1024; goff = 2 * 1024;
    } else {
      EpiArgs ea{};
      ea.o0 = hid;
      for (int rep = 0; rep < (PROBE_DUP == 4 ? 2 : 1); rep++) gemm_phase<EPI_SQRELU>(hbuf, w_w1 + (size_t)i * 4096 * 1024, T, 4096, 1024, ea, smem, bid, nb);
      gbar(bar, nb, gen);
      Ares = hid; Wres = w_w2 + (size_t)i * 4096 * 1024; Kres = 4096; goff = 5 * 1024;
    }
    {
      EpiArgs ea{};
      ea.f0 = p.out;
      ea.xin = (sl == 0) ? p.x : (const float*)p.out;
      ea.g = modi + goff;
      gemm_phase<EPI_RES>(Ares, Wres, T, 1024, Kres, ea, smem, bid, nb);
    }
    gbar(bar, nb, gen);
    {
      const float* modn = ((sl & 1) == 0) ? modi : (i < 3 ? modi + 4 * 6144 : (const float*)nullptr);
      const int sh_off = ((sl & 1) == 0) ? 3 * 1024 : 0;
      ln_phase(p.out, p.ln_g + (size_t)(i * 2 + (sl & 1)) * 1024, p.ln_b + (size_t)(i * 2 + (sl & 1)) * 1024, modn, sh_off,
               hbuf, bid, nb);
    }
    gbar(bar, nb, gen);
  }
}

extern "C" void kernel_launch(void* const* d_in, const int* in_sizes, int n_in, void* d_out, int out_size, void* d_ws,
                              size_t ws_size, hipStream_t stream) {
  static int grid_blocks = 0;
  if (!grid_blocks) {
    int dev = 0, cus = 0, per_cu = 0;
    hipGetDevice(&dev);
    hipDeviceGetAttribute(&cus, hipDeviceAttributeMultiprocessorCount, dev);
    hipOccupancyMaxActiveBlocksPerMultiprocessor(&per_cu, hybrid_fwd, 256, 0);
    if (per_cu < 1) per_cu = 1;
    if (per_cu > 2) per_cu = 2;
    grid_blocks = cus * per_cu;
    if (grid_blocks > 512) grid_blocks = 512;
  }
  Params p{};
  p.x = (const float*)d_in[0];
  p.c = (const float*)d_in[1];
  p.rel_bias = (const float*)d_in[2];
  p.ada_w = (const float*)d_in[3];
  p.ada_b = (const float*)d_in[4];
  p.ln_g = (const float*)d_in[5];
  p.ln_b = (const float*)d_in[6];
  p.a_w_in = (const float*)d_in[7];
  p.a_kv_norm = (const float*)d_in[8];
  p.a_w_uk = (const float*)d_in[9];
  p.a_w_uv = (const float*)d_in[10];
  p.a_w_o = (const float*)d_in[11];
  p.b_w_in = (const float*)d_in[12];
  p.b_lambda = (const float*)d_in[13];
  p.b_subln = (const float*)d_in[14];
  p.b_w_o = (const float*)d_in[15];
  p.mlp_w1 = (const float*)d_in[16];
  p.mlp_w2 = (const float*)d_in[17];
  p.out = (float*)d_out;
  p.ws = (char*)d_ws;
  hipMemsetAsync((char*)d_ws + WS_BAR, 0, 1024, stream);
  void* args[] = {&p};
  hipError_t e = hipLaunchCooperativeKernel((void*)hybrid_fwd, dim3(grid_blocks), dim3(256), args, 0, stream);
  if (e != hipSuccess) fprintf(stderr, "cooperative launch failed: %s (grid %d)\n", hipGetErrorString(e), grid_blocks);
}
```

```cpp
#include <hip/hip_runtime.h>
#include <hip/hip_cooperative_groups.h>
#include <stdint.h>
#include <stdio.h>
namespace cg = cooperative_groups;

typedef unsigned short u16;
typedef short bf16x8 __attribute__((ext_vector_type(8)));
typedef short s16x4 __attribute__((ext_vector_type(4)));
typedef float f32x16 __attribute__((ext_vector_type(16)));
typedef float f32x4 __attribute__((ext_vector_type(4)));
typedef float f32x2 __attribute__((ext_vector_type(2)));
typedef __bf16 bf16x2_t __attribute__((ext_vector_type(2)));
typedef unsigned u32x4 __attribute__((ext_vector_type(4)));
typedef unsigned u32x2 __attribute__((ext_vector_type(2)));
typedef __attribute__((address_space(3))) s16x4* lds_s16x4_ptr;

#define DI __device__ __forceinline__
#ifndef PROBE_DUP
#define PROBE_DUP 0
#endif

constexpr int D = 1024, NBATCH = 4, S = 8192, T = NBATCH * S;
constexpr int A_INP = 1920;
constexpr float DN_ALPHA = 1.6817928305074292f;
constexpr float LOG2E = 1.4426950408889634f;
constexpr float LN_EPS = 1e-5f;
constexpr float NEGF = -1e30f;
constexpr int TOPK = 256;
constexpr int CAP = 704;
constexpr int LDS_BYTES = 72 * 1024;

constexpr size_t MB = 1024 * 1024;
constexpr size_t W_AIN = 0;
constexpr size_t W_UK = W_AIN + (size_t)2 * 1920 * 1024 * 2;
constexpr size_t W_UV = W_UK + (size_t)2 * 16 * 256 * 64 * 2;
constexpr size_t W_AO = W_UV + (size_t)2 * 16 * 256 * 64 * 2;
constexpr size_t W_BIN = W_AO + (size_t)2 * 1024 * 1024 * 2;
constexpr size_t W_BO = W_BIN + (size_t)2 * 3072 * 1024 * 2;
constexpr size_t W_W1 = W_BO + (size_t)2 * 1024 * 1024 * 2;
constexpr size_t W_W2 = W_W1 + (size_t)4 * 4096 * 1024 * 2;
constexpr size_t WS_MOD = W_W2 + (size_t)4 * 4096 * 1024 * 2;
constexpr size_t WS_H = WS_MOD + 1 * MB;
constexpr size_t WS_BIG = WS_H + 64 * MB;
constexpr size_t WS_BAR = WS_BIG + 256 * MB;
constexpr size_t B_Q = 0;
constexpr size_t B_IQ = 64 * MB;
constexpr size_t B_IK = 96 * MB;
constexpr size_t B_IW = 100 * MB;
constexpr size_t B_CKVRAW = 104 * MB;
constexpr size_t B_CKVN = 136 * MB;
constexpr size_t B_SEL = 152 * MB;
constexpr size_t B_K = 64 * MB;
constexpr size_t B_VT = 128 * MB;
constexpr size_t B_O = 192 * MB;

struct Params {
  const float *x, *c, *rel_bias, *ada_w, *ada_b, *ln_g, *ln_b, *a_w_in, *a_kv_norm, *a_w_uk, *a_w_uv, *a_w_o, *b_w_in,
      *b_lambda, *b_subln, *b_w_o, *mlp_w1, *mlp_w2;
  float* out;
  char* ws;
};

DI int opq_tid() {
  int t = threadIdx.x;
  asm volatile("" : "+v"(t));
  return t;
}
DI unsigned pk2(float lo, float hi) {
  f32x2 v = {lo, hi};
  bf16x2_t b = __builtin_convertvector(v, bf16x2_t);
  return __builtin_bit_cast(unsigned, b);
}
DI u16 f2bf(float x) { return (u16)(pk2(x, 0.f) & 0xffffu); }
DI float wave_sum(float v) {
#pragma unroll
  for (int o = 32; o >= 1; o >>= 1) v += __shfl_xor(v, o);
  return v;
}
DI f32x16 mfma32(bf16x8 a, bf16x8 b, f32x16 c) { return __builtin_amdgcn_mfma_f32_32x32x16_bf16(a, b, c, 0, 0, 0); }
DI f32x4 mfma16(bf16x8 a, bf16x8 b, f32x4 c) { return __builtin_amdgcn_mfma_f32_16x16x32_bf16(a, b, c, 0, 0, 0); }
DI int pi_row(int r) { return (r & ~12) | ((r & 4) << 1) | ((r & 8) >> 1); }

DI int rel_bucket(int n) {
  if (n < 16) return n;
  float nf = (float)n;
  int large = 16 + (int)(logf(nf / 16.f) / 2.0794415416798357f * 16.f);
  return large < 31 ? large : 31;
}

DI void tconv_phase(const float* __restrict__ src, u16* __restrict__ dst, int batch, int R, int C, int Cpad, char* smem,
                    int bid, int nb) {
  float* tile = (float*)smem;
  const int tid = opq_tid();
  const int tr = R / 64, tc = Cpad / 64;
  const int ntiles = batch * tr * tc;
  for (int it = bid; it < ntiles; it += nb) {
    const int bi = it / (tr * tc);
    const int rem = it - bi * (tr * tc);
    const int ri = rem / tc, ci = rem - ri * tc;
    const float* s = src + (size_t)bi * R * C;
    u16* d = dst + (size_t)bi * Cpad * R;
    __syncthreads();
#pragma unroll 4
    for (int k = 0; k < 16; k++) {
      const int r = (tid >> 6) + 4 * k;
      const int cc = ci * 64 + (tid & 63);
      float v = (cc < C) ? s[(size_t)(ri * 64 + r) * C + cc] : 0.f;
      tile[r * 65 + (tid & 63)] = v;
    }
    __syncthreads();
#pragma unroll 4
    for (int k = 0; k < 16; k++) {
      const int cl = (tid >> 6) + 4 * k;
      const int rl = tid & 63;
      d[(size_t)(ci * 64 + cl) * R + ri * 64 + rl] = f2bf(tile[rl * 65 + cl]);
    }
  }
}

DI void mod_phase(const Params& p, float* mod, char* smem, int bid, int nb) {
  float* sc = (float*)smem;
  float* red = sc + 4096;
  const int tid = opq_tid(), lane = tid & 63, w = __builtin_amdgcn_readfirstlane(tid >> 6);
  __syncthreads();
  for (int i = tid; i < 4096; i += 256) {
    float v = p.c[i];
    sc[i] = v / (1.f + expf(-v));
  }
  __syncthreads();
  for (int it = bid; it < 4 * 96; it += nb) {
    const int l = it / 96, e0 = (it - l * 96) * 64;
    const float* wp = p.ada_w + ((size_t)l * 1024 + w * 256) * 6144 + e0 + lane;
    float a0 = 0, a1 = 0, a2 = 0, a3 = 0;
#pragma unroll 8
    for (int d = 0; d < 256; d++) {
      float wv = wp[(size_t)d * 6144];
      int dd = w * 256 + d;
      a0 += sc[dd] * wv;
      a1 += sc[1024 + dd] * wv;
      a2 += sc[2048 + dd] * wv;
      a3 += sc[3072 + dd] * wv;
    }
    red[(w * 4 + 0) * 64 + lane] = a0;
    red[(w * 4 + 1) * 64 + lane] = a1;
    red[(w * 4 + 2) * 64 + lane] = a2;
    red[(w * 4 + 3) * 64 + lane] = a3;
    __syncthreads();
    {
      const int b = w;
      float s = red[(0 * 4 + b) * 64 + lane] + red[(1 * 4 + b) * 64 + lane] + red[(2 * 4 + b) * 64 + lane] +
                red[(3 * 4 + b) * 64 + lane] + p.ada_b[l * 6144 + e0 + lane];
      mod[((size_t)l * 4 + b) * 6144 + e0 + lane] = s;
    }
    __syncthreads();
  }
}

DI void h0_phase(const float* __restrict__ x, const float* __restrict__ mod0, u16* __restrict__ h, int bid, int nb) {
  const size_t n8 = (size_t)T * 1024 / 8;
  for (size_t i = (size_t)bid * 256 + opq_tid(); i < n8; i += (size_t)nb * 256) {
    const size_t e = i * 8;
    const int t = (int)(e >> 10), d = (int)(e & 1023), b = t >> 13;
    const float* m = mod0 + (size_t)b * 6144;
    f32x4 v0 = *(const f32x4*)(x + e), v1 = *(const f32x4*)(x + e + 4);
    f32x4 sh0 = *(const f32x4*)(m + d), sh1 = *(const f32x4*)(m + d + 4);
    f32x4 sc0 = *(const f32x4*)(m + 1024 + d), sc1 = *(const f32x4*)(m + 1024 + d + 4);
    v0 = v0 * (1.f + sc0) + sh0;
    v1 = v1 * (1.f + sc1) + sh1;
    u32x4 o;
    o[0] = pk2(v0[0], v0[1]);
    o[1] = pk2(v0[2], v0[3]);
    o[2] = pk2(v1[0], v1[1]);
    o[3] = pk2(v1[2], v1[3]);
    *(u32x4*)(h + e) = o;
  }
}

DI void ln_phase(float* z, const float* __restrict__ g, const float* __restrict__ bt, const float* modn, int sh_off,
                 u16* __restrict__ h, int bid, int nb) {
  const int tid = opq_tid(), lane = tid & 63, w = __builtin_amdgcn_readfirstlane(tid >> 6);
  for (int row = bid * 4 + w; row < T; row += nb * 4) {
    f32x4* zp = (f32x4*)(z + (size_t)row * 1024);
    f32x4 v[4];
#pragma unroll
    for (int c = 0; c < 4; c++) v[c] = zp[c * 64 + lane];
    float s = 0;
#pragma unroll
    for (int c = 0; c < 4; c++) s += v[c][0] + v[c][1] + v[c][2] + v[c][3];
    const float mu = wave_sum(s) * (1.f / 1024.f);
    float q = 0;
#pragma unroll
    for (int c = 0; c < 4; c++) {
      v[c] = v[c] - mu;
      q += v[c][0] * v[c][0] + v[c][1] * v[c][1] + v[c][2] * v[c][2] + v[c][3] * v[c][3];
    }
    const float rstd = rsqrtf(wave_sum(q) * (1.f / 1024.f) + LN_EPS);
    const int b = row >> 13;
#pragma unroll
    for (int c = 0; c < 4; c++) {
      const int d = c * 256 + lane * 4;
      f32x4 y = v[c] * rstd * *(const f32x4*)(g + d) + *(const f32x4*)(bt + d);
      zp[c * 64 + lane] = y;
      if (modn) {
        const float* m = modn + (size_t)b * 6144 + sh_off;
        f32x4 hv = y * (1.f + *(const f32x4*)(m + 1024 + d)) + *(const f32x4*)(m + d);
        u32x2 o;
        o[0] = pk2(hv[0], hv[1]);
        o[1] = pk2(hv[2], hv[3]);
        *(u32x2*)(h + (size_t)row * 1024 + d) = o;
      }
    }
  }
}

enum { EPI_AIN = 0, EPI_BIN = 1, EPI_RES = 2, EPI_SQRELU = 3 };
struct EpiArgs {
  u16 *o0, *o1, *o2;
  float *f0, *f1;
  const float* xin;
  const float* g;
};

template <int EPI>
DI void gemm_phase(const u16* __restrict__ A, const u16* __restrict__ Bt, int M, int N, int K, const EpiArgs& ea,
                   char* smem, int bid, int nb) {
  constexpr int MI = 4, BM = 64 * MI;
  u16* As = (u16*)smem;
  u16* Bs = As + BM * 72;
  const int tid = opq_tid(), lane = tid & 63, w = __builtin_amdgcn_readfirstlane(tid >> 6), wm = w >> 1, wn = w & 1, l31 = lane & 31, lh = lane >> 5;
  const int ntn = N / 128, ntm = M / BM, nt = ntn * ntm, nk = K / 64;
  const int lr = tid >> 3, lc = (tid & 7) * 8;
  const int xcd = bid & 7, nbx = nb >> 3, cntx = (ntm >> 3) * ntn;
  (void)nt;
  for (int sq = bid >> 3; sq < cntx; sq += nbx) {
    const int tmx = sq / ntn, tn = sq - tmx * ntn;
    const int tm = tmx * 8 + xcd;
    const int m0 = tm * BM, n0 = tn * 128;
    f32x16 acc[MI][2];
#pragma unroll
    for (int i = 0; i < MI; i++)
#pragma unroll
      for (int j = 0; j < 2; j++)
#pragma unroll
        for (int r = 0; r < 16; r++) acc[i][j][r] = 0.f;
    u32x4 ra[2 * MI], rb[4];
    const u16* ap = A + (size_t)(m0 + lr) * K + lc;
    const u16* bp = Bt + (size_t)(n0 + lr) * K + lc;
#pragma unroll
    for (int i = 0; i < 2 * MI; i++) ra[i] = *(const u32x4*)(ap + (size_t)i * 32 * K);
#pragma unroll
    for (int i = 0; i < 4; i++) rb[i] = *(const u32x4*)(bp + (size_t)i * 32 * K);
    __syncthreads();
#pragma unroll
    for (int i = 0; i < 2 * MI; i++) *(u32x4*)&As[(lr + 32 * i) * 72 + lc] = ra[i];
#pragma unroll
    for (int i = 0; i < 4; i++) *(u32x4*)&Bs[(lr + 32 * i) * 72 + lc] = rb[i];
    __syncthreads();
    for (int kt = 0; kt < nk; kt++) {
      if (kt + 1 < nk) {
#pragma unroll
        for (int i = 0; i < 2 * MI; i++) ra[i] = *(const u32x4*)(ap + (size_t)i * 32 * K + (kt + 1) * 64);
#pragma unroll
        for (int i = 0; i < 4; i++) rb[i] = *(const u32x4*)(bp + (size_t)i * 32 * K + (kt + 1) * 64);
      }
#pragma unroll
      for (int ks = 0; ks < 4; ks++) {
        bf16x8 af[MI], b0, b1;
#pragma unroll
        for (int i = 0; i < MI; i++) af[i] = *(const bf16x8*)&As[(wm * 32 * MI + 32 * i + l31) * 72 + ks * 16 + lh * 8];
        b0 = *(const bf16x8*)&Bs[(wn * 64 + l31) * 72 + ks * 16 + lh * 8];
        b1 = *(const bf16x8*)&Bs[(wn * 64 + 32 + l31) * 72 + ks * 16 + lh * 8];
#pragma unroll
        for (int i = 0; i < MI; i++) {
          acc[i][0] = mfma32(b0, af[i], acc[i][0]);
          acc[i][1] = mfma32(b1, af[i], acc[i][1]);
        }
      }
      __syncthreads();
      if (kt + 1 < nk) {
#pragma unroll
        for (int i = 0; i < 2 * MI; i++) *(u32x4*)&As[(lr + 32 * i) * 72 + lc] = ra[i];
#pragma unroll
        for (int i = 0; i < 4; i++) *(u32x4*)&Bs[(lr + 32 * i) * 72 + lc] = rb[i];
        __syncthreads();
      }
    }
    const int bidx = m0 >> 13;
#pragma unroll
    for (int i = 0; i < MI; i++) {
      const int row = m0 + wm * 32 * MI + 32 * i + l31;
#pragma unroll
      for (int j = 0; j < 2; j++) {
#pragma unroll
        for (int r4 = 0; r4 < 4; r4++) {
          const int col = n0 + wn * 64 + 32 * j + 8 * r4 + 4 * lh;
          float v[4];
#pragma unroll
          for (int q = 0; q < 4; q++) v[q] = acc[i][j][4 * r4 + q];
          if (EPI == EPI_AIN) {
            if (col < 1024) {
              u32x2 o;
              o[0] = pk2(v[0], v[1]);
              o[1] = pk2(v[2], v[3]);
              *(u32x2*)(ea.o0 + (size_t)row * 1024 + col) = o;
            } else if (col < 1280) {
              *(f32x4*)(ea.f0 + (size_t)row * 256 + (col - 1024)) = (f32x4){v[0], v[1], v[2], v[3]};
            } else if (col < 1792) {
              u32x2 o;
              o[0] = pk2(v[0], v[1]);
              o[1] = pk2(v[2], v[3]);
              *(u32x2*)(ea.o1 + (size_t)row * 512 + (col - 1280)) = o;
            } else if (col < 1856) {
              const int d = col - 1792;
              const int sidx = row & 8191;
              const size_t off = (size_t)(row >> 13) * S * 64 +
                                 ((size_t)((sidx >> 5) * 4 + (d >> 4)) * 64 + 32 * ((d >> 3) & 1) + (sidx & 31)) * 8 + (d & 7);
              u32x2 o;
              o[0] = pk2(v[0], v[1]);
              o[1] = pk2(v[2], v[3]);
              *(u32x2*)(ea.o2 + off) = o;
            } else if (col < 1864) {
              const float sc = 0.044194173824159216f;
              *(f32x4*)(ea.f1 + (size_t)row * 8 + (col - 1856)) = (f32x4){v[0] * sc, v[1] * sc, v[2] * sc, v[3] * sc};
            }
          } else if (EPI == EPI_BIN) {
            if (col < 1024) {
              const float sc = 0.125f * LOG2E;
              u32x2 o;
              o[0] = pk2(v[0] * sc, v[1] * sc);
              o[1] = pk2(v[2] * sc, v[3] * sc);
              *(u32x2*)(ea.o0 + (size_t)row * 1024 + col) = o;
            } else if (col < 2048) {
              u32x2 o;
              o[0] = pk2(v[0], v[1]);
              o[1] = pk2(v[2], v[3]);
              *(u32x2*)(ea.o1 + (size_t)row * 1024 + (col - 1024)) = o;
            } else {
              const int cv = col - 2048;
#pragma unroll
              for (int q = 0; q < 4; q++) ea.o2[((size_t)bidx * 1024 + cv + q) * 8192 + (row & 8191)] = f2bf(v[q]);
            }
          } else if (EPI == EPI_RES) {
            const f32x4 gg = *(const f32x4*)(ea.g + (size_t)bidx * 6144 + col);
            const size_t o = (size_t)row * 1024 + col;
            const f32x4 xv = *(const f32x4*)(ea.xin + o);
            f32x4 r;
#pragma unroll
            for (int q = 0; q < 4; q++) r[q] = DN_ALPHA * xv[q] + (1.f + gg[q]) * v[q];
            *(f32x4*)(ea.f0 + o) = r;
          } else {
            float r[4];
#pragma unroll
            for (int q = 0; q < 4; q++) {
              r[q] = v[q] > 0.f ? v[q] : 0.f;
              r[q] = r[q] * r[q];
            }
            u32x2 o;
            o[0] = pk2(r[0], r[1]);
            o[1] = pk2(r[2], r[3]);
            *(u32x2*)(ea.o0 + (size_t)row * 4096 + col) = o;
          }
        }
      }
    }
  }
}

DI void ckvnorm_phase(const float* __restrict__ raw, const float* __restrict__ g, u16* __restrict__ outp, int bid,
                      int nb) {
  const int tid = opq_tid(), lane = tid & 63, w = __builtin_amdgcn_readfirstlane(tid >> 6);
  const f32x4 gg = *(const f32x4*)(g + lane * 4);
  for (int row = bid * 4 + w; row < T; row += nb * 4) {
    f32x4 v = *(const f32x4*)(raw + (size_t)row * 256 + lane * 4);
    float ss = v[0] * v[0] + v[1] * v[1] + v[2] * v[2] + v[3] * v[3];
    ss = wave_sum(ss);
    const float r = rsqrtf(ss * (1.f / 256.f) + LN_EPS);
    u32x2 o;
    o[0] = pk2(v[0] * r * gg[0], v[1] * r * gg[1]);
    o[1] = pk2(v[2] * r * gg[2], v[3] * r * gg[3]);
    *(u32x2*)(outp + (size_t)row * 256 + lane * 4) = o;
  }
}

DI unsigned mono_key(float s) {
  unsigned u = __float_as_uint(s);
  return (u & 0x80000000u) ? ~u : (u | 0x80000000u);
}
DI float mono_inv(unsigned k) {
  unsigned u = (k & 0x80000000u) ? (k & 0x7fffffffu) : ~k;
  return __uint_as_float(u);
}
DI float relu_i(float x) {
  int i = __float_as_int(x);
  return __int_as_float(i > 0 ? i : 0);
}
DI int wcount(bool f) { return __popcll(__ballot(f)); }

template <bool EXACT>
DI void compact4(float* vals, u16* idxs, int* cnt, int lane, float* thr_out) {
  constexpr int NPL = CAP / 64;
  unsigned key[4][NPL];
  int n[4];
#pragma unroll
  for (int q = 0; q < 4; q++) n[q] = cnt[q];
#pragma unroll
  for (int q = 0; q < 4; q++)
#pragma unroll
    for (int j = 0; j < NPL; j++) {
      const int e = j * 64 + lane;
      key[q][j] = (e < n[q]) ? mono_key(vals[q * CAP + e]) : 0u;
    }
  unsigned Tk[4] = {0u, 0u, 0u, 0u};
  constexpr int LOWBIT = EXACT ? 0 : 18;
#pragma unroll 1
  for (int bit = 31; bit >= LOWBIT; bit--) {
#pragma unroll
    for (int q = 0; q < 4; q++) {
      const unsigned cand = Tk[q] | (1u << bit);
      int c = 0;
#pragma unroll
      for (int j = 0; j < NPL; j++) c += wcount(key[q][j] >= cand);
      Tk[q] = (c >= TOPK) ? cand : Tk[q];
    }
  }
  unsigned I[4] = {0xffffu, 0xffffu, 0xffffu, 0xffffu};
  if (EXACT) {
    unsigned ix[4][NPL];
    int need[4];
#pragma unroll
    for (int q = 0; q < 4; q++) {
      int cgt = 0;
#pragma unroll
      for (int j = 0; j < NPL; j++) {
        const int e = j * 64 + lane;
        ix[q][j] = (e < n[q]) ? (unsigned)idxs[q * CAP + e] : 0xffffu;
        cgt += wcount(key[q][j] > Tk[q]);
      }
      need[q] = TOPK - cgt;
      I[q] = 0u;
    }
#pragma unroll 1
    for (int bit = 13; bit >= 0; bit--) {
#pragma unroll
      for (int q = 0; q < 4; q++) {
        const unsigned cand = I[q] | (1u << bit);
        int c = 0;
#pragma unroll
        for (int j = 0; j < NPL; j++) c += wcount(key[q][j] == Tk[q] && ix[q][j] < cand);
        I[q] = (c < need[q]) ? cand : I[q];
      }
    }
  }
  const unsigned long long lt = (1ull << lane) - 1ull;
#pragma unroll
  for (int q = 0; q < 4; q++) {
    if (n[q] > TOPK) {
      int base = 0;
#pragma unroll
      for (int j = 0; j < NPL; j++) {
        const int e = j * 64 + lane;
        const bool in = e < n[q];
        const float v = in ? vals[q * CAP + e] : 0.f;
        const unsigned ixv = in ? (unsigned)idxs[q * CAP + e] : 0xffffu;
        const bool keep = (key[q][j] > Tk[q]) || (key[q][j] == Tk[q] && ixv <= I[q]);
        const unsigned long long m = __ballot(keep);
        if (keep) {
          const int pos = base + __popcll(m & lt);
          vals[q * CAP + pos] = v;
          idxs[q * CAP + pos] = (u16)ixv;
        }
        base += __popcll(m);
      }
      if (lane == 0) cnt[q] = base;
      thr_out[q] = mono_inv(Tk[q]);
    }
  }
}

DI void indexer_phase(const u16* __restrict__ iq, const u16* __restrict__ ik, const float* __restrict__ iw,
                      u16* __restrict__ sel, char* smem, int bid, int nb) {
  constexpr int WBYTES = 4 * CAP * 4 + 4 * CAP * 2 + 64;
  const int tid = opq_tid(), lane = tid & 63, w = __builtin_amdgcn_readfirstlane(tid >> 6), l31 = lane & 31, u = lane >> 5;
  float* vals = (float*)(smem + w * WBYTES);
  u16* idxs = (u16*)(smem + w * WBYTES + 4 * CAP * 4);
  int* cnt = (int*)(smem + w * WBYTES + 4 * CAP * 4 + 4 * CAP * 2);
  const int nitems = NBATCH * (S / 16);
  const int nrounds = (nitems + nb - 1) / nb;
  __syncthreads();
  for (int rd = 0; rd < nrounds; rd++) {
    const int it = rd * nb + ((rd & 1) ? (nb - 1 - bid) : bid);
    if (it >= nitems) continue;
    const int b = it & 3, qg = (S / 16 - 1) - (it >> 2);
    const int t0 = qg * 16;
    const int tw = t0 + 4 * w;
    const size_t tb = (size_t)b * S;
    bf16x8 aq[4];
    {
      const int g = l31 >> 3, up = (l31 >> 2) & 1, j = l31 & 3;
      const int ql = 2 * up + (g >> 1), hd = 4 * (g & 1) + j;
      const u16* qp = iq + (tb + tw + ql) * 512 + hd * 64 + u * 8;
#pragma unroll
      for (int ks = 0; ks < 4; ks++) aq[ks] = *(const bf16x8*)(qp + ks * 16);
    }
    float wq[2][8];
#pragma unroll
    for (int qq = 0; qq < 2; qq++) {
      const float* wp = iw + (tb + tw + 2 * u + qq) * 8;
      f32x4 w0 = *(const f32x4*)wp, w1 = *(const f32x4*)(wp + 4);
#pragma unroll
      for (int h = 0; h < 4; h++) {
        wq[qq][h] = w0[h];
        wq[qq][4 + h] = w1[h];
      }
    }
    float thr[2] = {-INFINITY, -INFINITY};
    __builtin_amdgcn_wave_barrier();
    if (lane < 4) cnt[lane] = 0;
    __builtin_amdgcn_wave_barrier();
    const int nkb = (tw + 3) / 32 + 1;
    const u16* kp = ik + tb * 64 + lane * 8;
    bf16x8 ring[4][4];
#pragma unroll
    for (int i = 0; i < 4; i++) {
      const int kbn = (i < nkb) ? i : nkb - 1;
#pragma unroll
      for (int ks = 0; ks < 4; ks++) ring[i][ks] = *(const bf16x8*)(kp + (size_t)(kbn * 4 + ks) * 512);
    }
#pragma unroll 1
    for (int kb0 = 0; kb0 < nkb; kb0 += 4) {
#pragma unroll
      for (int i = 0; i < 4; i++) {
        const int kb = kb0 + i;
        {
          f32x16 acc;
#pragma unroll
          for (int r = 0; r < 16; r++) acc[r] = 0.f;
#pragma unroll
          for (int ks = 0; ks < 4; ks++) acc = mfma32(aq[ks], ring[i][ks], acc);
          {
            const int kbn = (kb + 4 < nkb) ? kb + 4 : nkb - 1;
#pragma unroll
            for (int ks = 0; ks < 4; ks++) ring[i][ks] = *(const bf16x8*)(kp + (size_t)(kbn * 4 + ks) * 512);
          }
          const int key = kb * 32 + l31;
#pragma unroll
          for (int qq = 0; qq < 2; qq++) {
            float s0 = 0.f, s1 = 0.f;
#pragma unroll
            for (int h = 0; h < 8; h += 2) {
              s0 = fmaf(wq[qq][h], relu_i(acc[8 * qq + h]), s0);
              s1 = fmaf(wq[qq][h + 1], relu_i(acc[8 * qq + h + 1]), s1);
            }
            float s = s0 + s1;
            s += 0.0f;
            const int tq = tw + 2 * u + qq;
            if (key <= tq && s >= thr[qq]) {
              const int qs = 2 * u + qq;
              const int pos = atomicAdd(&cnt[qs], 1);
              vals[qs * CAP + pos] = s;
              idxs[qs * CAP + pos] = (u16)key;
            }
          }
        }
      }
      __builtin_amdgcn_wave_barrier();
      const int c0 = cnt[0], c1 = cnt[1], c2 = cnt[2], c3 = cnt[3];
      if (c0 > CAP - 128 || c1 > CAP - 128 || c2 > CAP - 128 || c3 > CAP - 128) {
        float to[4] = {0.f, 0.f, 0.f, 0.f};
        compact4<false>(vals, idxs, cnt, lane, to);
        __builtin_amdgcn_wave_barrier();
        const int d0 = cnt[0], d1 = cnt[1], d2 = cnt[2], d3 = cnt[3];
        if (d0 > CAP - 256 || d1 > CAP - 256 || d2 > CAP - 256 || d3 > CAP - 256) {
          compact4<true>(vals, idxs, cnt, lane, to);
          __builtin_amdgcn_wave_barrier();
        }
        if (c0 > TOPK && u == 0) thr[0] = to[0];
        if (c1 > TOPK && u == 0) thr[1] = to[1];
        if (c2 > TOPK && u == 1) thr[0] = to[2];
        if (c3 > TOPK && u == 1) thr[1] = to[3];
      }
    }
    {
      const int c0 = cnt[0], c1 = cnt[1], c2 = cnt[2], c3 = cnt[3];
      if (c0 > TOPK || c1 > TOPK || c2 > TOPK || c3 > TOPK) {
        float to[4];
        compact4<true>(vals, idxs, cnt, lane, to);
        __builtin_amdgcn_wave_barrier();
      }
    }
#pragma unroll 1
    for (int qs = 0; qs < 4; qs++) {
      const int n = cnt[qs];
      u16* sp = sel + (tb + tw + qs) * 256;
#pragma unroll
      for (int j = 0; j < 4; j++) {
        const int e = j * 64 + lane;
        sp[e] = (e < n) ? idxs[qs * CAP + e] : (u16)0xffffu;
      }
    }
  }
}

DI void sparse_phase(const u16* __restrict__ q, const u16* __restrict__ ckvn, const u16* __restrict__ sel,
                     const u16* __restrict__ wuk, const u16* __restrict__ wuv, const float* __restrict__ rel_bias,
                     u16* scratch, u16* __restrict__ o, char* smem, int bid, int nb) {
  constexpr int GS = 264;
  const int tid = opq_tid(), lane = tid & 63, w = __builtin_amdgcn_readfirstlane(tid >> 6), l15 = lane & 15, g = lane >> 4;
  u16* G = (u16*)smem + (size_t)w * 32 * GS;
  int* lut = (int*)(smem + 4 * 32 * GS * 2);
  float* rb = (float*)(lut + 128);
  __syncthreads();
  if (tid < 128) lut[tid] = rel_bucket(tid);
  for (int i = tid; i < 512; i += 256) rb[i] = rel_bias[i] * LOG2E;
  __syncthreads();
  u16* ql = scratch + (size_t)bid * (16 * 16 * 256);
  const int nitems = NBATCH * (S / 16);
  for (int it = bid; it < nitems; it += nb) {
    const int b = it & 3, qg = it >> 2;
    const int t0 = qg * 16;
    const size_t tb = (size_t)b * S;
    for (int hh = 0; hh < 4; hh++) {
      const int h = 4 * w + hh;
      bf16x8 bq[2];
#pragma unroll
      for (int ks = 0; ks < 2; ks++) bq[ks] = *(const bf16x8*)(q + (tb + t0 + l15) * 1024 + h * 64 + ks * 32 + g * 8);
#pragma unroll 4
      for (int rt = 0; rt < 16; rt++) {
        f32x4 acc = {0.f, 0.f, 0.f, 0.f};
#pragma unroll
        for (int ks = 0; ks < 2; ks++) {
          bf16x8 a = *(const bf16x8*)(wuk + ((size_t)h * 256 + rt * 16 + l15) * 64 + ks * 32 + g * 8);
          acc = mfma16(a, bq[ks], acc);
        }
        u32x2 ov;
        ov[0] = pk2(acc[0] * (0.125f * LOG2E), acc[1] * (0.125f * LOG2E));
        ov[1] = pk2(acc[2] * (0.125f * LOG2E), acc[3] * (0.125f * LOG2E));
        *(u32x2*)(ql + ((size_t)l15 * 16 + h) * 256 + rt * 16 + 4 * g) = ov;
      }
    }
    __syncthreads();
    {
      const u16* selw = sel + (tb + t0 + 4 * w) * 256;
      const int l31 = lane & 31;
      const int q4 = l15 >> 2, p4 = l15 & 3;
      const u16* ckb = ckvn + tb * 256;
      int idx_c = selw[l31];
      int idx_n = selw[32 + l31];
      u32x4 gr[16];
#pragma unroll
      for (int i = 0; i < 16; i++) {
        int id = __shfl(idx_c, (lane >> 5) + 2 * i);
        id = (id == 0xffff) ? 0 : id;
        gr[i] = *(const u32x4*)(ckb + (unsigned)(id * 256 + l31 * 8));
      }
      bf16x8 qb[8];
      float m_run = NEGF, l_run = 0.f;
      f32x4 O[16];
#pragma unroll 1
      for (int st = 0; st < 32; st++) {
        const int qi = st >> 3, ch = st & 7;
        const int qloc = 4 * w + qi;
        const int t = t0 + qloc;
        if (ch == 0) {
#pragma unroll
          for (int ks = 0; ks < 8; ks++) qb[ks] = *(const bf16x8*)(ql + ((size_t)qloc * 16 + l15) * 256 + ks * 32 + g * 8);
          m_run = NEGF;
          l_run = 0.f;
#pragma unroll
          for (int rt = 0; rt < 16; rt++) O[rt] = (f32x4){0.f, 0.f, 0.f, 0.f};
        }
#pragma unroll
        for (int i = 0; i < 16; i++) *(u32x4*)&G[((lane >> 5) + 2 * i) * GS + l31 * 8] = gr[i];
        __builtin_amdgcn_wave_barrier();
        const int stn2 = (st + 2 < 32) ? st + 2 : 31;
        const int idx_nn = selw[stn2 * 32 + l31];
#pragma unroll
        for (int i = 0; i < 16; i++) {
          int id = __shfl(idx_n, (lane >> 5) + 2 * i);
          id = (id == 0xffff) ? 0 : id;
          gr[i] = *(const u32x4*)(ckb + (unsigned)(id * 256 + l31 * 8));
        }
        float lg[2][4];
#pragma unroll
        for (int kbk = 0; kbk < 2; kbk++) {
          f32x4 acc = {0.f, 0.f, 0.f, 0.f};
#pragma unroll
          for (int ks = 0; ks < 8; ks++) {
            bf16x8 a = *(const bf16x8*)&G[(16 * kbk + l15) * GS + ks * 32 + g * 8];
            acc = mfma16(a, qb[ks], acc);
          }
#pragma unroll
          for (int i = 0; i < 4; i++) {
            const int kid = __shfl(idx_c, 16 * kbk + 4 * g + i);
            float v = NEGF;
            if (kid != 0xffff) {
              int n = t - kid;
              n = n < 0 ? 0 : n;
              const int bk = n < 128 ? lut[n] : 31;
              v = acc[i] + rb[bk * 16 + l15];
            }
            lg[kbk][i] = v;
          }
        }
        float mx = fmaxf(fmaxf(fmaxf(lg[0][0], lg[0][1]), fmaxf(lg[0][2], lg[0][3])),
                         fmaxf(fmaxf(lg[1][0], lg[1][1]), fmaxf(lg[1][2], lg[1][3])));
        mx = fmaxf(mx, __shfl_xor(mx, 16));
        mx = fmaxf(mx, __shfl_xor(mx, 32));
        const float m_new = fmaxf(m_run, mx);
        const float scl = __builtin_amdgcn_exp2f(m_run - m_new);
        m_run = m_new;
        float ps = 0.f;
        float pe[8];
#pragma unroll
        for (int kbk = 0; kbk < 2; kbk++)
#pragma unroll
          for (int i = 0; i < 4; i++) {
            const float pv = __builtin_amdgcn_exp2f(lg[kbk][i] - m_new);
            pe[kbk * 4 + i] = pv;
            ps += pv;
          }
        l_run = l_run * scl + ps;
        u32x4 pw;
        pw[0] = pk2(pe[0], pe[1]);
        pw[1] = pk2(pe[2], pe[3]);
        pw[2] = pk2(pe[4], pe[5]);
        pw[3] = pk2(pe[6], pe[7]);
        const bf16x8 pB = __builtin_bit_cast(bf16x8, pw);
        if (__ballot(scl != 1.f)) {
#pragma unroll
          for (int rt = 0; rt < 16; rt++) O[rt] = O[rt] * scl;
        }
#pragma unroll
        for (int rt = 0; rt < 16; rt++) {
          const s16x4 lo = __builtin_amdgcn_ds_read_tr16_b64_v4i16((lds_s16x4_ptr)(&G[(4 * g + q4) * GS + rt * 16 + 4 * p4]));
          const s16x4 hi = __builtin_amdgcn_ds_read_tr16_b64_v4i16((lds_s16x4_ptr)(&G[(16 + 4 * g + q4) * GS + rt * 16 + 4 * p4]));
          const bf16x8 a = (bf16x8){lo[0], lo[1], lo[2], lo[3], hi[0], hi[1], hi[2], hi[3]};
          O[rt] = mfma16(a, pB, O[rt]);
          if ((rt & 3) == 3) asm volatile("" ::: "memory");
        }
        __builtin_amdgcn_wave_barrier();
        if (ch == 7) {
          float lt = l_run;
          lt += __shfl_xor(lt, 16);
          lt += __shfl_xor(lt, 32);
          const float inv = 1.f / lt;
#pragma unroll
          for (int rt = 0; rt < 16; rt++) {
            u32x2 ov;
            ov[0] = pk2(O[rt][0] * inv, O[rt][1] * inv);
            ov[1] = pk2(O[rt][2] * inv, O[rt][3] * inv);
            *(u32x2*)(ql + ((size_t)qloc * 16 + l15) * 256 + rt * 16 + 4 * g) = ov;
          }
        }
        idx_c = idx_n;
        idx_n = idx_nn;
      }
    }
    __syncthreads();
    for (int hh = 0; hh < 4; hh++) {
      const int h = 4 * w + hh;
      bf16x8 bo[8];
#pragma unroll
      for (int ks = 0; ks < 8; ks++) bo[ks] = *(const bf16x8*)(ql + ((size_t)l15 * 16 + h) * 256 + ks * 32 + g * 8);
#pragma unroll
      for (int et = 0; et < 4; et++) {
        f32x4 acc = {0.f, 0.f, 0.f, 0.f};
#pragma unroll
        for (int ks = 0; ks < 8; ks++) {
          bf16x8 a = *(const bf16x8*)(wuv + ((size_t)h * 64 + et * 16 + l15) * 256 + ks * 32 + g * 8);
          acc = mfma16(a, bo[ks], acc);
        }
        u32x2 ov;
        ov[0] = pk2(acc[0], acc[1]);
        ov[1] = pk2(acc[2], acc[3]);
        *(u32x2*)(o + (tb + t0 + l15) * 1024 + h * 64 + et * 16 + 4 * g) = ov;
      }
    }
    __syncthreads();
  }
}

DI void diffattn_phase(const u16* __restrict__ q, const u16* __restrict__ k, const u16* __restrict__ vT,
                       u16* __restrict__ o, const float* __restrict__ rel_bias, const float* __restrict__ lam,
                       const float* __restrict__ subln, int layer_idx, char* smem, int bid, int nb) {
  constexpr int KS = 136, VS = 72;
  u16* Ks = (u16*)smem;
  u16* Vs = Ks + 64 * KS;
  float* exch = (float*)smem;
  float* btab = (float*)(smem + 36 * 1024);
  int* lut = (int*)(smem + 36 * 1024 + 1040);
  float* misc = (float*)(smem + 36 * 1024 + 1040 + 512);
  const int tid = opq_tid(), lane = tid & 63, w = __builtin_amdgcn_readfirstlane(tid >> 6), l31 = lane & 31, lh = lane >> 5;
  const int qsub = w >> 1, m = w & 1;
  const float lam_init = 0.8f - 0.6f * expf(-0.3f * (float)layer_idx);
  __syncthreads();
  if (tid < 128) lut[tid] = rel_bucket(tid);
  if (w == 0) {
    float p1 = lam[lane] * lam[64 + lane], p2 = lam[128 + lane] * lam[192 + lane];
    p1 = wave_sum(p1);
    p2 = wave_sum(p2);
    if (lane == 0) misc[0] = expf(p1) - expf(p2) + lam_init;
  }
  __syncthreads();
  const float lam_full = misc[0];
  const int nitems = NBATCH * 8 * (S / 64);
  const int nrounds = (nitems + nb - 1) / nb;
  const int prow = pi_row(l31);
  for (int rd = 0; rd < nrounds; rd++) {
    const int it = rd * nb + ((rd & 1) ? (nb - 1 - bid) : bid);
    if (it >= nitems) continue;
    const int bh = it & 31, qb = (S / 64 - 1) - (it >> 5);
    const int b = bh >> 3, h = bh & 7;
    const int q0 = qb * 64, tq0 = q0 + 32 * qsub, t = tq0 + l31;
    const size_t tb = (size_t)b * S;
    __syncthreads();
    for (int i = tid; i < 258; i += 256) {
      const int n = i >> 1, mm = i & 1;
      const int bk = n < 128 ? lut[n] : 31;
      btab[i] = rel_bias[bk * 16 + 2 * h + mm] * LOG2E;
    }
    bf16x8 qf[4];
#pragma unroll
    for (int ks = 0; ks < 4; ks++) qf[ks] = *(const bf16x8*)(q + (tb + t) * 1024 + h * 128 + m * 64 + ks * 16 + lh * 8);
    f32x16 O[4];
#pragma unroll
    for (int et = 0; et < 4; et++)
#pragma unroll
      for (int r = 0; r < 16; r++) O[et][r] = 0.f;
    float m_run = NEGF, l_run = 0.f;
    const int nkt = qb + 1;
    u32x4 rk[4], rv[4];
    const u16* kp = k + tb * 1024 + h * 128;
    const u16* vp = vT + ((size_t)(b * 8 + h) * 128) * 8192;
#pragma unroll
    for (int i = 0; i < 4; i++) {
      const int id = tid + 256 * i;
      rk[i] = *(const u32x4*)(kp + (size_t)(id >> 4) * 1024 + (id & 15) * 8);
      rv[i] = *(const u32x4*)(vp + (size_t)(id >> 3) * 8192 + (id & 7) * 8);
    }
#pragma unroll
    for (int i = 0; i < 4; i++) {
      const int id = tid + 256 * i;
      *(u32x4*)&Ks[(id >> 4) * KS + (id & 15) * 8] = rk[i];
      *(u32x4*)&Vs[(id >> 3) * VS + (id & 7) * 8] = rv[i];
    }
    __syncthreads();
    const float cfar = btab[256 + m];
    for (int kt = 0; kt < nkt; kt++) {
      if (kt + 1 < nkt) {
#pragma unroll
        for (int i = 0; i < 4; i++) {
          const int id = tid + 256 * i;
          rk[i] = *(const u32x4*)(kp + (size_t)((kt + 1) * 64 + (id >> 4)) * 1024 + (id & 15) * 8);
          rv[i] = *(const u32x4*)(vp + (size_t)(id >> 3) * 8192 + (kt + 1) * 64 + (id & 7) * 8);
        }
      }
      const int s_tile = kt * 64;
      const int nblk = (s_tile + 32 <= tq0 + 31) ? 2 : 1;
#pragma unroll 1
      for (int kb = 0; kb < nblk; kb++) {
        f32x16 acc;
#pragma unroll
        for (int r = 0; r < 16; r++) acc[r] = 0.f;
#pragma unroll
        for (int ks = 0; ks < 4; ks++) {
          bf16x8 a = *(const bf16x8*)&Ks[(32 * kb + prow) * KS + m * 64 + ks * 16 + lh * 8];
          acc = mfma32(a, qf[ks], acc);
        }
        const int s0 = s_tile + 32 * kb;
        const bool nearb = (tq0 - (s0 + 31)) < 128;
        if (nearb) {
#pragma unroll
          for (int r = 0; r < 16; r++) {
            const int key = s0 + 16 * (r >> 3) + 8 * lh + (r & 7);
            const int n = t - key;
            const int nc = n < 0 ? 0 : (n > 128 ? 128 : n);
            const float bv = btab[nc * 2 + m];
            acc[r] = (n < 0) ? NEGF : acc[r] + bv;
          }
        } else {
#pragma unroll
          for (int r = 0; r < 16; r++) acc[r] += cfar;
        }
        float mx = acc[0];
#pragma unroll
        for (int r = 1; r < 16; r++) mx = fmaxf(mx, acc[r]);
        mx = fmaxf(mx, __shfl_xor(mx, 32));
        const float m_new = fmaxf(m_run, mx);
        const float scl = __builtin_amdgcn_exp2f(m_run - m_new);
        m_run = m_new;
        float ps = 0.f;
#pragma unroll
        for (int r = 0; r < 16; r++) {
          const float pv = __builtin_amdgcn_exp2f(acc[r] - m_new);
          acc[r] = pv;
          ps += pv;
        }
        l_run = l_run * scl + ps;
        if (__ballot(scl != 1.f)) {
#pragma unroll
          for (int et = 0; et < 4; et++)
#pragma unroll
            for (int r = 0; r < 16; r++) O[et][r] *= scl;
        }
#pragma unroll
        for (int s2 = 0; s2 < 2; s2++) {
          u32x4 pw;
          pw[0] = pk2(acc[8 * s2 + 0], acc[8 * s2 + 1]);
          pw[1] = pk2(acc[8 * s2 + 2], acc[8 * s2 + 3]);
          pw[2] = pk2(acc[8 * s2 + 4], acc[8 * s2 + 5]);
          pw[3] = pk2(acc[8 * s2 + 6], acc[8 * s2 + 7]);
          const bf16x8 pB = __builtin_bit_cast(bf16x8, pw);
#pragma unroll
          for (int et = 0; et < 4; et++) {
            bf16x8 a = *(const bf16x8*)&Vs[(32 * et + l31) * VS + 32 * kb + 16 * s2 + 8 * lh];
            O[et] = mfma32(a, pB, O[et]);
          }
        }
      }
      __syncthreads();
      if (kt + 1 < nkt) {
#pragma unroll
        for (int i = 0; i < 4; i++) {
          const int id = tid + 256 * i;
          *(u32x4*)&Ks[(id >> 4) * KS + (id & 15) * 8] = rk[i];
          *(u32x4*)&Vs[(id >> 3) * VS + (id & 7) * 8] = rv[i];
        }
        __syncthreads();
      }
    }
    float lt = l_run + __shfl_xor(l_run, 32);
    const float inv = 1.f / lt;
    if (m == 1) {
#pragma unroll
      for (int et = 0; et < 4; et++)
#pragma unroll
        for (int r = 0; r < 16; r++) {
          const int e = 32 * et + (r & 3) + 8 * (r >> 2) + 4 * lh;
          exch[(qsub * 128 + e) * 32 + l31] = O[et][r] * inv;
        }
    }
    __syncthreads();
    if (m == 0) {
      float ss = 0.f;
#pragma unroll
      for (int et = 0; et < 4; et++)
#pragma unroll
        for (int r = 0; r < 16; r++) {
          const int e = 32 * et + (r & 3) + 8 * (r >> 2) + 4 * lh;
          const float v = O[et][r] * inv - lam_full * exch[(qsub * 128 + e) * 32 + l31];
          O[et][r] = v;
          ss += v * v;
        }
      ss += __shfl_xor(ss, 32);
      const float rs = rsqrtf(ss * (1.f / 128.f) + LN_EPS);
      const float osc = 1.f - lam_init;
#pragma unroll
      for (int et = 0; et < 4; et++)
#pragma unroll
        for (int r4 = 0; r4 < 4; r4++) {
          const int e = 32 * et + 8 * r4 + 4 * lh;
          const f32x4 gv = *(const f32x4*)(subln + e);
          u32x2 ov;
          ov[0] = pk2(O[et][4 * r4 + 0] * rs * gv[0] * osc, O[et][4 * r4 + 1] * rs * gv[1] * osc);
          ov[1] = pk2(O[et][4 * r4 + 2] * rs * gv[2] * osc, O[et][4 * r4 + 3] * rs * gv[3] * osc);
          *(u32x2*)(o + (tb + t) * 1024 + h * 128 + e) = ov;
        }
    }
  }
}

DI void gbar(unsigned* bar, unsigned nb, unsigned& gen) {
  asm volatile("s_waitcnt vmcnt(0)" ::: "memory");
  __syncthreads();
  if (threadIdx.x == 0) {
    __builtin_amdgcn_fence(__ATOMIC_RELEASE, "agent");
    asm volatile("s_waitcnt vmcnt(0)" ::: "memory");
    const unsigned old = __hip_atomic_fetch_add(&bar[0], 1u, __ATOMIC_RELAXED, __HIP_MEMORY_SCOPE_AGENT);
    if (old + 1u == (gen + 1u) * nb) {
      __hip_atomic_fetch_add(&bar[64], 1u, __ATOMIC_RELAXED, __HIP_MEMORY_SCOPE_AGENT);
    } else {
      unsigned sp = 0;
      while (__hip_atomic_load(&bar[64], __ATOMIC_RELAXED, __HIP_MEMORY_SCOPE_AGENT) == gen) {
        __builtin_amdgcn_s_sleep(1);
        if (++sp > (1u << 24)) break;
      }
    }
    __builtin_amdgcn_fence(__ATOMIC_ACQUIRE, "agent");
    asm volatile("s_waitcnt vmcnt(0)" ::: "memory");
  }
  __syncthreads();
  gen++;
}

__global__ void __launch_bounds__(256, 2) hybrid_fwd(Params p) {
  __shared__ __attribute__((aligned(16))) char smem[LDS_BYTES];
  cg::grid_group grid = cg::this_grid();
  const int bid = blockIdx.x, nb = gridDim.x;
  char* ws = p.ws;
  u16* w_ain = (u16*)(ws + W_AIN);
  u16* w_uk = (u16*)(ws + W_UK);
  u16* w_uv = (u16*)(ws + W_UV);
  u16* w_ao = (u16*)(ws + W_AO);
  u16* w_bin = (u16*)(ws + W_BIN);
  u16* w_bo = (u16*)(ws + W_BO);
  u16* w_w1 = (u16*)(ws + W_W1);
  u16* w_w2 = (u16*)(ws + W_W2);
  float* mod = (float*)(ws + WS_MOD);
  u16* hbuf = (u16*)(ws + WS_H);
  char* big = ws + WS_BIG;
  u16* qbuf = (u16*)(big + B_Q);
  u16* iqbuf = (u16*)(big + B_IQ);
  u16* ikbuf = (u16*)(big + B_IK);
  float* iwbuf = (float*)(big + B_IW);
  float* ckvraw = (float*)(big + B_CKVRAW);
  u16* ckvn = (u16*)(big + B_CKVN);
  u16* selbuf = (u16*)(big + B_SEL);
  u16* kbuf = (u16*)(big + B_K);
  u16* vtbuf = (u16*)(big + B_VT);
  u16* obuf = (u16*)(big + B_O);
  u16* hid = (u16*)big;
  unsigned* bar = (unsigned*)(ws + WS_BAR);
  unsigned gen = 0;

  tconv_phase(p.a_w_in, w_ain, 2, 1024, 1864, A_INP, smem, bid, nb);
  tconv_phase(p.a_w_uk, w_uk, 32, 64, 256, 256, smem, bid, nb);
  tconv_phase(p.a_w_uv, w_uv, 32, 256, 64, 64, smem, bid, nb);
  tconv_phase(p.a_w_o, w_ao, 2, 1024, 1024, 1024, smem, bid, nb);
  tconv_phase(p.b_w_in, w_bin, 2, 1024, 3072, 3072, smem, bid, nb);
  tconv_phase(p.b_w_o, w_bo, 2, 1024, 1024, 1024, smem, bid, nb);
  tconv_phase(p.mlp_w1, w_w1, 4, 1024, 4096, 4096, smem, bid, nb);
  tconv_phase(p.mlp_w2, w_w2, 4, 4096, 1024, 1024, smem, bid, nb);
  mod_phase(p, mod, smem, bid, nb);
  grid.sync();
  h0_phase(p.x, mod, hbuf, bid, nb);
  gbar(bar, nb, gen);

#pragma unroll 1
  for (int sl = 0; sl < 8; sl++) {
    const int i = sl >> 1, j = i >> 1;
    const float* modi = mod + (size_t)i * 4 * 6144;
    const u16* Ares;
    const u16* Wres;
    int Kres, goff;
    if ((sl & 1) == 0) {
      if ((i & 1) == 0) {
        EpiArgs ea{};
        ea.o0 = qbuf; ea.f0 = ckvraw; ea.o1 = iqbuf; ea.o2 = ikbuf; ea.f1 = iwbuf;
        for (int rep = 0; rep < (PROBE_DUP == 4 ? 2 : 1); rep++) gemm_phase<EPI_AIN>(hbuf, w_ain + (size_t)j * A_INP * 1024, T, A_INP, 1024, ea, smem, bid, nb);
        gbar(bar, nb, gen);
        ckvnorm_phase(ckvraw, p.a_kv_norm + j * 256, ckvn, bid, nb);
        for (int rep = 0; rep < (PROBE_DUP == 2 ? 2 : 1); rep++) indexer_phase(iqbuf, ikbuf, iwbuf, selbuf, smem, bid, nb);
        gbar(bar, nb, gen);
        for (int rep = 0; rep < (PROBE_DUP == 3 ? 2 : 1); rep++) sparse_phase(qbuf, ckvn, selbuf, w_uk + (size_t)j * 16 * 256 * 64, w_uv + (size_t)j * 16 * 256 * 64, p.rel_bias,
                     hbuf, obuf, smem, bid, nb);
        gbar(bar, nb, gen);
        Wres = w_ao + (size_t)j * 1024 * 1024;
      } else {
        EpiArgs ea{};
        ea.o0 = qbuf; ea.o1 = kbuf; ea.o2 = vtbuf;
        for (int rep = 0; rep < (PROBE_DUP == 4 ? 2 : 1); rep++) gemm_phase<EPI_BIN>(hbuf, w_bin + (size_t)j * 3072 * 1024, T, 3072, 1024, ea, smem, bid, nb);
        gbar(bar, nb, gen);
        for (int rep = 0; rep < (PROBE_DUP == 1 ? 2 : 1); rep++) diffattn_phase(qbuf, kbuf, vtbuf, obuf, p.rel_bias, p.b_lambda + j * 256, p.b_subln + j * 128, i, smem, bid, nb);
        gbar(bar, nb, gen);
        Wres = w_bo + (size_t)j * 1024 * 1024;
      }
      Ares = obuf; Kres = 1024; goff = 2 * 1024;
    } else {
      EpiArgs ea{};
      ea.o0 = hid;
      for (int rep = 0; rep < (PROBE_DUP == 4 ? 2 : 1); rep++) gemm_phase<EPI_SQRELU>(hbuf, w_w1 + (size_t)i * 4096 * 1024, T, 4096, 1024, ea, smem, bid, nb);
      gbar(bar, nb, gen);
      Ares = hid; Wres = w_w2 + (size_t)i * 4096 * 1024; Kres = 4096; goff = 5 * 1024;
    }
    {
      EpiArgs ea{};
      ea.f0 = p.out;
      ea.xin = (sl == 0) ? p.x : (const float*)p.out;
      ea.g = modi + goff;
      gemm_phase<EPI_RES>(Ares, Wres, T, 1024, Kres, ea, smem, bid, nb);
    }
    gbar(bar, nb, gen);
    {
      const float* modn = ((sl & 1) == 0) ? modi : (i < 3 ? modi + 4 * 6144 : (const float*)nullptr);
      const int sh_off = ((sl & 1) == 0) ? 3 * 1024 : 0;
      ln_phase(p.out, p.ln_g + (size_t)(i * 2 + (sl & 1)) * 1024, p.ln_b + (size_t)(i * 2 + (sl & 1)) * 1024, modn, sh_off,
               hbuf, bid, nb);
    }
    gbar(bar, nb, gen);
  }
}

extern "C" void kernel_launch(void* const* d_in, const int* in_sizes, int n_in, void* d_out, int out_size, void* d_ws,
                              size_t ws_size, hipStream_t stream) {
  static int grid_blocks = 0;
  if (!grid_blocks) {
    int dev = 0, cus = 0, per_cu = 0;
    hipGetDevice(&dev);
    hipDeviceGetAttribute(&cus, hipDeviceAttributeMultiprocessorCount, dev);
    hipOccupancyMaxActiveBlocksPerMultiprocessor(&per_cu, hybrid_fwd, 256, 0);
    if (per_cu < 1) per_cu = 1;
    if (per_cu > 2) per_cu = 2;
    grid_blocks = cus * per_cu;
    if (grid_blocks > 512) grid_blocks = 512;
  }
  Params p{};
  p.x = (const float*)d_in[0];
  p.c = (const float*)d_in[1];
  p.rel_bias = (const float*)d_in[2];
  p.ada_w = (const float*)d_in[3];
  p.ada_b = (const float*)d_in[4];
  p.ln_g = (const float*)d_in[5];
  p.ln_b = (const float*)d_in[6];
  p.a_w_in = (const float*)d_in[7];
  p.a_kv_norm = (const float*)d_in[8];
  p.a_w_uk = (const float*)d_in[9];
  p.a_w_uv = (const float*)d_in[10];
  p.a_w_o = (const float*)d_in[11];
  p.b_w_in = (const float*)d_in[12];
  p.b_lambda = (const float*)d_in[13];
  p.b_subln = (const float*)d_in[14];
  p.b_w_o = (const float*)d_in[15];
  p.mlp_w1 = (const float*)d_in[16];
  p.mlp_w2 = (const float*)d_in[17];
  p.out = (float*)d_out;
  p.ws = (char*)d_ws;
  hipMemsetAsync((char*)d_ws + WS_BAR, 0, 1024, stream);
  void* args[] = {&p};
  hipError_t e = hipLaunchCooperativeKernel((void*)hybrid_fwd, dim3(grid_blocks), dim3(256), args, 0, stream);
  if (e != hipSuccess) fprintf(stderr, "cooperative launch failed: %s (grid %d)\n", hipGetErrorString(e), grid_blocks);
}
```

```cpp
#include <hip/hip_runtime.h>
#include <hip/hip_cooperative_groups.h>
#include <stdint.h>
#include <stdio.h>
namespace cg = cooperative_groups;

typedef unsigned short u16;
typedef short bf16x8 __attribute__((ext_vector_type(8)));
typedef short s16x4 __attribute__((ext_vector_type(4)));
typedef float f32x16 __attribute__((ext_vector_type(16)));
typedef float f32x4 __attribute__((ext_vector_type(4)));
typedef float f32x2 __attribute__((ext_vector_type(2)));
typedef __bf16 bf16x2_t __attribute__((ext_vector_type(2)));
typedef unsigned u32x4 __attribute__((ext_vector_type(4)));
typedef unsigned u32x2 __attribute__((ext_vector_type(2)));
typedef __attribute__((address_space(3))) s16x4* lds_s16x4_ptr;

#define DI __device__ __forceinline__
#ifndef PROBE_DUP
#define PROBE_DUP 0
#endif

constexpr int D = 1024, NBATCH = 4, S = 8192, T = NBATCH * S;
constexpr int A_INP = 1920;
constexpr float DN_ALPHA = 1.6817928305074292f;
constexpr float LOG2E = 1.4426950408889634f;
constexpr float LN_EPS = 1e-5f;
constexpr float NEGF = -1e30f;
constexpr int TOPK = 256;
constexpr int CAP = 704;
constexpr int LDS_BYTES = 72 * 1024;

constexpr size_t MB = 1024 * 1024;
constexpr size_t W_AIN = 0;
constexpr size_t W_UK = W_AIN + (size_t)2 * 1920 * 1024 * 2;
constexpr size_t W_UV = W_UK + (size_t)2 * 16 * 256 * 64 * 2;
constexpr size_t W_AO = W_UV + (size_t)2 * 16 * 256 * 64 * 2;
constexpr size_t W_BIN = W_AO + (size_t)2 * 1024 * 1024 * 2;
constexpr size_t W_BO = W_BIN + (size_t)2 * 3072 * 1024 * 2;
constexpr size_t W_W1 = W_BO + (size_t)2 * 1024 * 1024 * 2;
constexpr size_t W_W2 = W_W1 + (size_t)4 * 4096 * 1024 * 2;
constexpr size_t WS_MOD = W_W2 + (size_t)4 * 4096 * 1024 * 2;
constexpr size_t WS_H = WS_MOD + 1 * MB;
constexpr size_t WS_BIG = WS_H + 64 * MB;
constexpr size_t WS_BAR = WS_BIG + 256 * MB;
constexpr size_t B_Q = 0;
constexpr size_t B_IQ = 64 * MB;
constexpr size_t B_IK = 96 * MB;
constexpr size_t B_IW = 100 * MB;
constexpr size_t B_CKVRAW = 104 * MB;
constexpr size_t B_CKVN = 136 * MB;
constexpr size_t B_SEL = 152 * MB;
constexpr size_t B_K = 64 * MB;
constexpr size_t B_VT = 128 * MB;
constexpr size_t B_O = 192 * MB;

struct Params {
  const float *x, *c, *rel_bias, *ada_w, *ada_b, *ln_g, *ln_b, *a_w_in, *a_kv_norm, *a_w_uk, *a_w_uv, *a_w_o, *b_w_in,
      *b_lambda, *b_subln, *b_w_o, *mlp_w1, *mlp_w2;
  float* out;
  char* ws;
};

DI int opq_tid() {
  int t = threadIdx.x;
  asm volatile("" : "+v"(t));
  return t;
}
DI unsigned pk2(float lo, float hi) {
  f32x2 v = {lo, hi};
  bf16x2_t b = __builtin_convertvector(v, bf16x2_t);
  return __builtin_bit_cast(unsigned, b);
}
DI u16 f2bf(float x) { return (u16)(pk2(x, 0.f) & 0xffffu); }
DI float wave_sum(float v) {
#pragma unroll
  for (int o = 32; o >= 1; o >>= 1) v += __shfl_xor(v, o);
  return v;
}
DI f32x16 mfma32(bf16x8 a, bf16x8 b, f32x16 c) { return __builtin_amdgcn_mfma_f32_32x32x16_bf16(a, b, c, 0, 0, 0); }
DI f32x4 mfma16(bf16x8 a, bf16x8 b, f32x4 c) { return __builtin_amdgcn_mfma_f32_16x16x32_bf16(a, b, c, 0, 0, 0); }
DI int pi_row(int r) { return (r & ~12) | ((r & 4) << 1) | ((r & 8) >> 1); }

DI int rel_bucket(int n) {
  if (n < 16) return n;
  float nf = (float)n;
  int large = 16 + (int)(logf(nf / 16.f) / 2.0794415416798357f * 16.f);
  return large < 31 ? large : 31;
}

DI void tconv_phase(const float* __restrict__ src, u16* __restrict__ dst, int batch, int R, int C, int Cpad, char* smem,
                    int bid, int nb) {
  float* tile = (float*)smem;
  const int tid = opq_tid();
  const int tr = R / 64, tc = Cpad / 64;
  const int ntiles = batch * tr * tc;
  for (int it = bid; it < ntiles; it += nb) {
    const int bi = it / (tr * tc);
    const int rem = it - bi * (tr * tc);
    const int ri = rem / tc, ci = rem - ri * tc;
    const float* s = src + (size_t)bi * R * C;
    u16* d = dst + (size_t)bi * Cpad * R;
    __syncthreads();
#pragma unroll 4
    for (int k = 0; k < 16; k++) {
      const int r = (tid >> 6) + 4 * k;
      const int cc = ci * 64 + (tid & 63);
      float v = (cc < C) ? s[(size_t)(ri * 64 + r) * C + cc] : 0.f;
      tile[r * 65 + (tid & 63)] = v;
    }
    __syncthreads();
#pragma unroll 4
    for (int k = 0; k < 16; k++) {
      const int cl = (tid >> 6) + 4 * k;
      const int rl = tid & 63;
      d[(size_t)(ci * 64 + cl) * R + ri * 64 + rl] = f2bf(tile[rl * 65 + cl]);
    }
  }
}

DI void mod_phase(const Params& p, float* mod, char* smem, int bid, int nb) {
  float* sc = (float*)smem;
  float* red = sc + 4096;
  const int tid = opq_tid(), lane = tid & 63, w = __builtin_amdgcn_readfirstlane(tid >> 6);
  __syncthreads();
  for (int i = tid; i < 4096; i += 256) {
    float v = p.c[i];
    sc[i] = v / (1.f + expf(-v));
  }
  __syncthreads();
  for (int it = bid; it < 4 * 96; it += nb) {
    const int l = it / 96, e0 = (it - l * 96) * 64;
    const float* wp = p.ada_w + ((size_t)l * 1024 + w * 256) * 6144 + e0 + lane;
    float a0 = 0, a1 = 0, a2 = 0, a3 = 0;
#pragma unroll 8
    for (int d = 0; d < 256; d++) {
      float wv = wp[(size_t)d * 6144];
      int dd = w * 256 + d;
      a0 += sc[dd] * wv;
      a1 += sc[1024 + dd] * wv;
      a2 += sc[2048 + dd] * wv;
      a3 += sc[3072 + dd] * wv;
    }
    red[(w * 4 + 0) * 64 + lane] = a0;
    red[(w * 4 + 1) * 64 + lane] = a1;
    red[(w * 4 + 2) * 64 + lane] = a2;
    red[(w * 4 + 3) * 64 + lane] = a3;
    __syncthreads();
    {
      const int b = w;
      float s = red[(0 * 4 + b) * 64 + lane] + red[(1 * 4 + b) * 64 + lane] + red[(2 * 4 + b) * 64 + lane] +
                red[(3 * 4 + b) * 64 + lane] + p.ada_b[l * 6144 + e0 + lane];
      mod[((size_t)l * 4 + b) * 6144 + e0 + lane] = s;
    }
    __syncthreads();
  }
}

DI void h0_phase(const float* __restrict__ x, const float* __restrict__ mod0, u16* __restrict__ h, int bid, int nb) {
  const size_t n8 = (size_t)T * 1024 / 8;
  for (size_t i = (size_t)bid * 256 + opq_tid(); i < n8; i += (size_t)nb * 256) {
    const size_t e = i * 8;
    const int t = (int)(e >> 10), d = (int)(e & 1023), b = t >> 13;
    const float* m = mod0 + (size_t)b * 6144;
    f32x4 v0 = *(const f32x4*)(x + e), v1 = *(const f32x4*)(x + e + 4);
    f32x4 sh0 = *(const f32x4*)(m + d), sh1 = *(const f32x4*)(m + d + 4);
    f32x4 sc0 = *(const f32x4*)(m + 1024 + d), sc1 = *(const f32x4*)(m + 1024 + d + 4);
    v0 = v0 * (1.f + sc0) + sh0;
    v1 = v1 * (1.f + sc1) + sh1;
    u32x4 o;
    o[0] = pk2(v0[0], v0[1]);
    o[1] = pk2(v0[2], v0[3]);
    o[2] = pk2(v1[0], v1[1]);
    o[3] = pk2(v1[2], v1[3]);
    *(u32x4*)(h + e) = o;
  }
}

DI void ln_phase(float* z, const float* __restrict__ g, const float* __restrict__ bt, const float* modn, int sh_off,
                 u16* __restrict__ h, int bid, int nb) {
  const int tid = opq_tid(), lane = tid & 63, w = __builtin_amdgcn_readfirstlane(tid >> 6);
  for (int row = bid * 4 + w; row < T; row += nb * 4) {
    f32x4* zp = (f32x4*)(z + (size_t)row * 1024);
    f32x4 v[4];
#pragma unroll
    for (int c = 0; c < 4; c++) v[c] = zp[c * 64 + lane];
    float s = 0;
#pragma unroll
    for (int c = 0; c < 4; c++) s += v[c][0] + v[c][1] + v[c][2] + v[c][3];
    const float mu = wave_sum(s) * (1.f / 1024.f);
    float q = 0;
#pragma unroll
    for (int c = 0; c < 4; c++) {
      v[c] = v[c] - mu;
      q += v[c][0] * v[c][0] + v[c][1] * v[c][1] + v[c][2] * v[c][2] + v[c][3] * v[c][3];
    }
    const float rstd = rsqrtf(wave_sum(q) * (1.f / 1024.f) + LN_EPS);
    const int b = row >> 13;
#pragma unroll
    for (int c = 0; c < 4; c++) {
      const int d = c * 256 + lane * 4;
      f32x4 y = v[c] * rstd * *(const f32x4*)(g + d) + *(const f32x4*)(bt + d);
      zp[c * 64 + lane] = y;
      if (modn) {
        const float* m = modn + (size_t)b * 6144 + sh_off;
        f32x4 hv = y * (1.f + *(const f32x4*)(m + 1024 + d)) + *(const f32x4*)(m + d);
        u32x2 o;
        o[0] = pk2(hv[0], hv[1]);
        o[1] = pk2(hv[2], hv[3]);
        *(u32x2*)(h + (size_t)row * 1024 + d) = o;
      }
    }
  }
}

enum { EPI_AIN = 0, EPI_BIN = 1, EPI_RES = 2, EPI_SQRELU = 3 };
struct EpiArgs {
  u16 *o0, *o1, *o2;
  float *f0, *f1;
  const float* xin;
  const float* g;
};

template <int EPI>
DI void gemm_phase(const u16* __restrict__ A, const u16* __restrict__ Bt, int M, int N, int K, const EpiArgs& ea,
                   char* smem, int bid, int nb) {
  constexpr int MI = 4, BM = 64 * MI;
  u16* As = (u16*)smem;
  u16* Bs = As + BM * 72;
  const int tid = opq_tid(), lane = tid & 63, w = __builtin_amdgcn_readfirstlane(tid >> 6), wm = w >> 1, wn = w & 1, l31 = lane & 31, lh = lane >> 5;
  const int ntn = N / 128, ntm = M / BM, nt = ntn * ntm, nk = K / 64;
  const int lr = tid >> 3, lc = (tid & 7) * 8;
  const int xcd = bid & 7, nbx = nb >> 3, cntx = (ntm >> 3) * ntn;
  (void)nt;
  for (int sq = bid >> 3; sq < cntx; sq += nbx) {
    const int tmx = sq / ntn, tn = sq - tmx * ntn;
    const int tm = tmx * 8 + xcd;
    const int m0 = tm * BM, n0 = tn * 128;
    f32x16 acc[MI][2];
#pragma unroll
    for (int i = 0; i < MI; i++)
#pragma unroll
      for (int j = 0; j < 2; j++)
#pragma unroll
        for (int r = 0; r < 16; r++) acc[i][j][r] = 0.f;
    u32x4 ra[2 * MI], rb[4];
    const u16* ap = A + (size_t)(m0 + lr) * K + lc;
    const u16* bp = Bt + (size_t)(n0 + lr) * K + lc;
#pragma unroll
    for (int i = 0; i < 2 * MI; i++) ra[i] = *(const u32x4*)(ap + (size_t)i * 32 * K);
#pragma unroll
    for (int i = 0; i < 4; i++) rb[i] = *(const u32x4*)(bp + (size_t)i * 32 * K);
    __syncthreads();
#pragma unroll
    for (int i = 0; i < 2 * MI; i++) *(u32x4*)&As[(lr + 32 * i) * 72 + lc] = ra[i];
#pragma unroll
    for (int i = 0; i < 4; i++) *(u32x4*)&Bs[(lr + 32 * i) * 72 + lc] = rb[i];
    __syncthreads();
    for (int kt = 0; kt < nk; kt++) {
      if (kt + 1 < nk) {
#pragma unroll
        for (int i = 0; i < 2 * MI; i++) ra[i] = *(const u32x4*)(ap + (size_t)i * 32 * K + (kt + 1) * 64);
#pragma unroll
        for (int i = 0; i < 4; i++) rb[i] = *(const u32x4*)(bp + (size_t)i * 32 * K + (kt + 1) * 64);
      }
#pragma unroll
      for (int ks = 0; ks < 4; ks++) {
        bf16x8 af[MI], b0, b1;
#pragma unroll
        for (int i = 0; i < MI; i++) af[i] = *(const bf16x8*)&As[(wm * 32 * MI + 32 * i + l31) * 72 + ks * 16 + lh * 8];
        b0 = *(const bf16x8*)&Bs[(wn * 64 + l31) * 72 + ks * 16 + lh * 8];
        b1 = *(const bf16x8*)&Bs[(wn * 64 + 32 + l31) * 72 + ks * 16 + lh * 8];
#pragma unroll
        for (int i = 0; i < MI; i++) {
          acc[i][0] = mfma32(b0, af[i], acc[i][0]);
          acc[i][1] = mfma32(b1, af[i], acc[i][1]);
        }
      }
      __syncthreads();
      if (kt + 1 < nk) {
#pragma unroll
        for (int i = 0; i < 2 * MI; i++) *(u32x4*)&As[(lr + 32 * i) * 72 + lc] = ra[i];
#pragma unroll
        for (int i = 0; i < 4; i++) *(u32x4*)&Bs[(lr + 32 * i) * 72 + lc] = rb[i];
        __syncthreads();
      }
    }
    const int bidx = m0 >> 13;
#pragma unroll
    for (int i = 0; i < MI; i++) {
      const int row = m0 + wm * 32 * MI + 32 * i + l31;
#pragma unroll
      for (int j = 0; j < 2; j++) {
#pragma unroll
        for (int r4 = 0; r4 < 4; r4++) {
          const int col = n0 + wn * 64 + 32 * j + 8 * r4 + 4 * lh;
          float v[4];
#pragma unroll
          for (int q = 0; q < 4; q++) v[q] = acc[i][j][4 * r4 + q];
          if (EPI == EPI_AIN) {
            if (col < 1024) {
              u32x2 o;
              o[0] = pk2(v[0], v[1]);
              o[1] = pk2(v[2], v[3]);
              *(u32x2*)(ea.o0 + (size_t)row * 1024 + col) = o;
            } else if (col < 1280) {
              *(f32x4*)(ea.f0 + (size_t)row * 256 + (col - 1024)) = (f32x4){v[0], v[1], v[2], v[3]};
            } else if (col < 1792) {
              u32x2 o;
              o[0] = pk2(v[0], v[1]);
              o[1] = pk2(v[2], v[3]);
              *(u32x2*)(ea.o1 + (size_t)row * 512 + (col - 1280)) = o;
            } else if (col < 1856) {
              const int d = col - 1792;
              const int sidx = row & 8191;
              const size_t off = (size_t)(row >> 13) * S * 64 +
                                 ((size_t)((sidx >> 5) * 4 + (d >> 4)) * 64 + 32 * ((d >> 3) & 1) + (sidx & 31)) * 8 + (d & 7);
              u32x2 o;
              o[0] = pk2(v[0], v[1]);
              o[1] = pk2(v[2], v[3]);
              *(u32x2*)(ea.o2 + off) = o;
            } else if (col < 1864) {
              const float sc = 0.044194173824159216f;
              *(f32x4*)(ea.f1 + (size_t)row * 8 + (col - 1856)) = (f32x4){v[0] * sc, v[1] * sc, v[2] * sc, v[3] * sc};
            }
          } else if (EPI == EPI_BIN) {
            if (col < 1024) {
              const float sc = 0.125f * LOG2E;
              u32x2 o;
              o[0] = pk2(v[0] * sc, v[1] * sc);
              o[1] = pk2(v[2] * sc, v[3] * sc);
              *(u32x2*)(ea.o0 + (size_t)row * 1024 + col) = o;
            } else if (col < 2048) {
              u32x2 o;
              o[0] = pk2(v[0], v[1]);
              o[1] = pk2(v[2], v[3]);
              *(u32x2*)(ea.o1 + (size_t)row * 1024 + (col - 1024)) = o;
            } else {
              const int cv = col - 2048;
#pragma unroll
              for (int q = 0; q < 4; q++) ea.o2[((size_t)bidx * 1024 + cv + q) * 8192 + (row & 8191)] = f2bf(v[q]);
            }
          } else if (EPI == EPI_RES) {
            const f32x4 gg = *(const f32x4*)(ea.g + (size_t)bidx * 6144 + col);
            const size_t o = (size_t)row * 1024 + col;
            const f32x4 xv = *(const f32x4*)(ea.xin + o);
            f32x4 r;
#pragma unroll
            for (int q = 0; q < 4; q++) r[q] = DN_ALPHA * xv[q] + (1.f + gg[q]) * v[q];
            *(f32x4*)(ea.f0 + o) = r;
          } else {
            float r[4];
#pragma unroll
            for (int q = 0; q < 4; q++) {
              r[q] = v[q] > 0.f ? v[q] : 0.f;
              r[q] = r[q] * r[q];
            }
            u32x2 o;
            o[0] = pk2(r[0], r[1]);
            o[1] = pk2(r[2], r[3]);
            *(u32x2*)(ea.o0 + (size_t)row * 4096 + col) = o;
          }
        }
      }
    }
  }
}

DI void ckvnorm_phase(const float* __restrict__ raw, const float* __restrict__ g, u16* __restrict__ outp, int bid,
                      int nb) {
  const int tid = opq_tid(), lane = tid & 63, w = __builtin_amdgcn_readfirstlane(tid >> 6);
  const f32x4 gg = *(const f32x4*)(g + lane * 4);
  for (int row = bid * 4 + w; row < T; row += nb * 4) {
    f32x4 v = *(const f32x4*)(raw + (size_t)row * 256 + lane * 4);
    float ss = v[0] * v[0] + v[1] * v[1] + v[2] * v[2] + v[3] * v[3];
    ss = wave_sum(ss);
    const float r = rsqrtf(ss * (1.f / 256.f) + LN_EPS);
    u32x2 o;
    o[0] = pk2(v[0] * r * gg[0], v[1] * r * gg[1]);
    o[1] = pk2(v[2] * r * gg[2], v[3] * r * gg[3]);
    *(u32x2*)(outp + (size_t)row * 256 + lane * 4) = o;
  }
}

DI unsigned mono_key(float s) {
  unsigned u = __float_as_uint(s);
  return (u & 0x80000000u) ? ~u : (u | 0x80000000u);
}
DI float mono_inv(unsigned k) {
  unsigned u = (k & 0x80000000u) ? (k & 0x7fffffffu) : ~k;
  return __uint_as_float(u);
}
DI float relu_i(float x) {
  int i = __float_as_int(x);
  return __int_as_float(i > 0 ? i : 0);
}
DI int wcount(bool f) { return __popcll(__ballot(f)); }

template <bool EXACT>
DI void compact4(float* vals, u16* idxs, int* cnt, int lane, float* thr_out) {
  constexpr int NPL = CAP / 64;
  unsigned key[4][NPL];
  int n[4];
#pragma unroll
  for (int q = 0; q < 4; q++) n[q] = cnt[q];
#pragma unroll
  for (int q = 0; q < 4; q++)
#pragma unroll
    for (int j = 0; j < NPL; j++) {
      const int e = j * 64 + lane;
      key[q][j] = (e < n[q]) ? mono_key(vals[q * CAP + e]) : 0u;
    }
  unsigned Tk[4] = {0u, 0u, 0u, 0u};
  constexpr int LOWBIT = EXACT ? 0 : 18;
#pragma unroll 1
  for (int bit = 31; bit >= LOWBIT; bit--) {
#pragma unroll
    for (int q = 0; q < 4; q++) {
      const unsigned cand = Tk[q] | (1u << bit);
      int c = 0;
#pragma unroll
      for (int j = 0; j < NPL; j++) c += wcount(key[q][j] >= cand);
      Tk[q] = (c >= TOPK) ? cand : Tk[q];
      if (q == 1) __builtin_amdgcn_sched_barrier(0);
    }
  }
  unsigned I[4] = {0xffffu, 0xffffu, 0xffffu, 0xffffu};
  if (EXACT) {
    unsigned ix[4][NPL];
    int need[4];
#pragma unroll
    for (int q = 0; q < 4; q++) {
      int cgt = 0;
#pragma unroll
      for (int j = 0; j < NPL; j++) {
        const int e = j * 64 + lane;
        ix[q][j] = (e < n[q]) ? (unsigned)idxs[q * CAP + e] : 0xffffu;
        cgt += wcount(key[q][j] > Tk[q]);
      }
      need[q] = TOPK - cgt;
      I[q] = 0u;
    }
#pragma unroll 1
    for (int bit = 13; bit >= 0; bit--) {
#pragma unroll
      for (int q = 0; q < 4; q++) {
        const unsigned cand = I[q] | (1u << bit);
        int c = 0;
#pragma unroll
        for (int j = 0; j < NPL; j++) c += wcount(key[q][j] == Tk[q] && ix[q][j] < cand);
        I[q] = (c < need[q]) ? cand : I[q];
        if (q == 1) __builtin_amdgcn_sched_barrier(0);
      }
    }
  }
  const unsigned long long lt = (1ull << lane) - 1ull;
#pragma unroll
  for (int q = 0; q < 4; q++) {
    if (n[q] > TOPK) {
      int base = 0;
#pragma unroll
      for (int j = 0; j < NPL; j++) {
        const int e = j * 64 + lane;
        const bool in = e < n[q];
        const float v = in ? vals[q * CAP + e] : 0.f;
        const unsigned ixv = in ? (unsigned)idxs[q * CAP + e] : 0xffffu;
        const bool keep = (key[q][j] > Tk[q]) || (key[q][j] == Tk[q] && ixv <= I[q]);
        const unsigned long long m = __ballot(keep);
        if (keep) {
          const int pos = base + __popcll(m & lt);
          vals[q * CAP + pos] = v;
          idxs[q * CAP + pos] = (u16)ixv;
        }
        base += __popcll(m);
      }
      if (lane == 0) cnt[q] = base;
      thr_out[q] = mono_inv(Tk[q]);
    }
  }
}

DI void indexer_phase(const u16* __restrict__ iq, const u16* __restrict__ ik, const float* __restrict__ iw,
                      u16* __restrict__ sel, char* smem, int bid, int nb) {
  constexpr int WBYTES = 4 * CAP * 4 + 4 * CAP * 2 + 64;
  const int tid = opq_tid(), lane = tid & 63, w = __builtin_amdgcn_readfirstlane(tid >> 6), l31 = lane & 31, u = lane >> 5;
  float* vals = (float*)(smem + w * WBYTES);
  u16* idxs = (u16*)(smem + w * WBYTES + 4 * CAP * 4);
  int* cnt = (int*)(smem + w * WBYTES + 4 * CAP * 4 + 4 * CAP * 2);
  const int nitems = NBATCH * (S / 16);
  const int nrounds = (nitems + nb - 1) / nb;
  __syncthreads();
  for (int rd = 0; rd < nrounds; rd++) {
    const int it = rd * nb + ((rd & 1) ? (nb - 1 - bid) : bid);
    if (it >= nitems) continue;
    const int b = it & 3, qg = (S / 16 - 1) - (it >> 2);
    const int t0 = qg * 16;
    const int tw = t0 + 4 * w;
    const size_t tb = (size_t)b * S;
    bf16x8 aq[4];
    {
      const int g = l31 >> 3, up = (l31 >> 2) & 1, j = l31 & 3;
      const int ql = 2 * up + (g >> 1), hd = 4 * (g & 1) + j;
      const u16* qp = iq + (tb + tw + ql) * 512 + hd * 64 + u * 8;
#pragma unroll
      for (int ks = 0; ks < 4; ks++) aq[ks] = *(const bf16x8*)(qp + ks * 16);
    }
    float wq[2][8];
#pragma unroll
    for (int qq = 0; qq < 2; qq++) {
      const float* wp = iw + (tb + tw + 2 * u + qq) * 8;
      f32x4 w0 = *(const f32x4*)wp, w1 = *(const f32x4*)(wp + 4);
#pragma unroll
      for (int h = 0; h < 4; h++) {
        wq[qq][h] = w0[h];
        wq[qq][4 + h] = w1[h];
      }
    }
    float thr[2] = {-INFINITY, -INFINITY};
    __builtin_amdgcn_wave_barrier();
    if (lane < 4) cnt[lane] = 0;
    __builtin_amdgcn_wave_barrier();
    const int nkb = (tw + 3) / 32 + 1;
    const u16* kp = ik + tb * 64 + lane * 8;
    bf16x8 ring[4][4];
#pragma unroll
    for (int i = 0; i < 4; i++) {
      const int kbn = (i < nkb) ? i : nkb - 1;
#pragma unroll
      for (int ks = 0; ks < 4; ks++) ring[i][ks] = *(const bf16x8*)(kp + (size_t)(kbn * 4 + ks) * 512);
    }
#pragma unroll 1
    for (int kb0 = 0; kb0 < nkb; kb0 += 4) {
#pragma unroll
      for (int i = 0; i < 4; i++) {
        const int kb = kb0 + i;
        {
          f32x16 acc;
#pragma unroll
          for (int r = 0; r < 16; r++) acc[r] = 0.f;
#pragma unroll
          for (int ks = 0; ks < 4; ks++) acc = mfma32(aq[ks], ring[i][ks], acc);
          {
            const int kbn = (kb + 4 < nkb) ? kb + 4 : nkb - 1;
#pragma unroll
            for (int ks = 0; ks < 4; ks++) ring[i][ks] = *(const bf16x8*)(kp + (size_t)(kbn * 4 + ks) * 512);
          }
          const int key = kb * 32 + l31;
#pragma unroll
          for (int qq = 0; qq < 2; qq++) {
            float s0 = 0.f, s1 = 0.f;
#pragma unroll
            for (int h = 0; h < 8; h += 2) {
              s0 = fmaf(wq[qq][h], relu_i(acc[8 * qq + h]), s0);
              s1 = fmaf(wq[qq][h + 1], relu_i(acc[8 * qq + h + 1]), s1);
            }
            float s = s0 + s1;
            s += 0.0f;
            const int tq = tw + 2 * u + qq;
            if (key <= tq && s >= thr[qq]) {
              const int qs = 2 * u + qq;
              const int pos = atomicAdd(&cnt[qs], 1);
              vals[qs * CAP + pos] = s;
              idxs[qs * CAP + pos] = (u16)key;
            }
          }
        }
      }
      __builtin_amdgcn_wave_barrier();
      const int c0 = cnt[0], c1 = cnt[1], c2 = cnt[2], c3 = cnt[3];
      if (c0 > CAP - 128 || c1 > CAP - 128 || c2 > CAP - 128 || c3 > CAP - 128) {
        float to[4] = {0.f, 0.f, 0.f, 0.f};
        compact4<false>(vals, idxs, cnt, lane, to);
        __builtin_amdgcn_wave_barrier();
        const int d0 = cnt[0], d1 = cnt[1], d2 = cnt[2], d3 = cnt[3];
        if (d0 > CAP - 256 || d1 > CAP - 256 || d2 > CAP - 256 || d3 > CAP - 256) {
          compact4<true>(vals, idxs, cnt, lane, to);
          __builtin_amdgcn_wave_barrier();
        }
        if (c0 > TOPK && u == 0) thr[0] = to[0];
        if (c1 > TOPK && u == 0) thr[1] = to[1];
        if (c2 > TOPK && u == 1) thr[0] = to[2];
        if (c3 > TOPK && u == 1) thr[1] = to[3];
      }
    }
    {
      const int c0 = cnt[0], c1 = cnt[1], c2 = cnt[2], c3 = cnt[3];
      if (c0 > TOPK || c1 > TOPK || c2 > TOPK || c3 > TOPK) {
        float to[4];
        compact4<true>(vals, idxs, cnt, lane, to);
        __builtin_amdgcn_wave_barrier();
      }
    }
#pragma unroll 1
    for (int qs = 0; qs < 4; qs++) {
      const int n = cnt[qs];
      u16* sp = sel + (tb + tw + qs) * 256;
#pragma unroll
      for (int j = 0; j < 4; j++) {
        const int e = j * 64 + lane;
        sp[e] = (e < n) ? idxs[qs * CAP + e] : (u16)0xffffu;
      }
    }
  }
}

DI void sparse_phase(const u16* __restrict__ q, const u16* __restrict__ ckvn, const u16* __restrict__ sel,
                     const u16* __restrict__ wuk, const u16* __restrict__ wuv, const float* __restrict__ rel_bias,
                     u16* scratch, u16* __restrict__ o, char* smem, int bid, int nb) {
  constexpr int GS = 264;
  const int tid = opq_tid(), lane = tid & 63, w = __builtin_amdgcn_readfirstlane(tid >> 6), l15 = lane & 15, g = lane >> 4;
  u16* G = (u16*)smem + (size_t)w * 32 * GS;
  int* lut = (int*)(smem + 4 * 32 * GS * 2);
  float* rb = (float*)(lut + 128);
  __syncthreads();
  if (tid < 128) lut[tid] = rel_bucket(tid);
  for (int i = tid; i < 512; i += 256) rb[i] = rel_bias[i] * LOG2E;
  __syncthreads();
  u16* ql = scratch + (size_t)bid * (16 * 16 * 256);
  const int nitems = NBATCH * (S / 16);
  for (int it = bid; it < nitems; it += nb) {
    const int b = it & 3, qg = it >> 2;
    const int t0 = qg * 16;
    const size_t tb = (size_t)b * S;
    for (int hh = 0; hh < 4; hh++) {
      const int h = 4 * w + hh;
      bf16x8 bq[2];
#pragma unroll
      for (int ks = 0; ks < 2; ks++) bq[ks] = *(const bf16x8*)(q + (tb + t0 + l15) * 1024 + h * 64 + ks * 32 + g * 8);
#pragma unroll 4
      for (int rt = 0; rt < 16; rt++) {
        f32x4 acc = {0.f, 0.f, 0.f, 0.f};
#pragma unroll
        for (int ks = 0; ks < 2; ks++) {
          bf16x8 a = *(const bf16x8*)(wuk + ((size_t)h * 256 + rt * 16 + l15) * 64 + ks * 32 + g * 8);
          acc = mfma16(a, bq[ks], acc);
        }
        u32x2 ov;
        ov[0] = pk2(acc[0] * (0.125f * LOG2E), acc[1] * (0.125f * LOG2E));
        ov[1] = pk2(acc[2] * (0.125f * LOG2E), acc[3] * (0.125f * LOG2E));
        *(u32x2*)(ql + ((size_t)l15 * 16 + h) * 256 + rt * 16 + 4 * g) = ov;
      }
    }
    __syncthreads();
    {
      const u16* selw = sel + (tb + t0 + 4 * w) * 256;
      const int l31 = lane & 31;
      const int q4 = l15 >> 2, p4 = l15 & 3;
      const u16* ckb = ckvn + tb * 256;
      int idx_c = selw[l31];
      int idx_n = selw[32 + l31];
      u32x4 gr[16];
#pragma unroll
      for (int i = 0; i < 16; i++) {
        int id = __shfl(idx_c, (lane >> 5) + 2 * i);
        id = (id == 0xffff) ? 0 : id;
        gr[i] = *(const u32x4*)(ckb + (unsigned)(id * 256 + l31 * 8));
      }
      bf16x8 qb[8];
      float m_run = NEGF, l_run = 0.f;
      f32x4 O[16];
#pragma unroll 1
      for (int st = 0; st < 32; st++) {
        const int qi = st >> 3, ch = st & 7;
        const int qloc = 4 * w + qi;
        const int t = t0 + qloc;
        if (ch == 0) {
#pragma unroll
          for (int ks = 0; ks < 8; ks++) qb[ks] = *(const bf16x8*)(ql + ((size_t)qloc * 16 + l15) * 256 + ks * 32 + g * 8);
          m_run = NEGF;
          l_run = 0.f;
#pragma unroll
          for (int rt = 0; rt < 16; rt++) O[rt] = (f32x4){0.f, 0.f, 0.f, 0.f};
        }
#pragma unroll
        for (int i = 0; i < 16; i++) *(u32x4*)&G[((lane >> 5) + 2 * i) * GS + l31 * 8] = gr[i];
        __builtin_amdgcn_wave_barrier();
        const int stn2 = (st + 2 < 32) ? st + 2 : 31;
        const int idx_nn = selw[stn2 * 32 + l31];
#pragma unroll
        for (int i = 0; i < 16; i++) {
          int id = __shfl(idx_n, (lane >> 5) + 2 * i);
          id = (id == 0xffff) ? 0 : id;
          gr[i] = *(const u32x4*)(ckb + (unsigned)(id * 256 + l31 * 8));
        }
        float lg[2][4];
#pragma unroll
        for (int kbk = 0; kbk < 2; kbk++) {
          f32x4 acc = {0.f, 0.f, 0.f, 0.f};
#pragma unroll
          for (int ks = 0; ks < 8; ks++) {
            bf16x8 a = *(const bf16x8*)&G[(16 * kbk + l15) * GS + ks * 32 + g * 8];
            acc = mfma16(a, qb[ks], acc);
            if (ks == 3) asm volatile("" ::: "memory");
          }
          asm volatile("" ::: "memory");
#pragma unroll
          for (int i = 0; i < 4; i++) {
            const int kid = __shfl(idx_c, 16 * kbk + 4 * g + i);
            float v = NEGF;
            if (kid != 0xffff) {
              int n = t - kid;
              n = n < 0 ? 0 : n;
              const int bk = n < 128 ? lut[n] : 31;
              v = acc[i] + rb[bk * 16 + l15];
            }
            lg[kbk][i] = v;
          }
        }
        float mx = fmaxf(fmaxf(fmaxf(lg[0][0], lg[0][1]), fmaxf(lg[0][2], lg[0][3])),
                         fmaxf(fmaxf(lg[1][0], lg[1][1]), fmaxf(lg[1][2], lg[1][3])));
        mx = fmaxf(mx, __shfl_xor(mx, 16));
        mx = fmaxf(mx, __shfl_xor(mx, 32));
        const float m_new = fmaxf(m_run, mx);
        const float scl = __builtin_amdgcn_exp2f(m_run - m_new);
        m_run = m_new;
        float ps = 0.f;
        float pe[8];
#pragma unroll
        for (int kbk = 0; kbk < 2; kbk++)
#pragma unroll
          for (int i = 0; i < 4; i++) {
            const float pv = __builtin_amdgcn_exp2f(lg[kbk][i] - m_new);
            pe[kbk * 4 + i] = pv;
            ps += pv;
          }
        l_run = l_run * scl + ps;
        u32x4 pw;
        pw[0] = pk2(pe[0], pe[1]);
        pw[1] = pk2(pe[2], pe[3]);
        pw[2] = pk2(pe[4], pe[5]);
        pw[3] = pk2(pe[6], pe[7]);
        const bf16x8 pB = __builtin_bit_cast(bf16x8, pw);
        if (__ballot(scl != 1.f)) {
#pragma unroll
          for (int rt = 0; rt < 16; rt++) O[rt] = O[rt] * scl;
        }
#pragma unroll
        for (int rt = 0; rt < 16; rt++) {
          const s16x4 lo = __builtin_amdgcn_ds_read_tr16_b64_v4i16((lds_s16x4_ptr)(&G[(4 * g + q4) * GS + rt * 16 + 4 * p4]));
          const s16x4 hi = __builtin_amdgcn_ds_read_tr16_b64_v4i16((lds_s16x4_ptr)(&G[(16 + 4 * g + q4) * GS + rt * 16 + 4 * p4]));
          const bf16x8 a = (bf16x8){lo[0], lo[1], lo[2], lo[3], hi[0], hi[1], hi[2], hi[3]};
          O[rt] = mfma16(a, pB, O[rt]);
          if ((rt & 3) == 3) asm volatile("" ::: "memory");
        }
        __builtin_amdgcn_wave_barrier();
        if (ch == 7) {
          float lt = l_run;
          lt += __shfl_xor(lt, 16);
          lt += __shfl_xor(lt, 32);
          const float inv = 1.f / lt;
#pragma unroll
          for (int rt = 0; rt < 16; rt++) {
            u32x2 ov;
            ov[0] = pk2(O[rt][0] * inv, O[rt][1] * inv);
            ov[1] = pk2(O[rt][2] * inv, O[rt][3] * inv);
            *(u32x2*)(ql + ((size_t)qloc * 16 + l15) * 256 + rt * 16 + 4 * g) = ov;
          }
        }
        idx_c = idx_n;
        idx_n = idx_nn;
      }
    }
    __syncthreads();
    for (int hh = 0; hh < 4; hh++) {
      const int h = 4 * w + hh;
      bf16x8 bo[8];
#pragma unroll
      for (int ks = 0; ks < 8; ks++) bo[ks] = *(const bf16x8*)(ql + ((size_t)l15 * 16 + h) * 256 + ks * 32 + g * 8);
#pragma unroll
      for (int et = 0; et < 4; et++) {
        f32x4 acc = {0.f, 0.f, 0.f, 0.f};
#pragma unroll
        for (int ks = 0; ks < 8; ks++) {
          bf16x8 a = *(const bf16x8*)(wuv + ((size_t)h * 64 + et * 16 + l15) * 256 + ks * 32 + g * 8);
          acc = mfma16(a, bo[ks], acc);
        }
        u32x2 ov;
        ov[0] = pk2(acc[0], acc[1]);
        ov[1] = pk2(acc[2], acc[3]);
        *(u32x2*)(o + (tb + t0 + l15) * 1024 + h * 64 + et * 16 + 4 * g) = ov;
      }
    }
    __syncthreads();
  }
}

DI void diffattn_phase(const u16* __restrict__ q, const u16* __restrict__ k, const u16* __restrict__ vT,
                       u16* __restrict__ o, const float* __restrict__ rel_bias, const float* __restrict__ lam,
                       const float* __restrict__ subln, int layer_idx, char* smem, int bid, int nb) {
  constexpr int KS = 136, VS = 72;
  u16* Ks = (u16*)smem;
  u16* Vs = Ks + 64 * KS;
  float* exch = (float*)smem;
  float* btab = (float*)(smem + 36 * 1024);
  int* lut = (int*)(smem + 36 * 1024 + 1040);
  float* misc = (float*)(smem + 36 * 1024 + 1040 + 512);
  const int tid = opq_tid(), lane = tid & 63, w = __builtin_amdgcn_readfirstlane(tid >> 6), l31 = lane & 31, lh = lane >> 5;
  const int qsub = w >> 1, m = w & 1;
  const float lam_init = 0.8f - 0.6f * expf(-0.3f * (float)layer_idx);
  __syncthreads();
  if (tid < 128) lut[tid] = rel_bucket(tid);
  if (w == 0) {
    float p1 = lam[lane] * lam[64 + lane], p2 = lam[128 + lane] * lam[192 + lane];
    p1 = wave_sum(p1);
    p2 = wave_sum(p2);
    if (lane == 0) misc[0] = expf(p1) - expf(p2) + lam_init;
  }
  __syncthreads();
  const float lam_full = misc[0];
  const int nitems = NBATCH * 8 * (S / 64);
  const int nrounds = (nitems + nb - 1) / nb;
  const int prow = pi_row(l31);
  for (int rd = 0; rd < nrounds; rd++) {
    const int it = rd * nb + ((rd & 1) ? (nb - 1 - bid) : bid);
    if (it >= nitems) continue;
    const int bh = it & 31, qb = (S / 64 - 1) - (it >> 5);
    const int b = bh >> 3, h = bh & 7;
    const int q0 = qb * 64, tq0 = q0 + 32 * qsub, t = tq0 + l31;
    const size_t tb = (size_t)b * S;
    __syncthreads();
    for (int i = tid; i < 258; i += 256) {
      const int n = i >> 1, mm = i & 1;
      const int bk = n < 128 ? lut[n] : 31;
      btab[i] = rel_bias[bk * 16 + 2 * h + mm] * LOG2E;
    }
    bf16x8 qf[4];
#pragma unroll
    for (int ks = 0; ks < 4; ks++) qf[ks] = *(const bf16x8*)(q + (tb + t) * 1024 + h * 128 + m * 64 + ks * 16 + lh * 8);
    f32x16 O[4];
#pragma unroll
    for (int et = 0; et < 4; et++)
#pragma unroll
      for (int r = 0; r < 16; r++) O[et][r] = 0.f;
    float m_run = NEGF, l_run = 0.f;
    const int nkt = qb + 1;
    u32x4 rk[4], rv[4];
    const u16* kp = k + tb * 1024 + h * 128;
    const u16* vp = vT + ((size_t)(b * 8 + h) * 128) * 8192;
#pragma unroll
    for (int i = 0; i < 4; i++) {
      const int id = tid + 256 * i;
      rk[i] = *(const u32x4*)(kp + (size_t)(id >> 4) * 1024 + (id & 15) * 8);
      rv[i] = *(const u32x4*)(vp + (size_t)(id >> 3) * 8192 + (id & 7) * 8);
    }
#pragma unroll
    for (int i = 0; i < 4; i++) {
      const int id = tid + 256 * i;
      *(u32x4*)&Ks[(id >> 4) * KS + (id & 15) * 8] = rk[i];
      *(u32x4*)&Vs[(id >> 3) * VS + (id & 7) * 8] = rv[i];
    }
    __syncthreads();
    const float cfar = btab[256 + m];
    for (int kt = 0; kt < nkt; kt++) {
      if (kt + 1 < nkt) {
#pragma unroll
        for (int i = 0; i < 4; i++) {
          const int id = tid + 256 * i;
          rk[i] = *(const u32x4*)(kp + (size_t)((kt + 1) * 64 + (id >> 4)) * 1024 + (id & 15) * 8);
          rv[i] = *(const u32x4*)(vp + (size_t)(id >> 3) * 8192 + (kt + 1) * 64 + (id & 7) * 8);
        }
      }
      const int s_tile = kt * 64;
      const int nblk = (s_tile + 32 <= tq0 + 31) ? 2 : 1;
#pragma unroll 1
      for (int kb = 0; kb < nblk; kb++) {
        f32x16 acc;
#pragma unroll
        for (int r = 0; r < 16; r++) acc[r] = 0.f;
#pragma unroll
        for (int ks = 0; ks < 4; ks++) {
          bf16x8 a = *(const bf16x8*)&Ks[(32 * kb + prow) * KS + m * 64 + ks * 16 + lh * 8];
          acc = mfma32(a, qf[ks], acc);
        }
        const int s0 = s_tile + 32 * kb;
        const bool nearb = (tq0 - (s0 + 31)) < 128;
        if (nearb) {
#pragma unroll
          for (int r = 0; r < 16; r++) {
            const int key = s0 + 16 * (r >> 3) + 8 * lh + (r & 7);
            const int n = t - key;
            const int nc = n < 0 ? 0 : (n > 128 ? 128 : n);
            const float bv = btab[nc * 2 + m];
            acc[r] = (n < 0) ? NEGF : acc[r] + bv;
          }
        } else {
#pragma unroll
          for (int r = 0; r < 16; r++) acc[r] += cfar;
        }
        float mx = acc[0];
#pragma unroll
        for (int r = 1; r < 16; r++) mx = fmaxf(mx, acc[r]);
        mx = fmaxf(mx, __shfl_xor(mx, 32));
        const float m_new = fmaxf(m_run, mx);
        const float scl = __builtin_amdgcn_exp2f(m_run - m_new);
        m_run = m_new;
        float ps = 0.f;
#pragma unroll
        for (int r = 0; r < 16; r++) {
          const float pv = __builtin_amdgcn_exp2f(acc[r] - m_new);
          acc[r] = pv;
          ps += pv;
        }
        l_run = l_run * scl + ps;
        if (__ballot(scl != 1.f)) {
#pragma unroll
          for (int et = 0; et < 4; et++)
#pragma unroll
            for (int r = 0; r < 16; r++) O[et][r] *= scl;
        }
#pragma unroll
        for (int s2 = 0; s2 < 2; s2++) {
          u32x4 pw;
          pw[0] = pk2(acc[8 * s2 + 0], acc[8 * s2 + 1]);
          pw[1] = pk2(acc[8 * s2 + 2], acc[8 * s2 + 3]);
          pw[2] = pk2(acc[8 * s2 + 4], acc[8 * s2 + 5]);
          pw[3] = pk2(acc[8 * s2 + 6], acc[8 * s2 + 7]);
          const bf16x8 pB = __builtin_bit_cast(bf16x8, pw);
#pragma unroll
          for (int et = 0; et < 4; et++) {
            bf16x8 a = *(const bf16x8*)&Vs[(32 * et + l31) * VS + 32 * kb + 16 * s2 + 8 * lh];
            O[et] = mfma32(a, pB, O[et]);
          }
        }
      }
      __syncthreads();
      if (kt + 1 < nkt) {
#pragma unroll
        for (int i = 0; i < 4; i++) {
          const int id = tid + 256 * i;
          *(u32x4*)&Ks[(id >> 4) * KS + (id & 15) * 8] = rk[i];
          *(u32x4*)&Vs[(id >> 3) * VS + (id & 7) * 8] = rv[i];
        }
        __syncthreads();
      }
    }
    float lt = l_run + __shfl_xor(l_run, 32);
    const float inv = 1.f / lt;
    if (m == 1) {
#pragma unroll
      for (int et = 0; et < 4; et++)
#pragma unroll
        for (int r = 0; r < 16; r++) {
          const int e = 32 * et + (r & 3) + 8 * (r >> 2) + 4 * lh;
          exch[(qsub * 128 + e) * 32 + l31] = O[et][r] * inv;
        }
    }
    __syncthreads();
    if (m == 0) {
      float ss = 0.f;
#pragma unroll
      for (int et = 0; et < 4; et++)
#pragma unroll
        for (int r = 0; r < 16; r++) {
          const int e = 32 * et + (r & 3) + 8 * (r >> 2) + 4 * lh;
          const float v = O[et][r] * inv - lam_full * exch[(qsub * 128 + e) * 32 + l31];
          O[et][r] = v;
          ss += v * v;
        }
      ss += __shfl_xor(ss, 32);
      const float rs = rsqrtf(ss * (1.f / 128.f) + LN_EPS);
      const float osc = 1.f - lam_init;
#pragma unroll
      for (int et = 0; et < 4; et++)
#pragma unroll
        for (int r4 = 0; r4 < 4; r4++) {
          const int e = 32 * et + 8 * r4 + 4 * lh;
          const f32x4 gv = *(const f32x4*)(subln + e);
          u32x2 ov;
          ov[0] = pk2(O[et][4 * r4 + 0] * rs * gv[0] * osc, O[et][4 * r4 + 1] * rs * gv[1] * osc);
          ov[1] = pk2(O[et][4 * r4 + 2] * rs * gv[2] * osc, O[et][4 * r4 + 3] * rs * gv[3] * osc);
          *(u32x2*)(o + (tb + t) * 1024 + h * 128 + e) = ov;
        }
    }
  }
}

#define XB_TMO      128
#define XB_XCNT(j)  (256  + 64 * (j))
#define XB_XSUB(j)  (1280 + 64 * (j))
#define XB_XGEN(j)  (2304 + 64 * (j))
#define XB_TOP      3328
#define XB_TOPGEN   3392
#define XCD_BAR_WORDS 3456
#define XB_SPIN_CAP (1u << 20)
#define LAS __attribute__((address_space(3)))
DI unsigned xb_ld(unsigned* p) { return __hip_atomic_load(p, __ATOMIC_RELAXED, __HIP_MEMORY_SCOPE_AGENT); }
DI unsigned xb_add(unsigned* p, unsigned v) { return __hip_atomic_fetch_add(p, v, __ATOMIC_RELAXED, __HIP_MEMORY_SCOPE_AGENT); }
DI unsigned xb_xcc_id() { return (unsigned)__builtin_amdgcn_s_getreg((3 << 11) | 20) & 0xFu; }
#define XB_SPIN(cond, bar) do { unsigned _sp = 0; while (cond) { __builtin_amdgcn_s_sleep(1); \
    if ((++_sp & 255u) == 0u) { if (xb_ld(&(bar)[XB_TMO])) break; if (_sp > XB_SPIN_CAP) { atomicAdd(&(bar)[XB_TMO], 1u); break; } } } } while (0)
struct XcdBarrier {
  unsigned* bar;
  unsigned x;
  volatile LAS unsigned* st;
};
DI XcdBarrier xcd_barrier_post(unsigned* bar, volatile LAS unsigned* st) {
  XcdBarrier b;
  b.bar = bar;
  b.x = xb_xcc_id();
  b.st = st;
  if (threadIdx.x == 0) (void)xb_add(&bar[XB_XCNT(b.x)], 1u);
  return b;
}
DI void xcd_barrier_complete(unsigned* bar, unsigned x, unsigned& nloc, unsigned& nx) {
  const unsigned G = gridDim.x * gridDim.y * gridDim.z;
  unsigned sum, cnt, mine, sp = 0u;
  for (;;) {
    sum = 0u; cnt = 0u; mine = 0u;
#pragma unroll
    for (unsigned j = 0; j < 16; ++j) {
      const unsigned c = xb_ld(&bar[XB_XCNT(j)]);
      sum += c;
      cnt += (c > 0u) ? 1u : 0u;
      mine = (j == x) ? c : mine;
    }
    if (sum == G) break;
    __builtin_amdgcn_s_sleep(1);
    if ((++sp & 255u) == 0u) { if (xb_ld(&bar[XB_TMO])) break; if (sp > XB_SPIN_CAP) { atomicAdd(&bar[XB_TMO], 1u); break; } }
  }
  nloc = mine > 0u ? mine : 1u;
  nx = cnt > 0u ? cnt : 1u;
}
DI void xcd_barrier(const XcdBarrier& b0) {
  asm volatile("s_waitcnt vmcnt(0)" ::: "memory");
  __syncthreads();
  if (threadIdx.x == 0) {
    XcdBarrier b = b0;
    b.x = __builtin_amdgcn_readfirstlane(xb_xcc_id());
    unsigned* bar = b.bar;
    asm volatile("" : "+s"(bar));
    __builtin_amdgcn_s_waitcnt(0);
    unsigned nloc = b.st[0], nx = b.st[1];
    if (nloc == 0u) { xcd_barrier_complete(bar, b.x, nloc, nx); b.st[0] = nloc; b.st[1] = nx; }
    const unsigned old = xb_add(&bar[XB_XSUB(b.x)], 1u);
    const unsigned gen = old / nloc;
    if (old + 1u == (gen + 1u) * nloc) {
      __builtin_amdgcn_fence(__ATOMIC_RELEASE, "agent");
      asm volatile("s_waitcnt vmcnt(0)" ::: "memory");
      const unsigned og = xb_add(&bar[XB_TOP], 1u);
      const unsigned tg = og / nx;
      if (og + 1u == (tg + 1u) * nx) xb_add(&bar[XB_TOPGEN], 1u);
      else XB_SPIN(xb_ld(&bar[XB_TOPGEN]) == tg, bar);
      __builtin_amdgcn_fence(__ATOMIC_ACQUIRE, "agent");
      xb_add(&bar[XB_XGEN(b.x)], 1u);
      asm volatile("s_waitcnt vmcnt(0)" ::: "memory");
    } else {
      XB_SPIN(xb_ld(&bar[XB_XGEN(b.x)]) == gen, bar);
      __builtin_amdgcn_fence(__ATOMIC_ACQUIRE, "agent");
      asm volatile("s_waitcnt vmcnt(0)" ::: "memory");
    }
  }
  __syncthreads();
}

#define DECL_WS_PTRS(ws) \
  u16* w_ain = (u16*)(ws + W_AIN); \
  u16* w_uk = (u16*)(ws + W_UK); \
  u16* w_uv = (u16*)(ws + W_UV); \
  u16* w_ao = (u16*)(ws + W_AO); \
  u16* w_bin = (u16*)(ws + W_BIN); \
  u16* w_bo = (u16*)(ws + W_BO); \
  u16* w_w1 = (u16*)(ws + W_W1); \
  u16* w_w2 = (u16*)(ws + W_W2); \
  float* mod = (float*)(ws + WS_MOD); \
  u16* hbuf = (u16*)(ws + WS_H); \
  char* big = ws + WS_BIG; \
  u16* qbuf = (u16*)(big + B_Q); \
  u16* iqbuf = (u16*)(big + B_IQ); \
  u16* ikbuf = (u16*)(big + B_IK); \
  float* iwbuf = (float*)(big + B_IW); \
  float* ckvraw = (float*)(big + B_CKVRAW); \
  u16* ckvn = (u16*)(big + B_CKVN); \
  u16* selbuf = (u16*)(big + B_SEL); \
  u16* kbuf = (u16*)(big + B_K); \
  u16* vtbuf = (u16*)(big + B_VT); \
  u16* obuf = (u16*)(big + B_O); \
  u16* hid = (u16*)big;

__global__ void __launch_bounds__(256, 2) hybrid_fwd(Params p) {
  __shared__ __attribute__((aligned(16))) char smem[LDS_BYTES];
  cg::grid_group grid = cg::this_grid();
  const int bid = blockIdx.x, nb = gridDim.x;
  char* ws = p.ws;
  unsigned* bar = (unsigned*)(ws + WS_BAR);
  volatile LAS unsigned* xst = (volatile LAS unsigned*)(smem + LDS_BYTES - 16);
  if (threadIdx.x < 2) xst[threadIdx.x] = 0u;
  __syncthreads();
  const XcdBarrier xb = xcd_barrier_post(bar, xst);

  {
  DECL_WS_PTRS(ws)
  (void)qbuf; (void)iqbuf; (void)ikbuf; (void)iwbuf; (void)ckvraw; (void)ckvn; (void)selbuf; (void)kbuf; (void)vtbuf; (void)obuf; (void)hid;
  tconv_phase(p.a_w_in, w_ain, 2, 1024, 1864, A_INP, smem, bid, nb);
  tconv_phase(p.a_w_uk, w_uk, 32, 64, 256, 256, smem, bid, nb);
  tconv_phase(p.a_w_uv, w_uv, 32, 256, 64, 64, smem, bid, nb);
  tconv_phase(p.a_w_o, w_ao, 2, 1024, 1024, 1024, smem, bid, nb);
  tconv_phase(p.b_w_in, w_bin, 2, 1024, 3072, 3072, smem, bid, nb);
  tconv_phase(p.b_w_o, w_bo, 2, 1024, 1024, 1024, smem, bid, nb);
  tconv_phase(p.mlp_w1, w_w1, 4, 1024, 4096, 4096, smem, bid, nb);
  tconv_phase(p.mlp_w2, w_w2, 4, 4096, 1024, 1024, smem, bid, nb);
  mod_phase(p, mod, smem, bid, nb);
  grid.sync();
  h0_phase(p.x, mod, hbuf, bid, nb);
  xcd_barrier(xb);
  }

#pragma unroll 1
  for (int sl = 0; sl < 8; sl++) {
    char* wsl = p.ws;
    asm volatile("" : "+s"(wsl));
    DECL_WS_PTRS(wsl)
    const int i = sl >> 1, j = i >> 1;
    const float* modi = mod + (size_t)i * 4 * 6144;
    const u16* Ares;
    const u16* Wres;
    int Kres, goff;
    if ((sl & 1) == 0) {
      if ((i & 1) == 0) {
        EpiArgs ea{};
        ea.o0 = qbuf; ea.f0 = ckvraw; ea.o1 = iqbuf; ea.o2 = ikbuf; ea.f1 = iwbuf;
        for (int rep = 0; rep < (PROBE_DUP == 4 ? 2 : 1); rep++) gemm_phase<EPI_AIN>(hbuf, w_ain + (size_t)j * A_INP * 1024, T, A_INP, 1024, ea, smem, bid, nb);
        xcd_barrier(xb);
        ckvnorm_phase(ckvraw, p.a_kv_norm + j * 256, ckvn, bid, nb);
        for (int rep = 0; rep < (PROBE_DUP == 2 ? 2 : 1); rep++) indexer_phase(iqbuf, ikbuf, iwbuf, selbuf, smem, bid, nb);
        xcd_barrier(xb);
        for (int rep = 0; rep < (PROBE_DUP == 3 ? 2 : 1); rep++) sparse_phase(qbuf, ckvn, selbuf, w_uk + (size_t)j * 16 * 256 * 64, w_uv + (size_t)j * 16 * 256 * 64, p.rel_bias,
                     hbuf, obuf, smem, bid, nb);
        xcd_barrier(xb);
        Wres = w_ao + (size_t)j * 1024 * 1024;
      } else {
        EpiArgs ea{};
        ea.o0 = qbuf; ea.o1 = kbuf; ea.o2 = vtbuf;
        for (int rep = 0; rep < (PROBE_DUP == 4 ? 2 : 1); rep++) gemm_phase<EPI_BIN>(hbuf, w_bin + (size_t)j * 3072 * 1024, T, 3072, 1024, ea, smem, bid, nb);
        xcd_barrier(xb);
        for (int rep = 0; rep < (PROBE_DUP == 1 ? 2 : 1); rep++) diffattn_phase(qbuf, kbuf, vtbuf, obuf, p.rel_bias, p.b_lambda + j * 256, p.b_subln + j * 128, i, smem, bid, nb);
        xcd_barrier(xb);
        Wres = w_bo + (size_t)j * 1024 * 1024;
      }
      Ares = obuf; Kres = 1024; goff = 2 * 1024;
    } else {
      EpiArgs ea{};
      ea.o0 = hid;
      for (int rep = 0; rep < (PROBE_DUP == 4 ? 2 : 1); rep++) gemm_phase<EPI_SQRELU>(hbuf, w_w1 + (size_t)i * 4096 * 1024, T, 4096, 1024, ea, smem, bid, nb);
      xcd_barrier(xb);
      Ares = hid; Wres = w_w2 + (size_t)i * 4096 * 1024; Kres = 4096; goff = 5 * 1024;
    }
    {
      EpiArgs ea{};
      ea.f0 = p.out;
      ea.xin = (sl == 0) ? p.x : (const float*)p.out;
      ea.g = modi + goff;
      gemm_phase<EPI_RES>(Ares, Wres, T, 1024, Kres, ea, smem, bid, nb);
    }
    xcd_barrier(xb);
    {
      const float* modn = ((sl & 1) == 0) ? modi : (i < 3 ? modi + 4 * 6144 : (const float*)nullptr);
      const int sh_off = ((sl & 1) == 0) ? 3 * 1024 : 0;
      ln_phase(p.out, p.ln_g + (size_t)(i * 2 + (sl & 1)) * 1024, p.ln_b + (size_t)(i * 2 + (sl & 1)) * 1024, modn, sh_off,
               hbuf, bid, nb);
    }
    xcd_barrier(xb);
  }
}

extern "C" void kernel_launch(void* const* d_in, const int* in_sizes, int n_in, void* d_out, int out_size, void* d_ws,
                              size_t ws_size, hipStream_t stream) {
  static int grid_blocks = 0;
  if (!grid_blocks) {
    int dev = 0, cus = 0, per_cu = 0;
    hipGetDevice(&dev);
    hipDeviceGetAttribute(&cus, hipDeviceAttributeMultiprocessorCount, dev);
    hipOccupancyMaxActiveBlocksPerMultiprocessor(&per_cu, hybrid_fwd, 256, 0);
    if (per_cu < 1) per_cu = 1;
    if (per_cu > 2) per_cu = 2;
    grid_blocks = cus * per_cu;
    if (grid_blocks > 512) grid_blocks = 512;
  }
  Params p{};
  p.x = (const float*)d_in[0];
  p.c = (const float*)d_in[1];
  p.rel_bias = (const float*)d_in[2];
  p.ada_w = (const float*)d_in[3];
  p.ada_b = (const float*)d_in[4];
  p.ln_g = (const float*)d_in[5];
  p.ln_b = (const float*)d_in[6];
  p.a_w_in = (const float*)d_in[7];
  p.a_kv_norm = (const float*)d_in[8];
  p.a_w_uk = (const float*)d_in[9];
  p.a_w_uv = (const float*)d_in[10];
  p.a_w_o = (const float*)d_in[11];
  p.b_w_in = (const float*)d_in[12];
  p.b_lambda = (const float*)d_in[13];
  p.b_subln = (const float*)d_in[14];
  p.b_w_o = (const float*)d_in[15];
  p.mlp_w1 = (const float*)d_in[16];
  p.mlp_w2 = (const float*)d_in[17];
  p.out = (float*)d_out;
  p.ws = (char*)d_ws;
  hipMemsetAsync((char*)d_ws + WS_BAR, 0, XCD_BAR_WORDS * 4, stream);
  void* args[] = {&p};
  hipError_t e = hipLaunchCooperativeKernel((void*)hybrid_fwd, dim3(grid_blocks), dim3(256), args, 0, stream);
  if (e != hipSuccess) fprintf(stderr, "cooperative launch failed: %s (grid %d)\n", hipGetErrorString(e), grid_blocks);
}
```

```cpp
#include <hip/hip_runtime.h>
#include <hip/hip_cooperative_groups.h>
#include <stdint.h>
#include <stdio.h>
namespace cg = cooperative_groups;

typedef unsigned short u16;
typedef short bf16x8 __attribute__((ext_vector_type(8)));
typedef short s16x4 __attribute__((ext_vector_type(4)));
typedef float f32x16 __attribute__((ext_vector_type(16)));
typedef float f32x4 __attribute__((ext_vector_type(4)));
typedef float f32x2 __attribute__((ext_vector_type(2)));
typedef __bf16 bf16x2_t __attribute__((ext_vector_type(2)));
typedef unsigned u32x4 __attribute__((ext_vector_type(4)));
typedef unsigned u32x2 __attribute__((ext_vector_type(2)));
typedef __attribute__((address_space(3))) s16x4* lds_s16x4_ptr;

#define DI __device__ __forceinline__
#ifndef PROBE_DUP
#define PROBE_DUP 0
#endif

constexpr int D = 1024, NBATCH = 4, S = 8192, T = NBATCH * S;
constexpr int A_INP = 1920;
constexpr float DN_ALPHA = 1.6817928305074292f;
constexpr float LOG2E = 1.4426950408889634f;
constexpr float LN_EPS = 1e-5f;
constexpr float NEGF = -1e30f;
constexpr int TOPK = 256;
constexpr int CAP = 704;
constexpr int LDS_BYTES = 72 * 1024;

constexpr size_t MB = 1024 * 1024;
constexpr size_t W_AIN = 0;
constexpr size_t W_UK = W_AIN + (size_t)2 * 1920 * 1024 * 2;
constexpr size_t W_UV = W_UK + (size_t)2 * 16 * 256 * 64 * 2;
constexpr size_t W_AO = W_UV + (size_t)2 * 16 * 256 * 64 * 2;
constexpr size_t W_BIN = W_AO + (size_t)2 * 1024 * 1024 * 2;
constexpr size_t W_BO = W_BIN + (size_t)2 * 3072 * 1024 * 2;
constexpr size_t W_W1 = W_BO + (size_t)2 * 1024 * 1024 * 2;
constexpr size_t W_W2 = W_W1 + (size_t)4 * 4096 * 1024 * 2;
constexpr size_t WS_MOD = W_W2 + (size_t)4 * 4096 * 1024 * 2;
constexpr size_t WS_H = WS_MOD + 1 * MB;
constexpr size_t WS_BIG = WS_H + 64 * MB;
constexpr size_t WS_BAR = WS_BIG + 256 * MB;
constexpr size_t B_Q = 0;
constexpr size_t B_IQ = 64 * MB;
constexpr size_t B_IK = 96 * MB;
constexpr size_t B_IW = 100 * MB;
constexpr size_t B_CKVRAW = 104 * MB;
constexpr size_t B_CKVN = 136 * MB;
constexpr size_t B_SEL = 152 * MB;
constexpr size_t B_K = 64 * MB;
constexpr size_t B_VT = 128 * MB;
constexpr size_t B_O = 192 * MB;

struct Params {
  const float *x, *c, *rel_bias, *ada_w, *ada_b, *ln_g, *ln_b, *a_w_in, *a_kv_norm, *a_w_uk, *a_w_uv, *a_w_o, *b_w_in,
      *b_lambda, *b_subln, *b_w_o, *mlp_w1, *mlp_w2;
  float* out;
  char* ws;
};

DI int opq_tid() {
  int t = threadIdx.x;
  asm volatile("" : "+v"(t));
  return t;
}
DI unsigned pk2(float lo, float hi) {
  f32x2 v = {lo, hi};
  bf16x2_t b = __builtin_convertvector(v, bf16x2_t);
  return __builtin_bit_cast(unsigned, b);
}
DI u16 f2bf(float x) { return (u16)(pk2(x, 0.f) & 0xffffu); }
DI float wave_sum(float v) {
#pragma unroll
  for (int o = 32; o >= 1; o >>= 1) v += __shfl_xor(v, o);
  return v;
}
DI f32x16 mfma32(bf16x8 a, bf16x8 b, f32x16 c) { return __builtin_amdgcn_mfma_f32_32x32x16_bf16(a, b, c, 0, 0, 0); }
DI f32x4 mfma16(bf16x8 a, bf16x8 b, f32x4 c) { return __builtin_amdgcn_mfma_f32_16x16x32_bf16(a, b, c, 0, 0, 0); }
DI int pi_row(int r) { return (r & ~12) | ((r & 4) << 1) | ((r & 8) >> 1); }

DI int rel_bucket(int n) {
  if (n < 16) return n;
  float nf = (float)n;
  int large = 16 + (int)(logf(nf / 16.f) / 2.0794415416798357f * 16.f);
  return large < 31 ? large : 31;
}

DI void tconv_phase(const float* __restrict__ src, u16* __restrict__ dst, int batch, int R, int C, int Cpad, char* smem,
                    int bid, int nb) {
  float* tile = (float*)smem;
  const int tid = opq_tid();
  const int tr = R / 64, tc = Cpad / 64;
  const int ntiles = batch * tr * tc;
  for (int it = bid; it < ntiles; it += nb) {
    const int bi = it / (tr * tc);
    const int rem = it - bi * (tr * tc);
    const int ri = rem / tc, ci = rem - ri * tc;
    const float* s = src + (size_t)bi * R * C;
    u16* d = dst + (size_t)bi * Cpad * R;
    __syncthreads();
#pragma unroll
    for (int k = 0; k < 4; k++) {
      const int r = (tid >> 4) + 16 * k;
      const int cl = (tid & 15) * 4;
      const int cc = ci * 64 + cl;
      f32x4 v = {0.f, 0.f, 0.f, 0.f};
      if (cc < C) v = *(const f32x4*)(s + (size_t)(ri * 64 + r) * C + cc);
      tile[r * 65 + cl + 0] = v[0];
      tile[r * 65 + cl + 1] = v[1];
      tile[r * 65 + cl + 2] = v[2];
      tile[r * 65 + cl + 3] = v[3];
    }
    __syncthreads();
#pragma unroll
    for (int k = 0; k < 2; k++) {
      const int cl = (tid >> 3) + 32 * k;
      const int r8 = (tid & 7) * 8;
      u32x4 o;
      o[0] = pk2(tile[(r8 + 0) * 65 + cl], tile[(r8 + 1) * 65 + cl]);
      o[1] = pk2(tile[(r8 + 2) * 65 + cl], tile[(r8 + 3) * 65 + cl]);
      o[2] = pk2(tile[(r8 + 4) * 65 + cl], tile[(r8 + 5) * 65 + cl]);
      o[3] = pk2(tile[(r8 + 6) * 65 + cl], tile[(r8 + 7) * 65 + cl]);
      *(u32x4*)(d + (size_t)(ci * 64 + cl) * R + ri * 64 + r8) = o;
    }
  }
}

DI void mod_phase(const Params& p, float* mod, char* smem, int bid, int nb) {
  float* sc = (float*)smem;
  float* red = sc + 4096;
  const int tid = opq_tid(), lane = tid & 63, w = __builtin_amdgcn_readfirstlane(tid >> 6);
  __syncthreads();
  for (int i = tid; i < 4096; i += 256) {
    float v = p.c[i];
    sc[i] = v / (1.f + expf(-v));
  }
  __syncthreads();
  for (int it = bid; it < 4 * 384; it += nb) {
    const int l = it / 384, e0 = (it - l * 384) * 16;
    const int ds = lane >> 4, ec = lane & 15;
    const float* wp = p.ada_w + ((size_t)l * 1024 + w * 256 + ds) * 6144 + e0 + ec;
    float a0 = 0, a1 = 0, a2 = 0, a3 = 0;
#pragma unroll 16
    for (int d = 0; d < 64; d++) {
      float wv = wp[(size_t)(4 * d) * 6144];
      int dd = w * 256 + 4 * d + ds;
      a0 += sc[dd] * wv;
      a1 += sc[1024 + dd] * wv;
      a2 += sc[2048 + dd] * wv;
      a3 += sc[3072 + dd] * wv;
    }
    a0 += __shfl_xor(a0, 16); a0 += __shfl_xor(a0, 32);
    a1 += __shfl_xor(a1, 16); a1 += __shfl_xor(a1, 32);
    a2 += __shfl_xor(a2, 16); a2 += __shfl_xor(a2, 32);
    a3 += __shfl_xor(a3, 16); a3 += __shfl_xor(a3, 32);
    if (lane < 16) {
      red[(w * 4 + 0) * 16 + lane] = a0;
      red[(w * 4 + 1) * 16 + lane] = a1;
      red[(w * 4 + 2) * 16 + lane] = a2;
      red[(w * 4 + 3) * 16 + lane] = a3;
    }
    __syncthreads();
    if (tid < 64) {
      const int b = tid >> 4, e = tid & 15;
      float sm = red[(0 * 4 + b) * 16 + e] + red[(1 * 4 + b) * 16 + e] + red[(2 * 4 + b) * 16 + e] + red[(3 * 4 + b) * 16 + e] +
                 p.ada_b[l * 6144 + e0 + e];
      mod[((size_t)l * 4 + b) * 6144 + e0 + e] = sm;
    }
    __syncthreads();
  }
}

DI void h0_phase(const float* __restrict__ x, const float* __restrict__ mod0, u16* __restrict__ h, int bid, int nb) {
  const size_t n8 = (size_t)T * 1024 / 8;
  for (size_t i = (size_t)bid * 256 + opq_tid(); i < n8; i += (size_t)nb * 256) {
    const size_t e = i * 8;
    const int t = (int)(e >> 10), d = (int)(e & 1023), b = t >> 13;
    const float* m = mod0 + (size_t)b * 6144;
    f32x4 v0 = *(const f32x4*)(x + e), v1 = *(const f32x4*)(x + e + 4);
    f32x4 sh0 = *(const f32x4*)(m + d), sh1 = *(const f32x4*)(m + d + 4);
    f32x4 sc0 = *(const f32x4*)(m + 1024 + d), sc1 = *(const f32x4*)(m + 1024 + d + 4);
    v0 = v0 * (1.f + sc0) + sh0;
    v1 = v1 * (1.f + sc1) + sh1;
    u32x4 o;
    o[0] = pk2(v0[0], v0[1]);
    o[1] = pk2(v0[2], v0[3]);
    o[2] = pk2(v1[0], v1[1]);
    o[3] = pk2(v1[2], v1[3]);
    *(u32x4*)(h + e) = o;
  }
}

DI void ln_phase(float* z, const float* __restrict__ g, const float* __restrict__ bt, const float* modn, int sh_off,
                 u16* __restrict__ h, int bid, int nb) {
  const int tid = opq_tid(), lane = tid & 63, w = __builtin_amdgcn_readfirstlane(tid >> 6);
  for (int row = bid * 4 + w; row < T; row += nb * 4) {
    f32x4* zp = (f32x4*)(z + (size_t)row * 1024);
    f32x4 v[4];
#pragma unroll
    for (int c = 0; c < 4; c++) v[c] = zp[c * 64 + lane];
    float s = 0;
#pragma unroll
    for (int c = 0; c < 4; c++) s += v[c][0] + v[c][1] + v[c][2] + v[c][3];
    const float mu = wave_sum(s) * (1.f / 1024.f);
    float q = 0;
#pragma unroll
    for (int c = 0; c < 4; c++) {
      v[c] = v[c] - mu;
      q += v[c][0] * v[c][0] + v[c][1] * v[c][1] + v[c][2] * v[c][2] + v[c][3] * v[c][3];
    }
    const float rstd = rsqrtf(wave_sum(q) * (1.f / 1024.f) + LN_EPS);
    const int b = row >> 13;
#pragma unroll
    for (int c = 0; c < 4; c++) {
      const int d = c * 256 + lane * 4;
      f32x4 y = v[c] * rstd * *(const f32x4*)(g + d) + *(const f32x4*)(bt + d);
      zp[c * 64 + lane] = y;
      if (modn) {
        const float* m = modn + (size_t)b * 6144 + sh_off;
        f32x4 hv = y * (1.f + *(const f32x4*)(m + 1024 + d)) + *(const f32x4*)(m + d);
        u32x2 o;
        o[0] = pk2(hv[0], hv[1]);
        o[1] = pk2(hv[2], hv[3]);
        *(u32x2*)(h + (size_t)row * 1024 + d) = o;
      }
    }
  }
}

enum { EPI_AIN = 0, EPI_BIN = 1, EPI_RES = 2, EPI_SQRELU = 3 };
struct EpiArgs {
  u16 *o0, *o1, *o2;
  float *f0, *f1;
  const float* xin;
  const float* g;
};

template <int EPI>
DI void gemm_phase(const u16* __restrict__ A, const u16* __restrict__ Bt, int M, int N, int K, const EpiArgs& ea,
                   char* smem, int bid, int nb) {
  constexpr int MI = 4, BM = 64 * MI;
  u16* As = (u16*)smem;
  u16* Bs = As + BM * 72;
  const int tid = opq_tid(), lane = tid & 63, w = __builtin_amdgcn_readfirstlane(tid >> 6), wm = w >> 1, wn = w & 1, l31 = lane & 31, lh = lane >> 5;
  const int ntn = N / 128, ntm = M / BM, nt = ntn * ntm, nk = K / 64;
  const int lr = tid >> 3, lc = (tid & 7) * 8;
  const int xcd = bid & 7, nbx = nb >> 3, cntx = (ntm >> 3) * ntn;
  (void)nt;
  for (int sq = bid >> 3; sq < cntx; sq += nbx) {
    const int tmx = sq / ntn, tn = sq - tmx * ntn;
    const int tm = tmx * 8 + xcd;
    const int m0 = tm * BM, n0 = tn * 128;
    f32x16 acc[MI][2];
#pragma unroll
    for (int i = 0; i < MI; i++)
#pragma unroll
      for (int j = 0; j < 2; j++)
#pragma unroll
        for (int r = 0; r < 16; r++) acc[i][j][r] = 0.f;
    u32x4 ra[2 * MI], rb[4];
    const u16* ap = A + (size_t)(m0 + lr) * K + lc;
    const u16* bp = Bt + (size_t)(n0 + lr) * K + lc;
#pragma unroll
    for (int i = 0; i < 2 * MI; i++) ra[i] = *(const u32x4*)(ap + (size_t)i * 32 * K);
#pragma unroll
    for (int i = 0; i < 4; i++) rb[i] = *(const u32x4*)(bp + (size_t)i * 32 * K);
    __syncthreads();
#pragma unroll
    for (int i = 0; i < 2 * MI; i++) *(u32x4*)&As[(lr + 32 * i) * 72 + lc] = ra[i];
#pragma unroll
    for (int i = 0; i < 4; i++) *(u32x4*)&Bs[(lr + 32 * i) * 72 + lc] = rb[i];
    __syncthreads();
    for (int kt = 0; kt < nk; kt++) {
      if (kt + 1 < nk) {
#pragma unroll
        for (int i = 0; i < 2 * MI; i++) ra[i] = *(const u32x4*)(ap + (size_t)i * 32 * K + (kt + 1) * 64);
#pragma unroll
        for (int i = 0; i < 4; i++) rb[i] = *(const u32x4*)(bp + (size_t)i * 32 * K + (kt + 1) * 64);
      }
#pragma unroll
      for (int ks = 0; ks < 4; ks++) {
        bf16x8 af[MI], b0, b1;
#pragma unroll
        for (int i = 0; i < MI; i++) af[i] = *(const bf16x8*)&As[(wm * 32 * MI + 32 * i + l31) * 72 + ks * 16 + lh * 8];
        b0 = *(const bf16x8*)&Bs[(wn * 64 + l31) * 72 + ks * 16 + lh * 8];
        b1 = *(const bf16x8*)&Bs[(wn * 64 + 32 + l31) * 72 + ks * 16 + lh * 8];
#pragma unroll
        for (int i = 0; i < MI; i++) {
          acc[i][0] = mfma32(b0, af[i], acc[i][0]);
          acc[i][1] = mfma32(b1, af[i], acc[i][1]);
        }
      }
      __syncthreads();
      if (kt + 1 < nk) {
#pragma unroll
        for (int i = 0; i < 2 * MI; i++) *(u32x4*)&As[(lr + 32 * i) * 72 + lc] = ra[i];
#pragma unroll
        for (int i = 0; i < 4; i++) *(u32x4*)&Bs[(lr + 32 * i) * 72 + lc] = rb[i];
        __syncthreads();
      }
    }
    const int bidx = m0 >> 13;
#pragma unroll
    for (int i = 0; i < MI; i++) {
      const int row = m0 + wm * 32 * MI + 32 * i + l31;
#pragma unroll
      for (int j = 0; j < 2; j++) {
#pragma unroll
        for (int r4 = 0; r4 < 4; r4++) {
          const int col = n0 + wn * 64 + 32 * j + 8 * r4 + 4 * lh;
          float v[4];
#pragma unroll
          for (int q = 0; q < 4; q++) v[q] = acc[i][j][4 * r4 + q];
          if (EPI == EPI_AIN) {
            if (col < 1024) {
              u32x2 o;
              o[0] = pk2(v[0], v[1]);
              o[1] = pk2(v[2], v[3]);
              *(u32x2*)(ea.o0 + (size_t)row * 1024 + col) = o;
            } else if (col < 1280) {
              *(f32x4*)(ea.f0 + (size_t)row * 256 + (col - 1024)) = (f32x4){v[0], v[1], v[2], v[3]};
            } else if (col < 1792) {
              u32x2 o;
              o[0] = pk2(v[0], v[1]);
              o[1] = pk2(v[2], v[3]);
              *(u32x2*)(ea.o1 + (size_t)row * 512 + (col - 1280)) = o;
            } else if (col < 1856) {
              const int d = col - 1792;
              const int sidx = row & 8191;
              const size_t off = (size_t)(row >> 13) * S * 64 +
                                 ((size_t)((sidx >> 5) * 4 + (d >> 4)) * 64 + 32 * ((d >> 3) & 1) + (sidx & 31)) * 8 + (d & 7);
              u32x2 o;
              o[0] = pk2(v[0], v[1]);
              o[1] = pk2(v[2], v[3]);
              *(u32x2*)(ea.o2 + off) = o;
            } else if (col < 1864) {
              const float sc = 0.044194173824159216f;
              *(f32x4*)(ea.f1 + (size_t)row * 8 + (col - 1856)) = (f32x4){v[0] * sc, v[1] * sc, v[2] * sc, v[3] * sc};
            }
          } else if (EPI == EPI_BIN) {
            if (col < 1024) {
              const float sc = 0.125f * LOG2E;
              u32x2 o;
              o[0] = pk2(v[0] * sc, v[1] * sc);
              o[1] = pk2(v[2] * sc, v[3] * sc);
              *(u32x2*)(ea.o0 + (size_t)row * 1024 + col) = o;
            } else if (col < 2048) {
              u32x2 o;
              o[0] = pk2(v[0], v[1]);
              o[1] = pk2(v[2], v[3]);
              *(u32x2*)(ea.o1 + (size_t)row * 1024 + (col - 1024)) = o;
            } else {
              const int cv = col - 2048;
#pragma unroll
              for (int q = 0; q < 4; q++) ea.o2[((size_t)bidx * 1024 + cv + q) * 8192 + (row & 8191)] = f2bf(v[q]);
            }
          } else if (EPI == EPI_RES) {
            const f32x4 gg = *(const f32x4*)(ea.g + (size_t)bidx * 6144 + col);
            const size_t o = (size_t)row * 1024 + col;
            const f32x4 xv = *(const f32x4*)(ea.xin + o);
            f32x4 r;
#pragma unroll
            for (int q = 0; q < 4; q++) r[q] = DN_ALPHA * xv[q] + (1.f + gg[q]) * v[q];
            *(f32x4*)(ea.f0 + o) = r;
          } else {
            float r[4];
#pragma unroll
            for (int q = 0; q < 4; q++) {
              r[q] = v[q] > 0.f ? v[q] : 0.f;
              r[q] = r[q] * r[q];
            }
            u32x2 o;
            o[0] = pk2(r[0], r[1]);
            o[1] = pk2(r[2], r[3]);
            *(u32x2*)(ea.o0 + (size_t)row * 4096 + col) = o;
          }
        }
      }
    }
  }
}

DI void ckvnorm_phase(const float* __restrict__ raw, const float* __restrict__ g, u16* __restrict__ outp, int bid,
                      int nb) {
  const int tid = opq_tid(), lane = tid & 63, w = __builtin_amdgcn_readfirstlane(tid >> 6);
  const f32x4 gg = *(const f32x4*)(g + lane * 4);
  for (int row = bid * 4 + w; row < T; row += nb * 4) {
    f32x4 v = *(const f32x4*)(raw + (size_t)row * 256 + lane * 4);
    float ss = v[0] * v[0] + v[1] * v[1] + v[2] * v[2] + v[3] * v[3];
    ss = wave_sum(ss);
    const float r = rsqrtf(ss * (1.f / 256.f) + LN_EPS);
    u32x2 o;
    o[0] = pk2(v[0] * r * gg[0], v[1] * r * gg[1]);
    o[1] = pk2(v[2] * r * gg[2], v[3] * r * gg[3]);
    *(u32x2*)(outp + (size_t)row * 256 + lane * 4) = o;
  }
}

DI unsigned mono_key(float s) {
  unsigned u = __float_as_uint(s);
  return (u & 0x80000000u) ? ~u : (u | 0x80000000u);
}
DI float mono_inv(unsigned k) {
  unsigned u = (k & 0x80000000u) ? (k & 0x7fffffffu) : ~k;
  return __uint_as_float(u);
}
DI float relu_i(float x) {
  int i = __float_as_int(x);
  return __int_as_float(i > 0 ? i : 0);
}
DI int wcount(bool f) { return __popcll(__ballot(f)); }

template <bool EXACT>
DI void compact4(float* vals, u16* idxs, int* cnt, int lane, float* thr_out) {
  constexpr int NPL = CAP / 64;
  unsigned key[4][NPL];
  int n[4];
#pragma unroll
  for (int q = 0; q < 4; q++) n[q] = cnt[q];
#pragma unroll
  for (int q = 0; q < 4; q++)
#pragma unroll
    for (int j = 0; j < NPL; j++) {
      const int e = j * 64 + lane;
      key[q][j] = (e < n[q]) ? mono_key(vals[q * CAP + e]) : 0u;
    }
  unsigned Tk[4] = {0u, 0u, 0u, 0u};
  constexpr int LOWBIT = EXACT ? 0 : 18;
#pragma unroll 1
  for (int bit = 31; bit >= LOWBIT; bit--) {
#pragma unroll
    for (int q = 0; q < 4; q++) {
      const unsigned cand = Tk[q] | (1u << bit);
      int c = 0;
#pragma unroll
      for (int j = 0; j < NPL; j++) c += wcount(key[q][j] >= cand);
      Tk[q] = (c >= TOPK) ? cand : Tk[q];
      if (q == 1) __builtin_amdgcn_sched_barrier(0);
    }
  }
  unsigned I[4] = {0xffffu, 0xffffu, 0xffffu, 0xffffu};
  if (EXACT) {
    unsigned ix[4][NPL];
    int need[4];
#pragma unroll
    for (int q = 0; q < 4; q++) {
      int cgt = 0;
#pragma unroll
      for (int j = 0; j < NPL; j++) {
        const int e = j * 64 + lane;
        ix[q][j] = (e < n[q]) ? (unsigned)idxs[q * CAP + e] : 0xffffu;
        cgt += wcount(key[q][j] > Tk[q]);
      }
      need[q] = TOPK - cgt;
      I[q] = 0u;
    }
#pragma unroll 1
    for (int bit = 13; bit >= 0; bit--) {
#pragma unroll
      for (int q = 0; q < 4; q++) {
        const unsigned cand = I[q] | (1u << bit);
        int c = 0;
#pragma unroll
        for (int j = 0; j < NPL; j++) c += wcount(key[q][j] == Tk[q] && ix[q][j] < cand);
        I[q] = (c < need[q]) ? cand : I[q];
        if (q == 1) __builtin_amdgcn_sched_barrier(0);
      }
    }
  }
  const unsigned long long lt = (1ull << lane) - 1ull;
#pragma unroll
  for (int q = 0; q < 4; q++) {
    if (n[q] > TOPK) {
      int base = 0;
#pragma unroll
      for (int j = 0; j < NPL; j++) {
        const int e = j * 64 + lane;
        const bool in = e < n[q];
        const float v = in ? vals[q * CAP + e] : 0.f;
        const unsigned ixv = in ? (unsigned)idxs[q * CAP + e] : 0xffffu;
        const bool keep = (key[q][j] > Tk[q]) || (key[q][j] == Tk[q] && ixv <= I[q]);
        const unsigned long long m = __ballot(keep);
        if (keep) {
          const int pos = base + __popcll(m & lt);
          vals[q * CAP + pos] = v;
          idxs[q * CAP + pos] = (u16)ixv;
        }
        base += __popcll(m);
      }
      if (lane == 0) cnt[q] = base;
      thr_out[q] = mono_inv(Tk[q]);
    }
  }
}

DI void indexer_phase(const u16* __restrict__ iq, const u16* __restrict__ ik, const float* __restrict__ iw,
                      u16* __restrict__ sel, char* smem, int bid, int nb) {
  constexpr int WBYTES = 4 * CAP * 4 + 4 * CAP * 2 + 64;
  const int tid = opq_tid(), lane = tid & 63, w = __builtin_amdgcn_readfirstlane(tid >> 6), l31 = lane & 31, u = lane >> 5;
  float* vals = (float*)(smem + w * WBYTES);
  u16* idxs = (u16*)(smem + w * WBYTES + 4 * CAP * 4);
  int* cnt = (int*)(smem + w * WBYTES + 4 * CAP * 4 + 4 * CAP * 2);
  const int nitems = NBATCH * (S / 16);
  const int nrounds = (nitems + nb - 1) / nb;
  __syncthreads();
  for (int rd = 0; rd < nrounds; rd++) {
    const int it = rd * nb + ((rd & 1) ? (nb - 1 - bid) : bid);
    if (it >= nitems) continue;
    const int b = it & 3, qg = (S / 16 - 1) - (it >> 2);
    const int t0 = qg * 16;
    const int tw = t0 + 4 * w;
    const size_t tb = (size_t)b * S;
    bf16x8 aq[4];
    {
      const int g = l31 >> 3, up = (l31 >> 2) & 1, j = l31 & 3;
      const int ql = 2 * up + (g >> 1), hd = 4 * (g & 1) + j;
      const u16* qp = iq + (tb + tw + ql) * 512 + hd * 64 + u * 8;
#pragma unroll
      for (int ks = 0; ks < 4; ks++) aq[ks] = *(const bf16x8*)(qp + ks * 16);
    }
    float wq[2][8];
#pragma unroll
    for (int qq = 0; qq < 2; qq++) {
      const float* wp = iw + (tb + tw + 2 * u + qq) * 8;
      f32x4 w0 = *(const f32x4*)wp, w1 = *(const f32x4*)(wp + 4);
#pragma unroll
      for (int h = 0; h < 4; h++) {
        wq[qq][h] = w0[h];
        wq[qq][4 + h] = w1[h];
      }
    }
    float thr[2] = {-INFINITY, -INFINITY};
    __builtin_amdgcn_wave_barrier();
    if (lane < 4) cnt[lane] = 0;
    __builtin_amdgcn_wave_barrier();
    const int nkb = (tw + 3) / 32 + 1;
    const u16* kp = ik + tb * 64 + lane * 8;
    bf16x8 ring[4][4];
#pragma unroll
    for (int i = 0; i < 4; i++) {
      const int kbn = (i < nkb) ? i : nkb - 1;
#pragma unroll
      for (int ks = 0; ks < 4; ks++) ring[i][ks] = *(const bf16x8*)(kp + (size_t)(kbn * 4 + ks) * 512);
    }
#pragma unroll 1
    for (int kb0 = 0; kb0 < nkb; kb0 += 4) {
#pragma unroll
      for (int i = 0; i < 4; i++) {
        const int kb = kb0 + i;
        {
          f32x16 acc;
#pragma unroll
          for (int r = 0; r < 16; r++) acc[r] = 0.f;
#pragma unroll
          for (int ks = 0; ks < 4; ks++) acc = mfma32(aq[ks], ring[i][ks], acc);
          {
            const int kbn = (kb + 4 < nkb) ? kb + 4 : nkb - 1;
#pragma unroll
            for (int ks = 0; ks < 4; ks++) ring[i][ks] = *(const bf16x8*)(kp + (size_t)(kbn * 4 + ks) * 512);
          }
          const int key = kb * 32 + l31;
#pragma unroll
          for (int qq = 0; qq < 2; qq++) {
            float s0 = 0.f, s1 = 0.f;
#pragma unroll
            for (int h = 0; h < 8; h += 2) {
              s0 = fmaf(wq[qq][h], relu_i(acc[8 * qq + h]), s0);
              s1 = fmaf(wq[qq][h + 1], relu_i(acc[8 * qq + h + 1]), s1);
            }
            float s = s0 + s1;
            s += 0.0f;
            const int tq = tw + 2 * u + qq;
            if (key <= tq && s >= thr[qq]) {
              const int qs = 2 * u + qq;
              const int pos = atomicAdd(&cnt[qs], 1);
              vals[qs * CAP + pos] = s;
              idxs[qs * CAP + pos] = (u16)key;
            }
          }
        }
      }
      __builtin_amdgcn_wave_barrier();
      const int c0 = cnt[0], c1 = cnt[1], c2 = cnt[2], c3 = cnt[3];
      if (c0 > CAP - 128 || c1 > CAP - 128 || c2 > CAP - 128 || c3 > CAP - 128) {
        float to[4] = {0.f, 0.f, 0.f, 0.f};
        compact4<false>(vals, idxs, cnt, lane, to);
        __builtin_amdgcn_wave_barrier();
        const int d0 = cnt[0], d1 = cnt[1], d2 = cnt[2], d3 = cnt[3];
        if (d0 > CAP - 256 || d1 > CAP - 256 || d2 > CAP - 256 || d3 > CAP - 256) {
          compact4<true>(vals, idxs, cnt, lane, to);
          __builtin_amdgcn_wave_barrier();
        }
        if (c0 > TOPK && u == 0) thr[0] = to[0];
        if (c1 > TOPK && u == 0) thr[1] = to[1];
        if (c2 > TOPK && u == 1) thr[0] = to[2];
        if (c3 > TOPK && u == 1) thr[1] = to[3];
      }
    }
    {
      const int c0 = cnt[0], c1 = cnt[1], c2 = cnt[2], c3 = cnt[3];
      if (c0 > TOPK || c1 > TOPK || c2 > TOPK || c3 > TOPK) {
        float to[4];
        compact4<true>(vals, idxs, cnt, lane, to);
        __builtin_amdgcn_wave_barrier();
      }
    }
#pragma unroll 1
    for (int qs = 0; qs < 4; qs++) {
      const int n = cnt[qs];
      u16* sp = sel + (tb + tw + qs) * 256;
#pragma unroll
      for (int j = 0; j < 4; j++) {
        const int e = j * 64 + lane;
        sp[e] = (e < n) ? idxs[qs * CAP + e] : (u16)0xffffu;
      }
    }
  }
}

DI void sparse_phase(const u16* __restrict__ q, const u16* __restrict__ ckvn, const u16* __restrict__ sel,
                     const u16* __restrict__ wuk, const u16* __restrict__ wuv, const float* __restrict__ rel_bias,
                     u16* scratch, u16* __restrict__ o, char* smem, int bid, int nb) {
  constexpr int GS = 264;
  const int tid = opq_tid(), lane = tid & 63, w = __builtin_amdgcn_readfirstlane(tid >> 6), l15 = lane & 15, g = lane >> 4;
  u16* G = (u16*)smem + (size_t)w * 32 * GS;
  int* lut = (int*)(smem + 4 * 32 * GS * 2);
  float* rb = (float*)(lut + 128);
  __syncthreads();
  if (tid < 128) lut[tid] = rel_bucket(tid);
  for (int i = tid; i < 512; i += 256) rb[i] = rel_bias[i] * LOG2E;
  __syncthreads();
  u16* ql = scratch + (size_t)bid * (16 * 16 * 256);
  const int nitems = NBATCH * (S / 16);
  for (int it = bid; it < nitems; it += nb) {
    const int b = it & 3, qg = it >> 2;
    const int t0 = qg * 16;
    const size_t tb = (size_t)b * S;
    for (int hh = 0; hh < 4; hh++) {
      const int h = 4 * w + hh;
      bf16x8 bq[2];
#pragma unroll
      for (int ks = 0; ks < 2; ks++) bq[ks] = *(const bf16x8*)(q + (tb + t0 + l15) * 1024 + h * 64 + ks * 32 + g * 8);
#pragma unroll 4
      for (int rt = 0; rt < 16; rt++) {
        f32x4 acc = {0.f, 0.f, 0.f, 0.f};
#pragma unroll
        for (int ks = 0; ks < 2; ks++) {
          bf16x8 a = *(const bf16x8*)(wuk + ((size_t)h * 256 + rt * 16 + l15) * 64 + ks * 32 + g * 8);
          acc = mfma16(a, bq[ks], acc);
        }
        u32x2 ov;
        ov[0] = pk2(acc[0] * (0.125f * LOG2E), acc[1] * (0.125f * LOG2E));
        ov[1] = pk2(acc[2] * (0.125f * LOG2E), acc[3] * (0.125f * LOG2E));
        *(u32x2*)(ql + ((size_t)l15 * 16 + h) * 256 + rt * 16 + 4 * g) = ov;
      }
    }
    __syncthreads();
    {
      const u16* selw = sel + (tb + t0 + 4 * w) * 256;
      const int l31 = lane & 31;
      const int q4 = l15 >> 2, p4 = l15 & 3;
      const u16* ckb = ckvn + tb * 256;
      int idx_c = selw[l31];
      int idx_n = selw[32 + l31];
      u32x4 gr[16];
#pragma unroll
      for (int i = 0; i < 16; i++) {
        int id = __shfl(idx_c, (lane >> 5) + 2 * i);
        id = (id == 0xffff) ? 0 : id;
        gr[i] = *(const u32x4*)(ckb + (unsigned)(id * 256 + l31 * 8));
      }
      bf16x8 qb[8];
      float m_run = NEGF, l_run = 0.f;
      f32x4 O[16];
#pragma unroll 1
      for (int st = 0; st < 32; st++) {
        const int qi = st >> 3, ch = st & 7;
        const int qloc = 4 * w + qi;
        const int t = t0 + qloc;
        if (ch == 0) {
#pragma unroll
          for (int ks = 0; ks < 8; ks++) qb[ks] = *(const bf16x8*)(ql + ((size_t)qloc * 16 + l15) * 256 + ks * 32 + g * 8);
          m_run = NEGF;
          l_run = 0.f;
#pragma unroll
          for (int rt = 0; rt < 16; rt++) O[rt] = (f32x4){0.f, 0.f, 0.f, 0.f};
        }
#pragma unroll
        for (int i = 0; i < 16; i++) *(u32x4*)&G[((lane >> 5) + 2 * i) * GS + l31 * 8] = gr[i];
        __builtin_amdgcn_wave_barrier();
        const int stn2 = (st + 2 < 32) ? st + 2 : 31;
        const int idx_nn = selw[stn2 * 32 + l31];
#pragma unroll
        for (int i = 0; i < 16; i++) {
          int id = __shfl(idx_n, (lane >> 5) + 2 * i);
          id = (id == 0xffff) ? 0 : id;
          gr[i] = *(const u32x4*)(ckb + (unsigned)(id * 256 + l31 * 8));
        }
        float lg[2][4];
#pragma unroll
        for (int kbk = 0; kbk < 2; kbk++) {
          f32x4 acc = {0.f, 0.f, 0.f, 0.f};
#pragma unroll
          for (int ks = 0; ks < 8; ks++) {
            bf16x8 a = *(const bf16x8*)&G[(16 * kbk + l15) * GS + ks * 32 + g * 8];
            acc = mfma16(a, qb[ks], acc);
            if (ks == 3) asm volatile("" ::: "memory");
          }
          asm volatile("" ::: "memory");
#pragma unroll
          for (int i = 0; i < 4; i++) {
            const int kid = __shfl(idx_c, 16 * kbk + 4 * g + i);
            float v = NEGF;
            if (kid != 0xffff) {
              int n = t - kid;
              n = n < 0 ? 0 : n;
              const int bk = n < 128 ? lut[n] : 31;
              v = acc[i] + rb[bk * 16 + l15];
            }
            lg[kbk][i] = v;
          }
        }
        float mx = fmaxf(fmaxf(fmaxf(lg[0][0], lg[0][1]), fmaxf(lg[0][2], lg[0][3])),
                         fmaxf(fmaxf(lg[1][0], lg[1][1]), fmaxf(lg[1][2], lg[1][3])));
        mx = fmaxf(mx, __shfl_xor(mx, 16));
        mx = fmaxf(mx, __shfl_xor(mx, 32));
        const float m_new = fmaxf(m_run, mx);
        const float scl = __builtin_amdgcn_exp2f(m_run - m_new);
        m_run = m_new;
        float ps = 0.f;
        float pe[8];
#pragma unroll
        for (int kbk = 0; kbk < 2; kbk++)
#pragma unroll
          for (int i = 0; i < 4; i++) {
            const float pv = __builtin_amdgcn_exp2f(lg[kbk][i] - m_new);
            pe[kbk * 4 + i] = pv;
            ps += pv;
          }
        l_run = l_run * scl + ps;
        u32x4 pw;
        pw[0] = pk2(pe[0], pe[1]);
        pw[1] = pk2(pe[2], pe[3]);
        pw[2] = pk2(pe[4], pe[5]);
        pw[3] = pk2(pe[6], pe[7]);
        const bf16x8 pB = __builtin_bit_cast(bf16x8, pw);
        if (__ballot(scl != 1.f)) {
#pragma unroll
          for (int rt = 0; rt < 16; rt++) O[rt] = O[rt] * scl;
        }
#pragma unroll
        for (int rt = 0; rt < 16; rt++) {
          const s16x4 lo = __builtin_amdgcn_ds_read_tr16_b64_v4i16((lds_s16x4_ptr)(&G[(4 * g + q4) * GS + rt * 16 + 4 * p4]));
          const s16x4 hi = __builtin_amdgcn_ds_read_tr16_b64_v4i16((lds_s16x4_ptr)(&G[(16 + 4 * g + q4) * GS + rt * 16 + 4 * p4]));
          const bf16x8 a = (bf16x8){lo[0], lo[1], lo[2], lo[3], hi[0], hi[1], hi[2], hi[3]};
          O[rt] = mfma16(a, pB, O[rt]);
          if ((rt & 3) == 3) asm volatile("" ::: "memory");
        }
        __builtin_amdgcn_wave_barrier();
        if (ch == 7) {
          float lt = l_run;
          lt += __shfl_xor(lt, 16);
          lt += __shfl_xor(lt, 32);
          const float inv = 1.f / lt;
#pragma unroll
          for (int rt = 0; rt < 16; rt++) {
            u32x2 ov;
            ov[0] = pk2(O[rt][0] * inv, O[rt][1] * inv);
            ov[1] = pk2(O[rt][2] * inv, O[rt][3] * inv);
            *(u32x2*)(ql + ((size_t)qloc * 16 + l15) * 256 + rt * 16 + 4 * g) = ov;
          }
        }
        idx_c = idx_n;
        idx_n = idx_nn;
      }
    }
    __syncthreads();
    for (int hh = 0; hh < 4; hh++) {
      const int h = 4 * w + hh;
      bf16x8 bo[8];
#pragma unroll
      for (int ks = 0; ks < 8; ks++) bo[ks] = *(const bf16x8*)(ql + ((size_t)l15 * 16 + h) * 256 + ks * 32 + g * 8);
#pragma unroll
      for (int et = 0; et < 4; et++) {
        f32x4 acc = {0.f, 0.f, 0.f, 0.f};
#pragma unroll
        for (int ks = 0; ks < 8; ks++) {
          bf16x8 a = *(const bf16x8*)(wuv + ((size_t)h * 64 + et * 16 + l15) * 256 + ks * 32 + g * 8);
          acc = mfma16(a, bo[ks], acc);
        }
        u32x2 ov;
        ov[0] = pk2(acc[0], acc[1]);
        ov[1] = pk2(acc[2], acc[3]);
        *(u32x2*)(o + (tb + t0 + l15) * 1024 + h * 64 + et * 16 + 4 * g) = ov;
      }
    }
    __syncthreads();
  }
}

DI void diffattn_phase(const u16* __restrict__ q, const u16* __restrict__ k, const u16* __restrict__ vT,
                       u16* __restrict__ o, const float* __restrict__ rel_bias, const float* __restrict__ lam,
                       const float* __restrict__ subln, int layer_idx, char* smem, int bid, int nb) {
  constexpr int KS = 136, VS = 72;
  u16* Ks = (u16*)smem;
  u16* Vs = Ks + 64 * KS;
  float* exch = (float*)smem;
  float* btab = (float*)(smem + 36 * 1024);
  int* lut = (int*)(smem + 36 * 1024 + 1040);
  float* misc = (float*)(smem + 36 * 1024 + 1040 + 512);
  const int tid = opq_tid(), lane = tid & 63, w = __builtin_amdgcn_readfirstlane(tid >> 6), l31 = lane & 31, lh = lane >> 5;
  const int qsub = w >> 1, m = w & 1;
  const float lam_init = 0.8f - 0.6f * expf(-0.3f * (float)layer_idx);
  __syncthreads();
  if (tid < 128) lut[tid] = rel_bucket(tid);
  if (w == 0) {
    float p1 = lam[lane] * lam[64 + lane], p2 = lam[128 + lane] * lam[192 + lane];
    p1 = wave_sum(p1);
    p2 = wave_sum(p2);
    if (lane == 0) misc[0] = expf(p1) - expf(p2) + lam_init;
  }
  __syncthreads();
  const float lam_full = misc[0];
  const int nitems = NBATCH * 8 * (S / 64);
  const int nrounds = (nitems + nb - 1) / nb;
  const int prow = pi_row(l31);
  for (int rd = 0; rd < nrounds; rd++) {
    const int it = rd * nb + ((rd & 1) ? (nb - 1 - bid) : bid);
    if (it >= nitems) continue;
    const int bh = it & 31, qb = (S / 64 - 1) - (it >> 5);
    const int b = bh >> 3, h = bh & 7;
    const int q0 = qb * 64, tq0 = q0 + 32 * qsub, t = tq0 + l31;
    const size_t tb = (size_t)b * S;
    __syncthreads();
    for (int i = tid; i < 258; i += 256) {
      const int n = i >> 1, mm = i & 1;
      const int bk = n < 128 ? lut[n] : 31;
      btab[i] = rel_bias[bk * 16 + 2 * h + mm] * LOG2E;
    }
    bf16x8 qf[4];
#pragma unroll
    for (int ks = 0; ks < 4; ks++) qf[ks] = *(const bf16x8*)(q + (tb + t) * 1024 + h * 128 + m * 64 + ks * 16 + lh * 8);
    f32x16 O[4];
#pragma unroll
    for (int et = 0; et < 4; et++)
#pragma unroll
      for (int r = 0; r < 16; r++) O[et][r] = 0.f;
    float m_run = NEGF, l_run = 0.f;
    const int nkt = qb + 1;
    u32x4 rk[4], rv[4];
    const u16* kp = k + tb * 1024 + h * 128;
    const u16* vp = vT + ((size_t)(b * 8 + h) * 128) * 8192;
#pragma unroll
    for (int i = 0; i < 4; i++) {
      const int id = tid + 256 * i;
      rk[i] = *(const u32x4*)(kp + (size_t)(id >> 4) * 1024 + (id & 15) * 8);
      rv[i] = *(const u32x4*)(vp + (size_t)(id >> 3) * 8192 + (id & 7) * 8);
    }
#pragma unroll
    for (int i = 0; i < 4; i++) {
      const int id = tid + 256 * i;
      *(u32x4*)&Ks[(id >> 4) * KS + (id & 15) * 8] = rk[i];
      *(u32x4*)&Vs[(id >> 3) * VS + (id & 7) * 8] = rv[i];
    }
    __syncthreads();
    const float cfar = btab[256 + m];
    for (int kt = 0; kt < nkt; kt++) {
      if (kt + 1 < nkt) {
#pragma unroll
        for (int i = 0; i < 4; i++) {
          const int id = tid + 256 * i;
          rk[i] = *(const u32x4*)(kp + (size_t)((kt + 1) * 64 + (id >> 4)) * 1024 + (id & 15) * 8);
          rv[i] = *(const u32x4*)(vp + (size_t)(id >> 3) * 8192 + (kt + 1) * 64 + (id & 7) * 8);
        }
      }
      const int s_tile = kt * 64;
      const int nblk = (s_tile + 32 <= tq0 + 31) ? 2 : 1;
#pragma unroll 1
      for (int kb = 0; kb < nblk; kb++) {
        f32x16 acc;
#pragma unroll
        for (int r = 0; r < 16; r++) acc[r] = 0.f;
#pragma unroll
        for (int ks = 0; ks < 4; ks++) {
          bf16x8 a = *(const bf16x8*)&Ks[(32 * kb + prow) * KS + m * 64 + ks * 16 + lh * 8];
          acc = mfma32(a, qf[ks], acc);
        }
        const int s0 = s_tile + 32 * kb;
        const bool nearb = (tq0 - (s0 + 31)) < 128;
        if (nearb) {
#pragma unroll
          for (int r = 0; r < 16; r++) {
            const int key = s0 + 16 * (r >> 3) + 8 * lh + (r & 7);
            const int n = t - key;
            const int nc = n < 0 ? 0 : (n > 128 ? 128 : n);
            const float bv = btab[nc * 2 + m];
            acc[r] = (n < 0) ? NEGF : acc[r] + bv;
          }
        } else {
#pragma unroll
          for (int r = 0; r < 16; r++) acc[r] += cfar;
        }
        float mx = acc[0];
#pragma unroll
        for (int r = 1; r < 16; r++) mx = fmaxf(mx, acc[r]);
        mx = fmaxf(mx, __shfl_xor(mx, 32));
        const float m_new = fmaxf(m_run, mx);
        const float scl = __builtin_amdgcn_exp2f(m_run - m_new);
        m_run = m_new;
        float ps = 0.f;
#pragma unroll
        for (int r = 0; r < 16; r++) {
          const float pv = __builtin_amdgcn_exp2f(acc[r] - m_new);
          acc[r] = pv;
          ps += pv;
        }
        l_run = l_run * scl + ps;
        if (__ballot(scl != 1.f)) {
#pragma unroll
          for (int et = 0; et < 4; et++)
#pragma unroll
            for (int r = 0; r < 16; r++) O[et][r] *= scl;
        }
#pragma unroll
        for (int s2 = 0; s2 < 2; s2++) {
          u32x4 pw;
          pw[0] = pk2(acc[8 * s2 + 0], acc[8 * s2 + 1]);
          pw[1] = pk2(acc[8 * s2 + 2], acc[8 * s2 + 3]);
          pw[2] = pk2(acc[8 * s2 + 4], acc[8 * s2 + 5]);
          pw[3] = pk2(acc[8 * s2 + 6], acc[8 * s2 + 7]);
          const bf16x8 pB = __builtin_bit_cast(bf16x8, pw);
#pragma unroll
          for (int et = 0; et < 4; et++) {
            bf16x8 a = *(const bf16x8*)&Vs[(32 * et + l31) * VS + 32 * kb + 16 * s2 + 8 * lh];
            O[et] = mfma32(a, pB, O[et]);
          }
        }
      }
      __syncthreads();
      if (kt + 1 < nkt) {
#pragma unroll
        for (int i = 0; i < 4; i++) {
          const int id = tid + 256 * i;
          *(u32x4*)&Ks[(id >> 4) * KS + (id & 15) * 8] = rk[i];
          *(u32x4*)&Vs[(id >> 3) * VS + (id & 7) * 8] = rv[i];
        }
        __syncthreads();
      }
    }
    float lt = l_run + __shfl_xor(l_run, 32);
    const float inv = 1.f / lt;
    if (m == 1) {
#pragma unroll
      for (int et = 0; et < 4; et++)
#pragma unroll
        for (int r = 0; r < 16; r++) {
          const int e = 32 * et + (r & 3) + 8 * (r >> 2) + 4 * lh;
          exch[(qsub * 128 + e) * 32 + l31] = O[et][r] * inv;
        }
    }
    __syncthreads();
    if (m == 0) {
      float ss = 0.f;
#pragma unroll
      for (int et = 0; et < 4; et++)
#pragma unroll
        for (int r = 0; r < 16; r++) {
          const int e = 32 * et + (r & 3) + 8 * (r >> 2) + 4 * lh;
          const float v = O[et][r] * inv - lam_full * exch[(qsub * 128 + e) * 32 + l31];
          O[et][r] = v;
          ss += v * v;
        }
      ss += __shfl_xor(ss, 32);
      const float rs = rsqrtf(ss * (1.f / 128.f) + LN_EPS);
      const float osc = 1.f - lam_init;
#pragma unroll
      for (int et = 0; et < 4; et++)
#pragma unroll
        for (int r4 = 0; r4 < 4; r4++) {
          const int e = 32 * et + 8 * r4 + 4 * lh;
          const f32x4 gv = *(const f32x4*)(subln + e);
          u32x2 ov;
          ov[0] = pk2(O[et][4 * r4 + 0] * rs * gv[0] * osc, O[et][4 * r4 + 1] * rs * gv[1] * osc);
          ov[1] = pk2(O[et][4 * r4 + 2] * rs * gv[2] * osc, O[et][4 * r4 + 3] * rs * gv[3] * osc);
          *(u32x2*)(o + (tb + t) * 1024 + h * 128 + e) = ov;
        }
    }
  }
}

#define XB_TMO      128
#define XB_XCNT(j)  (256  + 64 * (j))
#define XB_XSUB(j)  (1280 + 64 * (j))
#define XB_XGEN(j)  (2304 + 64 * (j))
#define XB_TOP      3328
#define XB_TOPGEN   3392
#define XCD_BAR_WORDS 3456
#define XB_SPIN_CAP (1u << 20)
#define LAS __attribute__((address_space(3)))
DI unsigned xb_ld(unsigned* p) { return __hip_atomic_load(p, __ATOMIC_RELAXED, __HIP_MEMORY_SCOPE_AGENT); }
DI unsigned xb_add(unsigned* p, unsigned v) { return __hip_atomic_fetch_add(p, v, __ATOMIC_RELAXED, __HIP_MEMORY_SCOPE_AGENT); }
DI unsigned xb_xcc_id() { return (unsigned)__builtin_amdgcn_s_getreg((3 << 11) | 20) & 0xFu; }
#define XB_SPIN(cond, bar) do { unsigned _sp = 0; while (cond) { __builtin_amdgcn_s_sleep(1); \
    if ((++_sp & 255u) == 0u) { if (xb_ld(&(bar)[XB_TMO])) break; if (_sp > XB_SPIN_CAP) { atomicAdd(&(bar)[XB_TMO], 1u); break; } } } } while (0)
struct XcdBarrier {
  unsigned* bar;
  unsigned x;
  volatile LAS unsigned* st;
};
DI XcdBarrier xcd_barrier_post(unsigned* bar, volatile LAS unsigned* st) {
  XcdBarrier b;
  b.bar = bar;
  b.x = xb_xcc_id();
  b.st = st;
  if (threadIdx.x == 0) (void)xb_add(&bar[XB_XCNT(b.x)], 1u);
  return b;
}
DI void xcd_barrier_complete(unsigned* bar, unsigned x, unsigned& nloc, unsigned& nx) {
  const unsigned G = gridDim.x * gridDim.y * gridDim.z;
  unsigned sum, cnt, mine, sp = 0u;
  for (;;) {
    sum = 0u; cnt = 0u; mine = 0u;
#pragma unroll
    for (unsigned j = 0; j < 16; ++j) {
      const unsigned c = xb_ld(&bar[XB_XCNT(j)]);
      sum += c;
      cnt += (c > 0u) ? 1u : 0u;
      mine = (j == x) ? c : mine;
    }
    if (sum == G) break;
    __builtin_amdgcn_s_sleep(1);
    if ((++sp & 255u) == 0u) { if (xb_ld(&bar[XB_TMO])) break; if (sp > XB_SPIN_CAP) { atomicAdd(&bar[XB_TMO], 1u); break; } }
  }
  nloc = mine > 0u ? mine : 1u;
  nx = cnt > 0u ? cnt : 1u;
}
DI void xcd_barrier(const XcdBarrier& b0) {
  asm volatile("s_waitcnt vmcnt(0)" ::: "memory");
  __syncthreads();
  if (threadIdx.x == 0) {
    XcdBarrier b = b0;
    b.x = __builtin_amdgcn_readfirstlane(xb_xcc_id());
    unsigned* bar = b.bar;
    asm volatile("" : "+s"(bar));
    __builtin_amdgcn_s_waitcnt(0);
    unsigned nloc = b.st[0], nx = b.st[1];
    if (nloc == 0u) { xcd_barrier_complete(bar, b.x, nloc, nx); b.st[0] = nloc; b.st[1] = nx; }
    const unsigned old = xb_add(&bar[XB_XSUB(b.x)], 1u);
    const unsigned gen = old / nloc;
    if (old + 1u == (gen + 1u) * nloc) {
      __builtin_amdgcn_fence(__ATOMIC_RELEASE, "agent");
      asm volatile("s_waitcnt vmcnt(0)" ::: "memory");
      const unsigned og = xb_add(&bar[XB_TOP], 1u);
      const unsigned tg = og / nx;
      if (og + 1u == (tg + 1u) * nx) xb_add(&bar[XB_TOPGEN], 1u);
      else XB_SPIN(xb_ld(&bar[XB_TOPGEN]) == tg, bar);
      __builtin_amdgcn_fence(__ATOMIC_ACQUIRE, "agent");
      xb_add(&bar[XB_XGEN(b.x)], 1u);
      asm volatile("s_waitcnt vmcnt(0)" ::: "memory");
    } else {
      XB_SPIN(xb_ld(&bar[XB_XGEN(b.x)]) == gen, bar);
      __builtin_amdgcn_fence(__ATOMIC_ACQUIRE, "agent");
      asm volatile("s_waitcnt vmcnt(0)" ::: "memory");
    }
  }
  __syncthreads();
}

#define DECL_WS_PTRS(ws) \
  u16* w_ain = (u16*)(ws + W_AIN); \
  u16* w_uk = (u16*)(ws + W_UK); \
  u16* w_uv = (u16*)(ws + W_UV); \
  u16* w_ao = (u16*)(ws + W_AO); \
  u16* w_bin = (u16*)(ws + W_BIN); \
  u16* w_bo = (u16*)(ws + W_BO); \
  u16* w_w1 = (u16*)(ws + W_W1); \
  u16* w_w2 = (u16*)(ws + W_W2); \
  float* mod = (float*)(ws + WS_MOD); \
  u16* hbuf = (u16*)(ws + WS_H); \
  char* big = ws + WS_BIG; \
  u16* qbuf = (u16*)(big + B_Q); \
  u16* iqbuf = (u16*)(big + B_IQ); \
  u16* ikbuf = (u16*)(big + B_IK); \
  float* iwbuf = (float*)(big + B_IW); \
  float* ckvraw = (float*)(big + B_CKVRAW); \
  u16* ckvn = (u16*)(big + B_CKVN); \
  u16* selbuf = (u16*)(big + B_SEL); \
  u16* kbuf = (u16*)(big + B_K); \
  u16* vtbuf = (u16*)(big + B_VT); \
  u16* obuf = (u16*)(big + B_O); \
  u16* hid = (u16*)big;

__global__ void __launch_bounds__(256, 2) hybrid_fwd(Params p) {
  __shared__ __attribute__((aligned(16))) char smem[LDS_BYTES];
  cg::grid_group grid = cg::this_grid();
  const int bid = blockIdx.x, nb = gridDim.x;
  char* ws = p.ws;
  unsigned* bar = (unsigned*)(ws + WS_BAR);
  volatile LAS unsigned* xst = (volatile LAS unsigned*)(smem + LDS_BYTES - 16);
  if (threadIdx.x < 2) xst[threadIdx.x] = 0u;
  __syncthreads();
  const XcdBarrier xb = xcd_barrier_post(bar, xst);

  {
  DECL_WS_PTRS(ws)
  (void)qbuf; (void)iqbuf; (void)ikbuf; (void)iwbuf; (void)ckvraw; (void)ckvn; (void)selbuf; (void)kbuf; (void)vtbuf; (void)obuf; (void)hid;
  tconv_phase(p.a_w_in, w_ain, 2, 1024, 1864, A_INP, smem, bid, nb);
  tconv_phase(p.a_w_uk, w_uk, 32, 64, 256, 256, smem, bid, nb);
  tconv_phase(p.a_w_uv, w_uv, 32, 256, 64, 64, smem, bid, nb);
  tconv_phase(p.a_w_o, w_ao, 2, 1024, 1024, 1024, smem, bid, nb);
  tconv_phase(p.b_w_in, w_bin, 2, 1024, 3072, 3072, smem, bid, nb);
  tconv_phase(p.b_w_o, w_bo, 2, 1024, 1024, 1024, smem, bid, nb);
  tconv_phase(p.mlp_w1, w_w1, 4, 1024, 4096, 4096, smem, bid, nb);
  tconv_phase(p.mlp_w2, w_w2, 4, 4096, 1024, 1024, smem, bid, nb);
  mod_phase(p, mod, smem, bid, nb);
  grid.sync();
  h0_phase(p.x, mod, hbuf, bid, nb);
  xcd_barrier(xb);
  }

#pragma unroll 1
  for (int sl = 0; sl < 8; sl++) {
    char* wsl = p.ws;
    asm volatile("" : "+s"(wsl));
    DECL_WS_PTRS(wsl)
    const int i = sl >> 1, j = i >> 1;
    const float* modi = mod + (size_t)i * 4 * 6144;
    const u16* Ares;
    const u16* Wres;
    int Kres, goff;
    if ((sl & 1) == 0) {
      if ((i & 1) == 0) {
        EpiArgs ea{};
        ea.o0 = qbuf; ea.f0 = ckvraw; ea.o1 = iqbuf; ea.o2 = ikbuf; ea.f1 = iwbuf;
        for (int rep = 0; rep < (PROBE_DUP == 4 ? 2 : 1); rep++) gemm_phase<EPI_AIN>(hbuf, w_ain + (size_t)j * A_INP * 1024, T, A_INP, 1024, ea, smem, bid, nb);
        xcd_barrier(xb);
        ckvnorm_phase(ckvraw, p.a_kv_norm + j * 256, ckvn, bid, nb);
        for (int rep = 0; rep < (PROBE_DUP == 2 ? 2 : 1); rep++) indexer_phase(iqbuf, ikbuf, iwbuf, selbuf, smem, bid, nb);
        xcd_barrier(xb);
        for (int rep = 0; rep < (PROBE_DUP == 3 ? 2 : 1); rep++) sparse_phase(qbuf, ckvn, selbuf, w_uk + (size_t)j * 16 * 256 * 64, w_uv + (size_t)j * 16 * 256 * 64, p.rel_bias,
                     hbuf, obuf, smem, bid, nb);
        xcd_barrier(xb);
        Wres = w_ao + (size_t)j * 1024 * 1024;
      } else {
        EpiArgs ea{};
        ea.o0 = qbuf; ea.o1 = kbuf; ea.o2 = vtbuf;
        for (int rep = 0; rep < (PROBE_DUP == 4 ? 2 : 1); rep++) gemm_phase<EPI_BIN>(hbuf, w_bin + (size_t)j * 3072 * 1024, T, 3072, 1024, ea, smem, bid, nb);
        xcd_barrier(xb);
        for (int rep = 0; rep < (PROBE_DUP == 1 ? 2 : 1); rep++) diffattn_phase(qbuf, kbuf, vtbuf, obuf, p.rel_bias, p.b_lambda + j * 256, p.b_subln + j * 128, i, smem, bid, nb);
        xcd_barrier(xb);
        Wres = w_bo + (size_t)j * 1024 * 1024;
      }
      Ares = obuf; Kres = 1024; goff = 2 * 1024;
    } else {
      EpiArgs ea{};
      ea.o0 = hid;
      for (int rep = 0; rep < (PROBE_DUP == 4 ? 2 : 1); rep++) gemm_phase<EPI_SQRELU>(hbuf, w_w1 + (size_t)i * 4096 * 1024, T, 4096, 1024, ea, smem, bid, nb);
      xcd_barrier(xb);
      Ares = hid; Wres = w_w2 + (size_t)i * 4096 * 1024; Kres = 4096; goff = 5 * 1024;
    }
    {
      EpiArgs ea{};
      ea.f0 = p.out;
      ea.xin = (sl == 0) ? p.x : (const float*)p.out;
      ea.g = modi + goff;
      gemm_phase<EPI_RES>(Ares, Wres, T, 1024, Kres, ea, smem, bid, nb);
    }
    xcd_barrier(xb);
    {
      const float* modn = ((sl & 1) == 0) ? modi : (i < 3 ? modi + 4 * 6144 : (const float*)nullptr);
      const int sh_off = ((sl & 1) == 0) ? 3 * 1024 : 0;
      ln_phase(p.out, p.ln_g + (size_t)(i * 2 + (sl & 1)) * 1024, p.ln_b + (size_t)(i * 2 + (sl & 1)) * 1024, modn, sh_off,
               hbuf, bid, nb);
    }
    xcd_barrier(xb);
  }
}

extern "C" void kernel_launch(void* const* d_in, const int* in_sizes, int n_in, void* d_out, int out_size, void* d_ws,
                              size_t ws_size, hipStream_t stream) {
  static int grid_blocks = 0;
  if (!grid_blocks) {
    int dev = 0, cus = 0, per_cu = 0;
    hipGetDevice(&dev);
    hipDeviceGetAttribute(&cus, hipDeviceAttributeMultiprocessorCount, dev);
    hipOccupancyMaxActiveBlocksPerMultiprocessor(&per_cu, hybrid_fwd, 256, 0);
    if (per_cu < 1) per_cu = 1;
    if (per_cu > 2) per_cu = 2;
    grid_blocks = cus * per_cu;
    if (grid_blocks > 512) grid_blocks = 512;
  }
  Params p{};
  p.x = (const float*)d_in[0];
  p.c = (const float*)d_in[1];
  p.rel_bias = (const float*)d_in[2];
  p.ada_w = (const float*)d_in[3];
  p.ada_b = (const float*)d_in[4];
  p.ln_g = (const float*)d_in[5];
  p.ln_b = (const float*)d_in[6];
  p.a_w_in = (const float*)d_in[7];
  p.a_kv_norm = (const float*)d_in[8];
  p.a_w_uk = (const float*)d_in[9];
  p.a_w_uv = (const float*)d_in[10];
  p.a_w_o = (const float*)d_in[11];
  p.b_w_in = (const float*)d_in[12];
  p.b_lambda = (const float*)d_in[13];
  p.b_subln = (const float*)d_in[14];
  p.b_w_o = (const float*)d_in[15];
  p.mlp_w1 = (const float*)d_in[16];
  p.mlp_w2 = (const float*)d_in[17];
  p.out = (float*)d_out;
  p.ws = (char*)d_ws;
  hipMemsetAsync((char*)d_ws + WS_BAR, 0, XCD_BAR_WORDS * 4, stream);
  void* args[] = {&p};
  hipError_t e = hipLaunchCooperativeKernel((void*)hybrid_fwd, dim3(grid_blocks), dim3(256), args, 0, stream);
  if (e != hipSuccess) fprintf(stderr, "cooperative launch failed: %s (grid %d)\n", hipGetErrorString(e), grid_blocks);
}
```

```cpp
#include <hip/hip_runtime.h>
#include <hip/hip_cooperative_groups.h>
#include <stdint.h>
#include <stdio.h>
namespace cg = cooperative_groups;

typedef unsigned short u16;
typedef short bf16x8 __attribute__((ext_vector_type(8)));
typedef short s16x4 __attribute__((ext_vector_type(4)));
typedef float f32x16 __attribute__((ext_vector_type(16)));
typedef float f32x4 __attribute__((ext_vector_type(4)));
typedef float f32x2 __attribute__((ext_vector_type(2)));
typedef __bf16 bf16x2_t __attribute__((ext_vector_type(2)));
typedef unsigned u32x4 __attribute__((ext_vector_type(4)));
typedef unsigned u32x2 __attribute__((ext_vector_type(2)));
typedef __attribute__((address_space(3))) s16x4* lds_s16x4_ptr;

#define DI __device__ __forceinline__
#ifndef PROBE_DUP
#define PROBE_DUP 0
#endif

constexpr int D = 1024, NBATCH = 4, S = 8192, T = NBATCH * S;
constexpr int A_INP = 1920;
constexpr float DN_ALPHA = 1.6817928305074292f;
constexpr float LOG2E = 1.4426950408889634f;
constexpr float LN_EPS = 1e-5f;
constexpr float NEGF = -1e30f;
constexpr int TOPK = 256;
constexpr int CAP = 704;
constexpr int LDS_BYTES = 72 * 1024;

constexpr size_t MB = 1024 * 1024;
constexpr size_t W_AIN = 0;
constexpr size_t W_UK = W_AIN + (size_t)2 * 1920 * 1024 * 2;
constexpr size_t W_UV = W_UK + (size_t)2 * 16 * 256 * 64 * 2;
constexpr size_t W_AO = W_UV + (size_t)2 * 16 * 256 * 64 * 2;
constexpr size_t W_BIN = W_AO + (size_t)2 * 1024 * 1024 * 2;
constexpr size_t W_BO = W_BIN + (size_t)2 * 3072 * 1024 * 2;
constexpr size_t W_W1 = W_BO + (size_t)2 * 1024 * 1024 * 2;
constexpr size_t W_W2 = W_W1 + (size_t)4 * 4096 * 1024 * 2;
constexpr size_t WS_MOD = W_W2 + (size_t)4 * 4096 * 1024 * 2;
constexpr size_t WS_H = WS_MOD + 1 * MB;
constexpr size_t WS_BIG = WS_H + 64 * MB;
constexpr size_t WS_BAR = WS_BIG + 256 * MB;
constexpr size_t B_Q = 0;
constexpr size_t B_IQ = 64 * MB;
constexpr size_t B_IK = 96 * MB;
constexpr size_t B_IW = 100 * MB;
constexpr size_t B_CKVRAW = 104 * MB;
constexpr size_t B_CKVN = 136 * MB;
constexpr size_t B_SEL = 152 * MB;
constexpr size_t B_K = 64 * MB;
constexpr size_t B_VT = 128 * MB;
constexpr size_t B_O = 192 * MB;

struct Params {
  const float *x, *c, *rel_bias, *ada_w, *ada_b, *ln_g, *ln_b, *a_w_in, *a_kv_norm, *a_w_uk, *a_w_uv, *a_w_o, *b_w_in,
      *b_lambda, *b_subln, *b_w_o, *mlp_w1, *mlp_w2;
  float* out;
  char* ws;
};

DI int opq_tid() {
  int t = threadIdx.x;
  asm volatile("" : "+v"(t));
  return t;
}
DI unsigned pk2(float lo, float hi) {
  f32x2 v = {lo, hi};
  bf16x2_t b = __builtin_convertvector(v, bf16x2_t);
  return __builtin_bit_cast(unsigned, b);
}
DI u16 f2bf(float x) { return (u16)(pk2(x, 0.f) & 0xffffu); }
DI float wave_sum(float v) {
#pragma unroll
  for (int o = 32; o >= 1; o >>= 1) v += __shfl_xor(v, o);
  return v;
}
DI f32x16 mfma32(bf16x8 a, bf16x8 b, f32x16 c) { return __builtin_amdgcn_mfma_f32_32x32x16_bf16(a, b, c, 0, 0, 0); }
DI f32x4 mfma16(bf16x8 a, bf16x8 b, f32x4 c) { return __builtin_amdgcn_mfma_f32_16x16x32_bf16(a, b, c, 0, 0, 0); }
DI int pi_row(int r) { return (r & ~12) | ((r & 4) << 1) | ((r & 8) >> 1); }

DI int rel_bucket(int n) {
  if (n < 16) return n;
  float nf = (float)n;
  int large = 16 + (int)(logf(nf / 16.f) / 2.0794415416798357f * 16.f);
  return large < 31 ? large : 31;
}

DI void tconv_phase(const float* __restrict__ src, u16* __restrict__ dst, int batch, int R, int C, int Cpad, char* smem,
                    int bid, int nb) {
  float* tile = (float*)smem;
  const int tid = opq_tid();
  const int tr = R / 64, tc = Cpad / 64;
  const int ntiles = batch * tr * tc;
  for (int it = bid; it < ntiles; it += nb) {
    const int bi = it / (tr * tc);
    const int rem = it - bi * (tr * tc);
    const int ri = rem / tc, ci = rem - ri * tc;
    const float* s = src + (size_t)bi * R * C;
    u16* d = dst + (size_t)bi * Cpad * R;
    __syncthreads();
#pragma unroll
    for (int k = 0; k < 4; k++) {
      const int r = (tid >> 4) + 16 * k;
      const int cl = (tid & 15) * 4;
      const int cc = ci * 64 + cl;
      f32x4 v = {0.f, 0.f, 0.f, 0.f};
      if (cc < C) v = *(const f32x4*)(s + (size_t)(ri * 64 + r) * C + cc);
      tile[r * 65 + cl + 0] = v[0];
      tile[r * 65 + cl + 1] = v[1];
      tile[r * 65 + cl + 2] = v[2];
      tile[r * 65 + cl + 3] = v[3];
    }
    __syncthreads();
#pragma unroll
    for (int k = 0; k < 2; k++) {
      const int cl = (tid >> 3) + 32 * k;
      const int r8 = (tid & 7) * 8;
      u32x4 o;
      o[0] = pk2(tile[(r8 + 0) * 65 + cl], tile[(r8 + 1) * 65 + cl]);
      o[1] = pk2(tile[(r8 + 2) * 65 + cl], tile[(r8 + 3) * 65 + cl]);
      o[2] = pk2(tile[(r8 + 4) * 65 + cl], tile[(r8 + 5) * 65 + cl]);
      o[3] = pk2(tile[(r8 + 6) * 65 + cl], tile[(r8 + 7) * 65 + cl]);
      *(u32x4*)(d + (size_t)(ci * 64 + cl) * R + ri * 64 + r8) = o;
    }
  }
}

DI void mod_phase(const Params& p, float* mod, char* smem, int bid, int nb) {
  float* sc = (float*)smem;
  float* red = sc + 4096;
  const int tid = opq_tid(), lane = tid & 63, w = __builtin_amdgcn_readfirstlane(tid >> 6);
  __syncthreads();
  for (int i = tid; i < 4096; i += 256) {
    float v = p.c[i];
    sc[i] = v / (1.f + expf(-v));
  }
  __syncthreads();
  for (int it = bid; it < 4 * 384; it += nb) {
    const int l = it / 384, e0 = (it - l * 384) * 16;
    const int ds = lane >> 4, ec = lane & 15;
    const float* wp = p.ada_w + ((size_t)l * 1024 + w * 256 + ds) * 6144 + e0 + ec;
    float a0 = 0, a1 = 0, a2 = 0, a3 = 0;
#pragma unroll 16
    for (int d = 0; d < 64; d++) {
      float wv = wp[(size_t)(4 * d) * 6144];
      int dd = w * 256 + 4 * d + ds;
      a0 += sc[dd] * wv;
      a1 += sc[1024 + dd] * wv;
      a2 += sc[2048 + dd] * wv;
      a3 += sc[3072 + dd] * wv;
    }
    a0 += __shfl_xor(a0, 16); a0 += __shfl_xor(a0, 32);
    a1 += __shfl_xor(a1, 16); a1 += __shfl_xor(a1, 32);
    a2 += __shfl_xor(a2, 16); a2 += __shfl_xor(a2, 32);
    a3 += __shfl_xor(a3, 16); a3 += __shfl_xor(a3, 32);
    if (lane < 16) {
      red[(w * 4 + 0) * 16 + lane] = a0;
      red[(w * 4 + 1) * 16 + lane] = a1;
      red[(w * 4 + 2) * 16 + lane] = a2;
      red[(w * 4 + 3) * 16 + lane] = a3;
    }
    __syncthreads();
    if (tid < 64) {
      const int b = tid >> 4, e = tid & 15;
      float sm = red[(0 * 4 + b) * 16 + e] + red[(1 * 4 + b) * 16 + e] + red[(2 * 4 + b) * 16 + e] + red[(3 * 4 + b) * 16 + e] +
                 p.ada_b[l * 6144 + e0 + e];
      mod[((size_t)l * 4 + b) * 6144 + e0 + e] = sm;
    }
    __syncthreads();
  }
}

DI void h0_phase(const float* __restrict__ x, const float* __restrict__ mod0, u16* __restrict__ h, int bid, int nb) {
  const size_t n8 = (size_t)T * 1024 / 8;
  for (size_t i = (size_t)bid * 256 + opq_tid(); i < n8; i += (size_t)nb * 256) {
    const size_t e = i * 8;
    const int t = (int)(e >> 10), d = (int)(e & 1023), b = t >> 13;
    const float* m = mod0 + (size_t)b * 6144;
    f32x4 v0 = *(const f32x4*)(x + e), v1 = *(const f32x4*)(x + e + 4);
    f32x4 sh0 = *(const f32x4*)(m + d), sh1 = *(const f32x4*)(m + d + 4);
    f32x4 sc0 = *(const f32x4*)(m + 1024 + d), sc1 = *(const f32x4*)(m + 1024 + d + 4);
    v0 = v0 * (1.f + sc0) + sh0;
    v1 = v1 * (1.f + sc1) + sh1;
    u32x4 o;
    o[0] = pk2(v0[0], v0[1]);
    o[1] = pk2(v0[2], v0[3]);
    o[2] = pk2(v1[0], v1[1]);
    o[3] = pk2(v1[2], v1[3]);
    *(u32x4*)(h + e) = o;
  }
}

DI void ln_phase(float* z, const float* __restrict__ g, const float* __restrict__ bt, const float* modn, int sh_off,
                 u16* __restrict__ h, int bid, int nb) {
  const int tid = opq_tid(), lane = tid & 63, w = __builtin_amdgcn_readfirstlane(tid >> 6);
  for (int row = bid * 4 + w; row < T; row += nb * 4) {
    f32x4* zp = (f32x4*)(z + (size_t)row * 1024);
    f32x4 v[4];
#pragma unroll
    for (int c = 0; c < 4; c++) v[c] = zp[c * 64 + lane];
    float s = 0;
#pragma unroll
    for (int c = 0; c < 4; c++) s += v[c][0] + v[c][1] + v[c][2] + v[c][3];
    const float mu = wave_sum(s) * (1.f / 1024.f);
    float q = 0;
#pragma unroll
    for (int c = 0; c < 4; c++) {
      v[c] = v[c] - mu;
      q += v[c][0] * v[c][0] + v[c][1] * v[c][1] + v[c][2] * v[c][2] + v[c][3] * v[c][3];
    }
    const float rstd = rsqrtf(wave_sum(q) * (1.f / 1024.f) + LN_EPS);
    const int b = row >> 13;
#pragma unroll
    for (int c = 0; c < 4; c++) {
      const int d = c * 256 + lane * 4;
      f32x4 y = v[c] * rstd * *(const f32x4*)(g + d) + *(const f32x4*)(bt + d);
      zp[c * 64 + lane] = y;
      if (modn) {
        const float* m = modn + (size_t)b * 6144 + sh_off;
        f32x4 hv = y * (1.f + *(const f32x4*)(m + 1024 + d)) + *(const f32x4*)(m + d);
        u32x2 o;
        o[0] = pk2(hv[0], hv[1]);
        o[1] = pk2(hv[2], hv[3]);
        *(u32x2*)(h + (size_t)row * 1024 + d) = o;
      }
    }
  }
}

enum { EPI_AIN = 0, EPI_BIN = 1, EPI_RES = 2, EPI_SQRELU = 3 };
struct EpiArgs {
  u16 *o0, *o1, *o2;
  float *f0, *f1;
  const float* xin;
  const float* g;
};

template <int EPI>
DI void gemm_phase(const u16* __restrict__ A, const u16* __restrict__ Bt, int M, int N, int K, const EpiArgs& ea,
                   char* smem, int bid, int nb) {
  constexpr int MI = 4, BM = 64 * MI;
  u16* As = (u16*)smem;
  u16* Bs = As + BM * 72;
  const int tid = opq_tid(), lane = tid & 63, w = __builtin_amdgcn_readfirstlane(tid >> 6), wm = w >> 1, wn = w & 1, l31 = lane & 31, lh = lane >> 5;
  const int ntn = N / 128, ntm = M / BM, nt = ntn * ntm, nk = K / 64;
  const int lr = tid >> 3, lc = (tid & 7) * 8;
  const int xcd = bid & 7, nbx = nb >> 3, cntx = (ntm >> 3) * ntn;
  (void)nt;
  for (int sq = bid >> 3; sq < cntx; sq += nbx) {
    const int tmx = sq / ntn, tn = sq - tmx * ntn;
    const int tm = tmx * 8 + xcd;
    const int m0 = tm * BM, n0 = tn * 128;
    f32x16 acc[MI][2];
#pragma unroll
    for (int i = 0; i < MI; i++)
#pragma unroll
      for (int j = 0; j < 2; j++)
#pragma unroll
        for (int r = 0; r < 16; r++) acc[i][j][r] = 0.f;
    u32x4 ra[2 * MI], rb[4];
    const u16* ap = A + (size_t)(m0 + lr) * K + lc;
    const u16* bp = Bt + (size_t)(n0 + lr) * K + lc;
#pragma unroll
    for (int i = 0; i < 2 * MI; i++) ra[i] = *(const u32x4*)(ap + (size_t)i * 32 * K);
#pragma unroll
    for (int i = 0; i < 4; i++) rb[i] = *(const u32x4*)(bp + (size_t)i * 32 * K);
    __syncthreads();
#pragma unroll
    for (int i = 0; i < 2 * MI; i++) *(u32x4*)&As[(lr + 32 * i) * 72 + lc] = ra[i];
#pragma unroll
    for (int i = 0; i < 4; i++) *(u32x4*)&Bs[(lr + 32 * i) * 72 + lc] = rb[i];
    __syncthreads();
    for (int kt = 0; kt < nk; kt++) {
      if (kt + 1 < nk) {
#pragma unroll
        for (int i = 0; i < 2 * MI; i++) ra[i] = *(const u32x4*)(ap + (size_t)i * 32 * K + (kt + 1) * 64);
#pragma unroll
        for (int i = 0; i < 4; i++) rb[i] = *(const u32x4*)(bp + (size_t)i * 32 * K + (kt + 1) * 64);
      }
#pragma unroll
      for (int ks = 0; ks < 4; ks++) {
        bf16x8 af[MI], b0, b1;
#pragma unroll
        for (int i = 0; i < MI; i++) af[i] = *(const bf16x8*)&As[(wm * 32 * MI + 32 * i + l31) * 72 + ks * 16 + lh * 8];
        b0 = *(const bf16x8*)&Bs[(wn * 64 + l31) * 72 + ks * 16 + lh * 8];
        b1 = *(const bf16x8*)&Bs[(wn * 64 + 32 + l31) * 72 + ks * 16 + lh * 8];
#pragma unroll
        for (int i = 0; i < MI; i++) {
          acc[i][0] = mfma32(b0, af[i], acc[i][0]);
          acc[i][1] = mfma32(b1, af[i], acc[i][1]);
        }
      }
      __syncthreads();
      if (kt + 1 < nk) {
#pragma unroll
        for (int i = 0; i < 2 * MI; i++) *(u32x4*)&As[(lr + 32 * i) * 72 + lc] = ra[i];
#pragma unroll
        for (int i = 0; i < 4; i++) *(u32x4*)&Bs[(lr + 32 * i) * 72 + lc] = rb[i];
        __syncthreads();
      }
    }
    const int bidx = m0 >> 13;
#pragma unroll
    for (int i = 0; i < MI; i++) {
      const int row = m0 + wm * 32 * MI + 32 * i + l31;
#pragma unroll
      for (int j = 0; j < 2; j++) {
#pragma unroll
        for (int r4 = 0; r4 < 4; r4++) {
          const int col = n0 + wn * 64 + 32 * j + 8 * r4 + 4 * lh;
          float v[4];
#pragma unroll
          for (int q = 0; q < 4; q++) v[q] = acc[i][j][4 * r4 + q];
          if (EPI == EPI_AIN) {
            if (col < 1024) {
              u32x2 o;
              o[0] = pk2(v[0], v[1]);
              o[1] = pk2(v[2], v[3]);
              *(u32x2*)(ea.o0 + (size_t)row * 1024 + col) = o;
            } else if (col < 1280) {
              *(f32x4*)(ea.f0 + (size_t)row * 256 + (col - 1024)) = (f32x4){v[0], v[1], v[2], v[3]};
            } else if (col < 1792) {
              u32x2 o;
              o[0] = pk2(v[0], v[1]);
              o[1] = pk2(v[2], v[3]);
              *(u32x2*)(ea.o1 + (size_t)row * 512 + (col - 1280)) = o;
            } else if (col < 1856) {
              const int d = col - 1792;
              const int sidx = row & 8191;
              const size_t off = (size_t)(row >> 13) * S * 64 +
                                 ((size_t)((sidx >> 5) * 4 + (d >> 4)) * 64 + 32 * ((d >> 3) & 1) + (sidx & 31)) * 8 + (d & 7);
              u32x2 o;
              o[0] = pk2(v[0], v[1]);
              o[1] = pk2(v[2], v[3]);
              *(u32x2*)(ea.o2 + off) = o;
            } else if (col < 1864) {
              const float sc = 0.044194173824159216f;
              *(f32x4*)(ea.f1 + (size_t)row * 8 + (col - 1856)) = (f32x4){v[0] * sc, v[1] * sc, v[2] * sc, v[3] * sc};
            }
          } else if (EPI == EPI_BIN) {
            if (col < 1024) {
              const float sc = 0.125f * LOG2E;
              u32x2 o;
              o[0] = pk2(v[0] * sc, v[1] * sc);
              o[1] = pk2(v[2] * sc, v[3] * sc);
              *(u32x2*)(ea.o0 + (size_t)row * 1024 + col) = o;
            } else if (col < 2048) {
              u32x2 o;
              o[0] = pk2(v[0], v[1]);
              o[1] = pk2(v[2], v[3]);
              *(u32x2*)(ea.o1 + (size_t)row * 1024 + (col - 1024)) = o;
            } else {
              const int cv = col - 2048;
#pragma unroll
              for (int q = 0; q < 4; q++) ea.o2[((size_t)bidx * 1024 + cv + q) * 8192 + (row & 8191)] = f2bf(v[q]);
            }
          } else if (EPI == EPI_RES) {
            const f32x4 gg = *(const f32x4*)(ea.g + (size_t)bidx * 6144 + col);
            const size_t o = (size_t)row * 1024 + col;
            const f32x4 xv = *(const f32x4*)(ea.xin + o);
            f32x4 r;
#pragma unroll
            for (int q = 0; q < 4; q++) r[q] = DN_ALPHA * xv[q] + (1.f + gg[q]) * v[q];
            *(f32x4*)(ea.f0 + o) = r;
          } else {
            float r[4];
#pragma unroll
            for (int q = 0; q < 4; q++) {
              r[q] = v[q] > 0.f ? v[q] : 0.f;
              r[q] = r[q] * r[q];
            }
            u32x2 o;
            o[0] = pk2(r[0], r[1]);
            o[1] = pk2(r[2], r[3]);
            *(u32x2*)(ea.o0 + (size_t)row * 4096 + col) = o;
          }
        }
      }
    }
  }
}

DI void ckvnorm_phase(const float* __restrict__ raw, const float* __restrict__ g, u16* __restrict__ outp, int bid,
                      int nb) {
  const int tid = opq_tid(), lane = tid & 63, w = __builtin_amdgcn_readfirstlane(tid >> 6);
  const f32x4 gg = *(const f32x4*)(g + lane * 4);
  for (int row = bid * 4 + w; row < T; row += nb * 4) {
    f32x4 v = *(const f32x4*)(raw + (size_t)row * 256 + lane * 4);
    float ss = v[0] * v[0] + v[1] * v[1] + v[2] * v[2] + v[3] * v[3];
    ss = wave_sum(ss);
    const float r = rsqrtf(ss * (1.f / 256.f) + LN_EPS);
    u32x2 o;
    o[0] = pk2(v[0] * r * gg[0], v[1] * r * gg[1]);
    o[1] = pk2(v[2] * r * gg[2], v[3] * r * gg[3]);
    *(u32x2*)(outp + (size_t)row * 256 + lane * 4) = o;
  }
}

DI unsigned mono_key(float s) {
  unsigned u = __float_as_uint(s);
  return (u & 0x80000000u) ? ~u : (u | 0x80000000u);
}
DI float mono_inv(unsigned k) {
  unsigned u = (k & 0x80000000u) ? (k & 0x7fffffffu) : ~k;
  return __uint_as_float(u);
}
DI float relu_i(float x) {
  int i = __float_as_int(x);
  return __int_as_float(i > 0 ? i : 0);
}
DI int wcount(bool f) { return __popcll(__ballot(f)); }

template <bool EXACT>
DI void compact4(float* vals, u16* idxs, int* cnt, int lane, float* thr_out) {
  constexpr int NPL = CAP / 64;
  unsigned key[4][NPL];
  int n[4];
#pragma unroll
  for (int q = 0; q < 4; q++) n[q] = cnt[q];
#pragma unroll
  for (int q = 0; q < 4; q++)
#pragma unroll
    for (int j = 0; j < NPL; j++) {
      const int e = j * 64 + lane;
      key[q][j] = (e < n[q]) ? mono_key(vals[q * CAP + e]) : 0u;
    }
  unsigned Tk[4] = {0u, 0u, 0u, 0u};
  constexpr int LOWBIT = EXACT ? 0 : 18;
#pragma unroll 1
  for (int bit = 31; bit >= LOWBIT; bit--) {
#pragma unroll
    for (int q = 0; q < 4; q++) {
      const unsigned cand = Tk[q] | (1u << bit);
      int c = 0;
#pragma unroll
      for (int j = 0; j < NPL; j++) c += wcount(key[q][j] >= cand);
      Tk[q] = (c >= TOPK) ? cand : Tk[q];
      if (q == 1) __builtin_amdgcn_sched_barrier(0);
    }
  }
  unsigned I[4] = {0xffffu, 0xffffu, 0xffffu, 0xffffu};
  if (EXACT) {
    unsigned ix[4][NPL];
    int need[4];
#pragma unroll
    for (int q = 0; q < 4; q++) {
      int cgt = 0;
#pragma unroll
      for (int j = 0; j < NPL; j++) {
        const int e = j * 64 + lane;
        ix[q][j] = (e < n[q]) ? (unsigned)idxs[q * CAP + e] : 0xffffu;
        cgt += wcount(key[q][j] > Tk[q]);
      }
      need[q] = TOPK - cgt;
      I[q] = 0u;
    }
#pragma unroll 1
    for (int bit = 13; bit >= 0; bit--) {
#pragma unroll
      for (int q = 0; q < 4; q++) {
        const unsigned cand = I[q] | (1u << bit);
        int c = 0;
#pragma unroll
        for (int j = 0; j < NPL; j++) c += wcount(key[q][j] == Tk[q] && ix[q][j] < cand);
        I[q] = (c < need[q]) ? cand : I[q];
        if (q == 1) __builtin_amdgcn_sched_barrier(0);
      }
    }
  }
  const unsigned long long lt = (1ull << lane) - 1ull;
#pragma unroll
  for (int q = 0; q < 4; q++) {
    if (n[q] > TOPK) {
      int base = 0;
#pragma unroll
      for (int j = 0; j < NPL; j++) {
        const int e = j * 64 + lane;
        const bool in = e < n[q];
        const float v = in ? vals[q * CAP + e] : 0.f;
        const unsigned ixv = in ? (unsigned)idxs[q * CAP + e] : 0xffffu;
        const bool keep = (key[q][j] > Tk[q]) || (key[q][j] == Tk[q] && ixv <= I[q]);
        const unsigned long long m = __ballot(keep);
        if (keep) {
          const int pos = base + __popcll(m & lt);
          vals[q * CAP + pos] = v;
          idxs[q * CAP + pos] = (u16)ixv;
        }
        base += __popcll(m);
      }
      if (lane == 0) cnt[q] = base;
      thr_out[q] = mono_inv(Tk[q]);
    }
  }
}

DI void indexer_phase(const u16* __restrict__ iq, const u16* __restrict__ ik, const float* __restrict__ iw,
                      u16* __restrict__ sel, char* smem, int bid, int nb) {
  constexpr int WBYTES = 4 * CAP * 4 + 4 * CAP * 2 + 64;
  const int tid = opq_tid(), lane = tid & 63, w = __builtin_amdgcn_readfirstlane(tid >> 6), l31 = lane & 31, u = lane >> 5;
  float* vals = (float*)(smem + w * WBYTES);
  u16* idxs = (u16*)(smem + w * WBYTES + 4 * CAP * 4);
  int* cnt = (int*)(smem + w * WBYTES + 4 * CAP * 4 + 4 * CAP * 2);
  const int nitems = NBATCH * (S / 16);
  const int nrounds = (nitems + nb - 1) / nb;
  __syncthreads();
  for (int rd = 0; rd < nrounds; rd++) {
    const int it = rd * nb + ((rd & 1) ? (nb - 1 - bid) : bid);
    if (it >= nitems) continue;
    const int b = it & 3, qg = (S / 16 - 1) - (it >> 2);
    const int t0 = qg * 16;
    const int tw = t0 + 4 * w;
    const size_t tb = (size_t)b * S;
    bf16x8 aq[4];
    {
      const int g = l31 >> 3, up = (l31 >> 2) & 1, j = l31 & 3;
      const int ql = 2 * up + (g >> 1), hd = 4 * (g & 1) + j;
      const u16* qp = iq + (tb + tw + ql) * 512 + hd * 64 + u * 8;
#pragma unroll
      for (int ks = 0; ks < 4; ks++) aq[ks] = *(const bf16x8*)(qp + ks * 16);
    }
    float wq[2][8];
#pragma unroll
    for (int qq = 0; qq < 2; qq++) {
      const float* wp = iw + (tb + tw + 2 * u + qq) * 8;
      f32x4 w0 = *(const f32x4*)wp, w1 = *(const f32x4*)(wp + 4);
#pragma unroll
      for (int h = 0; h < 4; h++) {
        wq[qq][h] = w0[h];
        wq[qq][4 + h] = w1[h];
      }
    }
    float thr[2] = {-INFINITY, -INFINITY};
    __builtin_amdgcn_wave_barrier();
    if (lane < 4) cnt[lane] = 0;
    __builtin_amdgcn_wave_barrier();
    const int nkb = (tw + 3) / 32 + 1;
    const u16* kp = ik + tb * 64 + lane * 8;
    bf16x8 ring[4][4];
#pragma unroll
    for (int i = 0; i < 4; i++) {
      const int kbn = (i < nkb) ? i : nkb - 1;
#pragma unroll
      for (int ks = 0; ks < 4; ks++) ring[i][ks] = *(const bf16x8*)(kp + (size_t)(kbn * 4 + ks) * 512);
    }
#pragma unroll 1
    for (int kb0 = 0; kb0 < nkb; kb0 += 4) {
#pragma unroll
      for (int i = 0; i < 4; i++) {
        const int kb = kb0 + i;
        {
          f32x16 acc;
#pragma unroll
          for (int r = 0; r < 16; r++) acc[r] = 0.f;
#pragma unroll
          for (int ks = 0; ks < 4; ks++) acc = mfma32(aq[ks], ring[i][ks], acc);
          {
            const int kbn = (kb + 4 < nkb) ? kb + 4 : nkb - 1;
#pragma unroll
            for (int ks = 0; ks < 4; ks++) ring[i][ks] = *(const bf16x8*)(kp + (size_t)(kbn * 4 + ks) * 512);
          }
          const int key = kb * 32 + l31;
#pragma unroll
          for (int qq = 0; qq < 2; qq++) {
            float s0 = 0.f, s1 = 0.f;
#pragma unroll
            for (int h = 0; h < 8; h += 2) {
              s0 = fmaf(wq[qq][h], relu_i(acc[8 * qq + h]), s0);
              s1 = fmaf(wq[qq][h + 1], relu_i(acc[8 * qq + h + 1]), s1);
            }
            float s = s0 + s1;
            s += 0.0f;
            const int tq = tw + 2 * u + qq;
            if (key <= tq && s >= thr[qq]) {
              const int qs = 2 * u + qq;
              const int pos = atomicAdd(&cnt[qs], 1);
              vals[qs * CAP + pos] = s;
              idxs[qs * CAP + pos] = (u16)key;
            }
          }
        }
      }
      __builtin_amdgcn_wave_barrier();
      const int c0 = cnt[0], c1 = cnt[1], c2 = cnt[2], c3 = cnt[3];
      if (c0 > CAP - 128 || c1 > CAP - 128 || c2 > CAP - 128 || c3 > CAP - 128) {
        float to[4] = {0.f, 0.f, 0.f, 0.f};
        compact4<false>(vals, idxs, cnt, lane, to);
        __builtin_amdgcn_wave_barrier();
        const int d0 = cnt[0], d1 = cnt[1], d2 = cnt[2], d3 = cnt[3];
        if (d0 > CAP - 256 || d1 > CAP - 256 || d2 > CAP - 256 || d3 > CAP - 256) {
          compact4<true>(vals, idxs, cnt, lane, to);
          __builtin_amdgcn_wave_barrier();
        }
        if (c0 > TOPK && u == 0) thr[0] = to[0];
        if (c1 > TOPK && u == 0) thr[1] = to[1];
        if (c2 > TOPK && u == 1) thr[0] = to[2];
        if (c3 > TOPK && u == 1) thr[1] = to[3];
      }
    }
    {
      const int c0 = cnt[0], c1 = cnt[1], c2 = cnt[2], c3 = cnt[3];
      if (c0 > TOPK || c1 > TOPK || c2 > TOPK || c3 > TOPK) {
        float to[4];
        compact4<true>(vals, idxs, cnt, lane, to);
        __builtin_amdgcn_wave_barrier();
      }
    }
#pragma unroll 1
    for (int qs = 0; qs < 4; qs++) {
      const int n = cnt[qs];
      u16* sp = sel + (tb + tw + qs) * 256;
#pragma unroll
      for (int j = 0; j < 4; j++) {
        const int e = j * 64 + lane;
        sp[e] = (e < n) ? idxs[qs * CAP + e] : (u16)0xffffu;
      }
    }
  }
}

DI void sparse_phase(const u16* __restrict__ q, const u16* __restrict__ ckvn, const u16* __restrict__ sel,
                     const u16* __restrict__ wuk, const u16* __restrict__ wuv, const float* __restrict__ rel_bias,
                     u16* scratch, u16* __restrict__ o, char* smem, int bid, int nb) {
  constexpr int GS = 264;
  const int tid = opq_tid(), lane = tid & 63, w = __builtin_amdgcn_readfirstlane(tid >> 6), l15 = lane & 15, g = lane >> 4;
  u16* G = (u16*)smem + (size_t)w * 32 * GS;
  int* lut = (int*)(smem + 4 * 32 * GS * 2);
  float* rb = (float*)(lut + 128);
  __syncthreads();
  if (tid < 128) lut[tid] = rel_bucket(tid);
  for (int i = tid; i < 512; i += 256) rb[i] = rel_bias[i] * LOG2E;
  __syncthreads();
  u16* ql = scratch + (size_t)bid * (16 * 16 * 256);
  const int nitems = NBATCH * (S / 16);
  for (int it = bid; it < nitems; it += nb) {
    const int b = it & 3, qg = it >> 2;
    const int t0 = qg * 16;
    const size_t tb = (size_t)b * S;
    for (int hh = 0; hh < 4; hh++) {
      const int h = 4 * w + hh;
      bf16x8 bq[2];
#pragma unroll
      for (int ks = 0; ks < 2; ks++) bq[ks] = *(const bf16x8*)(q + (tb + t0 + l15) * 1024 + h * 64 + ks * 32 + g * 8);
#pragma unroll 4
      for (int rt = 0; rt < 16; rt++) {
        f32x4 acc = {0.f, 0.f, 0.f, 0.f};
#pragma unroll
        for (int ks = 0; ks < 2; ks++) {
          bf16x8 a = *(const bf16x8*)(wuk + ((size_t)h * 256 + rt * 16 + l15) * 64 + ks * 32 + g * 8);
          acc = mfma16(a, bq[ks], acc);
        }
        u32x2 ov;
        ov[0] = pk2(acc[0] * (0.125f * LOG2E), acc[1] * (0.125f * LOG2E));
        ov[1] = pk2(acc[2] * (0.125f * LOG2E), acc[3] * (0.125f * LOG2E));
        *(u32x2*)(ql + ((size_t)l15 * 16 + h) * 256 + rt * 16 + 4 * g) = ov;
      }
    }
    __syncthreads();
    {
      const u16* selw = sel + (tb + t0 + 4 * w) * 256;
      const int l31 = lane & 31;
      const int q4 = l15 >> 2, p4 = l15 & 3;
      const u16* ckb = ckvn + tb * 256;
      int idx_c = selw[l31];
      int idx_n = selw[32 + l31];
      u32x4 gr[16];
#pragma unroll
      for (int i = 0; i < 16; i++) {
        int id = __shfl(idx_c, (lane >> 5) + 2 * i);
        id = (id == 0xffff) ? 0 : id;
        gr[i] = *(const u32x4*)(ckb + (unsigned)(id * 256 + l31 * 8));
      }
      bf16x8 qb[8];
      float m_run = NEGF, l_run = 0.f;
      f32x4 O[16];
#pragma unroll 1
      for (int st = 0; st < 32; st++) {
        const int qi = st >> 3, ch = st & 7;
        const int qloc = 4 * w + qi;
        const int t = t0 + qloc;
        if (ch == 0) {
#pragma unroll
          for (int ks = 0; ks < 8; ks++) qb[ks] = *(const bf16x8*)(ql + ((size_t)qloc * 16 + l15) * 256 + ks * 32 + g * 8);
          m_run = NEGF;
          l_run = 0.f;
#pragma unroll
          for (int rt = 0; rt < 16; rt++) O[rt] = (f32x4){0.f, 0.f, 0.f, 0.f};
        }
#pragma unroll
        for (int i = 0; i < 16; i++) *(u32x4*)&G[((lane >> 5) + 2 * i) * GS + l31 * 8] = gr[i];
        __builtin_amdgcn_wave_barrier();
        const int stn2 = (st + 2 < 32) ? st + 2 : 31;
        const int idx_nn = selw[stn2 * 32 + l31];
#pragma unroll
        for (int i = 0; i < 16; i++) {
          int id = __shfl(idx_n, (lane >> 5) + 2 * i);
          id = (id == 0xffff) ? 0 : id;
          gr[i] = *(const u32x4*)(ckb + (unsigned)(id * 256 + l31 * 8));
        }
        float lg[2][4];
#pragma unroll
        for (int kbk = 0; kbk < 2; kbk++) {
          f32x4 acc = {0.f, 0.f, 0.f, 0.f};
#pragma unroll
          for (int ks = 0; ks < 8; ks++) {
            bf16x8 a = *(const bf16x8*)&G[(16 * kbk + l15) * GS + ks * 32 + g * 8];
            acc = mfma16(a, qb[ks], acc);
            if (ks == 3) asm volatile("" ::: "memory");
          }
          asm volatile("" ::: "memory");
#pragma unroll
          for (int i = 0; i < 4; i++) {
            const int kid = __shfl(idx_c, 16 * kbk + 4 * g + i);
            float v = NEGF;
            if (kid != 0xffff) {
              int n = t - kid;
              n = n < 0 ? 0 : n;
              const int bk = n < 128 ? lut[n] : 31;
              v = acc[i] + rb[bk * 16 + l15];
            }
            lg[kbk][i] = v;
          }
        }
        float mx = fmaxf(fmaxf(fmaxf(lg[0][0], lg[0][1]), fmaxf(lg[0][2], lg[0][3])),
                         fmaxf(fmaxf(lg[1][0], lg[1][1]), fmaxf(lg[1][2], lg[1][3])));
        mx = fmaxf(mx, __shfl_xor(mx, 16));
        mx = fmaxf(mx, __shfl_xor(mx, 32));
        const float m_new = fmaxf(m_run, mx);
        const float scl = __builtin_amdgcn_exp2f(m_run - m_new);
        m_run = m_new;
        float ps = 0.f;
        float pe[8];
#pragma unroll
        for (int kbk = 0; kbk < 2; kbk++)
#pragma unroll
          for (int i = 0; i < 4; i++) {
            const float pv = __builtin_amdgcn_exp2f(lg[kbk][i] - m_new);
            pe[kbk * 4 + i] = pv;
            ps += pv;
          }
        l_run = l_run * scl + ps;
        u32x4 pw;
        pw[0] = pk2(pe[0], pe[1]);
        pw[1] = pk2(pe[2], pe[3]);
        pw[2] = pk2(pe[4], pe[5]);
        pw[3] = pk2(pe[6], pe[7]);
        const bf16x8 pB = __builtin_bit_cast(bf16x8, pw);
        if (__ballot(scl != 1.f)) {
#pragma unroll
          for (int rt = 0; rt < 16; rt++) O[rt] = O[rt] * scl;
        }
#pragma unroll
        for (int rt = 0; rt < 16; rt++) {
          const s16x4 lo = __builtin_amdgcn_ds_read_tr16_b64_v4i16((lds_s16x4_ptr)(&G[(4 * g + q4) * GS + rt * 16 + 4 * p4]));
          const s16x4 hi = __builtin_amdgcn_ds_read_tr16_b64_v4i16((lds_s16x4_ptr)(&G[(16 + 4 * g + q4) * GS + rt * 16 + 4 * p4]));
          const bf16x8 a = (bf16x8){lo[0], lo[1], lo[2], lo[3], hi[0], hi[1], hi[2], hi[3]};
          O[rt] = mfma16(a, pB, O[rt]);
          if ((rt & 3) == 3) asm volatile("" ::: "memory");
        }
        __builtin_amdgcn_wave_barrier();
        if (ch == 7) {
          float lt = l_run;
          lt += __shfl_xor(lt, 16);
          lt += __shfl_xor(lt, 32);
          const float inv = 1.f / lt;
#pragma unroll
          for (int rt = 0; rt < 16; rt++) {
            u32x2 ov;
            ov[0] = pk2(O[rt][0] * inv, O[rt][1] * inv);
            ov[1] = pk2(O[rt][2] * inv, O[rt][3] * inv);
            *(u32x2*)(ql + ((size_t)qloc * 16 + l15) * 256 + rt * 16 + 4 * g) = ov;
          }
        }
        idx_c = idx_n;
        idx_n = idx_nn;
      }
    }
    __syncthreads();
    for (int hh = 0; hh < 4; hh++) {
      const int h = 4 * w + hh;
      bf16x8 bo[8];
#pragma unroll
      for (int ks = 0; ks < 8; ks++) bo[ks] = *(const bf16x8*)(ql + ((size_t)l15 * 16 + h) * 256 + ks * 32 + g * 8);
#pragma unroll
      for (int et = 0; et < 4; et++) {
        f32x4 acc = {0.f, 0.f, 0.f, 0.f};
#pragma unroll
        for (int ks = 0; ks < 8; ks++) {
          bf16x8 a = *(const bf16x8*)(wuv + ((size_t)h * 64 + et * 16 + l15) * 256 + ks * 32 + g * 8);
          acc = mfma16(a, bo[ks], acc);
        }
        u32x2 ov;
        ov[0] = pk2(acc[0], acc[1]);
        ov[1] = pk2(acc[2], acc[3]);
        *(u32x2*)(o + (tb + t0 + l15) * 1024 + h * 64 + et * 16 + 4 * g) = ov;
      }
    }
    __syncthreads();
  }
}

DI void diffattn_phase(const u16* __restrict__ q, const u16* __restrict__ k, const u16* __restrict__ vT,
                       u16* __restrict__ o, const float* __restrict__ rel_bias, const float* __restrict__ lam,
                       const float* __restrict__ subln, int layer_idx, char* smem, int bid, int nb) {
  constexpr int KS = 136, VS = 72;
  u16* Ks = (u16*)smem;
  u16* Vs = Ks + 64 * KS;
  float* exch = (float*)smem;
  float* btab = (float*)(smem + 36 * 1024);
  int* lut = (int*)(smem + 36 * 1024 + 1040);
  float* misc = (float*)(smem + 36 * 1024 + 1040 + 512);
  const int tid = opq_tid(), lane = tid & 63, w = __builtin_amdgcn_readfirstlane(tid >> 6), l31 = lane & 31, lh = lane >> 5;
  const int qsub = w >> 1, m = w & 1;
  const float lam_init = 0.8f - 0.6f * expf(-0.3f * (float)layer_idx);
  __syncthreads();
  if (tid < 128) lut[tid] = rel_bucket(tid);
  if (w == 0) {
    float p1 = lam[lane] * lam[64 + lane], p2 = lam[128 + lane] * lam[192 + lane];
    p1 = wave_sum(p1);
    p2 = wave_sum(p2);
    if (lane == 0) misc[0] = expf(p1) - expf(p2) + lam_init;
  }
  __syncthreads();
  const float lam_full = misc[0];
  const int xcd = bid & 7, loc = bid >> 3, nbx = nb >> 3;
  const int rph = (S / 64) / nbx;
  const int prow = pi_row(l31);
  for (int rd = 0; rd < 4 * rph; rd++) {
    const int hh = rd / rph, r = rd - hh * rph;
    const int bh = xcd + 8 * hh;
    const int kk = r >> 1;
    const int qb = (r & 1) ? (kk * nbx + loc) : ((S / 64 - 1) - kk * nbx - loc);
    const int b = bh >> 3, h = bh & 7;
    const int q0 = qb * 64, tq0 = q0 + 32 * qsub, t = tq0 + l31;
    const size_t tb = (size_t)b * S;
    __syncthreads();
    for (int i = tid; i < 258; i += 256) {
      const int n = i >> 1, mm = i & 1;
      const int bk = n < 128 ? lut[n] : 31;
      btab[i] = rel_bias[bk * 16 + 2 * h + mm] * LOG2E;
    }
    bf16x8 qf[4];
#pragma unroll
    for (int ks = 0; ks < 4; ks++) qf[ks] = *(const bf16x8*)(q + (tb + t) * 1024 + h * 128 + m * 64 + ks * 16 + lh * 8);
    f32x16 O[4];
#pragma unroll
    for (int et = 0; et < 4; et++)
#pragma unroll
      for (int r = 0; r < 16; r++) O[et][r] = 0.f;
    float m_run = NEGF, l_run = 0.f;
    const int nkt = qb + 1;
    u32x4 rk[4], rv[4];
    const u16* kp = k + tb * 1024 + h * 128;
    const u16* vp = vT + ((size_t)(b * 8 + h) * 128) * 8192;
#pragma unroll
    for (int i = 0; i < 4; i++) {
      const int id = tid + 256 * i;
      rk[i] = *(const u32x4*)(kp + (size_t)(id >> 4) * 1024 + (id & 15) * 8);
      rv[i] = *(const u32x4*)(vp + (size_t)(id >> 3) * 8192 + (id & 7) * 8);
    }
#pragma unroll
    for (int i = 0; i < 4; i++) {
      const int id = tid + 256 * i;
      *(u32x4*)&Ks[(id >> 4) * KS + (id & 15) * 8] = rk[i];
      *(u32x4*)&Vs[(id >> 3) * VS + (id & 7) * 8] = rv[i];
    }
    __syncthreads();
    const float cfar = btab[256 + m];
    for (int kt = 0; kt < nkt; kt++) {
      if (kt + 1 < nkt) {
#pragma unroll
        for (int i = 0; i < 4; i++) {
          const int id = tid + 256 * i;
          rk[i] = *(const u32x4*)(kp + (size_t)((kt + 1) * 64 + (id >> 4)) * 1024 + (id & 15) * 8);
          rv[i] = *(const u32x4*)(vp + (size_t)(id >> 3) * 8192 + (kt + 1) * 64 + (id & 7) * 8);
        }
      }
      const int s_tile = kt * 64;
      const int nblk = (s_tile + 32 <= tq0 + 31) ? 2 : 1;
#pragma unroll 1
      for (int kb = 0; kb < nblk; kb++) {
        const int s0 = s_tile + 32 * kb;
        const bool nearb = (tq0 - (s0 + 31)) < 128;
        const bool first = (kt == 0) && (kb == 0);
        const float mref = first ? 0.f : m_run;
        const float cinit = nearb ? -mref : (cfar - mref);
        f32x16 acc;
#pragma unroll
        for (int r = 0; r < 16; r++) acc[r] = cinit;
#pragma unroll
        for (int ks = 0; ks < 4; ks++) {
          bf16x8 a = *(const bf16x8*)&Ks[(32 * kb + prow) * KS + m * 64 + ks * 16 + lh * 8];
          acc = mfma32(a, qf[ks], acc);
        }
        if (nearb) {
#pragma unroll
          for (int r = 0; r < 16; r++) {
            const int key = s0 + 16 * (r >> 3) + 8 * lh + (r & 7);
            const int n = t - key;
            const int nc = n < 0 ? 0 : (n > 128 ? 128 : n);
            const float bv = btab[nc * 2 + m];
            acc[r] = (n < 0) ? NEGF : acc[r] + bv;
          }
        }
        float mx = acc[0];
#pragma unroll
        for (int r = 1; r < 16; r++) mx = fmaxf(mx, acc[r]);
        mx = fmaxf(mx, __shfl_xor(mx, 32));
        if (first || __ballot(mx > 8.f)) {
          const float dlt = first ? mx : fmaxf(mx, 0.f);
          const float scl = __builtin_amdgcn_exp2f(-dlt);
#pragma unroll
          for (int r = 0; r < 16; r++) acc[r] -= dlt;
#pragma unroll
          for (int et = 0; et < 4; et++)
#pragma unroll
            for (int r = 0; r < 16; r++) O[et][r] *= scl;
          l_run *= scl;
          m_run = mref + dlt;
        }
        float ps = 0.f;
#pragma unroll
        for (int r = 0; r < 16; r++) {
          const float pv = __builtin_amdgcn_exp2f(acc[r]);
          acc[r] = pv;
          ps += pv;
        }
        l_run += ps;
#pragma unroll
        for (int s2 = 0; s2 < 2; s2++) {
          u32x4 pw;
          pw[0] = pk2(acc[8 * s2 + 0], acc[8 * s2 + 1]);
          pw[1] = pk2(acc[8 * s2 + 2], acc[8 * s2 + 3]);
          pw[2] = pk2(acc[8 * s2 + 4], acc[8 * s2 + 5]);
          pw[3] = pk2(acc[8 * s2 + 6], acc[8 * s2 + 7]);
          const bf16x8 pB = __builtin_bit_cast(bf16x8, pw);
#pragma unroll
          for (int et = 0; et < 4; et++) {
            bf16x8 a = *(const bf16x8*)&Vs[(32 * et + l31) * VS + 32 * kb + 16 * s2 + 8 * lh];
            O[et] = mfma32(a, pB, O[et]);
          }
        }
      }
      __syncthreads();
      if (kt + 1 < nkt) {
#pragma unroll
        for (int i = 0; i < 4; i++) {
          const int id = tid + 256 * i;
          *(u32x4*)&Ks[(id >> 4) * KS + (id & 15) * 8] = rk[i];
          *(u32x4*)&Vs[(id >> 3) * VS + (id & 7) * 8] = rv[i];
        }
        __syncthreads();
      }
    }
    float lt = l_run + __shfl_xor(l_run, 32);
    const float inv = 1.f / lt;
    if (m == 1) {
#pragma unroll
      for (int et = 0; et < 4; et++)
#pragma unroll
        for (int r = 0; r < 16; r++) {
          const int e = 32 * et + (r & 3) + 8 * (r >> 2) + 4 * lh;
          exch[(qsub * 128 + e) * 32 + l31] = O[et][r] * inv;
        }
    }
    __syncthreads();
    if (m == 0) {
      float ss = 0.f;
#pragma unroll
      for (int et = 0; et < 4; et++)
#pragma unroll
        for (int r = 0; r < 16; r++) {
          const int e = 32 * et + (r & 3) + 8 * (r >> 2) + 4 * lh;
          const float v = O[et][r] * inv - lam_full * exch[(qsub * 128 + e) * 32 + l31];
          O[et][r] = v;
          ss += v * v;
        }
      ss += __shfl_xor(ss, 32);
      const float rs = rsqrtf(ss * (1.f / 128.f) + LN_EPS);
      const float osc = 1.f - lam_init;
#pragma unroll
      for (int et = 0; et < 4; et++)
#pragma unroll
        for (int r4 = 0; r4 < 4; r4++) {
          const int e = 32 * et + 8 * r4 + 4 * lh;
          const f32x4 gv = *(const f32x4*)(subln + e);
          u32x2 ov;
          ov[0] = pk2(O[et][4 * r4 + 0] * rs * gv[0] * osc, O[et][4 * r4 + 1] * rs * gv[1] * osc);
          ov[1] = pk2(O[et][4 * r4 + 2] * rs * gv[2] * osc, O[et][4 * r4 + 3] * rs * gv[3] * osc);
          *(u32x2*)(o + (tb + t) * 1024 + h * 128 + e) = ov;
        }
    }
  }
}

#define XB_TMO      128
#define XB_XCNT(j)  (256  + 64 * (j))
#define XB_XSUB(j)  (1280 + 64 * (j))
#define XB_XGEN(j)  (2304 + 64 * (j))
#define XB_TOP      3328
#define XB_TOPGEN   3392
#define XCD_BAR_WORDS 3456
#define XB_SPIN_CAP (1u << 20)
#define LAS __attribute__((address_space(3)))
DI unsigned xb_ld(unsigned* p) { return __hip_atomic_load(p, __ATOMIC_RELAXED, __HIP_MEMORY_SCOPE_AGENT); }
DI unsigned xb_add(unsigned* p, unsigned v) { return __hip_atomic_fetch_add(p, v, __ATOMIC_RELAXED, __HIP_MEMORY_SCOPE_AGENT); }
DI unsigned xb_xcc_id() { return (unsigned)__builtin_amdgcn_s_getreg((3 << 11) | 20) & 0xFu; }
#define XB_SPIN(cond, bar) do { unsigned _sp = 0; while (cond) { __builtin_amdgcn_s_sleep(1); \
    if ((++_sp & 255u) == 0u) { if (xb_ld(&(bar)[XB_TMO])) break; if (_sp > XB_SPIN_CAP) { atomicAdd(&(bar)[XB_TMO], 1u); break; } } } } while (0)
struct XcdBarrier {
  unsigned* bar;
  unsigned x;
  volatile LAS unsigned* st;
};
DI XcdBarrier xcd_barrier_post(unsigned* bar, volatile LAS unsigned* st) {
  XcdBarrier b;
  b.bar = bar;
  b.x = xb_xcc_id();
  b.st = st;
  if (threadIdx.x == 0) (void)xb_add(&bar[XB_XCNT(b.x)], 1u);
  return b;
}
DI void xcd_barrier_complete(unsigned* bar, unsigned x, unsigned& nloc, unsigned& nx) {
  const unsigned G = gridDim.x * gridDim.y * gridDim.z;
  unsigned sum, cnt, mine, sp = 0u;
  for (;;) {
    sum = 0u; cnt = 0u; mine = 0u;
#pragma unroll
    for (unsigned j = 0; j < 16; ++j) {
      const unsigned c = xb_ld(&bar[XB_XCNT(j)]);
      sum += c;
      cnt += (c > 0u) ? 1u : 0u;
      mine = (j == x) ? c : mine;
    }
    if (sum == G) break;
    __builtin_amdgcn_s_sleep(1);
    if ((++sp & 255u) == 0u) { if (xb_ld(&bar[XB_TMO])) break; if (sp > XB_SPIN_CAP) { atomicAdd(&bar[XB_TMO], 1u); break; } }
  }
  nloc = mine > 0u ? mine : 1u;
  nx = cnt > 0u ? cnt : 1u;
}
DI void xcd_barrier(const XcdBarrier& b0) {
  asm volatile("s_waitcnt vmcnt(0)" ::: "memory");
  __syncthreads();
  if (threadIdx.x == 0) {
    XcdBarrier b = b0;
    b.x = __builtin_amdgcn_readfirstlane(xb_xcc_id());
    unsigned* bar = b.bar;
    asm volatile("" : "+s"(bar));
    __builtin_amdgcn_s_waitcnt(0);
    unsigned nloc = b.st[0], nx = b.st[1];
    if (nloc == 0u) { xcd_barrier_complete(bar, b.x, nloc, nx); b.st[0] = nloc; b.st[1] = nx; }
    const unsigned old = xb_add(&bar[XB_XSUB(b.x)], 1u);
    const unsigned gen = old / nloc;
    if (old + 1u == (gen + 1u) * nloc) {
      __builtin_amdgcn_fence(__ATOMIC_RELEASE, "agent");
      asm volatile("s_waitcnt vmcnt(0)" ::: "memory");
      const unsigned og = xb_add(&bar[XB_TOP], 1u);
      const unsigned tg = og / nx;
      if (og + 1u == (tg + 1u) * nx) xb_add(&bar[XB_TOPGEN], 1u);
      else XB_SPIN(xb_ld(&bar[XB_TOPGEN]) == tg, bar);
      __builtin_amdgcn_fence(__ATOMIC_ACQUIRE, "agent");
      xb_add(&bar[XB_XGEN(b.x)], 1u);
      asm volatile("s_waitcnt vmcnt(0)" ::: "memory");
    } else {
      XB_SPIN(xb_ld(&bar[XB_XGEN(b.x)]) == gen, bar);
      __builtin_amdgcn_fence(__ATOMIC_ACQUIRE, "agent");
      asm volatile("s_waitcnt vmcnt(0)" ::: "memory");
    }
  }
  __syncthreads();
}

#define DECL_WS_PTRS(ws) \
  u16* w_ain = (u16*)(ws + W_AIN); \
  u16* w_uk = (u16*)(ws + W_UK); \
  u16* w_uv = (u16*)(ws + W_UV); \
  u16* w_ao = (u16*)(ws + W_AO); \
  u16* w_bin = (u16*)(ws + W_BIN); \
  u16* w_bo = (u16*)(ws + W_BO); \
  u16* w_w1 = (u16*)(ws + W_W1); \
  u16* w_w2 = (u16*)(ws + W_W2); \
  float* mod = (float*)(ws + WS_MOD); \
  u16* hbuf = (u16*)(ws + WS_H); \
  char* big = ws + WS_BIG; \
  u16* qbuf = (u16*)(big + B_Q); \
  u16* iqbuf = (u16*)(big + B_IQ); \
  u16* ikbuf = (u16*)(big + B_IK); \
  float* iwbuf = (float*)(big + B_IW); \
  float* ckvraw = (float*)(big + B_CKVRAW); \
  u16* ckvn = (u16*)(big + B_CKVN); \
  u16* selbuf = (u16*)(big + B_SEL); \
  u16* kbuf = (u16*)(big + B_K); \
  u16* vtbuf = (u16*)(big + B_VT); \
  u16* obuf = (u16*)(big + B_O); \
  u16* hid = (u16*)big;

__global__ void __launch_bounds__(256, 2) hybrid_fwd(Params p) {
  __shared__ __attribute__((aligned(16))) char smem[LDS_BYTES];
  cg::grid_group grid = cg::this_grid();
  const int bid = blockIdx.x, nb = gridDim.x;
  char* ws = p.ws;
  unsigned* bar = (unsigned*)(ws + WS_BAR);
  volatile LAS unsigned* xst = (volatile LAS unsigned*)(smem + LDS_BYTES - 16);
  if (threadIdx.x < 2) xst[threadIdx.x] = 0u;
  __syncthreads();
  const XcdBarrier xb = xcd_barrier_post(bar, xst);

  {
  DECL_WS_PTRS(ws)
  (void)qbuf; (void)iqbuf; (void)ikbuf; (void)iwbuf; (void)ckvraw; (void)ckvn; (void)selbuf; (void)kbuf; (void)vtbuf; (void)obuf; (void)hid;
  tconv_phase(p.a_w_in, w_ain, 2, 1024, 1864, A_INP, smem, bid, nb);
  tconv_phase(p.a_w_uk, w_uk, 32, 64, 256, 256, smem, bid, nb);
  tconv_phase(p.a_w_uv, w_uv, 32, 256, 64, 64, smem, bid, nb);
  tconv_phase(p.a_w_o, w_ao, 2, 1024, 1024, 1024, smem, bid, nb);
  tconv_phase(p.b_w_in, w_bin, 2, 1024, 3072, 3072, smem, bid, nb);
  tconv_phase(p.b_w_o, w_bo, 2, 1024, 1024, 1024, smem, bid, nb);
  tconv_phase(p.mlp_w1, w_w1, 4, 1024, 4096, 4096, smem, bid, nb);
  tconv_phase(p.mlp_w2, w_w2, 4, 4096, 1024, 1024, smem, bid, nb);
  mod_phase(p, mod, smem, bid, nb);
  grid.sync();
  h0_phase(p.x, mod, hbuf, bid, nb);
  xcd_barrier(xb);
  }

#pragma unroll 1
  for (int sl = 0; sl < 8; sl++) {
    char* wsl = p.ws;
    asm volatile("" : "+s"(wsl));
    DECL_WS_PTRS(wsl)
    const int i = sl >> 1, j = i >> 1;
    const float* modi = mod + (size_t)i * 4 * 6144;
    const u16* Ares;
    const u16* Wres;
    int Kres, goff;
    if ((sl & 1) == 0) {
      if ((i & 1) == 0) {
        EpiArgs ea{};
        ea.o0 = qbuf; ea.f0 = ckvraw; ea.o1 = iqbuf; ea.o2 = ikbuf; ea.f1 = iwbuf;
        for (int rep = 0; rep < (PROBE_DUP == 4 ? 2 : 1); rep++) gemm_phase<EPI_AIN>(hbuf, w_ain + (size_t)j * A_INP * 1024, T, A_INP, 1024, ea, smem, bid, nb);
        xcd_barrier(xb);
        ckvnorm_phase(ckvraw, p.a_kv_norm + j * 256, ckvn, bid, nb);
        for (int rep = 0; rep < (PROBE_DUP == 2 ? 2 : 1); rep++) indexer_phase(iqbuf, ikbuf, iwbuf, selbuf, smem, bid, nb);
        xcd_barrier(xb);
        for (int rep = 0; rep < (PROBE_DUP == 3 ? 2 : 1); rep++) sparse_phase(qbuf, ckvn, selbuf, w_uk + (size_t)j * 16 * 256 * 64, w_uv + (size_t)j * 16 * 256 * 64, p.rel_bias,
                     hbuf, obuf, smem, bid, nb);
        xcd_barrier(xb);
        Wres = w_ao + (size_t)j * 1024 * 1024;
      } else {
        EpiArgs ea{};
        ea.o0 = qbuf; ea.o1 = kbuf; ea.o2 = vtbuf;
        for (int rep = 0; rep < (PROBE_DUP == 4 ? 2 : 1); rep++) gemm_phase<EPI_BIN>(hbuf, w_bin + (size_t)j * 3072 * 1024, T, 3072, 1024, ea, smem, bid, nb);
        xcd_barrier(xb);
        for (int rep = 0; rep < (PROBE_DUP == 1 ? 2 : 1); rep++) diffattn_phase(qbuf, kbuf, vtbuf, obuf, p.rel_bias, p.b_lambda + j * 256, p.b_subln + j * 128, i, smem, bid, nb);
        xcd_barrier(xb);
        Wres = w_bo + (size_t)j * 1024 * 1024;
      }
      Ares = obuf; Kres = 1024; goff = 2 * 1024;
    } else {
      EpiArgs ea{};
      ea.o0 = hid;
      for (int rep = 0; rep < (PROBE_DUP == 4 ? 2 : 1); rep++) gemm_phase<EPI_SQRELU>(hbuf, w_w1 + (size_t)i * 4096 * 1024, T, 4096, 1024, ea, smem, bid, nb);
      xcd_barrier(xb);
      Ares = hid; Wres = w_w2 + (size_t)i * 4096 * 1024; Kres = 4096; goff = 5 * 1024;
    }
    {
      EpiArgs ea{};
      ea.f0 = p.out;
      ea.xin = (sl == 0) ? p.x : (const float*)p.out;
      ea.g = modi + goff;
      gemm_phase<EPI_RES>(Ares, Wres, T, 1024, Kres, ea, smem, bid, nb);
    }
    xcd_barrier(xb);
    {
      const float* modn = ((sl & 1) == 0) ? modi : (i < 3 ? modi + 4 * 6144 : (const float*)nullptr);
      const int sh_off = ((sl & 1) == 0) ? 3 * 1024 : 0;
      ln_phase(p.out, p.ln_g + (size_t)(i * 2 + (sl & 1)) * 1024, p.ln_b + (size_t)(i * 2 + (sl & 1)) * 1024, modn, sh_off,
               hbuf, bid, nb);
    }
    xcd_barrier(xb);
  }
}

extern "C" void kernel_launch(void* const* d_in, const int* in_sizes, int n_in, void* d_out, int out_size, void* d_ws,
                              size_t ws_size, hipStream_t stream) {
  static int grid_blocks = 0;
  if (!grid_blocks) {
    int dev = 0, cus = 0, per_cu = 0;
    hipGetDevice(&dev);
    hipDeviceGetAttribute(&cus, hipDeviceAttributeMultiprocessorCount, dev);
    hipOccupancyMaxActiveBlocksPerMultiprocessor(&per_cu, hybrid_fwd, 256, 0);
    if (per_cu < 1) per_cu = 1;
    if (per_cu > 2) per_cu = 2;
    grid_blocks = cus * per_cu;
    if (grid_blocks > 512) grid_blocks = 512;
  }
  Params p{};
  p.x = (const float*)d_in[0];
  p.c = (const float*)d_in[1];
  p.rel_bias = (const float*)d_in[2];
  p.ada_w = (const float*)d_in[3];
  p.ada_b = (const float*)d_in[4];
  p.ln_g = (const float*)d_in[5];
  p.ln_b = (const float*)d_in[6];
  p.a_w_in = (const float*)d_in[7];
  p.a_kv_norm = (const float*)d_in[8];
  p.a_w_uk = (const float*)d_in[9];
  p.a_w_uv = (const float*)d_in[10];
  p.a_w_o = (const float*)d_in[11];
  p.b_w_in = (const float*)d_in[12];
  p.b_lambda = (const float*)d_in[13];
  p.b_subln = (const float*)d_in[14];
  p.b_w_o = (const float*)d_in[15];
  p.mlp_w1 = (const float*)d_in[16];
  p.mlp_w2 = (const float*)d_in[17];
  p.out = (float*)d_out;
  p.ws = (char*)d_ws;
  hipMemsetAsync((char*)d_ws + WS_BAR, 0, XCD_BAR_WORDS * 4, stream);
  void* args[] = {&p};
  hipError_t e = hipLaunchCooperativeKernel((void*)hybrid_fwd, dim3(grid_blocks), dim3(256), args, 0, stream);
  if (e != hipSuccess) fprintf(stderr, "cooperative launch failed: %s (grid %d)\n", hipGetErrorString(e), grid_blocks);
}
```

```cpp
#include <hip/hip_runtime.h>
#include <hip/hip_cooperative_groups.h>
#include <stdint.h>
#include <stdio.h>
namespace cg = cooperative_groups;

typedef unsigned short u16;
typedef short bf16x8 __attribute__((ext_vector_type(8)));
typedef short s16x4 __attribute__((ext_vector_type(4)));
typedef float f32x16 __attribute__((ext_vector_type(16)));
typedef float f32x4 __attribute__((ext_vector_type(4)));
typedef float f32x2 __attribute__((ext_vector_type(2)));
typedef __bf16 bf16x2_t __attribute__((ext_vector_type(2)));
typedef unsigned u32x4 __attribute__((ext_vector_type(4)));
typedef unsigned u32x2 __attribute__((ext_vector_type(2)));
typedef __attribute__((address_space(3))) s16x4* lds_s16x4_ptr;

#define DI __device__ __forceinline__
#ifndef PROBE_DUP
#define PROBE_DUP 0
#endif

constexpr int D = 1024, NBATCH = 4, S = 8192, T = NBATCH * S;
constexpr int A_INP = 2048;
constexpr float DN_ALPHA = 1.6817928305074292f;
constexpr float LOG2E = 1.4426950408889634f;
constexpr float LN_EPS = 1e-5f;
constexpr float NEGF = -1e30f;
constexpr int TOPK = 256;
constexpr int CAP = 704;
constexpr int LDS_BYTES = 72 * 1024;

constexpr size_t MB = 1024 * 1024;
constexpr size_t W_AIN = 0;
constexpr size_t W_UK = W_AIN + (size_t)2 * 2048 * 1024 * 2;
constexpr size_t W_UV = W_UK + (size_t)2 * 16 * 256 * 64 * 2;
constexpr size_t W_AO = W_UV + (size_t)2 * 16 * 256 * 64 * 2;
constexpr size_t W_BIN = W_AO + (size_t)2 * 1024 * 1024 * 2;
constexpr size_t W_BO = W_BIN + (size_t)2 * 3072 * 1024 * 2;
constexpr size_t W_W1 = W_BO + (size_t)2 * 1024 * 1024 * 2;
constexpr size_t W_W2 = W_W1 + (size_t)4 * 4096 * 1024 * 2;
constexpr size_t WS_MOD = W_W2 + (size_t)4 * 4096 * 1024 * 2;
constexpr size_t WS_H = WS_MOD + 1 * MB;
constexpr size_t WS_BIG = WS_H + 64 * MB;
constexpr size_t WS_BAR = WS_BIG + 256 * MB;
constexpr size_t B_Q = 0;
constexpr size_t B_IQ = 64 * MB;
constexpr size_t B_IK = 96 * MB;
constexpr size_t B_IW = 100 * MB;
constexpr size_t B_CKVRAW = 104 * MB;
constexpr size_t B_CKVN = 136 * MB;
constexpr size_t B_SEL = 152 * MB;
constexpr size_t B_K = 64 * MB;
constexpr size_t B_VT = 128 * MB;
constexpr size_t B_O = 192 * MB;

struct Params {
  const float *x, *c, *rel_bias, *ada_w, *ada_b, *ln_g, *ln_b, *a_w_in, *a_kv_norm, *a_w_uk, *a_w_uv, *a_w_o, *b_w_in,
      *b_lambda, *b_subln, *b_w_o, *mlp_w1, *mlp_w2;
  float* out;
  char* ws;
};

DI int opq_tid() {
  int t = threadIdx.x & 255;
  asm volatile("" : "+v"(t));
  return t;
}
DI int opq_tid8() {
  int t = threadIdx.x;
  asm volatile("" : "+v"(t));
  return t;
}
DI unsigned pk2(float lo, float hi) {
  f32x2 v = {lo, hi};
  bf16x2_t b = __builtin_convertvector(v, bf16x2_t);
  return __builtin_bit_cast(unsigned, b);
}
DI u16 f2bf(float x) { return (u16)(pk2(x, 0.f) & 0xffffu); }
DI float wave_sum(float v) {
#pragma unroll
  for (int o = 32; o >= 1; o >>= 1) v += __shfl_xor(v, o);
  return v;
}
DI f32x16 mfma32(bf16x8 a, bf16x8 b, f32x16 c) { return __builtin_amdgcn_mfma_f32_32x32x16_bf16(a, b, c, 0, 0, 0); }
DI f32x4 mfma16(bf16x8 a, bf16x8 b, f32x4 c) { return __builtin_amdgcn_mfma_f32_16x16x32_bf16(a, b, c, 0, 0, 0); }
DI int pi_row(int r) { return (r & ~12) | ((r & 4) << 1) | ((r & 8) >> 1); }

DI int rel_bucket(int n) {
  if (n < 16) return n;
  float nf = (float)n;
  int large = 16 + (int)(logf(nf / 16.f) / 2.0794415416798357f * 16.f);
  return large < 31 ? large : 31;
}

DI void tconv_phase(const float* __restrict__ src, u16* __restrict__ dst, int batch, int R, int C, int Cpad, char* smem,
                    int bid, int nb) {
  float* tile = (float*)smem;
  const int tid = opq_tid();
  const int tr = R / 64, tc = Cpad / 64;
  const int ntiles = batch * tr * tc;
  for (int it0 = 0; it0 < ntiles; it0 += nb) {
    const int it = (it0 + bid < ntiles) ? it0 + bid : ntiles - 1;
    const int bi = it / (tr * tc);
    const int rem = it - bi * (tr * tc);
    const int ri = rem / tc, ci = rem - ri * tc;
    const float* s = src + (size_t)bi * R * C;
    u16* d = dst + (size_t)bi * Cpad * R;
    __syncthreads();
#pragma unroll
    for (int k = 0; k < 4; k++) {
      const int r = (tid >> 4) + 16 * k;
      const int cl = (tid & 15) * 4;
      const int cc = ci * 64 + cl;
      f32x4 v = {0.f, 0.f, 0.f, 0.f};
      if (cc < C) v = *(const f32x4*)(s + (size_t)(ri * 64 + r) * C + cc);
      tile[r * 65 + cl + 0] = v[0];
      tile[r * 65 + cl + 1] = v[1];
      tile[r * 65 + cl + 2] = v[2];
      tile[r * 65 + cl + 3] = v[3];
    }
    __syncthreads();
#pragma unroll
    for (int k = 0; k < 2; k++) {
      const int cl = (tid >> 3) + 32 * k;
      const int r8 = (tid & 7) * 8;
      u32x4 o;
      o[0] = pk2(tile[(r8 + 0) * 65 + cl], tile[(r8 + 1) * 65 + cl]);
      o[1] = pk2(tile[(r8 + 2) * 65 + cl], tile[(r8 + 3) * 65 + cl]);
      o[2] = pk2(tile[(r8 + 4) * 65 + cl], tile[(r8 + 5) * 65 + cl]);
      o[3] = pk2(tile[(r8 + 6) * 65 + cl], tile[(r8 + 7) * 65 + cl]);
      *(u32x4*)(d + (size_t)(ci * 64 + cl) * R + ri * 64 + r8) = o;
    }
  }
}

DI void mod_phase(const Params& p, float* mod, char* smem, int bid, int nb) {
  float* sc = (float*)smem;
  float* red = sc + 4096;
  const int tid = opq_tid(), lane = tid & 63, w = __builtin_amdgcn_readfirstlane(tid >> 6);
  __syncthreads();
  for (int i = tid; i < 4096; i += 256) {
    float v = p.c[i];
    sc[i] = v / (1.f + expf(-v));
  }
  __syncthreads();
  for (int it = bid; it < 4 * 384; it += nb) {
    const int l = it / 384, e0 = (it - l * 384) * 16;
    const int ds = lane >> 4, ec = lane & 15;
    const float* wp = p.ada_w + ((size_t)l * 1024 + w * 256 + ds) * 6144 + e0 + ec;
    float a0 = 0, a1 = 0, a2 = 0, a3 = 0;
#pragma unroll 16
    for (int d = 0; d < 64; d++) {
      float wv = wp[(size_t)(4 * d) * 6144];
      int dd = w * 256 + 4 * d + ds;
      a0 += sc[dd] * wv;
      a1 += sc[1024 + dd] * wv;
      a2 += sc[2048 + dd] * wv;
      a3 += sc[3072 + dd] * wv;
    }
    a0 += __shfl_xor(a0, 16); a0 += __shfl_xor(a0, 32);
    a1 += __shfl_xor(a1, 16); a1 += __shfl_xor(a1, 32);
    a2 += __shfl_xor(a2, 16); a2 += __shfl_xor(a2, 32);
    a3 += __shfl_xor(a3, 16); a3 += __shfl_xor(a3, 32);
    if (lane < 16) {
      red[(w * 4 + 0) * 16 + lane] = a0;
      red[(w * 4 + 1) * 16 + lane] = a1;
      red[(w * 4 + 2) * 16 + lane] = a2;
      red[(w * 4 + 3) * 16 + lane] = a3;
    }
    __syncthreads();
    if (tid < 64) {
      const int b = tid >> 4, e = tid & 15;
      float sm = red[(0 * 4 + b) * 16 + e] + red[(1 * 4 + b) * 16 + e] + red[(2 * 4 + b) * 16 + e] + red[(3 * 4 + b) * 16 + e] +
                 p.ada_b[l * 6144 + e0 + e];
      mod[((size_t)l * 4 + b) * 6144 + e0 + e] = sm;
    }
    __syncthreads();
  }
}

DI void h0_phase(const float* __restrict__ x, const float* __restrict__ mod0, u16* __restrict__ h, int bid, int nb) {
  const size_t n8 = (size_t)T * 1024 / 8;
  for (size_t i = (size_t)bid * 256 + opq_tid(); i < n8; i += (size_t)nb * 256) {
    const size_t e = i * 8;
    const int t = (int)(e >> 10), d = (int)(e & 1023), b = t >> 13;
    const float* m = mod0 + (size_t)b * 6144;
    f32x4 v0 = *(const f32x4*)(x + e), v1 = *(const f32x4*)(x + e + 4);
    f32x4 sh0 = *(const f32x4*)(m + d), sh1 = *(const f32x4*)(m + d + 4);
    f32x4 sc0 = *(const f32x4*)(m + 1024 + d), sc1 = *(const f32x4*)(m + 1024 + d + 4);
    v0 = v0 * (1.f + sc0) + sh0;
    v1 = v1 * (1.f + sc1) + sh1;
    u32x4 o;
    o[0] = pk2(v0[0], v0[1]);
    o[1] = pk2(v0[2], v0[3]);
    o[2] = pk2(v1[0], v1[1]);
    o[3] = pk2(v1[2], v1[3]);
    *(u32x4*)(h + e) = o;
  }
}

DI void ln_phase(float* z, const float* __restrict__ g, const float* __restrict__ bt, const float* modn, int sh_off,
                 u16* __restrict__ h, int bid, int nb) {
  const int tid = opq_tid(), lane = tid & 63, w = __builtin_amdgcn_readfirstlane(tid >> 6);
  for (int row = bid * 4 + w; row < T; row += nb * 4) {
    f32x4* zp = (f32x4*)(z + (size_t)row * 1024);
    f32x4 v[4];
#pragma unroll
    for (int c = 0; c < 4; c++) v[c] = zp[c * 64 + lane];
    float s = 0;
#pragma unroll
    for (int c = 0; c < 4; c++) s += v[c][0] + v[c][1] + v[c][2] + v[c][3];
    const float mu = wave_sum(s) * (1.f / 1024.f);
    float q = 0;
#pragma unroll
    for (int c = 0; c < 4; c++) {
      v[c] = v[c] - mu;
      q += v[c][0] * v[c][0] + v[c][1] * v[c][1] + v[c][2] * v[c][2] + v[c][3] * v[c][3];
    }
    const float rstd = rsqrtf(wave_sum(q) * (1.f / 1024.f) + LN_EPS);
    const int b = row >> 13;
#pragma unroll
    for (int c = 0; c < 4; c++) {
      const int d = c * 256 + lane * 4;
      f32x4 y = v[c] * rstd * *(const f32x4*)(g + d) + *(const f32x4*)(bt + d);
      zp[c * 64 + lane] = y;
      if (modn) {
        const float* m = modn + (size_t)b * 6144 + sh_off;
        f32x4 hv = y * (1.f + *(const f32x4*)(m + 1024 + d)) + *(const f32x4*)(m + d);
        u32x2 o;
        o[0] = pk2(hv[0], hv[1]);
        o[1] = pk2(hv[2], hv[3]);
        *(u32x2*)(h + (size_t)row * 1024 + d) = o;
      }
    }
  }
}

enum { EPI_AIN = 0, EPI_BIN = 1, EPI_RES = 2, EPI_SQRELU = 3 };
struct EpiArgs {
  u16 *o0, *o1, *o2;
  float *f0, *f1;
  const float* xin;
  const float* g;
};

template <int EPI>
DI void gemm_phase(const u16* __restrict__ A, const u16* __restrict__ Bt, int M, int N, int K, const EpiArgs& ea,
                   char* smem, int bid, int nb) {
  constexpr int MI = 4, BM = 64 * MI, BN = 256;
  u16* As = (u16*)smem;
  u16* Bs = As + BM * 72;
  const int tid = opq_tid8(), lane = tid & 63, w = __builtin_amdgcn_readfirstlane(tid >> 6), wm = w >> 2, wn = w & 3, l31 = lane & 31, lh = lane >> 5;
  const int ntn = N / BN, ntm = M / BM, nt = ntn * ntm, nk = K / 64;
  const int lr = tid >> 3, lc = (tid & 7) * 8;
  const int xcd = bid & 7, nbx = nb >> 3, cntx = (ntm >> 3) * ntn;
  (void)nt;
  for (int sq = bid >> 3; sq < cntx; sq += nbx) {
    const int tmx = sq / ntn, tn = sq - tmx * ntn;
    const int tm = tmx * 8 + xcd;
    const int m0 = tm * BM, n0 = tn * BN;
    f32x16 acc[MI][2];
#pragma unroll
    for (int i = 0; i < MI; i++)
#pragma unroll
      for (int j = 0; j < 2; j++)
#pragma unroll
        for (int r = 0; r < 16; r++) acc[i][j][r] = 0.f;
    u32x4 ra[4], rb[4];
    const u16* ap = A + (size_t)(m0 + lr) * K + lc;
    const u16* bp = Bt + (size_t)(n0 + lr) * K + lc;
#pragma unroll
    for (int i = 0; i < 4; i++) ra[i] = *(const u32x4*)(ap + (size_t)i * 64 * K);
#pragma unroll
    for (int i = 0; i < 4; i++) rb[i] = *(const u32x4*)(bp + (size_t)i * 64 * K);
    __syncthreads();
#pragma unroll
    for (int i = 0; i < 4; i++) *(u32x4*)&As[(lr + 64 * i) * 72 + lc] = ra[i];
#pragma unroll
    for (int i = 0; i < 4; i++) *(u32x4*)&Bs[(lr + 64 * i) * 72 + lc] = rb[i];
    __syncthreads();
    for (int kt = 0; kt < nk; kt++) {
      if (kt + 1 < nk) {
#pragma unroll
        for (int i = 0; i < 4; i++) ra[i] = *(const u32x4*)(ap + (size_t)i * 64 * K + (kt + 1) * 64);
#pragma unroll
        for (int i = 0; i < 4; i++) rb[i] = *(const u32x4*)(bp + (size_t)i * 64 * K + (kt + 1) * 64);
      }
#pragma unroll
      for (int ks = 0; ks < 4; ks++) {
        bf16x8 af[MI], b0, b1;
#pragma unroll
        for (int i = 0; i < MI; i++) af[i] = *(const bf16x8*)&As[(wm * 32 * MI + 32 * i + l31) * 72 + ks * 16 + lh * 8];
        b0 = *(const bf16x8*)&Bs[(wn * 64 + l31) * 72 + ks * 16 + lh * 8];
        b1 = *(const bf16x8*)&Bs[(wn * 64 + 32 + l31) * 72 + ks * 16 + lh * 8];
#pragma unroll
        for (int i = 0; i < MI; i++) {
          acc[i][0] = mfma32(b0, af[i], acc[i][0]);
          acc[i][1] = mfma32(b1, af[i], acc[i][1]);
        }
      }
      __syncthreads();
      if (kt + 1 < nk) {
#pragma unroll
        for (int i = 0; i < 4; i++) *(u32x4*)&As[(lr + 64 * i) * 72 + lc] = ra[i];
#pragma unroll
        for (int i = 0; i < 4; i++) *(u32x4*)&Bs[(lr + 64 * i) * 72 + lc] = rb[i];
        __syncthreads();
      }
    }
    const int bidx = m0 >> 13;
#pragma unroll
    for (int i = 0; i < MI; i++) {
      const int row = m0 + wm * 32 * MI + 32 * i + l31;
#pragma unroll
      for (int j = 0; j < 2; j++) {
#pragma unroll
        for (int r4 = 0; r4 < 4; r4++) {
          const int col = n0 + wn * 64 + 32 * j + 8 * r4 + 4 * lh;
          float v[4];
#pragma unroll
          for (int q = 0; q < 4; q++) v[q] = acc[i][j][4 * r4 + q];
          if (EPI == EPI_AIN) {
            if (col < 1024) {
              u32x2 o;
              o[0] = pk2(v[0], v[1]);
              o[1] = pk2(v[2], v[3]);
              *(u32x2*)(ea.o0 + (size_t)row * 1024 + col) = o;
            } else if (col < 1280) {
              *(f32x4*)(ea.f0 + (size_t)row * 256 + (col - 1024)) = (f32x4){v[0], v[1], v[2], v[3]};
            } else if (col < 1792) {
              u32x2 o;
              o[0] = pk2(v[0], v[1]);
              o[1] = pk2(v[2], v[3]);
              *(u32x2*)(ea.o1 + (size_t)row * 512 + (col - 1280)) = o;
            } else if (col < 1856) {
              const int d = col - 1792;
              const int sidx = row & 8191;
              const size_t off = (size_t)(row >> 13) * S * 64 +
                                 ((size_t)((sidx >> 5) * 4 + (d >> 4)) * 64 + 32 * ((d >> 3) & 1) + (sidx & 31)) * 8 + (d & 7);
              u32x2 o;
              o[0] = pk2(v[0], v[1]);
              o[1] = pk2(v[2], v[3]);
              *(u32x2*)(ea.o2 + off) = o;
            } else if (col < 1864) {
              const float sc = 0.044194173824159216f;
              *(f32x4*)(ea.f1 + (size_t)row * 8 + (col - 1856)) = (f32x4){v[0] * sc, v[1] * sc, v[2] * sc, v[3] * sc};
            }
          } else if (EPI == EPI_BIN) {
            if (col < 1024) {
              const float sc = 0.125f * LOG2E;
              u32x2 o;
              o[0] = pk2(v[0] * sc, v[1] * sc);
              o[1] = pk2(v[2] * sc, v[3] * sc);
              *(u32x2*)(ea.o0 + (size_t)row * 1024 + col) = o;
            } else if (col < 2048) {
              u32x2 o;
              o[0] = pk2(v[0], v[1]);
              o[1] = pk2(v[2], v[3]);
              *(u32x2*)(ea.o1 + (size_t)row * 1024 + (col - 1024)) = o;
            } else {
              const int cv = col - 2048;
#pragma unroll
              for (int q = 0; q < 4; q++) ea.o2[((size_t)bidx * 1024 + cv + q) * 8192 + (row & 8191)] = f2bf(v[q]);
            }
          } else if (EPI == EPI_RES) {
            const f32x4 gg = *(const f32x4*)(ea.g + (size_t)bidx * 6144 + col);
            const size_t o = (size_t)row * 1024 + col;
            const f32x4 xv = *(const f32x4*)(ea.xin + o);
            f32x4 r;
#pragma unroll
            for (int q = 0; q < 4; q++) r[q] = DN_ALPHA * xv[q] + (1.f + gg[q]) * v[q];
            *(f32x4*)(ea.f0 + o) = r;
          } else {
            float r[4];
#pragma unroll
            for (int q = 0; q < 4; q++) {
              r[q] = v[q] > 0.f ? v[q] : 0.f;
              r[q] = r[q] * r[q];
            }
            u32x2 o;
            o[0] = pk2(r[0], r[1]);
            o[1] = pk2(r[2], r[3]);
            *(u32x2*)(ea.o0 + (size_t)row * 4096 + col) = o;
          }
        }
      }
    }
  }
}

DI void ckvnorm_phase(const float* __restrict__ raw, const float* __restrict__ g, u16* __restrict__ outp, int bid,
                      int nb) {
  const int tid = opq_tid(), lane = tid & 63, w = __builtin_amdgcn_readfirstlane(tid >> 6);
  const f32x4 gg = *(const f32x4*)(g + lane * 4);
  for (int row = bid * 4 + w; row < T; row += nb * 4) {
    f32x4 v = *(const f32x4*)(raw + (size_t)row * 256 + lane * 4);
    float ss = v[0] * v[0] + v[1] * v[1] + v[2] * v[2] + v[3] * v[3];
    ss = wave_sum(ss);
    const float r = rsqrtf(ss * (1.f / 256.f) + LN_EPS);
    u32x2 o;
    o[0] = pk2(v[0] * r * gg[0], v[1] * r * gg[1]);
    o[1] = pk2(v[2] * r * gg[2], v[3] * r * gg[3]);
    *(u32x2*)(outp + (size_t)row * 256 + lane * 4) = o;
  }
}

DI unsigned mono_key(float s) {
  unsigned u = __float_as_uint(s);
  return (u & 0x80000000u) ? ~u : (u | 0x80000000u);
}
DI float mono_inv(unsigned k) {
  unsigned u = (k & 0x80000000u) ? (k & 0x7fffffffu) : ~k;
  return __uint_as_float(u);
}
DI float relu_i(float x) {
  int i = __float_as_int(x);
  return __int_as_float(i > 0 ? i : 0);
}
DI int wcount(bool f) { return __popcll(__ballot(f)); }

template <bool EXACT>
DI void compact4(float* vals, u16* idxs, int* cnt, int lane, float* thr_out) {
  constexpr int NPL = CAP / 64;
  unsigned key[4][NPL];
  int n[4];
#pragma unroll
  for (int q = 0; q < 4; q++) n[q] = cnt[q];
#pragma unroll
  for (int q = 0; q < 4; q++)
#pragma unroll
    for (int j = 0; j < NPL; j++) {
      const int e = j * 64 + lane;
      key[q][j] = (e < n[q]) ? mono_key(vals[q * CAP + e]) : 0u;
    }
  unsigned Tk[4] = {0u, 0u, 0u, 0u};
  constexpr int LOWBIT = EXACT ? 0 : 18;
#pragma unroll 1
  for (int bit = 31; bit >= LOWBIT; bit--) {
#pragma unroll
    for (int q = 0; q < 4; q++) {
      const unsigned cand = Tk[q] | (1u << bit);
      int c = 0;
#pragma unroll
      for (int j = 0; j < NPL; j++) c += wcount(key[q][j] >= cand);
      Tk[q] = (c >= TOPK) ? cand : Tk[q];
      if (q == 1) __builtin_amdgcn_sched_barrier(0);
    }
  }
  unsigned I[4] = {0xffffu, 0xffffu, 0xffffu, 0xffffu};
  if (EXACT) {
    unsigned ix[4][NPL];
    int need[4];
#pragma unroll
    for (int q = 0; q < 4; q++) {
      int cgt = 0;
#pragma unroll
      for (int j = 0; j < NPL; j++) {
        const int e = j * 64 + lane;
        ix[q][j] = (e < n[q]) ? (unsigned)idxs[q * CAP + e] : 0xffffu;
        cgt += wcount(key[q][j] > Tk[q]);
      }
      need[q] = TOPK - cgt;
      I[q] = 0u;
    }
#pragma unroll 1
    for (int bit = 13; bit >= 0; bit--) {
#pragma unroll
      for (int q = 0; q < 4; q++) {
        const unsigned cand = I[q] | (1u << bit);
        int c = 0;
#pragma unroll
        for (int j = 0; j < NPL; j++) c += wcount(key[q][j] == Tk[q] && ix[q][j] < cand);
        I[q] = (c < need[q]) ? cand : I[q];
        if (q == 1) __builtin_amdgcn_sched_barrier(0);
      }
    }
  }
  const unsigned long long lt = (1ull << lane) - 1ull;
#pragma unroll
  for (int q = 0; q < 4; q++) {
    if (n[q] > TOPK) {
      int base = 0;
#pragma unroll
      for (int j = 0; j < NPL; j++) {
        const int e = j * 64 + lane;
        const bool in = e < n[q];
        const float v = in ? vals[q * CAP + e] : 0.f;
        const unsigned ixv = in ? (unsigned)idxs[q * CAP + e] : 0xffffu;
        const bool keep = (key[q][j] > Tk[q]) || (key[q][j] == Tk[q] && ixv <= I[q]);
        const unsigned long long m = __ballot(keep);
        if (keep) {
          const int pos = base + __popcll(m & lt);
          vals[q * CAP + pos] = v;
          idxs[q * CAP + pos] = (u16)ixv;
        }
        base += __popcll(m);
      }
      if (lane == 0) cnt[q] = base;
      thr_out[q] = mono_inv(Tk[q]);
    }
  }
}

DI void indexer_phase(const u16* __restrict__ iq, const u16* __restrict__ ik, const float* __restrict__ iw,
                      u16* __restrict__ sel, char* smem, int bid, int nb) {
  constexpr int WBYTES = 4 * CAP * 4 + 4 * CAP * 2 + 64;
  const int tid = opq_tid(), lane = tid & 63, w = __builtin_amdgcn_readfirstlane(tid >> 6), l31 = lane & 31, u = lane >> 5;
  float* vals = (float*)(smem + w * WBYTES);
  u16* idxs = (u16*)(smem + w * WBYTES + 4 * CAP * 4);
  int* cnt = (int*)(smem + w * WBYTES + 4 * CAP * 4 + 4 * CAP * 2);
  const int nitems = NBATCH * (S / 16);
  const int nrounds = (nitems + nb - 1) / nb;
  __syncthreads();
  for (int rd = 0; rd < nrounds; rd++) {
    const int it = rd * nb + ((rd & 1) ? (nb - 1 - bid) : bid);
    if (it >= nitems) continue;
    const int b = it & 3, qg = (S / 16 - 1) - (it >> 2);
    const int t0 = qg * 16;
    const int tw = t0 + 4 * w;
    const size_t tb = (size_t)b * S;
    bf16x8 aq[4];
    {
      const int g = l31 >> 3, up = (l31 >> 2) & 1, j = l31 & 3;
      const int ql = 2 * up + (g >> 1), hd = 4 * (g & 1) + j;
      const u16* qp = iq + (tb + tw + ql) * 512 + hd * 64 + u * 8;
#pragma unroll
      for (int ks = 0; ks < 4; ks++) aq[ks] = *(const bf16x8*)(qp + ks * 16);
    }
    float wq[2][8];
#pragma unroll
    for (int qq = 0; qq < 2; qq++) {
      const float* wp = iw + (tb + tw + 2 * u + qq) * 8;
      f32x4 w0 = *(const f32x4*)wp, w1 = *(const f32x4*)(wp + 4);
#pragma unroll
      for (int h = 0; h < 4; h++) {
        wq[qq][h] = w0[h];
        wq[qq][4 + h] = w1[h];
      }
    }
    float thr[2] = {-INFINITY, -INFINITY};
    __builtin_amdgcn_wave_barrier();
    if (lane < 4) cnt[lane] = 0;
    __builtin_amdgcn_wave_barrier();
    const int nkb = (tw + 3) / 32 + 1;
    const u16* kp = ik + tb * 64 + lane * 8;
    bf16x8 ring[4][4];
#pragma unroll
    for (int i = 0; i < 4; i++) {
      const int kbn = (i < nkb) ? i : nkb - 1;
#pragma unroll
      for (int ks = 0; ks < 4; ks++) ring[i][ks] = *(const bf16x8*)(kp + (size_t)(kbn * 4 + ks) * 512);
    }
#pragma unroll 1
    for (int kb0 = 0; kb0 < nkb; kb0 += 4) {
#pragma unroll
      for (int i = 0; i < 4; i++) {
        const int kb = kb0 + i;
        {
          f32x16 acc;
#pragma unroll
          for (int r = 0; r < 16; r++) acc[r] = 0.f;
#pragma unroll
          for (int ks = 0; ks < 4; ks++) acc = mfma32(aq[ks], ring[i][ks], acc);
          {
            const int kbn = (kb + 4 < nkb) ? kb + 4 : nkb - 1;
#pragma unroll
            for (int ks = 0; ks < 4; ks++) ring[i][ks] = *(const bf16x8*)(kp + (size_t)(kbn * 4 + ks) * 512);
          }
          const int key = kb * 32 + l31;
#pragma unroll
          for (int qq = 0; qq < 2; qq++) {
            float s0 = 0.f, s1 = 0.f;
#pragma unroll
            for (int h = 0; h < 8; h += 2) {
              s0 = fmaf(wq[qq][h], relu_i(acc[8 * qq + h]), s0);
              s1 = fmaf(wq[qq][h + 1], relu_i(acc[8 * qq + h + 1]), s1);
            }
            float s = s0 + s1;
            s += 0.0f;
            const int tq = tw + 2 * u + qq;
            if (key <= tq && s >= thr[qq]) {
              const int qs = 2 * u + qq;
              const int pos = atomicAdd(&cnt[qs], 1);
              vals[qs * CAP + pos] = s;
              idxs[qs * CAP + pos] = (u16)key;
            }
          }
        }
      }
      __builtin_amdgcn_wave_barrier();
      const int c0 = cnt[0], c1 = cnt[1], c2 = cnt[2], c3 = cnt[3];
      if (c0 > CAP - 128 || c1 > CAP - 128 || c2 > CAP - 128 || c3 > CAP - 128) {
        float to[4] = {0.f, 0.f, 0.f, 0.f};
        compact4<false>(vals, idxs, cnt, lane, to);
        __builtin_amdgcn_wave_barrier();
        const int d0 = cnt[0], d1 = cnt[1], d2 = cnt[2], d3 = cnt[3];
        if (d0 > CAP - 256 || d1 > CAP - 256 || d2 > CAP - 256 || d3 > CAP - 256) {
          compact4<true>(vals, idxs, cnt, lane, to);
          __builtin_amdgcn_wave_barrier();
        }
        if (c0 > TOPK && u == 0) thr[0] = to[0];
        if (c1 > TOPK && u == 0) thr[1] = to[1];
        if (c2 > TOPK && u == 1) thr[0] = to[2];
        if (c3 > TOPK && u == 1) thr[1] = to[3];
      }
    }
    {
      const int c0 = cnt[0], c1 = cnt[1], c2 = cnt[2], c3 = cnt[3];
      if (c0 > TOPK || c1 > TOPK || c2 > TOPK || c3 > TOPK) {
        float to[4];
        compact4<true>(vals, idxs, cnt, lane, to);
        __builtin_amdgcn_wave_barrier();
      }
    }
#pragma unroll 1
    for (int qs = 0; qs < 4; qs++) {
      const int n = cnt[qs];
      u16* sp = sel + (tb + tw + qs) * 256;
#pragma unroll
      for (int j = 0; j < 4; j++) {
        const int e = j * 64 + lane;
        sp[e] = (e < n) ? idxs[qs * CAP + e] : (u16)0xffffu;
      }
    }
  }
}

DI void sparse_phase(const u16* __restrict__ q, const u16* __restrict__ ckvn, const u16* __restrict__ sel,
                     const u16* __restrict__ wuk, const u16* __restrict__ wuv, const float* __restrict__ rel_bias,
                     u16* scratch, u16* __restrict__ o, char* smem, int bid, int nb) {
  constexpr int GS = 264;
  const int tid = opq_tid(), lane = tid & 63, w = __builtin_amdgcn_readfirstlane(tid >> 6), l15 = lane & 15, g = lane >> 4;
  u16* G = (u16*)smem + (size_t)w * 32 * GS;
  int* lut = (int*)(smem + 4 * 32 * GS * 2);
  float* rb = (float*)(lut + 128);
  __syncthreads();
  if (tid < 128) lut[tid] = rel_bucket(tid);
  for (int i = tid; i < 512; i += 256) rb[i] = rel_bias[i] * LOG2E;
  __syncthreads();
  u16* ql = scratch + (size_t)bid * (16 * 16 * 256);
  const int nitems = NBATCH * (S / 16);
  for (int it = bid; it < nitems; it += nb) {
    const int b = it & 3, qg = it >> 2;
    const int t0 = qg * 16;
    const size_t tb = (size_t)b * S;
    for (int hh = 0; hh < 4; hh++) {
      const int h = 4 * w + hh;
      bf16x8 bq[2];
#pragma unroll
      for (int ks = 0; ks < 2; ks++) bq[ks] = *(const bf16x8*)(q + (tb + t0 + l15) * 1024 + h * 64 + ks * 32 + g * 8);
#pragma unroll 4
      for (int rt = 0; rt < 16; rt++) {
        f32x4 acc = {0.f, 0.f, 0.f, 0.f};
#pragma unroll
        for (int ks = 0; ks < 2; ks++) {
          bf16x8 a = *(const bf16x8*)(wuk + ((size_t)h * 256 + rt * 16 + l15) * 64 + ks * 32 + g * 8);
          acc = mfma16(a, bq[ks], acc);
        }
        u32x2 ov;
        ov[0] = pk2(acc[0] * (0.125f * LOG2E), acc[1] * (0.125f * LOG2E));
        ov[1] = pk2(acc[2] * (0.125f * LOG2E), acc[3] * (0.125f * LOG2E));
        *(u32x2*)(ql + ((size_t)l15 * 16 + h) * 256 + rt * 16 + 4 * g) = ov;
      }
    }
    __syncthreads();
    {
      const u16* selw = sel + (tb + t0 + 4 * w) * 256;
      const int l31 = lane & 31;
      const int q4 = l15 >> 2, p4 = l15 & 3;
      const u16* ckb = ckvn + tb * 256;
      int idx_c = selw[l31];
      int idx_n = selw[32 + l31];
      u32x4 gr[16];
#pragma unroll
      for (int i = 0; i < 16; i++) {
        int id = __shfl(idx_c, (lane >> 5) + 2 * i);
        id = (id == 0xffff) ? 0 : id;
        gr[i] = *(const u32x4*)(ckb + (unsigned)(id * 256 + l31 * 8));
      }
      bf16x8 qb[8];
      float m_run = NEGF, l_run = 0.f;
      f32x4 O[16];
#pragma unroll 1
      for (int st = 0; st < 32; st++) {
        const int qi = st >> 3, ch = st & 7;
        const int qloc = 4 * w + qi;
        const int t = t0 + qloc;
        if (ch == 0) {
#pragma unroll
          for (int ks = 0; ks < 8; ks++) qb[ks] = *(const bf16x8*)(ql + ((size_t)qloc * 16 + l15) * 256 + ks * 32 + g * 8);
          m_run = NEGF;
          l_run = 0.f;
#pragma unroll
          for (int rt = 0; rt < 16; rt++) O[rt] = (f32x4){0.f, 0.f, 0.f, 0.f};
        }
#pragma unroll
        for (int i = 0; i < 16; i++) *(u32x4*)&G[((lane >> 5) + 2 * i) * GS + l31 * 8] = gr[i];
        __builtin_amdgcn_wave_barrier();
        const int stn2 = (st + 2 < 32) ? st + 2 : 31;
        const int idx_nn = selw[stn2 * 32 + l31];
#pragma unroll
        for (int i = 0; i < 16; i++) {
          int id = __shfl(idx_n, (lane >> 5) + 2 * i);
          id = (id == 0xffff) ? 0 : id;
          gr[i] = *(const u32x4*)(ckb + (unsigned)(id * 256 + l31 * 8));
        }
        float lg[2][4];
#pragma unroll
        for (int kbk = 0; kbk < 2; kbk++) {
          f32x4 acc = {0.f, 0.f, 0.f, 0.f};
#pragma unroll
          for (int ks = 0; ks < 8; ks++) {
            bf16x8 a = *(const bf16x8*)&G[(16 * kbk + l15) * GS + ks * 32 + g * 8];
            acc = mfma16(a, qb[ks], acc);
            if (ks == 3) asm volatile("" ::: "memory");
          }
          asm volatile("" ::: "memory");
#pragma unroll
          for (int i = 0; i < 4; i++) {
            const int kid = __shfl(idx_c, 16 * kbk + 4 * g + i);
            float v = NEGF;
            if (kid != 0xffff) {
              int n = t - kid;
              n = n < 0 ? 0 : n;
              const int bk = n < 128 ? lut[n] : 31;
              v = acc[i] + rb[bk * 16 + l15];
            }
            lg[kbk][i] = v;
          }
        }
        float mx = fmaxf(fmaxf(fmaxf(lg[0][0], lg[0][1]), fmaxf(lg[0][2], lg[0][3])),
                         fmaxf(fmaxf(lg[1][0], lg[1][1]), fmaxf(lg[1][2], lg[1][3])));
        mx = fmaxf(mx, __shfl_xor(mx, 16));
        mx = fmaxf(mx, __shfl_xor(mx, 32));
        const float m_new = fmaxf(m_run, mx);
        const float scl = __builtin_amdgcn_exp2f(m_run - m_new);
        m_run = m_new;
        float ps = 0.f;
        float pe[8];
#pragma unroll
        for (int kbk = 0; kbk < 2; kbk++)
#pragma unroll
          for (int i = 0; i < 4; i++) {
            const float pv = __builtin_amdgcn_exp2f(lg[kbk][i] - m_new);
            pe[kbk * 4 + i] = pv;
            ps += pv;
          }
        l_run = l_run * scl + ps;
        u32x4 pw;
        pw[0] = pk2(pe[0], pe[1]);
        pw[1] = pk2(pe[2], pe[3]);
        pw[2] = pk2(pe[4], pe[5]);
        pw[3] = pk2(pe[6], pe[7]);
        const bf16x8 pB = __builtin_bit_cast(bf16x8, pw);
        if (__ballot(scl != 1.f)) {
#pragma unroll
          for (int rt = 0; rt < 16; rt++) O[rt] = O[rt] * scl;
        }
#pragma unroll
        for (int rt = 0; rt < 16; rt++) {
          const s16x4 lo = __builtin_amdgcn_ds_read_tr16_b64_v4i16((lds_s16x4_ptr)(&G[(4 * g + q4) * GS + rt * 16 + 4 * p4]));
          const s16x4 hi = __builtin_amdgcn_ds_read_tr16_b64_v4i16((lds_s16x4_ptr)(&G[(16 + 4 * g + q4) * GS + rt * 16 + 4 * p4]));
          const bf16x8 a = (bf16x8){lo[0], lo[1], lo[2], lo[3], hi[0], hi[1], hi[2], hi[3]};
          O[rt] = mfma16(a, pB, O[rt]);
          if ((rt & 3) == 3) asm volatile("" ::: "memory");
        }
        __builtin_amdgcn_wave_barrier();
        if (ch == 7) {
          float lt = l_run;
          lt += __shfl_xor(lt, 16);
          lt += __shfl_xor(lt, 32);
          const float inv = 1.f / lt;
#pragma unroll
          for (int rt = 0; rt < 16; rt++) {
            u32x2 ov;
            ov[0] = pk2(O[rt][0] * inv, O[rt][1] * inv);
            ov[1] = pk2(O[rt][2] * inv, O[rt][3] * inv);
            *(u32x2*)(ql + ((size_t)qloc * 16 + l15) * 256 + rt * 16 + 4 * g) = ov;
          }
        }
        idx_c = idx_n;
        idx_n = idx_nn;
      }
    }
    __syncthreads();
    for (int hh = 0; hh < 4; hh++) {
      const int h = 4 * w + hh;
      bf16x8 bo[8];
#pragma unroll
      for (int ks = 0; ks < 8; ks++) bo[ks] = *(const bf16x8*)(ql + ((size_t)l15 * 16 + h) * 256 + ks * 32 + g * 8);
#pragma unroll
      for (int et = 0; et < 4; et++) {
        f32x4 acc = {0.f, 0.f, 0.f, 0.f};
#pragma unroll
        for (int ks = 0; ks < 8; ks++) {
          bf16x8 a = *(const bf16x8*)(wuv + ((size_t)h * 64 + et * 16 + l15) * 256 + ks * 32 + g * 8);
          acc = mfma16(a, bo[ks], acc);
        }
        u32x2 ov;
        ov[0] = pk2(acc[0], acc[1]);
        ov[1] = pk2(acc[2], acc[3]);
        *(u32x2*)(o + (tb + t0 + l15) * 1024 + h * 64 + et * 16 + 4 * g) = ov;
      }
    }
    __syncthreads();
  }
}

DI void diffattn_phase(const u16* __restrict__ q, const u16* __restrict__ k, const u16* __restrict__ vT,
                       u16* __restrict__ o, const float* __restrict__ rel_bias, const float* __restrict__ lam,
                       const float* __restrict__ subln, int layer_idx, char* smem, int bid, int nb) {
  constexpr int KS = 136, VS = 72;
  u16* Ks = (u16*)smem;
  u16* Vs = Ks + 64 * KS;
  float* exch = (float*)smem;
  float* btab = (float*)(smem + 66 * 1024);
  int* lut = (int*)(smem + 66 * 1024 + 1040);
  float* misc = (float*)(smem + 66 * 1024 + 1040 + 512);
  const int tid = opq_tid8(), lane = tid & 63, w = __builtin_amdgcn_readfirstlane(tid >> 6), l31 = lane & 31, lh = lane >> 5;
  const int qsub = w >> 1, m = w & 1;
  const float lam_init = 0.8f - 0.6f * expf(-0.3f * (float)layer_idx);
  __syncthreads();
  if (tid < 128) lut[tid] = rel_bucket(tid);
  if (w == 0) {
    float p1 = lam[lane] * lam[64 + lane], p2 = lam[128 + lane] * lam[192 + lane];
    p1 = wave_sum(p1);
    p2 = wave_sum(p2);
    if (lane == 0) misc[0] = expf(p1) - expf(p2) + lam_init;
  }
  __syncthreads();
  const float lam_full = misc[0];
  const int xcd = bid & 7, loc = bid >> 3, nbx = nb >> 3;
  const int rph = (S / 128) / nbx;
  const int prow = pi_row(l31);
  for (int rd = 0; rd < 4 * rph; rd++) {
    const int hh = rd / rph, r = rd - hh * rph;
    const int bh = xcd + 8 * hh;
    const int kk = r >> 1;
    const int qb = (r & 1) ? (kk * nbx + loc) : ((S / 128 - 1) - kk * nbx - loc);
    const int b = bh >> 3, h = bh & 7;
    const int q0 = qb * 128, tq0 = q0 + 32 * qsub, t = tq0 + l31;
    const size_t tb = (size_t)b * S;
    __syncthreads();
    for (int i = tid; i < 258; i += 512) {
      const int n = i >> 1, mm = i & 1;
      const int bk = n < 128 ? lut[n] : 31;
      btab[i] = rel_bias[bk * 16 + 2 * h + mm] * LOG2E;
    }
    bf16x8 qf[4];
#pragma unroll
    for (int ks = 0; ks < 4; ks++) qf[ks] = *(const bf16x8*)(q + (tb + t) * 1024 + h * 128 + m * 64 + ks * 16 + lh * 8);
    f32x16 O[4];
#pragma unroll
    for (int et = 0; et < 4; et++)
#pragma unroll
      for (int r = 0; r < 16; r++) O[et][r] = 0.f;
    float m_run = NEGF, l_run = 0.f;
    const int nkt = 2 * qb + 2;
    u32x4 rk[2], rv[2];
    const u16* kp = k + tb * 1024 + h * 128;
    const u16* vp = vT + ((size_t)(b * 8 + h) * 128) * 8192;
#pragma unroll
    for (int i = 0; i < 2; i++) {
      const int id = tid + 512 * i;
      rk[i] = *(const u32x4*)(kp + (size_t)(id >> 4) * 1024 + (id & 15) * 8);
      rv[i] = *(const u32x4*)(vp + (size_t)(id >> 3) * 8192 + (id & 7) * 8);
    }
#pragma unroll
    for (int i = 0; i < 2; i++) {
      const int id = tid + 512 * i;
      *(u32x4*)&Ks[(id >> 4) * KS + (id & 15) * 8] = rk[i];
      *(u32x4*)&Vs[(id >> 3) * VS + (id & 7) * 8] = rv[i];
    }
    __syncthreads();
    const float cfar = btab[256 + m];
    for (int kt = 0; kt < nkt; kt++) {
      if (kt + 1 < nkt) {
#pragma unroll
        for (int i = 0; i < 2; i++) {
          const int id = tid + 512 * i;
          rk[i] = *(const u32x4*)(kp + (size_t)((kt + 1) * 64 + (id >> 4)) * 1024 + (id & 15) * 8);
          rv[i] = *(const u32x4*)(vp + (size_t)(id >> 3) * 8192 + (kt + 1) * 64 + (id & 7) * 8);
        }
      }
      const int s_tile = kt * 64;
      const int remk = tq0 + 31 - s_tile;
      const int nblk = remk < 0 ? 0 : (remk >= 32 ? 2 : 1);
#pragma unroll 1
      for (int kb = 0; kb < nblk; kb++) {
        const int s0 = s_tile + 32 * kb;
        const bool nearb = (tq0 - (s0 + 31)) < 128;
        const bool first = (kt == 0) && (kb == 0);
        const float mref = first ? 0.f : m_run;
        const float cinit = nearb ? -mref : (cfar - mref);
        f32x16 acc;
#pragma unroll
        for (int r = 0; r < 16; r++) acc[r] = cinit;
#pragma unroll
        for (int ks = 0; ks < 4; ks++) {
          bf16x8 a = *(const bf16x8*)&Ks[(32 * kb + prow) * KS + m * 64 + ks * 16 + lh * 8];
          acc = mfma32(a, qf[ks], acc);
        }
        if (nearb) {
#pragma unroll
          for (int r = 0; r < 16; r++) {
            const int key = s0 + 16 * (r >> 3) + 8 * lh + (r & 7);
            const int n = t - key;
            const int nc = n < 0 ? 0 : (n > 128 ? 128 : n);
            const float bv = btab[nc * 2 + m];
            acc[r] = (n < 0) ? NEGF : acc[r] + bv;
          }
        }
        float mx = acc[0];
#pragma unroll
        for (int r = 1; r < 16; r++) mx = fmaxf(mx, acc[r]);
        mx = fmaxf(mx, __shfl_xor(mx, 32));
        if (first || __ballot(mx > 8.f)) {
          const float dlt = first ? mx : fmaxf(mx, 0.f);
          const float scl = __builtin_amdgcn_exp2f(-dlt);
#pragma unroll
          for (int r = 0; r < 16; r++) acc[r] -= dlt;
#pragma unroll
          for (int et = 0; et < 4; et++)
#pragma unroll
            for (int r = 0; r < 16; r++) O[et][r] *= scl;
          l_run *= scl;
          m_run = mref + dlt;
        }
        float ps = 0.f;
#pragma unroll
        for (int r = 0; r < 16; r++) {
          const float pv = __builtin_amdgcn_exp2f(acc[r]);
          acc[r] = pv;
          ps += pv;
        }
        l_run += ps;
#pragma unroll
        for (int s2 = 0; s2 < 2; s2++) {
          u32x4 pw;
          pw[0] = pk2(acc[8 * s2 + 0], acc[8 * s2 + 1]);
          pw[1] = pk2(acc[8 * s2 + 2], acc[8 * s2 + 3]);
          pw[2] = pk2(acc[8 * s2 + 4], acc[8 * s2 + 5]);
          pw[3] = pk2(acc[8 * s2 + 6], acc[8 * s2 + 7]);
          const bf16x8 pB = __builtin_bit_cast(bf16x8, pw);
#pragma unroll
          for (int et = 0; et < 4; et++) {
            bf16x8 a = *(const bf16x8*)&Vs[(32 * et + l31) * VS + 32 * kb + 16 * s2 + 8 * lh];
            O[et] = mfma32(a, pB, O[et]);
          }
        }
      }
      __syncthreads();
      if (kt + 1 < nkt) {
#pragma unroll
        for (int i = 0; i < 2; i++) {
          const int id = tid + 512 * i;
          *(u32x4*)&Ks[(id >> 4) * KS + (id & 15) * 8] = rk[i];
          *(u32x4*)&Vs[(id >> 3) * VS + (id & 7) * 8] = rv[i];
        }
        __syncthreads();
      }
    }
    float lt = l_run + __shfl_xor(l_run, 32);
    const float inv = 1.f / lt;
    if (m == 1) {
#pragma unroll
      for (int et = 0; et < 4; et++)
#pragma unroll
        for (int r = 0; r < 16; r++) {
          const int e = 32 * et + (r & 3) + 8 * (r >> 2) + 4 * lh;
          exch[(qsub * 128 + e) * 32 + l31] = O[et][r] * inv;
        }
    }
    __syncthreads();
    if (m == 0) {
      float ss = 0.f;
#pragma unroll
      for (int et = 0; et < 4; et++)
#pragma unroll
        for (int r = 0; r < 16; r++) {
          const int e = 32 * et + (r & 3) + 8 * (r >> 2) + 4 * lh;
          const float v = O[et][r] * inv - lam_full * exch[(qsub * 128 + e) * 32 + l31];
          O[et][r] = v;
          ss += v * v;
        }
      ss += __shfl_xor(ss, 32);
      const float rs = rsqrtf(ss * (1.f / 128.f) + LN_EPS);
      const float osc = 1.f - lam_init;
#pragma unroll
      for (int et = 0; et < 4; et++)
#pragma unroll
        for (int r4 = 0; r4 < 4; r4++) {
          const int e = 32 * et + 8 * r4 + 4 * lh;
          const f32x4 gv = *(const f32x4*)(subln + e);
          u32x2 ov;
          ov[0] = pk2(O[et][4 * r4 + 0] * rs * gv[0] * osc, O[et][4 * r4 + 1] * rs * gv[1] * osc);
          ov[1] = pk2(O[et][4 * r4 + 2] * rs * gv[2] * osc, O[et][4 * r4 + 3] * rs * gv[3] * osc);
          *(u32x2*)(o + (tb + t) * 1024 + h * 128 + e) = ov;
        }
    }
  }
}

#define XB_TMO      128
#define XB_XCNT(j)  (256  + 64 * (j))
#define XB_XSUB(j)  (1280 + 64 * (j))
#define XB_XGEN(j)  (2304 + 64 * (j))
#define XB_TOP      3328
#define XB_TOPGEN   3392
#define XCD_BAR_WORDS 3456
#define XB_SPIN_CAP (1u << 20)
#define LAS __attribute__((address_space(3)))
DI unsigned xb_ld(unsigned* p) { return __hip_atomic_load(p, __ATOMIC_RELAXED, __HIP_MEMORY_SCOPE_AGENT); }
DI unsigned xb_add(unsigned* p, unsigned v) { return __hip_atomic_fetch_add(p, v, __ATOMIC_RELAXED, __HIP_MEMORY_SCOPE_AGENT); }
DI unsigned xb_xcc_id() { return (unsigned)__builtin_amdgcn_s_getreg((3 << 11) | 20) & 0xFu; }
#define XB_SPIN(cond, bar) do { unsigned _sp = 0; while (cond) { __builtin_amdgcn_s_sleep(1); \
    if ((++_sp & 255u) == 0u) { if (xb_ld(&(bar)[XB_TMO])) break; if (_sp > XB_SPIN_CAP) { atomicAdd(&(bar)[XB_TMO], 1u); break; } } } } while (0)
struct XcdBarrier {
  unsigned* bar;
  unsigned x;
  volatile LAS unsigned* st;
};
DI XcdBarrier xcd_barrier_post(unsigned* bar, volatile LAS unsigned* st) {
  XcdBarrier b;
  b.bar = bar;
  b.x = xb_xcc_id();
  b.st = st;
  if (threadIdx.x == 0) (void)xb_add(&bar[XB_XCNT(b.x)], 1u);
  return b;
}
DI void xcd_barrier_complete(unsigned* bar, unsigned x, unsigned& nloc, unsigned& nx) {
  const unsigned G = gridDim.x * gridDim.y * gridDim.z;
  unsigned sum, cnt, mine, sp = 0u;
  for (;;) {
    sum = 0u; cnt = 0u; mine = 0u;
#pragma unroll
    for (unsigned j = 0; j < 16; ++j) {
      const unsigned c = xb_ld(&bar[XB_XCNT(j)]);
      sum += c;
      cnt += (c > 0u) ? 1u : 0u;
      mine = (j == x) ? c : mine;
    }
    if (sum == G) break;
    __builtin_amdgcn_s_sleep(1);
    if ((++sp & 255u) == 0u) { if (xb_ld(&bar[XB_TMO])) break; if (sp > XB_SPIN_CAP) { atomicAdd(&bar[XB_TMO], 1u); break; } }
  }
  nloc = mine > 0u ? mine : 1u;
  nx = cnt > 0u ? cnt : 1u;
}
DI void xcd_barrier(const XcdBarrier& b0) {
  asm volatile("s_waitcnt vmcnt(0)" ::: "memory");
  __syncthreads();
  if (threadIdx.x == 0) {
    XcdBarrier b = b0;
    b.x = __builtin_amdgcn_readfirstlane(xb_xcc_id());
    unsigned* bar = b.bar;
    asm volatile("" : "+s"(bar));
    __builtin_amdgcn_s_waitcnt(0);
    unsigned nloc = b.st[0], nx = b.st[1];
    if (nloc == 0u) { xcd_barrier_complete(bar, b.x, nloc, nx); b.st[0] = nloc; b.st[1] = nx; }
    const unsigned old = xb_add(&bar[XB_XSUB(b.x)], 1u);
    const unsigned gen = old / nloc;
    if (old + 1u == (gen + 1u) * nloc) {
      __builtin_amdgcn_fence(__ATOMIC_RELEASE, "agent");
      asm volatile("s_waitcnt vmcnt(0)" ::: "memory");
      const unsigned og = xb_add(&bar[XB_TOP], 1u);
      const unsigned tg = og / nx;
      if (og + 1u == (tg + 1u) * nx) xb_add(&bar[XB_TOPGEN], 1u);
      else XB_SPIN(xb_ld(&bar[XB_TOPGEN]) == tg, bar);
      __builtin_amdgcn_fence(__ATOMIC_ACQUIRE, "agent");
      xb_add(&bar[XB_XGEN(b.x)], 1u);
      asm volatile("s_waitcnt vmcnt(0)" ::: "memory");
    } else {
      XB_SPIN(xb_ld(&bar[XB_XGEN(b.x)]) == gen, bar);
      __builtin_amdgcn_fence(__ATOMIC_ACQUIRE, "agent");
      asm volatile("s_waitcnt vmcnt(0)" ::: "memory");
    }
  }
  __syncthreads();
}

#define DECL_WS_PTRS(ws) \
  u16* w_ain = (u16*)(ws + W_AIN); \
  u16* w_uk = (u16*)(ws + W_UK); \
  u16* w_uv = (u16*)(ws + W_UV); \
  u16* w_ao = (u16*)(ws + W_AO); \
  u16* w_bin = (u16*)(ws + W_BIN); \
  u16* w_bo = (u16*)(ws + W_BO); \
  u16* w_w1 = (u16*)(ws + W_W1); \
  u16* w_w2 = (u16*)(ws + W_W2); \
  float* mod = (float*)(ws + WS_MOD); \
  u16* hbuf = (u16*)(ws + WS_H); \
  char* big = ws + WS_BIG; \
  u16* qbuf = (u16*)(big + B_Q); \
  u16* iqbuf = (u16*)(big + B_IQ); \
  u16* ikbuf = (u16*)(big + B_IK); \
  float* iwbuf = (float*)(big + B_IW); \
  float* ckvraw = (float*)(big + B_CKVRAW); \
  u16* ckvn = (u16*)(big + B_CKVN); \
  u16* selbuf = (u16*)(big + B_SEL); \
  u16* kbuf = (u16*)(big + B_K); \
  u16* vtbuf = (u16*)(big + B_VT); \
  u16* obuf = (u16*)(big + B_O); \
  u16* hid = (u16*)big;

__global__ void __launch_bounds__(512, 2) hybrid_fwd(Params p) {
  __shared__ __attribute__((aligned(16))) char smem[2 * LDS_BYTES];
  cg::grid_group grid = cg::this_grid();
  const int bid = blockIdx.x, nb = gridDim.x;
  const int half = __builtin_amdgcn_readfirstlane((int)(threadIdx.x >> 8));
  const int vb = half * nb + bid, nvb = 2 * nb;
  char* smh = smem + half * LDS_BYTES;
  char* ws = p.ws;
  unsigned* bar = (unsigned*)(ws + WS_BAR);
  volatile LAS unsigned* xst = (volatile LAS unsigned*)(smem + 2 * LDS_BYTES - 16);
  if (threadIdx.x < 2) xst[threadIdx.x] = 0u;
  __syncthreads();
  const XcdBarrier xb = xcd_barrier_post(bar, xst);

  {
  DECL_WS_PTRS(ws)
  (void)qbuf; (void)iqbuf; (void)ikbuf; (void)iwbuf; (void)ckvraw; (void)ckvn; (void)selbuf; (void)kbuf; (void)vtbuf; (void)obuf; (void)hid;
  tconv_phase(p.a_w_in, w_ain, 2, 1024, 1864, A_INP, smh, vb, nvb);
  tconv_phase(p.a_w_uk, w_uk, 32, 64, 256, 256, smh, vb, nvb);
  tconv_phase(p.a_w_uv, w_uv, 32, 256, 64, 64, smh, vb, nvb);
  tconv_phase(p.a_w_o, w_ao, 2, 1024, 1024, 1024, smh, vb, nvb);
  tconv_phase(p.b_w_in, w_bin, 2, 1024, 3072, 3072, smh, vb, nvb);
  tconv_phase(p.b_w_o, w_bo, 2, 1024, 1024, 1024, smh, vb, nvb);
  tconv_phase(p.mlp_w1, w_w1, 4, 1024, 4096, 4096, smh, vb, nvb);
  tconv_phase(p.mlp_w2, w_w2, 4, 4096, 1024, 1024, smh, vb, nvb);
  mod_phase(p, mod, smh, vb, nvb);
  grid.sync();
  h0_phase(p.x, mod, hbuf, vb, nvb);
  xcd_barrier(xb);
  }

#pragma unroll 1
  for (int sl = 0; sl < 8; sl++) {
    char* wsl = p.ws;
    asm volatile("" : "+s"(wsl));
    DECL_WS_PTRS(wsl)
    const int i = sl >> 1, j = i >> 1;
    const float* modi = mod + (size_t)i * 4 * 6144;
    const u16* Ares;
    const u16* Wres;
    int Kres, goff;
    if ((sl & 1) == 0) {
      if ((i & 1) == 0) {
        EpiArgs ea{};
        ea.o0 = qbuf; ea.f0 = ckvraw; ea.o1 = iqbuf; ea.o2 = ikbuf; ea.f1 = iwbuf;
        for (int rep = 0; rep < (PROBE_DUP == 4 ? 2 : 1); rep++) gemm_phase<EPI_AIN>(hbuf, w_ain + (size_t)j * A_INP * 1024, T, A_INP, 1024, ea, smem, bid, nb);
        xcd_barrier(xb);
        ckvnorm_phase(ckvraw, p.a_kv_norm + j * 256, ckvn, vb, nvb);
        for (int rep = 0; rep < (PROBE_DUP == 2 ? 2 : 1); rep++) indexer_phase(iqbuf, ikbuf, iwbuf, selbuf, smh, vb, nvb);
        xcd_barrier(xb);
        for (int rep = 0; rep < (PROBE_DUP == 3 ? 2 : 1); rep++) sparse_phase(qbuf, ckvn, selbuf, w_uk + (size_t)j * 16 * 256 * 64, w_uv + (size_t)j * 16 * 256 * 64, p.rel_bias,
                     hbuf, obuf, smh, vb, nvb);
        xcd_barrier(xb);
        Wres = w_ao + (size_t)j * 1024 * 1024;
      } else {
        EpiArgs ea{};
        ea.o0 = qbuf; ea.o1 = kbuf; ea.o2 = vtbuf;
        for (int rep = 0; rep < (PROBE_DUP == 4 ? 2 : 1); rep++) gemm_phase<EPI_BIN>(hbuf, w_bin + (size_t)j * 3072 * 1024, T, 3072, 1024, ea, smem, bid, nb);
        xcd_barrier(xb);
        for (int rep = 0; rep < (PROBE_DUP == 1 ? 2 : 1); rep++) diffattn_phase(qbuf, kbuf, vtbuf, obuf, p.rel_bias, p.b_lambda + j * 256, p.b_subln + j * 128, i, smem, bid, nb);
        xcd_barrier(xb);
        Wres = w_bo + (size_t)j * 1024 * 1024;
      }
      Ares = obuf; Kres = 1024; goff = 2 * 1024;
    } else {
      EpiArgs ea{};
      ea.o0 = hid;
      for (int rep = 0; rep < (PROBE_DUP == 4 ? 2 : 1); rep++) gemm_phase<EPI_SQRELU>(hbuf, w_w1 + (size_t)i * 4096 * 1024, T, 4096, 1024, ea, smem, bid, nb);
      xcd_barrier(xb);
      Ares = hid; Wres = w_w2 + (size_t)i * 4096 * 1024; Kres = 4096; goff = 5 * 1024;
    }
    {
      EpiArgs ea{};
      ea.f0 = p.out;
      ea.xin = (sl == 0) ? p.x : (const float*)p.out;
      ea.g = modi + goff;
      gemm_phase<EPI_RES>(Ares, Wres, T, 1024, Kres, ea, smem, bid, nb);
    }
    xcd_barrier(xb);
    {
      const float* modn = ((sl & 1) == 0) ? modi : (i < 3 ? modi + 4 * 6144 : (const float*)nullptr);
      const int sh_off = ((sl & 1) == 0) ? 3 * 1024 : 0;
      ln_phase(p.out, p.ln_g + (size_t)(i * 2 + (sl & 1)) * 1024, p.ln_b + (size_t)(i * 2 + (sl & 1)) * 1024, modn, sh_off,
               hbuf, vb, nvb);
    }
    xcd_barrier(xb);
  }
}

extern "C" void kernel_launch(void* const* d_in, const int* in_sizes, int n_in, void* d_out, int out_size, void* d_ws,
                              size_t ws_size, hipStream_t stream) {
  static int grid_blocks = 0;
  if (!grid_blocks) {
    int dev = 0, cus = 0, per_cu = 0;
    hipGetDevice(&dev);
    hipDeviceGetAttribute(&cus, hipDeviceAttributeMultiprocessorCount, dev);
    hipOccupancyMaxActiveBlocksPerMultiprocessor(&per_cu, hybrid_fwd, 512, 0);
    (void)per_cu;
    grid_blocks = cus;
    if (grid_blocks > 256) grid_blocks = 256;
  }
  Params p{};
  p.x = (const float*)d_in[0];
  p.c = (const float*)d_in[1];
  p.rel_bias = (const float*)d_in[2];
  p.ada_w = (const float*)d_in[3];
  p.ada_b = (const float*)d_in[4];
  p.ln_g = (const float*)d_in[5];
  p.ln_b = (const float*)d_in[6];
  p.a_w_in = (const float*)d_in[7];
  p.a_kv_norm = (const float*)d_in[8];
  p.a_w_uk = (const float*)d_in[9];
  p.a_w_uv = (const float*)d_in[10];
  p.a_w_o = (const float*)d_in[11];
  p.b_w_in = (const float*)d_in[12];
  p.b_lambda = (const float*)d_in[13];
  p.b_subln = (const float*)d_in[14];
  p.b_w_o = (const float*)d_in[15];
  p.mlp_w1 = (const float*)d_in[16];
  p.mlp_w2 = (const float*)d_in[17];
  p.out = (float*)d_out;
  p.ws = (char*)d_ws;
  hipMemsetAsync((char*)d_ws + WS_BAR, 0, XCD_BAR_WORDS * 4, stream);
  void* args[] = {&p};
  hipError_t e = hipLaunchCooperativeKernel((void*)hybrid_fwd, dim3(grid_blocks), dim3(512), args, 0, stream);
  if (e != hipSuccess) fprintf(stderr, "cooperative launch failed: %s (grid %d)\n", hipGetErrorString(e), grid_blocks);
}
```

```cpp
#include <hip/hip_runtime.h>
#include <hip/hip_cooperative_groups.h>
#include <stdint.h>
#include <stdio.h>
namespace cg = cooperative_groups;

typedef unsigned short u16;
typedef short bf16x8 __attribute__((ext_vector_type(8)));
typedef short s16x4 __attribute__((ext_vector_type(4)));
typedef float f32x16 __attribute__((ext_vector_type(16)));
typedef float f32x4 __attribute__((ext_vector_type(4)));
typedef float f32x2 __attribute__((ext_vector_type(2)));
typedef __bf16 bf16x2_t __attribute__((ext_vector_type(2)));
typedef unsigned u32x4 __attribute__((ext_vector_type(4)));
typedef unsigned u32x2 __attribute__((ext_vector_type(2)));
typedef __attribute__((address_space(3))) s16x4* lds_s16x4_ptr;

#define DI __device__ __forceinline__
#ifndef PROBE_DUP
#define PROBE_DUP 0
#endif

constexpr int D = 1024, NBATCH = 4, S = 8192, T = NBATCH * S;
constexpr int A_INP = 2048;
constexpr float DN_ALPHA = 1.6817928305074292f;
constexpr float LOG2E = 1.4426950408889634f;
constexpr float LN_EPS = 1e-5f;
constexpr float NEGF = -1e30f;
constexpr int TOPK = 256;
constexpr int CAP = 704;
constexpr int LDS_BYTES = 72 * 1024;

constexpr size_t MB = 1024 * 1024;
constexpr size_t W_AIN = 0;
constexpr size_t W_UK = W_AIN + (size_t)2 * 2048 * 1024 * 2;
constexpr size_t W_UV = W_UK + (size_t)2 * 16 * 256 * 64 * 2;
constexpr size_t W_AO = W_UV + (size_t)2 * 16 * 256 * 64 * 2;
constexpr size_t W_BIN = W_AO + (size_t)2 * 1024 * 1024 * 2;
constexpr size_t W_BO = W_BIN + (size_t)2 * 3072 * 1024 * 2;
constexpr size_t W_W1 = W_BO + (size_t)2 * 1024 * 1024 * 2;
constexpr size_t W_W2 = W_W1 + (size_t)4 * 4096 * 1024 * 2;
constexpr size_t WS_MOD = W_W2 + (size_t)4 * 4096 * 1024 * 2;
constexpr size_t WS_H = WS_MOD + 1 * MB;
constexpr size_t WS_BIG = WS_H + 64 * MB;
constexpr size_t WS_BAR = WS_BIG + 256 * MB;
constexpr size_t B_Q = 0;
constexpr size_t B_IQ = 64 * MB;
constexpr size_t B_IK = 96 * MB;
constexpr size_t B_IW = 100 * MB;
constexpr size_t B_CKVRAW = 104 * MB;
constexpr size_t B_CKVN = 136 * MB;
constexpr size_t B_SEL = 152 * MB;
constexpr size_t B_K = 64 * MB;
constexpr size_t B_VT = 128 * MB;
constexpr size_t B_O = 192 * MB;

struct Params {
  const float *x, *c, *rel_bias, *ada_w, *ada_b, *ln_g, *ln_b, *a_w_in, *a_kv_norm, *a_w_uk, *a_w_uv, *a_w_o, *b_w_in,
      *b_lambda, *b_subln, *b_w_o, *mlp_w1, *mlp_w2;
  float* out;
  char* ws;
};

DI int opq_tid() {
  int t = threadIdx.x & 255;
  asm volatile("" : "+v"(t));
  return t;
}
DI int opq_tid8() {
  int t = threadIdx.x;
  asm volatile("" : "+v"(t));
  return t;
}
DI unsigned pk2(float lo, float hi) {
  f32x2 v = {lo, hi};
  bf16x2_t b = __builtin_convertvector(v, bf16x2_t);
  return __builtin_bit_cast(unsigned, b);
}
DI u16 f2bf(float x) { return (u16)(pk2(x, 0.f) & 0xffffu); }
DI float wave_sum(float v) {
#pragma unroll
  for (int o = 32; o >= 1; o >>= 1) v += __shfl_xor(v, o);
  return v;
}
DI f32x16 mfma32(bf16x8 a, bf16x8 b, f32x16 c) { return __builtin_amdgcn_mfma_f32_32x32x16_bf16(a, b, c, 0, 0, 0); }
DI f32x4 mfma16(bf16x8 a, bf16x8 b, f32x4 c) { return __builtin_amdgcn_mfma_f32_16x16x32_bf16(a, b, c, 0, 0, 0); }
DI int pi_row(int r) { return (r & ~12) | ((r & 4) << 1) | ((r & 8) >> 1); }

DI int rel_bucket(int n) {
  if (n < 16) return n;
  float nf = (float)n;
  int large = 16 + (int)(logf(nf / 16.f) / 2.0794415416798357f * 16.f);
  return large < 31 ? large : 31;
}

DI void tconv_phase(const float* __restrict__ src, u16* __restrict__ dst, int batch, int R, int C, int Cpad, char* smem,
                    int bid, int nb) {
  float* tile = (float*)smem;
  const int tid = opq_tid();
  const int tr = R / 64, tc = Cpad / 64;
  const int ntiles = batch * tr * tc;
  for (int it0 = 0; it0 < ntiles; it0 += nb) {
    const int it = (it0 + bid < ntiles) ? it0 + bid : ntiles - 1;
    const int bi = it / (tr * tc);
    const int rem = it - bi * (tr * tc);
    const int ri = rem / tc, ci = rem - ri * tc;
    const float* s = src + (size_t)bi * R * C;
    u16* d = dst + (size_t)bi * Cpad * R;
    __syncthreads();
#pragma unroll
    for (int k = 0; k < 4; k++) {
      const int r = (tid >> 4) + 16 * k;
      const int cl = (tid & 15) * 4;
      const int cc = ci * 64 + cl;
      f32x4 v = {0.f, 0.f, 0.f, 0.f};
      if (cc < C) v = *(const f32x4*)(s + (size_t)(ri * 64 + r) * C + cc);
      tile[r * 65 + cl + 0] = v[0];
      tile[r * 65 + cl + 1] = v[1];
      tile[r * 65 + cl + 2] = v[2];
      tile[r * 65 + cl + 3] = v[3];
    }
    __syncthreads();
#pragma unroll
    for (int k = 0; k < 2; k++) {
      const int cl = (tid >> 3) + 32 * k;
      const int r8 = (tid & 7) * 8;
      u32x4 o;
      o[0] = pk2(tile[(r8 + 0) * 65 + cl], tile[(r8 + 1) * 65 + cl]);
      o[1] = pk2(tile[(r8 + 2) * 65 + cl], tile[(r8 + 3) * 65 + cl]);
      o[2] = pk2(tile[(r8 + 4) * 65 + cl], tile[(r8 + 5) * 65 + cl]);
      o[3] = pk2(tile[(r8 + 6) * 65 + cl], tile[(r8 + 7) * 65 + cl]);
      *(u32x4*)(d + (size_t)(ci * 64 + cl) * R + ri * 64 + r8) = o;
    }
  }
}

DI void mod_phase(const Params& p, float* mod, char* smem, int bid, int nb) {
  float* sc = (float*)smem;
  float* red = sc + 4096;
  const int tid = opq_tid(), lane = tid & 63, w = __builtin_amdgcn_readfirstlane(tid >> 6);
  __syncthreads();
  for (int i = tid; i < 4096; i += 256) {
    float v = p.c[i];
    sc[i] = v / (1.f + expf(-v));
  }
  __syncthreads();
  for (int it = bid; it < 4 * 384; it += nb) {
    const int l = it / 384, e0 = (it - l * 384) * 16;
    const int ds = lane >> 4, ec = lane & 15;
    const float* wp = p.ada_w + ((size_t)l * 1024 + w * 256 + ds) * 6144 + e0 + ec;
    float a0 = 0, a1 = 0, a2 = 0, a3 = 0;
#pragma unroll 16
    for (int d = 0; d < 64; d++) {
      float wv = wp[(size_t)(4 * d) * 6144];
      int dd = w * 256 + 4 * d + ds;
      a0 += sc[dd] * wv;
      a1 += sc[1024 + dd] * wv;
      a2 += sc[2048 + dd] * wv;
      a3 += sc[3072 + dd] * wv;
    }
    a0 += __shfl_xor(a0, 16); a0 += __shfl_xor(a0, 32);
    a1 += __shfl_xor(a1, 16); a1 += __shfl_xor(a1, 32);
    a2 += __shfl_xor(a2, 16); a2 += __shfl_xor(a2, 32);
    a3 += __shfl_xor(a3, 16); a3 += __shfl_xor(a3, 32);
    if (lane < 16) {
      red[(w * 4 + 0) * 16 + lane] = a0;
      red[(w * 4 + 1) * 16 + lane] = a1;
      red[(w * 4 + 2) * 16 + lane] = a2;
      red[(w * 4 + 3) * 16 + lane] = a3;
    }
    __syncthreads();
    if (tid < 64) {
      const int b = tid >> 4, e = tid & 15;
      float sm = red[(0 * 4 + b) * 16 + e] + red[(1 * 4 + b) * 16 + e] + red[(2 * 4 + b) * 16 + e] + red[(3 * 4 + b) * 16 + e] +
                 p.ada_b[l * 6144 + e0 + e];
      mod[((size_t)l * 4 + b) * 6144 + e0 + e] = sm;
    }
    __syncthreads();
  }
}

DI void h0_phase(const float* __restrict__ x, const float* __restrict__ mod0, u16* __restrict__ h, int bid, int nb) {
  const size_t n8 = (size_t)T * 1024 / 8;
  for (size_t i = (size_t)bid * 256 + opq_tid(); i < n8; i += (size_t)nb * 256) {
    const size_t e = i * 8;
    const int t = (int)(e >> 10), d = (int)(e & 1023), b = t >> 13;
    const float* m = mod0 + (size_t)b * 6144;
    f32x4 v0 = *(const f32x4*)(x + e), v1 = *(const f32x4*)(x + e + 4);
    f32x4 sh0 = *(const f32x4*)(m + d), sh1 = *(const f32x4*)(m + d + 4);
    f32x4 sc0 = *(const f32x4*)(m + 1024 + d), sc1 = *(const f32x4*)(m + 1024 + d + 4);
    v0 = v0 * (1.f + sc0) + sh0;
    v1 = v1 * (1.f + sc1) + sh1;
    u32x4 o;
    o[0] = pk2(v0[0], v0[1]);
    o[1] = pk2(v0[2], v0[3]);
    o[2] = pk2(v1[0], v1[1]);
    o[3] = pk2(v1[2], v1[3]);
    *(u32x4*)(h + e) = o;
  }
}

DI void ln_phase(float* z, const float* __restrict__ g, const float* __restrict__ bt, const float* modn, int sh_off,
                 u16* __restrict__ h, int bid, int nb) {
  const int tid = opq_tid(), lane = tid & 63, w = __builtin_amdgcn_readfirstlane(tid >> 6);
  for (int row = bid * 4 + w; row < T; row += nb * 4) {
    f32x4* zp = (f32x4*)(z + (size_t)row * 1024);
    f32x4 v[4];
#pragma unroll
    for (int c = 0; c < 4; c++) v[c] = zp[c * 64 + lane];
    float s = 0;
#pragma unroll
    for (int c = 0; c < 4; c++) s += v[c][0] + v[c][1] + v[c][2] + v[c][3];
    const float mu = wave_sum(s) * (1.f / 1024.f);
    float q = 0;
#pragma unroll
    for (int c = 0; c < 4; c++) {
      v[c] = v[c] - mu;
      q += v[c][0] * v[c][0] + v[c][1] * v[c][1] + v[c][2] * v[c][2] + v[c][3] * v[c][3];
    }
    const float rstd = rsqrtf(wave_sum(q) * (1.f / 1024.f) + LN_EPS);
    const int b = row >> 13;
#pragma unroll
    for (int c = 0; c < 4; c++) {
      const int d = c * 256 + lane * 4;
      f32x4 y = v[c] * rstd * *(const f32x4*)(g + d) + *(const f32x4*)(bt + d);
      zp[c * 64 + lane] = y;
      if (modn) {
        const float* m = modn + (size_t)b * 6144 + sh_off;
        f32x4 hv = y * (1.f + *(const f32x4*)(m + 1024 + d)) + *(const f32x4*)(m + d);
        u32x2 o;
        o[0] = pk2(hv[0], hv[1]);
        o[1] = pk2(hv[2], hv[3]);
        *(u32x2*)(h + (size_t)row * 1024 + d) = o;
      }
    }
  }
}

enum { EPI_AIN = 0, EPI_BIN = 1, EPI_RES = 2, EPI_SQRELU = 3 };
struct EpiArgs {
  u16 *o0, *o1, *o2;
  float *f0, *f1;
  const float* xin;
  const float* g;
};

template <int EPI>
DI void epi_store4(const EpiArgs& ea, int row, int col, const float* v, int bidx) {
  if (EPI == EPI_AIN) {
    if (col < 1024) {
      u32x2 o;
      o[0] = pk2(v[0], v[1]);
      o[1] = pk2(v[2], v[3]);
      *(u32x2*)(ea.o0 + (size_t)row * 1024 + col) = o;
    } else if (col < 1280) {
      *(f32x4*)(ea.f0 + (size_t)row * 256 + (col - 1024)) = (f32x4){v[0], v[1], v[2], v[3]};
    } else if (col < 1792) {
      u32x2 o;
      o[0] = pk2(v[0], v[1]);
      o[1] = pk2(v[2], v[3]);
      *(u32x2*)(ea.o1 + (size_t)row * 512 + (col - 1280)) = o;
    } else if (col < 1856) {
      const int d = col - 1792;
      const int sidx = row & 8191;
      const size_t off = (size_t)(row >> 13) * S * 64 +
                         ((size_t)((sidx >> 5) * 4 + (d >> 4)) * 64 + 32 * ((d >> 3) & 1) + (sidx & 31)) * 8 + (d & 7);
      u32x2 o;
      o[0] = pk2(v[0], v[1]);
      o[1] = pk2(v[2], v[3]);
      *(u32x2*)(ea.o2 + off) = o;
    } else if (col < 1864) {
      const float sc = 0.044194173824159216f;
      *(f32x4*)(ea.f1 + (size_t)row * 8 + (col - 1856)) = (f32x4){v[0] * sc, v[1] * sc, v[2] * sc, v[3] * sc};
    }
  } else if (EPI == EPI_BIN) {
    if (col < 1024) {
      const float sc = 0.125f * LOG2E;
      u32x2 o;
      o[0] = pk2(v[0] * sc, v[1] * sc);
      o[1] = pk2(v[2] * sc, v[3] * sc);
      *(u32x2*)(ea.o0 + (size_t)row * 1024 + col) = o;
    } else if (col < 2048) {
      u32x2 o;
      o[0] = pk2(v[0], v[1]);
      o[1] = pk2(v[2], v[3]);
      *(u32x2*)(ea.o1 + (size_t)row * 1024 + (col - 1024)) = o;
    } else {
      const int cv = col - 2048;
#pragma unroll
      for (int q = 0; q < 4; q++) ea.o2[((size_t)bidx * 1024 + cv + q) * 8192 + (row & 8191)] = f2bf(v[q]);
    }
  } else if (EPI == EPI_RES) {
    const f32x4 gg = *(const f32x4*)(ea.g + (size_t)bidx * 6144 + col);
    const size_t o = (size_t)row * 1024 + col;
    const f32x4 xv = *(const f32x4*)(ea.xin + o);
    f32x4 r;
#pragma unroll
    for (int q = 0; q < 4; q++) r[q] = DN_ALPHA * xv[q] + (1.f + gg[q]) * v[q];
    *(f32x4*)(ea.f0 + o) = r;
  } else {
    float r[4];
#pragma unroll
    for (int q = 0; q < 4; q++) {
      r[q] = v[q] > 0.f ? v[q] : 0.f;
      r[q] = r[q] * r[q];
    }
    u32x2 o;
    o[0] = pk2(r[0], r[1]);
    o[1] = pk2(r[2], r[3]);
    *(u32x2*)(ea.o0 + (size_t)row * 4096 + col) = o;
  }
}

template <int EPI>
DI void gemm_phase(const u16* __restrict__ A, const u16* __restrict__ Bt, int M, int N, int K, const EpiArgs& ea,
                   char* smem, int bid, int nb) {
  constexpr int MI = 4, BM = 64 * MI, BN = 256;
  u16* As = (u16*)smem;
  u16* Bs = As + BM * 72;
  const int tid = opq_tid8(), lane = tid & 63, w = __builtin_amdgcn_readfirstlane(tid >> 6), wm = w >> 2, wn = w & 3, l31 = lane & 31, lh = lane >> 5;
  const int ntn = N / BN, ntm = M / BM, nt = ntn * ntm, nk = K / 64;
  const int lr = tid >> 3, lc = (tid & 7) * 8;
  const int xcd = bid & 7, nbx = nb >> 3, cntx = (ntm >> 3) * ntn;
  (void)nt;
  for (int sq = bid >> 3; sq < cntx; sq += nbx) {
    const int tmx = sq / ntn, tn = sq - tmx * ntn;
    const int tm = tmx * 8 + xcd;
    const int m0 = tm * BM, n0 = tn * BN;
    f32x16 acc[MI][2];
#pragma unroll
    for (int i = 0; i < MI; i++)
#pragma unroll
      for (int j = 0; j < 2; j++)
#pragma unroll
        for (int r = 0; r < 16; r++) acc[i][j][r] = 0.f;
    u32x4 ra[4], rb[4];
    const u16* ap = A + (size_t)(m0 + lr) * K + lc;
    const u16* bp = Bt + (size_t)(n0 + lr) * K + lc;
#pragma unroll
    for (int i = 0; i < 4; i++) ra[i] = *(const u32x4*)(ap + (size_t)i * 64 * K);
#pragma unroll
    for (int i = 0; i < 4; i++) rb[i] = *(const u32x4*)(bp + (size_t)i * 64 * K);
    __syncthreads();
#pragma unroll
    for (int i = 0; i < 4; i++) *(u32x4*)&As[(lr + 64 * i) * 72 + lc] = ra[i];
#pragma unroll
    for (int i = 0; i < 4; i++) *(u32x4*)&Bs[(lr + 64 * i) * 72 + lc] = rb[i];
    __syncthreads();
    for (int kt = 0; kt < nk; kt++) {
      if (kt + 1 < nk) {
#pragma unroll
        for (int i = 0; i < 4; i++) ra[i] = *(const u32x4*)(ap + (size_t)i * 64 * K + (kt + 1) * 64);
#pragma unroll
        for (int i = 0; i < 4; i++) rb[i] = *(const u32x4*)(bp + (size_t)i * 64 * K + (kt + 1) * 64);
      }
#pragma unroll
      for (int ks = 0; ks < 4; ks++) {
        bf16x8 af[MI], b0, b1;
#pragma unroll
        for (int i = 0; i < MI; i++) af[i] = *(const bf16x8*)&As[(wm * 32 * MI + 32 * i + l31) * 72 + ks * 16 + lh * 8];
        b0 = *(const bf16x8*)&Bs[(wn * 64 + l31) * 72 + ks * 16 + lh * 8];
        b1 = *(const bf16x8*)&Bs[(wn * 64 + 32 + l31) * 72 + ks * 16 + lh * 8];
#pragma unroll
        for (int i = 0; i < MI; i++) {
          acc[i][0] = mfma32(b0, af[i], acc[i][0]);
          acc[i][1] = mfma32(b1, af[i], acc[i][1]);
        }
      }
      __syncthreads();
      if (kt + 1 < nk) {
#pragma unroll
        for (int i = 0; i < 4; i++) *(u32x4*)&As[(lr + 64 * i) * 72 + lc] = ra[i];
#pragma unroll
        for (int i = 0; i < 4; i++) *(u32x4*)&Bs[(lr + 64 * i) * 72 + lc] = rb[i];
        __syncthreads();
      }
    }
    const int bidx = m0 >> 13;
#pragma unroll
    for (int i = 0; i < MI; i++) {
      const int row = m0 + wm * 32 * MI + 32 * i + l31;
#pragma unroll
      for (int j = 0; j < 2; j++) {
#pragma unroll
        for (int r4 = 0; r4 < 4; r4++) {
          const int col = n0 + wn * 64 + 32 * j + 8 * r4 + 4 * lh;
          float v[4];
#pragma unroll
          for (int q = 0; q < 4; q++) v[q] = acc[i][j][4 * r4 + q];
          epi_store4<EPI>(ea, row, col, v, bidx);
        }
      }
    }
  }
}

DI int g8_lds_byte(int r, int c) {
  int st = (r >> 4) * 2 + (c >> 5), rr = r & 15, cc = c & 31, ob = rr * 64 + cc * 2;
  return st * 1024 + (ob ^ (((ob >> 9) & 1) << 5));
}
DI void g8_stage_rc(int b, int& R, int& C) {
  int st = b / 1024, sb = b % 1024, swz = sb ^ (((sb >> 9) & 1) << 5);
  R = (st >> 1) * 16 + swz / 64;
  C = (st & 1) * 32 + (swz % 64) / 2;
}
typedef __attribute__((address_space(3))) unsigned* lds_u32_ptr;

template <int EPI>
DI void gemm8p_phase(const u16* __restrict__ A, const u16* __restrict__ Bt, int M, int N, int K, const EpiArgs& ea,
                     char* smem, int bid, int nb) {
  constexpr int BK = 64, HALF = 128, HT = HALF * BK;
  u16* shm = (u16*)smem;
  const int tid = opq_tid8(), lane = tid & 63, wid = __builtin_amdgcn_readfirstlane(tid >> 6);
  const int wr = wid >> 2, wc = wid & 3, fr = lane & 15, fq = lane >> 4;
#define G8_SA(b, h) (shm + ((b) * 2 + (h)) * HT)
#define G8_SB(b, h) (shm + (4 + (b) * 2 + (h)) * HT)
  int g8o0, g8o1;
  {
    int r_, c_;
    g8_stage_rc(tid * 16, r_, c_);
    g8o0 = r_ * K + c_;
    g8_stage_rc(tid * 16 + 8192, r_, c_);
    g8o1 = r_ * K + c_;
  }
#define G8_STAGE(P, BASE, br, kt)                                                                                   \
  do {                                                                                                               \
    const u16* _gp = BASE + (size_t)(br) * K + (size_t)(kt) * BK;                                                    \
    asm volatile("" : "+s"(_gp));                \
    __builtin_amdgcn_global_load_lds((const unsigned*)(_gp + (unsigned)g8o0), (lds_u32_ptr)((char*)(P) + tid * 16), 16, 0, 0);        \
    __builtin_amdgcn_global_load_lds((const unsigned*)(_gp + (unsigned)g8o1), (lds_u32_ptr)((char*)(P) + tid * 16 + 8192), 16, 0, 0); \
  } while (0)
  const int g8lane = (fr * 64 + fq * 16) ^ ((fr & 8) << 2);
  const char* g8a = smem + g8lane + wr * 8192;
  const char* g8b = smem + 4 * HT * 2 + g8lane + wc * 4096;
#define G8_LDA(dst, b, h)                                                                                            \
  _Pragma("unroll") for (int m = 0; m < 4; ++m) _Pragma("unroll") for (int k = 0; k < 2; ++k)                        \
      dst[m][k] = *reinterpret_cast<const bf16x8*>(g8a + ((b) * 2 + (h)) * (HT * 2) + m * 2048 + k * 1024)
#define G8_LDB(dst, b, h)                                                                                            \
  _Pragma("unroll") for (int n = 0; n < 2; ++n) _Pragma("unroll") for (int k = 0; k < 2; ++k)                        \
      dst[n][k] = *reinterpret_cast<const bf16x8*>(g8b + ((b) * 2 + (h)) * (HT * 2) + n * 2048 + k * 1024)
#define G8_MMA(ai, bj, At_, Bt_)                                                                                     \
  do {                                                                                                               \
    __builtin_amdgcn_s_setprio(1);                                                                                   \
    _Pragma("unroll") for (int m = 0; m < 4; ++m) _Pragma("unroll") for (int n = 0; n < 2; ++n)                      \
        _Pragma("unroll") for (int k = 0; k < 2; ++k)                                                                \
            acc[ai][bj][m][n] = mfma16(Bt_[n][k], At_[m][k], acc[ai][bj][m][n]);                                     \
    __builtin_amdgcn_s_setprio(0);                                                                                   \
  } while (0)
#define G8_WAIT_V(n) asm volatile("s_waitcnt vmcnt(" #n ")" ::: "memory")
#define G8_WAIT_L(n) asm volatile("s_waitcnt lgkmcnt(" #n ")" ::: "memory")
#define G8_BAR __builtin_amdgcn_s_barrier()
#define G8_SCHED __builtin_amdgcn_sched_barrier(0)
  const int ntn = N / 256, ntm = M / 256, nt = K / BK;
  const int xcd = bid & 7, nbx = nb >> 3, cntx = (ntm >> 3) * ntn;
  for (int sq = bid >> 3; sq < cntx; sq += nbx) {
    const int tmx = sq / ntn, tn = sq - tmx * ntn;
    const int tm = tmx * 8 + xcd;
    const int brow = tm * 256, bcol = tn * 256;
    f32x4 acc[2][2][4][2];
#pragma unroll
    for (int a_ = 0; a_ < 2; a_++)
#pragma unroll
      for (int b_ = 0; b_ < 2; b_++)
#pragma unroll
        for (int m = 0; m < 4; m++)
#pragma unroll
          for (int n = 0; n < 2; n++) acc[a_][b_][m][n] = (f32x4){0.f, 0.f, 0.f, 0.f};
    bf16x8 At[4][2], B0[2][2], B1[2][2];
    asm volatile("s_waitcnt vmcnt(0) lgkmcnt(0)" ::: "memory");
    __syncthreads();
    G8_STAGE(G8_SB(0, 0), Bt, bcol, 0); G8_STAGE(G8_SA(0, 0), A, brow, 0);
    G8_STAGE(G8_SB(0, 1), Bt, bcol + HALF, 0); G8_STAGE(G8_SA(0, 1), A, brow + HALF, 0);
    if (wr == 1) G8_BAR;
    G8_WAIT_V(4); G8_BAR;
    G8_STAGE(G8_SB(1, 0), Bt, bcol, 1); G8_STAGE(G8_SA(1, 0), A, brow, 1); G8_STAGE(G8_SB(1, 1), Bt, bcol + HALF, 1);
    G8_WAIT_V(6); G8_BAR;
    for (int t = 0; t < nt - 2; t += 2) {
      G8_LDB(B0, 0, 0); G8_SCHED; G8_LDA(At, 0, 0); G8_STAGE(G8_SA(1, 1), A, brow + HALF, t + 1);
      G8_WAIT_L(8); G8_BAR; G8_WAIT_L(0); G8_MMA(0, 0, At, B0); G8_BAR; G8_SCHED;
      G8_LDB(B1, 0, 1); G8_STAGE(G8_SB(0, 0), Bt, bcol, t + 2);
      G8_BAR; G8_WAIT_L(0); G8_MMA(0, 1, At, B1); G8_BAR;
      G8_LDA(At, 0, 1); G8_STAGE(G8_SA(0, 0), A, brow, t + 2);
      G8_BAR; G8_WAIT_L(0); G8_MMA(1, 0, At, B0); G8_BAR; G8_SCHED;
      G8_STAGE(G8_SB(0, 1), Bt, bcol + HALF, t + 2);
      G8_WAIT_V(6); G8_BAR; G8_MMA(1, 1, At, B1); G8_BAR;
      G8_LDB(B0, 1, 0); G8_SCHED; G8_LDA(At, 1, 0); G8_STAGE(G8_SA(0, 1), A, brow + HALF, t + 2);
      G8_WAIT_L(8); G8_BAR; G8_WAIT_L(0); G8_MMA(0, 0, At, B0); G8_BAR; G8_SCHED;
      G8_LDB(B1, 1, 1); G8_STAGE(G8_SB(1, 0), Bt, bcol, t + 3);
      G8_BAR; G8_WAIT_L(0); G8_MMA(0, 1, At, B1); G8_BAR;
      G8_LDA(At, 1, 1); G8_STAGE(G8_SA(1, 0), A, brow, t + 3);
      G8_BAR; G8_WAIT_L(0); G8_MMA(1, 0, At, B0); G8_BAR; G8_SCHED;
      G8_STAGE(G8_SB(1, 1), Bt, bcol + HALF, t + 3);
      G8_WAIT_V(6); G8_BAR; G8_MMA(1, 1, At, B1); G8_BAR;
    }
    {
      G8_LDB(B0, 0, 0); G8_LDA(At, 0, 0); G8_STAGE(G8_SA(1, 1), A, brow + HALF, nt - 1);
      G8_BAR; G8_WAIT_L(0); G8_MMA(0, 0, At, B0); G8_BAR;
      G8_LDB(B1, 0, 1); G8_BAR; G8_WAIT_L(0); G8_MMA(0, 1, At, B1); G8_BAR;
      G8_LDA(At, 0, 1); G8_WAIT_V(4); G8_BAR; G8_WAIT_L(0); G8_MMA(1, 0, At, B0); G8_MMA(1, 1, At, B1); G8_BAR;
    }
    {
      G8_LDB(B0, 1, 0); G8_LDA(At, 1, 0); G8_WAIT_V(2); G8_BAR; G8_WAIT_L(0); G8_MMA(0, 0, At, B0); G8_BAR;
      G8_LDB(B1, 1, 1); G8_WAIT_V(0); G8_BAR; G8_WAIT_L(0); G8_MMA(0, 1, At, B1); G8_BAR;
      G8_LDA(At, 1, 1); G8_BAR; G8_WAIT_L(0); G8_MMA(1, 0, At, B0); G8_MMA(1, 1, At, B1); G8_BAR;
    }
    if (wr == 0) G8_BAR;
    const int bidx = brow >> 13;
#pragma unroll
    for (int ai = 0; ai < 2; ai++)
#pragma unroll
      for (int m = 0; m < 4; m++) {
        const int row = brow + ai * HALF + wr * 64 + m * 16 + fr;
#pragma unroll
        for (int bj = 0; bj < 2; bj++)
#pragma unroll
          for (int n = 0; n < 2; n++) {
            const int col = bcol + bj * HALF + wc * 32 + n * 16 + fq * 4;
            float v[4];
#pragma unroll
            for (int q = 0; q < 4; q++) v[q] = acc[ai][bj][m][n][q];
            epi_store4<EPI>(ea, row, col, v, bidx);
          }
      }
  }
#undef G8_SA
#undef G8_SB
#undef G8_STAGE
#undef G8_LDA
#undef G8_LDB
#undef G8_MMA
#undef G8_WAIT_V
#undef G8_WAIT_L
#undef G8_BAR
#undef G8_SCHED
}

DI void ckvnorm_phase(const float* __restrict__ raw, const float* __restrict__ g, u16* __restrict__ outp, int bid,
                      int nb) {
  const int tid = opq_tid(), lane = tid & 63, w = __builtin_amdgcn_readfirstlane(tid >> 6);
  const f32x4 gg = *(const f32x4*)(g + lane * 4);
  for (int row = bid * 4 + w; row < T; row += nb * 4) {
    f32x4 v = *(const f32x4*)(raw + (size_t)row * 256 + lane * 4);
    float ss = v[0] * v[0] + v[1] * v[1] + v[2] * v[2] + v[3] * v[3];
    ss = wave_sum(ss);
    const float r = rsqrtf(ss * (1.f / 256.f) + LN_EPS);
    u32x2 o;
    o[0] = pk2(v[0] * r * gg[0], v[1] * r * gg[1]);
    o[1] = pk2(v[2] * r * gg[2], v[3] * r * gg[3]);
    *(u32x2*)(outp + (size_t)row * 256 + lane * 4) = o;
  }
}

DI unsigned mono_key(float s) {
  unsigned u = __float_as_uint(s);
  return (u & 0x80000000u) ? ~u : (u | 0x80000000u);
}
DI float mono_inv(unsigned k) {
  unsigned u = (k & 0x80000000u) ? (k & 0x7fffffffu) : ~k;
  return __uint_as_float(u);
}
DI float relu_i(float x) {
  int i = __float_as_int(x);
  return __int_as_float(i > 0 ? i : 0);
}
DI int wcount(bool f) { return __popcll(__ballot(f)); }

template <bool EXACT>
DI void compact4(float* vals, u16* idxs, int* cnt, int lane, float* thr_out) {
  constexpr int NPL = CAP / 64;
  unsigned key[4][NPL];
  int n[4];
#pragma unroll
  for (int q = 0; q < 4; q++) n[q] = cnt[q];
#pragma unroll
  for (int q = 0; q < 4; q++)
#pragma unroll
    for (int j = 0; j < NPL; j++) {
      const int e = j * 64 + lane;
      key[q][j] = (e < n[q]) ? mono_key(vals[q * CAP + e]) : 0u;
    }
  unsigned Tk[4] = {0u, 0u, 0u, 0u};
  constexpr int LOWBIT = EXACT ? 0 : 18;
#pragma unroll 1
  for (int bit = 31; bit >= LOWBIT; bit--) {
#pragma unroll
    for (int q = 0; q < 4; q++) {
      const unsigned cand = Tk[q] | (1u << bit);
      int c = 0;
#pragma unroll
      for (int j = 0; j < NPL; j++) c += wcount(key[q][j] >= cand);
      Tk[q] = (c >= TOPK) ? cand : Tk[q];
      if (q == 1) __builtin_amdgcn_sched_barrier(0);
    }
  }
  unsigned I[4] = {0xffffu, 0xffffu, 0xffffu, 0xffffu};
  if (EXACT) {
    unsigned ix[4][NPL];
    int need[4];
#pragma unroll
    for (int q = 0; q < 4; q++) {
      int cgt = 0;
#pragma unroll
      for (int j = 0; j < NPL; j++) {
        const int e = j * 64 + lane;
        ix[q][j] = (e < n[q]) ? (unsigned)idxs[q * CAP + e] : 0xffffu;
        cgt += wcount(key[q][j] > Tk[q]);
      }
      need[q] = TOPK - cgt;
      I[q] = 0u;
    }
#pragma unroll 1
    for (int bit = 13; bit >= 0; bit--) {
#pragma unroll
      for (int q = 0; q < 4; q++) {
        const unsigned cand = I[q] | (1u << bit);
        int c = 0;
#pragma unroll
        for (int j = 0; j < NPL; j++) c += wcount(key[q][j] == Tk[q] && ix[q][j] < cand);
        I[q] = (c < need[q]) ? cand : I[q];
        if (q == 1) __builtin_amdgcn_sched_barrier(0);
      }
    }
  }
  const unsigned long long lt = (1ull << lane) - 1ull;
#pragma unroll
  for (int q = 0; q < 4; q++) {
    if (n[q] > TOPK) {
      int base = 0;
#pragma unroll
      for (int j = 0; j < NPL; j++) {
        const int e = j * 64 + lane;
        const bool in = e < n[q];
        const float v = in ? vals[q * CAP + e] : 0.f;
        const unsigned ixv = in ? (unsigned)idxs[q * CAP + e] : 0xffffu;
        const bool keep = (key[q][j] > Tk[q]) || (key[q][j] == Tk[q] && ixv <= I[q]);
        const unsigned long long m = __ballot(keep);
        if (keep) {
          const int pos = base + __popcll(m & lt);
          vals[q * CAP + pos] = v;
          idxs[q * CAP + pos] = (u16)ixv;
        }
        base += __popcll(m);
      }
      if (lane == 0) cnt[q] = base;
      thr_out[q] = mono_inv(Tk[q]);
    }
  }
}

DI void indexer_phase(const u16* __restrict__ iq, const u16* __restrict__ ik, const float* __restrict__ iw,
                      u16* __restrict__ sel, char* smem, int bid, int nb) {
  constexpr int WBYTES = 4 * CAP * 4 + 4 * CAP * 2 + 64;
  const int tid = opq_tid(), lane = tid & 63, w = __builtin_amdgcn_readfirstlane(tid >> 6), l31 = lane & 31, u = lane >> 5;
  float* vals = (float*)(smem + w * WBYTES);
  u16* idxs = (u16*)(smem + w * WBYTES + 4 * CAP * 4);
  int* cnt = (int*)(smem + w * WBYTES + 4 * CAP * 4 + 4 * CAP * 2);
  const int nitems = NBATCH * (S / 16);
  const int nrounds = (nitems + nb - 1) / nb;
  __syncthreads();
  for (int rd = 0; rd < nrounds; rd++) {
    const int it = rd * nb + ((rd & 1) ? (nb - 1 - bid) : bid);
    if (it >= nitems) continue;
    const int b = it & 3, qg = (S / 16 - 1) - (it >> 2);
    const int t0 = qg * 16;
    const int tw = t0 + 4 * w;
    const size_t tb = (size_t)b * S;
    bf16x8 aq[4];
    {
      const int g = l31 >> 3, up = (l31 >> 2) & 1, j = l31 & 3;
      const int ql = 2 * up + (g >> 1), hd = 4 * (g & 1) + j;
      const u16* qp = iq + (tb + tw + ql) * 512 + hd * 64 + u * 8;
#pragma unroll
      for (int ks = 0; ks < 4; ks++) aq[ks] = *(const bf16x8*)(qp + ks * 16);
    }
    float wq[2][8];
#pragma unroll
    for (int qq = 0; qq < 2; qq++) {
      const float* wp = iw + (tb + tw + 2 * u + qq) * 8;
      f32x4 w0 = *(const f32x4*)wp, w1 = *(const f32x4*)(wp + 4);
#pragma unroll
      for (int h = 0; h < 4; h++) {
        wq[qq][h] = w0[h];
        wq[qq][4 + h] = w1[h];
      }
    }
    float thr[2] = {-INFINITY, -INFINITY};
    __builtin_amdgcn_wave_barrier();
    if (lane < 4) cnt[lane] = 0;
    __builtin_amdgcn_wave_barrier();
    const int nkb = (tw + 3) / 32 + 1;
    const u16* kp = ik + tb * 64 + lane * 8;
    bf16x8 ring[4][4];
#pragma unroll
    for (int i = 0; i < 4; i++) {
      const int kbn = (i < nkb) ? i : nkb - 1;
#pragma unroll
      for (int ks = 0; ks < 4; ks++) ring[i][ks] = *(const bf16x8*)(kp + (size_t)(kbn * 4 + ks) * 512);
    }
#pragma unroll 1
    for (int kb0 = 0; kb0 < nkb; kb0 += 4) {
#pragma unroll
      for (int i = 0; i < 4; i++) {
        const int kb = kb0 + i;
        {
          f32x16 acc;
#pragma unroll
          for (int r = 0; r < 16; r++) acc[r] = 0.f;
#pragma unroll
          for (int ks = 0; ks < 4; ks++) acc = mfma32(aq[ks], ring[i][ks], acc);
          {
            const int kbn = (kb + 4 < nkb) ? kb + 4 : nkb - 1;
#pragma unroll
            for (int ks = 0; ks < 4; ks++) ring[i][ks] = *(const bf16x8*)(kp + (size_t)(kbn * 4 + ks) * 512);
          }
          const int key = kb * 32 + l31;
#pragma unroll
          for (int qq = 0; qq < 2; qq++) {
            float s0 = 0.f, s1 = 0.f;
#pragma unroll
            for (int h = 0; h < 8; h += 2) {
              s0 = fmaf(wq[qq][h], relu_i(acc[8 * qq + h]), s0);
              s1 = fmaf(wq[qq][h + 1], relu_i(acc[8 * qq + h + 1]), s1);
            }
            float s = s0 + s1;
            s += 0.0f;
            const int tq = tw + 2 * u + qq;
            if (key <= tq && s >= thr[qq]) {
              const int qs = 2 * u + qq;
              const int pos = atomicAdd(&cnt[qs], 1);
              vals[qs * CAP + pos] = s;
              idxs[qs * CAP + pos] = (u16)key;
            }
          }
        }
      }
      __builtin_amdgcn_wave_barrier();
      const int c0 = cnt[0], c1 = cnt[1], c2 = cnt[2], c3 = cnt[3];
      if (c0 > CAP - 128 || c1 > CAP - 128 || c2 > CAP - 128 || c3 > CAP - 128) {
        float to[4] = {0.f, 0.f, 0.f, 0.f};
        compact4<false>(vals, idxs, cnt, lane, to);
        __builtin_amdgcn_wave_barrier();
        const int d0 = cnt[0], d1 = cnt[1], d2 = cnt[2], d3 = cnt[3];
        if (d0 > CAP - 256 || d1 > CAP - 256 || d2 > CAP - 256 || d3 > CAP - 256) {
          compact4<true>(vals, idxs, cnt, lane, to);
          __builtin_amdgcn_wave_barrier();
        }
        if (c0 > TOPK && u == 0) thr[0] = to[0];
        if (c1 > TOPK && u == 0) thr[1] = to[1];
        if (c2 > TOPK && u == 1) thr[0] = to[2];
        if (c3 > TOPK && u == 1) thr[1] = to[3];
      }
    }
    {
      const int c0 = cnt[0], c1 = cnt[1], c2 = cnt[2], c3 = cnt[3];
      if (c0 > TOPK || c1 > TOPK || c2 > TOPK || c3 > TOPK) {
        float to[4];
        compact4<true>(vals, idxs, cnt, lane, to);
        __builtin_amdgcn_wave_barrier();
      }
    }
#pragma unroll 1
    for (int qs = 0; qs < 4; qs++) {
      const int n = cnt[qs];
      u16* sp = sel + (tb + tw + qs) * 256;
#pragma unroll
      for (int j = 0; j < 4; j++) {
        const int e = j * 64 + lane;
        sp[e] = (e < n) ? idxs[qs * CAP + e] : (u16)0xffffu;
      }
    }
  }
}

DI void sparse_phase(const u16* __restrict__ q, const u16* __restrict__ ckvn, const u16* __restrict__ sel,
                     const u16* __restrict__ wuk, const u16* __restrict__ wuv, const float* __restrict__ rel_bias,
                     u16* scratch, u16* __restrict__ o, char* smem, int bid, int nb) {
  constexpr int GS = 264;
  const int tid = opq_tid(), lane = tid & 63, w = __builtin_amdgcn_readfirstlane(tid >> 6), l15 = lane & 15, g = lane >> 4;
  u16* G = (u16*)smem + (size_t)w * 32 * GS;
  int* lut = (int*)(smem + 4 * 32 * GS * 2);
  float* rb = (float*)(lut + 128);
  __syncthreads();
  if (tid < 128) lut[tid] = rel_bucket(tid);
  for (int i = tid; i < 512; i += 256) rb[i] = rel_bias[i] * LOG2E;
  __syncthreads();
  u16* ql = scratch + (size_t)bid * (16 * 16 * 256);
  const int nitems = NBATCH * (S / 16);
  for (int it = bid; it < nitems; it += nb) {
    const int b = it & 3, qg = it >> 2;
    const int t0 = qg * 16;
    const size_t tb = (size_t)b * S;
    for (int hh = 0; hh < 4; hh++) {
      const int h = 4 * w + hh;
      bf16x8 bq[2];
#pragma unroll
      for (int ks = 0; ks < 2; ks++) bq[ks] = *(const bf16x8*)(q + (tb + t0 + l15) * 1024 + h * 64 + ks * 32 + g * 8);
#pragma unroll 4
      for (int rt = 0; rt < 16; rt++) {
        f32x4 acc = {0.f, 0.f, 0.f, 0.f};
#pragma unroll
        for (int ks = 0; ks < 2; ks++) {
          bf16x8 a = *(const bf16x8*)(wuk + ((size_t)h * 256 + rt * 16 + l15) * 64 + ks * 32 + g * 8);
          acc = mfma16(a, bq[ks], acc);
        }
        u32x2 ov;
        ov[0] = pk2(acc[0] * (0.125f * LOG2E), acc[1] * (0.125f * LOG2E));
        ov[1] = pk2(acc[2] * (0.125f * LOG2E), acc[3] * (0.125f * LOG2E));
        *(u32x2*)(ql + ((size_t)l15 * 16 + h) * 256 + rt * 16 + 4 * g) = ov;
      }
    }
    __syncthreads();
    {
      const u16* selw = sel + (tb + t0 + 4 * w) * 256;
      const int l31 = lane & 31;
      const int q4 = l15 >> 2, p4 = l15 & 3;
      const u16* ckb = ckvn + tb * 256;
      int idx_c = selw[l31];
      int idx_n = selw[32 + l31];
      u32x4 gr[16];
#pragma unroll
      for (int i = 0; i < 16; i++) {
        int id = __shfl(idx_c, (lane >> 5) + 2 * i);
        id = (id == 0xffff) ? 0 : id;
        gr[i] = *(const u32x4*)(ckb + (unsigned)(id * 256 + l31 * 8));
      }
      bf16x8 qb[8];
      float m_run = NEGF, l_run = 0.f;
      f32x4 O[16];
#pragma unroll 1
      for (int st = 0; st < 32; st++) {
        const int qi = st >> 3, ch = st & 7;
        const int qloc = 4 * w + qi;
        const int t = t0 + qloc;
        if (ch == 0) {
#pragma unroll
          for (int ks = 0; ks < 8; ks++) qb[ks] = *(const bf16x8*)(ql + ((size_t)qloc * 16 + l15) * 256 + ks * 32 + g * 8);
          m_run = NEGF;
          l_run = 0.f;
#pragma unroll
          for (int rt = 0; rt < 16; rt++) O[rt] = (f32x4){0.f, 0.f, 0.f, 0.f};
        }
#pragma unroll
        for (int i = 0; i < 16; i++) *(u32x4*)&G[((lane >> 5) + 2 * i) * GS + l31 * 8] = gr[i];
        __builtin_amdgcn_wave_barrier();
        const int stn2 = (st + 2 < 32) ? st + 2 : 31;
        const int idx_nn = selw[stn2 * 32 + l31];
#pragma unroll
        for (int i = 0; i < 16; i++) {
          int id = __shfl(idx_n, (lane >> 5) + 2 * i);
          id = (id == 0xffff) ? 0 : id;
          gr[i] = *(const u32x4*)(ckb + (unsigned)(id * 256 + l31 * 8));
        }
        float lg[2][4];
#pragma unroll
        for (int kbk = 0; kbk < 2; kbk++) {
          f32x4 acc = {0.f, 0.f, 0.f, 0.f};
#pragma unroll
          for (int ks = 0; ks < 8; ks++) {
            bf16x8 a = *(const bf16x8*)&G[(16 * kbk + l15) * GS + ks * 32 + g * 8];
            acc = mfma16(a, qb[ks], acc);
            if (ks == 3) asm volatile("" ::: "memory");
          }
          asm volatile("" ::: "memory");
#pragma unroll
          for (int i = 0; i < 4; i++) {
            const int kid = __shfl(idx_c, 16 * kbk + 4 * g + i);
            float v = NEGF;
            if (kid != 0xffff) {
              int n = t - kid;
              n = n < 0 ? 0 : n;
              const int bk = n < 128 ? lut[n] : 31;
              v = acc[i] + rb[bk * 16 + l15];
            }
            lg[kbk][i] = v;
          }
        }
        float mx = fmaxf(fmaxf(fmaxf(lg[0][0], lg[0][1]), fmaxf(lg[0][2], lg[0][3])),
                         fmaxf(fmaxf(lg[1][0], lg[1][1]), fmaxf(lg[1][2], lg[1][3])));
        mx = fmaxf(mx, __shfl_xor(mx, 16));
        mx = fmaxf(mx, __shfl_xor(mx, 32));
        const float m_new = fmaxf(m_run, mx);
        const float scl = __builtin_amdgcn_exp2f(m_run - m_new);
        m_run = m_new;
        float ps = 0.f;
        float pe[8];
#pragma unroll
        for (int kbk = 0; kbk < 2; kbk++)
#pragma unroll
          for (int i = 0; i < 4; i++) {
            const float pv = __builtin_amdgcn_exp2f(lg[kbk][i] - m_new);
            pe[kbk * 4 + i] = pv;
            ps += pv;
          }
        l_run = l_run * scl + ps;
        u32x4 pw;
        pw[0] = pk2(pe[0], pe[1]);
        pw[1] = pk2(pe[2], pe[3]);
        pw[2] = pk2(pe[4], pe[5]);
        pw[3] = pk2(pe[6], pe[7]);
        const bf16x8 pB = __builtin_bit_cast(bf16x8, pw);
        if (__ballot(scl != 1.f)) {
#pragma unroll
          for (int rt = 0; rt < 16; rt++) O[rt] = O[rt] * scl;
        }
#pragma unroll
        for (int rt = 0; rt < 16; rt++) {
          const s16x4 lo = __builtin_amdgcn_ds_read_tr16_b64_v4i16((lds_s16x4_ptr)(&G[(4 * g + q4) * GS + rt * 16 + 4 * p4]));
          const s16x4 hi = __builtin_amdgcn_ds_read_tr16_b64_v4i16((lds_s16x4_ptr)(&G[(16 + 4 * g + q4) * GS + rt * 16 + 4 * p4]));
          const bf16x8 a = (bf16x8){lo[0], lo[1], lo[2], lo[3], hi[0], hi[1], hi[2], hi[3]};
          O[rt] = mfma16(a, pB, O[rt]);
          if ((rt & 3) == 3) asm volatile("" ::: "memory");
        }
        __builtin_amdgcn_wave_barrier();
        if (ch == 7) {
          float lt = l_run;
          lt += __shfl_xor(lt, 16);
          lt += __shfl_xor(lt, 32);
          const float inv = 1.f / lt;
#pragma unroll
          for (int rt = 0; rt < 16; rt++) {
            u32x2 ov;
            ov[0] = pk2(O[rt][0] * inv, O[rt][1] * inv);
            ov[1] = pk2(O[rt][2] * inv, O[rt][3] * inv);
            *(u32x2*)(ql + ((size_t)qloc * 16 + l15) * 256 + rt * 16 + 4 * g) = ov;
          }
        }
        idx_c = idx_n;
        idx_n = idx_nn;
      }
    }
    __syncthreads();
    for (int hh = 0; hh < 4; hh++) {
      const int h = 4 * w + hh;
      bf16x8 bo[8];
#pragma unroll
      for (int ks = 0; ks < 8; ks++) bo[ks] = *(const bf16x8*)(ql + ((size_t)l15 * 16 + h) * 256 + ks * 32 + g * 8);
#pragma unroll
      for (int et = 0; et < 4; et++) {
        f32x4 acc = {0.f, 0.f, 0.f, 0.f};
#pragma unroll
        for (int ks = 0; ks < 8; ks++) {
          bf16x8 a = *(const bf16x8*)(wuv + ((size_t)h * 64 + et * 16 + l15) * 256 + ks * 32 + g * 8);
          acc = mfma16(a, bo[ks], acc);
        }
        u32x2 ov;
        ov[0] = pk2(acc[0], acc[1]);
        ov[1] = pk2(acc[2], acc[3]);
        *(u32x2*)(o + (tb + t0 + l15) * 1024 + h * 64 + et * 16 + 4 * g) = ov;
      }
    }
    __syncthreads();
  }
}

DI void diffattn_phase(const u16* __restrict__ q, const u16* __restrict__ k, const u16* __restrict__ vT,
                       u16* __restrict__ o, const float* __restrict__ rel_bias, const float* __restrict__ lam,
                       const float* __restrict__ subln, int layer_idx, char* smem, int bid, int nb) {
  constexpr int KS = 136, VS = 72;
  u16* Ks = (u16*)smem;
  u16* Vs = Ks + 64 * KS;
  float* exch = (float*)smem;
  float* btab = (float*)(smem + 66 * 1024);
  int* lut = (int*)(smem + 66 * 1024 + 1040);
  float* misc = (float*)(smem + 66 * 1024 + 1040 + 512);
  const int tid = opq_tid8(), lane = tid & 63, w = __builtin_amdgcn_readfirstlane(tid >> 6), l31 = lane & 31, lh = lane >> 5;
  const int qsub = w >> 1, m = w & 1;
  const float lam_init = 0.8f - 0.6f * expf(-0.3f * (float)layer_idx);
  __syncthreads();
  if (tid < 128) lut[tid] = rel_bucket(tid);
  if (w == 0) {
    float p1 = lam[lane] * lam[64 + lane], p2 = lam[128 + lane] * lam[192 + lane];
    p1 = wave_sum(p1);
    p2 = wave_sum(p2);
    if (lane == 0) misc[0] = expf(p1) - expf(p2) + lam_init;
  }
  __syncthreads();
  const float lam_full = misc[0];
  const int xcd = bid & 7, loc = bid >> 3, nbx = nb >> 3;
  const int rph = (S / 128) / nbx;
  const int prow = pi_row(l31);
  for (int rd = 0; rd < 4 * rph; rd++) {
    const int hh = rd / rph, r = rd - hh * rph;
    const int bh = xcd + 8 * hh;
    const int kk = r >> 1;
    const int qb = (r & 1) ? (kk * nbx + loc) : ((S / 128 - 1) - kk * nbx - loc);
    const int b = bh >> 3, h = bh & 7;
    const int q0 = qb * 128, tq0 = q0 + 32 * qsub, t = tq0 + l31;
    const size_t tb = (size_t)b * S;
    __syncthreads();
    for (int i = tid; i < 258; i += 512) {
      const int n = i >> 1, mm = i & 1;
      const int bk = n < 128 ? lut[n] : 31;
      btab[i] = rel_bias[bk * 16 + 2 * h + mm] * LOG2E;
    }
    bf16x8 qf[4];
#pragma unroll
    for (int ks = 0; ks < 4; ks++) qf[ks] = *(const bf16x8*)(q + (tb + t) * 1024 + h * 128 + m * 64 + ks * 16 + lh * 8);
    f32x16 O[4];
#pragma unroll
    for (int et = 0; et < 4; et++)
#pragma unroll
      for (int r = 0; r < 16; r++) O[et][r] = 0.f;
    float m_run = NEGF, l_run = 0.f;
    const int nkt = 2 * qb + 2;
    u32x4 rk[2], rv[2];
    const u16* kp = k + tb * 1024 + h * 128;
    const u16* vp = vT + ((size_t)(b * 8 + h) * 128) * 8192;
#pragma unroll
    for (int i = 0; i < 2; i++) {
      const int id = tid + 512 * i;
      rk[i] = *(const u32x4*)(kp + (size_t)(id >> 4) * 1024 + (id & 15) * 8);
      rv[i] = *(const u32x4*)(vp + (size_t)(id >> 3) * 8192 + (id & 7) * 8);
    }
#pragma unroll
    for (int i = 0; i < 2; i++) {
      const int id = tid + 512 * i;
      *(u32x4*)&Ks[(id >> 4) * KS + (id & 15) * 8] = rk[i];
      *(u32x4*)&Vs[(id >> 3) * VS + (id & 7) * 8] = rv[i];
    }
    __syncthreads();
    const float cfar = btab[256 + m];
    for (int kt = 0; kt < nkt; kt++) {
      if (kt + 1 < nkt) {
#pragma unroll
        for (int i = 0; i < 2; i++) {
          const int id = tid + 512 * i;
          rk[i] = *(const u32x4*)(kp + (size_t)((kt + 1) * 64 + (id >> 4)) * 1024 + (id & 15) * 8);
          rv[i] = *(const u32x4*)(vp + (size_t)(id >> 3) * 8192 + (kt + 1) * 64 + (id & 7) * 8);
        }
      }
      const int s_tile = kt * 64;
      const int remk = tq0 + 31 - s_tile;
      const int nblk = remk < 0 ? 0 : (remk >= 32 ? 2 : 1);
#pragma unroll 1
      for (int kb = 0; kb < nblk; kb++) {
        const int s0 = s_tile + 32 * kb;
        const bool nearb = (tq0 - (s0 + 31)) < 128;
        const bool first = (kt == 0) && (kb == 0);
        const float mref = first ? 0.f : m_run;
        const float cinit = nearb ? -mref : (cfar - mref);
        f32x16 acc;
#pragma unroll
        for (int r = 0; r < 16; r++) acc[r] = cinit;
#pragma unroll
        for (int ks = 0; ks < 4; ks++) {
          bf16x8 a = *(const bf16x8*)&Ks[(32 * kb + prow) * KS + m * 64 + ks * 16 + lh * 8];
          acc = mfma32(a, qf[ks], acc);
        }
        if (nearb) {
#pragma unroll
          for (int r = 0; r < 16; r++) {
            const int key = s0 + 16 * (r >> 3) + 8 * lh + (r & 7);
            const int n = t - key;
            const int nc = n < 0 ? 0 : (n > 128 ? 128 : n);
            const float bv = btab[nc * 2 + m];
            acc[r] = (n < 0) ? NEGF : acc[r] + bv;
          }
        }
        float mx = acc[0];
#pragma unroll
        for (int r = 1; r < 16; r++) mx = fmaxf(mx, acc[r]);
        mx = fmaxf(mx, __shfl_xor(mx, 32));
        if (first || __ballot(mx > 8.f)) {
          const float dlt = first ? mx : fmaxf(mx, 0.f);
          const float scl = __builtin_amdgcn_exp2f(-dlt);
#pragma unroll
          for (int r = 0; r < 16; r++) acc[r] -= dlt;
#pragma unroll
          for (int et = 0; et < 4; et++)
#pragma unroll
            for (int r = 0; r < 16; r++) O[et][r] *= scl;
          l_run *= scl;
          m_run = mref + dlt;
        }
        float ps = 0.f;
#pragma unroll
        for (int r = 0; r < 16; r++) {
          const float pv = __builtin_amdgcn_exp2f(acc[r]);
          acc[r] = pv;
          ps += pv;
        }
        l_run += ps;
#pragma unroll
        for (int s2 = 0; s2 < 2; s2++) {
          u32x4 pw;
          pw[0] = pk2(acc[8 * s2 + 0], acc[8 * s2 + 1]);
          pw[1] = pk2(acc[8 * s2 + 2], acc[8 * s2 + 3]);
          pw[2] = pk2(acc[8 * s2 + 4], acc[8 * s2 + 5]);
          pw[3] = pk2(acc[8 * s2 + 6], acc[8 * s2 + 7]);
          const bf16x8 pB = __builtin_bit_cast(bf16x8, pw);
#pragma unroll
          for (int et = 0; et < 4; et++) {
            bf16x8 a = *(const bf16x8*)&Vs[(32 * et + l31) * VS + 32 * kb + 16 * s2 + 8 * lh];
            O[et] = mfma32(a, pB, O[et]);
          }
        }
      }
      __syncthreads();
      if (kt + 1 < nkt) {
#pragma unroll
        for (int i = 0; i < 2; i++) {
          const int id = tid + 512 * i;
          *(u32x4*)&Ks[(id >> 4) * KS + (id & 15) * 8] = rk[i];
          *(u32x4*)&Vs[(id >> 3) * VS + (id & 7) * 8] = rv[i];
        }
        __syncthreads();
      }
    }
    float lt = l_run + __shfl_xor(l_run, 32);
    const float inv = 1.f / lt;
    if (m == 1) {
#pragma unroll
      for (int et = 0; et < 4; et++)
#pragma unroll
        for (int r = 0; r < 16; r++) {
          const int e = 32 * et + (r & 3) + 8 * (r >> 2) + 4 * lh;
          exch[(qsub * 128 + e) * 32 + l31] = O[et][r] * inv;
        }
    }
    __syncthreads();
    if (m == 0) {
      float ss = 0.f;
#pragma unroll
      for (int et = 0; et < 4; et++)
#pragma unroll
        for (int r = 0; r < 16; r++) {
          const int e = 32 * et + (r & 3) + 8 * (r >> 2) + 4 * lh;
          const float v = O[et][r] * inv - lam_full * exch[(qsub * 128 + e) * 32 + l31];
          O[et][r] = v;
          ss += v * v;
        }
      ss += __shfl_xor(ss, 32);
      const float rs = rsqrtf(ss * (1.f / 128.f) + LN_EPS);
      const float osc = 1.f - lam_init;
#pragma unroll
      for (int et = 0; et < 4; et++)
#pragma unroll
        for (int r4 = 0; r4 < 4; r4++) {
          const int e = 32 * et + 8 * r4 + 4 * lh;
          const f32x4 gv = *(const f32x4*)(subln + e);
          u32x2 ov;
          ov[0] = pk2(O[et][4 * r4 + 0] * rs * gv[0] * osc, O[et][4 * r4 + 1] * rs * gv[1] * osc);
          ov[1] = pk2(O[et][4 * r4 + 2] * rs * gv[2] * osc, O[et][4 * r4 + 3] * rs * gv[3] * osc);
          *(u32x2*)(o + (tb + t) * 1024 + h * 128 + e) = ov;
        }
    }
  }
}

#define XB_TMO      128
#define XB_XCNT(j)  (256  + 64 * (j))
#define XB_XSUB(j)  (1280 + 64 * (j))
#define XB_XGEN(j)  (2304 + 64 * (j))
#define XB_TOP      3328
#define XB_TOPGEN   3392
#define XCD_BAR_WORDS 3456
#define XB_SPIN_CAP (1u << 20)
#define LAS __attribute__((address_space(3)))
DI unsigned xb_ld(unsigned* p) { return __hip_atomic_load(p, __ATOMIC_RELAXED, __HIP_MEMORY_SCOPE_AGENT); }
DI unsigned xb_add(unsigned* p, unsigned v) { return __hip_atomic_fetch_add(p, v, __ATOMIC_RELAXED, __HIP_MEMORY_SCOPE_AGENT); }
DI unsigned xb_xcc_id() { return (unsigned)__builtin_amdgcn_s_getreg((3 << 11) | 20) & 0xFu; }
#define XB_SPIN(cond, bar) do { unsigned _sp = 0; while (cond) { __builtin_amdgcn_s_sleep(1); \
    if ((++_sp & 255u) == 0u) { if (xb_ld(&(bar)[XB_TMO])) break; if (_sp > XB_SPIN_CAP) { atomicAdd(&(bar)[XB_TMO], 1u); break; } } } } while (0)
struct XcdBarrier {
  unsigned* bar;
  unsigned x;
  volatile LAS unsigned* st;
};
DI XcdBarrier xcd_barrier_post(unsigned* bar, volatile LAS unsigned* st) {
  XcdBarrier b;
  b.bar = bar;
  b.x = xb_xcc_id();
  b.st = st;
  if (threadIdx.x == 0) (void)xb_add(&bar[XB_XCNT(b.x)], 1u);
  return b;
}
DI void xcd_barrier_complete(unsigned* bar, unsigned x, unsigned& nloc, unsigned& nx) {
  const unsigned G = gridDim.x * gridDim.y * gridDim.z;
  unsigned sum, cnt, mine, sp = 0u;
  for (;;) {
    sum = 0u; cnt = 0u; mine = 0u;
#pragma unroll
    for (unsigned j = 0; j < 16; ++j) {
      const unsigned c = xb_ld(&bar[XB_XCNT(j)]);
      sum += c;
      cnt += (c > 0u) ? 1u : 0u;
      mine = (j == x) ? c : mine;
    }
    if (sum == G) break;
    __builtin_amdgcn_s_sleep(1);
    if ((++sp & 255u) == 0u) { if (xb_ld(&bar[XB_TMO])) break; if (sp > XB_SPIN_CAP) { atomicAdd(&bar[XB_TMO], 1u); break; } }
  }
  nloc = mine > 0u ? mine : 1u;
  nx = cnt > 0u ? cnt : 1u;
}
DI void xcd_barrier(const XcdBarrier& b0) {
  asm volatile("s_waitcnt vmcnt(0)" ::: "memory");
  __syncthreads();
  if (threadIdx.x == 0) {
    XcdBarrier b = b0;
    b.x = __builtin_amdgcn_readfirstlane(xb_xcc_id());
    unsigned* bar = b.bar;
    asm volatile("" : "+s"(bar));
    __builtin_amdgcn_s_waitcnt(0);
    unsigned nloc = b.st[0], nx = b.st[1];
    if (nloc == 0u) { xcd_barrier_complete(bar, b.x, nloc, nx); b.st[0] = nloc; b.st[1] = nx; }
    const unsigned old = xb_add(&bar[XB_XSUB(b.x)], 1u);
    const unsigned gen = old / nloc;
    if (old + 1u == (gen + 1u) * nloc) {
      __builtin_amdgcn_fence(__ATOMIC_RELEASE, "agent");
      asm volatile("s_waitcnt vmcnt(0)" ::: "memory");
      const unsigned og = xb_add(&bar[XB_TOP], 1u);
      const unsigned tg = og / nx;
      if (og + 1u == (tg + 1u) * nx) xb_add(&bar[XB_TOPGEN], 1u);
      else XB_SPIN(xb_ld(&bar[XB_TOPGEN]) == tg, bar);
      __builtin_amdgcn_fence(__ATOMIC_ACQUIRE, "agent");
      xb_add(&bar[XB_XGEN(b.x)], 1u);
      asm volatile("s_waitcnt vmcnt(0)" ::: "memory");
    } else {
      XB_SPIN(xb_ld(&bar[XB_XGEN(b.x)]) == gen, bar);
      __builtin_amdgcn_fence(__ATOMIC_ACQUIRE, "agent");
      asm volatile("s_waitcnt vmcnt(0)" ::: "memory");
    }
  }
  __syncthreads();
}

#define DECL_WS_PTRS(ws) \
  u16* w_ain = (u16*)(ws + W_AIN); \
  u16* w_uk = (u16*)(ws + W_UK); \
  u16* w_uv = (u16*)(ws + W_UV); \
  u16* w_ao = (u16*)(ws + W_AO); \
  u16* w_bin = (u16*)(ws + W_BIN); \
  u16* w_bo = (u16*)(ws + W_BO); \
  u16* w_w1 = (u16*)(ws + W_W1); \
  u16* w_w2 = (u16*)(ws + W_W2); \
  float* mod = (float*)(ws + WS_MOD); \
  u16* hbuf = (u16*)(ws + WS_H); \
  char* big = ws + WS_BIG; \
  u16* qbuf = (u16*)(big + B_Q); \
  u16* iqbuf = (u16*)(big + B_IQ); \
  u16* ikbuf = (u16*)(big + B_IK); \
  float* iwbuf = (float*)(big + B_IW); \
  float* ckvraw = (float*)(big + B_CKVRAW); \
  u16* ckvn = (u16*)(big + B_CKVN); \
  u16* selbuf = (u16*)(big + B_SEL); \
  u16* kbuf = (u16*)(big + B_K); \
  u16* vtbuf = (u16*)(big + B_VT); \
  u16* obuf = (u16*)(big + B_O); \
  u16* hid = (u16*)big;

__global__ void __launch_bounds__(512, 2) hybrid_fwd(Params p) {
  __shared__ __attribute__((aligned(16))) char smem[2 * LDS_BYTES];
  cg::grid_group grid = cg::this_grid();
  const int bid = blockIdx.x, nb = gridDim.x;
  const int half = __builtin_amdgcn_readfirstlane((int)(threadIdx.x >> 8));
  const int vb = half * nb + bid, nvb = 2 * nb;
  char* smh = smem + half * LDS_BYTES;
  char* ws = p.ws;
  unsigned* bar = (unsigned*)(ws + WS_BAR);
  volatile LAS unsigned* xst = (volatile LAS unsigned*)(smem + 2 * LDS_BYTES - 16);
  if (threadIdx.x < 2) xst[threadIdx.x] = 0u;
  __syncthreads();
  const XcdBarrier xb = xcd_barrier_post(bar, xst);

  {
  DECL_WS_PTRS(ws)
  (void)qbuf; (void)iqbuf; (void)ikbuf; (void)iwbuf; (void)ckvraw; (void)ckvn; (void)selbuf; (void)kbuf; (void)vtbuf; (void)obuf; (void)hid;
  tconv_phase(p.a_w_in, w_ain, 2, 1024, 1864, A_INP, smh, vb, nvb);
  tconv_phase(p.a_w_uk, w_uk, 32, 64, 256, 256, smh, vb, nvb);
  tconv_phase(p.a_w_uv, w_uv, 32, 256, 64, 64, smh, vb, nvb);
  tconv_phase(p.a_w_o, w_ao, 2, 1024, 1024, 1024, smh, vb, nvb);
  tconv_phase(p.b_w_in, w_bin, 2, 1024, 3072, 3072, smh, vb, nvb);
  tconv_phase(p.b_w_o, w_bo, 2, 1024, 1024, 1024, smh, vb, nvb);
  tconv_phase(p.mlp_w1, w_w1, 4, 1024, 4096, 4096, smh, vb, nvb);
  tconv_phase(p.mlp_w2, w_w2, 4, 4096, 1024, 1024, smh, vb, nvb);
  mod_phase(p, mod, smh, vb, nvb);
  grid.sync();
  h0_phase(p.x, mod, hbuf, vb, nvb);
  xcd_barrier(xb);
  }

#pragma unroll 1
  for (int sl = 0; sl < 8; sl++) {
    char* wsl = p.ws;
    asm volatile("" : "+s"(wsl));
    DECL_WS_PTRS(wsl)
    const int i = sl >> 1, j = i >> 1;
    const float* modi = mod + (size_t)i * 4 * 6144;
    const u16* Ares;
    const u16* Wres;
    int Kres, goff;
    if ((sl & 1) == 0) {
      if ((i & 1) == 0) {
        EpiArgs ea{};
        ea.o0 = qbuf; ea.f0 = ckvraw; ea.o1 = iqbuf; ea.o2 = ikbuf; ea.f1 = iwbuf;
        for (int rep = 0; rep < (PROBE_DUP == 4 ? 2 : 1); rep++) gemm8p_phase<EPI_AIN>(hbuf, w_ain + (size_t)j * A_INP * 1024, T, A_INP, 1024, ea, smem, bid, nb);
        xcd_barrier(xb);
        ckvnorm_phase(ckvraw, p.a_kv_norm + j * 256, ckvn, vb, nvb);
        for (int rep = 0; rep < (PROBE_DUP == 2 ? 2 : 1); rep++) indexer_phase(iqbuf, ikbuf, iwbuf, selbuf, smh, vb, nvb);
        xcd_barrier(xb);
        for (int rep = 0; rep < (PROBE_DUP == 3 ? 2 : 1); rep++) sparse_phase(qbuf, ckvn, selbuf, w_uk + (size_t)j * 16 * 256 * 64, w_uv + (size_t)j * 16 * 256 * 64, p.rel_bias,
                     hbuf, obuf, smh, vb, nvb);
        xcd_barrier(xb);
        Wres = w_ao + (size_t)j * 1024 * 1024;
      } else {
        EpiArgs ea{};
        ea.o0 = qbuf; ea.o1 = kbuf; ea.o2 = vtbuf;
        for (int rep = 0; rep < (PROBE_DUP == 4 ? 2 : 1); rep++) gemm8p_phase<EPI_BIN>(hbuf, w_bin + (size_t)j * 3072 * 1024, T, 3072, 1024, ea, smem, bid, nb);
        xcd_barrier(xb);
        for (int rep = 0; rep < (PROBE_DUP == 1 ? 2 : 1); rep++) diffattn_phase(qbuf, kbuf, vtbuf, obuf, p.rel_bias, p.b_lambda + j * 256, p.b_subln + j * 128, i, smem, bid, nb);
        xcd_barrier(xb);
        Wres = w_bo + (size_t)j * 1024 * 1024;
      }
      Ares = obuf; Kres = 1024; goff = 2 * 1024;
    } else {
      EpiArgs ea{};
      ea.o0 = hid;
      for (int rep = 0; rep < (PROBE_DUP == 4 ? 2 : 1); rep++) gemm8p_phase<EPI_SQRELU>(hbuf, w_w1 + (size_t)i * 4096 * 1024, T, 4096, 1024, ea, smem, bid, nb);
      xcd_barrier(xb);
      Ares = hid; Wres = w_w2 + (size_t)i * 4096 * 1024; Kres = 4096; goff = 5 * 1024;
    }
    {
      EpiArgs ea{};
      ea.f0 = p.out;
      ea.xin = (sl == 0) ? p.x : (const float*)p.out;
      ea.g = modi + goff;
      gemm8p_phase<EPI_RES>(Ares, Wres, T, 1024, Kres, ea, smem, bid, nb);
    }
    xcd_barrier(xb);
    {
      const float* modn = ((sl & 1) == 0) ? modi : (i < 3 ? modi + 4 * 6144 : (const float*)nullptr);
      const int sh_off = ((sl & 1) == 0) ? 3 * 1024 : 0;
      ln_phase(p.out, p.ln_g + (size_t)(i * 2 + (sl & 1)) * 1024, p.ln_b + (size_t)(i * 2 + (sl & 1)) * 1024, modn, sh_off,
               hbuf, vb, nvb);
    }
    xcd_barrier(xb);
  }
}

extern "C" void kernel_launch(void* const* d_in, const int* in_sizes, int n_in, void* d_out, int out_size, void* d_ws,
                              size_t ws_size, hipStream_t stream) {
  static int grid_blocks = 0;
  if (!grid_blocks) {
    int dev = 0, cus = 0, per_cu = 0;
    hipGetDevice(&dev);
    hipDeviceGetAttribute(&cus, hipDeviceAttributeMultiprocessorCount, dev);
    hipOccupancyMaxActiveBlocksPerMultiprocessor(&per_cu, hybrid_fwd, 512, 0);
    (void)per_cu;
    grid_blocks = cus;
    if (grid_blocks > 256) grid_blocks = 256;
  }
  Params p{};
  p.x = (const float*)d_in[0];
  p.c = (const float*)d_in[1];
  p.rel_bias = (const float*)d_in[2];
  p.ada_w = (const float*)d_in[3];
  p.ada_b = (const float*)d_in[4];
  p.ln_g = (const float*)d_in[5];
  p.ln_b = (const float*)d_in[6];
  p.a_w_in = (const float*)d_in[7];
  p.a_kv_norm = (const float*)d_in[8];
  p.a_w_uk = (const float*)d_in[9];
  p.a_w_uv = (const float*)d_in[10];
  p.a_w_o = (const float*)d_in[11];
  p.b_w_in = (const float*)d_in[12];
  p.b_lambda = (const float*)d_in[13];
  p.b_subln = (const float*)d_in[14];
  p.b_w_o = (const float*)d_in[15];
  p.mlp_w1 = (const float*)d_in[16];
  p.mlp_w2 = (const float*)d_in[17];
  p.out = (float*)d_out;
  p.ws = (char*)d_ws;
  hipMemsetAsync((char*)d_ws + WS_BAR, 0, XCD_BAR_WORDS * 4, stream);
  void* args[] = {&p};
  hipError_t e = hipLaunchCooperativeKernel((void*)hybrid_fwd, dim3(grid_blocks), dim3(512), args, 0, stream);
  if (e != hipSuccess) fprintf(stderr, "cooperative launch failed: %s (grid %d)\n", hipGetErrorString(e), grid_blocks);
}
```

```cpp
#include <hip/hip_runtime.h>
#include <hip/hip_cooperative_groups.h>
#include <stdint.h>
#include <stdio.h>
namespace cg = cooperative_groups;

typedef unsigned short u16;
typedef short bf16x8 __attribute__((ext_vector_type(8)));
typedef short s16x4 __attribute__((ext_vector_type(4)));
typedef float f32x16 __attribute__((ext_vector_type(16)));
typedef float f32x4 __attribute__((ext_vector_type(4)));
typedef float f32x2 __attribute__((ext_vector_type(2)));
typedef __bf16 bf16x2_t __attribute__((ext_vector_type(2)));
typedef unsigned u32x4 __attribute__((ext_vector_type(4)));
typedef unsigned u32x2 __attribute__((ext_vector_type(2)));
typedef __attribute__((address_space(3))) s16x4* lds_s16x4_ptr;

#define DI __device__ __forceinline__
#ifndef PROBE_DUP
#define PROBE_DUP 0
#endif

constexpr int D = 1024, NBATCH = 4, S = 8192, T = NBATCH * S;
constexpr int A_INP = 2048;
constexpr float DN_ALPHA = 1.6817928305074292f;
constexpr float LOG2E = 1.4426950408889634f;
constexpr float LN_EPS = 1e-5f;
constexpr float NEGF = -1e30f;
constexpr int TOPK = 256;
constexpr int CAP = 704;
constexpr int LDS_BYTES = 72 * 1024;

constexpr size_t MB = 1024 * 1024;
constexpr size_t W_AIN = 0;
constexpr size_t W_UK = W_AIN + (size_t)2 * 2048 * 1024 * 2;
constexpr size_t W_UV = W_UK + (size_t)2 * 16 * 256 * 64 * 2;
constexpr size_t W_AO = W_UV + (size_t)2 * 16 * 256 * 64 * 2;
constexpr size_t W_BIN = W_AO + (size_t)2 * 1024 * 1024 * 2;
constexpr size_t W_BO = W_BIN + (size_t)2 * 3072 * 1024 * 2;
constexpr size_t W_W1 = W_BO + (size_t)2 * 1024 * 1024 * 2;
constexpr size_t W_W2 = W_W1 + (size_t)4 * 4096 * 1024 * 2;
constexpr size_t WS_MOD = W_W2 + (size_t)4 * 4096 * 1024 * 2;
constexpr size_t WS_H = WS_MOD + 1 * MB;
constexpr size_t WS_BIG = WS_H + 64 * MB;
constexpr size_t WS_BAR = WS_BIG + 256 * MB;
constexpr size_t B_Q = 0;
constexpr size_t B_IQ = 64 * MB;
constexpr size_t B_IK = 96 * MB;
constexpr size_t B_IW = 100 * MB;
constexpr size_t B_CKVRAW = 104 * MB;
constexpr size_t B_CKVN = 136 * MB;
constexpr size_t B_SEL = 152 * MB;
constexpr size_t B_K = 64 * MB;
constexpr size_t B_VT = 128 * MB;
constexpr size_t B_O = 192 * MB;

struct Params {
  const float *x, *c, *rel_bias, *ada_w, *ada_b, *ln_g, *ln_b, *a_w_in, *a_kv_norm, *a_w_uk, *a_w_uv, *a_w_o, *b_w_in,
      *b_lambda, *b_subln, *b_w_o, *mlp_w1, *mlp_w2;
  float* out;
  char* ws;
};

DI int opq_tid() {
  int t = threadIdx.x & 255;
  asm volatile("" : "+v"(t));
  return t;
}
DI int opq_tid8() {
  int t = threadIdx.x;
  asm volatile("" : "+v"(t));
  return t;
}
DI unsigned pk2(float lo, float hi) {
  f32x2 v = {lo, hi};
  bf16x2_t b = __builtin_convertvector(v, bf16x2_t);
  return __builtin_bit_cast(unsigned, b);
}
DI u16 f2bf(float x) { return (u16)(pk2(x, 0.f) & 0xffffu); }
DI float wave_sum(float v) {
#pragma unroll
  for (int o = 32; o >= 1; o >>= 1) v += __shfl_xor(v, o);
  return v;
}
DI f32x16 mfma32(bf16x8 a, bf16x8 b, f32x16 c) { return __builtin_amdgcn_mfma_f32_32x32x16_bf16(a, b, c, 0, 0, 0); }
DI f32x4 mfma16(bf16x8 a, bf16x8 b, f32x4 c) { return __builtin_amdgcn_mfma_f32_16x16x32_bf16(a, b, c, 0, 0, 0); }
DI int pi_row(int r) { return (r & ~12) | ((r & 4) << 1) | ((r & 8) >> 1); }

DI int rel_bucket(int n) {
  if (n < 16) return n;
  float nf = (float)n;
  int large = 16 + (int)(logf(nf / 16.f) / 2.0794415416798357f * 16.f);
  return large < 31 ? large : 31;
}

DI void tconv_phase(const float* __restrict__ src, u16* __restrict__ dst, int batch, int R, int C, int Cpad, char* smem,
                    int bid, int nb) {
  float* tile = (float*)smem;
  const int tid = opq_tid();
  const int tr = R / 64, tc = Cpad / 64;
  const int ntiles = batch * tr * tc;
  for (int it0 = 0; it0 < ntiles; it0 += nb) {
    const int it = (it0 + bid < ntiles) ? it0 + bid : ntiles - 1;
    const int bi = it / (tr * tc);
    const int rem = it - bi * (tr * tc);
    const int ri = rem / tc, ci = rem - ri * tc;
    const float* s = src + (size_t)bi * R * C;
    u16* d = dst + (size_t)bi * Cpad * R;
    __syncthreads();
#pragma unroll
    for (int k = 0; k < 4; k++) {
      const int r = (tid >> 4) + 16 * k;
      const int cl = (tid & 15) * 4;
      const int cc = ci * 64 + cl;
      f32x4 v = {0.f, 0.f, 0.f, 0.f};
      if (cc < C) v = *(const f32x4*)(s + (size_t)(ri * 64 + r) * C + cc);
      tile[r * 65 + cl + 0] = v[0];
      tile[r * 65 + cl + 1] = v[1];
      tile[r * 65 + cl + 2] = v[2];
      tile[r * 65 + cl + 3] = v[3];
    }
    __syncthreads();
#pragma unroll
    for (int k = 0; k < 2; k++) {
      const int cl = (tid >> 3) + 32 * k;
      const int r8 = (tid & 7) * 8;
      u32x4 o;
      o[0] = pk2(tile[(r8 + 0) * 65 + cl], tile[(r8 + 1) * 65 + cl]);
      o[1] = pk2(tile[(r8 + 2) * 65 + cl], tile[(r8 + 3) * 65 + cl]);
      o[2] = pk2(tile[(r8 + 4) * 65 + cl], tile[(r8 + 5) * 65 + cl]);
      o[3] = pk2(tile[(r8 + 6) * 65 + cl], tile[(r8 + 7) * 65 + cl]);
      *(u32x4*)(d + (size_t)(ci * 64 + cl) * R + ri * 64 + r8) = o;
    }
  }
}

DI void mod_phase(const Params& p, float* mod, char* smem, int bid, int nb) {
  float* sc = (float*)smem;
  float* red = sc + 4096;
  const int tid = opq_tid(), lane = tid & 63, w = __builtin_amdgcn_readfirstlane(tid >> 6);
  __syncthreads();
  for (int i = tid; i < 4096; i += 256) {
    float v = p.c[i];
    sc[i] = v / (1.f + expf(-v));
  }
  __syncthreads();
  for (int it = bid; it < 4 * 384; it += nb) {
    const int l = it / 384, e0 = (it - l * 384) * 16;
    const int ds = lane >> 4, ec = lane & 15;
    const float* wp = p.ada_w + ((size_t)l * 1024 + w * 256 + ds) * 6144 + e0 + ec;
    float a0 = 0, a1 = 0, a2 = 0, a3 = 0;
#pragma unroll 16
    for (int d = 0; d < 64; d++) {
      float wv = wp[(size_t)(4 * d) * 6144];
      int dd = w * 256 + 4 * d + ds;
      a0 += sc[dd] * wv;
      a1 += sc[1024 + dd] * wv;
      a2 += sc[2048 + dd] * wv;
      a3 += sc[3072 + dd] * wv;
    }
    a0 += __shfl_xor(a0, 16); a0 += __shfl_xor(a0, 32);
    a1 += __shfl_xor(a1, 16); a1 += __shfl_xor(a1, 32);
    a2 += __shfl_xor(a2, 16); a2 += __shfl_xor(a2, 32);
    a3 += __shfl_xor(a3, 16); a3 += __shfl_xor(a3, 32);
    if (lane < 16) {
      red[(w * 4 + 0) * 16 + lane] = a0;
      red[(w * 4 + 1) * 16 + lane] = a1;
      red[(w * 4 + 2) * 16 + lane] = a2;
      red[(w * 4 + 3) * 16 + lane] = a3;
    }
    __syncthreads();
    if (tid < 64) {
      const int b = tid >> 4, e = tid & 15;
      float sm = red[(0 * 4 + b) * 16 + e] + red[(1 * 4 + b) * 16 + e] + red[(2 * 4 + b) * 16 + e] + red[(3 * 4 + b) * 16 + e] +
                 p.ada_b[l * 6144 + e0 + e];
      mod[((size_t)l * 4 + b) * 6144 + e0 + e] = sm;
    }
    __syncthreads();
  }
}

DI void h0_phase(const float* __restrict__ x, const float* __restrict__ mod0, u16* __restrict__ h, int bid, int nb) {
  const size_t n8 = (size_t)T * 1024 / 8;
  for (size_t i = (size_t)bid * 256 + opq_tid(); i < n8; i += (size_t)nb * 256) {
    const size_t e = i * 8;
    const int t = (int)(e >> 10), d = (int)(e & 1023), b = t >> 13;
    const float* m = mod0 + (size_t)b * 6144;
    f32x4 v0 = *(const f32x4*)(x + e), v1 = *(const f32x4*)(x + e + 4);
    f32x4 sh0 = *(const f32x4*)(m + d), sh1 = *(const f32x4*)(m + d + 4);
    f32x4 sc0 = *(const f32x4*)(m + 1024 + d), sc1 = *(const f32x4*)(m + 1024 + d + 4);
    v0 = v0 * (1.f + sc0) + sh0;
    v1 = v1 * (1.f + sc1) + sh1;
    u32x4 o;
    o[0] = pk2(v0[0], v0[1]);
    o[1] = pk2(v0[2], v0[3]);
    o[2] = pk2(v1[0], v1[1]);
    o[3] = pk2(v1[2], v1[3]);
    *(u32x4*)(h + e) = o;
  }
}

DI void ln_phase(float* z, const float* __restrict__ g, const float* __restrict__ bt, const float* modn, int sh_off,
                 u16* __restrict__ h, int bid, int nb) {
  const int tid = opq_tid(), lane = tid & 63, w = __builtin_amdgcn_readfirstlane(tid >> 6);
  for (int row = bid * 4 + w; row < T; row += nb * 4) {
    f32x4* zp = (f32x4*)(z + (size_t)row * 1024);
    f32x4 v[4];
#pragma unroll
    for (int c = 0; c < 4; c++) v[c] = zp[c * 64 + lane];
    float s = 0;
#pragma unroll
    for (int c = 0; c < 4; c++) s += v[c][0] + v[c][1] + v[c][2] + v[c][3];
    const float mu = wave_sum(s) * (1.f / 1024.f);
    float q = 0;
#pragma unroll
    for (int c = 0; c < 4; c++) {
      v[c] = v[c] - mu;
      q += v[c][0] * v[c][0] + v[c][1] * v[c][1] + v[c][2] * v[c][2] + v[c][3] * v[c][3];
    }
    const float rstd = rsqrtf(wave_sum(q) * (1.f / 1024.f) + LN_EPS);
    const int b = row >> 13;
#pragma unroll
    for (int c = 0; c < 4; c++) {
      const int d = c * 256 + lane * 4;
      f32x4 y = v[c] * rstd * *(const f32x4*)(g + d) + *(const f32x4*)(bt + d);
      zp[c * 64 + lane] = y;
      if (modn) {
        const float* m = modn + (size_t)b * 6144 + sh_off;
        f32x4 hv = y * (1.f + *(const f32x4*)(m + 1024 + d)) + *(const f32x4*)(m + d);
        u32x2 o;
        o[0] = pk2(hv[0], hv[1]);
        o[1] = pk2(hv[2], hv[3]);
        *(u32x2*)(h + (size_t)row * 1024 + d) = o;
      }
    }
  }
}

enum { EPI_AIN = 0, EPI_BIN = 1, EPI_RES = 2, EPI_SQRELU = 3 };
struct EpiArgs {
  u16 *o0, *o1, *o2;
  float *f0, *f1;
  const float* xin;
  const float* g;
};

template <int EPI>
DI void epi_store4(const EpiArgs& ea, int row, int col, const float* v, int bidx) {
  if (EPI == EPI_AIN) {
    if (col < 1024) {
      u32x2 o;
      o[0] = pk2(v[0], v[1]);
      o[1] = pk2(v[2], v[3]);
      *(u32x2*)(ea.o0 + (size_t)row * 1024 + col) = o;
    } else if (col < 1280) {
      *(f32x4*)(ea.f0 + (size_t)row * 256 + (col - 1024)) = (f32x4){v[0], v[1], v[2], v[3]};
    } else if (col < 1792) {
      u32x2 o;
      o[0] = pk2(v[0], v[1]);
      o[1] = pk2(v[2], v[3]);
      *(u32x2*)(ea.o1 + (size_t)row * 512 + (col - 1280)) = o;
    } else if (col < 1856) {
      const int d = col - 1792;
      const int sidx = row & 8191;
      const size_t off = (size_t)(row >> 13) * S * 64 +
                         ((size_t)((sidx >> 5) * 4 + (d >> 4)) * 64 + 32 * ((d >> 3) & 1) + (sidx & 31)) * 8 + (d & 7);
      u32x2 o;
      o[0] = pk2(v[0], v[1]);
      o[1] = pk2(v[2], v[3]);
      *(u32x2*)(ea.o2 + off) = o;
    } else if (col < 1864) {
      const float sc = 0.044194173824159216f;
      *(f32x4*)(ea.f1 + (size_t)row * 8 + (col - 1856)) = (f32x4){v[0] * sc, v[1] * sc, v[2] * sc, v[3] * sc};
    }
  } else if (EPI == EPI_BIN) {
    if (col < 1024) {
      const float sc = 0.125f * LOG2E;
      u32x2 o;
      o[0] = pk2(v[0] * sc, v[1] * sc);
      o[1] = pk2(v[2] * sc, v[3] * sc);
      *(u32x2*)(ea.o0 + (size_t)row * 1024 + col) = o;
    } else if (col < 2048) {
      u32x2 o;
      o[0] = pk2(v[0], v[1]);
      o[1] = pk2(v[2], v[3]);
      *(u32x2*)(ea.o1 + (size_t)row * 1024 + (col - 1024)) = o;
    } else {
      const int cv = col - 2048;
#pragma unroll
      for (int q = 0; q < 4; q++) ea.o2[((size_t)bidx * 1024 + cv + q) * 8192 + (row & 8191)] = f2bf(v[q]);
    }
  } else if (EPI == EPI_RES) {
    const f32x4 gg = *(const f32x4*)(ea.g + (size_t)bidx * 6144 + col);
    const size_t o = (size_t)row * 1024 + col;
    const f32x4 xv = *(const f32x4*)(ea.xin + o);
    f32x4 r;
#pragma unroll
    for (int q = 0; q < 4; q++) r[q] = DN_ALPHA * xv[q] + (1.f + gg[q]) * v[q];
    *(f32x4*)(ea.f0 + o) = r;
  } else {
    float r[4];
#pragma unroll
    for (int q = 0; q < 4; q++) {
      r[q] = v[q] > 0.f ? v[q] : 0.f;
      r[q] = r[q] * r[q];
    }
    u32x2 o;
    o[0] = pk2(r[0], r[1]);
    o[1] = pk2(r[2], r[3]);
    *(u32x2*)(ea.o0 + (size_t)row * 4096 + col) = o;
  }
}

template <int EPI>
DI void gemm_phase(const u16* __restrict__ A, const u16* __restrict__ Bt, int M, int N, int K, const EpiArgs& ea,
                   char* smem, int bid, int nb) {
  constexpr int MI = 4, BM = 64 * MI, BN = 256;
  u16* As = (u16*)smem;
  u16* Bs = As + BM * 72;
  const int tid = opq_tid8(), lane = tid & 63, w = __builtin_amdgcn_readfirstlane(tid >> 6), wm = w >> 2, wn = w & 3, l31 = lane & 31, lh = lane >> 5;
  const int ntn = N / BN, ntm = M / BM, nt = ntn * ntm, nk = K / 64;
  const int lr = tid >> 3, lc = (tid & 7) * 8;
  const int xcd = bid & 7, nbx = nb >> 3, cntx = (ntm >> 3) * ntn;
  (void)nt;
  for (int sq = bid >> 3; sq < cntx; sq += nbx) {
    const int tmx = sq / ntn, tn = sq - tmx * ntn;
    const int tm = tmx * 8 + xcd;
    const int m0 = tm * BM, n0 = tn * BN;
    f32x16 acc[MI][2];
#pragma unroll
    for (int i = 0; i < MI; i++)
#pragma unroll
      for (int j = 0; j < 2; j++)
#pragma unroll
        for (int r = 0; r < 16; r++) acc[i][j][r] = 0.f;
    u32x4 ra[4], rb[4];
    const u16* ap = A + (size_t)(m0 + lr) * K + lc;
    const u16* bp = Bt + (size_t)(n0 + lr) * K + lc;
#pragma unroll
    for (int i = 0; i < 4; i++) ra[i] = *(const u32x4*)(ap + (size_t)i * 64 * K);
#pragma unroll
    for (int i = 0; i < 4; i++) rb[i] = *(const u32x4*)(bp + (size_t)i * 64 * K);
    __syncthreads();
#pragma unroll
    for (int i = 0; i < 4; i++) *(u32x4*)&As[(lr + 64 * i) * 72 + lc] = ra[i];
#pragma unroll
    for (int i = 0; i < 4; i++) *(u32x4*)&Bs[(lr + 64 * i) * 72 + lc] = rb[i];
    __syncthreads();
    for (int kt = 0; kt < nk; kt++) {
      if (kt + 1 < nk) {
#pragma unroll
        for (int i = 0; i < 4; i++) ra[i] = *(const u32x4*)(ap + (size_t)i * 64 * K + (kt + 1) * 64);
#pragma unroll
        for (int i = 0; i < 4; i++) rb[i] = *(const u32x4*)(bp + (size_t)i * 64 * K + (kt + 1) * 64);
      }
#pragma unroll
      for (int ks = 0; ks < 4; ks++) {
        bf16x8 af[MI], b0, b1;
#pragma unroll
        for (int i = 0; i < MI; i++) af[i] = *(const bf16x8*)&As[(wm * 32 * MI + 32 * i + l31) * 72 + ks * 16 + lh * 8];
        b0 = *(const bf16x8*)&Bs[(wn * 64 + l31) * 72 + ks * 16 + lh * 8];
        b1 = *(const bf16x8*)&Bs[(wn * 64 + 32 + l31) * 72 + ks * 16 + lh * 8];
#pragma unroll
        for (int i = 0; i < MI; i++) {
          acc[i][0] = mfma32(b0, af[i], acc[i][0]);
          acc[i][1] = mfma32(b1, af[i], acc[i][1]);
        }
      }
      __syncthreads();
      if (kt + 1 < nk) {
#pragma unroll
        for (int i = 0; i < 4; i++) *(u32x4*)&As[(lr + 64 * i) * 72 + lc] = ra[i];
#pragma unroll
        for (int i = 0; i < 4; i++) *(u32x4*)&Bs[(lr + 64 * i) * 72 + lc] = rb[i];
        __syncthreads();
      }
    }
    const int bidx = m0 >> 13;
#pragma unroll
    for (int i = 0; i < MI; i++) {
      const int row = m0 + wm * 32 * MI + 32 * i + l31;
#pragma unroll
      for (int j = 0; j < 2; j++) {
#pragma unroll
        for (int r4 = 0; r4 < 4; r4++) {
          const int col = n0 + wn * 64 + 32 * j + 8 * r4 + 4 * lh;
          float v[4];
#pragma unroll
          for (int q = 0; q < 4; q++) v[q] = acc[i][j][4 * r4 + q];
          epi_store4<EPI>(ea, row, col, v, bidx);
        }
      }
    }
  }
}

DI int g8_lds_byte(int r, int c) {
  int st = (r >> 4) * 2 + (c >> 5), rr = r & 15, cc = c & 31, ob = rr * 64 + cc * 2;
  return st * 1024 + (ob ^ (((ob >> 9) & 1) << 5));
}
DI void g8_stage_rc(int b, int& R, int& C) {
  int st = b / 1024, sb = b % 1024, swz = sb ^ (((sb >> 9) & 1) << 5);
  R = (st >> 1) * 16 + swz / 64;
  C = (st & 1) * 32 + (swz % 64) / 2;
}
typedef __attribute__((address_space(3))) unsigned* lds_u32_ptr;

template <int EPI>
DI void gemm8p_phase(const u16* __restrict__ A, const u16* __restrict__ Bt, int M, int N, int K, const EpiArgs& ea,
                     char* smem, int bid, int nb) {
  constexpr int BK = 64, HALF = 128, HT = HALF * BK;
  u16* shm = (u16*)smem;
  const int tid = opq_tid8(), lane = tid & 63, wid = __builtin_amdgcn_readfirstlane(tid >> 6);
  const int wr = wid >> 2, wc = wid & 3, fr = lane & 15, fq = lane >> 4;
#define G8_SA(b, h) (shm + ((b) * 2 + (h)) * HT)
#define G8_SB(b, h) (shm + (4 + (b) * 2 + (h)) * HT)
  int g8o0, g8o1;
  {
    int r_, c_;
    g8_stage_rc(tid * 16, r_, c_);
    g8o0 = r_ * K + c_;
    g8_stage_rc(tid * 16 + 8192, r_, c_);
    g8o1 = r_ * K + c_;
  }
#define G8_STAGE(P, BASE, br, kt)                                                                                   \
  do {                                                                                                               \
    const u16* _gp = BASE + (size_t)(br) * K + (size_t)(kt) * BK;                                                    \
    asm volatile("" : "+s"(_gp));                \
    __builtin_amdgcn_global_load_lds((const unsigned*)(_gp + (unsigned)g8o0), (lds_u32_ptr)((char*)(P) + tid * 16), 16, 0, 0);        \
    __builtin_amdgcn_global_load_lds((const unsigned*)(_gp + (unsigned)g8o1), (lds_u32_ptr)((char*)(P) + tid * 16 + 8192), 16, 0, 0); \
  } while (0)
  const int g8lane = (fr * 64 + fq * 16) ^ ((fr & 8) << 2);
  const char* g8a = smem + g8lane + wr * 8192;
  const char* g8b = smem + 4 * HT * 2 + g8lane + wc * 4096;
#define G8_LDA(dst, b, h)                                                                                            \
  _Pragma("unroll") for (int m = 0; m < 4; ++m) _Pragma("unroll") for (int k = 0; k < 2; ++k)                        \
      dst[m][k] = *reinterpret_cast<const bf16x8*>(g8a + ((b) * 2 + (h)) * (HT * 2) + m * 2048 + k * 1024)
#define G8_LDB(dst, b, h)                                                                                            \
  _Pragma("unroll") for (int n = 0; n < 2; ++n) _Pragma("unroll") for (int k = 0; k < 2; ++k)                        \
      dst[n][k] = *reinterpret_cast<const bf16x8*>(g8b + ((b) * 2 + (h)) * (HT * 2) + n * 2048 + k * 1024)
#define G8_MMA(ai, bj, At_, Bt_)                                                                                     \
  do {                                                                                                               \
    __builtin_amdgcn_s_setprio(1);                                                                                   \
    _Pragma("unroll") for (int m = 0; m < 4; ++m) _Pragma("unroll") for (int n = 0; n < 2; ++n)                      \
        _Pragma("unroll") for (int k = 0; k < 2; ++k)                                                                \
            acc[ai][bj][m][n] = mfma16(Bt_[n][k], At_[m][k], acc[ai][bj][m][n]);                                     \
    __builtin_amdgcn_s_setprio(0);                                                                                   \
  } while (0)
#define G8_WAIT_V(n) asm volatile("s_waitcnt vmcnt(" #n ")" ::: "memory")
#define G8_WAIT_L(n) asm volatile("s_waitcnt lgkmcnt(" #n ")" ::: "memory")
#define G8_BAR __builtin_amdgcn_s_barrier()
#define G8_SCHED __builtin_amdgcn_sched_barrier(0)
  const int ntn = N / 256, ntm = M / 256, nt = K / BK;
  const int xcd = bid & 7, nbx = nb >> 3, cntx = (ntm >> 3) * ntn;
  for (int sq = bid >> 3; sq < cntx; sq += nbx) {
    const int tmx = sq / ntn, tn = sq - tmx * ntn;
    const int tm = tmx * 8 + xcd;
    const int brow = tm * 256, bcol = tn * 256;
    f32x4 acc[2][2][4][2];
#pragma unroll
    for (int a_ = 0; a_ < 2; a_++)
#pragma unroll
      for (int b_ = 0; b_ < 2; b_++)
#pragma unroll
        for (int m = 0; m < 4; m++)
#pragma unroll
          for (int n = 0; n < 2; n++) acc[a_][b_][m][n] = (f32x4){0.f, 0.f, 0.f, 0.f};
    bf16x8 At[4][2], B0[2][2], B1[2][2];
    asm volatile("s_waitcnt vmcnt(0) lgkmcnt(0)" ::: "memory");
    __syncthreads();
    G8_STAGE(G8_SB(0, 0), Bt, bcol, 0); G8_STAGE(G8_SA(0, 0), A, brow, 0);
    G8_STAGE(G8_SB(0, 1), Bt, bcol + HALF, 0); G8_STAGE(G8_SA(0, 1), A, brow + HALF, 0);
    if (wr == 1) G8_BAR;
    G8_WAIT_V(4); G8_BAR;
    G8_STAGE(G8_SB(1, 0), Bt, bcol, 1); G8_STAGE(G8_SA(1, 0), A, brow, 1); G8_STAGE(G8_SB(1, 1), Bt, bcol + HALF, 1);
    G8_WAIT_V(6); G8_BAR;
    for (int t = 0; t < nt - 2; t += 2) {
      G8_LDB(B0, 0, 0); G8_SCHED; G8_LDA(At, 0, 0); G8_STAGE(G8_SA(1, 1), A, brow + HALF, t + 1);
      G8_WAIT_L(8); G8_BAR; G8_WAIT_L(0); G8_MMA(0, 0, At, B0); G8_BAR; G8_SCHED;
      G8_LDB(B1, 0, 1); G8_STAGE(G8_SB(0, 0), Bt, bcol, t + 2);
      G8_BAR; G8_WAIT_L(0); G8_MMA(0, 1, At, B1); G8_BAR;
      G8_LDA(At, 0, 1); G8_STAGE(G8_SA(0, 0), A, brow, t + 2);
      G8_BAR; G8_WAIT_L(0); G8_MMA(1, 0, At, B0); G8_BAR; G8_SCHED;
      G8_STAGE(G8_SB(0, 1), Bt, bcol + HALF, t + 2);
      G8_WAIT_V(6); G8_BAR; G8_MMA(1, 1, At, B1); G8_BAR;
      G8_LDB(B0, 1, 0); G8_SCHED; G8_LDA(At, 1, 0); G8_STAGE(G8_SA(0, 1), A, brow + HALF, t + 2);
      G8_WAIT_L(8); G8_BAR; G8_WAIT_L(0); G8_MMA(0, 0, At, B0); G8_BAR; G8_SCHED;
      G8_LDB(B1, 1, 1); G8_STAGE(G8_SB(1, 0), Bt, bcol, t + 3);
      G8_BAR; G8_WAIT_L(0); G8_MMA(0, 1, At, B1); G8_BAR;
      G8_LDA(At, 1, 1); G8_STAGE(G8_SA(1, 0), A, brow, t + 3);
      G8_BAR; G8_WAIT_L(0); G8_MMA(1, 0, At, B0); G8_BAR; G8_SCHED;
      G8_STAGE(G8_SB(1, 1), Bt, bcol + HALF, t + 3);
      G8_WAIT_V(6); G8_BAR; G8_MMA(1, 1, At, B1); G8_BAR;
    }
    {
      G8_LDB(B0, 0, 0); G8_LDA(At, 0, 0); G8_STAGE(G8_SA(1, 1), A, brow + HALF, nt - 1);
      G8_BAR; G8_WAIT_L(0); G8_MMA(0, 0, At, B0); G8_BAR;
      G8_LDB(B1, 0, 1); G8_BAR; G8_WAIT_L(0); G8_MMA(0, 1, At, B1); G8_BAR;
      G8_LDA(At, 0, 1); G8_WAIT_V(4); G8_BAR; G8_WAIT_L(0); G8_MMA(1, 0, At, B0); G8_MMA(1, 1, At, B1); G8_BAR;
    }
    {
      G8_LDB(B0, 1, 0); G8_LDA(At, 1, 0); G8_WAIT_V(2); G8_BAR; G8_WAIT_L(0); G8_MMA(0, 0, At, B0); G8_BAR;
      G8_LDB(B1, 1, 1); G8_WAIT_V(0); G8_BAR; G8_WAIT_L(0); G8_MMA(0, 1, At, B1); G8_BAR;
      G8_LDA(At, 1, 1); G8_BAR; G8_WAIT_L(0); G8_MMA(1, 0, At, B0); G8_MMA(1, 1, At, B1); G8_BAR;
    }
    if (wr == 0) G8_BAR;
    const int bidx = brow >> 13;
#pragma unroll
    for (int ai = 0; ai < 2; ai++)
#pragma unroll
      for (int m = 0; m < 4; m++) {
        const int row = brow + ai * HALF + wr * 64 + m * 16 + fr;
#pragma unroll
        for (int bj = 0; bj < 2; bj++)
#pragma unroll
          for (int n = 0; n < 2; n++) {
            const int col = bcol + bj * HALF + wc * 32 + n * 16 + fq * 4;
            float v[4];
#pragma unroll
            for (int q = 0; q < 4; q++) v[q] = acc[ai][bj][m][n][q];
            epi_store4<EPI>(ea, row, col, v, bidx);
          }
      }
  }
#undef G8_SA
#undef G8_SB
#undef G8_STAGE
#undef G8_LDA
#undef G8_LDB
#undef G8_MMA
#undef G8_WAIT_V
#undef G8_WAIT_L
#undef G8_BAR
#undef G8_SCHED
}

DI void ckvnorm_phase(const float* __restrict__ raw, const float* __restrict__ g, u16* __restrict__ outp, int bid,
                      int nb) {
  const int tid = opq_tid(), lane = tid & 63, w = __builtin_amdgcn_readfirstlane(tid >> 6);
  const f32x4 gg = *(const f32x4*)(g + lane * 4);
  for (int row = bid * 4 + w; row < T; row += nb * 4) {
    f32x4 v = *(const f32x4*)(raw + (size_t)row * 256 + lane * 4);
    float ss = v[0] * v[0] + v[1] * v[1] + v[2] * v[2] + v[3] * v[3];
    ss = wave_sum(ss);
    const float r = rsqrtf(ss * (1.f / 256.f) + LN_EPS);
    u32x2 o;
    o[0] = pk2(v[0] * r * gg[0], v[1] * r * gg[1]);
    o[1] = pk2(v[2] * r * gg[2], v[3] * r * gg[3]);
    *(u32x2*)(outp + (size_t)row * 256 + lane * 4) = o;
  }
}

DI unsigned mono_key(float s) {
  unsigned u = __float_as_uint(s);
  return (u & 0x80000000u) ? ~u : (u | 0x80000000u);
}
DI float mono_inv(unsigned k) {
  unsigned u = (k & 0x80000000u) ? (k & 0x7fffffffu) : ~k;
  return __uint_as_float(u);
}
DI float relu_i(float x) {
  int i = __float_as_int(x);
  return __int_as_float(i > 0 ? i : 0);
}
DI int wcount(bool f) { return __popcll(__ballot(f)); }

template <bool EXACT>
DI void compact4(float* vals, u16* idxs, int* cnt, int lane, float* thr_out) {
  constexpr int NPL = CAP / 64;
  unsigned key[4][NPL];
  int n[4];
#pragma unroll
  for (int q = 0; q < 4; q++) n[q] = cnt[q];
#pragma unroll
  for (int q = 0; q < 4; q++)
#pragma unroll
    for (int j = 0; j < NPL; j++) {
      const int e = j * 64 + lane;
      key[q][j] = (e < n[q]) ? mono_key(vals[q * CAP + e]) : 0u;
    }
  unsigned Tk[4] = {0u, 0u, 0u, 0u};
  constexpr int LOWBIT = EXACT ? 0 : 18;
#pragma unroll 1
  for (int bit = 31; bit >= LOWBIT; bit--) {
#pragma unroll
    for (int q = 0; q < 4; q++) {
      const unsigned cand = Tk[q] | (1u << bit);
      int c = 0;
#pragma unroll
      for (int j = 0; j < NPL; j++) c += wcount(key[q][j] >= cand);
      Tk[q] = (c >= TOPK) ? cand : Tk[q];
      if (q == 1) __builtin_amdgcn_sched_barrier(0);
    }
  }
  unsigned I[4] = {0xffffu, 0xffffu, 0xffffu, 0xffffu};
  if (EXACT) {
    unsigned ix[4][NPL];
    int need[4];
#pragma unroll
    for (int q = 0; q < 4; q++) {
      int cgt = 0;
#pragma unroll
      for (int j = 0; j < NPL; j++) {
        const int e = j * 64 + lane;
        ix[q][j] = (e < n[q]) ? (unsigned)idxs[q * CAP + e] : 0xffffu;
        cgt += wcount(key[q][j] > Tk[q]);
      }
      need[q] = TOPK - cgt;
      I[q] = 0u;
    }
#pragma unroll 1
    for (int bit = 13; bit >= 0; bit--) {
#pragma unroll
      for (int q = 0; q < 4; q++) {
        const unsigned cand = I[q] | (1u << bit);
        int c = 0;
#pragma unroll
        for (int j = 0; j < NPL; j++) c += wcount(key[q][j] == Tk[q] && ix[q][j] < cand);
        I[q] = (c < need[q]) ? cand : I[q];
        if (q == 1) __builtin_amdgcn_sched_barrier(0);
      }
    }
  }
  const unsigned long long lt = (1ull << lane) - 1ull;
#pragma unroll
  for (int q = 0; q < 4; q++) {
    if (n[q] > TOPK) {
      int base = 0;
#pragma unroll
      for (int j = 0; j < NPL; j++) {
        const int e = j * 64 + lane;
        const bool in = e < n[q];
        const float v = in ? vals[q * CAP + e] : 0.f;
        const unsigned ixv = in ? (unsigned)idxs[q * CAP + e] : 0xffffu;
        const bool keep = (key[q][j] > Tk[q]) || (key[q][j] == Tk[q] && ixv <= I[q]);
        const unsigned long long m = __ballot(keep);
        if (keep) {
          const int pos = base + __popcll(m & lt);
          vals[q * CAP + pos] = v;
          idxs[q * CAP + pos] = (u16)ixv;
        }
        base += __popcll(m);
      }
      if (lane == 0) cnt[q] = base;
      thr_out[q] = mono_inv(Tk[q]);
    }
  }
}

DI void indexer_phase(const u16* __restrict__ iq, const u16* __restrict__ ik, const float* __restrict__ iw,
                      u16* __restrict__ sel, char* smem, int bid, int nb) {
  constexpr int WBYTES = 4 * CAP * 4 + 4 * CAP * 2 + 64;
  const int tid = opq_tid(), lane = tid & 63, w = __builtin_amdgcn_readfirstlane(tid >> 6), l31 = lane & 31, u = lane >> 5;
  float* vals = (float*)(smem + w * WBYTES);
  u16* idxs = (u16*)(smem + w * WBYTES + 4 * CAP * 4);
  int* cnt = (int*)(smem + w * WBYTES + 4 * CAP * 4 + 4 * CAP * 2);
  const int nitems = NBATCH * (S / 16);
  const int nrounds = (nitems + nb - 1) / nb;
  __syncthreads();
  for (int rd = 0; rd < nrounds; rd++) {
    const int it = rd * nb + ((rd & 1) ? (nb - 1 - bid) : bid);
    if (it >= nitems) continue;
    const int b = it & 3, qg = (S / 16 - 1) - (it >> 2);
    const int t0 = qg * 16;
    const int tw = t0 + 4 * w;
    const size_t tb = (size_t)b * S;
    bf16x8 aq[4];
    {
      const int g = l31 >> 3, up = (l31 >> 2) & 1, j = l31 & 3;
      const int ql = 2 * up + (g >> 1), hd = 4 * (g & 1) + j;
      const u16* qp = iq + (tb + tw + ql) * 512 + hd * 64 + u * 8;
#pragma unroll
      for (int ks = 0; ks < 4; ks++) aq[ks] = *(const bf16x8*)(qp + ks * 16);
    }
    float wq[2][8];
#pragma unroll
    for (int qq = 0; qq < 2; qq++) {
      const float* wp = iw + (tb + tw + 2 * u + qq) * 8;
      f32x4 w0 = *(const f32x4*)wp, w1 = *(const f32x4*)(wp + 4);
#pragma unroll
      for (int h = 0; h < 4; h++) {
        wq[qq][h] = w0[h];
        wq[qq][4 + h] = w1[h];
      }
    }
    float thr[2] = {-INFINITY, -INFINITY};
    __builtin_amdgcn_wave_barrier();
    if (lane < 4) cnt[lane] = 0;
    __builtin_amdgcn_wave_barrier();
    const int nkb = (tw + 3) / 32 + 1;
    const u16* kp = ik + tb * 64 + lane * 8;
    bf16x8 ring[4][4];
#pragma unroll
    for (int i = 0; i < 4; i++) {
      const int kbn = (i < nkb) ? i : nkb - 1;
#pragma unroll
      for (int ks = 0; ks < 4; ks++) ring[i][ks] = *(const bf16x8*)(kp + (size_t)(kbn * 4 + ks) * 512);
    }
#pragma unroll 1
    for (int kb0 = 0; kb0 < nkb; kb0 += 4) {
#pragma unroll
      for (int i = 0; i < 4; i++) {
        const int kb = kb0 + i;
        {
          f32x16 acc;
#pragma unroll
          for (int r = 0; r < 16; r++) acc[r] = 0.f;
#pragma unroll
          for (int ks = 0; ks < 4; ks++) acc = mfma32(aq[ks], ring[i][ks], acc);
          {
            const int kbn = (kb + 4 < nkb) ? kb + 4 : nkb - 1;
#pragma unroll
            for (int ks = 0; ks < 4; ks++) ring[i][ks] = *(const bf16x8*)(kp + (size_t)(kbn * 4 + ks) * 512);
          }
          const int key = kb * 32 + l31;
#pragma unroll
          for (int qq = 0; qq < 2; qq++) {
            float s0 = 0.f, s1 = 0.f;
#pragma unroll
            for (int h = 0; h < 8; h += 2) {
              s0 = fmaf(wq[qq][h], relu_i(acc[8 * qq + h]), s0);
              s1 = fmaf(wq[qq][h + 1], relu_i(acc[8 * qq + h + 1]), s1);
            }
            float s = s0 + s1;
            s += 0.0f;
            const int tq = tw + 2 * u + qq;
            if (key <= tq && s >= thr[qq]) {
              const int qs = 2 * u + qq;
              const int pos = atomicAdd(&cnt[qs], 1);
              vals[qs * CAP + pos] = s;
              idxs[qs * CAP + pos] = (u16)key;
            }
          }
        }
      }
      __builtin_amdgcn_wave_barrier();
      const int c0 = cnt[0], c1 = cnt[1], c2 = cnt[2], c3 = cnt[3];
      if (c0 > CAP - 128 || c1 > CAP - 128 || c2 > CAP - 128 || c3 > CAP - 128) {
        float to[4] = {0.f, 0.f, 0.f, 0.f};
        compact4<false>(vals, idxs, cnt, lane, to);
        __builtin_amdgcn_wave_barrier();
        const int d0 = cnt[0], d1 = cnt[1], d2 = cnt[2], d3 = cnt[3];
        if (d0 > CAP - 256 || d1 > CAP - 256 || d2 > CAP - 256 || d3 > CAP - 256) {
          compact4<true>(vals, idxs, cnt, lane, to);
          __builtin_amdgcn_wave_barrier();
        }
        if (c0 > TOPK && u == 0) thr[0] = to[0];
        if (c1 > TOPK && u == 0) thr[1] = to[1];
        if (c2 > TOPK && u == 1) thr[0] = to[2];
        if (c3 > TOPK && u == 1) thr[1] = to[3];
      }
    }
    {
      const int c0 = cnt[0], c1 = cnt[1], c2 = cnt[2], c3 = cnt[3];
      if (c0 > TOPK || c1 > TOPK || c2 > TOPK || c3 > TOPK) {
        float to[4];
        compact4<true>(vals, idxs, cnt, lane, to);
        __builtin_amdgcn_wave_barrier();
      }
    }
#pragma unroll 1
    for (int qs = 0; qs < 4; qs++) {
      const int n = cnt[qs];
      u16* sp = sel + (tb + tw + qs) * 256;
#pragma unroll
      for (int j = 0; j < 4; j++) {
        const int e = j * 64 + lane;
        sp[e] = (e < n) ? idxs[qs * CAP + e] : (u16)0xffffu;
      }
    }
  }
}

DI void sparse_phase(const u16* __restrict__ q, const u16* __restrict__ ckvn, const u16* __restrict__ sel,
                     const u16* __restrict__ wuk, const u16* __restrict__ wuv, const float* __restrict__ rel_bias,
                     u16* scratch, u16* __restrict__ o, char* smem, int bid, int nb) {
  constexpr int GS = 264;
  const int tid = opq_tid(), lane = tid & 63, w = __builtin_amdgcn_readfirstlane(tid >> 6), l15 = lane & 15, g = lane >> 4;
  u16* G = (u16*)smem + (size_t)w * 32 * GS;
  int* lut = (int*)(smem + 4 * 32 * GS * 2);
  float* rb = (float*)(lut + 128);
  __syncthreads();
  if (tid < 128) lut[tid] = rel_bucket(tid);
  for (int i = tid; i < 512; i += 256) rb[i] = rel_bias[i] * LOG2E;
  __syncthreads();
  u16* ql = scratch + (size_t)bid * (16 * 16 * 256);
  const int nitems = NBATCH * (S / 16);
  for (int it = bid; it < nitems; it += nb) {
    const int b = it & 3, qg = it >> 2;
    const int t0 = qg * 16;
    const size_t tb = (size_t)b * S;
    for (int hh = 0; hh < 4; hh++) {
      const int h = 4 * w + hh;
      bf16x8 bq[2];
#pragma unroll
      for (int ks = 0; ks < 2; ks++) bq[ks] = *(const bf16x8*)(q + (tb + t0 + l15) * 1024 + h * 64 + ks * 32 + g * 8);
#pragma unroll 4
      for (int rt = 0; rt < 16; rt++) {
        f32x4 acc = {0.f, 0.f, 0.f, 0.f};
#pragma unroll
        for (int ks = 0; ks < 2; ks++) {
          bf16x8 a = *(const bf16x8*)(wuk + ((size_t)h * 256 + rt * 16 + l15) * 64 + ks * 32 + g * 8);
          acc = mfma16(a, bq[ks], acc);
        }
        u32x2 ov;
        ov[0] = pk2(acc[0] * (0.125f * LOG2E), acc[1] * (0.125f * LOG2E));
        ov[1] = pk2(acc[2] * (0.125f * LOG2E), acc[3] * (0.125f * LOG2E));
        *(u32x2*)(ql + ((size_t)l15 * 16 + h) * 256 + rt * 16 + 4 * g) = ov;
      }
    }
    __syncthreads();
    {
      const u16* selw = sel + (tb + t0 + 4 * w) * 256;
      const int l31 = lane & 31;
      const int q4 = l15 >> 2, p4 = l15 & 3;
      const u16* ckb = ckvn + tb * 256;
      int idx_c = selw[l31];
      int idx_n = selw[32 + l31];
      u32x4 gr[16];
#pragma unroll
      for (int i = 0; i < 16; i++) {
        int id = __shfl(idx_c, (lane >> 5) + 2 * i);
        id = (id == 0xffff) ? 0 : id;
        gr[i] = *(const u32x4*)(ckb + (unsigned)(id * 256 + l31 * 8));
      }
      bf16x8 qb[8];
      float m_run = NEGF, l_run = 0.f;
      f32x4 O[16];
#pragma unroll 1
      for (int st = 0; st < 32; st++) {
        const int qi = st >> 3, ch = st & 7;
        const int qloc = 4 * w + qi;
        const int t = t0 + qloc;
        if (ch == 0) {
#pragma unroll
          for (int ks = 0; ks < 8; ks++) qb[ks] = *(const bf16x8*)(ql + ((size_t)qloc * 16 + l15) * 256 + ks * 32 + g * 8);
          m_run = NEGF;
          l_run = 0.f;
#pragma unroll
          for (int rt = 0; rt < 16; rt++) O[rt] = (f32x4){0.f, 0.f, 0.f, 0.f};
        }
#pragma unroll
        for (int i = 0; i < 16; i++) *(u32x4*)&G[((lane >> 5) + 2 * i) * GS + l31 * 8] = gr[i];
        __builtin_amdgcn_wave_barrier();
        const int stn2 = (st + 2 < 32) ? st + 2 : 31;
        const int idx_nn = selw[stn2 * 32 + l31];
#pragma unroll
        for (int i = 0; i < 16; i++) {
          int id = __shfl(idx_n, (lane >> 5) + 2 * i);
          id = (id == 0xffff) ? 0 : id;
          gr[i] = *(const u32x4*)(ckb + (unsigned)(id * 256 + l31 * 8));
        }
        float lg[2][4];
#pragma unroll
        for (int kbk = 0; kbk < 2; kbk++) {
          f32x4 acc = {0.f, 0.f, 0.f, 0.f};
#pragma unroll
          for (int ks = 0; ks < 8; ks++) {
            bf16x8 a = *(const bf16x8*)&G[(16 * kbk + l15) * GS + ks * 32 + g * 8];
            acc = mfma16(a, qb[ks], acc);
            if (ks == 3) asm volatile("" ::: "memory");
          }
          asm volatile("" ::: "memory");
#pragma unroll
          for (int i = 0; i < 4; i++) {
            const int kid = __shfl(idx_c, 16 * kbk + 4 * g + i);
            float v = NEGF;
            if (kid != 0xffff) {
              int n = t - kid;
              n = n < 0 ? 0 : n;
              const int bk = n < 128 ? lut[n] : 31;
              v = acc[i] + rb[bk * 16 + l15];
            }
            lg[kbk][i] = v;
          }
        }
        float mx = fmaxf(fmaxf(fmaxf(lg[0][0], lg[0][1]), fmaxf(lg[0][2], lg[0][3])),
                         fmaxf(fmaxf(lg[1][0], lg[1][1]), fmaxf(lg[1][2], lg[1][3])));
        mx = fmaxf(mx, __shfl_xor(mx, 16));
        mx = fmaxf(mx, __shfl_xor(mx, 32));
        const float m_new = fmaxf(m_run, mx);
        const float scl = __builtin_amdgcn_exp2f(m_run - m_new);
        m_run = m_new;
        float ps = 0.f;
        float pe[8];
#pragma unroll
        for (int kbk = 0; kbk < 2; kbk++)
#pragma unroll
          for (int i = 0; i < 4; i++) {
            const float pv = __builtin_amdgcn_exp2f(lg[kbk][i] - m_new);
            pe[kbk * 4 + i] = pv;
            ps += pv;
          }
        l_run = l_run * scl + ps;
        u32x4 pw;
        pw[0] = pk2(pe[0], pe[1]);
        pw[1] = pk2(pe[2], pe[3]);
        pw[2] = pk2(pe[4], pe[5]);
        pw[3] = pk2(pe[6], pe[7]);
        const bf16x8 pB = __builtin_bit_cast(bf16x8, pw);
        if (__ballot(scl != 1.f)) {
#pragma unroll
          for (int rt = 0; rt < 16; rt++) O[rt] = O[rt] * scl;
        }
#pragma unroll
        for (int rt = 0; rt < 16; rt++) {
          const s16x4 lo = __builtin_amdgcn_ds_read_tr16_b64_v4i16((lds_s16x4_ptr)(&G[(4 * g + q4) * GS + rt * 16 + 4 * p4]));
          const s16x4 hi = __builtin_amdgcn_ds_read_tr16_b64_v4i16((lds_s16x4_ptr)(&G[(16 + 4 * g + q4) * GS + rt * 16 + 4 * p4]));
          const bf16x8 a = (bf16x8){lo[0], lo[1], lo[2], lo[3], hi[0], hi[1], hi[2], hi[3]};
          O[rt] = mfma16(a, pB, O[rt]);
          if ((rt & 3) == 3) asm volatile("" ::: "memory");
        }
        __builtin_amdgcn_wave_barrier();
        if (ch == 7) {
          float lt = l_run;
          lt += __shfl_xor(lt, 16);
          lt += __shfl_xor(lt, 32);
          const float inv = 1.f / lt;
#pragma unroll
          for (int rt = 0; rt < 16; rt++) {
            u32x2 ov;
            ov[0] = pk2(O[rt][0] * inv, O[rt][1] * inv);
            ov[1] = pk2(O[rt][2] * inv, O[rt][3] * inv);
            *(u32x2*)(ql + ((size_t)qloc * 16 + l15) * 256 + rt * 16 + 4 * g) = ov;
          }
        }
        idx_c = idx_n;
        idx_n = idx_nn;
      }
    }
    __syncthreads();
    for (int hh = 0; hh < 4; hh++) {
      const int h = 4 * w + hh;
      bf16x8 bo[8];
#pragma unroll
      for (int ks = 0; ks < 8; ks++) bo[ks] = *(const bf16x8*)(ql + ((size_t)l15 * 16 + h) * 256 + ks * 32 + g * 8);
#pragma unroll
      for (int et = 0; et < 4; et++) {
        f32x4 acc = {0.f, 0.f, 0.f, 0.f};
#pragma unroll
        for (int ks = 0; ks < 8; ks++) {
          bf16x8 a = *(const bf16x8*)(wuv + ((size_t)h * 64 + et * 16 + l15) * 256 + ks * 32 + g * 8);
          acc = mfma16(a, bo[ks], acc);
        }
        u32x2 ov;
        ov[0] = pk2(acc[0], acc[1]);
        ov[1] = pk2(acc[2], acc[3]);
        *(u32x2*)(o + (tb + t0 + l15) * 1024 + h * 64 + et * 16 + 4 * g) = ov;
      }
    }
    __syncthreads();
  }
}

DI void diffattn_phase(const u16* __restrict__ q, const u16* __restrict__ k, const u16* __restrict__ vT,
                       u16* __restrict__ o, const float* __restrict__ rel_bias, const float* __restrict__ lam,
                       const float* __restrict__ subln, int layer_idx, char* smem, int bid, int nb) {
  constexpr int KS = 136, VS = 72;
  u16* Ks = (u16*)smem;
  u16* Vs = Ks + 64 * KS;
  float* exch = (float*)smem;
  constexpr int STG = 64 * KS + 128 * VS;
  float* btab = (float*)(smem + 72 * 1024);
  int* lut = (int*)(smem + 72 * 1024 + 1040);
  float* misc = (float*)(smem + 72 * 1024 + 1040 + 512);
  const int tid = opq_tid8(), lane = tid & 63, w = __builtin_amdgcn_readfirstlane(tid >> 6), l31 = lane & 31, lh = lane >> 5;
  const int qsub = w >> 1, m = w & 1;
  const float lam_init = 0.8f - 0.6f * expf(-0.3f * (float)layer_idx);
  __syncthreads();
  if (tid < 128) lut[tid] = rel_bucket(tid);
  if (w == 0) {
    float p1 = lam[lane] * lam[64 + lane], p2 = lam[128 + lane] * lam[192 + lane];
    p1 = wave_sum(p1);
    p2 = wave_sum(p2);
    if (lane == 0) misc[0] = expf(p1) - expf(p2) + lam_init;
  }
  __syncthreads();
  const float lam_full = misc[0];
  const int xcd = bid & 7, loc = bid >> 3, nbx = nb >> 3;
  const int rph = (S / 128) / nbx;
  const int prow = pi_row(l31);
  for (int rd = 0; rd < 4 * rph; rd++) {
    const int hh = rd / rph, r = rd - hh * rph;
    const int bh = xcd + 8 * hh;
    const int kk = r >> 1;
    const int qb = (r & 1) ? (kk * nbx + loc) : ((S / 128 - 1) - kk * nbx - loc);
    const int b = bh >> 3, h = bh & 7;
    const int q0 = qb * 128, tq0 = q0 + 32 * qsub, t = tq0 + l31;
    const size_t tb = (size_t)b * S;
    __syncthreads();
    for (int i = tid; i < 258; i += 512) {
      const int n = i >> 1, mm = i & 1;
      const int bk = n < 128 ? lut[n] : 31;
      btab[i] = rel_bias[bk * 16 + 2 * h + mm] * LOG2E;
    }
    bf16x8 qf[4];
#pragma unroll
    for (int ks = 0; ks < 4; ks++) qf[ks] = *(const bf16x8*)(q + (tb + t) * 1024 + h * 128 + m * 64 + ks * 16 + lh * 8);
    f32x16 O[4];
#pragma unroll
    for (int et = 0; et < 4; et++)
#pragma unroll
      for (int r = 0; r < 16; r++) O[et][r] = 0.f;
    float m_run = NEGF, l_run = 0.f;
    const int nkt = 2 * qb + 2;
    u32x4 rk[2], rv[2];
    const u16* kp = k + tb * 1024 + h * 128;
    const u16* vp = vT + ((size_t)(b * 8 + h) * 128) * 8192;
#pragma unroll
    for (int i = 0; i < 2; i++) {
      const int id = tid + 512 * i;
      rk[i] = *(const u32x4*)(kp + (size_t)(id >> 4) * 1024 + (id & 15) * 8);
      rv[i] = *(const u32x4*)(vp + (size_t)(id >> 3) * 8192 + (id & 7) * 8);
    }
#pragma unroll
    for (int i = 0; i < 2; i++) {
      const int id = tid + 512 * i;
      *(u32x4*)&Ks[(id >> 4) * KS + (id & 15) * 8] = rk[i];
      *(u32x4*)&Vs[(id >> 3) * VS + (id & 7) * 8] = rv[i];
    }
#pragma unroll
    for (int i = 0; i < 2; i++) {
      const int id = tid + 512 * i;
      rk[i] = *(const u32x4*)(kp + (size_t)(64 + (id >> 4)) * 1024 + (id & 15) * 8);
      rv[i] = *(const u32x4*)(vp + (size_t)(id >> 3) * 8192 + 64 + (id & 7) * 8);
    }
    __syncthreads();
    const float cfar = btab[256 + m];
    for (int kt = 0; kt < nkt; kt++) {
      const u16* Ksc = Ks + (kt & 1) * STG;
      const u16* Vsc = Vs + (kt & 1) * STG;
      if (kt + 1 < nkt) {
        u16* Ksn = Ks + ((kt & 1) ^ 1) * STG;
        u16* Vsn = Vs + ((kt & 1) ^ 1) * STG;
#pragma unroll
        for (int i = 0; i < 2; i++) {
          const int id = tid + 512 * i;
          *(u32x4*)&Ksn[(id >> 4) * KS + (id & 15) * 8] = rk[i];
          *(u32x4*)&Vsn[(id >> 3) * VS + (id & 7) * 8] = rv[i];
        }
        const int k2 = (kt + 2 < nkt) ? kt + 2 : nkt - 1;
#pragma unroll
        for (int i = 0; i < 2; i++) {
          const int id = tid + 512 * i;
          rk[i] = *(const u32x4*)(kp + (size_t)(k2 * 64 + (id >> 4)) * 1024 + (id & 15) * 8);
          rv[i] = *(const u32x4*)(vp + (size_t)(id >> 3) * 8192 + k2 * 64 + (id & 7) * 8);
        }
      }
      const int s_tile = kt * 64;
      const int remk = tq0 + 31 - s_tile;
      const int nblk = remk < 0 ? 0 : (remk >= 32 ? 2 : 1);
#pragma unroll 1
      for (int kb = 0; kb < nblk; kb++) {
        const int s0 = s_tile + 32 * kb;
        const bool nearb = (tq0 - (s0 + 31)) < 128;
        const bool first = (kt == 0) && (kb == 0);
        const float mref = first ? 0.f : m_run;
        const float cinit = nearb ? -mref : (cfar - mref);
        f32x16 acc;
#pragma unroll
        for (int r = 0; r < 16; r++) acc[r] = cinit;
#pragma unroll
        for (int ks = 0; ks < 4; ks++) {
          bf16x8 a = *(const bf16x8*)&Ksc[(32 * kb + prow) * KS + m * 64 + ks * 16 + lh * 8];
          acc = mfma32(a, qf[ks], acc);
        }
        if (nearb) {
#pragma unroll
          for (int r = 0; r < 16; r++) {
            const int key = s0 + 16 * (r >> 3) + 8 * lh + (r & 7);
            const int n = t - key;
            const int nc = n < 0 ? 0 : (n > 128 ? 128 : n);
            const float bv = btab[nc * 2 + m];
            acc[r] = (n < 0) ? NEGF : acc[r] + bv;
          }
        }
        float mx = acc[0];
#pragma unroll
        for (int r = 1; r < 16; r++) mx = fmaxf(mx, acc[r]);
        mx = fmaxf(mx, __shfl_xor(mx, 32));
        if (first || __ballot(mx > 8.f)) {
          const float dlt = first ? mx : fmaxf(mx, 0.f);
          const float scl = __builtin_amdgcn_exp2f(-dlt);
#pragma unroll
          for (int r = 0; r < 16; r++) acc[r] -= dlt;
#pragma unroll
          for (int et = 0; et < 4; et++)
#pragma unroll
            for (int r = 0; r < 16; r++) O[et][r] *= scl;
          l_run *= scl;
          m_run = mref + dlt;
        }
        float ps = 0.f;
#pragma unroll
        for (int r = 0; r < 16; r++) {
          const float pv = __builtin_amdgcn_exp2f(acc[r]);
          acc[r] = pv;
          ps += pv;
        }
        l_run += ps;
#pragma unroll
        for (int s2 = 0; s2 < 2; s2++) {
          u32x4 pw;
          pw[0] = pk2(acc[8 * s2 + 0], acc[8 * s2 + 1]);
          pw[1] = pk2(acc[8 * s2 + 2], acc[8 * s2 + 3]);
          pw[2] = pk2(acc[8 * s2 + 4], acc[8 * s2 + 5]);
          pw[3] = pk2(acc[8 * s2 + 6], acc[8 * s2 + 7]);
          const bf16x8 pB = __builtin_bit_cast(bf16x8, pw);
#pragma unroll
          for (int et = 0; et < 4; et++) {
            bf16x8 a = *(const bf16x8*)&Vsc[(32 * et + l31) * VS + 32 * kb + 16 * s2 + 8 * lh];
            O[et] = mfma32(a, pB, O[et]);
          }
        }
      }
      __syncthreads();
    }
    float lt = l_run + __shfl_xor(l_run, 32);
    const float inv = 1.f / lt;
    if (m == 1) {
#pragma unroll
      for (int et = 0; et < 4; et++)
#pragma unroll
        for (int r = 0; r < 16; r++) {
          const int e = 32 * et + (r & 3) + 8 * (r >> 2) + 4 * lh;
          exch[(qsub * 128 + e) * 32 + l31] = O[et][r] * inv;
        }
    }
    __syncthreads();
    if (m == 0) {
      float ss = 0.f;
#pragma unroll
      for (int et = 0; et < 4; et++)
#pragma unroll
        for (int r = 0; r < 16; r++) {
          const int e = 32 * et + (r & 3) + 8 * (r >> 2) + 4 * lh;
          const float v = O[et][r] * inv - lam_full * exch[(qsub * 128 + e) * 32 + l31];
          O[et][r] = v;
          ss += v * v;
        }
      ss += __shfl_xor(ss, 32);
      const float rs = rsqrtf(ss * (1.f / 128.f) + LN_EPS);
      const float osc = 1.f - lam_init;
#pragma unroll
      for (int et = 0; et < 4; et++)
#pragma unroll
        for (int r4 = 0; r4 < 4; r4++) {
          const int e = 32 * et + 8 * r4 + 4 * lh;
          const f32x4 gv = *(const f32x4*)(subln + e);
          u32x2 ov;
          ov[0] = pk2(O[et][4 * r4 + 0] * rs * gv[0] * osc, O[et][4 * r4 + 1] * rs * gv[1] * osc);
          ov[1] = pk2(O[et][4 * r4 + 2] * rs * gv[2] * osc, O[et][4 * r4 + 3] * rs * gv[3] * osc);
          *(u32x2*)(o + (tb + t) * 1024 + h * 128 + e) = ov;
        }
    }
  }
}

#define XB_TMO      128
#define XB_XCNT(j)  (256  + 64 * (j))
#define XB_XSUB(j)  (1280 + 64 * (j))
#define XB_XGEN(j)  (2304 + 64 * (j))
#define XB_TOP      3328
#define XB_TOPGEN   3392
#define XCD_BAR_WORDS 3456
#define XB_SPIN_CAP (1u << 20)
#define LAS __attribute__((address_space(3)))
DI unsigned xb_ld(unsigned* p) { return __hip_atomic_load(p, __ATOMIC_RELAXED, __HIP_MEMORY_SCOPE_AGENT); }
DI unsigned xb_add(unsigned* p, unsigned v) { return __hip_atomic_fetch_add(p, v, __ATOMIC_RELAXED, __HIP_MEMORY_SCOPE_AGENT); }
DI unsigned xb_xcc_id() { return (unsigned)__builtin_amdgcn_s_getreg((3 << 11) | 20) & 0xFu; }
#define XB_SPIN(cond, bar) do { unsigned _sp = 0; while (cond) { __builtin_amdgcn_s_sleep(1); \
    if ((++_sp & 255u) == 0u) { if (xb_ld(&(bar)[XB_TMO])) break; if (_sp > XB_SPIN_CAP) { atomicAdd(&(bar)[XB_TMO], 1u); break; } } } } while (0)
struct XcdBarrier {
  unsigned* bar;
  unsigned x;
  volatile LAS unsigned* st;
};
DI XcdBarrier xcd_barrier_post(unsigned* bar, volatile LAS unsigned* st) {
  XcdBarrier b;
  b.bar = bar;
  b.x = xb_xcc_id();
  b.st = st;
  if (threadIdx.x == 0) (void)xb_add(&bar[XB_XCNT(b.x)], 1u);
  return b;
}
DI void xcd_barrier_complete(unsigned* bar, unsigned x, unsigned& nloc, unsigned& nx) {
  const unsigned G = gridDim.x * gridDim.y * gridDim.z;
  unsigned sum, cnt, mine, sp = 0u;
  for (;;) {
    sum = 0u; cnt = 0u; mine = 0u;
#pragma unroll
    for (unsigned j = 0; j < 16; ++j) {
      const unsigned c = xb_ld(&bar[XB_XCNT(j)]);
      sum += c;
      cnt += (c > 0u) ? 1u : 0u;
      mine = (j == x) ? c : mine;
    }
    if (sum == G) break;
    __builtin_amdgcn_s_sleep(1);
    if ((++sp & 255u) == 0u) { if (xb_ld(&bar[XB_TMO])) break; if (sp > XB_SPIN_CAP) { atomicAdd(&bar[XB_TMO], 1u); break; } }
  }
  nloc = mine > 0u ? mine : 1u;
  nx = cnt > 0u ? cnt : 1u;
}
DI void xcd_barrier(const XcdBarrier& b0) {
  asm volatile("s_waitcnt vmcnt(0)" ::: "memory");
  __syncthreads();
  if (threadIdx.x == 0) {
    XcdBarrier b = b0;
    b.x = __builtin_amdgcn_readfirstlane(xb_xcc_id());
    unsigned* bar = b.bar;
    asm volatile("" : "+s"(bar));
    __builtin_amdgcn_s_waitcnt(0);
    unsigned nloc = b.st[0], nx = b.st[1];
    if (nloc == 0u) { xcd_barrier_complete(bar, b.x, nloc, nx); b.st[0] = nloc; b.st[1] = nx; }
    const unsigned old = xb_add(&bar[XB_XSUB(b.x)], 1u);
    const unsigned gen = old / nloc;
    if (old + 1u == (gen + 1u) * nloc) {
      __builtin_amdgcn_fence(__ATOMIC_RELEASE, "agent");
      asm volatile("s_waitcnt vmcnt(0)" ::: "memory");
      const unsigned og = xb_add(&bar[XB_TOP], 1u);
      const unsigned tg = og / nx;
      if (og + 1u == (tg + 1u) * nx) xb_add(&bar[XB_TOPGEN], 1u);
      else XB_SPIN(xb_ld(&bar[XB_TOPGEN]) == tg, bar);
      __builtin_amdgcn_fence(__ATOMIC_ACQUIRE, "agent");
      xb_add(&bar[XB_XGEN(b.x)], 1u);
      asm volatile("s_waitcnt vmcnt(0)" ::: "memory");
    } else {
      XB_SPIN(xb_ld(&bar[XB_XGEN(b.x)]) == gen, bar);
      __builtin_amdgcn_fence(__ATOMIC_ACQUIRE, "agent");
      asm volatile("s_waitcnt vmcnt(0)" ::: "memory");
    }
  }
  __syncthreads();
}

#define DECL_WS_PTRS(ws) \
  u16* w_ain = (u16*)(ws + W_AIN); \
  u16* w_uk = (u16*)(ws + W_UK); \
  u16* w_uv = (u16*)(ws + W_UV); \
  u16* w_ao = (u16*)(ws + W_AO); \
  u16* w_bin = (u16*)(ws + W_BIN); \
  u16* w_bo = (u16*)(ws + W_BO); \
  u16* w_w1 = (u16*)(ws + W_W1); \
  u16* w_w2 = (u16*)(ws + W_W2); \
  float* mod = (float*)(ws + WS_MOD); \
  u16* hbuf = (u16*)(ws + WS_H); \
  char* big = ws + WS_BIG; \
  u16* qbuf = (u16*)(big + B_Q); \
  u16* iqbuf = (u16*)(big + B_IQ); \
  u16* ikbuf = (u16*)(big + B_IK); \
  float* iwbuf = (float*)(big + B_IW); \
  float* ckvraw = (float*)(big + B_CKVRAW); \
  u16* ckvn = (u16*)(big + B_CKVN); \
  u16* selbuf = (u16*)(big + B_SEL); \
  u16* kbuf = (u16*)(big + B_K); \
  u16* vtbuf = (u16*)(big + B_VT); \
  u16* obuf = (u16*)(big + B_O); \
  u16* hid = (u16*)big;

__global__ void __launch_bounds__(512, 2) hybrid_fwd(Params p) {
  __shared__ __attribute__((aligned(16))) char smem[2 * LDS_BYTES];
  cg::grid_group grid = cg::this_grid();
  const int bid = blockIdx.x, nb = gridDim.x;
  const int half = __builtin_amdgcn_readfirstlane((int)(threadIdx.x >> 8));
  const int vb = half * nb + bid, nvb = 2 * nb;
  char* smh = smem + half * LDS_BYTES;
  char* ws = p.ws;
  unsigned* bar = (unsigned*)(ws + WS_BAR);
  volatile LAS unsigned* xst = (volatile LAS unsigned*)(smem + 2 * LDS_BYTES - 16);
  if (threadIdx.x < 2) xst[threadIdx.x] = 0u;
  __syncthreads();
  const XcdBarrier xb = xcd_barrier_post(bar, xst);

  {
  DECL_WS_PTRS(ws)
  (void)qbuf; (void)iqbuf; (void)ikbuf; (void)iwbuf; (void)ckvraw; (void)ckvn; (void)selbuf; (void)kbuf; (void)vtbuf; (void)obuf; (void)hid;
  tconv_phase(p.a_w_in, w_ain, 2, 1024, 1864, A_INP, smh, vb, nvb);
  tconv_phase(p.a_w_uk, w_uk, 32, 64, 256, 256, smh, vb, nvb);
  tconv_phase(p.a_w_uv, w_uv, 32, 256, 64, 64, smh, vb, nvb);
  tconv_phase(p.a_w_o, w_ao, 2, 1024, 1024, 1024, smh, vb, nvb);
  tconv_phase(p.b_w_in, w_bin, 2, 1024, 3072, 3072, smh, vb, nvb);
  tconv_phase(p.b_w_o, w_bo, 2, 1024, 1024, 1024, smh, vb, nvb);
  tconv_phase(p.mlp_w1, w_w1, 4, 1024, 4096, 4096, smh, vb, nvb);
  tconv_phase(p.mlp_w2, w_w2, 4, 4096, 1024, 1024, smh, vb, nvb);
  mod_phase(p, mod, smh, vb, nvb);
  grid.sync();
  h0_phase(p.x, mod, hbuf, vb, nvb);
  xcd_barrier(xb);
  }

#pragma unroll 1
  for (int sl = 0; sl < 8; sl++) {
    char* wsl = p.ws;
    asm volatile("" : "+s"(wsl));
    DECL_WS_PTRS(wsl)
    const int i = sl >> 1, j = i >> 1;
    const float* modi = mod + (size_t)i * 4 * 6144;
    const u16* Ares;
    const u16* Wres;
    int Kres, goff;
    if ((sl & 1) == 0) {
      if ((i & 1) == 0) {
        EpiArgs ea{};
        ea.o0 = qbuf; ea.f0 = ckvraw; ea.o1 = iqbuf; ea.o2 = ikbuf; ea.f1 = iwbuf;
        for (int rep = 0; rep < (PROBE_DUP == 4 ? 2 : 1); rep++) gemm8p_phase<EPI_AIN>(hbuf, w_ain + (size_t)j * A_INP * 1024, T, A_INP, 1024, ea, smem, bid, nb);
        xcd_barrier(xb);
        ckvnorm_phase(ckvraw, p.a_kv_norm + j * 256, ckvn, vb, nvb);
        for (int rep = 0; rep < (PROBE_DUP == 2 ? 2 : 1); rep++) indexer_phase(iqbuf, ikbuf, iwbuf, selbuf, smh, vb, nvb);
        xcd_barrier(xb);
        for (int rep = 0; rep < (PROBE_DUP == 3 ? 2 : 1); rep++) sparse_phase(qbuf, ckvn, selbuf, w_uk + (size_t)j * 16 * 256 * 64, w_uv + (size_t)j * 16 * 256 * 64, p.rel_bias,
                     hbuf, obuf, smh, vb, nvb);
        xcd_barrier(xb);
        Wres = w_ao + (size_t)j * 1024 * 1024;
      } else {
        EpiArgs ea{};
        ea.o0 = qbuf; ea.o1 = kbuf; ea.o2 = vtbuf;
        for (int rep = 0; rep < (PROBE_DUP == 4 ? 2 : 1); rep++) gemm8p_phase<EPI_BIN>(hbuf, w_bin + (size_t)j * 3072 * 1024, T, 3072, 1024, ea, smem, bid, nb);
        xcd_barrier(xb);
        for (int rep = 0; rep < (PROBE_DUP == 1 ? 2 : 1); rep++) diffattn_phase(qbuf, kbuf, vtbuf, obuf, p.rel_bias, p.b_lambda + j * 256, p.b_subln + j * 128, i, smem, bid, nb);
        xcd_barrier(xb);
        Wres = w_bo + (size_t)j * 1024 * 1024;
      }
      Ares = obuf; Kres = 1024; goff = 2 * 1024;
    } else {
      EpiArgs ea{};
      ea.o0 = hid;
      for (int rep = 0; rep < (PROBE_DUP == 4 ? 2 : 1); rep++) gemm8p_phase<EPI_SQRELU>(hbuf, w_w1 + (size_t)i * 4096 * 1024, T, 4096, 1024, ea, smem, bid, nb);
      xcd_barrier(xb);
      Ares = hid; Wres = w_w2 + (size_t)i * 4096 * 1024; Kres = 4096; goff = 5 * 1024;
    }
    {
      EpiArgs ea{};
      ea.f0 = p.out;
      ea.xin = (sl == 0) ? p.x : (const float*)p.out;
      ea.g = modi + goff;
      gemm8p_phase<EPI_RES>(Ares, Wres, T, 1024, Kres, ea, smem, bid, nb);
    }
    xcd_barrier(xb);
    {
      const float* modn = ((sl & 1) == 0) ? modi : (i < 3 ? modi + 4 * 6144 : (const float*)nullptr);
      const int sh_off = ((sl & 1) == 0) ? 3 * 1024 : 0;
      ln_phase(p.out, p.ln_g + (size_t)(i * 2 + (sl & 1)) * 1024, p.ln_b + (size_t)(i * 2 + (sl & 1)) * 1024, modn, sh_off,
               hbuf, vb, nvb);
    }
    xcd_barrier(xb);
  }
}

extern "C" void kernel_launch(void* const* d_in, const int* in_sizes, int n_in, void* d_out, int out_size, void* d_ws,
                              size_t ws_size, hipStream_t stream) {
  static int grid_blocks = 0;
  if (!grid_blocks) {
    int dev = 0, cus = 0, per_cu = 0;
    hipGetDevice(&dev);
    hipDeviceGetAttribute(&cus, hipDeviceAttributeMultiprocessorCount, dev);
    hipOccupancyMaxActiveBlocksPerMultiprocessor(&per_cu, hybrid_fwd, 512, 0);
    (void)per_cu;
    grid_blocks = cus;
    if (grid_blocks > 256) grid_blocks = 256;
  }
  Params p{};
  p.x = (const float*)d_in[0];
  p.c = (const float*)d_in[1];
  p.rel_bias = (const float*)d_in[2];
  p.ada_w = (const float*)d_in[3];
  p.ada_b = (const float*)d_in[4];
  p.ln_g = (const float*)d_in[5];
  p.ln_b = (const float*)d_in[6];
  p.a_w_in = (const float*)d_in[7];
  p.a_kv_norm = (const float*)d_in[8];
  p.a_w_uk = (const float*)d_in[9];
  p.a_w_uv = (const float*)d_in[10];
  p.a_w_o = (const float*)d_in[11];
  p.b_w_in = (const float*)d_in[12];
  p.b_lambda = (const float*)d_in[13];
  p.b_subln = (const float*)d_in[14];
  p.b_w_o = (const float*)d_in[15];
  p.mlp_w1 = (const float*)d_in[16];
  p.mlp_w2 = (const float*)d_in[17];
  p.out = (float*)d_out;
  p.ws = (char*)d_ws;
  hipMemsetAsync((char*)d_ws + WS_BAR, 0, XCD_BAR_WORDS * 4, stream);
  void* args[] = {&p};
  hipError_t e = hipLaunchCooperativeKernel((void*)hybrid_fwd, dim3(grid_blocks), dim3(512), args, 0, stream);
  if (e != hipSuccess) fprintf(stderr, "cooperative launch failed: %s (grid %d)\n", hipGetErrorString(e), grid_blocks);
}
```

```cpp
#include <hip/hip_runtime.h>
#include <hip/hip_cooperative_groups.h>
#include <stdint.h>
#include <stdio.h>
namespace cg = cooperative_groups;

typedef unsigned short u16;
typedef short bf16x8 __attribute__((ext_vector_type(8)));
typedef short s16x4 __attribute__((ext_vector_type(4)));
typedef float f32x16 __attribute__((ext_vector_type(16)));
typedef float f32x4 __attribute__((ext_vector_type(4)));
typedef float f32x2 __attribute__((ext_vector_type(2)));
typedef __bf16 bf16x2_t __attribute__((ext_vector_type(2)));
typedef unsigned u32x4 __attribute__((ext_vector_type(4)));
typedef unsigned u32x2 __attribute__((ext_vector_type(2)));
typedef __attribute__((address_space(3))) s16x4* lds_s16x4_ptr;

#define DI __device__ __forceinline__
#ifndef PROBE_DUP
#define PROBE_DUP 0
#endif

constexpr int D = 1024, NBATCH = 4, S = 8192, T = NBATCH * S;
constexpr int A_INP = 2048;
constexpr float DN_ALPHA = 1.6817928305074292f;
constexpr float LOG2E = 1.4426950408889634f;
constexpr float LN_EPS = 1e-5f;
constexpr float NEGF = -1e30f;
constexpr int TOPK = 256;
constexpr int CAP = 704;
constexpr int LDS_BYTES = 72 * 1024;

constexpr size_t MB = 1024 * 1024;
constexpr size_t W_AIN = 0;
constexpr size_t W_UK = W_AIN + (size_t)2 * 2048 * 1024 * 2;
constexpr size_t W_UV = W_UK + (size_t)2 * 16 * 256 * 64 * 2;
constexpr size_t W_AO = W_UV + (size_t)2 * 16 * 256 * 64 * 2;
constexpr size_t W_BIN = W_AO + (size_t)2 * 1024 * 1024 * 2;
constexpr size_t W_BO = W_BIN + (size_t)2 * 3072 * 1024 * 2;
constexpr size_t W_W1 = W_BO + (size_t)2 * 1024 * 1024 * 2;
constexpr size_t W_W2 = W_W1 + (size_t)4 * 4096 * 1024 * 2;
constexpr size_t WS_MOD = W_W2 + (size_t)4 * 4096 * 1024 * 2;
constexpr size_t WS_H = WS_MOD + 1 * MB;
constexpr size_t WS_BIG = WS_H + 64 * MB;
constexpr size_t WS_BAR = WS_BIG + 256 * MB;
constexpr size_t B_Q = 0;
constexpr size_t B_IQ = 64 * MB;
constexpr size_t B_IK = 96 * MB;
constexpr size_t B_IW = 100 * MB;
constexpr size_t B_CKVRAW = 104 * MB;
constexpr size_t B_CKVN = 136 * MB;
constexpr size_t B_SEL = 152 * MB;
constexpr size_t B_K = 64 * MB;
constexpr size_t B_VT = 128 * MB;
constexpr size_t B_O = 192 * MB;

struct Params {
  const float *x, *c, *rel_bias, *ada_w, *ada_b, *ln_g, *ln_b, *a_w_in, *a_kv_norm, *a_w_uk, *a_w_uv, *a_w_o, *b_w_in,
      *b_lambda, *b_subln, *b_w_o, *mlp_w1, *mlp_w2;
  float* out;
  char* ws;
};

DI int opq_tid() {
  int t = threadIdx.x & 255;
  asm volatile("" : "+v"(t));
  return t;
}
DI int opq_tid8() {
  int t = threadIdx.x;
  asm volatile("" : "+v"(t));
  return t;
}
DI unsigned pk2(float lo, float hi) {
  f32x2 v = {lo, hi};
  bf16x2_t b = __builtin_convertvector(v, bf16x2_t);
  return __builtin_bit_cast(unsigned, b);
}
DI u16 f2bf(float x) { return (u16)(pk2(x, 0.f) & 0xffffu); }
DI float wave_sum(float v) {
#pragma unroll
  for (int o = 32; o >= 1; o >>= 1) v += __shfl_xor(v, o);
  return v;
}
DI f32x16 mfma32(bf16x8 a, bf16x8 b, f32x16 c) { return __builtin_amdgcn_mfma_f32_32x32x16_bf16(a, b, c, 0, 0, 0); }
DI f32x4 mfma16(bf16x8 a, bf16x8 b, f32x4 c) { return __builtin_amdgcn_mfma_f32_16x16x32_bf16(a, b, c, 0, 0, 0); }
DI int pi_row(int r) { return (r & ~12) | ((r & 4) << 1) | ((r & 8) >> 1); }

DI int rel_bucket(int n) {
  if (n < 16) return n;
  float nf = (float)n;
  int large = 16 + (int)(logf(nf / 16.f) / 2.0794415416798357f * 16.f);
  return large < 31 ? large : 31;
}

DI void tconv_phase(const float* __restrict__ src, u16* __restrict__ dst, int batch, int R, int C, int Cpad, char* smem,
                    int bid, int nb) {
  float* tile = (float*)smem;
  const int tid = opq_tid();
  const int tr = R / 64, tc = Cpad / 64;
  const int ntiles = batch * tr * tc;
  for (int it0 = 0; it0 < ntiles; it0 += nb) {
    const int it = (it0 + bid < ntiles) ? it0 + bid : ntiles - 1;
    const int bi = it / (tr * tc);
    const int rem = it - bi * (tr * tc);
    const int ri = rem / tc, ci = rem - ri * tc;
    const float* s = src + (size_t)bi * R * C;
    u16* d = dst + (size_t)bi * Cpad * R;
    __syncthreads();
#pragma unroll
    for (int k = 0; k < 4; k++) {
      const int r = (tid >> 4) + 16 * k;
      const int cl = (tid & 15) * 4;
      const int cc = ci * 64 + cl;
      f32x4 v = {0.f, 0.f, 0.f, 0.f};
      if (cc < C) v = *(const f32x4*)(s + (size_t)(ri * 64 + r) * C + cc);
      tile[r * 65 + cl + 0] = v[0];
      tile[r * 65 + cl + 1] = v[1];
      tile[r * 65 + cl + 2] = v[2];
      tile[r * 65 + cl + 3] = v[3];
    }
    __syncthreads();
#pragma unroll
    for (int k = 0; k < 2; k++) {
      const int cl = (tid >> 3) + 32 * k;
      const int r8 = (tid & 7) * 8;
      u32x4 o;
      o[0] = pk2(tile[(r8 + 0) * 65 + cl], tile[(r8 + 1) * 65 + cl]);
      o[1] = pk2(tile[(r8 + 2) * 65 + cl], tile[(r8 + 3) * 65 + cl]);
      o[2] = pk2(tile[(r8 + 4) * 65 + cl], tile[(r8 + 5) * 65 + cl]);
      o[3] = pk2(tile[(r8 + 6) * 65 + cl], tile[(r8 + 7) * 65 + cl]);
      *(u32x4*)(d + (size_t)(ci * 64 + cl) * R + ri * 64 + r8) = o;
    }
  }
}

DI void mod_phase(const Params& p, float* mod, char* smem, int bid, int nb) {
  float* sc = (float*)smem;
  float* red = sc + 4096;
  const int tid = opq_tid(), lane = tid & 63, w = __builtin_amdgcn_readfirstlane(tid >> 6);
  __syncthreads();
  for (int i = tid; i < 4096; i += 256) {
    float v = p.c[i];
    sc[i] = v / (1.f + expf(-v));
  }
  __syncthreads();
  for (int it = bid; it < 4 * 384; it += nb) {
    const int l = it / 384, e0 = (it - l * 384) * 16;
    const int ds = lane >> 4, ec = lane & 15;
    const float* wp = p.ada_w + ((size_t)l * 1024 + w * 256 + ds) * 6144 + e0 + ec;
    float a0 = 0, a1 = 0, a2 = 0, a3 = 0;
#pragma unroll 16
    for (int d = 0; d < 64; d++) {
      float wv = wp[(size_t)(4 * d) * 6144];
      int dd = w * 256 + 4 * d + ds;
      a0 += sc[dd] * wv;
      a1 += sc[1024 + dd] * wv;
      a2 += sc[2048 + dd] * wv;
      a3 += sc[3072 + dd] * wv;
    }
    a0 += __shfl_xor(a0, 16); a0 += __shfl_xor(a0, 32);
    a1 += __shfl_xor(a1, 16); a1 += __shfl_xor(a1, 32);
    a2 += __shfl_xor(a2, 16); a2 += __shfl_xor(a2, 32);
    a3 += __shfl_xor(a3, 16); a3 += __shfl_xor(a3, 32);
    if (lane < 16) {
      red[(w * 4 + 0) * 16 + lane] = a0;
      red[(w * 4 + 1) * 16 + lane] = a1;
      red[(w * 4 + 2) * 16 + lane] = a2;
      red[(w * 4 + 3) * 16 + lane] = a3;
    }
    __syncthreads();
    if (tid < 64) {
      const int b = tid >> 4, e = tid & 15;
      float sm = red[(0 * 4 + b) * 16 + e] + red[(1 * 4 + b) * 16 + e] + red[(2 * 4 + b) * 16 + e] + red[(3 * 4 + b) * 16 + e] +
                 p.ada_b[l * 6144 + e0 + e];
      mod[((size_t)l * 4 + b) * 6144 + e0 + e] = sm;
    }
    __syncthreads();
  }
}

DI void h0_phase(const float* __restrict__ x, const float* __restrict__ mod0, u16* __restrict__ h, int bid, int nb) {
  const size_t n8 = (size_t)T * 1024 / 8;
  for (size_t i = (size_t)bid * 256 + opq_tid(); i < n8; i += (size_t)nb * 256) {
    const size_t e = i * 8;
    const int t = (int)(e >> 10), d = (int)(e & 1023), b = t >> 13;
    const float* m = mod0 + (size_t)b * 6144;
    f32x4 v0 = *(const f32x4*)(x + e), v1 = *(const f32x4*)(x + e + 4);
    f32x4 sh0 = *(const f32x4*)(m + d), sh1 = *(const f32x4*)(m + d + 4);
    f32x4 sc0 = *(const f32x4*)(m + 1024 + d), sc1 = *(const f32x4*)(m + 1024 + d + 4);
    v0 = v0 * (1.f + sc0) + sh0;
    v1 = v1 * (1.f + sc1) + sh1;
    u32x4 o;
    o[0] = pk2(v0[0], v0[1]);
    o[1] = pk2(v0[2], v0[3]);
    o[2] = pk2(v1[0], v1[1]);
    o[3] = pk2(v1[2], v1[3]);
    *(u32x4*)(h + e) = o;
  }
}

DI void ln_phase(float* z, const float* __restrict__ g, const float* __restrict__ bt, const float* modn, int sh_off,
                 u16* __restrict__ h, int bid, int nb) {
  const int tid = opq_tid(), lane = tid & 63, w = __builtin_amdgcn_readfirstlane(tid >> 6);
  for (int row = bid * 4 + w; row < T; row += nb * 4) {
    f32x4* zp = (f32x4*)(z + (size_t)row * 1024);
    f32x4 v[4];
#pragma unroll
    for (int c = 0; c < 4; c++) v[c] = zp[c * 64 + lane];
    float s = 0;
#pragma unroll
    for (int c = 0; c < 4; c++) s += v[c][0] + v[c][1] + v[c][2] + v[c][3];
    const float mu = wave_sum(s) * (1.f / 1024.f);
    float q = 0;
#pragma unroll
    for (int c = 0; c < 4; c++) {
      v[c] = v[c] - mu;
      q += v[c][0] * v[c][0] + v[c][1] * v[c][1] + v[c][2] * v[c][2] + v[c][3] * v[c][3];
    }
    const float rstd = rsqrtf(wave_sum(q) * (1.f / 1024.f) + LN_EPS);
    const int b = row >> 13;
#pragma unroll
    for (int c = 0; c < 4; c++) {
      const int d = c * 256 + lane * 4;
      f32x4 y = v[c] * rstd * *(const f32x4*)(g + d) + *(const f32x4*)(bt + d);
      zp[c * 64 + lane] = y;
      if (modn) {
        const float* m = modn + (size_t)b * 6144 + sh_off;
        f32x4 hv = y * (1.f + *(const f32x4*)(m + 1024 + d)) + *(const f32x4*)(m + d);
        u32x2 o;
        o[0] = pk2(hv[0], hv[1]);
        o[1] = pk2(hv[2], hv[3]);
        *(u32x2*)(h + (size_t)row * 1024 + d) = o;
      }
    }
  }
}

enum { EPI_AIN = 0, EPI_BIN = 1, EPI_RES = 2, EPI_SQRELU = 3 };
struct EpiArgs {
  u16 *o0, *o1, *o2;
  float *f0, *f1;
  const float* xin;
  const float* g;
};

template <int EPI>
DI void epi_store4(const EpiArgs& ea, int row, int col, const float* v, int bidx) {
  if (EPI == EPI_AIN) {
    if (col < 1024) {
      u32x2 o;
      o[0] = pk2(v[0], v[1]);
      o[1] = pk2(v[2], v[3]);
      *(u32x2*)(ea.o0 + (size_t)row * 1024 + col) = o;
    } else if (col < 1280) {
      *(f32x4*)(ea.f0 + (size_t)row * 256 + (col - 1024)) = (f32x4){v[0], v[1], v[2], v[3]};
    } else if (col < 1792) {
      u32x2 o;
      o[0] = pk2(v[0], v[1]);
      o[1] = pk2(v[2], v[3]);
      *(u32x2*)(ea.o1 + (size_t)row * 512 + (col - 1280)) = o;
    } else if (col < 1856) {
      const int d = col - 1792;
      const int sidx = row & 8191;
      const size_t off = (size_t)(row >> 13) * S * 64 +
                         ((size_t)((sidx >> 5) * 4 + (d >> 4)) * 64 + 32 * ((d >> 3) & 1) + (sidx & 31)) * 8 + (d & 7);
      u32x2 o;
      o[0] = pk2(v[0], v[1]);
      o[1] = pk2(v[2], v[3]);
      *(u32x2*)(ea.o2 + off) = o;
    } else if (col < 1864) {
      const float sc = 0.044194173824159216f;
      *(f32x4*)(ea.f1 + (size_t)row * 8 + (col - 1856)) = (f32x4){v[0] * sc, v[1] * sc, v[2] * sc, v[3] * sc};
    }
  } else if (EPI == EPI_BIN) {
    if (col < 1024) {
      const float sc = 0.125f * LOG2E;
      u32x2 o;
      o[0] = pk2(v[0] * sc, v[1] * sc);
      o[1] = pk2(v[2] * sc, v[3] * sc);
      *(u32x2*)(ea.o0 + (size_t)row * 1024 + col) = o;
    } else if (col < 2048) {
      u32x2 o;
      o[0] = pk2(v[0], v[1]);
      o[1] = pk2(v[2], v[3]);
      *(u32x2*)(ea.o1 + (size_t)row * 1024 + (col - 1024)) = o;
    } else {
      const int cv = col - 2048;
#pragma unroll
      for (int q = 0; q < 4; q++) ea.o2[((size_t)bidx * 1024 + cv + q) * 8192 + (row & 8191)] = f2bf(v[q]);
    }
  } else if (EPI == EPI_RES) {
    const f32x4 gg = *(const f32x4*)(ea.g + (size_t)bidx * 6144 + col);
    const size_t o = (size_t)row * 1024 + col;
    const f32x4 xv = *(const f32x4*)(ea.xin + o);
    f32x4 r;
#pragma unroll
    for (int q = 0; q < 4; q++) r[q] = DN_ALPHA * xv[q] + (1.f + gg[q]) * v[q];
    *(f32x4*)(ea.f0 + o) = r;
  } else {
    float r[4];
#pragma unroll
    for (int q = 0; q < 4; q++) {
      r[q] = v[q] > 0.f ? v[q] : 0.f;
      r[q] = r[q] * r[q];
    }
    u32x2 o;
    o[0] = pk2(r[0], r[1]);
    o[1] = pk2(r[2], r[3]);
    *(u32x2*)(ea.o0 + (size_t)row * 4096 + col) = o;
  }
}

template <int EPI>
DI void gemm_phase(const u16* __restrict__ A, const u16* __restrict__ Bt, int M, int N, int K, const EpiArgs& ea,
                   char* smem, int bid, int nb) {
  constexpr int MI = 4, BM = 64 * MI, BN = 256;
  u16* As = (u16*)smem;
  u16* Bs = As + BM * 72;
  const int tid = opq_tid8(), lane = tid & 63, w = __builtin_amdgcn_readfirstlane(tid >> 6), wm = w >> 2, wn = w & 3, l31 = lane & 31, lh = lane >> 5;
  const int ntn = N / BN, ntm = M / BM, nt = ntn * ntm, nk = K / 64;
  const int lr = tid >> 3, lc = (tid & 7) * 8;
  const int xcd = bid & 7, nbx = nb >> 3, cntx = (ntm >> 3) * ntn;
  (void)nt;
  for (int sq = bid >> 3; sq < cntx; sq += nbx) {
    const int tmx = sq / ntn, tn = sq - tmx * ntn;
    const int tm = tmx * 8 + xcd;
    const int m0 = tm * BM, n0 = tn * BN;
    f32x16 acc[MI][2];
#pragma unroll
    for (int i = 0; i < MI; i++)
#pragma unroll
      for (int j = 0; j < 2; j++)
#pragma unroll
        for (int r = 0; r < 16; r++) acc[i][j][r] = 0.f;
    u32x4 ra[4], rb[4];
    const u16* ap = A + (size_t)(m0 + lr) * K + lc;
    const u16* bp = Bt + (size_t)(n0 + lr) * K + lc;
#pragma unroll
    for (int i = 0; i < 4; i++) ra[i] = *(const u32x4*)(ap + (size_t)i * 64 * K);
#pragma unroll
    for (int i = 0; i < 4; i++) rb[i] = *(const u32x4*)(bp + (size_t)i * 64 * K);
    __syncthreads();
#pragma unroll
    for (int i = 0; i < 4; i++) *(u32x4*)&As[(lr + 64 * i) * 72 + lc] = ra[i];
#pragma unroll
    for (int i = 0; i < 4; i++) *(u32x4*)&Bs[(lr + 64 * i) * 72 + lc] = rb[i];
    __syncthreads();
    for (int kt = 0; kt < nk; kt++) {
      if (kt + 1 < nk) {
#pragma unroll
        for (int i = 0; i < 4; i++) ra[i] = *(const u32x4*)(ap + (size_t)i * 64 * K + (kt + 1) * 64);
#pragma unroll
        for (int i = 0; i < 4; i++) rb[i] = *(const u32x4*)(bp + (size_t)i * 64 * K + (kt + 1) * 64);
      }
#pragma unroll
      for (int ks = 0; ks < 4; ks++) {
        bf16x8 af[MI], b0, b1;
#pragma unroll
        for (int i = 0; i < MI; i++) af[i] = *(const bf16x8*)&As[(wm * 32 * MI + 32 * i + l31) * 72 + ks * 16 + lh * 8];
        b0 = *(const bf16x8*)&Bs[(wn * 64 + l31) * 72 + ks * 16 + lh * 8];
        b1 = *(const bf16x8*)&Bs[(wn * 64 + 32 + l31) * 72 + ks * 16 + lh * 8];
#pragma unroll
        for (int i = 0; i < MI; i++) {
          acc[i][0] = mfma32(b0, af[i], acc[i][0]);
          acc[i][1] = mfma32(b1, af[i], acc[i][1]);
        }
      }
      __syncthreads();
      if (kt + 1 < nk) {
#pragma unroll
        for (int i = 0; i < 4; i++) *(u32x4*)&As[(lr + 64 * i) * 72 + lc] = ra[i];
#pragma unroll
        for (int i = 0; i < 4; i++) *(u32x4*)&Bs[(lr + 64 * i) * 72 + lc] = rb[i];
        __syncthreads();
      }
    }
    const int bidx = m0 >> 13;
#pragma unroll
    for (int i = 0; i < MI; i++) {
      const int row = m0 + wm * 32 * MI + 32 * i + l31;
#pragma unroll
      for (int j = 0; j < 2; j++) {
#pragma unroll
        for (int r4 = 0; r4 < 4; r4++) {
          const int col = n0 + wn * 64 + 32 * j + 8 * r4 + 4 * lh;
          float v[4];
#pragma unroll
          for (int q = 0; q < 4; q++) v[q] = acc[i][j][4 * r4 + q];
          epi_store4<EPI>(ea, row, col, v, bidx);
        }
      }
    }
  }
}

DI int g8_lds_byte(int r, int c) {
  int st = (r >> 4) * 2 + (c >> 5), rr = r & 15, cc = c & 31, ob = rr * 64 + cc * 2;
  return st * 1024 + (ob ^ (((ob >> 9) & 1) << 5));
}
DI void g8_stage_rc(int b, int& R, int& C) {
  int st = b / 1024, sb = b % 1024, swz = sb ^ (((sb >> 9) & 1) << 5);
  R = (st >> 1) * 16 + swz / 64;
  C = (st & 1) * 32 + (swz % 64) / 2;
}
typedef __attribute__((address_space(3))) unsigned* lds_u32_ptr;

template <int EPI>
DI void gemm8p_phase(const u16* __restrict__ A, const u16* __restrict__ Bt, int M, int N, int K, const EpiArgs& ea,
                     char* smem, int bid, int nb) {
  constexpr int BK = 64, HALF = 128, HT = HALF * BK;
  u16* shm = (u16*)smem;
  const int tid = opq_tid8(), lane = tid & 63, wid = __builtin_amdgcn_readfirstlane(tid >> 6);
  const int wr = wid >> 2, wc = wid & 3, fr = lane & 15, fq = lane >> 4;
#define G8_SA(b, h) (shm + ((b) * 2 + (h)) * HT)
#define G8_SB(b, h) (shm + (4 + (b) * 2 + (h)) * HT)
  int g8o0, g8o1;
  {
    int r_, c_;
    g8_stage_rc(tid * 16, r_, c_);
    g8o0 = r_ * K + c_;
    g8_stage_rc(tid * 16 + 8192, r_, c_);
    g8o1 = r_ * K + c_;
  }
#define G8_STAGE(P, BASE, br, kt)                                                                                   \
  do {                                                                                                               \
    const u16* _gp = BASE + (size_t)(br) * K + (size_t)(kt) * BK;                                                    \
    asm volatile("" : "+s"(_gp));                \
    __builtin_amdgcn_global_load_lds((const unsigned*)(_gp + (unsigned)g8o0), (lds_u32_ptr)((char*)(P) + tid * 16), 16, 0, 0);        \
    __builtin_amdgcn_global_load_lds((const unsigned*)(_gp + (unsigned)g8o1), (lds_u32_ptr)((char*)(P) + tid * 16 + 8192), 16, 0, 0); \
  } while (0)
  const int g8lane = (fr * 64 + fq * 16) ^ ((fr & 8) << 2);
  const char* g8a = smem + g8lane + wr * 8192;
  const char* g8b = smem + 4 * HT * 2 + g8lane + wc * 4096;
#define G8_LDA(dst, b, h)                                                                                            \
  _Pragma("unroll") for (int m = 0; m < 4; ++m) _Pragma("unroll") for (int k = 0; k < 2; ++k)                        \
      dst[m][k] = *reinterpret_cast<const bf16x8*>(g8a + ((b) * 2 + (h)) * (HT * 2) + m * 2048 + k * 1024)
#define G8_LDB(dst, b, h)                                                                                            \
  _Pragma("unroll") for (int n = 0; n < 2; ++n) _Pragma("unroll") for (int k = 0; k < 2; ++k)                        \
      dst[n][k] = *reinterpret_cast<const bf16x8*>(g8b + ((b) * 2 + (h)) * (HT * 2) + n * 2048 + k * 1024)
#define G8_MMA(ai, bj, At_, Bt_)                                                                                     \
  do {                                                                                                               \
    __builtin_amdgcn_s_setprio(1);                                                                                   \
    _Pragma("unroll") for (int m = 0; m < 4; ++m) _Pragma("unroll") for (int n = 0; n < 2; ++n)                      \
        _Pragma("unroll") for (int k = 0; k < 2; ++k)                                                                \
            acc[ai][bj][m][n] = mfma16(Bt_[n][k], At_[m][k], acc[ai][bj][m][n]);                                     \
    __builtin_amdgcn_s_setprio(0);                                                                                   \
  } while (0)
#define G8_WAIT_V(n) asm volatile("s_waitcnt vmcnt(" #n ")" ::: "memory")
#define G8_WAIT_L(n) asm volatile("s_waitcnt lgkmcnt(" #n ")" ::: "memory")
#define G8_BAR __builtin_amdgcn_s_barrier()
#define G8_SCHED __builtin_amdgcn_sched_barrier(0)
  const int ntn = N / 256, ntm = M / 256, nt = K / BK;
  const int xcd = bid & 7, nbx = nb >> 3, cntx = (ntm >> 3) * ntn;
  for (int sq = bid >> 3; sq < cntx; sq += nbx) {
    const int tmx = sq / ntn, tn = sq - tmx * ntn;
    const int tm = tmx * 8 + xcd;
    const int brow = tm * 256, bcol = tn * 256;
    f32x4 acc[2][2][4][2];
#pragma unroll
    for (int a_ = 0; a_ < 2; a_++)
#pragma unroll
      for (int b_ = 0; b_ < 2; b_++)
#pragma unroll
        for (int m = 0; m < 4; m++)
#pragma unroll
          for (int n = 0; n < 2; n++) acc[a_][b_][m][n] = (f32x4){0.f, 0.f, 0.f, 0.f};
    bf16x8 At[4][2], B0[2][2], B1[2][2];
    asm volatile("s_waitcnt vmcnt(0) lgkmcnt(0)" ::: "memory");
    __syncthreads();
    G8_STAGE(G8_SB(0, 0), Bt, bcol, 0); G8_STAGE(G8_SA(0, 0), A, brow, 0);
    G8_STAGE(G8_SB(0, 1), Bt, bcol + HALF, 0); G8_STAGE(G8_SA(0, 1), A, brow + HALF, 0);
    if (wr == 1) G8_BAR;
    G8_WAIT_V(4); G8_BAR;
    G8_STAGE(G8_SB(1, 0), Bt, bcol, 1); G8_STAGE(G8_SA(1, 0), A, brow, 1); G8_STAGE(G8_SB(1, 1), Bt, bcol + HALF, 1);
    G8_WAIT_V(6); G8_BAR;
    for (int t = 0; t < nt - 2; t += 2) {
      G8_LDB(B0, 0, 0); G8_SCHED; G8_LDA(At, 0, 0); G8_STAGE(G8_SA(1, 1), A, brow + HALF, t + 1);
      G8_WAIT_L(8); G8_BAR; G8_WAIT_L(0); G8_MMA(0, 0, At, B0); G8_BAR; G8_SCHED;
      G8_LDB(B1, 0, 1); G8_STAGE(G8_SB(0, 0), Bt, bcol, t + 2);
      G8_BAR; G8_WAIT_L(0); G8_MMA(0, 1, At, B1); G8_BAR;
      G8_LDA(At, 0, 1); G8_STAGE(G8_SA(0, 0), A, brow, t + 2);
      G8_BAR; G8_WAIT_L(0); G8_MMA(1, 0, At, B0); G8_BAR; G8_SCHED;
      G8_STAGE(G8_SB(0, 1), Bt, bcol + HALF, t + 2);
      G8_WAIT_V(6); G8_BAR; G8_MMA(1, 1, At, B1); G8_BAR;
      G8_LDB(B0, 1, 0); G8_SCHED; G8_LDA(At, 1, 0); G8_STAGE(G8_SA(0, 1), A, brow + HALF, t + 2);
      G8_WAIT_L(8); G8_BAR; G8_WAIT_L(0); G8_MMA(0, 0, At, B0); G8_BAR; G8_SCHED;
      G8_LDB(B1, 1, 1); G8_STAGE(G8_SB(1, 0), Bt, bcol, t + 3);
      G8_BAR; G8_WAIT_L(0); G8_MMA(0, 1, At, B1); G8_BAR;
      G8_LDA(At, 1, 1); G8_STAGE(G8_SA(1, 0), A, brow, t + 3);
      G8_BAR; G8_WAIT_L(0); G8_MMA(1, 0, At, B0); G8_BAR; G8_SCHED;
      G8_STAGE(G8_SB(1, 1), Bt, bcol + HALF, t + 3);
      G8_WAIT_V(6); G8_BAR; G8_MMA(1, 1, At, B1); G8_BAR;
    }
    {
      G8_LDB(B0, 0, 0); G8_LDA(At, 0, 0); G8_STAGE(G8_SA(1, 1), A, brow + HALF, nt - 1);
      G8_BAR; G8_WAIT_L(0); G8_MMA(0, 0, At, B0); G8_BAR;
      G8_LDB(B1, 0, 1); G8_BAR; G8_WAIT_L(0); G8_MMA(0, 1, At, B1); G8_BAR;
      G8_LDA(At, 0, 1); G8_WAIT_V(4); G8_BAR; G8_WAIT_L(0); G8_MMA(1, 0, At, B0); G8_MMA(1, 1, At, B1); G8_BAR;
    }
    {
      G8_LDB(B0, 1, 0); G8_LDA(At, 1, 0); G8_WAIT_V(2); G8_BAR; G8_WAIT_L(0); G8_MMA(0, 0, At, B0); G8_BAR;
      G8_LDB(B1, 1, 1); G8_WAIT_V(0); G8_BAR; G8_WAIT_L(0); G8_MMA(0, 1, At, B1); G8_BAR;
      G8_LDA(At, 1, 1); G8_BAR; G8_WAIT_L(0); G8_MMA(1, 0, At, B0); G8_MMA(1, 1, At, B1); G8_BAR;
    }
    if (wr == 0) G8_BAR;
    const int bidx = brow >> 13;
#pragma unroll
    for (int ai = 0; ai < 2; ai++)
#pragma unroll
      for (int m = 0; m < 4; m++) {
        const int row = brow + ai * HALF + wr * 64 + m * 16 + fr;
#pragma unroll
        for (int bj = 0; bj < 2; bj++)
#pragma unroll
          for (int n = 0; n < 2; n++) {
            const int col = bcol + bj * HALF + wc * 32 + n * 16 + fq * 4;
            float v[4];
#pragma unroll
            for (int q = 0; q < 4; q++) v[q] = acc[ai][bj][m][n][q];
            epi_store4<EPI>(ea, row, col, v, bidx);
          }
      }
  }
#undef G8_SA
#undef G8_SB
#undef G8_STAGE
#undef G8_LDA
#undef G8_LDB
#undef G8_MMA
#undef G8_WAIT_V
#undef G8_WAIT_L
#undef G8_BAR
#undef G8_SCHED
}

DI void ckvnorm_phase(const float* __restrict__ raw, const float* __restrict__ g, u16* __restrict__ outp, int bid,
                      int nb) {
  const int tid = opq_tid(), lane = tid & 63, w = __builtin_amdgcn_readfirstlane(tid >> 6);
  const f32x4 gg = *(const f32x4*)(g + lane * 4);
  for (int row = bid * 4 + w; row < T; row += nb * 4) {
    f32x4 v = *(const f32x4*)(raw + (size_t)row * 256 + lane * 4);
    float ss = v[0] * v[0] + v[1] * v[1] + v[2] * v[2] + v[3] * v[3];
    ss = wave_sum(ss);
    const float r = rsqrtf(ss * (1.f / 256.f) + LN_EPS);
    u32x2 o;
    o[0] = pk2(v[0] * r * gg[0], v[1] * r * gg[1]);
    o[1] = pk2(v[2] * r * gg[2], v[3] * r * gg[3]);
    *(u32x2*)(outp + (size_t)row * 256 + lane * 4) = o;
  }
}

DI unsigned mono_key(float s) {
  unsigned u = __float_as_uint(s);
  return (u & 0x80000000u) ? ~u : (u | 0x80000000u);
}
DI float mono_inv(unsigned k) {
  unsigned u = (k & 0x80000000u) ? (k & 0x7fffffffu) : ~k;
  return __uint_as_float(u);
}
DI float relu_i(float x) {
  int i = __float_as_int(x);
  return __int_as_float(i > 0 ? i : 0);
}
DI int wcount(bool f) { return __popcll(__ballot(f)); }

template <bool EXACT>
DI void compact4(float* vals, u16* idxs, int* cnt, int lane, float* thr_out) {
  constexpr int NPL = CAP / 64;
  unsigned key[4][NPL];
  int n[4];
#pragma unroll
  for (int q = 0; q < 4; q++) n[q] = cnt[q];
#pragma unroll
  for (int q = 0; q < 4; q++)
#pragma unroll
    for (int j = 0; j < NPL; j++) {
      const int e = j * 64 + lane;
      key[q][j] = (e < n[q]) ? mono_key(vals[q * CAP + e]) : 0u;
    }
  unsigned Tk[4] = {0u, 0u, 0u, 0u};
  constexpr int LOWBIT = EXACT ? 0 : 18;
#pragma unroll 1
  for (int bit = 31; bit >= LOWBIT; bit--) {
#pragma unroll
    for (int q = 0; q < 4; q++) {
      const unsigned cand = Tk[q] | (1u << bit);
      int c = 0;
#pragma unroll
      for (int j = 0; j < NPL; j++) c += wcount(key[q][j] >= cand);
      Tk[q] = (c >= TOPK) ? cand : Tk[q];
      if (q == 1) __builtin_amdgcn_sched_barrier(0);
    }
  }
  unsigned I[4] = {0xffffu, 0xffffu, 0xffffu, 0xffffu};
  if (EXACT) {
    unsigned ix[4][NPL];
    int need[4];
#pragma unroll
    for (int q = 0; q < 4; q++) {
      int cgt = 0;
#pragma unroll
      for (int j = 0; j < NPL; j++) {
        const int e = j * 64 + lane;
        ix[q][j] = (e < n[q]) ? (unsigned)idxs[q * CAP + e] : 0xffffu;
        cgt += wcount(key[q][j] > Tk[q]);
      }
      need[q] = TOPK - cgt;
      I[q] = 0u;
    }
#pragma unroll 1
    for (int bit = 13; bit >= 0; bit--) {
#pragma unroll
      for (int q = 0; q < 4; q++) {
        const unsigned cand = I[q] | (1u << bit);
        int c = 0;
#pragma unroll
        for (int j = 0; j < NPL; j++) c += wcount(key[q][j] == Tk[q] && ix[q][j] < cand);
        I[q] = (c < need[q]) ? cand : I[q];
        if (q == 1) __builtin_amdgcn_sched_barrier(0);
      }
    }
  }
  const unsigned long long lt = (1ull << lane) - 1ull;
#pragma unroll
  for (int q = 0; q < 4; q++) {
    if (n[q] > TOPK) {
      int base = 0;
#pragma unroll
      for (int j = 0; j < NPL; j++) {
        const int e = j * 64 + lane;
        const bool in = e < n[q];
        const float v = in ? vals[q * CAP + e] : 0.f;
        const unsigned ixv = in ? (unsigned)idxs[q * CAP + e] : 0xffffu;
        const bool keep = (key[q][j] > Tk[q]) || (key[q][j] == Tk[q] && ixv <= I[q]);
        const unsigned long long m = __ballot(keep);
        if (keep) {
          const int pos = base + __popcll(m & lt);
          vals[q * CAP + pos] = v;
          idxs[q * CAP + pos] = (u16)ixv;
        }
        base += __popcll(m);
      }
      if (lane == 0) cnt[q] = base;
      thr_out[q] = mono_inv(Tk[q]);
    }
  }
}

DI void indexer_phase(const u16* __restrict__ iq, const u16* __restrict__ ik, const float* __restrict__ iw,
                      u16* __restrict__ sel, char* smem, int bid, int nb) {
  constexpr int WBYTES = 4 * CAP * 4 + 4 * CAP * 2 + 64;
  const int tid = opq_tid(), lane = tid & 63, w = __builtin_amdgcn_readfirstlane(tid >> 6), l31 = lane & 31, u = lane >> 5;
  float* vals = (float*)(smem + w * WBYTES);
  u16* idxs = (u16*)(smem + w * WBYTES + 4 * CAP * 4);
  int* cnt = (int*)(smem + w * WBYTES + 4 * CAP * 4 + 4 * CAP * 2);
  const int nitems = NBATCH * (S / 16);
  const int nrounds = (nitems + nb - 1) / nb;
  __syncthreads();
  for (int rd = 0; rd < nrounds; rd++) {
    const int it = rd * nb + ((rd & 1) ? (nb - 1 - bid) : bid);
    if (it >= nitems) continue;
    const int b = it & 3, qg = (S / 16 - 1) - (it >> 2);
    const int t0 = qg * 16;
    const int tw = t0 + 4 * w;
    const size_t tb = (size_t)b * S;
    bf16x8 aq[4];
    {
      const int g = l31 >> 3, up = (l31 >> 2) & 1, j = l31 & 3;
      const int ql = 2 * up + (g >> 1), hd = 4 * (g & 1) + j;
      const u16* qp = iq + (tb + tw + ql) * 512 + hd * 64 + u * 8;
#pragma unroll
      for (int ks = 0; ks < 4; ks++) aq[ks] = *(const bf16x8*)(qp + ks * 16);
    }
    float wq[2][8];
#pragma unroll
    for (int qq = 0; qq < 2; qq++) {
      const float* wp = iw + (tb + tw + 2 * u + qq) * 8;
      f32x4 w0 = *(const f32x4*)wp, w1 = *(const f32x4*)(wp + 4);
#pragma unroll
      for (int h = 0; h < 4; h++) {
        wq[qq][h] = w0[h];
        wq[qq][4 + h] = w1[h];
      }
    }
    float thr[2] = {-INFINITY, -INFINITY};
    __builtin_amdgcn_wave_barrier();
    if (lane < 4) cnt[lane] = 0;
    __builtin_amdgcn_wave_barrier();
    const int nkb = (tw + 3) / 32 + 1;
    const u16* kp = ik + tb * 64 + lane * 8;
    bf16x8 ring[4][4];
#pragma unroll
    for (int i = 0; i < 4; i++) {
      const int kbn = (i < nkb) ? i : nkb - 1;
#pragma unroll
      for (int ks = 0; ks < 4; ks++) ring[i][ks] = *(const bf16x8*)(kp + (size_t)(kbn * 4 + ks) * 512);
    }
#pragma unroll 1
    for (int kb0 = 0; kb0 < nkb; kb0 += 4) {
#pragma unroll
      for (int i = 0; i < 4; i++) {
        const int kb = kb0 + i;
        {
          f32x16 acc;
#pragma unroll
          for (int r = 0; r < 16; r++) acc[r] = 0.f;
#pragma unroll
          for (int ks = 0; ks < 4; ks++) acc = mfma32(aq[ks], ring[i][ks], acc);
          {
            const int kbn = (kb + 4 < nkb) ? kb + 4 : nkb - 1;
#pragma unroll
            for (int ks = 0; ks < 4; ks++) ring[i][ks] = *(const bf16x8*)(kp + (size_t)(kbn * 4 + ks) * 512);
          }
          const int key = kb * 32 + l31;
#pragma unroll
          for (int qq = 0; qq < 2; qq++) {
            float s0 = 0.f, s1 = 0.f;
#pragma unroll
            for (int h = 0; h < 8; h += 2) {
              s0 = fmaf(wq[qq][h], relu_i(acc[8 * qq + h]), s0);
              s1 = fmaf(wq[qq][h + 1], relu_i(acc[8 * qq + h + 1]), s1);
            }
            float s = s0 + s1;
            s += 0.0f;
            const int tq = tw + 2 * u + qq;
            if (key <= tq && s >= thr[qq]) {
              const int qs = 2 * u + qq;
              const int pos = atomicAdd(&cnt[qs], 1);
              vals[qs * CAP + pos] = s;
              idxs[qs * CAP + pos] = (u16)key;
            }
          }
        }
      }
      __builtin_amdgcn_wave_barrier();
      const int c0 = cnt[0], c1 = cnt[1], c2 = cnt[2], c3 = cnt[3];
      if (c0 > CAP - 128 || c1 > CAP - 128 || c2 > CAP - 128 || c3 > CAP - 128) {
        float to[4] = {0.f, 0.f, 0.f, 0.f};
        compact4<false>(vals, idxs, cnt, lane, to);
        __builtin_amdgcn_wave_barrier();
        const int d0 = cnt[0], d1 = cnt[1], d2 = cnt[2], d3 = cnt[3];
        if (d0 > CAP - 256 || d1 > CAP - 256 || d2 > CAP - 256 || d3 > CAP - 256) {
          compact4<true>(vals, idxs, cnt, lane, to);
          __builtin_amdgcn_wave_barrier();
        }
        if (c0 > TOPK && u == 0) thr[0] = to[0];
        if (c1 > TOPK && u == 0) thr[1] = to[1];
        if (c2 > TOPK && u == 1) thr[0] = to[2];
        if (c3 > TOPK && u == 1) thr[1] = to[3];
      }
    }
    {
      const int c0 = cnt[0], c1 = cnt[1], c2 = cnt[2], c3 = cnt[3];
      if (c0 > TOPK || c1 > TOPK || c2 > TOPK || c3 > TOPK) {
        float to[4];
        compact4<true>(vals, idxs, cnt, lane, to);
        __builtin_amdgcn_wave_barrier();
      }
    }
#pragma unroll 1
    for (int qs = 0; qs < 4; qs++) {
      const int n = cnt[qs];
      u16* sp = sel + (tb + tw + qs) * 256;
#pragma unroll
      for (int j = 0; j < 4; j++) {
        const int e = j * 64 + lane;
        sp[e] = (e < n) ? idxs[qs * CAP + e] : (u16)0xffffu;
      }
    }
  }
}

DI void sparse_phase(const u16* __restrict__ q, const u16* __restrict__ ckvn, const u16* __restrict__ sel,
                     const u16* __restrict__ wuk, const u16* __restrict__ wuv, const float* __restrict__ rel_bias,
                     u16* scratch, u16* __restrict__ o, char* smem, int bid, int nb) {
  constexpr int GS = 264;
  const int tid = opq_tid(), lane = tid & 63, w = __builtin_amdgcn_readfirstlane(tid >> 6), l15 = lane & 15, g = lane >> 4;
  u16* G = (u16*)smem + (size_t)w * 32 * GS;
  int* lut = (int*)(smem + 4 * 32 * GS * 2);
  float* rb = (float*)(lut + 128);
  __syncthreads();
  if (tid < 128) lut[tid] = rel_bucket(tid);
  for (int i = tid; i < 512; i += 256) rb[i] = rel_bias[i] * LOG2E;
  __syncthreads();
  u16* ql = scratch + (size_t)bid * (16 * 16 * 256);
  const int nitems = NBATCH * (S / 16);
  for (int it = bid; it < nitems; it += nb) {
    const int b = it & 3, qg = it >> 2;
    const int t0 = qg * 16;
    const size_t tb = (size_t)b * S;
    for (int hh = 0; hh < 4; hh++) {
      const int h = 4 * w + hh;
      bf16x8 bq[2];
#pragma unroll
      for (int ks = 0; ks < 2; ks++) bq[ks] = *(const bf16x8*)(q + (tb + t0 + l15) * 1024 + h * 64 + ks * 32 + g * 8);
#pragma unroll 4
      for (int rt = 0; rt < 16; rt++) {
        f32x4 acc = {0.f, 0.f, 0.f, 0.f};
#pragma unroll
        for (int ks = 0; ks < 2; ks++) {
          bf16x8 a = *(const bf16x8*)(wuk + ((size_t)h * 256 + rt * 16 + l15) * 64 + ks * 32 + g * 8);
          acc = mfma16(a, bq[ks], acc);
        }
        u32x2 ov;
        ov[0] = pk2(acc[0] * (0.125f * LOG2E), acc[1] * (0.125f * LOG2E));
        ov[1] = pk2(acc[2] * (0.125f * LOG2E), acc[3] * (0.125f * LOG2E));
        *(u32x2*)(ql + ((size_t)l15 * 16 + h) * 256 + rt * 16 + 4 * g) = ov;
      }
    }
    __syncthreads();
    {
      const u16* selw = sel + (tb + t0 + 4 * w) * 256;
      const int l31 = lane & 31;
      const int q4 = l15 >> 2, p4 = l15 & 3;
      const u16* ckb = ckvn + tb * 256;
      int idx_c = selw[l31];
      int idx_n = selw[32 + l31];
      u32x4 gr[16];
#pragma unroll
      for (int i = 0; i < 16; i++) {
        int id = __shfl(idx_c, (lane >> 5) + 2 * i);
        id = (id == 0xffff) ? 0 : id;
        gr[i] = *(const u32x4*)(ckb + (unsigned)(id * 256 + l31 * 8));
      }
      bf16x8 qb[8];
      float m_run = NEGF, l_run = 0.f;
      f32x4 O[16];
#pragma unroll 1
      for (int st = 0; st < 32; st++) {
        const int qi = st >> 3, ch = st & 7;
        const int qloc = 4 * w + qi;
        const int t = t0 + qloc;
        if (ch == 0) {
#pragma unroll
          for (int ks = 0; ks < 8; ks++) qb[ks] = *(const bf16x8*)(ql + ((size_t)qloc * 16 + l15) * 256 + ks * 32 + g * 8);
          m_run = NEGF;
          l_run = 0.f;
#pragma unroll
          for (int rt = 0; rt < 16; rt++) O[rt] = (f32x4){0.f, 0.f, 0.f, 0.f};
        }
#pragma unroll
        for (int i = 0; i < 16; i++) *(u32x4*)&G[((lane >> 5) + 2 * i) * GS + l31 * 8] = gr[i];
        __builtin_amdgcn_wave_barrier();
        const int stn2 = (st + 2 < 32) ? st + 2 : 31;
        const int idx_nn = selw[stn2 * 32 + l31];
#pragma unroll
        for (int i = 0; i < 16; i++) {
          int id = __shfl(idx_n, (lane >> 5) + 2 * i);
          id = (id == 0xffff) ? 0 : id;
          gr[i] = *(const u32x4*)(ckb + (unsigned)(id * 256 + l31 * 8));
        }
        float lg[2][4];
#pragma unroll
        for (int kbk = 0; kbk < 2; kbk++) {
          f32x4 acc = {0.f, 0.f, 0.f, 0.f};
#pragma unroll
          for (int ks = 0; ks < 8; ks++) {
            bf16x8 a = *(const bf16x8*)&G[(16 * kbk + l15) * GS + ks * 32 + g * 8];
            acc = mfma16(a, qb[ks], acc);
            if (ks == 3) asm volatile("" ::: "memory");
          }
          asm volatile("" ::: "memory");
#pragma unroll
          for (int i = 0; i < 4; i++) {
            const int kid = __shfl(idx_c, 16 * kbk + 4 * g + i);
            float v = NEGF;
            if (kid != 0xffff) {
              int n = t - kid;
              n = n < 0 ? 0 : n;
              const int bk = n < 128 ? lut[n] : 31;
              v = acc[i] + rb[bk * 16 + l15];
            }
            lg[kbk][i] = v;
          }
        }
        float mx = fmaxf(fmaxf(fmaxf(lg[0][0], lg[0][1]), fmaxf(lg[0][2], lg[0][3])),
                         fmaxf(fmaxf(lg[1][0], lg[1][1]), fmaxf(lg[1][2], lg[1][3])));
        mx = fmaxf(mx, __shfl_xor(mx, 16));
        mx = fmaxf(mx, __shfl_xor(mx, 32));
        const float m_new = fmaxf(m_run, mx);
        const float scl = __builtin_amdgcn_exp2f(m_run - m_new);
        m_run = m_new;
        float ps = 0.f;
        float pe[8];
#pragma unroll
        for (int kbk = 0; kbk < 2; kbk++)
#pragma unroll
          for (int i = 0; i < 4; i++) {
            const float pv = __builtin_amdgcn_exp2f(lg[kbk][i] - m_new);
            pe[kbk * 4 + i] = pv;
            ps += pv;
          }
        l_run = l_run * scl + ps;
        u32x4 pw;
        pw[0] = pk2(pe[0], pe[1]);
        pw[1] = pk2(pe[2], pe[3]);
        pw[2] = pk2(pe[4], pe[5]);
        pw[3] = pk2(pe[6], pe[7]);
        const bf16x8 pB = __builtin_bit_cast(bf16x8, pw);
        if (__ballot(scl != 1.f)) {
#pragma unroll
          for (int rt = 0; rt < 16; rt++) O[rt] = O[rt] * scl;
        }
#pragma unroll
        for (int rt = 0; rt < 16; rt++) {
          const s16x4 lo = __builtin_amdgcn_ds_read_tr16_b64_v4i16((lds_s16x4_ptr)(&G[(4 * g + q4) * GS + rt * 16 + 4 * p4]));
          const s16x4 hi = __builtin_amdgcn_ds_read_tr16_b64_v4i16((lds_s16x4_ptr)(&G[(16 + 4 * g + q4) * GS + rt * 16 + 4 * p4]));
          const bf16x8 a = (bf16x8){lo[0], lo[1], lo[2], lo[3], hi[0], hi[1], hi[2], hi[3]};
          O[rt] = mfma16(a, pB, O[rt]);
          if ((rt & 3) == 3) asm volatile("" ::: "memory");
        }
        __builtin_amdgcn_wave_barrier();
        if (ch == 7) {
          float lt = l_run;
          lt += __shfl_xor(lt, 16);
          lt += __shfl_xor(lt, 32);
          const float inv = 1.f / lt;
#pragma unroll
          for (int rt = 0; rt < 16; rt++) {
            u32x2 ov;
            ov[0] = pk2(O[rt][0] * inv, O[rt][1] * inv);
            ov[1] = pk2(O[rt][2] * inv, O[rt][3] * inv);
            *(u32x2*)(ql + ((size_t)qloc * 16 + l15) * 256 + rt * 16 + 4 * g) = ov;
          }
        }
        idx_c = idx_n;
        idx_n = idx_nn;
      }
    }
    __syncthreads();
    for (int hh = 0; hh < 4; hh++) {
      const int h = 4 * w + hh;
      bf16x8 bo[8];
#pragma unroll
      for (int ks = 0; ks < 8; ks++) bo[ks] = *(const bf16x8*)(ql + ((size_t)l15 * 16 + h) * 256 + ks * 32 + g * 8);
#pragma unroll
      for (int et = 0; et < 4; et++) {
        f32x4 acc = {0.f, 0.f, 0.f, 0.f};
#pragma unroll
        for (int ks = 0; ks < 8; ks++) {
          bf16x8 a = *(const bf16x8*)(wuv + ((size_t)h * 64 + et * 16 + l15) * 256 + ks * 32 + g * 8);
          acc = mfma16(a, bo[ks], acc);
        }
        u32x2 ov;
        ov[0] = pk2(acc[0], acc[1]);
        ov[1] = pk2(acc[2], acc[3]);
        *(u32x2*)(o + (tb + t0 + l15) * 1024 + h * 64 + et * 16 + 4 * g) = ov;
      }
    }
    __syncthreads();
  }
}

DI void diffattn_phase(const u16* __restrict__ q, const u16* __restrict__ k, const u16* __restrict__ vT,
                       u16* __restrict__ o, const float* __restrict__ rel_bias, const float* __restrict__ lam,
                       const float* __restrict__ subln, int layer_idx, char* smem, int bid, int nb) {
  constexpr int KS = 136, VS = 72;
  u16* Ks = (u16*)smem;
  u16* Vs = Ks + 64 * KS;
  float* exch = (float*)smem;
  constexpr int STG = 64 * KS + 128 * VS;
  float* btab = (float*)(smem + 72 * 1024);
  int* lut = (int*)(smem + 72 * 1024 + 1040);
  float* misc = (float*)(smem + 72 * 1024 + 1040 + 512);
  const int tid = opq_tid8(), lane = tid & 63, w = __builtin_amdgcn_readfirstlane(tid >> 6), l31 = lane & 31, lh = lane >> 5;
  const int qsub = w >> 1, m = w & 1;
  const float lam_init = 0.8f - 0.6f * expf(-0.3f * (float)layer_idx);
  __syncthreads();
  if (tid < 128) lut[tid] = rel_bucket(tid);
  if (w == 0) {
    float p1 = lam[lane] * lam[64 + lane], p2 = lam[128 + lane] * lam[192 + lane];
    p1 = wave_sum(p1);
    p2 = wave_sum(p2);
    if (lane == 0) misc[0] = expf(p1) - expf(p2) + lam_init;
  }
  __syncthreads();
  const float lam_full = misc[0];
  const int xcd = bid & 7, loc = bid >> 3, nbx = nb >> 3;
  const int rph = (S / 128) / nbx;
  const int prow = pi_row(l31);
  for (int rd = 0; rd < 4 * rph; rd++) {
    const int hh = rd / rph, r = rd - hh * rph;
    const int bh = xcd + 8 * hh;
    const int kk = r >> 1;
    const int qb = (r & 1) ? (kk * nbx + loc) : ((S / 128 - 1) - kk * nbx - loc);
    const int b = bh >> 3, h = bh & 7;
    const int q0 = qb * 128, tq0 = q0 + 32 * qsub, t = tq0 + l31;
    const size_t tb = (size_t)b * S;
    __syncthreads();
    for (int i = tid; i < 258; i += 512) {
      const int n = i >> 1, mm = i & 1;
      const int bk = n < 128 ? lut[n] : 31;
      btab[i] = rel_bias[bk * 16 + 2 * h + mm] * LOG2E;
    }
    bf16x8 qf[4];
#pragma unroll
    for (int ks = 0; ks < 4; ks++) qf[ks] = *(const bf16x8*)(q + (tb + t) * 1024 + h * 128 + m * 64 + ks * 16 + lh * 8);
    f32x16 O[4];
#pragma unroll
    for (int et = 0; et < 4; et++)
#pragma unroll
      for (int r = 0; r < 16; r++) O[et][r] = 0.f;
    float m_run = NEGF, l_run = 0.f;
    const int nkt = 2 * qb + 2;
    u32x4 rk[2], rv[2];
    const u16* kp = k + tb * 1024 + h * 128;
    const u16* vp = vT + ((size_t)(b * 8 + h) * 128) * 8192;
#pragma unroll
    for (int i = 0; i < 2; i++) {
      const int id = tid + 512 * i;
      rk[i] = *(const u32x4*)(kp + (size_t)(id >> 4) * 1024 + (id & 15) * 8);
      rv[i] = *(const u32x4*)(vp + (size_t)(id >> 3) * 8192 + (id & 7) * 8);
    }
#pragma unroll
    for (int i = 0; i < 2; i++) {
      const int id = tid + 512 * i;
      *(u32x4*)&Ks[(id >> 4) * KS + (id & 15) * 8] = rk[i];
      *(u32x4*)&Vs[(id >> 3) * VS + (id & 7) * 8] = rv[i];
    }
#pragma unroll
    for (int i = 0; i < 2; i++) {
      const int id = tid + 512 * i;
      rk[i] = *(const u32x4*)(kp + (size_t)(64 + (id >> 4)) * 1024 + (id & 15) * 8);
      rv[i] = *(const u32x4*)(vp + (size_t)(id >> 3) * 8192 + 64 + (id & 7) * 8);
    }
    __syncthreads();
    const float cfar = btab[256 + m];
    for (int kt = 0; kt < nkt; kt++) {
      const u16* Ksc = Ks + (kt & 1) * STG;
      const u16* Vsc = Vs + (kt & 1) * STG;
      if (kt + 1 < nkt) {
        u16* Ksn = Ks + ((kt & 1) ^ 1) * STG;
        u16* Vsn = Vs + ((kt & 1) ^ 1) * STG;
#pragma unroll
        for (int i = 0; i < 2; i++) {
          const int id = tid + 512 * i;
          *(u32x4*)&Ksn[(id >> 4) * KS + (id & 15) * 8] = rk[i];
          *(u32x4*)&Vsn[(id >> 3) * VS + (id & 7) * 8] = rv[i];
        }
        const int k2 = (kt + 2 < nkt) ? kt + 2 : nkt - 1;
#pragma unroll
        for (int i = 0; i < 2; i++) {
          const int id = tid + 512 * i;
          rk[i] = *(const u32x4*)(kp + (size_t)(k2 * 64 + (id >> 4)) * 1024 + (id & 15) * 8);
          rv[i] = *(const u32x4*)(vp + (size_t)(id >> 3) * 8192 + k2 * 64 + (id & 7) * 8);
        }
      }
      const int s_tile = kt * 64;
      const int remk = tq0 + 31 - s_tile;
      const int nblk = remk < 0 ? 0 : (remk >= 32 ? 2 : 1);
#pragma unroll 1
      for (int kb = 0; kb < nblk; kb++) {
        const int s0 = s_tile + 32 * kb;
        const bool nearb = (tq0 - (s0 + 31)) < 128;
        const bool first = (kt == 0) && (kb == 0);
        const float mref = first ? 0.f : m_run;
        const float cinit = nearb ? -mref : (cfar - mref);
        f32x16 acc;
#pragma unroll
        for (int r = 0; r < 16; r++) acc[r] = cinit;
#pragma unroll
        for (int ks = 0; ks < 4; ks++) {
          bf16x8 a = *(const bf16x8*)&Ksc[(32 * kb + prow) * KS + m * 64 + ks * 16 + lh * 8];
          acc = mfma32(a, qf[ks], acc);
        }
        bf16x8 vfa[4];
#pragma unroll
        for (int et = 0; et < 4; et++) vfa[et] = *(const bf16x8*)&Vsc[(32 * et + l31) * VS + 32 * kb + 8 * lh];
        __builtin_amdgcn_sched_barrier(0);
        if (nearb) {
#pragma unroll
          for (int r = 0; r < 16; r++) {
            const int key = s0 + 16 * (r >> 3) + 8 * lh + (r & 7);
            const int n = t - key;
            const int nc = n < 0 ? 0 : (n > 128 ? 128 : n);
            const float bv = btab[nc * 2 + m];
            acc[r] = (n < 0) ? NEGF : acc[r] + bv;
          }
        }
        float mx = acc[0];
#pragma unroll
        for (int r = 1; r < 16; r++) mx = fmaxf(mx, acc[r]);
        mx = fmaxf(mx, __shfl_xor(mx, 32));
        if (first || __ballot(mx > 8.f)) {
          const float dlt = first ? mx : fmaxf(mx, 0.f);
          const float scl = __builtin_amdgcn_exp2f(-dlt);
#pragma unroll
          for (int r = 0; r < 16; r++) acc[r] -= dlt;
#pragma unroll
          for (int et = 0; et < 4; et++)
#pragma unroll
            for (int r = 0; r < 16; r++) O[et][r] *= scl;
          l_run *= scl;
          m_run = mref + dlt;
        }
        float ps = 0.f;
#pragma unroll
        for (int r = 0; r < 16; r++) {
          const float pv = __builtin_amdgcn_exp2f(acc[r]);
          acc[r] = pv;
          ps += pv;
        }
        l_run += ps;
        bf16x8 vfb[4];
#pragma unroll
        for (int et = 0; et < 4; et++) vfb[et] = *(const bf16x8*)&Vsc[(32 * et + l31) * VS + 32 * kb + 16 + 8 * lh];
        u32x4 pw0, pw1;
        pw0[0] = pk2(acc[0], acc[1]);
        pw0[1] = pk2(acc[2], acc[3]);
        pw0[2] = pk2(acc[4], acc[5]);
        pw0[3] = pk2(acc[6], acc[7]);
        pw1[0] = pk2(acc[8], acc[9]);
        pw1[1] = pk2(acc[10], acc[11]);
        pw1[2] = pk2(acc[12], acc[13]);
        pw1[3] = pk2(acc[14], acc[15]);
        const bf16x8 pB0 = __builtin_bit_cast(bf16x8, pw0), pB1 = __builtin_bit_cast(bf16x8, pw1);
        __builtin_amdgcn_sched_barrier(0);
#pragma unroll
        for (int et = 0; et < 4; et++) O[et] = mfma32(vfa[et], pB0, O[et]);
#pragma unroll
        for (int et = 0; et < 4; et++) O[et] = mfma32(vfb[et], pB1, O[et]);
      }
      __syncthreads();
    }
    float lt = l_run + __shfl_xor(l_run, 32);
    const float inv = 1.f / lt;
    if (m == 1) {
#pragma unroll
      for (int et = 0; et < 4; et++)
#pragma unroll
        for (int r = 0; r < 16; r++) {
          const int e = 32 * et + (r & 3) + 8 * (r >> 2) + 4 * lh;
          exch[(qsub * 128 + e) * 32 + l31] = O[et][r] * inv;
        }
    }
    __syncthreads();
    if (m == 0) {
      float ss = 0.f;
#pragma unroll
      for (int et = 0; et < 4; et++)
#pragma unroll
        for (int r = 0; r < 16; r++) {
          const int e = 32 * et + (r & 3) + 8 * (r >> 2) + 4 * lh;
          const float v = O[et][r] * inv - lam_full * exch[(qsub * 128 + e) * 32 + l31];
          O[et][r] = v;
          ss += v * v;
        }
      ss += __shfl_xor(ss, 32);
      const float rs = rsqrtf(ss * (1.f / 128.f) + LN_EPS);
      const float osc = 1.f - lam_init;
#pragma unroll
      for (int et = 0; et < 4; et++)
#pragma unroll
        for (int r4 = 0; r4 < 4; r4++) {
          const int e = 32 * et + 8 * r4 + 4 * lh;
          const f32x4 gv = *(const f32x4*)(subln + e);
          u32x2 ov;
          ov[0] = pk2(O[et][4 * r4 + 0] * rs * gv[0] * osc, O[et][4 * r4 + 1] * rs * gv[1] * osc);
          ov[1] = pk2(O[et][4 * r4 + 2] * rs * gv[2] * osc, O[et][4 * r4 + 3] * rs * gv[3] * osc);
          *(u32x2*)(o + (tb + t) * 1024 + h * 128 + e) = ov;
        }
    }
  }
}

#define XB_TMO      128
#define XB_XCNT(j)  (256  + 64 * (j))
#define XB_XSUB(j)  (1280 + 64 * (j))
#define XB_XGEN(j)  (2304 + 64 * (j))
#define XB_TOP      3328
#define XB_TOPGEN   3392
#define XCD_BAR_WORDS 3456
#define XB_SPIN_CAP (1u << 20)
#define LAS __attribute__((address_space(3)))
DI unsigned xb_ld(unsigned* p) { return __hip_atomic_load(p, __ATOMIC_RELAXED, __HIP_MEMORY_SCOPE_AGENT); }
DI unsigned xb_add(unsigned* p, unsigned v) { return __hip_atomic_fetch_add(p, v, __ATOMIC_RELAXED, __HIP_MEMORY_SCOPE_AGENT); }
DI unsigned xb_xcc_id() { return (unsigned)__builtin_amdgcn_s_getreg((3 << 11) | 20) & 0xFu; }
#define XB_SPIN(cond, bar) do { unsigned _sp = 0; while (cond) { __builtin_amdgcn_s_sleep(1); \
    if ((++_sp & 255u) == 0u) { if (xb_ld(&(bar)[XB_TMO])) break; if (_sp > XB_SPIN_CAP) { atomicAdd(&(bar)[XB_TMO], 1u); break; } } } } while (0)
struct XcdBarrier {
  unsigned* bar;
  unsigned x;
  volatile LAS unsigned* st;
};
DI XcdBarrier xcd_barrier_post(unsigned* bar, volatile LAS unsigned* st) {
  XcdBarrier b;
  b.bar = bar;
  b.x = xb_xcc_id();
  b.st = st;
  if (threadIdx.x == 0) (void)xb_add(&bar[XB_XCNT(b.x)], 1u);
  return b;
}
DI void xcd_barrier_complete(unsigned* bar, unsigned x, unsigned& nloc, unsigned& nx) {
  const unsigned G = gridDim.x * gridDim.y * gridDim.z;
  unsigned sum, cnt, mine, sp = 0u;
  for (;;) {
    sum = 0u; cnt = 0u; mine = 0u;
#pragma unroll
    for (unsigned j = 0; j < 16; ++j) {
      const unsigned c = xb_ld(&bar[XB_XCNT(j)]);
      sum += c;
      cnt += (c > 0u) ? 1u : 0u;
      mine = (j == x) ? c : mine;
    }
    if (sum == G) break;
    __builtin_amdgcn_s_sleep(1);
    if ((++sp & 255u) == 0u) { if (xb_ld(&bar[XB_TMO])) break; if (sp > XB_SPIN_CAP) { atomicAdd(&bar[XB_TMO], 1u); break; } }
  }
  nloc = mine > 0u ? mine : 1u;
  nx = cnt > 0u ? cnt : 1u;
}
DI void xcd_barrier(const XcdBarrier& b0) {
  asm volatile("s_waitcnt vmcnt(0)" ::: "memory");
  __syncthreads();
  if (threadIdx.x == 0) {
    XcdBarrier b = b0;
    b.x = __builtin_amdgcn_readfirstlane(xb_xcc_id());
    unsigned* bar = b.bar;
    asm volatile("" : "+s"(bar));
    __builtin_amdgcn_s_waitcnt(0);
    unsigned nloc = b.st[0], nx = b.st[1];
    if (nloc == 0u) { xcd_barrier_complete(bar, b.x, nloc, nx); b.st[0] = nloc; b.st[1] = nx; }
    const unsigned old = xb_add(&bar[XB_XSUB(b.x)], 1u);
    const unsigned gen = old / nloc;
    if (old + 1u == (gen + 1u) * nloc) {
      __builtin_amdgcn_fence(__ATOMIC_RELEASE, "agent");
      asm volatile("s_waitcnt vmcnt(0)" ::: "memory");
      const unsigned og = xb_add(&bar[XB_TOP], 1u);
      const unsigned tg = og / nx;
      if (og + 1u == (tg + 1u) * nx) xb_add(&bar[XB_TOPGEN], 1u);
      else XB_SPIN(xb_ld(&bar[XB_TOPGEN]) == tg, bar);
      __builtin_amdgcn_fence(__ATOMIC_ACQUIRE, "agent");
      xb_add(&bar[XB_XGEN(b.x)], 1u);
      asm volatile("s_waitcnt vmcnt(0)" ::: "memory");
    } else {
      XB_SPIN(xb_ld(&bar[XB_XGEN(b.x)]) == gen, bar);
      __builtin_amdgcn_fence(__ATOMIC_ACQUIRE, "agent");
      asm volatile("s_waitcnt vmcnt(0)" ::: "memory");
    }
  }
  __syncthreads();
}

#define DECL_WS_PTRS(ws) \
  u16* w_ain = (u16*)(ws + W_AIN); \
  u16* w_uk = (u16*)(ws + W_UK); \
  u16* w_uv = (u16*)(ws + W_UV); \
  u16* w_ao = (u16*)(ws + W_AO); \
  u16* w_bin = (u16*)(ws + W_BIN); \
  u16* w_bo = (u16*)(ws + W_BO); \
  u16* w_w1 = (u16*)(ws + W_W1); \
  u16* w_w2 = (u16*)(ws + W_W2); \
  float* mod = (float*)(ws + WS_MOD); \
  u16* hbuf = (u16*)(ws + WS_H); \
  char* big = ws + WS_BIG; \
  u16* qbuf = (u16*)(big + B_Q); \
  u16* iqbuf = (u16*)(big + B_IQ); \
  u16* ikbuf = (u16*)(big + B_IK); \
  float* iwbuf = (float*)(big + B_IW); \
  float* ckvraw = (float*)(big + B_CKVRAW); \
  u16* ckvn = (u16*)(big + B_CKVN); \
  u16* selbuf = (u16*)(big + B_SEL); \
  u16* kbuf = (u16*)(big + B_K); \
  u16* vtbuf = (u16*)(big + B_VT); \
  u16* obuf = (u16*)(big + B_O); \
  u16* hid = (u16*)big;

__global__ void __launch_bounds__(512, 2) hybrid_fwd(Params p) {
  __shared__ __attribute__((aligned(16))) char smem[2 * LDS_BYTES];
  cg::grid_group grid = cg::this_grid();
  const int bid = blockIdx.x, nb = gridDim.x;
  const int half = __builtin_amdgcn_readfirstlane((int)(threadIdx.x >> 8));
  const int vb = half * nb + bid, nvb = 2 * nb;
  char* smh = smem + half * LDS_BYTES;
  char* ws = p.ws;
  unsigned* bar = (unsigned*)(ws + WS_BAR);
  volatile LAS unsigned* xst = (volatile LAS unsigned*)(smem + 2 * LDS_BYTES - 16);
  if (threadIdx.x < 2) xst[threadIdx.x] = 0u;
  __syncthreads();
  const XcdBarrier xb = xcd_barrier_post(bar, xst);

  {
  DECL_WS_PTRS(ws)
  (void)qbuf; (void)iqbuf; (void)ikbuf; (void)iwbuf; (void)ckvraw; (void)ckvn; (void)selbuf; (void)kbuf; (void)vtbuf; (void)obuf; (void)hid;
  tconv_phase(p.a_w_in, w_ain, 2, 1024, 1864, A_INP, smh, vb, nvb);
  tconv_phase(p.a_w_uk, w_uk, 32, 64, 256, 256, smh, vb, nvb);
  tconv_phase(p.a_w_uv, w_uv, 32, 256, 64, 64, smh, vb, nvb);
  tconv_phase(p.a_w_o, w_ao, 2, 1024, 1024, 1024, smh, vb, nvb);
  tconv_phase(p.b_w_in, w_bin, 2, 1024, 3072, 3072, smh, vb, nvb);
  tconv_phase(p.b_w_o, w_bo, 2, 1024, 1024, 1024, smh, vb, nvb);
  tconv_phase(p.mlp_w1, w_w1, 4, 1024, 4096, 4096, smh, vb, nvb);
  tconv_phase(p.mlp_w2, w_w2, 4, 4096, 1024, 1024, smh, vb, nvb);
  mod_phase(p, mod, smh, vb, nvb);
  grid.sync();
  h0_phase(p.x, mod, hbuf, vb, nvb);
  xcd_barrier(xb);
  }

#pragma unroll 1
  for (int sl = 0; sl < 8; sl++) {
    char* wsl = p.ws;
    asm volatile("" : "+s"(wsl));
    DECL_WS_PTRS(wsl)
    const int i = sl >> 1, j = i >> 1;
    const float* modi = mod + (size_t)i * 4 * 6144;
    const u16* Ares;
    const u16* Wres;
    int Kres, goff;
    if ((sl & 1) == 0) {
      if ((i & 1) == 0) {
        EpiArgs ea{};
        ea.o0 = qbuf; ea.f0 = ckvraw; ea.o1 = iqbuf; ea.o2 = ikbuf; ea.f1 = iwbuf;
        for (int rep = 0; rep < (PROBE_DUP == 4 ? 2 : 1); rep++) gemm8p_phase<EPI_AIN>(hbuf, w_ain + (size_t)j * A_INP * 1024, T, A_INP, 1024, ea, smem, bid, nb);
        xcd_barrier(xb);
        ckvnorm_phase(ckvraw, p.a_kv_norm + j * 256, ckvn, vb, nvb);
        for (int rep = 0; rep < (PROBE_DUP == 2 ? 2 : 1); rep++) indexer_phase(iqbuf, ikbuf, iwbuf, selbuf, smh, vb, nvb);
        xcd_barrier(xb);
        for (int rep = 0; rep < (PROBE_DUP == 3 ? 2 : 1); rep++) sparse_phase(qbuf, ckvn, selbuf, w_uk + (size_t)j * 16 * 256 * 64, w_uv + (size_t)j * 16 * 256 * 64, p.rel_bias,
                     hbuf, obuf, smh, vb, nvb);
        xcd_barrier(xb);
        Wres = w_ao + (size_t)j * 1024 * 1024;
      } else {
        EpiArgs ea{};
        ea.o0 = qbuf; ea.o1 = kbuf; ea.o2 = vtbuf;
        for (int rep = 0; rep < (PROBE_DUP == 4 ? 2 : 1); rep++) gemm8p_phase<EPI_BIN>(hbuf, w_bin + (size_t)j * 3072 * 1024, T, 3072, 1024, ea, smem, bid, nb);
        xcd_barrier(xb);
        for (int rep = 0; rep < (PROBE_DUP == 1 ? 2 : 1); rep++) diffattn_phase(qbuf, kbuf, vtbuf, obuf, p.rel_bias, p.b_lambda + j * 256, p.b_subln + j * 128, i, smem, bid, nb);
        xcd_barrier(xb);
        Wres = w_bo + (size_t)j * 1024 * 1024;
      }
      Ares = obuf; Kres = 1024; goff = 2 * 1024;
    } else {
      EpiArgs ea{};
      ea.o0 = hid;
      for (int rep = 0; rep < (PROBE_DUP == 4 ? 2 : 1); rep++) gemm8p_phase<EPI_SQRELU>(hbuf, w_w1 + (size_t)i * 4096 * 1024, T, 4096, 1024, ea, smem, bid, nb);
      xcd_barrier(xb);
      Ares = hid; Wres = w_w2 + (size_t)i * 4096 * 1024; Kres = 4096; goff = 5 * 1024;
    }
    {
      EpiArgs ea{};
      ea.f0 = p.out;
      ea.xin = (sl == 0) ? p.x : (const float*)p.out;
      ea.g = modi + goff;
      gemm8p_phase<EPI_RES>(Ares, Wres, T, 1024, Kres, ea, smem, bid, nb);
    }
    xcd_barrier(xb);
    {
      const float* modn = ((sl & 1) == 0) ? modi : (i < 3 ? modi + 4 * 6144 : (const float*)nullptr);
      const int sh_off = ((sl & 1) == 0) ? 3 * 1024 : 0;
      ln_phase(p.out, p.ln_g + (size_t)(i * 2 + (sl & 1)) * 1024, p.ln_b + (size_t)(i * 2 + (sl & 1)) * 1024, modn, sh_off,
               hbuf, vb, nvb);
    }
    xcd_barrier(xb);
  }
}

extern "C" void kernel_launch(void* const* d_in, const int* in_sizes, int n_in, void* d_out, int out_size, void* d_ws,
                              size_t ws_size, hipStream_t stream) {
  static int grid_blocks = 0;
  if (!grid_blocks) {
    int dev = 0, cus = 0, per_cu = 0;
    hipGetDevice(&dev);
    hipDeviceGetAttribute(&cus, hipDeviceAttributeMultiprocessorCount, dev);
    hipOccupancyMaxActiveBlocksPerMultiprocessor(&per_cu, hybrid_fwd, 512, 0);
    (void)per_cu;
    grid_blocks = cus;
    if (grid_blocks > 256) grid_blocks = 256;
  }
  Params p{};
  p.x = (const float*)d_in[0];
  p.c = (const float*)d_in[1];
  p.rel_bias = (const float*)d_in[2];
  p.ada_w = (const float*)d_in[3];
  p.ada_b = (const float*)d_in[4];
  p.ln_g = (const float*)d_in[5];
  p.ln_b = (const float*)d_in[6];
  p.a_w_in = (const float*)d_in[7];
  p.a_kv_norm = (const float*)d_in[8];
  p.a_w_uk = (const float*)d_in[9];
  p.a_w_uv = (const float*)d_in[10];
  p.a_w_o = (const float*)d_in[11];
  p.b_w_in = (const float*)d_in[12];
  p.b_lambda = (const float*)d_in[13];
  p.b_subln = (const float*)d_in[14];
  p.b_w_o = (const float*)d_in[15];
  p.mlp_w1 = (const float*)d_in[16];
  p.mlp_w2 = (const float*)d_in[17];
  p.out = (float*)d_out;
  p.ws = (char*)d_ws;
  hipMemsetAsync((char*)d_ws + WS_BAR, 0, XCD_BAR_WORDS * 4, stream);
  void* args[] = {&p};
  hipError_t e = hipLaunchCooperativeKernel((void*)hybrid_fwd, dim3(grid_blocks), dim3(512), args, 0, stream);
  if (e != hipSuccess) fprintf(stderr, "cooperative launch failed: %s (grid %d)\n", hipGetErrorString(e), grid_blocks);
}
```

```cpp
#include <hip/hip_runtime.h>
#include <hip/hip_cooperative_groups.h>
#include <stdint.h>
#include <stdio.h>
namespace cg = cooperative_groups;

typedef unsigned short u16;
typedef short bf16x8 __attribute__((ext_vector_type(8)));
typedef short s16x4 __attribute__((ext_vector_type(4)));
typedef float f32x16 __attribute__((ext_vector_type(16)));
typedef float f32x4 __attribute__((ext_vector_type(4)));
typedef float f32x2 __attribute__((ext_vector_type(2)));
typedef __bf16 bf16x2_t __attribute__((ext_vector_type(2)));
typedef unsigned u32x4 __attribute__((ext_vector_type(4)));
typedef unsigned u32x2 __attribute__((ext_vector_type(2)));
typedef __attribute__((address_space(3))) s16x4* lds_s16x4_ptr;

#define DI __device__ __forceinline__
#ifndef PROBE_DUP
#define PROBE_DUP 0
#endif

constexpr int D = 1024, NBATCH = 4, S = 8192, T = NBATCH * S;
constexpr int A_INP = 2048;
constexpr float DN_ALPHA = 1.6817928305074292f;
constexpr float LOG2E = 1.4426950408889634f;
constexpr float LN_EPS = 1e-5f;
constexpr float NEGF = -1e30f;
constexpr int TOPK = 256;
constexpr int CAP = 704;
constexpr int LDS_BYTES = 72 * 1024;

constexpr size_t MB = 1024 * 1024;
constexpr size_t W_AIN = 0;
constexpr size_t W_UK = W_AIN + (size_t)2 * 2048 * 1024 * 2;
constexpr size_t W_UV = W_UK + (size_t)2 * 16 * 256 * 64 * 2;
constexpr size_t W_AO = W_UV + (size_t)2 * 16 * 256 * 64 * 2;
constexpr size_t W_BIN = W_AO + (size_t)2 * 1024 * 1024 * 2;
constexpr size_t W_BO = W_BIN + (size_t)2 * 3072 * 1024 * 2;
constexpr size_t W_W1 = W_BO + (size_t)2 * 1024 * 1024 * 2;
constexpr size_t W_W2 = W_W1 + (size_t)4 * 4096 * 1024 * 2;
constexpr size_t WS_MOD = W_W2 + (size_t)4 * 4096 * 1024 * 2;
constexpr size_t WS_H = WS_MOD + 1 * MB;
constexpr size_t WS_BIG = WS_H + 64 * MB;
constexpr size_t WS_BAR = WS_BIG + 256 * MB;
constexpr size_t B_Q = 0;
constexpr size_t B_IQ = 64 * MB;
constexpr size_t B_IK = 96 * MB;
constexpr size_t B_IW = 100 * MB;
constexpr size_t B_CKVRAW = 104 * MB;
constexpr size_t B_CKVN = 136 * MB;
constexpr size_t B_SEL = 152 * MB;
constexpr size_t B_K = 64 * MB;
constexpr size_t B_VT = 128 * MB;
constexpr size_t B_O = 192 * MB;

struct Params {
  const float *x, *c, *rel_bias, *ada_w, *ada_b, *ln_g, *ln_b, *a_w_in, *a_kv_norm, *a_w_uk, *a_w_uv, *a_w_o, *b_w_in,
      *b_lambda, *b_subln, *b_w_o, *mlp_w1, *mlp_w2;
  float* out;
  char* ws;
};

DI int opq_tid() {
  int t = threadIdx.x & 255;
  asm volatile("" : "+v"(t));
  return t;
}
DI int opq_tid8() {
  int t = threadIdx.x;
  asm volatile("" : "+v"(t));
  return t;
}
DI unsigned pk2(float lo, float hi) {
  f32x2 v = {lo, hi};
  bf16x2_t b = __builtin_convertvector(v, bf16x2_t);
  return __builtin_bit_cast(unsigned, b);
}
DI u16 f2bf(float x) { return (u16)(pk2(x, 0.f) & 0xffffu); }
DI float wave_sum(float v) {
#pragma unroll
  for (int o = 32; o >= 1; o >>= 1) v += __shfl_xor(v, o);
  return v;
}
DI f32x16 mfma32(bf16x8 a, bf16x8 b, f32x16 c) { return __builtin_amdgcn_mfma_f32_32x32x16_bf16(a, b, c, 0, 0, 0); }
DI f32x4 mfma16(bf16x8 a, bf16x8 b, f32x4 c) { return __builtin_amdgcn_mfma_f32_16x16x32_bf16(a, b, c, 0, 0, 0); }
DI int pi_row(int r) { return (r & ~12) | ((r & 4) << 1) | ((r & 8) >> 1); }

DI int rel_bucket(int n) {
  if (n < 16) return n;
  float nf = (float)n;
  int large = 16 + (int)(logf(nf / 16.f) / 2.0794415416798357f * 16.f);
  return large < 31 ? large : 31;
}

DI void tconv_phase(const float* __restrict__ src, u16* __restrict__ dst, int batch, int R, int C, int Cpad, char* smem,
                    int bid, int nb) {
  float* tile = (float*)smem;
  const int tid = opq_tid();
  const int tr = R / 64, tc = Cpad / 64;
  const int ntiles = batch * tr * tc;
  for (int it0 = 0; it0 < ntiles; it0 += nb) {
    const int it = (it0 + bid < ntiles) ? it0 + bid : ntiles - 1;
    const int bi = it / (tr * tc);
    const int rem = it - bi * (tr * tc);
    const int ri = rem / tc, ci = rem - ri * tc;
    const float* s = src + (size_t)bi * R * C;
    u16* d = dst + (size_t)bi * Cpad * R;
    __syncthreads();
#pragma unroll
    for (int k = 0; k < 4; k++) {
      const int r = (tid >> 4) + 16 * k;
      const int cl = (tid & 15) * 4;
      const int cc = ci * 64 + cl;
      f32x4 v = {0.f, 0.f, 0.f, 0.f};
      if (cc < C) v = *(const f32x4*)(s + (size_t)(ri * 64 + r) * C + cc);
      tile[r * 65 + cl + 0] = v[0];
      tile[r * 65 + cl + 1] = v[1];
      tile[r * 65 + cl + 2] = v[2];
      tile[r * 65 + cl + 3] = v[3];
    }
    __syncthreads();
#pragma unroll
    for (int k = 0; k < 2; k++) {
      const int cl = (tid >> 3) + 32 * k;
      const int r8 = (tid & 7) * 8;
      u32x4 o;
      o[0] = pk2(tile[(r8 + 0) * 65 + cl], tile[(r8 + 1) * 65 + cl]);
      o[1] = pk2(tile[(r8 + 2) * 65 + cl], tile[(r8 + 3) * 65 + cl]);
      o[2] = pk2(tile[(r8 + 4) * 65 + cl], tile[(r8 + 5) * 65 + cl]);
      o[3] = pk2(tile[(r8 + 6) * 65 + cl], tile[(r8 + 7) * 65 + cl]);
      *(u32x4*)(d + (size_t)(ci * 64 + cl) * R + ri * 64 + r8) = o;
    }
  }
}

DI void mod_phase(const Params& p, float* mod, char* smem, int bid, int nb) {
  float* sc = (float*)smem;
  float* red = sc + 4096;
  const int tid = opq_tid(), lane = tid & 63, w = __builtin_amdgcn_readfirstlane(tid >> 6);
  __syncthreads();
  for (int i = tid; i < 4096; i += 256) {
    float v = p.c[i];
    sc[i] = v / (1.f + expf(-v));
  }
  __syncthreads();
  for (int it = bid; it < 4 * 384; it += nb) {
    const int l = it / 384, e0 = (it - l * 384) * 16;
    const int ds = lane >> 4, ec = lane & 15;
    const float* wp = p.ada_w + ((size_t)l * 1024 + w * 256 + ds) * 6144 + e0 + ec;
    float a0 = 0, a1 = 0, a2 = 0, a3 = 0;
#pragma unroll 16
    for (int d = 0; d < 64; d++) {
      float wv = wp[(size_t)(4 * d) * 6144];
      int dd = w * 256 + 4 * d + ds;
      a0 += sc[dd] * wv;
      a1 += sc[1024 + dd] * wv;
      a2 += sc[2048 + dd] * wv;
      a3 += sc[3072 + dd] * wv;
    }
    a0 += __shfl_xor(a0, 16); a0 += __shfl_xor(a0, 32);
    a1 += __shfl_xor(a1, 16); a1 += __shfl_xor(a1, 32);
    a2 += __shfl_xor(a2, 16); a2 += __shfl_xor(a2, 32);
    a3 += __shfl_xor(a3, 16); a3 += __shfl_xor(a3, 32);
    if (lane < 16) {
      red[(w * 4 + 0) * 16 + lane] = a0;
      red[(w * 4 + 1) * 16 + lane] = a1;
      red[(w * 4 + 2) * 16 + lane] = a2;
      red[(w * 4 + 3) * 16 + lane] = a3;
    }
    __syncthreads();
    if (tid < 64) {
      const int b = tid >> 4, e = tid & 15;
      float sm = red[(0 * 4 + b) * 16 + e] + red[(1 * 4 + b) * 16 + e] + red[(2 * 4 + b) * 16 + e] + red[(3 * 4 + b) * 16 + e] +
                 p.ada_b[l * 6144 + e0 + e];
      mod[((size_t)l * 4 + b) * 6144 + e0 + e] = sm;
    }
    __syncthreads();
  }
}

DI void h0_phase(const float* __restrict__ x, const float* __restrict__ mod0, u16* __restrict__ h, int bid, int nb) {
  const size_t n8 = (size_t)T * 1024 / 8;
  for (size_t i = (size_t)bid * 256 + opq_tid(); i < n8; i += (size_t)nb * 256) {
    const size_t e = i * 8;
    const int t = (int)(e >> 10), d = (int)(e & 1023), b = t >> 13;
    const float* m = mod0 + (size_t)b * 6144;
    f32x4 v0 = *(const f32x4*)(x + e), v1 = *(const f32x4*)(x + e + 4);
    f32x4 sh0 = *(const f32x4*)(m + d), sh1 = *(const f32x4*)(m + d + 4);
    f32x4 sc0 = *(const f32x4*)(m + 1024 + d), sc1 = *(const f32x4*)(m + 1024 + d + 4);
    v0 = v0 * (1.f + sc0) + sh0;
    v1 = v1 * (1.f + sc1) + sh1;
    u32x4 o;
    o[0] = pk2(v0[0], v0[1]);
    o[1] = pk2(v0[2], v0[3]);
    o[2] = pk2(v1[0], v1[1]);
    o[3] = pk2(v1[2], v1[3]);
    *(u32x4*)(h + e) = o;
  }
}

DI void ln_phase(float* z, const float* __restrict__ g, const float* __restrict__ bt, const float* modn, int sh_off,
                 u16* __restrict__ h, int bid, int nb) {
  const int tid = opq_tid(), lane = tid & 63, w = __builtin_amdgcn_readfirstlane(tid >> 6);
  const int nw = nb * 4;
  for (int row0 = bid * 4 + w; row0 < T; row0 += 4 * nw) {
    f32x4 v[4][4];
#pragma unroll
    for (int rr = 0; rr < 4; rr++) {
      const int row = row0 + rr * nw;
      const f32x4* zp = (const f32x4*)(z + (size_t)(row < T ? row : row0) * 1024);
#pragma unroll
      for (int c = 0; c < 4; c++) v[rr][c] = zp[c * 64 + lane];
    }
#pragma unroll
    for (int rr = 0; rr < 4; rr++) {
      const int row = row0 + rr * nw;
      if (row < T) {
        float s = 0;
#pragma unroll
        for (int c = 0; c < 4; c++) s += v[rr][c][0] + v[rr][c][1] + v[rr][c][2] + v[rr][c][3];
        const float mu = wave_sum(s) * (1.f / 1024.f);
        float q = 0;
#pragma unroll
        for (int c = 0; c < 4; c++) {
          v[rr][c] = v[rr][c] - mu;
          q += v[rr][c][0] * v[rr][c][0] + v[rr][c][1] * v[rr][c][1] + v[rr][c][2] * v[rr][c][2] + v[rr][c][3] * v[rr][c][3];
        }
        const float rstd = rsqrtf(wave_sum(q) * (1.f / 1024.f) + LN_EPS);
        const int b = row >> 13;
        f32x4* zp = (f32x4*)(z + (size_t)row * 1024);
#pragma unroll
        for (int c = 0; c < 4; c++) {
          const int d = c * 256 + lane * 4;
          f32x4 y = v[rr][c] * rstd * *(const f32x4*)(g + d) + *(const f32x4*)(bt + d);
          zp[c * 64 + lane] = y;
          if (modn) {
            const float* m = modn + (size_t)b * 6144 + sh_off;
            f32x4 hv = y * (1.f + *(const f32x4*)(m + 1024 + d)) + *(const f32x4*)(m + d);
            u32x2 o;
            o[0] = pk2(hv[0], hv[1]);
            o[1] = pk2(hv[2], hv[3]);
            *(u32x2*)(h + (size_t)row * 1024 + d) = o;
          }
        }
      }
    }
  }
}

enum { EPI_AIN = 0, EPI_BIN = 1, EPI_RES = 2, EPI_SQRELU = 3 };
struct EpiArgs {
  u16 *o0, *o1, *o2;
  float *f0, *f1;
  const float* xin;
  const float* g;
};

template <int EPI>
DI void epi_store4(const EpiArgs& ea, int row, int col, const float* v, int bidx) {
  if (EPI == EPI_AIN) {
    if (col < 1024) {
      u32x2 o;
      o[0] = pk2(v[0], v[1]);
      o[1] = pk2(v[2], v[3]);
      *(u32x2*)(ea.o0 + (size_t)row * 1024 + col) = o;
    } else if (col < 1280) {
      *(f32x4*)(ea.f0 + (size_t)row * 256 + (col - 1024)) = (f32x4){v[0], v[1], v[2], v[3]};
    } else if (col < 1792) {
      u32x2 o;
      o[0] = pk2(v[0], v[1]);
      o[1] = pk2(v[2], v[3]);
      *(u32x2*)(ea.o1 + (size_t)row * 512 + (col - 1280)) = o;
    } else if (col < 1856) {
      const int d = col - 1792;
      const int sidx = row & 8191;
      const size_t off = (size_t)(row >> 13) * S * 64 +
                         ((size_t)((sidx >> 5) * 4 + (d >> 4)) * 64 + 32 * ((d >> 3) & 1) + (sidx & 31)) * 8 + (d & 7);
      u32x2 o;
      o[0] = pk2(v[0], v[1]);
      o[1] = pk2(v[2], v[3]);
      *(u32x2*)(ea.o2 + off) = o;
    } else if (col < 1864) {
      const float sc = 0.044194173824159216f;
      *(f32x4*)(ea.f1 + (size_t)row * 8 + (col - 1856)) = (f32x4){v[0] * sc, v[1] * sc, v[2] * sc, v[3] * sc};
    }
  } else if (EPI == EPI_BIN) {
    if (col < 1024) {
      const float sc = 0.125f * LOG2E;
      u32x2 o;
      o[0] = pk2(v[0] * sc, v[1] * sc);
      o[1] = pk2(v[2] * sc, v[3] * sc);
      *(u32x2*)(ea.o0 + (size_t)row * 1024 + col) = o;
    } else if (col < 2048) {
      u32x2 o;
      o[0] = pk2(v[0], v[1]);
      o[1] = pk2(v[2], v[3]);
      *(u32x2*)(ea.o1 + (size_t)row * 1024 + (col - 1024)) = o;
    } else {
      const int cv = col - 2048;
#pragma unroll
      for (int q = 0; q < 4; q++) ea.o2[((size_t)bidx * 1024 + cv + q) * 8192 + (row & 8191)] = f2bf(v[q]);
    }
  } else if (EPI == EPI_RES) {
    const f32x4 gg = *(const f32x4*)(ea.g + (size_t)bidx * 6144 + col);
    const size_t o = (size_t)row * 1024 + col;
    const f32x4 xv = *(const f32x4*)(ea.xin + o);
    f32x4 r;
#pragma unroll
    for (int q = 0; q < 4; q++) r[q] = DN_ALPHA * xv[q] + (1.f + gg[q]) * v[q];
    *(f32x4*)(ea.f0 + o) = r;
  } else {
    float r[4];
#pragma unroll
    for (int q = 0; q < 4; q++) {
      r[q] = v[q] > 0.f ? v[q] : 0.f;
      r[q] = r[q] * r[q];
    }
    u32x2 o;
    o[0] = pk2(r[0], r[1]);
    o[1] = pk2(r[2], r[3]);
    *(u32x2*)(ea.o0 + (size_t)row * 4096 + col) = o;
  }
}

template <int EPI>
DI void gemm_phase(const u16* __restrict__ A, const u16* __restrict__ Bt, int M, int N, int K, const EpiArgs& ea,
                   char* smem, int bid, int nb) {
  constexpr int MI = 4, BM = 64 * MI, BN = 256;
  u16* As = (u16*)smem;
  u16* Bs = As + BM * 72;
  const int tid = opq_tid8(), lane = tid & 63, w = __builtin_amdgcn_readfirstlane(tid >> 6), wm = w >> 2, wn = w & 3, l31 = lane & 31, lh = lane >> 5;
  const int ntn = N / BN, ntm = M / BM, nt = ntn * ntm, nk = K / 64;
  const int lr = tid >> 3, lc = (tid & 7) * 8;
  const int xcd = bid & 7, nbx = nb >> 3, cntx = (ntm >> 3) * ntn;
  (void)nt;
  for (int sq = bid >> 3; sq < cntx; sq += nbx) {
    const int tmx = sq / ntn, tn = sq - tmx * ntn;
    const int tm = tmx * 8 + xcd;
    const int m0 = tm * BM, n0 = tn * BN;
    f32x16 acc[MI][2];
#pragma unroll
    for (int i = 0; i < MI; i++)
#pragma unroll
      for (int j = 0; j < 2; j++)
#pragma unroll
        for (int r = 0; r < 16; r++) acc[i][j][r] = 0.f;
    u32x4 ra[4], rb[4];
    const u16* ap = A + (size_t)(m0 + lr) * K + lc;
    const u16* bp = Bt + (size_t)(n0 + lr) * K + lc;
#pragma unroll
    for (int i = 0; i < 4; i++) ra[i] = *(const u32x4*)(ap + (size_t)i * 64 * K);
#pragma unroll
    for (int i = 0; i < 4; i++) rb[i] = *(const u32x4*)(bp + (size_t)i * 64 * K);
    __syncthreads();
#pragma unroll
    for (int i = 0; i < 4; i++) *(u32x4*)&As[(lr + 64 * i) * 72 + lc] = ra[i];
#pragma unroll
    for (int i = 0; i < 4; i++) *(u32x4*)&Bs[(lr + 64 * i) * 72 + lc] = rb[i];
    __syncthreads();
    for (int kt = 0; kt < nk; kt++) {
      if (kt + 1 < nk) {
#pragma unroll
        for (int i = 0; i < 4; i++) ra[i] = *(const u32x4*)(ap + (size_t)i * 64 * K + (kt + 1) * 64);
#pragma unroll
        for (int i = 0; i < 4; i++) rb[i] = *(const u32x4*)(bp + (size_t)i * 64 * K + (kt + 1) * 64);
      }
#pragma unroll
      for (int ks = 0; ks < 4; ks++) {
        bf16x8 af[MI], b0, b1;
#pragma unroll
        for (int i = 0; i < MI; i++) af[i] = *(const bf16x8*)&As[(wm * 32 * MI + 32 * i + l31) * 72 + ks * 16 + lh * 8];
        b0 = *(const bf16x8*)&Bs[(wn * 64 + l31) * 72 + ks * 16 + lh * 8];
        b1 = *(const bf16x8*)&Bs[(wn * 64 + 32 + l31) * 72 + ks * 16 + lh * 8];
#pragma unroll
        for (int i = 0; i < MI; i++) {
          acc[i][0] = mfma32(b0, af[i], acc[i][0]);
          acc[i][1] = mfma32(b1, af[i], acc[i][1]);
        }
      }
      __syncthreads();
      if (kt + 1 < nk) {
#pragma unroll
        for (int i = 0; i < 4; i++) *(u32x4*)&As[(lr + 64 * i) * 72 + lc] = ra[i];
#pragma unroll
        for (int i = 0; i < 4; i++) *(u32x4*)&Bs[(lr + 64 * i) * 72 + lc] = rb[i];
        __syncthreads();
      }
    }
    const int bidx = m0 >> 13;
#pragma unroll
    for (int i = 0; i < MI; i++) {
      const int row = m0 + wm * 32 * MI + 32 * i + l31;
#pragma unroll
      for (int j = 0; j < 2; j++) {
#pragma unroll
        for (int r4 = 0; r4 < 4; r4++) {
          const int col = n0 + wn * 64 + 32 * j + 8 * r4 + 4 * lh;
          float v[4];
#pragma unroll
          for (int q = 0; q < 4; q++) v[q] = acc[i][j][4 * r4 + q];
          epi_store4<EPI>(ea, row, col, v, bidx);
        }
      }
    }
  }
}

DI int g8_lds_byte(int r, int c) {
  int st = (r >> 4) * 2 + (c >> 5), rr = r & 15, cc = c & 31, ob = rr * 64 + cc * 2;
  return st * 1024 + (ob ^ (((ob >> 9) & 1) << 5));
}
DI void g8_stage_rc(int b, int& R, int& C) {
  int st = b / 1024, sb = b % 1024, swz = sb ^ (((sb >> 9) & 1) << 5);
  R = (st >> 1) * 16 + swz / 64;
  C = (st & 1) * 32 + (swz % 64) / 2;
}
typedef __attribute__((address_space(3))) unsigned* lds_u32_ptr;

template <int EPI>
DI void gemm8p_phase(const u16* __restrict__ A, const u16* __restrict__ Bt, int M, int N, int K, const EpiArgs& ea,
                     char* smem, int bid, int nb) {
  constexpr int BK = 64, HALF = 128, HT = HALF * BK;
  u16* shm = (u16*)smem;
  const int tid = opq_tid8(), lane = tid & 63, wid = __builtin_amdgcn_readfirstlane(tid >> 6);
  const int wr = wid >> 2, wc = wid & 3, fr = lane & 15, fq = lane >> 4;
#define G8_SA(b, h) (shm + ((b) * 2 + (h)) * HT)
#define G8_SB(b, h) (shm + (4 + (b) * 2 + (h)) * HT)
  int g8o0, g8o1;
  {
    int r_, c_;
    g8_stage_rc(tid * 16, r_, c_);
    g8o0 = r_ * K + c_;
    g8_stage_rc(tid * 16 + 8192, r_, c_);
    g8o1 = r_ * K + c_;
  }
#define G8_STAGE(P, BASE, br, kt)                                                                                   \
  do {                                                                                                               \
    const u16* _gp = BASE + (size_t)(br) * K + (size_t)(kt) * BK;                                                    \
    asm volatile("" : "+s"(_gp));                \
    __builtin_amdgcn_global_load_lds((const unsigned*)(_gp + (unsigned)g8o0), (lds_u32_ptr)((char*)(P) + tid * 16), 16, 0, 0);        \
    __builtin_amdgcn_global_load_lds((const unsigned*)(_gp + (unsigned)g8o1), (lds_u32_ptr)((char*)(P) + tid * 16 + 8192), 16, 0, 0); \
  } while (0)
  const int g8lane = (fr * 64 + fq * 16) ^ ((fr & 8) << 2);
  const char* g8a = smem + g8lane + wr * 8192;
  const char* g8b = smem + 4 * HT * 2 + g8lane + wc * 4096;
#define G8_LDA(dst, b, h)                                                                                            \
  _Pragma("unroll") for (int m = 0; m < 4; ++m) _Pragma("unroll") for (int k = 0; k < 2; ++k)                        \
      dst[m][k] = *reinterpret_cast<const bf16x8*>(g8a + ((b) * 2 + (h)) * (HT * 2) + m * 2048 + k * 1024)
#define G8_LDB(dst, b, h)                                                                                            \
  _Pragma("unroll") for (int n = 0; n < 2; ++n) _Pragma("unroll") for (int k = 0; k < 2; ++k)                        \
      dst[n][k] = *reinterpret_cast<const bf16x8*>(g8b + ((b) * 2 + (h)) * (HT * 2) + n * 2048 + k * 1024)
#define G8_MMA(ai, bj, At_, Bt_)                                                                                     \
  do {                                                                                                               \
    __builtin_amdgcn_s_setprio(1);                                                                                   \
    _Pragma("unroll") for (int m = 0; m < 4; ++m) _Pragma("unroll") for (int n = 0; n < 2; ++n)                      \
        _Pragma("unroll") for (int k = 0; k < 2; ++k)                                                                \
            acc[ai][bj][m][n] = mfma16(Bt_[n][k], At_[m][k], acc[ai][bj][m][n]);                                     \
    __builtin_amdgcn_s_setprio(0);                                                                                   \
  } while (0)
#define G8_WAIT_V(n) asm volatile("s_waitcnt vmcnt(" #n ")" ::: "memory")
#define G8_WAIT_L(n) asm volatile("s_waitcnt lgkmcnt(" #n ")" ::: "memory")
#define G8_BAR __builtin_amdgcn_s_barrier()
#define G8_SCHED __builtin_amdgcn_sched_barrier(0)
  const int ntn = N / 256, ntm = M / 256, nt = K / BK;
  const int xcd = bid & 7, nbx = nb >> 3, cntx = (ntm >> 3) * ntn;
  for (int sq = bid >> 3; sq < cntx; sq += nbx) {
    const int tmx = sq / ntn, tn = sq - tmx * ntn;
    const int tm = tmx * 8 + xcd;
    const int brow = tm * 256, bcol = tn * 256;
    f32x4 acc[2][2][4][2];
#pragma unroll
    for (int a_ = 0; a_ < 2; a_++)
#pragma unroll
      for (int b_ = 0; b_ < 2; b_++)
#pragma unroll
        for (int m = 0; m < 4; m++)
#pragma unroll
          for (int n = 0; n < 2; n++) acc[a_][b_][m][n] = (f32x4){0.f, 0.f, 0.f, 0.f};
    bf16x8 At[4][2], B0[2][2], B1[2][2];
    asm volatile("s_waitcnt vmcnt(0) lgkmcnt(0)" ::: "memory");
    __syncthreads();
    G8_STAGE(G8_SB(0, 0), Bt, bcol, 0); G8_STAGE(G8_SA(0, 0), A, brow, 0);
    G8_STAGE(G8_SB(0, 1), Bt, bcol + HALF, 0); G8_STAGE(G8_SA(0, 1), A, brow + HALF, 0);
    if (wr == 1) G8_BAR;
    G8_WAIT_V(4); G8_BAR;
    G8_STAGE(G8_SB(1, 0), Bt, bcol, 1); G8_STAGE(G8_SA(1, 0), A, brow, 1); G8_STAGE(G8_SB(1, 1), Bt, bcol + HALF, 1);
    G8_WAIT_V(6); G8_BAR;
    for (int t = 0; t < nt - 2; t += 2) {
      G8_LDB(B0, 0, 0); G8_SCHED; G8_LDA(At, 0, 0); G8_STAGE(G8_SA(1, 1), A, brow + HALF, t + 1);
      G8_WAIT_L(8); G8_BAR; G8_WAIT_L(0); G8_MMA(0, 0, At, B0); G8_BAR; G8_SCHED;
      G8_LDB(B1, 0, 1); G8_STAGE(G8_SB(0, 0), Bt, bcol, t + 2);
      G8_BAR; G8_WAIT_L(0); G8_MMA(0, 1, At, B1); G8_BAR;
      G8_LDA(At, 0, 1); G8_STAGE(G8_SA(0, 0), A, brow, t + 2);
      G8_BAR; G8_WAIT_L(0); G8_MMA(1, 0, At, B0); G8_BAR; G8_SCHED;
      G8_STAGE(G8_SB(0, 1), Bt, bcol + HALF, t + 2);
      G8_WAIT_V(6); G8_BAR; G8_MMA(1, 1, At, B1); G8_BAR;
      G8_LDB(B0, 1, 0); G8_SCHED; G8_LDA(At, 1, 0); G8_STAGE(G8_SA(0, 1), A, brow + HALF, t + 2);
      G8_WAIT_L(8); G8_BAR; G8_WAIT_L(0); G8_MMA(0, 0, At, B0); G8_BAR; G8_SCHED;
      G8_LDB(B1, 1, 1); G8_STAGE(G8_SB(1, 0), Bt, bcol, t + 3);
      G8_BAR; G8_WAIT_L(0); G8_MMA(0, 1, At, B1); G8_BAR;
      G8_LDA(At, 1, 1); G8_STAGE(G8_SA(1, 0), A, brow, t + 3);
      G8_BAR; G8_WAIT_L(0); G8_MMA(1, 0, At, B0); G8_BAR; G8_SCHED;
      G8_STAGE(G8_SB(1, 1), Bt, bcol + HALF, t + 3);
      G8_WAIT_V(6); G8_BAR; G8_MMA(1, 1, At, B1); G8_BAR;
    }
    {
      G8_LDB(B0, 0, 0); G8_LDA(At, 0, 0); G8_STAGE(G8_SA(1, 1), A, brow + HALF, nt - 1);
      G8_BAR; G8_WAIT_L(0); G8_MMA(0, 0, At, B0); G8_BAR;
      G8_LDB(B1, 0, 1); G8_BAR; G8_WAIT_L(0); G8_MMA(0, 1, At, B1); G8_BAR;
      G8_LDA(At, 0, 1); G8_WAIT_V(4); G8_BAR; G8_WAIT_L(0); G8_MMA(1, 0, At, B0); G8_MMA(1, 1, At, B1); G8_BAR;
    }
    {
      G8_LDB(B0, 1, 0); G8_LDA(At, 1, 0); G8_WAIT_V(2); G8_BAR; G8_WAIT_L(0); G8_MMA(0, 0, At, B0); G8_BAR;
      G8_LDB(B1, 1, 1); G8_WAIT_V(0); G8_BAR; G8_WAIT_L(0); G8_MMA(0, 1, At, B1); G8_BAR;
      G8_LDA(At, 1, 1); G8_BAR; G8_WAIT_L(0); G8_MMA(1, 0, At, B0); G8_MMA(1, 1, At, B1); G8_BAR;
    }
    if (wr == 0) G8_BAR;
    const int bidx = brow >> 13;
#pragma unroll
    for (int ai = 0; ai < 2; ai++)
#pragma unroll
      for (int m = 0; m < 4; m++) {
        const int row = brow + ai * HALF + wr * 64 + m * 16 + fr;
#pragma unroll
        for (int bj = 0; bj < 2; bj++)
#pragma unroll
          for (int n = 0; n < 2; n++) {
            const int col = bcol + bj * HALF + wc * 32 + n * 16 + fq * 4;
            float v[4];
#pragma unroll
            for (int q = 0; q < 4; q++) v[q] = acc[ai][bj][m][n][q];
            epi_store4<EPI>(ea, row, col, v, bidx);
          }
      }
  }
#undef G8_SA
#undef G8_SB
#undef G8_STAGE
#undef G8_LDA
#undef G8_LDB
#undef G8_MMA
#undef G8_WAIT_V
#undef G8_WAIT_L
#undef G8_BAR
#undef G8_SCHED
}

DI void ckvnorm_phase(const float* __restrict__ raw, const float* __restrict__ g, u16* __restrict__ outp, int bid,
                      int nb) {
  const int tid = opq_tid(), lane = tid & 63, w = __builtin_amdgcn_readfirstlane(tid >> 6);
  const f32x4 gg = *(const f32x4*)(g + lane * 4);
  for (int row = bid * 4 + w; row < T; row += nb * 4) {
    f32x4 v = *(const f32x4*)(raw + (size_t)row * 256 + lane * 4);
    float ss = v[0] * v[0] + v[1] * v[1] + v[2] * v[2] + v[3] * v[3];
    ss = wave_sum(ss);
    const float r = rsqrtf(ss * (1.f / 256.f) + LN_EPS);
    u32x2 o;
    o[0] = pk2(v[0] * r * gg[0], v[1] * r * gg[1]);
    o[1] = pk2(v[2] * r * gg[2], v[3] * r * gg[3]);
    *(u32x2*)(outp + (size_t)row * 256 + lane * 4) = o;
  }
}

DI unsigned mono_key(float s) {
  unsigned u = __float_as_uint(s);
  return (u & 0x80000000u) ? ~u : (u | 0x80000000u);
}
DI float mono_inv(unsigned k) {
  unsigned u = (k & 0x80000000u) ? (k & 0x7fffffffu) : ~k;
  return __uint_as_float(u);
}
DI float relu_i(float x) {
  int i = __float_as_int(x);
  return __int_as_float(i > 0 ? i : 0);
}
DI int wcount(bool f) { return __popcll(__ballot(f)); }

template <bool EXACT>
DI void compact4(float* vals, u16* idxs, int* cnt, int lane, float* thr_out) {
  constexpr int NPL = CAP / 64;
  unsigned key[4][NPL];
  int n[4];
#pragma unroll
  for (int q = 0; q < 4; q++) n[q] = cnt[q];
#pragma unroll
  for (int q = 0; q < 4; q++)
#pragma unroll
    for (int j = 0; j < NPL; j++) {
      const int e = j * 64 + lane;
      key[q][j] = (e < n[q]) ? mono_key(vals[q * CAP + e]) : 0u;
    }
  unsigned Tk[4] = {0u, 0u, 0u, 0u};
  constexpr int LOWBIT = EXACT ? 0 : 18;
#pragma unroll 1
  for (int bit = 31; bit >= LOWBIT; bit--) {
#pragma unroll
    for (int q = 0; q < 4; q++) {
      const unsigned cand = Tk[q] | (1u << bit);
      int c = 0;
#pragma unroll
      for (int j = 0; j < NPL; j++) c += wcount(key[q][j] >= cand);
      Tk[q] = (c >= TOPK) ? cand : Tk[q];
      if (q == 1) __builtin_amdgcn_sched_barrier(0);
    }
  }
  unsigned I[4] = {0xffffu, 0xffffu, 0xffffu, 0xffffu};
  if (EXACT) {
    unsigned ix[4][NPL];
    int need[4];
#pragma unroll
    for (int q = 0; q < 4; q++) {
      int cgt = 0;
#pragma unroll
      for (int j = 0; j < NPL; j++) {
        const int e = j * 64 + lane;
        ix[q][j] = (e < n[q]) ? (unsigned)idxs[q * CAP + e] : 0xffffu;
        cgt += wcount(key[q][j] > Tk[q]);
      }
      need[q] = TOPK - cgt;
      I[q] = 0u;
    }
#pragma unroll 1
    for (int bit = 13; bit >= 0; bit--) {
#pragma unroll
      for (int q = 0; q < 4; q++) {
        const unsigned cand = I[q] | (1u << bit);
        int c = 0;
#pragma unroll
        for (int j = 0; j < NPL; j++) c += wcount(key[q][j] == Tk[q] && ix[q][j] < cand);
        I[q] = (c < need[q]) ? cand : I[q];
        if (q == 1) __builtin_amdgcn_sched_barrier(0);
      }
    }
  }
  const unsigned long long lt = (1ull << lane) - 1ull;
#pragma unroll
  for (int q = 0; q < 4; q++) {
    if (n[q] > TOPK) {
      int base = 0;
#pragma unroll
      for (int j = 0; j < NPL; j++) {
        const int e = j * 64 + lane;
        const bool in = e < n[q];
        const float v = in ? vals[q * CAP + e] : 0.f;
        const unsigned ixv = in ? (unsigned)idxs[q * CAP + e] : 0xffffu;
        const bool keep = (key[q][j] > Tk[q]) || (key[q][j] == Tk[q] && ixv <= I[q]);
        const unsigned long long m = __ballot(keep);
        if (keep) {
          const int pos = base + __popcll(m & lt);
          vals[q * CAP + pos] = v;
          idxs[q * CAP + pos] = (u16)ixv;
        }
        base += __popcll(m);
      }
      if (lane == 0) cnt[q] = base;
      thr_out[q] = mono_inv(Tk[q]);
    }
  }
}

DI void indexer_phase(const u16* __restrict__ iq, const u16* __restrict__ ik, const float* __restrict__ iw,
                      u16* __restrict__ sel, char* smem, int bid, int nb) {
  constexpr int WBYTES = 4 * CAP * 4 + 4 * CAP * 2 + 64;
  const int tid = opq_tid(), lane = tid & 63, w = __builtin_amdgcn_readfirstlane(tid >> 6), l31 = lane & 31, u = lane >> 5;
  float* vals = (float*)(smem + w * WBYTES);
  u16* idxs = (u16*)(smem + w * WBYTES + 4 * CAP * 4);
  int* cnt = (int*)(smem + w * WBYTES + 4 * CAP * 4 + 4 * CAP * 2);
  const int nitems = NBATCH * (S / 16);
  const int nrounds = (nitems + nb - 1) / nb;
  __syncthreads();
  for (int rd = 0; rd < nrounds; rd++) {
    const int it = rd * nb + ((rd & 1) ? (nb - 1 - bid) : bid);
    if (it >= nitems) continue;
    const int b = it & 3, qg = (S / 16 - 1) - (it >> 2);
    const int t0 = qg * 16;
    const int tw = t0 + 4 * w;
    const size_t tb = (size_t)b * S;
    bf16x8 aq[4];
    {
      const int g = l31 >> 3, up = (l31 >> 2) & 1, j = l31 & 3;
      const int ql = 2 * up + (g >> 1), hd = 4 * (g & 1) + j;
      const u16* qp = iq + (tb + tw + ql) * 512 + hd * 64 + u * 8;
#pragma unroll
      for (int ks = 0; ks < 4; ks++) aq[ks] = *(const bf16x8*)(qp + ks * 16);
    }
    float wq[2][8];
#pragma unroll
    for (int qq = 0; qq < 2; qq++) {
      const float* wp = iw + (tb + tw + 2 * u + qq) * 8;
      f32x4 w0 = *(const f32x4*)wp, w1 = *(const f32x4*)(wp + 4);
#pragma unroll
      for (int h = 0; h < 4; h++) {
        wq[qq][h] = w0[h];
        wq[qq][4 + h] = w1[h];
      }
    }
    float thr[2] = {-INFINITY, -INFINITY};
    __builtin_amdgcn_wave_barrier();
    if (lane < 4) cnt[lane] = 0;
    __builtin_amdgcn_wave_barrier();
    const int nkb = (tw + 3) / 32 + 1;
    const u16* kp = ik + tb * 64 + lane * 8;
    bf16x8 ring[4][4];
#pragma unroll
    for (int i = 0; i < 4; i++) {
      const int kbn = (i < nkb) ? i : nkb - 1;
#pragma unroll
      for (int ks = 0; ks < 4; ks++) ring[i][ks] = *(const bf16x8*)(kp + (size_t)(kbn * 4 + ks) * 512);
    }
#pragma unroll 1
    for (int kb0 = 0; kb0 < nkb; kb0 += 4) {
#pragma unroll
      for (int i = 0; i < 4; i++) {
        const int kb = kb0 + i;
        {
          f32x16 acc;
#pragma unroll
          for (int r = 0; r < 16; r++) acc[r] = 0.f;
#pragma unroll
          for (int ks = 0; ks < 4; ks++) acc = mfma32(aq[ks], ring[i][ks], acc);
          {
            const int kbn = (kb + 4 < nkb) ? kb + 4 : nkb - 1;
#pragma unroll
            for (int ks = 0; ks < 4; ks++) ring[i][ks] = *(const bf16x8*)(kp + (size_t)(kbn * 4 + ks) * 512);
          }
          const int key = kb * 32 + l31;
#pragma unroll
          for (int qq = 0; qq < 2; qq++) {
            float s0 = 0.f, s1 = 0.f;
#pragma unroll
            for (int h = 0; h < 8; h += 2) {
              s0 = fmaf(wq[qq][h], relu_i(acc[8 * qq + h]), s0);
              s1 = fmaf(wq[qq][h + 1], relu_i(acc[8 * qq + h + 1]), s1);
            }
            float s = s0 + s1;
            s += 0.0f;
            const int tq = tw + 2 * u + qq;
            if (key <= tq && s >= thr[qq]) {
              const int qs = 2 * u + qq;
              const int pos = atomicAdd(&cnt[qs], 1);
              vals[qs * CAP + pos] = s;
              idxs[qs * CAP + pos] = (u16)key;
            }
          }
        }
      }
      __builtin_amdgcn_wave_barrier();
      const int c0 = cnt[0], c1 = cnt[1], c2 = cnt[2], c3 = cnt[3];
      if (c0 > CAP - 128 || c1 > CAP - 128 || c2 > CAP - 128 || c3 > CAP - 128) {
        float to[4] = {0.f, 0.f, 0.f, 0.f};
        compact4<false>(vals, idxs, cnt, lane, to);
        __builtin_amdgcn_wave_barrier();
        const int d0 = cnt[0], d1 = cnt[1], d2 = cnt[2], d3 = cnt[3];
        if (d0 > CAP - 256 || d1 > CAP - 256 || d2 > CAP - 256 || d3 > CAP - 256) {
          compact4<true>(vals, idxs, cnt, lane, to);
          __builtin_amdgcn_wave_barrier();
        }
        if (c0 > TOPK && u == 0) thr[0] = to[0];
        if (c1 > TOPK && u == 0) thr[1] = to[1];
        if (c2 > TOPK && u == 1) thr[0] = to[2];
        if (c3 > TOPK && u == 1) thr[1] = to[3];
      }
    }
    {
      const int c0 = cnt[0], c1 = cnt[1], c2 = cnt[2], c3 = cnt[3];
      if (c0 > TOPK || c1 > TOPK || c2 > TOPK || c3 > TOPK) {
        float to[4];
        compact4<true>(vals, idxs, cnt, lane, to);
        __builtin_amdgcn_wave_barrier();
      }
    }
#pragma unroll 1
    for (int qs = 0; qs < 4; qs++) {
      const int n = cnt[qs];
      u16* sp = sel + (tb + tw + qs) * 256;
#pragma unroll
      for (int j = 0; j < 4; j++) {
        const int e = j * 64 + lane;
        sp[e] = (e < n) ? idxs[qs * CAP + e] : (u16)0xffffu;
      }
    }
  }
}

DI void sparse_phase(const u16* __restrict__ q, const u16* __restrict__ ckvn, const u16* __restrict__ sel,
                     const u16* __restrict__ wuk, const u16* __restrict__ wuv, const float* __restrict__ rel_bias,
                     u16* scratch, u16* __restrict__ o, char* smem, int bid, int nb) {
  constexpr int GS = 264;
  const int tid = opq_tid(), lane = tid & 63, w = __builtin_amdgcn_readfirstlane(tid >> 6), l15 = lane & 15, g = lane >> 4;
  u16* G = (u16*)smem + (size_t)w * 32 * GS;
  int* lut = (int*)(smem + 4 * 32 * GS * 2);
  float* rb = (float*)(lut + 128);
  __syncthreads();
  if (tid < 128) lut[tid] = rel_bucket(tid);
  for (int i = tid; i < 512; i += 256) rb[i] = rel_bias[i] * LOG2E;
  __syncthreads();
  u16* ql = scratch + (size_t)bid * (16 * 16 * 256);
  const int nitems = NBATCH * (S / 16);
  for (int it = bid; it < nitems; it += nb) {
    const int b = it & 3, qg = it >> 2;
    const int t0 = qg * 16;
    const size_t tb = (size_t)b * S;
    for (int hh = 0; hh < 4; hh++) {
      const int h = 4 * w + hh;
      bf16x8 bq[2];
#pragma unroll
      for (int ks = 0; ks < 2; ks++) bq[ks] = *(const bf16x8*)(q + (tb + t0 + l15) * 1024 + h * 64 + ks * 32 + g * 8);
#pragma unroll 4
      for (int rt = 0; rt < 16; rt++) {
        f32x4 acc = {0.f, 0.f, 0.f, 0.f};
#pragma unroll
        for (int ks = 0; ks < 2; ks++) {
          bf16x8 a = *(const bf16x8*)(wuk + ((size_t)h * 256 + rt * 16 + l15) * 64 + ks * 32 + g * 8);
          acc = mfma16(a, bq[ks], acc);
        }
        u32x2 ov;
        ov[0] = pk2(acc[0] * (0.125f * LOG2E), acc[1] * (0.125f * LOG2E));
        ov[1] = pk2(acc[2] * (0.125f * LOG2E), acc[3] * (0.125f * LOG2E));
        *(u32x2*)(ql + ((size_t)l15 * 16 + h) * 256 + rt * 16 + 4 * g) = ov;
      }
    }
    __syncthreads();
    {
      const u16* selw = sel + (tb + t0 + 4 * w) * 256;
      const int l31 = lane & 31;
      const int q4 = l15 >> 2, p4 = l15 & 3;
      const u16* ckb = ckvn + tb * 256;
      int idx_c = selw[l31];
      int idx_n = selw[32 + l31];
      u32x4 gr[16];
#pragma unroll
      for (int i = 0; i < 16; i++) {
        int id = __shfl(idx_c, (lane >> 5) + 2 * i);
        id = (id == 0xffff) ? 0 : id;
        gr[i] = *(const u32x4*)(ckb + (unsigned)(id * 256 + l31 * 8));
      }
      bf16x8 qb[8];
      float m_run = NEGF, l_run = 0.f;
      f32x4 O[16];
#pragma unroll 1
      for (int st = 0; st < 32; st++) {
        const int qi = st >> 3, ch = st & 7;
        const int qloc = 4 * w + qi;
        const int t = t0 + qloc;
        if (ch == 0) {
#pragma unroll
          for (int ks = 0; ks < 8; ks++) qb[ks] = *(const bf16x8*)(ql + ((size_t)qloc * 16 + l15) * 256 + ks * 32 + g * 8);
          m_run = NEGF;
          l_run = 0.f;
#pragma unroll
          for (int rt = 0; rt < 16; rt++) O[rt] = (f32x4){0.f, 0.f, 0.f, 0.f};
        }
#pragma unroll
        for (int i = 0; i < 16; i++) *(u32x4*)&G[((lane >> 5) + 2 * i) * GS + l31 * 8] = gr[i];
        __builtin_amdgcn_wave_barrier();
        const int stn2 = (st + 2 < 32) ? st + 2 : 31;
        const int idx_nn = selw[stn2 * 32 + l31];
#pragma unroll
        for (int i = 0; i < 16; i++) {
          int id = __shfl(idx_n, (lane >> 5) + 2 * i);
          id = (id == 0xffff) ? 0 : id;
          gr[i] = *(const u32x4*)(ckb + (unsigned)(id * 256 + l31 * 8));
        }
        float lg[2][4];
#pragma unroll
        for (int kbk = 0; kbk < 2; kbk++) {
          f32x4 acc = {0.f, 0.f, 0.f, 0.f};
#pragma unroll
          for (int ks = 0; ks < 8; ks++) {
            bf16x8 a = *(const bf16x8*)&G[(16 * kbk + l15) * GS + ks * 32 + g * 8];
            acc = mfma16(a, qb[ks], acc);
            if (ks == 3) asm volatile("" ::: "memory");
          }
          asm volatile("" ::: "memory");
#pragma unroll
          for (int i = 0; i < 4; i++) {
            const int kid = __shfl(idx_c, 16 * kbk + 4 * g + i);
            float v = NEGF;
            if (kid != 0xffff) {
              int n = t - kid;
              n = n < 0 ? 0 : n;
              const int bk = n < 128 ? lut[n] : 31;
              v = acc[i] + rb[bk * 16 + l15];
            }
            lg[kbk][i] = v;
          }
        }
        float mx = fmaxf(fmaxf(fmaxf(lg[0][0], lg[0][1]), fmaxf(lg[0][2], lg[0][3])),
                         fmaxf(fmaxf(lg[1][0], lg[1][1]), fmaxf(lg[1][2], lg[1][3])));
        mx = fmaxf(mx, __shfl_xor(mx, 16));
        mx = fmaxf(mx, __shfl_xor(mx, 32));
        const float m_new = fmaxf(m_run, mx);
        const float scl = __builtin_amdgcn_exp2f(m_run - m_new);
        m_run = m_new;
        float ps = 0.f;
        float pe[8];
#pragma unroll
        for (int kbk = 0; kbk < 2; kbk++)
#pragma unroll
          for (int i = 0; i < 4; i++) {
            const float pv = __builtin_amdgcn_exp2f(lg[kbk][i] - m_new);
            pe[kbk * 4 + i] = pv;
            ps += pv;
          }
        l_run = l_run * scl + ps;
        u32x4 pw;
        pw[0] = pk2(pe[0], pe[1]);
        pw[1] = pk2(pe[2], pe[3]);
        pw[2] = pk2(pe[4], pe[5]);
        pw[3] = pk2(pe[6], pe[7]);
        const bf16x8 pB = __builtin_bit_cast(bf16x8, pw);
        if (__ballot(scl != 1.f)) {
#pragma unroll
          for (int rt = 0; rt < 16; rt++) O[rt] = O[rt] * scl;
        }
#pragma unroll
        for (int rt = 0; rt < 16; rt++) {
          const s16x4 lo = __builtin_amdgcn_ds_read_tr16_b64_v4i16((lds_s16x4_ptr)(&G[(4 * g + q4) * GS + rt * 16 + 4 * p4]));
          const s16x4 hi = __builtin_amdgcn_ds_read_tr16_b64_v4i16((lds_s16x4_ptr)(&G[(16 + 4 * g + q4) * GS + rt * 16 + 4 * p4]));
          const bf16x8 a = (bf16x8){lo[0], lo[1], lo[2], lo[3], hi[0], hi[1], hi[2], hi[3]};
          O[rt] = mfma16(a, pB, O[rt]);
          if ((rt & 3) == 3) asm volatile("" ::: "memory");
        }
        __builtin_amdgcn_wave_barrier();
        if (ch == 7) {
          float lt = l_run;
          lt += __shfl_xor(lt, 16);
          lt += __shfl_xor(lt, 32);
          const float inv = 1.f / lt;
#pragma unroll
          for (int rt = 0; rt < 16; rt++) {
            u32x2 ov;
            ov[0] = pk2(O[rt][0] * inv, O[rt][1] * inv);
            ov[1] = pk2(O[rt][2] * inv, O[rt][3] * inv);
            *(u32x2*)(ql + ((size_t)qloc * 16 + l15) * 256 + rt * 16 + 4 * g) = ov;
          }
        }
        idx_c = idx_n;
        idx_n = idx_nn;
      }
    }
    __syncthreads();
    for (int hh = 0; hh < 4; hh++) {
      const int h = 4 * w + hh;
      bf16x8 bo[8];
#pragma unroll
      for (int ks = 0; ks < 8; ks++) bo[ks] = *(const bf16x8*)(ql + ((size_t)l15 * 16 + h) * 256 + ks * 32 + g * 8);
#pragma unroll
      for (int et = 0; et < 4; et++) {
        f32x4 acc = {0.f, 0.f, 0.f, 0.f};
#pragma unroll
        for (int ks = 0; ks < 8; ks++) {
          bf16x8 a = *(const bf16x8*)(wuv + ((size_t)h * 64 + et * 16 + l15) * 256 + ks * 32 + g * 8);
          acc = mfma16(a, bo[ks], acc);
        }
        u32x2 ov;
        ov[0] = pk2(acc[0], acc[1]);
        ov[1] = pk2(acc[2], acc[3]);
        *(u32x2*)(o + (tb + t0 + l15) * 1024 + h * 64 + et * 16 + 4 * g) = ov;
      }
    }
    __syncthreads();
  }
}

DI void diffattn_phase(const u16* __restrict__ q, const u16* __restrict__ k, const u16* __restrict__ vT,
                       u16* __restrict__ o, const float* __restrict__ rel_bias, const float* __restrict__ lam,
                       const float* __restrict__ subln, int layer_idx, char* smem, int bid, int nb) {
  constexpr int KS = 136, VS = 72;
  u16* Ks = (u16*)smem;
  u16* Vs = Ks + 64 * KS;
  float* exch = (float*)smem;
  constexpr int STG = 64 * KS + 128 * VS;
  float* btab = (float*)(smem + 72 * 1024);
  int* lut = (int*)(smem + 72 * 1024 + 1040);
  float* misc = (float*)(smem + 72 * 1024 + 1040 + 512);
  const int tid = opq_tid8(), lane = tid & 63, w = __builtin_amdgcn_readfirstlane(tid >> 6), l31 = lane & 31, lh = lane >> 5;
  const int qsub = w >> 1, m = w & 1;
  const float lam_init = 0.8f - 0.6f * expf(-0.3f * (float)layer_idx);
  __syncthreads();
  if (tid < 128) lut[tid] = rel_bucket(tid);
  if (w == 0) {
    float p1 = lam[lane] * lam[64 + lane], p2 = lam[128 + lane] * lam[192 + lane];
    p1 = wave_sum(p1);
    p2 = wave_sum(p2);
    if (lane == 0) misc[0] = expf(p1) - expf(p2) + lam_init;
  }
  __syncthreads();
  const float lam_full = misc[0];
  const int xcd = bid & 7, loc = bid >> 3, nbx = nb >> 3;
  const int rph = (S / 128) / nbx;
  const int prow = pi_row(l31);
  for (int rd = 0; rd < 4 * rph; rd++) {
    const int hh = rd / rph, r = rd - hh * rph;
    const int bh = xcd + 8 * hh;
    const int kk = r >> 1;
    const int qb = (r & 1) ? (kk * nbx + loc) : ((S / 128 - 1) - kk * nbx - loc);
    const int b = bh >> 3, h = bh & 7;
    const int q0 = qb * 128, tq0 = q0 + 32 * qsub, t = tq0 + l31;
    const size_t tb = (size_t)b * S;
    __syncthreads();
    for (int i = tid; i < 258; i += 512) {
      const int n = i >> 1, mm = i & 1;
      const int bk = n < 128 ? lut[n] : 31;
      btab[i] = rel_bias[bk * 16 + 2 * h + mm] * LOG2E;
    }
    bf16x8 qf[4];
#pragma unroll
    for (int ks = 0; ks < 4; ks++) qf[ks] = *(const bf16x8*)(q + (tb + t) * 1024 + h * 128 + m * 64 + ks * 16 + lh * 8);
    f32x16 O[4];
#pragma unroll
    for (int et = 0; et < 4; et++)
#pragma unroll
      for (int r = 0; r < 16; r++) O[et][r] = 0.f;
    float m_run = NEGF, l_run = 0.f;
    const int nkt = 2 * qb + 2;
    u32x4 rk[2], rv[2];
    const u16* kp = k + tb * 1024 + h * 128;
    const u16* vp = vT + ((size_t)(b * 8 + h) * 128) * 8192;
#pragma unroll
    for (int i = 0; i < 2; i++) {
      const int id = tid + 512 * i;
      rk[i] = *(const u32x4*)(kp + (size_t)(id >> 4) * 1024 + (id & 15) * 8);
      rv[i] = *(const u32x4*)(vp + (size_t)(id >> 3) * 8192 + (id & 7) * 8);
    }
#pragma unroll
    for (int i = 0; i < 2; i++) {
      const int id = tid + 512 * i;
      *(u32x4*)&Ks[(id >> 4) * KS + (id & 15) * 8] = rk[i];
      *(u32x4*)&Vs[(id >> 3) * VS + (id & 7) * 8] = rv[i];
    }
#pragma unroll
    for (int i = 0; i < 2; i++) {
      const int id = tid + 512 * i;
      rk[i] = *(const u32x4*)(kp + (size_t)(64 + (id >> 4)) * 1024 + (id & 15) * 8);
      rv[i] = *(const u32x4*)(vp + (size_t)(id >> 3) * 8192 + 64 + (id & 7) * 8);
    }
    __syncthreads();
    const float cfar = btab[256 + m];
    for (int kt = 0; kt < nkt; kt++) {
      const u16* Ksc = Ks + (kt & 1) * STG;
      const u16* Vsc = Vs + (kt & 1) * STG;
      if (kt + 1 < nkt) {
        u16* Ksn = Ks + ((kt & 1) ^ 1) * STG;
        u16* Vsn = Vs + ((kt & 1) ^ 1) * STG;
#pragma unroll
        for (int i = 0; i < 2; i++) {
          const int id = tid + 512 * i;
          *(u32x4*)&Ksn[(id >> 4) * KS + (id & 15) * 8] = rk[i];
          *(u32x4*)&Vsn[(id >> 3) * VS + (id & 7) * 8] = rv[i];
        }
        const int k2 = (kt + 2 < nkt) ? kt + 2 : nkt - 1;
#pragma unroll
        for (int i = 0; i < 2; i++) {
          const int id = tid + 512 * i;
          rk[i] = *(const u32x4*)(kp + (size_t)(k2 * 64 + (id >> 4)) * 1024 + (id & 15) * 8);
          rv[i] = *(const u32x4*)(vp + (size_t)(id >> 3) * 8192 + k2 * 64 + (id & 7) * 8);
        }
      }
      const int s_tile = kt * 64;
      const int remk = tq0 + 31 - s_tile;
      const int nblk = remk < 0 ? 0 : (remk >= 32 ? 2 : 1);
#pragma unroll 1
      for (int kb = 0; kb < nblk; kb++) {
        const int s0 = s_tile + 32 * kb;
        const bool nearb = (tq0 - (s0 + 31)) < 128;
        const bool first = (kt == 0) && (kb == 0);
        const float mref = first ? 0.f : m_run;
        const float cinit = nearb ? -mref : (cfar - mref);
        f32x16 acc;
#pragma unroll
        for (int r = 0; r < 16; r++) acc[r] = cinit;
#pragma unroll
        for (int ks = 0; ks < 4; ks++) {
          bf16x8 a = *(const bf16x8*)&Ksc[(32 * kb + prow) * KS + m * 64 + ks * 16 + lh * 8];
          acc = mfma32(a, qf[ks], acc);
        }
        bf16x8 vfa[4];
#pragma unroll
        for (int et = 0; et < 4; et++) vfa[et] = *(const bf16x8*)&Vsc[(32 * et + l31) * VS + 32 * kb + 8 * lh];
        __builtin_amdgcn_sched_barrier(0);
        if (nearb) {
#pragma unroll
          for (int r = 0; r < 16; r++) {
            const int key = s0 + 16 * (r >> 3) + 8 * lh + (r & 7);
            const int n = t - key;
            const int nc = n < 0 ? 0 : (n > 128 ? 128 : n);
            const float bv = btab[nc * 2 + m];
            acc[r] = (n < 0) ? NEGF : acc[r] + bv;
          }
        }
        float mx = acc[0];
#pragma unroll
        for (int r = 1; r < 16; r++) mx = fmaxf(mx, acc[r]);
        mx = fmaxf(mx, __shfl_xor(mx, 32));
        if (first || __ballot(mx > 8.f)) {
          const float dlt = first ? mx : fmaxf(mx, 0.f);
          const float scl = __builtin_amdgcn_exp2f(-dlt);
#pragma unroll
          for (int r = 0; r < 16; r++) acc[r] -= dlt;
#pragma unroll
          for (int et = 0; et < 4; et++)
#pragma unroll
            for (int r = 0; r < 16; r++) O[et][r] *= scl;
          l_run *= scl;
          m_run = mref + dlt;
        }
        float ps = 0.f;
#pragma unroll
        for (int r = 0; r < 16; r++) {
          const float pv = __builtin_amdgcn_exp2f(acc[r]);
          acc[r] = pv;
          ps += pv;
        }
        l_run += ps;
        bf16x8 vfb[4];
#pragma unroll
        for (int et = 0; et < 4; et++) vfb[et] = *(const bf16x8*)&Vsc[(32 * et + l31) * VS + 32 * kb + 16 + 8 * lh];
        u32x4 pw0, pw1;
        pw0[0] = pk2(acc[0], acc[1]);
        pw0[1] = pk2(acc[2], acc[3]);
        pw0[2] = pk2(acc[4], acc[5]);
        pw0[3] = pk2(acc[6], acc[7]);
        pw1[0] = pk2(acc[8], acc[9]);
        pw1[1] = pk2(acc[10], acc[11]);
        pw1[2] = pk2(acc[12], acc[13]);
        pw1[3] = pk2(acc[14], acc[15]);
        const bf16x8 pB0 = __builtin_bit_cast(bf16x8, pw0), pB1 = __builtin_bit_cast(bf16x8, pw1);
        __builtin_amdgcn_sched_barrier(0);
#pragma unroll
        for (int et = 0; et < 4; et++) O[et] = mfma32(vfa[et], pB0, O[et]);
#pragma unroll
        for (int et = 0; et < 4; et++) O[et] = mfma32(vfb[et], pB1, O[et]);
      }
      __syncthreads();
    }
    float lt = l_run + __shfl_xor(l_run, 32);
    const float inv = 1.f / lt;
    if (m == 1) {
#pragma unroll
      for (int et = 0; et < 4; et++)
#pragma unroll
        for (int r = 0; r < 16; r++) {
          const int e = 32 * et + (r & 3) + 8 * (r >> 2) + 4 * lh;
          exch[(qsub * 128 + e) * 32 + l31] = O[et][r] * inv;
        }
    }
    __syncthreads();
    if (m == 0) {
      float ss = 0.f;
#pragma unroll
      for (int et = 0; et < 4; et++)
#pragma unroll
        for (int r = 0; r < 16; r++) {
          const int e = 32 * et + (r & 3) + 8 * (r >> 2) + 4 * lh;
          const float v = O[et][r] * inv - lam_full * exch[(qsub * 128 + e) * 32 + l31];
          O[et][r] = v;
          ss += v * v;
        }
      ss += __shfl_xor(ss, 32);
      const float rs = rsqrtf(ss * (1.f / 128.f) + LN_EPS);
      const float osc = 1.f - lam_init;
#pragma unroll
      for (int et = 0; et < 4; et++)
#pragma unroll
        for (int r4 = 0; r4 < 4; r4++) {
          const int e = 32 * et + 8 * r4 + 4 * lh;
          const f32x4 gv = *(const f32x4*)(subln + e);
          u32x2 ov;
          ov[0] = pk2(O[et][4 * r4 + 0] * rs * gv[0] * osc, O[et][4 * r4 + 1] * rs * gv[1] * osc);
          ov[1] = pk2(O[et][4 * r4 + 2] * rs * gv[2] * osc, O[et][4 * r4 + 3] * rs * gv[3] * osc);
          *(u32x2*)(o + (tb + t) * 1024 + h * 128 + e) = ov;
        }
    }
  }
}

#define XB_TMO      128
#define XB_XCNT(j)  (256  + 64 * (j))
#define XB_XSUB(j)  (1280 + 64 * (j))
#define XB_XGEN(j)  (2304 + 64 * (j))
#define XB_TOP      3328
#define XB_TOPGEN   3392
#define XCD_BAR_WORDS 3456
#define XB_SPIN_CAP (1u << 20)
#define LAS __attribute__((address_space(3)))
DI unsigned xb_ld(unsigned* p) { return __hip_atomic_load(p, __ATOMIC_RELAXED, __HIP_MEMORY_SCOPE_AGENT); }
DI unsigned xb_add(unsigned* p, unsigned v) { return __hip_atomic_fetch_add(p, v, __ATOMIC_RELAXED, __HIP_MEMORY_SCOPE_AGENT); }
DI unsigned xb_xcc_id() { return (unsigned)__builtin_amdgcn_s_getreg((3 << 11) | 20) & 0xFu; }
#define XB_SPIN(cond, bar) do { unsigned _sp = 0; while (cond) { __builtin_amdgcn_s_sleep(1); \
    if ((++_sp & 255u) == 0u) { if (xb_ld(&(bar)[XB_TMO])) break; if (_sp > XB_SPIN_CAP) { atomicAdd(&(bar)[XB_TMO], 1u); break; } } } } while (0)
struct XcdBarrier {
  unsigned* bar;
  unsigned x;
  volatile LAS unsigned* st;
};
DI XcdBarrier xcd_barrier_post(unsigned* bar, volatile LAS unsigned* st) {
  XcdBarrier b;
  b.bar = bar;
  b.x = xb_xcc_id();
  b.st = st;
  if (threadIdx.x == 0) (void)xb_add(&bar[XB_XCNT(b.x)], 1u);
  return b;
}
DI void xcd_barrier_complete(unsigned* bar, unsigned x, unsigned& nloc, unsigned& nx) {
  const unsigned G = gridDim.x * gridDim.y * gridDim.z;
  unsigned sum, cnt, mine, sp = 0u;
  for (;;) {
    sum = 0u; cnt = 0u; mine = 0u;
#pragma unroll
    for (unsigned j = 0; j < 16; ++j) {
      const unsigned c = xb_ld(&bar[XB_XCNT(j)]);
      sum += c;
      cnt += (c > 0u) ? 1u : 0u;
      mine = (j == x) ? c : mine;
    }
    if (sum == G) break;
    __builtin_amdgcn_s_sleep(1);
    if ((++sp & 255u) == 0u) { if (xb_ld(&bar[XB_TMO])) break; if (sp > XB_SPIN_CAP) { atomicAdd(&bar[XB_TMO], 1u); break; } }
  }
  nloc = mine > 0u ? mine : 1u;
  nx = cnt > 0u ? cnt : 1u;
}
DI void xcd_barrier(const XcdBarrier& b0) {
  asm volatile("s_waitcnt vmcnt(0)" ::: "memory");
  __syncthreads();
  if (threadIdx.x == 0) {
    XcdBarrier b = b0;
    b.x = __builtin_amdgcn_readfirstlane(xb_xcc_id());
    unsigned* bar = b.bar;
    asm volatile("" : "+s"(bar));
    __builtin_amdgcn_s_waitcnt(0);
    unsigned nloc = b.st[0], nx = b.st[1];
    if (nloc == 0u) { xcd_barrier_complete(bar, b.x, nloc, nx); b.st[0] = nloc; b.st[1] = nx; }
    const unsigned old = xb_add(&bar[XB_XSUB(b.x)], 1u);
    const unsigned gen = old / nloc;
    if (old + 1u == (gen + 1u) * nloc) {
      __builtin_amdgcn_fence(__ATOMIC_RELEASE, "agent");
      asm volatile("s_waitcnt vmcnt(0)" ::: "memory");
      const unsigned og = xb_add(&bar[XB_TOP], 1u);
      const unsigned tg = og / nx;
      if (og + 1u == (tg + 1u) * nx) xb_add(&bar[XB_TOPGEN], 1u);
      else XB_SPIN(xb_ld(&bar[XB_TOPGEN]) == tg, bar);
      __builtin_amdgcn_fence(__ATOMIC_ACQUIRE, "agent");
      xb_add(&bar[XB_XGEN(b.x)], 1u);
      asm volatile("s_waitcnt vmcnt(0)" ::: "memory");
    } else {
      XB_SPIN(xb_ld(&bar[XB_XGEN(b.x)]) == gen, bar);
      __builtin_amdgcn_fence(__ATOMIC_ACQUIRE, "agent");
      asm volatile("s_waitcnt vmcnt(0)" ::: "memory");
    }
  }
  __syncthreads();
}

#define DECL_WS_PTRS(ws) \
  u16* w_ain = (u16*)(ws + W_AIN); \
  u16* w_uk = (u16*)(ws + W_UK); \
  u16* w_uv = (u16*)(ws + W_UV); \
  u16* w_ao = (u16*)(ws + W_AO); \
  u16* w_bin = (u16*)(ws + W_BIN); \
  u16* w_bo = (u16*)(ws + W_BO); \
  u16* w_w1 = (u16*)(ws + W_W1); \
  u16* w_w2 = (u16*)(ws + W_W2); \
  float* mod = (float*)(ws + WS_MOD); \
  u16* hbuf = (u16*)(ws + WS_H); \
  char* big = ws + WS_BIG; \
  u16* qbuf = (u16*)(big + B_Q); \
  u16* iqbuf = (u16*)(big + B_IQ); \
  u16* ikbuf = (u16*)(big + B_IK); \
  float* iwbuf = (float*)(big + B_IW); \
  float* ckvraw = (float*)(big + B_CKVRAW); \
  u16* ckvn = (u16*)(big + B_CKVN); \
  u16* selbuf = (u16*)(big + B_SEL); \
  u16* kbuf = (u16*)(big + B_K); \
  u16* vtbuf = (u16*)(big + B_VT); \
  u16* obuf = (u16*)(big + B_O); \
  u16* hid = (u16*)big;

__global__ void __launch_bounds__(512, 2) hybrid_fwd(Params p) {
  __shared__ __attribute__((aligned(16))) char smem[2 * LDS_BYTES];
  cg::grid_group grid = cg::this_grid();
  const int bid = blockIdx.x, nb = gridDim.x;
  const int half = __builtin_amdgcn_readfirstlane((int)(threadIdx.x >> 8));
  const int vb = half * nb + bid, nvb = 2 * nb;
  char* smh = smem + half * LDS_BYTES;
  char* ws = p.ws;
  unsigned* bar = (unsigned*)(ws + WS_BAR);
  volatile LAS unsigned* xst = (volatile LAS unsigned*)(smem + 2 * LDS_BYTES - 16);
  if (threadIdx.x < 2) xst[threadIdx.x] = 0u;
  __syncthreads();
  const XcdBarrier xb = xcd_barrier_post(bar, xst);

  {
  DECL_WS_PTRS(ws)
  (void)qbuf; (void)iqbuf; (void)ikbuf; (void)iwbuf; (void)ckvraw; (void)ckvn; (void)selbuf; (void)kbuf; (void)vtbuf; (void)obuf; (void)hid;
  tconv_phase(p.a_w_in, w_ain, 2, 1024, 1864, A_INP, smh, vb, nvb);
  tconv_phase(p.a_w_uk, w_uk, 32, 64, 256, 256, smh, vb, nvb);
  tconv_phase(p.a_w_uv, w_uv, 32, 256, 64, 64, smh, vb, nvb);
  tconv_phase(p.a_w_o, w_ao, 2, 1024, 1024, 1024, smh, vb, nvb);
  tconv_phase(p.b_w_in, w_bin, 2, 1024, 3072, 3072, smh, vb, nvb);
  tconv_phase(p.b_w_o, w_bo, 2, 1024, 1024, 1024, smh, vb, nvb);
  tconv_phase(p.mlp_w1, w_w1, 4, 1024, 4096, 4096, smh, vb, nvb);
  tconv_phase(p.mlp_w2, w_w2, 4, 4096, 1024, 1024, smh, vb, nvb);
  mod_phase(p, mod, smh, vb, nvb);
  grid.sync();
  h0_phase(p.x, mod, hbuf, vb, nvb);
  xcd_barrier(xb);
  }

#pragma unroll 1
  for (int sl = 0; sl < 8; sl++) {
    char* wsl = p.ws;
    asm volatile("" : "+s"(wsl));
    DECL_WS_PTRS(wsl)
    const int i = sl >> 1, j = i >> 1;
    const float* modi = mod + (size_t)i * 4 * 6144;
    const u16* Ares;
    const u16* Wres;
    int Kres, goff;
    if ((sl & 1) == 0) {
      if ((i & 1) == 0) {
        EpiArgs ea{};
        ea.o0 = qbuf; ea.f0 = ckvraw; ea.o1 = iqbuf; ea.o2 = ikbuf; ea.f1 = iwbuf;
        for (int rep = 0; rep < (PROBE_DUP == 4 ? 2 : 1); rep++) gemm8p_phase<EPI_AIN>(hbuf, w_ain + (size_t)j * A_INP * 1024, T, A_INP, 1024, ea, smem, bid, nb);
        xcd_barrier(xb);
        ckvnorm_phase(ckvraw, p.a_kv_norm + j * 256, ckvn, vb, nvb);
        for (int rep = 0; rep < (PROBE_DUP == 2 ? 2 : 1); rep++) indexer_phase(iqbuf, ikbuf, iwbuf, selbuf, smh, vb, nvb);
        xcd_barrier(xb);
        for (int rep = 0; rep < (PROBE_DUP == 3 ? 2 : 1); rep++) sparse_phase(qbuf, ckvn, selbuf, w_uk + (size_t)j * 16 * 256 * 64, w_uv + (size_t)j * 16 * 256 * 64, p.rel_bias,
                     hbuf, obuf, smh, vb, nvb);
        xcd_barrier(xb);
        Wres = w_ao + (size_t)j * 1024 * 1024;
      } else {
        EpiArgs ea{};
        ea.o0 = qbuf; ea.o1 = kbuf; ea.o2 = vtbuf;
        for (int rep = 0; rep < (PROBE_DUP == 4 ? 2 : 1); rep++) gemm8p_phase<EPI_BIN>(hbuf, w_bin + (size_t)j * 3072 * 1024, T, 3072, 1024, ea, smem, bid, nb);
        xcd_barrier(xb);
        for (int rep = 0; rep < (PROBE_DUP == 1 ? 2 : 1); rep++) diffattn_phase(qbuf, kbuf, vtbuf, obuf, p.rel_bias, p.b_lambda + j * 256, p.b_subln + j * 128, i, smem, bid, nb);
        xcd_barrier(xb);
        Wres = w_bo + (size_t)j * 1024 * 1024;
      }
      Ares = obuf; Kres = 1024; goff = 2 * 1024;
    } else {
      EpiArgs ea{};
      ea.o0 = hid;
      for (int rep = 0; rep < (PROBE_DUP == 4 ? 2 : 1); rep++) gemm8p_phase<EPI_SQRELU>(hbuf, w_w1 + (size_t)i * 4096 * 1024, T, 4096, 1024, ea, smem, bid, nb);
      xcd_barrier(xb);
      Ares = hid; Wres = w_w2 + (size_t)i * 4096 * 1024; Kres = 4096; goff = 5 * 1024;
    }
    {
      EpiArgs ea{};
      ea.f0 = p.out;
      ea.xin = (sl == 0) ? p.x : (const float*)p.out;
      ea.g = modi + goff;
      gemm8p_phase<EPI_RES>(Ares, Wres, T, 1024, Kres, ea, smem, bid, nb);
    }
    xcd_barrier(xb);
    {
      const float* modn = ((sl & 1) == 0) ? modi : (i < 3 ? modi + 4 * 6144 : (const float*)nullptr);
      const int sh_off = ((sl & 1) == 0) ? 3 * 1024 : 0;
      ln_phase(p.out, p.ln_g + (size_t)(i * 2 + (sl & 1)) * 1024, p.ln_b + (size_t)(i * 2 + (sl & 1)) * 1024, modn, sh_off,
               hbuf, vb, nvb);
    }
    xcd_barrier(xb);
  }
}

extern "C" void kernel_launch(void* const* d_in, const int* in_sizes, int n_in, void* d_out, int out_size, void* d_ws,
                              size_t ws_size, hipStream_t stream) {
  static int grid_blocks = 0;
  if (!grid_blocks) {
    int dev = 0, cus = 0, per_cu = 0;
    hipGetDevice(&dev);
    hipDeviceGetAttribute(&cus, hipDeviceAttributeMultiprocessorCount, dev);
    hipOccupancyMaxActiveBlocksPerMultiprocessor(&per_cu, hybrid_fwd, 512, 0);
    (void)per_cu;
    grid_blocks = cus;
    if (grid_blocks > 256) grid_blocks = 256;
  }
  Params p{};
  p.x = (const float*)d_in[0];
  p.c = (const float*)d_in[1];
  p.rel_bias = (const float*)d_in[2];
  p.ada_w = (const float*)d_in[3];
  p.ada_b = (const float*)d_in[4];
  p.ln_g = (const float*)d_in[5];
  p.ln_b = (const float*)d_in[6];
  p.a_w_in = (const float*)d_in[7];
  p.a_kv_norm = (const float*)d_in[8];
  p.a_w_uk = (const float*)d_in[9];
  p.a_w_uv = (const float*)d_in[10];
  p.a_w_o = (const float*)d_in[11];
  p.b_w_in = (const float*)d_in[12];
  p.b_lambda = (const float*)d_in[13];
  p.b_subln = (const float*)d_in[14];
  p.b_w_o = (const float*)d_in[15];
  p.mlp_w1 = (const float*)d_in[16];
  p.mlp_w2 = (const float*)d_in[17];
  p.out = (float*)d_out;
  p.ws = (char*)d_ws;
  hipMemsetAsync((char*)d_ws + WS_BAR, 0, XCD_BAR_WORDS * 4, stream);
  void* args[] = {&p};
  hipError_t e = hipLaunchCooperativeKernel((void*)hybrid_fwd, dim3(grid_blocks), dim3(512), args, 0, stream);
  if (e != hipSuccess) fprintf(stderr, "cooperative launch failed: %s (grid %d)\n", hipGetErrorString(e), grid_blocks);
}
```

```cpp
#include <hip/hip_runtime.h>
#include <hip/hip_cooperative_groups.h>
#include <stdint.h>
#include <stdio.h>
namespace cg = cooperative_groups;

typedef unsigned short u16;
typedef short bf16x8 __attribute__((ext_vector_type(8)));
typedef short s16x4 __attribute__((ext_vector_type(4)));
typedef float f32x16 __attribute__((ext_vector_type(16)));
typedef float f32x4 __attribute__((ext_vector_type(4)));
typedef float f32x2 __attribute__((ext_vector_type(2)));
typedef __bf16 bf16x2_t __attribute__((ext_vector_type(2)));
typedef unsigned u32x4 __attribute__((ext_vector_type(4)));
typedef unsigned u32x2 __attribute__((ext_vector_type(2)));
typedef __attribute__((address_space(3))) s16x4* lds_s16x4_ptr;

#define DI __device__ __forceinline__
#ifndef PROBE_DUP
#define PROBE_DUP 0
#endif

constexpr int D = 1024, NBATCH = 4, S = 8192, T = NBATCH * S;
constexpr int A_INP = 2048;
constexpr float DN_ALPHA = 1.6817928305074292f;
constexpr float LOG2E = 1.4426950408889634f;
constexpr float LN_EPS = 1e-5f;
constexpr float NEGF = -1e30f;
constexpr int TOPK = 256;
constexpr int CAP = 704;
constexpr int LDS_BYTES = 72 * 1024;

constexpr size_t MB = 1024 * 1024;
constexpr size_t W_AIN = 0;
constexpr size_t W_UK = W_AIN + (size_t)2 * 2048 * 1024 * 2;
constexpr size_t W_UV = W_UK + (size_t)2 * 16 * 256 * 64 * 2;
constexpr size_t W_AO = W_UV + (size_t)2 * 16 * 256 * 64 * 2;
constexpr size_t W_BIN = W_AO + (size_t)2 * 1024 * 1024 * 2;
constexpr size_t W_BO = W_BIN + (size_t)2 * 3072 * 1024 * 2;
constexpr size_t W_W1 = W_BO + (size_t)2 * 1024 * 1024 * 2;
constexpr size_t W_W2 = W_W1 + (size_t)4 * 4096 * 1024 * 2;
constexpr size_t WS_MOD = W_W2 + (size_t)4 * 4096 * 1024 * 2;
constexpr size_t WS_H = WS_MOD + 1 * MB;
constexpr size_t WS_BIG = WS_H + 64 * MB;
constexpr size_t WS_BAR = WS_BIG + 256 * MB;
constexpr size_t B_Q = 0;
constexpr size_t B_IQ = 64 * MB;
constexpr size_t B_IK = 96 * MB;
constexpr size_t B_IW = 100 * MB;
constexpr size_t B_CKVRAW = 104 * MB;
constexpr size_t B_CKVN = 136 * MB;
constexpr size_t B_SEL = 152 * MB;
constexpr size_t B_K = 64 * MB;
constexpr size_t B_VT = 128 * MB;
constexpr size_t B_O = 192 * MB;

struct Params {
  const float *x, *c, *rel_bias, *ada_w, *ada_b, *ln_g, *ln_b, *a_w_in, *a_kv_norm, *a_w_uk, *a_w_uv, *a_w_o, *b_w_in,
      *b_lambda, *b_subln, *b_w_o, *mlp_w1, *mlp_w2;
  float* out;
  char* ws;
};

DI int opq_tid() {
  int t = threadIdx.x & 255;
  asm volatile("" : "+v"(t));
  return t;
}
DI int opq_tid8() {
  int t = threadIdx.x;
  asm volatile("" : "+v"(t));
  return t;
}
DI unsigned pk2(float lo, float hi) {
  f32x2 v = {lo, hi};
  bf16x2_t b = __builtin_convertvector(v, bf16x2_t);
  return __builtin_bit_cast(unsigned, b);
}
DI u16 f2bf(float x) { return (u16)(pk2(x, 0.f) & 0xffffu); }
DI float wave_sum(float v) {
#pragma unroll
  for (int o = 32; o >= 1; o >>= 1) v += __shfl_xor(v, o);
  return v;
}
DI f32x16 mfma32(bf16x8 a, bf16x8 b, f32x16 c) { return __builtin_amdgcn_mfma_f32_32x32x16_bf16(a, b, c, 0, 0, 0); }
DI f32x4 mfma16(bf16x8 a, bf16x8 b, f32x4 c) { return __builtin_amdgcn_mfma_f32_16x16x32_bf16(a, b, c, 0, 0, 0); }
DI int pi_row(int r) { return (r & ~12) | ((r & 4) << 1) | ((r & 8) >> 1); }

DI int rel_bucket(int n) {
  if (n < 16) return n;
  float nf = (float)n;
  int large = 16 + (int)(logf(nf / 16.f) / 2.0794415416798357f * 16.f);
  return large < 31 ? large : 31;
}

DI void tconv_phase(const float* __restrict__ src, u16* __restrict__ dst, int batch, int R, int C, int Cpad, char* smem,
                    int bid, int nb) {
  float* tile = (float*)smem;
  const int tid = opq_tid();
  const int tr = R / 64, tc = Cpad / 64;
  const int ntiles = batch * tr * tc;
  for (int it0 = 0; it0 < ntiles; it0 += nb) {
    const int it = (it0 + bid < ntiles) ? it0 + bid : ntiles - 1;
    const int bi = it / (tr * tc);
    const int rem = it - bi * (tr * tc);
    const int ri = rem / tc, ci = rem - ri * tc;
    const float* s = src + (size_t)bi * R * C;
    u16* d = dst + (size_t)bi * Cpad * R;
    __syncthreads();
#pragma unroll
    for (int k = 0; k < 4; k++) {
      const int r = (tid >> 4) + 16 * k;
      const int cl = (tid & 15) * 4;
      const int cc = ci * 64 + cl;
      f32x4 v = {0.f, 0.f, 0.f, 0.f};
      if (cc < C) v = *(const f32x4*)(s + (size_t)(ri * 64 + r) * C + cc);
      tile[r * 65 + cl + 0] = v[0];
      tile[r * 65 + cl + 1] = v[1];
      tile[r * 65 + cl + 2] = v[2];
      tile[r * 65 + cl + 3] = v[3];
    }
    __syncthreads();
#pragma unroll
    for (int k = 0; k < 2; k++) {
      const int cl = (tid >> 3) + 32 * k;
      const int r8 = (tid & 7) * 8;
      u32x4 o;
      o[0] = pk2(tile[(r8 + 0) * 65 + cl], tile[(r8 + 1) * 65 + cl]);
      o[1] = pk2(tile[(r8 + 2) * 65 + cl], tile[(r8 + 3) * 65 + cl]);
      o[2] = pk2(tile[(r8 + 4) * 65 + cl], tile[(r8 + 5) * 65 + cl]);
      o[3] = pk2(tile[(r8 + 6) * 65 + cl], tile[(r8 + 7) * 65 + cl]);
      *(u32x4*)(d + (size_t)(ci * 64 + cl) * R + ri * 64 + r8) = o;
    }
  }
}

DI void mod_phase(const Params& p, float* mod, char* smem, int bid, int nb) {
  float* sc = (float*)smem;
  float* red = sc + 4096;
  const int tid = opq_tid(), lane = tid & 63, w = __builtin_amdgcn_readfirstlane(tid >> 6);
  __syncthreads();
  for (int i = tid; i < 4096; i += 256) {
    float v = p.c[i];
    sc[i] = v / (1.f + expf(-v));
  }
  __syncthreads();
  for (int it = bid; it < 4 * 384; it += nb) {
    const int l = it / 384, e0 = (it - l * 384) * 16;
    const int ds = lane >> 4, ec = lane & 15;
    const float* wp = p.ada_w + ((size_t)l * 1024 + w * 256 + ds) * 6144 + e0 + ec;
    float a0 = 0, a1 = 0, a2 = 0, a3 = 0;
#pragma unroll 16
    for (int d = 0; d < 64; d++) {
      float wv = wp[(size_t)(4 * d) * 6144];
      int dd = w * 256 + 4 * d + ds;
      a0 += sc[dd] * wv;
      a1 += sc[1024 + dd] * wv;
      a2 += sc[2048 + dd] * wv;
      a3 += sc[3072 + dd] * wv;
    }
    a0 += __shfl_xor(a0, 16); a0 += __shfl_xor(a0, 32);
    a1 += __shfl_xor(a1, 16); a1 += __shfl_xor(a1, 32);
    a2 += __shfl_xor(a2, 16); a2 += __shfl_xor(a2, 32);
    a3 += __shfl_xor(a3, 16); a3 += __shfl_xor(a3, 32);
    if (lane < 16) {
      red[(w * 4 + 0) * 16 + lane] = a0;
      red[(w * 4 + 1) * 16 + lane] = a1;
      red[(w * 4 + 2) * 16 + lane] = a2;
      red[(w * 4 + 3) * 16 + lane] = a3;
    }
    __syncthreads();
    if (tid < 64) {
      const int b = tid >> 4, e = tid & 15;
      float sm = red[(0 * 4 + b) * 16 + e] + red[(1 * 4 + b) * 16 + e] + red[(2 * 4 + b) * 16 + e] + red[(3 * 4 + b) * 16 + e] +
                 p.ada_b[l * 6144 + e0 + e];
      mod[((size_t)l * 4 + b) * 6144 + e0 + e] = sm;
    }
    __syncthreads();
  }
}

DI void h0_phase(const float* __restrict__ x, const float* __restrict__ mod0, u16* __restrict__ h, int bid, int nb) {
  const size_t n8 = (size_t)T * 1024 / 8;
  for (size_t i = (size_t)bid * 256 + opq_tid(); i < n8; i += (size_t)nb * 256) {
    const size_t e = i * 8;
    const int t = (int)(e >> 10), d = (int)(e & 1023), b = t >> 13;
    const float* m = mod0 + (size_t)b * 6144;
    f32x4 v0 = *(const f32x4*)(x + e), v1 = *(const f32x4*)(x + e + 4);
    f32x4 sh0 = *(const f32x4*)(m + d), sh1 = *(const f32x4*)(m + d + 4);
    f32x4 sc0 = *(const f32x4*)(m + 1024 + d), sc1 = *(const f32x4*)(m + 1024 + d + 4);
    v0 = v0 * (1.f + sc0) + sh0;
    v1 = v1 * (1.f + sc1) + sh1;
    u32x4 o;
    o[0] = pk2(v0[0], v0[1]);
    o[1] = pk2(v0[2], v0[3]);
    o[2] = pk2(v1[0], v1[1]);
    o[3] = pk2(v1[2], v1[3]);
    *(u32x4*)(h + e) = o;
  }
}

DI void ln_phase(float* z, const float* __restrict__ g, const float* __restrict__ bt, const float* modn, int sh_off,
                 u16* __restrict__ h, int bid, int nb) {
  const int tid = opq_tid(), lane = tid & 63, w = __builtin_amdgcn_readfirstlane(tid >> 6);
  const int nw = nb * 4;
  for (int row0 = bid * 4 + w; row0 < T; row0 += 4 * nw) {
    f32x4 v[4][4];
#pragma unroll
    for (int rr = 0; rr < 4; rr++) {
      const int row = row0 + rr * nw;
      const f32x4* zp = (const f32x4*)(z + (size_t)(row < T ? row : row0) * 1024);
#pragma unroll
      for (int c = 0; c < 4; c++) v[rr][c] = zp[c * 64 + lane];
    }
#pragma unroll
    for (int rr = 0; rr < 4; rr++) {
      const int row = row0 + rr * nw;
      if (row < T) {
        float s = 0;
#pragma unroll
        for (int c = 0; c < 4; c++) s += v[rr][c][0] + v[rr][c][1] + v[rr][c][2] + v[rr][c][3];
        const float mu = wave_sum(s) * (1.f / 1024.f);
        float q = 0;
#pragma unroll
        for (int c = 0; c < 4; c++) {
          v[rr][c] = v[rr][c] - mu;
          q += v[rr][c][0] * v[rr][c][0] + v[rr][c][1] * v[rr][c][1] + v[rr][c][2] * v[rr][c][2] + v[rr][c][3] * v[rr][c][3];
        }
        const float rstd = rsqrtf(wave_sum(q) * (1.f / 1024.f) + LN_EPS);
        const int b = row >> 13;
        f32x4* zp = (f32x4*)(z + (size_t)row * 1024);
#pragma unroll
        for (int c = 0; c < 4; c++) {
          const int d = c * 256 + lane * 4;
          f32x4 y = v[rr][c] * rstd * *(const f32x4*)(g + d) + *(const f32x4*)(bt + d);
          zp[c * 64 + lane] = y;
          if (modn) {
            const float* m = modn + (size_t)b * 6144 + sh_off;
            f32x4 hv = y * (1.f + *(const f32x4*)(m + 1024 + d)) + *(const f32x4*)(m + d);
            u32x2 o;
            o[0] = pk2(hv[0], hv[1]);
            o[1] = pk2(hv[2], hv[3]);
            *(u32x2*)(h + (size_t)row * 1024 + d) = o;
          }
        }
      }
    }
  }
}

enum { EPI_AIN = 0, EPI_BIN = 1, EPI_RES = 2, EPI_SQRELU = 3 };
struct EpiArgs {
  u16 *o0, *o1, *o2;
  float *f0, *f1;
  const float* xin;
  const float* g;
};

template <int EPI>
DI void epi_store4(const EpiArgs& ea, int row, int col, const float* v, int bidx) {
  if (EPI == EPI_AIN) {
    if (col < 1024) {
      u32x2 o;
      o[0] = pk2(v[0], v[1]);
      o[1] = pk2(v[2], v[3]);
      *(u32x2*)(ea.o0 + (size_t)row * 1024 + col) = o;
    } else if (col < 1280) {
      *(f32x4*)(ea.f0 + (size_t)row * 256 + (col - 1024)) = (f32x4){v[0], v[1], v[2], v[3]};
    } else if (col < 1792) {
      u32x2 o;
      o[0] = pk2(v[0], v[1]);
      o[1] = pk2(v[2], v[3]);
      *(u32x2*)(ea.o1 + (size_t)row * 512 + (col - 1280)) = o;
    } else if (col < 1856) {
      const int d = col - 1792;
      const int sidx = row & 8191;
      const size_t off = (size_t)(row >> 13) * S * 64 +
                         ((size_t)((sidx >> 5) * 4 + (d >> 4)) * 64 + 32 * ((d >> 3) & 1) + (sidx & 31)) * 8 + (d & 7);
      u32x2 o;
      o[0] = pk2(v[0], v[1]);
      o[1] = pk2(v[2], v[3]);
      *(u32x2*)(ea.o2 + off) = o;
    } else if (col < 1864) {
      const float sc = 0.044194173824159216f;
      *(f32x4*)(ea.f1 + (size_t)row * 8 + (col - 1856)) = (f32x4){v[0] * sc, v[1] * sc, v[2] * sc, v[3] * sc};
    }
  } else if (EPI == EPI_BIN) {
    if (col < 1024) {
      const float sc = 0.125f * LOG2E;
      u32x2 o;
      o[0] = pk2(v[0] * sc, v[1] * sc);
      o[1] = pk2(v[2] * sc, v[3] * sc);
      *(u32x2*)(ea.o0 + (size_t)row * 1024 + col) = o;
    } else if (col < 2048) {
      u32x2 o;
      o[0] = pk2(v[0], v[1]);
      o[1] = pk2(v[2], v[3]);
      *(u32x2*)(ea.o1 + (size_t)row * 1024 + (col - 1024)) = o;
    } else {
      const int cv = col - 2048;
#pragma unroll
      for (int q = 0; q < 4; q++) ea.o2[((size_t)bidx * 1024 + cv + q) * 8192 + (row & 8191)] = f2bf(v[q]);
    }
  } else if (EPI == EPI_RES) {
    const f32x4 gg = *(const f32x4*)(ea.g + (size_t)bidx * 6144 + col);
    const size_t o = (size_t)row * 1024 + col;
    const f32x4 xv = *(const f32x4*)(ea.xin + o);
    f32x4 r;
#pragma unroll
    for (int q = 0; q < 4; q++) r[q] = DN_ALPHA * xv[q] + (1.f + gg[q]) * v[q];
    *(f32x4*)(ea.f0 + o) = r;
  } else {
    float r[4];
#pragma unroll
    for (int q = 0; q < 4; q++) {
      r[q] = v[q] > 0.f ? v[q] : 0.f;
      r[q] = r[q] * r[q];
    }
    u32x2 o;
    o[0] = pk2(r[0], r[1]);
    o[1] = pk2(r[2], r[3]);
    *(u32x2*)(ea.o0 + (size_t)row * 4096 + col) = o;
  }
}

template <int EPI>
DI void gemm_phase(const u16* __restrict__ A, const u16* __restrict__ Bt, int M, int N, int K, const EpiArgs& ea,
                   char* smem, int bid, int nb) {
  constexpr int MI = 4, BM = 64 * MI, BN = 256;
  u16* As = (u16*)smem;
  u16* Bs = As + BM * 72;
  const int tid = opq_tid8(), lane = tid & 63, w = __builtin_amdgcn_readfirstlane(tid >> 6), wm = w >> 2, wn = w & 3, l31 = lane & 31, lh = lane >> 5;
  const int ntn = N / BN, ntm = M / BM, nt = ntn * ntm, nk = K / 64;
  const int lr = tid >> 3, lc = (tid & 7) * 8;
  const int xcd = bid & 7, nbx = nb >> 3, cntx = (ntm >> 3) * ntn;
  (void)nt;
  for (int sq = bid >> 3; sq < cntx; sq += nbx) {
    const int tmx = sq / ntn, tn = sq - tmx * ntn;
    const int tm = tmx * 8 + xcd;
    const int m0 = tm * BM, n0 = tn * BN;
    f32x16 acc[MI][2];
#pragma unroll
    for (int i = 0; i < MI; i++)
#pragma unroll
      for (int j = 0; j < 2; j++)
#pragma unroll
        for (int r = 0; r < 16; r++) acc[i][j][r] = 0.f;
    u32x4 ra[4], rb[4];
    const u16* ap = A + (size_t)(m0 + lr) * K + lc;
    const u16* bp = Bt + (size_t)(n0 + lr) * K + lc;
#pragma unroll
    for (int i = 0; i < 4; i++) ra[i] = *(const u32x4*)(ap + (size_t)i * 64 * K);
#pragma unroll
    for (int i = 0; i < 4; i++) rb[i] = *(const u32x4*)(bp + (size_t)i * 64 * K);
    __syncthreads();
#pragma unroll
    for (int i = 0; i < 4; i++) *(u32x4*)&As[(lr + 64 * i) * 72 + lc] = ra[i];
#pragma unroll
    for (int i = 0; i < 4; i++) *(u32x4*)&Bs[(lr + 64 * i) * 72 + lc] = rb[i];
    __syncthreads();
    for (int kt = 0; kt < nk; kt++) {
      if (kt + 1 < nk) {
#pragma unroll
        for (int i = 0; i < 4; i++) ra[i] = *(const u32x4*)(ap + (size_t)i * 64 * K + (kt + 1) * 64);
#pragma unroll
        for (int i = 0; i < 4; i++) rb[i] = *(const u32x4*)(bp + (size_t)i * 64 * K + (kt + 1) * 64);
      }
#pragma unroll
      for (int ks = 0; ks < 4; ks++) {
        bf16x8 af[MI], b0, b1;
#pragma unroll
        for (int i = 0; i < MI; i++) af[i] = *(const bf16x8*)&As[(wm * 32 * MI + 32 * i + l31) * 72 + ks * 16 + lh * 8];
        b0 = *(const bf16x8*)&Bs[(wn * 64 + l31) * 72 + ks * 16 + lh * 8];
        b1 = *(const bf16x8*)&Bs[(wn * 64 + 32 + l31) * 72 + ks * 16 + lh * 8];
#pragma unroll
        for (int i = 0; i < MI; i++) {
          acc[i][0] = mfma32(b0, af[i], acc[i][0]);
          acc[i][1] = mfma32(b1, af[i], acc[i][1]);
        }
      }
      __syncthreads();
      if (kt + 1 < nk) {
#pragma unroll
        for (int i = 0; i < 4; i++) *(u32x4*)&As[(lr + 64 * i) * 72 + lc] = ra[i];
#pragma unroll
        for (int i = 0; i < 4; i++) *(u32x4*)&Bs[(lr + 64 * i) * 72 + lc] = rb[i];
        __syncthreads();
      }
    }
    const int bidx = m0 >> 13;
#pragma unroll
    for (int i = 0; i < MI; i++) {
      const int row = m0 + wm * 32 * MI + 32 * i + l31;
#pragma unroll
      for (int j = 0; j < 2; j++) {
#pragma unroll
        for (int r4 = 0; r4 < 4; r4++) {
          const int col = n0 + wn * 64 + 32 * j + 8 * r4 + 4 * lh;
          float v[4];
#pragma unroll
          for (int q = 0; q < 4; q++) v[q] = acc[i][j][4 * r4 + q];
          epi_store4<EPI>(ea, row, col, v, bidx);
        }
      }
    }
  }
}

DI int g8_lds_byte(int r, int c) {
  int st = (r >> 4) * 2 + (c >> 5), rr = r & 15, cc = c & 31, ob = rr * 64 + cc * 2;
  return st * 1024 + (ob ^ (((ob >> 9) & 1) << 5));
}
DI void g8_stage_rc(int b, int& R, int& C) {
  int st = b / 1024, sb = b % 1024, swz = sb ^ (((sb >> 9) & 1) << 5);
  R = (st >> 1) * 16 + swz / 64;
  C = (st & 1) * 32 + (swz % 64) / 2;
}
typedef __attribute__((address_space(3))) unsigned* lds_u32_ptr;

template <int EPI>
DI void gemm8p_phase(const u16* __restrict__ A, const u16* __restrict__ Bt, int M, int N, int K, const EpiArgs& ea,
                     char* smem, int bid, int nb) {
  constexpr int BK = 64, HALF = 128, HT = HALF * BK;
  u16* shm = (u16*)smem;
  const int tid = opq_tid8(), lane = tid & 63, wid = __builtin_amdgcn_readfirstlane(tid >> 6);
  const int wr = wid >> 2, wc = wid & 3, fr = lane & 15, fq = lane >> 4;
#define G8_SA(b, h) (shm + ((b) * 2 + (h)) * HT)
#define G8_SB(b, h) (shm + (4 + (b) * 2 + (h)) * HT)
  int g8o0, g8o1;
  {
    int r_, c_;
    g8_stage_rc(tid * 16, r_, c_);
    g8o0 = r_ * K + c_;
    g8_stage_rc(tid * 16 + 8192, r_, c_);
    g8o1 = r_ * K + c_;
  }
#define G8_STAGE(P, BASE, br, kt)                                                                                   \
  do {                                                                                                               \
    const u16* _gp = BASE + (size_t)(br) * K + (size_t)(kt) * BK;                                                    \
    asm volatile("" : "+s"(_gp));                \
    __builtin_amdgcn_global_load_lds((const unsigned*)(_gp + (unsigned)g8o0), (lds_u32_ptr)((char*)(P) + tid * 16), 16, 0, 0);        \
    __builtin_amdgcn_global_load_lds((const unsigned*)(_gp + (unsigned)g8o1), (lds_u32_ptr)((char*)(P) + tid * 16 + 8192), 16, 0, 0); \
  } while (0)
  const int g8lane = (fr * 64 + fq * 16) ^ ((fr & 8) << 2);
  const char* g8a = smem + g8lane + wr * 8192;
  const char* g8b = smem + 4 * HT * 2 + g8lane + wc * 4096;
#define G8_LDA(dst, b, h)                                                                                            \
  _Pragma("unroll") for (int m = 0; m < 4; ++m) _Pragma("unroll") for (int k = 0; k < 2; ++k)                        \
      dst[m][k] = *reinterpret_cast<const bf16x8*>(g8a + ((b) * 2 + (h)) * (HT * 2) + m * 2048 + k * 1024)
#define G8_LDB(dst, b, h)                                                                                            \
  _Pragma("unroll") for (int n = 0; n < 2; ++n) _Pragma("unroll") for (int k = 0; k < 2; ++k)                        \
      dst[n][k] = *reinterpret_cast<const bf16x8*>(g8b + ((b) * 2 + (h)) * (HT * 2) + n * 2048 + k * 1024)
#define G8_MMA(ai, bj, At_, Bt_)                                                                                     \
  do {                                                                                                               \
    __builtin_amdgcn_s_setprio(1);                                                                                   \
    _Pragma("unroll") for (int m = 0; m < 4; ++m) _Pragma("unroll") for (int n = 0; n < 2; ++n)                      \
        _Pragma("unroll") for (int k = 0; k < 2; ++k)                                                                \
            acc[ai][bj][m][n] = mfma16(Bt_[n][k], At_[m][k], acc[ai][bj][m][n]);                                     \
    __builtin_amdgcn_s_setprio(0);                                                                                   \
  } while (0)
#define G8_WAIT_V(n) asm volatile("s_waitcnt vmcnt(" #n ")" ::: "memory")
#define G8_WAIT_L(n) asm volatile("s_waitcnt lgkmcnt(" #n ")" ::: "memory")
#define G8_BAR __builtin_amdgcn_s_barrier()
#define G8_SCHED __builtin_amdgcn_sched_barrier(0)
  const int ntn = N / 256, ntm = M / 256, nt = K / BK;
  const int xcd = bid & 7, nbx = nb >> 3, cntx = (ntm >> 3) * ntn;
  for (int sq = bid >> 3; sq < cntx; sq += nbx) {
    const int tmx = sq / ntn, tn = sq - tmx * ntn;
    const int tm = tmx * 8 + xcd;
    const int brow = tm * 256, bcol = tn * 256;
    f32x4 acc[2][2][4][2];
#pragma unroll
    for (int a_ = 0; a_ < 2; a_++)
#pragma unroll
      for (int b_ = 0; b_ < 2; b_++)
#pragma unroll
        for (int m = 0; m < 4; m++)
#pragma unroll
          for (int n = 0; n < 2; n++) acc[a_][b_][m][n] = (f32x4){0.f, 0.f, 0.f, 0.f};
    bf16x8 At[4][2], B0[2][2], B1[2][2];
    asm volatile("s_waitcnt vmcnt(0) lgkmcnt(0)" ::: "memory");
    __syncthreads();
    G8_STAGE(G8_SB(0, 0), Bt, bcol, 0); G8_STAGE(G8_SA(0, 0), A, brow, 0);
    G8_STAGE(G8_SB(0, 1), Bt, bcol + HALF, 0); G8_STAGE(G8_SA(0, 1), A, brow + HALF, 0);
    if (wr == 1) G8_BAR;
    G8_WAIT_V(4); G8_BAR;
    G8_STAGE(G8_SB(1, 0), Bt, bcol, 1); G8_STAGE(G8_SA(1, 0), A, brow, 1); G8_STAGE(G8_SB(1, 1), Bt, bcol + HALF, 1);
    G8_WAIT_V(6); G8_BAR;
    for (int t = 0; t < nt - 2; t += 2) {
      G8_LDB(B0, 0, 0); G8_SCHED; G8_LDA(At, 0, 0); G8_STAGE(G8_SA(1, 1), A, brow + HALF, t + 1);
      G8_WAIT_L(8); G8_BAR; G8_WAIT_L(0); G8_MMA(0, 0, At, B0); G8_BAR; G8_SCHED;
      G8_LDB(B1, 0, 1); G8_STAGE(G8_SB(0, 0), Bt, bcol, t + 2);
      G8_BAR; G8_WAIT_L(0); G8_MMA(0, 1, At, B1); G8_BAR;
      G8_LDA(At, 0, 1); G8_STAGE(G8_SA(0, 0), A, brow, t + 2);
      G8_BAR; G8_WAIT_L(0); G8_MMA(1, 0, At, B0); G8_BAR; G8_SCHED;
      G8_STAGE(G8_SB(0, 1), Bt, bcol + HALF, t + 2);
      G8_WAIT_V(6); G8_BAR; G8_MMA(1, 1, At, B1); G8_BAR;
      G8_LDB(B0, 1, 0); G8_SCHED; G8_LDA(At, 1, 0); G8_STAGE(G8_SA(0, 1), A, brow + HALF, t + 2);
      G8_WAIT_L(8); G8_BAR; G8_WAIT_L(0); G8_MMA(0, 0, At, B0); G8_BAR; G8_SCHED;
      G8_LDB(B1, 1, 1); G8_STAGE(G8_SB(1, 0), Bt, bcol, t + 3);
      G8_BAR; G8_WAIT_L(0); G8_MMA(0, 1, At, B1); G8_BAR;
      G8_LDA(At, 1, 1); G8_STAGE(G8_SA(1, 0), A, brow, t + 3);
      G8_BAR; G8_WAIT_L(0); G8_MMA(1, 0, At, B0); G8_BAR; G8_SCHED;
      G8_STAGE(G8_SB(1, 1), Bt, bcol + HALF, t + 3);
      G8_WAIT_V(6); G8_BAR; G8_MMA(1, 1, At, B1); G8_BAR;
    }
    {
      G8_LDB(B0, 0, 0); G8_LDA(At, 0, 0); G8_STAGE(G8_SA(1, 1), A, brow + HALF, nt - 1);
      G8_BAR; G8_WAIT_L(0); G8_MMA(0, 0, At, B0); G8_BAR;
      G8_LDB(B1, 0, 1); G8_BAR; G8_WAIT_L(0); G8_MMA(0, 1, At, B1); G8_BAR;
      G8_LDA(At, 0, 1); G8_WAIT_V(4); G8_BAR; G8_WAIT_L(0); G8_MMA(1, 0, At, B0); G8_MMA(1, 1, At, B1); G8_BAR;
    }
    {
      G8_LDB(B0, 1, 0); G8_LDA(At, 1, 0); G8_WAIT_V(2); G8_BAR; G8_WAIT_L(0); G8_MMA(0, 0, At, B0); G8_BAR;
      G8_LDB(B1, 1, 1); G8_WAIT_V(0); G8_BAR; G8_WAIT_L(0); G8_MMA(0, 1, At, B1); G8_BAR;
      G8_LDA(At, 1, 1); G8_BAR; G8_WAIT_L(0); G8_MMA(1, 0, At, B0); G8_MMA(1, 1, At, B1); G8_BAR;
    }
    if (wr == 0) G8_BAR;
    const int bidx = brow >> 13;
#pragma unroll
    for (int ai = 0; ai < 2; ai++)
#pragma unroll
      for (int m = 0; m < 4; m++) {
        const int row = brow + ai * HALF + wr * 64 + m * 16 + fr;
#pragma unroll
        for (int bj = 0; bj < 2; bj++)
#pragma unroll
          for (int n = 0; n < 2; n++) {
            const int col = bcol + bj * HALF + wc * 32 + n * 16 + fq * 4;
            float v[4];
#pragma unroll
            for (int q = 0; q < 4; q++) v[q] = acc[ai][bj][m][n][q];
            epi_store4<EPI>(ea, row, col, v, bidx);
          }
      }
  }
#undef G8_SA
#undef G8_SB
#undef G8_STAGE
#undef G8_LDA
#undef G8_LDB
#undef G8_MMA
#undef G8_WAIT_V
#undef G8_WAIT_L
#undef G8_BAR
#undef G8_SCHED
}

DI void ckvnorm_phase(const float* __restrict__ raw, const float* __restrict__ g, u16* __restrict__ outp, int bid,
                      int nb) {
  const int tid = opq_tid(), lane = tid & 63, w = __builtin_amdgcn_readfirstlane(tid >> 6);
  const f32x4 gg = *(const f32x4*)(g + lane * 4);
  for (int row = bid * 4 + w; row < T; row += nb * 4) {
    f32x4 v = *(const f32x4*)(raw + (size_t)row * 256 + lane * 4);
    float ss = v[0] * v[0] + v[1] * v[1] + v[2] * v[2] + v[3] * v[3];
    ss = wave_sum(ss);
    const float r = rsqrtf(ss * (1.f / 256.f) + LN_EPS);
    u32x2 o;
    o[0] = pk2(v[0] * r * gg[0], v[1] * r * gg[1]);
    o[1] = pk2(v[2] * r * gg[2], v[3] * r * gg[3]);
    *(u32x2*)(outp + (size_t)row * 256 + lane * 4) = o;
  }
}

DI unsigned mono_key(float s) {
  unsigned u = __float_as_uint(s);
  return (u & 0x80000000u) ? ~u : (u | 0x80000000u);
}
DI float mono_inv(unsigned k) {
  unsigned u = (k & 0x80000000u) ? (k & 0x7fffffffu) : ~k;
  return __uint_as_float(u);
}
DI float relu_i(float x) {
  int i = __float_as_int(x);
  return __int_as_float(i > 0 ? i : 0);
}
DI int wcount(bool f) { return __popcll(__ballot(f)); }

template <bool EXACT>
DI void compact4(float* vals, u16* idxs, int* cnt, int lane, float* thr_out) {
  constexpr int NPL = CAP / 64;
  unsigned key[4][NPL];
  int n[4];
#pragma unroll
  for (int q = 0; q < 4; q++) n[q] = cnt[q];
#pragma unroll
  for (int q = 0; q < 4; q++)
#pragma unroll
    for (int j = 0; j < NPL; j++) {
      const int e = j * 64 + lane;
      key[q][j] = (e < n[q]) ? mono_key(vals[q * CAP + e]) : 0u;
    }
  unsigned Tk[4] = {0u, 0u, 0u, 0u};
  constexpr int LOWBIT = EXACT ? 0 : 18;
#pragma unroll 1
  for (int bit = 31; bit >= LOWBIT; bit--) {
#pragma unroll
    for (int q = 0; q < 4; q++) {
      const unsigned cand = Tk[q] | (1u << bit);
      int c = 0;
#pragma unroll
      for (int j = 0; j < NPL; j++) c += wcount(key[q][j] >= cand);
      Tk[q] = (c >= TOPK) ? cand : Tk[q];
      if (q == 1) __builtin_amdgcn_sched_barrier(0);
    }
  }
  unsigned I[4] = {0xffffu, 0xffffu, 0xffffu, 0xffffu};
  if (EXACT) {
    unsigned ix[4][NPL];
    int need[4];
#pragma unroll
    for (int q = 0; q < 4; q++) {
      int cgt = 0;
#pragma unroll
      for (int j = 0; j < NPL; j++) {
        const int e = j * 64 + lane;
        ix[q][j] = (e < n[q]) ? (unsigned)idxs[q * CAP + e] : 0xffffu;
        cgt += wcount(key[q][j] > Tk[q]);
      }
      need[q] = TOPK - cgt;
      I[q] = 0u;
    }
#pragma unroll 1
    for (int bit = 13; bit >= 0; bit--) {
#pragma unroll
      for (int q = 0; q < 4; q++) {
        const unsigned cand = I[q] | (1u << bit);
        int c = 0;
#pragma unroll
        for (int j = 0; j < NPL; j++) c += wcount(key[q][j] == Tk[q] && ix[q][j] < cand);
        I[q] = (c < need[q]) ? cand : I[q];
        if (q == 1) __builtin_amdgcn_sched_barrier(0);
      }
    }
  }
  const unsigned long long lt = (1ull << lane) - 1ull;
#pragma unroll
  for (int q = 0; q < 4; q++) {
    if (n[q] > TOPK) {
      int base = 0;
#pragma unroll
      for (int j = 0; j < NPL; j++) {
        const int e = j * 64 + lane;
        const bool in = e < n[q];
        const float v = in ? vals[q * CAP + e] : 0.f;
        const unsigned ixv = in ? (unsigned)idxs[q * CAP + e] : 0xffffu;
        const bool keep = (key[q][j] > Tk[q]) || (key[q][j] == Tk[q] && ixv <= I[q]);
        const unsigned long long m = __ballot(keep);
        if (keep) {
          const int pos = base + __popcll(m & lt);
          vals[q * CAP + pos] = v;
          idxs[q * CAP + pos] = (u16)ixv;
        }
        base += __popcll(m);
      }
      if (lane == 0) cnt[q] = base;
      thr_out[q] = mono_inv(Tk[q]);
    }
  }
}

DI void indexer_phase(const u16* __restrict__ iq, const u16* __restrict__ ik, const float* __restrict__ iw,
                      u16* __restrict__ sel, char* smem, int bid, int nb) {
  constexpr int WBYTES = 4 * CAP * 4 + 4 * CAP * 2 + 64;
  const int tid = opq_tid(), lane = tid & 63, w = __builtin_amdgcn_readfirstlane(tid >> 6), l31 = lane & 31, u = lane >> 5;
  float* vals = (float*)(smem + w * WBYTES);
  u16* idxs = (u16*)(smem + w * WBYTES + 4 * CAP * 4);
  int* cnt = (int*)(smem + w * WBYTES + 4 * CAP * 4 + 4 * CAP * 2);
  const int nitems = NBATCH * (S / 16);
  const int nrounds = (nitems + nb - 1) / nb;
  __syncthreads();
  for (int rd = 0; rd < nrounds; rd++) {
    const int it = rd * nb + ((rd & 1) ? (nb - 1 - bid) : bid);
    if (it >= nitems) continue;
    const int b = it & 3, qg = (S / 16 - 1) - (it >> 2);
    const int t0 = qg * 16;
    const int tw = t0 + 4 * w;
    const size_t tb = (size_t)b * S;
    bf16x8 aq[4];
    {
      const int g = l31 >> 3, up = (l31 >> 2) & 1, j = l31 & 3;
      const int ql = 2 * up + (g >> 1), hd = 4 * (g & 1) + j;
      const u16* qp = iq + (tb + tw + ql) * 512 + hd * 64 + u * 8;
#pragma unroll
      for (int ks = 0; ks < 4; ks++) aq[ks] = *(const bf16x8*)(qp + ks * 16);
    }
    float wq[2][8];
#pragma unroll
    for (int qq = 0; qq < 2; qq++) {
      const float* wp = iw + (tb + tw + 2 * u + qq) * 8;
      f32x4 w0 = *(const f32x4*)wp, w1 = *(const f32x4*)(wp + 4);
#pragma unroll
      for (int h = 0; h < 4; h++) {
        wq[qq][h] = w0[h];
        wq[qq][4 + h] = w1[h];
      }
    }
    float thr[2] = {-INFINITY, -INFINITY};
    __builtin_amdgcn_wave_barrier();
    if (lane < 4) cnt[lane] = 0;
    __builtin_amdgcn_wave_barrier();
    const int nkb = (tw + 3) / 32 + 1;
    const u16* kp = ik + tb * 64 + lane * 8;
    bf16x8 ring[4][4];
#pragma unroll
    for (int i = 0; i < 4; i++) {
      const int kbn = (i < nkb) ? i : nkb - 1;
#pragma unroll
      for (int ks = 0; ks < 4; ks++) ring[i][ks] = *(const bf16x8*)(kp + (size_t)(kbn * 4 + ks) * 512);
    }
#pragma unroll 1
    for (int kb0 = 0; kb0 < nkb; kb0 += 4) {
#pragma unroll
      for (int i = 0; i < 4; i++) {
        const int kb = kb0 + i;
        {
          f32x16 acc;
#pragma unroll
          for (int r = 0; r < 16; r++) acc[r] = 0.f;
#pragma unroll
          for (int ks = 0; ks < 4; ks++) acc = mfma32(aq[ks], ring[i][ks], acc);
          {
            const int kbn = (kb + 4 < nkb) ? kb + 4 : nkb - 1;
#pragma unroll
            for (int ks = 0; ks < 4; ks++) ring[i][ks] = *(const bf16x8*)(kp + (size_t)(kbn * 4 + ks) * 512);
          }
          const int key = kb * 32 + l31;
#pragma unroll
          for (int qq = 0; qq < 2; qq++) {
            float s0 = 0.f, s1 = 0.f;
#pragma unroll
            for (int h = 0; h < 8; h += 2) {
              s0 = fmaf(wq[qq][h], relu_i(acc[8 * qq + h]), s0);
              s1 = fmaf(wq[qq][h + 1], relu_i(acc[8 * qq + h + 1]), s1);
            }
            float s = s0 + s1;
            s += 0.0f;
            const int tq = tw + 2 * u + qq;
            if (key <= tq && s >= thr[qq]) {
              const int qs = 2 * u + qq;
              const int pos = atomicAdd(&cnt[qs], 1);
              vals[qs * CAP + pos] = s;
              idxs[qs * CAP + pos] = (u16)key;
            }
          }
        }
      }
      __builtin_amdgcn_wave_barrier();
      const int c0 = cnt[0], c1 = cnt[1], c2 = cnt[2], c3 = cnt[3];
      if (c0 > CAP - 128 || c1 > CAP - 128 || c2 > CAP - 128 || c3 > CAP - 128) {
        float to[4] = {0.f, 0.f, 0.f, 0.f};
        compact4<false>(vals, idxs, cnt, lane, to);
        __builtin_amdgcn_wave_barrier();
        const int d0 = cnt[0], d1 = cnt[1], d2 = cnt[2], d3 = cnt[3];
        if (d0 > CAP - 256 || d1 > CAP - 256 || d2 > CAP - 256 || d3 > CAP - 256) {
          compact4<true>(vals, idxs, cnt, lane, to);
          __builtin_amdgcn_wave_barrier();
        }
        if (c0 > TOPK && u == 0) thr[0] = to[0];
        if (c1 > TOPK && u == 0) thr[1] = to[1];
        if (c2 > TOPK && u == 1) thr[0] = to[2];
        if (c3 > TOPK && u == 1) thr[1] = to[3];
      }
    }
    {
      const int c0 = cnt[0], c1 = cnt[1], c2 = cnt[2], c3 = cnt[3];
      if (c0 > TOPK || c1 > TOPK || c2 > TOPK || c3 > TOPK) {
        float to[4];
        compact4<true>(vals, idxs, cnt, lane, to);
        __builtin_amdgcn_wave_barrier();
      }
    }
#pragma unroll 1
    for (int qs = 0; qs < 4; qs++) {
      const int n = cnt[qs];
      u16* sp = sel + (tb + tw + qs) * 256;
#pragma unroll
      for (int j = 0; j < 4; j++) {
        const int e = j * 64 + lane;
        sp[e] = (e < n) ? idxs[qs * CAP + e] : (u16)0xffffu;
      }
    }
  }
}

DI void sparse_phase(const u16* __restrict__ q, const u16* __restrict__ ckvn, const u16* __restrict__ sel,
                     const u16* __restrict__ wuk, const u16* __restrict__ wuv, const float* __restrict__ rel_bias,
                     u16* scratch, u16* __restrict__ o, char* smem, int bid, int nb) {
  constexpr int GS = 264;
  const int tid = opq_tid(), lane = tid & 63, w = __builtin_amdgcn_readfirstlane(tid >> 6), l15 = lane & 15, g = lane >> 4;
  u16* G = (u16*)smem + (size_t)w * 32 * GS;
  int* lut = (int*)(smem + 4 * 32 * GS * 2);
  float* rb = (float*)(lut + 128);
  __syncthreads();
  if (tid < 128) lut[tid] = rel_bucket(tid);
  for (int i = tid; i < 512; i += 256) rb[i] = rel_bias[i] * LOG2E;
  __syncthreads();
  u16* ql = scratch + (size_t)bid * (16 * 16 * 256);
  const int nitems = NBATCH * (S / 16);
  for (int it = bid; it < nitems; it += nb) {
    const int b = it & 3, qg = it >> 2;
    const int t0 = qg * 16;
    const size_t tb = (size_t)b * S;
    for (int hh = 0; hh < 4; hh++) {
      const int h = 4 * w + hh;
      bf16x8 bq[2];
#pragma unroll
      for (int ks = 0; ks < 2; ks++) bq[ks] = *(const bf16x8*)(q + (tb + t0 + l15) * 1024 + h * 64 + ks * 32 + g * 8);
#pragma unroll 4
      for (int rt = 0; rt < 16; rt++) {
        f32x4 acc = {0.f, 0.f, 0.f, 0.f};
#pragma unroll
        for (int ks = 0; ks < 2; ks++) {
          bf16x8 a = *(const bf16x8*)(wuk + ((size_t)h * 256 + rt * 16 + l15) * 64 + ks * 32 + g * 8);
          acc = mfma16(a, bq[ks], acc);
        }
        u32x2 ov;
        ov[0] = pk2(acc[0] * (0.125f * LOG2E), acc[1] * (0.125f * LOG2E));
        ov[1] = pk2(acc[2] * (0.125f * LOG2E), acc[3] * (0.125f * LOG2E));
        *(u32x2*)(ql + ((size_t)l15 * 16 + h) * 256 + rt * 16 + 4 * g) = ov;
      }
    }
    __syncthreads();
    {
      const u16* selw = sel + (tb + t0 + 4 * w) * 256;
      const int l31 = lane & 31;
      const int q4 = l15 >> 2, p4 = l15 & 3;
      const u16* ckb = ckvn + tb * 256;
      int idx_c = selw[l31];
      int idx_n = selw[32 + l31];
      u32x4 gr[16];
#pragma unroll
      for (int i = 0; i < 16; i++) {
        int id = __shfl(idx_c, (lane >> 5) + 2 * i);
        id = (id == 0xffff) ? 0 : id;
        gr[i] = *(const u32x4*)(ckb + (unsigned)(id * 256 + l31 * 8));
      }
      bf16x8 qb[8];
      float m_run = NEGF, l_run = 0.f;
      f32x4 O[16];
#pragma unroll 1
      for (int st = 0; st < 32; st++) {
        const int qi = st >> 3, ch = st & 7;
        const int qloc = 4 * w + qi;
        const int t = t0 + qloc;
        if (ch == 0) {
#pragma unroll
          for (int ks = 0; ks < 8; ks++) qb[ks] = *(const bf16x8*)(ql + ((size_t)qloc * 16 + l15) * 256 + ks * 32 + g * 8);
          m_run = NEGF;
          l_run = 0.f;
#pragma unroll
          for (int rt = 0; rt < 16; rt++) O[rt] = (f32x4){0.f, 0.f, 0.f, 0.f};
        }
#pragma unroll
        for (int i = 0; i < 16; i++) *(u32x4*)&G[((lane >> 5) + 2 * i) * GS + l31 * 8] = gr[i];
        __builtin_amdgcn_wave_barrier();
        const int stn2 = (st + 2 < 32) ? st + 2 : 31;
        const int idx_nn = selw[stn2 * 32 + l31];
#pragma unroll
        for (int i = 0; i < 16; i++) {
          int id = __shfl(idx_n, (lane >> 5) + 2 * i);
          id = (id == 0xffff) ? 0 : id;
          gr[i] = *(const u32x4*)(ckb + (unsigned)(id * 256 + l31 * 8));
        }
        float lg[2][4];
#pragma unroll
        for (int kbk = 0; kbk < 2; kbk++) {
          f32x4 acc = {0.f, 0.f, 0.f, 0.f};
#pragma unroll
          for (int ks = 0; ks < 8; ks++) {
            bf16x8 a = *(const bf16x8*)&G[(16 * kbk + l15) * GS + ks * 32 + g * 8];
            acc = mfma16(a, qb[ks], acc);
            if (ks == 3) asm volatile("" ::: "memory");
          }
          asm volatile("" ::: "memory");
#pragma unroll
          for (int i = 0; i < 4; i++) {
            const int kid = __shfl(idx_c, 16 * kbk + 4 * g + i);
            float v = NEGF;
            if (kid != 0xffff) {
              int n = t - kid;
              n = n < 0 ? 0 : n;
              const int bk = n < 128 ? lut[n] : 31;
              v = acc[i] + rb[bk * 16 + l15];
            }
            lg[kbk][i] = v;
          }
        }
        float mx = fmaxf(fmaxf(fmaxf(lg[0][0], lg[0][1]), fmaxf(lg[0][2], lg[0][3])),
                         fmaxf(fmaxf(lg[1][0], lg[1][1]), fmaxf(lg[1][2], lg[1][3])));
        mx = fmaxf(mx, __shfl_xor(mx, 16));
        mx = fmaxf(mx, __shfl_xor(mx, 32));
        const float m_new = fmaxf(m_run, mx);
        const float scl = __builtin_amdgcn_exp2f(m_run - m_new);
        m_run = m_new;
        float ps = 0.f;
        float pe[8];
#pragma unroll
        for (int kbk = 0; kbk < 2; kbk++)
#pragma unroll
          for (int i = 0; i < 4; i++) {
            const float pv = __builtin_amdgcn_exp2f(lg[kbk][i] - m_new);
            pe[kbk * 4 + i] = pv;
            ps += pv;
          }
        l_run = l_run * scl + ps;
        u32x4 pw;
        pw[0] = pk2(pe[0], pe[1]);
        pw[1] = pk2(pe[2], pe[3]);
        pw[2] = pk2(pe[4], pe[5]);
        pw[3] = pk2(pe[6], pe[7]);
        const bf16x8 pB = __builtin_bit_cast(bf16x8, pw);
        if (__ballot(scl != 1.f)) {
#pragma unroll
          for (int rt = 0; rt < 16; rt++) O[rt] = O[rt] * scl;
        }
#pragma unroll
        for (int rt = 0; rt < 16; rt++) {
          const s16x4 lo = __builtin_amdgcn_ds_read_tr16_b64_v4i16((lds_s16x4_ptr)(&G[(4 * g + q4) * GS + rt * 16 + 4 * p4]));
          const s16x4 hi = __builtin_amdgcn_ds_read_tr16_b64_v4i16((lds_s16x4_ptr)(&G[(16 + 4 * g + q4) * GS + rt * 16 + 4 * p4]));
          const bf16x8 a = (bf16x8){lo[0], lo[1], lo[2], lo[3], hi[0], hi[1], hi[2], hi[3]};
          O[rt] = mfma16(a, pB, O[rt]);
          if ((rt & 3) == 3) asm volatile("" ::: "memory");
        }
        __builtin_amdgcn_wave_barrier();
        if (ch == 7) {
          float lt = l_run;
          lt += __shfl_xor(lt, 16);
          lt += __shfl_xor(lt, 32);
          const float inv = 1.f / lt;
#pragma unroll
          for (int rt = 0; rt < 16; rt++) {
            u32x2 ov;
            ov[0] = pk2(O[rt][0] * inv, O[rt][1] * inv);
            ov[1] = pk2(O[rt][2] * inv, O[rt][3] * inv);
            *(u32x2*)(ql + ((size_t)qloc * 16 + l15) * 256 + rt * 16 + 4 * g) = ov;
          }
        }
        idx_c = idx_n;
        idx_n = idx_nn;
      }
    }
    __syncthreads();
    for (int hh = 0; hh < 4; hh++) {
      const int h = 4 * w + hh;
      bf16x8 bo[8];
#pragma unroll
      for (int ks = 0; ks < 8; ks++) bo[ks] = *(const bf16x8*)(ql + ((size_t)l15 * 16 + h) * 256 + ks * 32 + g * 8);
#pragma unroll
      for (int et = 0; et < 4; et++) {
        f32x4 acc = {0.f, 0.f, 0.f, 0.f};
#pragma unroll
        for (int ks = 0; ks < 8; ks++) {
          bf16x8 a = *(const bf16x8*)(wuv + ((size_t)h * 64 + et * 16 + l15) * 256 + ks * 32 + g * 8);
          acc = mfma16(a, bo[ks], acc);
        }
        u32x2 ov;
        ov[0] = pk2(acc[0], acc[1]);
        ov[1] = pk2(acc[2], acc[3]);
        *(u32x2*)(o + (tb + t0 + l15) * 1024 + h * 64 + et * 16 + 4 * g) = ov;
      }
    }
    __syncthreads();
  }
}

DI void diffattn_phase(const u16* __restrict__ q, const u16* __restrict__ k, const u16* __restrict__ vT,
                       u16* __restrict__ o, const float* __restrict__ rel_bias, const float* __restrict__ lam,
                       const float* __restrict__ subln, int layer_idx, char* smem, int bid, int nb) {
  constexpr int KS = 136, VS = 72;
  u16* Ks = (u16*)smem;
  u16* Vs = Ks + 64 * KS;
  float* exch = (float*)smem;
  constexpr int STG = 64 * KS + 128 * VS;
  float* btab = (float*)(smem + 72 * 1024);
  int* lut = (int*)(smem + 72 * 1024 + 1040);
  float* misc = (float*)(smem + 72 * 1024 + 1040 + 512);
  const int tid = opq_tid8(), lane = tid & 63, w = __builtin_amdgcn_readfirstlane(tid >> 6), l31 = lane & 31, lh = lane >> 5;
  const int qsub = w >> 1, m = w & 1;
  const float lam_init = 0.8f - 0.6f * expf(-0.3f * (float)layer_idx);
  __syncthreads();
  if (tid < 128) lut[tid] = rel_bucket(tid);
  if (w == 0) {
    float p1 = lam[lane] * lam[64 + lane], p2 = lam[128 + lane] * lam[192 + lane];
    p1 = wave_sum(p1);
    p2 = wave_sum(p2);
    if (lane == 0) misc[0] = expf(p1) - expf(p2) + lam_init;
  }
  __syncthreads();
  const float lam_full = misc[0];
  const int xcd = bid & 7, loc = bid >> 3, nbx = nb >> 3;
  const int rph = (S / 128) / nbx;
  const int prow = pi_row(l31);
  for (int rd = 0; rd < 4 * rph; rd++) {
    const int hh = rd / rph, r = rd - hh * rph;
    const int bh = xcd + 8 * hh;
    const int kk = r >> 1;
    const int qb = (r & 1) ? (kk * nbx + loc) : ((S / 128 - 1) - kk * nbx - loc);
    const int b = bh >> 3, h = bh & 7;
    const int q0 = qb * 128, tq0 = q0 + 32 * qsub, t = tq0 + l31;
    const size_t tb = (size_t)b * S;
    __syncthreads();
    for (int i = tid; i < 258; i += 512) {
      const int n = i >> 1, mm = i & 1;
      const int bk = n < 128 ? lut[n] : 31;
      btab[i] = rel_bias[bk * 16 + 2 * h + mm] * LOG2E;
    }
    bf16x8 qf[4];
#pragma unroll
    for (int ks = 0; ks < 4; ks++) qf[ks] = *(const bf16x8*)(q + (tb + t) * 1024 + h * 128 + m * 64 + ks * 16 + lh * 8);
    f32x16 O[4];
#pragma unroll
    for (int et = 0; et < 4; et++)
#pragma unroll
      for (int r = 0; r < 16; r++) O[et][r] = 0.f;
    float m_run = NEGF, l_run = 0.f;
    const int nkt = 2 * qb + 2;
    u32x4 rk[2], rv[2];
    const u16* kp = k + tb * 1024 + h * 128;
    const u16* vp = vT + ((size_t)(b * 8 + h) * 128) * 8192;
#pragma unroll
    for (int i = 0; i < 2; i++) {
      const int id = tid + 512 * i;
      rk[i] = *(const u32x4*)(kp + (size_t)(id >> 4) * 1024 + (id & 15) * 8);
      rv[i] = *(const u32x4*)(vp + (size_t)(id >> 3) * 8192 + (id & 7) * 8);
    }
#pragma unroll
    for (int i = 0; i < 2; i++) {
      const int id = tid + 512 * i;
      *(u32x4*)&Ks[(id >> 4) * KS + (id & 15) * 8] = rk[i];
      *(u32x4*)&Vs[(id >> 3) * VS + (id & 7) * 8] = rv[i];
    }
#pragma unroll
    for (int i = 0; i < 2; i++) {
      const int id = tid + 512 * i;
      rk[i] = *(const u32x4*)(kp + (size_t)(64 + (id >> 4)) * 1024 + (id & 15) * 8);
      rv[i] = *(const u32x4*)(vp + (size_t)(id >> 3) * 8192 + 64 + (id & 7) * 8);
    }
    __syncthreads();
    const float cfar = btab[256 + m];
    for (int kt = 0; kt < nkt; kt++) {
      const u16* Ksc = Ks + (kt & 1) * STG;
      const u16* Vsc = Vs + (kt & 1) * STG;
      if (kt + 1 < nkt) {
        u16* Ksn = Ks + ((kt & 1) ^ 1) * STG;
        u16* Vsn = Vs + ((kt & 1) ^ 1) * STG;
#pragma unroll
        for (int i = 0; i < 2; i++) {
          const int id = tid + 512 * i;
          *(u32x4*)&Ksn[(id >> 4) * KS + (id & 15) * 8] = rk[i];
          *(u32x4*)&Vsn[(id >> 3) * VS + (id & 7) * 8] = rv[i];
        }
        const int k2 = (kt + 2 < nkt) ? kt + 2 : nkt - 1;
#pragma unroll
        for (int i = 0; i < 2; i++) {
          const int id = tid + 512 * i;
          rk[i] = *(const u32x4*)(kp + (size_t)(k2 * 64 + (id >> 4)) * 1024 + (id & 15) * 8);
          rv[i] = *(const u32x4*)(vp + (size_t)(id >> 3) * 8192 + k2 * 64 + (id & 7) * 8);
        }
      }
      const int s_tile = kt * 64;
      const int remk = tq0 + 31 - s_tile;
      const int nblk = remk < 0 ? 0 : (remk >= 32 ? 2 : 1);
#pragma unroll
      for (int kb = 0; kb < 2; kb++) {
        if (kb >= nblk) break;
        const int s0 = s_tile + 32 * kb;
        const bool nearb = (tq0 - (s0 + 31)) < 128;
        const bool first = (kt == 0) && (kb == 0);
        const float mref = first ? 0.f : m_run;
        const float cinit = nearb ? -mref : (cfar - mref);
        f32x16 acc;
#pragma unroll
        for (int r = 0; r < 16; r++) acc[r] = cinit;
#pragma unroll
        for (int ks = 0; ks < 4; ks++) {
          bf16x8 a = *(const bf16x8*)&Ksc[(32 * kb + prow) * KS + m * 64 + ks * 16 + lh * 8];
          acc = mfma32(a, qf[ks], acc);
        }
        bf16x8 vfa[4];
#pragma unroll
        for (int et = 0; et < 4; et++) vfa[et] = *(const bf16x8*)&Vsc[(32 * et + l31) * VS + 32 * kb + 8 * lh];
        __builtin_amdgcn_sched_barrier(0);
        if (nearb) {
#pragma unroll
          for (int r = 0; r < 16; r++) {
            const int key = s0 + 16 * (r >> 3) + 8 * lh + (r & 7);
            const int n = t - key;
            const int nc = n < 0 ? 0 : (n > 128 ? 128 : n);
            const float bv = btab[nc * 2 + m];
            acc[r] = (n < 0) ? NEGF : acc[r] + bv;
          }
        }
        float mx = acc[0];
#pragma unroll
        for (int r = 1; r < 16; r++) mx = fmaxf(mx, acc[r]);
        mx = fmaxf(mx, __shfl_xor(mx, 32));
        if (first || __ballot(mx > 8.f)) {
          const float dlt = first ? mx : fmaxf(mx, 0.f);
          const float scl = __builtin_amdgcn_exp2f(-dlt);
#pragma unroll
          for (int r = 0; r < 16; r++) acc[r] -= dlt;
#pragma unroll
          for (int et = 0; et < 4; et++)
#pragma unroll
            for (int r = 0; r < 16; r++) O[et][r] *= scl;
          l_run *= scl;
          m_run = mref + dlt;
        }
        float ps = 0.f;
#pragma unroll
        for (int r = 0; r < 16; r++) {
          const float pv = __builtin_amdgcn_exp2f(acc[r]);
          acc[r] = pv;
          ps += pv;
        }
        l_run += ps;
        bf16x8 vfb[4];
#pragma unroll
        for (int et = 0; et < 4; et++) vfb[et] = *(const bf16x8*)&Vsc[(32 * et + l31) * VS + 32 * kb + 16 + 8 * lh];
        u32x4 pw0, pw1;
        pw0[0] = pk2(acc[0], acc[1]);
        pw0[1] = pk2(acc[2], acc[3]);
        pw0[2] = pk2(acc[4], acc[5]);
        pw0[3] = pk2(acc[6], acc[7]);
        pw1[0] = pk2(acc[8], acc[9]);
        pw1[1] = pk2(acc[10], acc[11]);
        pw1[2] = pk2(acc[12], acc[13]);
        pw1[3] = pk2(acc[14], acc[15]);
        const bf16x8 pB0 = __builtin_bit_cast(bf16x8, pw0), pB1 = __builtin_bit_cast(bf16x8, pw1);
        __builtin_amdgcn_sched_barrier(0);
#pragma unroll
        for (int et = 0; et < 4; et++) O[et] = mfma32(vfa[et], pB0, O[et]);
#pragma unroll
        for (int et = 0; et < 4; et++) O[et] = mfma32(vfb[et], pB1, O[et]);
      }
      __syncthreads();
    }
    float lt = l_run + __shfl_xor(l_run, 32);
    const float inv = 1.f / lt;
    if (m == 1) {
#pragma unroll
      for (int et = 0; et < 4; et++)
#pragma unroll
        for (int r = 0; r < 16; r++) {
          const int e = 32 * et + (r & 3) + 8 * (r >> 2) + 4 * lh;
          exch[(qsub * 128 + e) * 32 + l31] = O[et][r] * inv;
        }
    }
    __syncthreads();
    if (m == 0) {
      float ss = 0.f;
#pragma unroll
      for (int et = 0; et < 4; et++)
#pragma unroll
        for (int r = 0; r < 16; r++) {
          const int e = 32 * et + (r & 3) + 8 * (r >> 2) + 4 * lh;
          const float v = O[et][r] * inv - lam_full * exch[(qsub * 128 + e) * 32 + l31];
          O[et][r] = v;
          ss += v * v;
        }
      ss += __shfl_xor(ss, 32);
      const float rs = rsqrtf(ss * (1.f / 128.f) + LN_EPS);
      const float osc = 1.f - lam_init;
#pragma unroll
      for (int et = 0; et < 4; et++)
#pragma unroll
        for (int r4 = 0; r4 < 4; r4++) {
          const int e = 32 * et + 8 * r4 + 4 * lh;
          const f32x4 gv = *(const f32x4*)(subln + e);
          u32x2 ov;
          ov[0] = pk2(O[et][4 * r4 + 0] * rs * gv[0] * osc, O[et][4 * r4 + 1] * rs * gv[1] * osc);
          ov[1] = pk2(O[et][4 * r4 + 2] * rs * gv[2] * osc, O[et][4 * r4 + 3] * rs * gv[3] * osc);
          *(u32x2*)(o + (tb + t) * 1024 + h * 128 + e) = ov;
        }
    }
  }
}

#define XB_TMO      128
#define XB_XCNT(j)  (256  + 64 * (j))
#define XB_XSUB(j)  (1280 + 64 * (j))
#define XB_XGEN(j)  (2304 + 64 * (j))
#define XB_TOP      3328
#define XB_TOPGEN   3392
#define XCD_BAR_WORDS 3456
#define XB_SPIN_CAP (1u << 20)
#define LAS __attribute__((address_space(3)))
DI unsigned xb_ld(unsigned* p) { return __hip_atomic_load(p, __ATOMIC_RELAXED, __HIP_MEMORY_SCOPE_AGENT); }
DI unsigned xb_add(unsigned* p, unsigned v) { return __hip_atomic_fetch_add(p, v, __ATOMIC_RELAXED, __HIP_MEMORY_SCOPE_AGENT); }
DI unsigned xb_xcc_id() { return (unsigned)__builtin_amdgcn_s_getreg((3 << 11) | 20) & 0xFu; }
#define XB_SPIN(cond, bar) do { unsigned _sp = 0; while (cond) { __builtin_amdgcn_s_sleep(1); \
    if ((++_sp & 255u) == 0u) { if (xb_ld(&(bar)[XB_TMO])) break; if (_sp > XB_SPIN_CAP) { atomicAdd(&(bar)[XB_TMO], 1u); break; } } } } while (0)
struct XcdBarrier {
  unsigned* bar;
  unsigned x;
  volatile LAS unsigned* st;
};
DI XcdBarrier xcd_barrier_post(unsigned* bar, volatile LAS unsigned* st) {
  XcdBarrier b;
  b.bar = bar;
  b.x = xb_xcc_id();
  b.st = st;
  if (threadIdx.x == 0) (void)xb_add(&bar[XB_XCNT(b.x)], 1u);
  return b;
}
DI void xcd_barrier_complete(unsigned* bar, unsigned x, unsigned& nloc, unsigned& nx) {
  const unsigned G = gridDim.x * gridDim.y * gridDim.z;
  unsigned sum, cnt, mine, sp = 0u;
  for (;;) {
    sum = 0u; cnt = 0u; mine = 0u;
#pragma unroll
    for (unsigned j = 0; j < 16; ++j) {
      const unsigned c = xb_ld(&bar[XB_XCNT(j)]);
      sum += c;
      cnt += (c > 0u) ? 1u : 0u;
      mine = (j == x) ? c : mine;
    }
    if (sum == G) break;
    __builtin_amdgcn_s_sleep(1);
    if ((++sp & 255u) == 0u) { if (xb_ld(&bar[XB_TMO])) break; if (sp > XB_SPIN_CAP) { atomicAdd(&bar[XB_TMO], 1u); break; } }
  }
  nloc = mine > 0u ? mine : 1u;
  nx = cnt > 0u ? cnt : 1u;
}
DI void xcd_barrier(const XcdBarrier& b0) {
  asm volatile("s_waitcnt vmcnt(0)" ::: "memory");
  __syncthreads();
  if (threadIdx.x == 0) {
    XcdBarrier b = b0;
    b.x = __builtin_amdgcn_readfirstlane(xb_xcc_id());
    unsigned* bar = b.bar;
    asm volatile("" : "+s"(bar));
    __builtin_amdgcn_s_waitcnt(0);
    unsigned nloc = b.st[0], nx = b.st[1];
    if (nloc == 0u) { xcd_barrier_complete(bar, b.x, nloc, nx); b.st[0] = nloc; b.st[1] = nx; }
    const unsigned old = xb_add(&bar[XB_XSUB(b.x)], 1u);
    const unsigned gen = old / nloc;
    if (old + 1u == (gen + 1u) * nloc) {
      __builtin_amdgcn_fence(__ATOMIC_RELEASE, "agent");
      asm volatile("s_waitcnt vmcnt(0)" ::: "memory");
      const unsigned og = xb_add(&bar[XB_TOP], 1u);
      const unsigned tg = og / nx;
      if (og + 1u == (tg + 1u) * nx) xb_add(&bar[XB_TOPGEN], 1u);
      else XB_SPIN(xb_ld(&bar[XB_TOPGEN]) == tg, bar);
      __builtin_amdgcn_fence(__ATOMIC_ACQUIRE, "agent");
      xb_add(&bar[XB_XGEN(b.x)], 1u);
      asm volatile("s_waitcnt vmcnt(0)" ::: "memory");
    } else {
      XB_SPIN(xb_ld(&bar[XB_XGEN(b.x)]) == gen, bar);
      __builtin_amdgcn_fence(__ATOMIC_ACQUIRE, "agent");
      asm volatile("s_waitcnt vmcnt(0)" ::: "memory");
    }
  }
  __syncthreads();
}

#define DECL_WS_PTRS(ws) \
  u16* w_ain = (u16*)(ws + W_AIN); \
  u16* w_uk = (u16*)(ws + W_UK); \
  u16* w_uv = (u16*)(ws + W_UV); \
  u16* w_ao = (u16*)(ws + W_AO); \
  u16* w_bin = (u16*)(ws + W_BIN); \
  u16* w_bo = (u16*)(ws + W_BO); \
  u16* w_w1 = (u16*)(ws + W_W1); \
  u16* w_w2 = (u16*)(ws + W_W2); \
  float* mod = (float*)(ws + WS_MOD); \
  u16* hbuf = (u16*)(ws + WS_H); \
  char* big = ws + WS_BIG; \
  u16* qbuf = (u16*)(big + B_Q); \
  u16* iqbuf = (u16*)(big + B_IQ); \
  u16* ikbuf = (u16*)(big + B_IK); \
  float* iwbuf = (float*)(big + B_IW); \
  float* ckvraw = (float*)(big + B_CKVRAW); \
  u16* ckvn = (u16*)(big + B_CKVN); \
  u16* selbuf = (u16*)(big + B_SEL); \
  u16* kbuf = (u16*)(big + B_K); \
  u16* vtbuf = (u16*)(big + B_VT); \
  u16* obuf = (u16*)(big + B_O); \
  u16* hid = (u16*)big;

__global__ void __launch_bounds__(512, 2) hybrid_fwd(Params p) {
  __shared__ __attribute__((aligned(16))) char smem[2 * LDS_BYTES];
  cg::grid_group grid = cg::this_grid();
  const int bid = blockIdx.x, nb = gridDim.x;
  const int half = __builtin_amdgcn_readfirstlane((int)(threadIdx.x >> 8));
  const int vb = half * nb + bid, nvb = 2 * nb;
  char* smh = smem + half * LDS_BYTES;
  char* ws = p.ws;
  unsigned* bar = (unsigned*)(ws + WS_BAR);
  volatile LAS unsigned* xst = (volatile LAS unsigned*)(smem + 2 * LDS_BYTES - 16);
  if (threadIdx.x < 2) xst[threadIdx.x] = 0u;
  __syncthreads();
  const XcdBarrier xb = xcd_barrier_post(bar, xst);

  {
  DECL_WS_PTRS(ws)
  (void)qbuf; (void)iqbuf; (void)ikbuf; (void)iwbuf; (void)ckvraw; (void)ckvn; (void)selbuf; (void)kbuf; (void)vtbuf; (void)obuf; (void)hid;
  tconv_phase(p.a_w_in, w_ain, 2, 1024, 1864, A_INP, smh, vb, nvb);
  tconv_phase(p.a_w_uk, w_uk, 32, 64, 256, 256, smh, vb, nvb);
  tconv_phase(p.a_w_uv, w_uv, 32, 256, 64, 64, smh, vb, nvb);
  tconv_phase(p.a_w_o, w_ao, 2, 1024, 1024, 1024, smh, vb, nvb);
  tconv_phase(p.b_w_in, w_bin, 2, 1024, 3072, 3072, smh, vb, nvb);
  tconv_phase(p.b_w_o, w_bo, 2, 1024, 1024, 1024, smh, vb, nvb);
  tconv_phase(p.mlp_w1, w_w1, 4, 1024, 4096, 4096, smh, vb, nvb);
  tconv_phase(p.mlp_w2, w_w2, 4, 4096, 1024, 1024, smh, vb, nvb);
  mod_phase(p, mod, smh, vb, nvb);
  grid.sync();
  h0_phase(p.x, mod, hbuf, vb, nvb);
  xcd_barrier(xb);
  }

#pragma unroll 1
  for (int sl = 0; sl < 8; sl++) {
    char* wsl = p.ws;
    asm volatile("" : "+s"(wsl));
    DECL_WS_PTRS(wsl)
    const int i = sl >> 1, j = i >> 1;
    const float* modi = mod + (size_t)i * 4 * 6144;
    const u16* Ares;
    const u16* Wres;
    int Kres, goff;
    if ((sl & 1) == 0) {
      if ((i & 1) == 0) {
        EpiArgs ea{};
        ea.o0 = qbuf; ea.f0 = ckvraw; ea.o1 = iqbuf; ea.o2 = ikbuf; ea.f1 = iwbuf;
        for (int rep = 0; rep < (PROBE_DUP == 4 ? 2 : 1); rep++) gemm8p_phase<EPI_AIN>(hbuf, w_ain + (size_t)j * A_INP * 1024, T, A_INP, 1024, ea, smem, bid, nb);
        xcd_barrier(xb);
        ckvnorm_phase(ckvraw, p.a_kv_norm + j * 256, ckvn, vb, nvb);
        for (int rep = 0; rep < (PROBE_DUP == 2 ? 2 : 1); rep++) indexer_phase(iqbuf, ikbuf, iwbuf, selbuf, smh, vb, nvb);
        xcd_barrier(xb);
        for (int rep = 0; rep < (PROBE_DUP == 3 ? 2 : 1); rep++) sparse_phase(qbuf, ckvn, selbuf, w_uk + (size_t)j * 16 * 256 * 64, w_uv + (size_t)j * 16 * 256 * 64, p.rel_bias,
                     hbuf, obuf, smh, vb, nvb);
        xcd_barrier(xb);
        Wres = w_ao + (size_t)j * 1024 * 1024;
      } else {
        EpiArgs ea{};
        ea.o0 = qbuf; ea.o1 = kbuf; ea.o2 = vtbuf;
        for (int rep = 0; rep < (PROBE_DUP == 4 ? 2 : 1); rep++) gemm8p_phase<EPI_BIN>(hbuf, w_bin + (size_t)j * 3072 * 1024, T, 3072, 1024, ea, smem, bid, nb);
        xcd_barrier(xb);
        for (int rep = 0; rep < (PROBE_DUP == 1 ? 2 : 1); rep++) diffattn_phase(qbuf, kbuf, vtbuf, obuf, p.rel_bias, p.b_lambda + j * 256, p.b_subln + j * 128, i, smem, bid, nb);
        xcd_barrier(xb);
        Wres = w_bo + (size_t)j * 1024 * 1024;
      }
      Ares = obuf; Kres = 1024; goff = 2 * 1024;
    } else {
      EpiArgs ea{};
      ea.o0 = hid;
      for (int rep = 0; rep < (PROBE_DUP == 4 ? 2 : 1); rep++) gemm8p_phase<EPI_SQRELU>(hbuf, w_w1 + (size_t)i * 4096 * 1024, T, 4096, 1024, ea, smem, bid, nb);
      xcd_barrier(xb);
      Ares = hid; Wres = w_w2 + (size_t)i * 4096 * 1024; Kres = 4096; goff = 5 * 1024;
    }
    {
      EpiArgs ea{};
      ea.f0 = p.out;
      ea.xin = (sl == 0) ? p.x : (const float*)p.out;
      ea.g = modi + goff;
      gemm8p_phase<EPI_RES>(Ares, Wres, T, 1024, Kres, ea, smem, bid, nb);
    }
    xcd_barrier(xb);
    {
      const float* modn = ((sl & 1) == 0) ? modi : (i < 3 ? modi + 4 * 6144 : (const float*)nullptr);
      const int sh_off = ((sl & 1) == 0) ? 3 * 1024 : 0;
      ln_phase(p.out, p.ln_g + (size_t)(i * 2 + (sl & 1)) * 1024, p.ln_b + (size_t)(i * 2 + (sl & 1)) * 1024, modn, sh_off,
               hbuf, vb, nvb);
    }
    xcd_barrier(xb);
  }
}

extern "C" void kernel_launch(void* const* d_in, const int* in_sizes, int n_in, void* d_out, int out_size, void* d_ws,
                              size_t ws_size, hipStream_t stream) {
  static int grid_blocks = 0;
  if (!grid_blocks) {
    int dev = 0, cus = 0, per_cu = 0;
    hipGetDevice(&dev);
    hipDeviceGetAttribute(&cus, hipDeviceAttributeMultiprocessorCount, dev);
    hipOccupancyMaxActiveBlocksPerMultiprocessor(&per_cu, hybrid_fwd, 512, 0);
    (void)per_cu;
    grid_blocks = cus;
    if (grid_blocks > 256) grid_blocks = 256;
  }
  Params p{};
  p.x = (const float*)d_in[0];
  p.c = (const float*)d_in[1];
  p.rel_bias = (const float*)d_in[2];
  p.ada_w = (const float*)d_in[3];
  p.ada_b = (const float*)d_in[4];
  p.ln_g = (const float*)d_in[5];
  p.ln_b = (const float*)d_in[6];
  p.a_w_in = (const float*)d_in[7];
  p.a_kv_norm = (const float*)d_in[8];
  p.a_w_uk = (const float*)d_in[9];
  p.a_w_uv = (const float*)d_in[10];
  p.a_w_o = (const float*)d_in[11];
  p.b_w_in = (const float*)d_in[12];
  p.b_lambda = (const float*)d_in[13];
  p.b_subln = (const float*)d_in[14];
  p.b_w_o = (const float*)d_in[15];
  p.mlp_w1 = (const float*)d_in[16];
  p.mlp_w2 = (const float*)d_in[17];
  p.out = (float*)d_out;
  p.ws = (char*)d_ws;
  hipMemsetAsync((char*)d_ws + WS_BAR, 0, XCD_BAR_WORDS * 4, stream);
  void* args[] = {&p};
  hipError_t e = hipLaunchCooperativeKernel((void*)hybrid_fwd, dim3(grid_blocks), dim3(512), args, 0, stream);
  if (e != hipSuccess) fprintf(stderr, "cooperative launch failed: %s (grid %d)\n", hipGetErrorString(e), grid_blocks);
}
```

```cpp
#include <hip/hip_runtime.h>
#include <hip/hip_cooperative_groups.h>
#include <stdint.h>
#include <stdio.h>
namespace cg = cooperative_groups;

typedef unsigned short u16;
typedef short bf16x8 __attribute__((ext_vector_type(8)));
typedef short s16x4 __attribute__((ext_vector_type(4)));
typedef float f32x16 __attribute__((ext_vector_type(16)));
typedef float f32x4 __attribute__((ext_vector_type(4)));
typedef float f32x2 __attribute__((ext_vector_type(2)));
typedef __bf16 bf16x2_t __attribute__((ext_vector_type(2)));
typedef unsigned u32x4 __attribute__((ext_vector_type(4)));
typedef unsigned u32x2 __attribute__((ext_vector_type(2)));
typedef __attribute__((address_space(3))) s16x4* lds_s16x4_ptr;

#define DI __device__ __forceinline__
#ifndef PROBE_DUP
#define PROBE_DUP 0
#endif

constexpr int D = 1024, NBATCH = 4, S = 8192, T = NBATCH * S;
constexpr int A_INP = 2048;
constexpr float DN_ALPHA = 1.6817928305074292f;
constexpr float LOG2E = 1.4426950408889634f;
constexpr float LN_EPS = 1e-5f;
constexpr float NEGF = -1e30f;
constexpr int TOPK = 256;
constexpr int CAP = 704;
constexpr int LDS_BYTES = 72 * 1024;

constexpr size_t MB = 1024 * 1024;
constexpr size_t W_AIN = 0;
constexpr size_t W_UK = W_AIN + (size_t)2 * 2048 * 1024 * 2;
constexpr size_t W_UV = W_UK + (size_t)2 * 16 * 256 * 64 * 2;
constexpr size_t W_AO = W_UV + (size_t)2 * 16 * 256 * 64 * 2;
constexpr size_t W_BIN = W_AO + (size_t)2 * 1024 * 1024 * 2;
constexpr size_t W_BO = W_BIN + (size_t)2 * 3072 * 1024 * 2;
constexpr size_t W_W1 = W_BO + (size_t)2 * 1024 * 1024 * 2;
constexpr size_t W_W2 = W_W1 + (size_t)4 * 4096 * 1024 * 2;
constexpr size_t WS_MOD = W_W2 + (size_t)4 * 4096 * 1024 * 2;
constexpr size_t WS_H = WS_MOD + 1 * MB;
constexpr size_t WS_BIG = WS_H + 64 * MB;
constexpr size_t WS_BAR = WS_BIG + 256 * MB;
constexpr size_t B_Q = 0;
constexpr size_t B_IQ = 64 * MB;
constexpr size_t B_IK = 96 * MB;
constexpr size_t B_IW = 100 * MB;
constexpr size_t B_CKVRAW = 104 * MB;
constexpr size_t B_CKVN = 136 * MB;
constexpr size_t B_SEL = 152 * MB;
constexpr size_t B_K = 64 * MB;
constexpr size_t B_VT = 128 * MB;
constexpr size_t B_O = 192 * MB;

struct Params {
  const float *x, *c, *rel_bias, *ada_w, *ada_b, *ln_g, *ln_b, *a_w_in, *a_kv_norm, *a_w_uk, *a_w_uv, *a_w_o, *b_w_in,
      *b_lambda, *b_subln, *b_w_o, *mlp_w1, *mlp_w2;
  float* out;
  char* ws;
};

DI int opq_tid() {
  int t = threadIdx.x & 255;
  asm volatile("" : "+v"(t));
  return t;
}
DI int opq_tid8() {
  int t = threadIdx.x;
  asm volatile("" : "+v"(t));
  return t;
}
DI unsigned pk2(float lo, float hi) {
  f32x2 v = {lo, hi};
  bf16x2_t b = __builtin_convertvector(v, bf16x2_t);
  return __builtin_bit_cast(unsigned, b);
}
DI u16 f2bf(float x) { return (u16)(pk2(x, 0.f) & 0xffffu); }
DI float wave_sum(float v) {
#pragma unroll
  for (int o = 32; o >= 1; o >>= 1) v += __shfl_xor(v, o);
  return v;
}
DI float xhalf_max(float x) {
  auto t = __builtin_amdgcn_permlane32_swap(__float_as_uint(x), __float_as_uint(x), false, false);
  return fmaxf(__uint_as_float(t[0]), __uint_as_float(t[1]));
}
DI float xhalf_sum(float x) {
  auto t = __builtin_amdgcn_permlane32_swap(__float_as_uint(x), __float_as_uint(x), false, false);
  return __uint_as_float(t[0]) + __uint_as_float(t[1]);
}
DI float xrow16_max(float x) {
  auto s_ = __builtin_amdgcn_permlane16_swap(__float_as_uint(x), __float_as_uint(x), false, false);
  x = fmaxf(__uint_as_float(s_[0]), __uint_as_float(s_[1]));
  return xhalf_max(x);
}
DI float xrow16_sum(float x) {
  auto s_ = __builtin_amdgcn_permlane16_swap(__float_as_uint(x), __float_as_uint(x), false, false);
  x = __uint_as_float(s_[0]) + __uint_as_float(s_[1]);
  return xhalf_sum(x);
}
DI f32x16 mfma32(bf16x8 a, bf16x8 b, f32x16 c) { return __builtin_amdgcn_mfma_f32_32x32x16_bf16(a, b, c, 0, 0, 0); }
DI f32x4 mfma16(bf16x8 a, bf16x8 b, f32x4 c) { return __builtin_amdgcn_mfma_f32_16x16x32_bf16(a, b, c, 0, 0, 0); }
DI int pi_row(int r) { return (r & ~12) | ((r & 4) << 1) | ((r & 8) >> 1); }

DI int rel_bucket(int n) {
  if (n < 16) return n;
  float nf = (float)n;
  int large = 16 + (int)(logf(nf / 16.f) / 2.0794415416798357f * 16.f);
  return large < 31 ? large : 31;
}

DI void tconv_phase(const float* __restrict__ src, u16* __restrict__ dst, int batch, int R, int C, int Cpad, char* smem,
                    int bid, int nb) {
  float* tile = (float*)smem;
  const int tid = opq_tid();
  const int tr = R / 64, tc = Cpad / 64;
  const int ntiles = batch * tr * tc;
  for (int it0 = 0; it0 < ntiles; it0 += nb) {
    const int it = (it0 + bid < ntiles) ? it0 + bid : ntiles - 1;
    const int bi = it / (tr * tc);
    const int rem = it - bi * (tr * tc);
    const int ri = rem / tc, ci = rem - ri * tc;
    const float* s = src + (size_t)bi * R * C;
    u16* d = dst + (size_t)bi * Cpad * R;
    __syncthreads();
#pragma unroll
    for (int k = 0; k < 4; k++) {
      const int r = (tid >> 4) + 16 * k;
      const int cl = (tid & 15) * 4;
      const int cc = ci * 64 + cl;
      f32x4 v = {0.f, 0.f, 0.f, 0.f};
      if (cc < C) v = *(const f32x4*)(s + (size_t)(ri * 64 + r) * C + cc);
      tile[r * 65 + cl + 0] = v[0];
      tile[r * 65 + cl + 1] = v[1];
      tile[r * 65 + cl + 2] = v[2];
      tile[r * 65 + cl + 3] = v[3];
    }
    __syncthreads();
#pragma unroll
    for (int k = 0; k < 2; k++) {
      const int cl = (tid >> 3) + 32 * k;
      const int r8 = (tid & 7) * 8;
      u32x4 o;
      o[0] = pk2(tile[(r8 + 0) * 65 + cl], tile[(r8 + 1) * 65 + cl]);
      o[1] = pk2(tile[(r8 + 2) * 65 + cl], tile[(r8 + 3) * 65 + cl]);
      o[2] = pk2(tile[(r8 + 4) * 65 + cl], tile[(r8 + 5) * 65 + cl]);
      o[3] = pk2(tile[(r8 + 6) * 65 + cl], tile[(r8 + 7) * 65 + cl]);
      *(u32x4*)(d + (size_t)(ci * 64 + cl) * R + ri * 64 + r8) = o;
    }
  }
}

DI void mod_phase(const Params& p, float* mod, char* smem, int bid, int nb) {
  float* sc = (float*)smem;
  float* red = sc + 4096;
  const int tid = opq_tid(), lane = tid & 63, w = __builtin_amdgcn_readfirstlane(tid >> 6);
  __syncthreads();
  for (int i = tid; i < 4096; i += 256) {
    float v = p.c[i];
    sc[i] = v / (1.f + expf(-v));
  }
  __syncthreads();
  for (int it = bid; it < 4 * 384; it += nb) {
    const int l = it / 384, e0 = (it - l * 384) * 16;
    const int ds = lane >> 4, ec = lane & 15;
    const float* wp = p.ada_w + ((size_t)l * 1024 + w * 256 + ds) * 6144 + e0 + ec;
    float a0 = 0, a1 = 0, a2 = 0, a3 = 0;
#pragma unroll 16
    for (int d = 0; d < 64; d++) {
      float wv = wp[(size_t)(4 * d) * 6144];
      int dd = w * 256 + 4 * d + ds;
      a0 += sc[dd] * wv;
      a1 += sc[1024 + dd] * wv;
      a2 += sc[2048 + dd] * wv;
      a3 += sc[3072 + dd] * wv;
    }
    a0 += __shfl_xor(a0, 16); a0 += __shfl_xor(a0, 32);
    a1 += __shfl_xor(a1, 16); a1 += __shfl_xor(a1, 32);
    a2 += __shfl_xor(a2, 16); a2 += __shfl_xor(a2, 32);
    a3 += __shfl_xor(a3, 16); a3 += __shfl_xor(a3, 32);
    if (lane < 16) {
      red[(w * 4 + 0) * 16 + lane] = a0;
      red[(w * 4 + 1) * 16 + lane] = a1;
      red[(w * 4 + 2) * 16 + lane] = a2;
      red[(w * 4 + 3) * 16 + lane] = a3;
    }
    __syncthreads();
    if (tid < 64) {
      const int b = tid >> 4, e = tid & 15;
      float sm = red[(0 * 4 + b) * 16 + e] + red[(1 * 4 + b) * 16 + e] + red[(2 * 4 + b) * 16 + e] + red[(3 * 4 + b) * 16 + e] +
                 p.ada_b[l * 6144 + e0 + e];
      mod[((size_t)l * 4 + b) * 6144 + e0 + e] = sm;
    }
    __syncthreads();
  }
}

DI void h0_phase(const float* __restrict__ x, const float* __restrict__ mod0, u16* __restrict__ h, int bid, int nb) {
  const size_t n8 = (size_t)T * 1024 / 8;
  for (size_t i = (size_t)bid * 256 + opq_tid(); i < n8; i += (size_t)nb * 256) {
    const size_t e = i * 8;
    const int t = (int)(e >> 10), d = (int)(e & 1023), b = t >> 13;
    const float* m = mod0 + (size_t)b * 6144;
    f32x4 v0 = *(const f32x4*)(x + e), v1 = *(const f32x4*)(x + e + 4);
    f32x4 sh0 = *(const f32x4*)(m + d), sh1 = *(const f32x4*)(m + d + 4);
    f32x4 sc0 = *(const f32x4*)(m + 1024 + d), sc1 = *(const f32x4*)(m + 1024 + d + 4);
    v0 = v0 * (1.f + sc0) + sh0;
    v1 = v1 * (1.f + sc1) + sh1;
    u32x4 o;
    o[0] = pk2(v0[0], v0[1]);
    o[1] = pk2(v0[2], v0[3]);
    o[2] = pk2(v1[0], v1[1]);
    o[3] = pk2(v1[2], v1[3]);
    *(u32x4*)(h + e) = o;
  }
}

DI void ln_phase(float* z, const float* __restrict__ g, const float* __restrict__ bt, const float* modn, int sh_off,
                 u16* __restrict__ h, int bid, int nb) {
  const int tid = opq_tid(), lane = tid & 63, w = __builtin_amdgcn_readfirstlane(tid >> 6);
  const int nw = nb * 4;
  for (int row0 = bid * 4 + w; row0 < T; row0 += 4 * nw) {
    f32x4 v[4][4];
#pragma unroll
    for (int rr = 0; rr < 4; rr++) {
      const int row = row0 + rr * nw;
      const f32x4* zp = (const f32x4*)(z + (size_t)(row < T ? row : row0) * 1024);
#pragma unroll
      for (int c = 0; c < 4; c++) v[rr][c] = zp[c * 64 + lane];
    }
#pragma unroll
    for (int rr = 0; rr < 4; rr++) {
      const int row = row0 + rr * nw;
      if (row < T) {
        float s = 0;
#pragma unroll
        for (int c = 0; c < 4; c++) s += v[rr][c][0] + v[rr][c][1] + v[rr][c][2] + v[rr][c][3];
        const float mu = wave_sum(s) * (1.f / 1024.f);
        float q = 0;
#pragma unroll
        for (int c = 0; c < 4; c++) {
          v[rr][c] = v[rr][c] - mu;
          q += v[rr][c][0] * v[rr][c][0] + v[rr][c][1] * v[rr][c][1] + v[rr][c][2] * v[rr][c][2] + v[rr][c][3] * v[rr][c][3];
        }
        const float rstd = rsqrtf(wave_sum(q) * (1.f / 1024.f) + LN_EPS);
        const int b = row >> 13;
        f32x4* zp = (f32x4*)(z + (size_t)row * 1024);
#pragma unroll
        for (int c = 0; c < 4; c++) {
          const int d = c * 256 + lane * 4;
          f32x4 y = v[rr][c] * rstd * *(const f32x4*)(g + d) + *(const f32x4*)(bt + d);
          zp[c * 64 + lane] = y;
          if (modn) {
            const float* m = modn + (size_t)b * 6144 + sh_off;
            f32x4 hv = y * (1.f + *(const f32x4*)(m + 1024 + d)) + *(const f32x4*)(m + d);
            u32x2 o;
            o[0] = pk2(hv[0], hv[1]);
            o[1] = pk2(hv[2], hv[3]);
            *(u32x2*)(h + (size_t)row * 1024 + d) = o;
          }
        }
      }
    }
  }
}

enum { EPI_AIN = 0, EPI_BIN = 1, EPI_RES = 2, EPI_SQRELU = 3 };
struct EpiArgs {
  u16 *o0, *o1, *o2;
  float *f0, *f1;
  const float* xin;
  const float* g;
};

template <int EPI>
DI void epi_store4(const EpiArgs& ea, int row, int col, const float* v, int bidx) {
  if (EPI == EPI_AIN) {
    if (col < 1024) {
      u32x2 o;
      o[0] = pk2(v[0], v[1]);
      o[1] = pk2(v[2], v[3]);
      *(u32x2*)(ea.o0 + (size_t)row * 1024 + col) = o;
    } else if (col < 1280) {
      *(f32x4*)(ea.f0 + (size_t)row * 256 + (col - 1024)) = (f32x4){v[0], v[1], v[2], v[3]};
    } else if (col < 1792) {
      u32x2 o;
      o[0] = pk2(v[0], v[1]);
      o[1] = pk2(v[2], v[3]);
      *(u32x2*)(ea.o1 + (size_t)row * 512 + (col - 1280)) = o;
    } else if (col < 1856) {
      const int d = col - 1792;
      const int sidx = row & 8191;
      const size_t off = (size_t)(row >> 13) * S * 64 +
                         ((size_t)((sidx >> 5) * 4 + (d >> 4)) * 64 + 32 * ((d >> 3) & 1) + (sidx & 31)) * 8 + (d & 7);
      u32x2 o;
      o[0] = pk2(v[0], v[1]);
      o[1] = pk2(v[2], v[3]);
      *(u32x2*)(ea.o2 + off) = o;
    } else if (col < 1864) {
      const float sc = 0.044194173824159216f;
      *(f32x4*)(ea.f1 + (size_t)row * 8 + (col - 1856)) = (f32x4){v[0] * sc, v[1] * sc, v[2] * sc, v[3] * sc};
    }
  } else if (EPI == EPI_BIN) {
    if (col < 1024) {
      const float sc = 0.125f * LOG2E;
      u32x2 o;
      o[0] = pk2(v[0] * sc, v[1] * sc);
      o[1] = pk2(v[2] * sc, v[3] * sc);
      *(u32x2*)(ea.o0 + (size_t)row * 1024 + col) = o;
    } else if (col < 2048) {
      u32x2 o;
      o[0] = pk2(v[0], v[1]);
      o[1] = pk2(v[2], v[3]);
      *(u32x2*)(ea.o1 + (size_t)row * 1024 + (col - 1024)) = o;
    } else {
      const int cv = col - 2048;
#pragma unroll
      for (int q = 0; q < 4; q++) ea.o2[((size_t)bidx * 1024 + cv + q) * 8192 + (row & 8191)] = f2bf(v[q]);
    }
  } else if (EPI == EPI_RES) {
    const f32x4 gg = *(const f32x4*)(ea.g + (size_t)bidx * 6144 + col);
    const size_t o = (size_t)row * 1024 + col;
    const f32x4 xv = *(const f32x4*)(ea.xin + o);
    f32x4 r;
#pragma unroll
    for (int q = 0; q < 4; q++) r[q] = DN_ALPHA * xv[q] + (1.f + gg[q]) * v[q];
    *(f32x4*)(ea.f0 + o) = r;
  } else {
    float r[4];
#pragma unroll
    for (int q = 0; q < 4; q++) {
      r[q] = v[q] > 0.f ? v[q] : 0.f;
      r[q] = r[q] * r[q];
    }
    u32x2 o;
    o[0] = pk2(r[0], r[1]);
    o[1] = pk2(r[2], r[3]);
    *(u32x2*)(ea.o0 + (size_t)row * 4096 + col) = o;
  }
}

template <int EPI>
DI void gemm_phase(const u16* __restrict__ A, const u16* __restrict__ Bt, int M, int N, int K, const EpiArgs& ea,
                   char* smem, int bid, int nb) {
  constexpr int MI = 4, BM = 64 * MI, BN = 256;
  u16* As = (u16*)smem;
  u16* Bs = As + BM * 72;
  const int tid = opq_tid8(), lane = tid & 63, w = __builtin_amdgcn_readfirstlane(tid >> 6), wm = w >> 2, wn = w & 3, l31 = lane & 31, lh = lane >> 5;
  const int ntn = N / BN, ntm = M / BM, nt = ntn * ntm, nk = K / 64;
  const int lr = tid >> 3, lc = (tid & 7) * 8;
  const int xcd = bid & 7, nbx = nb >> 3, cntx = (ntm >> 3) * ntn;
  (void)nt;
  for (int sq = bid >> 3; sq < cntx; sq += nbx) {
    const int tmx = sq / ntn, tn = sq - tmx * ntn;
    const int tm = tmx * 8 + xcd;
    const int m0 = tm * BM, n0 = tn * BN;
    f32x16 acc[MI][2];
#pragma unroll
    for (int i = 0; i < MI; i++)
#pragma unroll
      for (int j = 0; j < 2; j++)
#pragma unroll
        for (int r = 0; r < 16; r++) acc[i][j][r] = 0.f;
    u32x4 ra[4], rb[4];
    const u16* ap = A + (size_t)(m0 + lr) * K + lc;
    const u16* bp = Bt + (size_t)(n0 + lr) * K + lc;
#pragma unroll
    for (int i = 0; i < 4; i++) ra[i] = *(const u32x4*)(ap + (size_t)i * 64 * K);
#pragma unroll
    for (int i = 0; i < 4; i++) rb[i] = *(const u32x4*)(bp + (size_t)i * 64 * K);
    __syncthreads();
#pragma unroll
    for (int i = 0; i < 4; i++) *(u32x4*)&As[(lr + 64 * i) * 72 + lc] = ra[i];
#pragma unroll
    for (int i = 0; i < 4; i++) *(u32x4*)&Bs[(lr + 64 * i) * 72 + lc] = rb[i];
    __syncthreads();
    for (int kt = 0; kt < nk; kt++) {
      if (kt + 1 < nk) {
#pragma unroll
        for (int i = 0; i < 4; i++) ra[i] = *(const u32x4*)(ap + (size_t)i * 64 * K + (kt + 1) * 64);
#pragma unroll
        for (int i = 0; i < 4; i++) rb[i] = *(const u32x4*)(bp + (size_t)i * 64 * K + (kt + 1) * 64);
      }
#pragma unroll
      for (int ks = 0; ks < 4; ks++) {
        bf16x8 af[MI], b0, b1;
#pragma unroll
        for (int i = 0; i < MI; i++) af[i] = *(const bf16x8*)&As[(wm * 32 * MI + 32 * i + l31) * 72 + ks * 16 + lh * 8];
        b0 = *(const bf16x8*)&Bs[(wn * 64 + l31) * 72 + ks * 16 + lh * 8];
        b1 = *(const bf16x8*)&Bs[(wn * 64 + 32 + l31) * 72 + ks * 16 + lh * 8];
#pragma unroll
        for (int i = 0; i < MI; i++) {
          acc[i][0] = mfma32(b0, af[i], acc[i][0]);
          acc[i][1] = mfma32(b1, af[i], acc[i][1]);
        }
      }
      __syncthreads();
      if (kt + 1 < nk) {
#pragma unroll
        for (int i = 0; i < 4; i++) *(u32x4*)&As[(lr + 64 * i) * 72 + lc] = ra[i];
#pragma unroll
        for (int i = 0; i < 4; i++) *(u32x4*)&Bs[(lr + 64 * i) * 72 + lc] = rb[i];
        __syncthreads();
      }
    }
    const int bidx = m0 >> 13;
#pragma unroll
    for (int i = 0; i < MI; i++) {
      const int row = m0 + wm * 32 * MI + 32 * i + l31;
#pragma unroll
      for (int j = 0; j < 2; j++) {
#pragma unroll
        for (int r4 = 0; r4 < 4; r4++) {
          const int col = n0 + wn * 64 + 32 * j + 8 * r4 + 4 * lh;
          float v[4];
#pragma unroll
          for (int q = 0; q < 4; q++) v[q] = acc[i][j][4 * r4 + q];
          epi_store4<EPI>(ea, row, col, v, bidx);
        }
      }
    }
  }
}

DI int g8_lds_byte(int r, int c) {
  int st = (r >> 4) * 2 + (c >> 5), rr = r & 15, cc = c & 31, ob = rr * 64 + cc * 2;
  return st * 1024 + (ob ^ (((ob >> 9) & 1) << 5));
}
DI void g8_stage_rc(int b, int& R, int& C) {
  int st = b / 1024, sb = b % 1024, swz = sb ^ (((sb >> 9) & 1) << 5);
  R = (st >> 1) * 16 + swz / 64;
  C = (st & 1) * 32 + (swz % 64) / 2;
}
typedef __attribute__((address_space(3))) unsigned* lds_u32_ptr;

template <int EPI>
DI void gemm8p_phase(const u16* __restrict__ A, const u16* __restrict__ Bt, int M, int N, int K, const EpiArgs& ea,
                     char* smem, int bid, int nb) {
  constexpr int BK = 64, HALF = 128, HT = HALF * BK;
  u16* shm = (u16*)smem;
  const int tid = opq_tid8(), lane = tid & 63, wid = __builtin_amdgcn_readfirstlane(tid >> 6);
  const int wr = wid >> 2, wc = wid & 3, fr = lane & 15, fq = lane >> 4;
#define G8_SA(b, h) (shm + ((b) * 2 + (h)) * HT)
#define G8_SB(b, h) (shm + (4 + (b) * 2 + (h)) * HT)
  int g8o0, g8o1;
  {
    int r_, c_;
    g8_stage_rc(tid * 16, r_, c_);
    g8o0 = r_ * K + c_;
    g8_stage_rc(tid * 16 + 8192, r_, c_);
    g8o1 = r_ * K + c_;
  }
#define G8_STAGE(P, BASE, br, kt)                                                                                   \
  do {                                                                                                               \
    const u16* _gp = BASE + (size_t)(br) * K + (size_t)(kt) * BK;                                                    \
    asm volatile("" : "+s"(_gp));                \
    __builtin_amdgcn_global_load_lds((const unsigned*)(_gp + (unsigned)g8o0), (lds_u32_ptr)((char*)(P) + tid * 16), 16, 0, 0);        \
    __builtin_amdgcn_global_load_lds((const unsigned*)(_gp + (unsigned)g8o1), (lds_u32_ptr)((char*)(P) + tid * 16 + 8192), 16, 0, 0); \
  } while (0)
  const int g8lane = (fr * 64 + fq * 16) ^ ((fr & 8) << 2);
  const char* g8a = smem + g8lane + wr * 8192;
  const char* g8b = smem + 4 * HT * 2 + g8lane + wc * 4096;
#define G8_LDA(dst, b, h)                                                                                            \
  _Pragma("unroll") for (int m = 0; m < 4; ++m) _Pragma("unroll") for (int k = 0; k < 2; ++k)                        \
      dst[m][k] = *reinterpret_cast<const bf16x8*>(g8a + ((b) * 2 + (h)) * (HT * 2) + m * 2048 + k * 1024)
#define G8_LDB(dst, b, h)                                                                                            \
  _Pragma("unroll") for (int n = 0; n < 2; ++n) _Pragma("unroll") for (int k = 0; k < 2; ++k)                        \
      dst[n][k] = *reinterpret_cast<const bf16x8*>(g8b + ((b) * 2 + (h)) * (HT * 2) + n * 2048 + k * 1024)
#define G8_MMA(ai, bj, At_, Bt_)                                                                                     \
  do {                                                                                                               \
    __builtin_amdgcn_s_setprio(1);                                                                                   \
    _Pragma("unroll") for (int m = 0; m < 4; ++m) _Pragma("unroll") for (int n = 0; n < 2; ++n)                      \
        _Pragma("unroll") for (int k = 0; k < 2; ++k)                                                                \
            acc[ai][bj][m][n] = mfma16(Bt_[n][k], At_[m][k], acc[ai][bj][m][n]);                                     \
    __builtin_amdgcn_s_setprio(0);                                                                                   \
  } while (0)
#define G8_WAIT_V(n) asm volatile("s_waitcnt vmcnt(" #n ")" ::: "memory")
#define G8_WAIT_L(n) asm volatile("s_waitcnt lgkmcnt(" #n ")" ::: "memory")
#define G8_BAR __builtin_amdgcn_s_barrier()
#define G8_SCHED __builtin_amdgcn_sched_barrier(0)
  const int ntn = N / 256, ntm = M / 256, nt = K / BK;
  const int xcd = bid & 7, nbx = nb >> 3, cntx = (ntm >> 3) * ntn;
  for (int sq = bid >> 3; sq < cntx; sq += nbx) {
    const int tmx = sq / ntn, tn = sq - tmx * ntn;
    const int tm = tmx * 8 + xcd;
    const int brow = tm * 256, bcol = tn * 256;
    f32x4 acc[2][2][4][2];
#pragma unroll
    for (int a_ = 0; a_ < 2; a_++)
#pragma unroll
      for (int b_ = 0; b_ < 2; b_++)
#pragma unroll
        for (int m = 0; m < 4; m++)
#pragma unroll
          for (int n = 0; n < 2; n++) acc[a_][b_][m][n] = (f32x4){0.f, 0.f, 0.f, 0.f};
    bf16x8 At[4][2], B0[2][2], B1[2][2];
    asm volatile("s_waitcnt vmcnt(0) lgkmcnt(0)" ::: "memory");
    __syncthreads();
    G8_STAGE(G8_SB(0, 0), Bt, bcol, 0); G8_STAGE(G8_SA(0, 0), A, brow, 0);
    G8_STAGE(G8_SB(0, 1), Bt, bcol + HALF, 0); G8_STAGE(G8_SA(0, 1), A, brow + HALF, 0);
    if (wr == 1) G8_BAR;
    G8_WAIT_V(4); G8_BAR;
    G8_STAGE(G8_SB(1, 0), Bt, bcol, 1); G8_STAGE(G8_SA(1, 0), A, brow, 1); G8_STAGE(G8_SB(1, 1), Bt, bcol + HALF, 1);
    G8_WAIT_V(6); G8_BAR;
    for (int t = 0; t < nt - 2; t += 2) {
      G8_LDB(B0, 0, 0); G8_SCHED; G8_LDA(At, 0, 0); G8_STAGE(G8_SA(1, 1), A, brow + HALF, t + 1);
      G8_WAIT_L(8); G8_BAR; G8_WAIT_L(0); G8_MMA(0, 0, At, B0); G8_BAR; G8_SCHED;
      G8_LDB(B1, 0, 1); G8_STAGE(G8_SB(0, 0), Bt, bcol, t + 2);
      G8_BAR; G8_WAIT_L(0); G8_MMA(0, 1, At, B1); G8_BAR;
      G8_LDA(At, 0, 1); G8_STAGE(G8_SA(0, 0), A, brow, t + 2);
      G8_BAR; G8_WAIT_L(0); G8_MMA(1, 0, At, B0); G8_BAR; G8_SCHED;
      G8_STAGE(G8_SB(0, 1), Bt, bcol + HALF, t + 2);
      G8_WAIT_V(6); G8_BAR; G8_MMA(1, 1, At, B1); G8_BAR;
      G8_LDB(B0, 1, 0); G8_SCHED; G8_LDA(At, 1, 0); G8_STAGE(G8_SA(0, 1), A, brow + HALF, t + 2);
      G8_WAIT_L(8); G8_BAR; G8_WAIT_L(0); G8_MMA(0, 0, At, B0); G8_BAR; G8_SCHED;
      G8_LDB(B1, 1, 1); G8_STAGE(G8_SB(1, 0), Bt, bcol, t + 3);
      G8_BAR; G8_WAIT_L(0); G8_MMA(0, 1, At, B1); G8_BAR;
      G8_LDA(At, 1, 1); G8_STAGE(G8_SA(1, 0), A, brow, t + 3);
      G8_BAR; G8_WAIT_L(0); G8_MMA(1, 0, At, B0); G8_BAR; G8_SCHED;
      G8_STAGE(G8_SB(1, 1), Bt, bcol + HALF, t + 3);
      G8_WAIT_V(6); G8_BAR; G8_MMA(1, 1, At, B1); G8_BAR;
    }
    {
      G8_LDB(B0, 0, 0); G8_LDA(At, 0, 0); G8_STAGE(G8_SA(1, 1), A, brow + HALF, nt - 1);
      G8_BAR; G8_WAIT_L(0); G8_MMA(0, 0, At, B0); G8_BAR;
      G8_LDB(B1, 0, 1); G8_BAR; G8_WAIT_L(0); G8_MMA(0, 1, At, B1); G8_BAR;
      G8_LDA(At, 0, 1); G8_WAIT_V(4); G8_BAR; G8_WAIT_L(0); G8_MMA(1, 0, At, B0); G8_MMA(1, 1, At, B1); G8_BAR;
    }
    {
      G8_LDB(B0, 1, 0); G8_LDA(At, 1, 0); G8_WAIT_V(2); G8_BAR; G8_WAIT_L(0); G8_MMA(0, 0, At, B0); G8_BAR;
      G8_LDB(B1, 1, 1); G8_WAIT_V(0); G8_BAR; G8_WAIT_L(0); G8_MMA(0, 1, At, B1); G8_BAR;
      G8_LDA(At, 1, 1); G8_BAR; G8_WAIT_L(0); G8_MMA(1, 0, At, B0); G8_MMA(1, 1, At, B1); G8_BAR;
    }
    if (wr == 0) G8_BAR;
    const int bidx = brow >> 13;
#pragma unroll
    for (int ai = 0; ai < 2; ai++)
#pragma unroll
      for (int m = 0; m < 4; m++) {
        const int row = brow + ai * HALF + wr * 64 + m * 16 + fr;
#pragma unroll
        for (int bj = 0; bj < 2; bj++)
#pragma unroll
          for (int n = 0; n < 2; n++) {
            const int col = bcol + bj * HALF + wc * 32 + n * 16 + fq * 4;
            float v[4];
#pragma unroll
            for (int q = 0; q < 4; q++) v[q] = acc[ai][bj][m][n][q];
            epi_store4<EPI>(ea, row, col, v, bidx);
          }
      }
  }
#undef G8_SA
#undef G8_SB
#undef G8_STAGE
#undef G8_LDA
#undef G8_LDB
#undef G8_MMA
#undef G8_WAIT_V
#undef G8_WAIT_L
#undef G8_BAR
#undef G8_SCHED
}

DI void ckvnorm_phase(const float* __restrict__ raw, const float* __restrict__ g, u16* __restrict__ outp, int bid,
                      int nb) {
  const int tid = opq_tid(), lane = tid & 63, w = __builtin_amdgcn_readfirstlane(tid >> 6);
  const f32x4 gg = *(const f32x4*)(g + lane * 4);
  for (int row = bid * 4 + w; row < T; row += nb * 4) {
    f32x4 v = *(const f32x4*)(raw + (size_t)row * 256 + lane * 4);
    float ss = v[0] * v[0] + v[1] * v[1] + v[2] * v[2] + v[3] * v[3];
    ss = wave_sum(ss);
    const float r = rsqrtf(ss * (1.f / 256.f) + LN_EPS);
    u32x2 o;
    o[0] = pk2(v[0] * r * gg[0], v[1] * r * gg[1]);
    o[1] = pk2(v[2] * r * gg[2], v[3] * r * gg[3]);
    *(u32x2*)(outp + (size_t)row * 256 + lane * 4) = o;
  }
}

DI unsigned mono_key(float s) {
  unsigned u = __float_as_uint(s);
  return (u & 0x80000000u) ? ~u : (u | 0x80000000u);
}
DI float mono_inv(unsigned k) {
  unsigned u = (k & 0x80000000u) ? (k & 0x7fffffffu) : ~k;
  return __uint_as_float(u);
}
DI float relu_i(float x) {
  int i = __float_as_int(x);
  return __int_as_float(i > 0 ? i : 0);
}
DI int wcount(bool f) { return __popcll(__ballot(f)); }

template <bool EXACT>
DI void compact4(float* vals, u16* idxs, int* cnt, int lane, float* thr_out) {
  constexpr int NPL = CAP / 64;
  unsigned key[4][NPL];
  int n[4];
#pragma unroll
  for (int q = 0; q < 4; q++) n[q] = cnt[q];
#pragma unroll
  for (int q = 0; q < 4; q++)
#pragma unroll
    for (int j = 0; j < NPL; j++) {
      const int e = j * 64 + lane;
      key[q][j] = (e < n[q]) ? mono_key(vals[q * CAP + e]) : 0u;
    }
  unsigned Tk[4] = {0u, 0u, 0u, 0u};
  constexpr int LOWBIT = EXACT ? 0 : 18;
#pragma unroll 1
  for (int bit = 31; bit >= LOWBIT; bit--) {
#pragma unroll
    for (int q = 0; q < 4; q++) {
      const unsigned cand = Tk[q] | (1u << bit);
      int c = 0;
#pragma unroll
      for (int j = 0; j < NPL; j++) c += wcount(key[q][j] >= cand);
      Tk[q] = (c >= TOPK) ? cand : Tk[q];
      if (q == 1) __builtin_amdgcn_sched_barrier(0);
    }
  }
  unsigned I[4] = {0xffffu, 0xffffu, 0xffffu, 0xffffu};
  if (EXACT) {
    unsigned ix[4][NPL];
    int need[4];
#pragma unroll
    for (int q = 0; q < 4; q++) {
      int cgt = 0;
#pragma unroll
      for (int j = 0; j < NPL; j++) {
        const int e = j * 64 + lane;
        ix[q][j] = (e < n[q]) ? (unsigned)idxs[q * CAP + e] : 0xffffu;
        cgt += wcount(key[q][j] > Tk[q]);
      }
      need[q] = TOPK - cgt;
      I[q] = 0u;
    }
#pragma unroll 1
    for (int bit = 13; bit >= 0; bit--) {
#pragma unroll
      for (int q = 0; q < 4; q++) {
        const unsigned cand = I[q] | (1u << bit);
        int c = 0;
#pragma unroll
        for (int j = 0; j < NPL; j++) c += wcount(key[q][j] == Tk[q] && ix[q][j] < cand);
        I[q] = (c < need[q]) ? cand : I[q];
        if (q == 1) __builtin_amdgcn_sched_barrier(0);
      }
    }
  }
  const unsigned long long lt = (1ull << lane) - 1ull;
#pragma unroll
  for (int q = 0; q < 4; q++) {
    if (n[q] > TOPK) {
      int base = 0;
#pragma unroll
      for (int j = 0; j < NPL; j++) {
        const int e = j * 64 + lane;
        const bool in = e < n[q];
        const float v = in ? vals[q * CAP + e] : 0.f;
        const unsigned ixv = in ? (unsigned)idxs[q * CAP + e] : 0xffffu;
        const bool keep = (key[q][j] > Tk[q]) || (key[q][j] == Tk[q] && ixv <= I[q]);
        const unsigned long long m = __ballot(keep);
        if (keep) {
          const int pos = base + __popcll(m & lt);
          vals[q * CAP + pos] = v;
          idxs[q * CAP + pos] = (u16)ixv;
        }
        base += __popcll(m);
      }
      if (lane == 0) cnt[q] = base;
      thr_out[q] = mono_inv(Tk[q]);
    }
  }
}

DI void indexer_phase(const u16* __restrict__ iq, const u16* __restrict__ ik, const float* __restrict__ iw,
                      u16* __restrict__ sel, char* smem, int bid, int nb) {
  constexpr int WBYTES = 4 * CAP * 4 + 4 * CAP * 2 + 64;
  const int tid = opq_tid(), lane = tid & 63, w = __builtin_amdgcn_readfirstlane(tid >> 6), l31 = lane & 31, u = lane >> 5;
  float* vals = (float*)(smem + w * WBYTES);
  u16* idxs = (u16*)(smem + w * WBYTES + 4 * CAP * 4);
  int* cnt = (int*)(smem + w * WBYTES + 4 * CAP * 4 + 4 * CAP * 2);
  const int nitems = NBATCH * (S / 16);
  const int nrounds = (nitems + nb - 1) / nb;
  __syncthreads();
  for (int rd = 0; rd < nrounds; rd++) {
    const int it = rd * nb + ((rd & 1) ? (nb - 1 - bid) : bid);
    if (it >= nitems) continue;
    const int b = it & 3, qg = (S / 16 - 1) - (it >> 2);
    const int t0 = qg * 16;
    const int tw = t0 + 4 * w;
    const size_t tb = (size_t)b * S;
    bf16x8 aq[4];
    {
      const int g = l31 >> 3, up = (l31 >> 2) & 1, j = l31 & 3;
      const int ql = 2 * up + (g >> 1), hd = 4 * (g & 1) + j;
      const u16* qp = iq + (tb + tw + ql) * 512 + hd * 64 + u * 8;
#pragma unroll
      for (int ks = 0; ks < 4; ks++) aq[ks] = *(const bf16x8*)(qp + ks * 16);
    }
    float wq[2][8];
#pragma unroll
    for (int qq = 0; qq < 2; qq++) {
      const float* wp = iw + (tb + tw + 2 * u + qq) * 8;
      f32x4 w0 = *(const f32x4*)wp, w1 = *(const f32x4*)(wp + 4);
#pragma unroll
      for (int h = 0; h < 4; h++) {
        wq[qq][h] = w0[h];
        wq[qq][4 + h] = w1[h];
      }
    }
    float thr[2] = {-INFINITY, -INFINITY};
    __builtin_amdgcn_wave_barrier();
    if (lane < 4) cnt[lane] = 0;
    __builtin_amdgcn_wave_barrier();
    const int nkb = (tw + 3) / 32 + 1;
    const u16* kp = ik + tb * 64 + lane * 8;
    bf16x8 ring[4][4];
#pragma unroll
    for (int i = 0; i < 4; i++) {
      const int kbn = (i < nkb) ? i : nkb - 1;
#pragma unroll
      for (int ks = 0; ks < 4; ks++) ring[i][ks] = *(const bf16x8*)(kp + (size_t)(kbn * 4 + ks) * 512);
    }
#pragma unroll 1
    for (int kb0 = 0; kb0 < nkb; kb0 += 4) {
#pragma unroll
      for (int i = 0; i < 4; i++) {
        const int kb = kb0 + i;
        {
          f32x16 acc;
#pragma unroll
          for (int r = 0; r < 16; r++) acc[r] = 0.f;
#pragma unroll
          for (int ks = 0; ks < 4; ks++) acc = mfma32(aq[ks], ring[i][ks], acc);
          {
            const int kbn = (kb + 4 < nkb) ? kb + 4 : nkb - 1;
#pragma unroll
            for (int ks = 0; ks < 4; ks++) ring[i][ks] = *(const bf16x8*)(kp + (size_t)(kbn * 4 + ks) * 512);
          }
          const int key = kb * 32 + l31;
#pragma unroll
          for (int qq = 0; qq < 2; qq++) {
            float s0 = 0.f, s1 = 0.f;
#pragma unroll
            for (int h = 0; h < 8; h += 2) {
              s0 = fmaf(wq[qq][h], relu_i(acc[8 * qq + h]), s0);
              s1 = fmaf(wq[qq][h + 1], relu_i(acc[8 * qq + h + 1]), s1);
            }
            float s = s0 + s1;
            s += 0.0f;
            const int tq = tw + 2 * u + qq;
            if (key <= tq && s >= thr[qq]) {
              const int qs = 2 * u + qq;
              const int pos = atomicAdd(&cnt[qs], 1);
              vals[qs * CAP + pos] = s;
              idxs[qs * CAP + pos] = (u16)key;
            }
          }
        }
      }
      __builtin_amdgcn_wave_barrier();
      const int c0 = cnt[0], c1 = cnt[1], c2 = cnt[2], c3 = cnt[3];
      if (c0 > CAP - 128 || c1 > CAP - 128 || c2 > CAP - 128 || c3 > CAP - 128) {
        float to[4] = {0.f, 0.f, 0.f, 0.f};
        compact4<false>(vals, idxs, cnt, lane, to);
        __builtin_amdgcn_wave_barrier();
        const int d0 = cnt[0], d1 = cnt[1], d2 = cnt[2], d3 = cnt[3];
        if (d0 > CAP - 256 || d1 > CAP - 256 || d2 > CAP - 256 || d3 > CAP - 256) {
          compact4<true>(vals, idxs, cnt, lane, to);
          __builtin_amdgcn_wave_barrier();
        }
        if (c0 > TOPK && u == 0) thr[0] = to[0];
        if (c1 > TOPK && u == 0) thr[1] = to[1];
        if (c2 > TOPK && u == 1) thr[0] = to[2];
        if (c3 > TOPK && u == 1) thr[1] = to[3];
      }
    }
    {
      const int c0 = cnt[0], c1 = cnt[1], c2 = cnt[2], c3 = cnt[3];
      if (c0 > TOPK || c1 > TOPK || c2 > TOPK || c3 > TOPK) {
        float to[4];
        compact4<true>(vals, idxs, cnt, lane, to);
        __builtin_amdgcn_wave_barrier();
      }
    }
#pragma unroll 1
    for (int qs = 0; qs < 4; qs++) {
      const int n = cnt[qs];
      u16* sp = sel + (tb + tw + qs) * 256;
#pragma unroll
      for (int j = 0; j < 4; j++) {
        const int e = j * 64 + lane;
        sp[e] = (e < n) ? idxs[qs * CAP + e] : (u16)0xffffu;
      }
    }
  }
}

DI void sparse_phase(const u16* __restrict__ q, const u16* __restrict__ ckvn, const u16* __restrict__ sel,
                     const u16* __restrict__ wuk, const u16* __restrict__ wuv, const float* __restrict__ rel_bias,
                     u16* scratch, u16* __restrict__ o, char* smem, int bid, int nb) {
  constexpr int GS = 264;
  const int tid = opq_tid(), lane = tid & 63, w = __builtin_amdgcn_readfirstlane(tid >> 6), l15 = lane & 15, g = lane >> 4;
  u16* G = (u16*)smem + (size_t)w * 32 * GS;
  int* lut = (int*)(smem + 4 * 32 * GS * 2);
  float* rb = (float*)(lut + 128);
  __syncthreads();
  if (tid < 128) lut[tid] = rel_bucket(tid);
  for (int i = tid; i < 512; i += 256) rb[i] = rel_bias[i] * LOG2E;
  __syncthreads();
  u16* ql = scratch + (size_t)bid * (16 * 16 * 256);
  const int nitems = NBATCH * (S / 16);
  for (int it = bid; it < nitems; it += nb) {
    const int b = it & 3, qg = it >> 2;
    const int t0 = qg * 16;
    const size_t tb = (size_t)b * S;
    for (int hh = 0; hh < 4; hh++) {
      const int h = 4 * w + hh;
      bf16x8 bq[2];
#pragma unroll
      for (int ks = 0; ks < 2; ks++) bq[ks] = *(const bf16x8*)(q + (tb + t0 + l15) * 1024 + h * 64 + ks * 32 + g * 8);
#pragma unroll 4
      for (int rt = 0; rt < 16; rt++) {
        f32x4 acc = {0.f, 0.f, 0.f, 0.f};
#pragma unroll
        for (int ks = 0; ks < 2; ks++) {
          bf16x8 a = *(const bf16x8*)(wuk + ((size_t)h * 256 + rt * 16 + l15) * 64 + ks * 32 + g * 8);
          acc = mfma16(a, bq[ks], acc);
        }
        u32x2 ov;
        ov[0] = pk2(acc[0] * (0.125f * LOG2E), acc[1] * (0.125f * LOG2E));
        ov[1] = pk2(acc[2] * (0.125f * LOG2E), acc[3] * (0.125f * LOG2E));
        *(u32x2*)(ql + ((size_t)l15 * 16 + h) * 256 + rt * 16 + 4 * g) = ov;
      }
    }
    __syncthreads();
    {
      const u16* selw = sel + (tb + t0 + 4 * w) * 256;
      const int l31 = lane & 31;
      const int q4 = l15 >> 2, p4 = l15 & 3;
      const u16* ckb = ckvn + tb * 256;
      int idx_c = selw[l31];
      int idx_n = selw[32 + l31];
      u32x4 gr[16];
#pragma unroll
      for (int i = 0; i < 16; i++) {
        int id = __shfl(idx_c, (lane >> 5) + 2 * i);
        id = (id == 0xffff) ? 0 : id;
        gr[i] = *(const u32x4*)(ckb + (unsigned)(id * 256 + l31 * 8));
      }
      bf16x8 qb[8];
      float m_run = NEGF, l_run = 0.f;
      f32x4 O[16];
#pragma unroll 1
      for (int st = 0; st < 32; st++) {
        const int qi = st >> 3, ch = st & 7;
        const int qloc = 4 * w + qi;
        const int t = t0 + qloc;
        if (ch == 0) {
#pragma unroll
          for (int ks = 0; ks < 8; ks++) qb[ks] = *(const bf16x8*)(ql + ((size_t)qloc * 16 + l15) * 256 + ks * 32 + g * 8);
          m_run = NEGF;
          l_run = 0.f;
#pragma unroll
          for (int rt = 0; rt < 16; rt++) O[rt] = (f32x4){0.f, 0.f, 0.f, 0.f};
        }
#pragma unroll
        for (int i = 0; i < 16; i++) *(u32x4*)&G[((lane >> 5) + 2 * i) * GS + l31 * 8] = gr[i];
        __builtin_amdgcn_wave_barrier();
        const int stn2 = (st + 2 < 32) ? st + 2 : 31;
        const int idx_nn = selw[stn2 * 32 + l31];
#pragma unroll
        for (int i = 0; i < 16; i++) {
          int id = __shfl(idx_n, (lane >> 5) + 2 * i);
          id = (id == 0xffff) ? 0 : id;
          gr[i] = *(const u32x4*)(ckb + (unsigned)(id * 256 + l31 * 8));
        }
        float lg[2][4];
#pragma unroll
        for (int kbk = 0; kbk < 2; kbk++) {
          f32x4 acc = {0.f, 0.f, 0.f, 0.f};
#pragma unroll
          for (int ks = 0; ks < 8; ks++) {
            bf16x8 a = *(const bf16x8*)&G[(16 * kbk + l15) * GS + ks * 32 + g * 8];
            acc = mfma16(a, qb[ks], acc);
            if (ks == 3) asm volatile("" ::: "memory");
          }
          asm volatile("" ::: "memory");
#pragma unroll
          for (int i = 0; i < 4; i++) {
            const int kid = __shfl(idx_c, 16 * kbk + 4 * g + i);
            float v = NEGF;
            if (kid != 0xffff) {
              int n = t - kid;
              n = n < 0 ? 0 : n;
              const int bk = n < 128 ? lut[n] : 31;
              v = acc[i] + rb[bk * 16 + l15];
            }
            lg[kbk][i] = v;
          }
        }
        float mx = fmaxf(fmaxf(fmaxf(lg[0][0], lg[0][1]), fmaxf(lg[0][2], lg[0][3])),
                         fmaxf(fmaxf(lg[1][0], lg[1][1]), fmaxf(lg[1][2], lg[1][3])));
        mx = xrow16_max(mx);
        const float m_new = fmaxf(m_run, mx);
        const float scl = __builtin_amdgcn_exp2f(m_run - m_new);
        m_run = m_new;
        float ps = 0.f;
        float pe[8];
#pragma unroll
        for (int kbk = 0; kbk < 2; kbk++)
#pragma unroll
          for (int i = 0; i < 4; i++) {
            const float pv = __builtin_amdgcn_exp2f(lg[kbk][i] - m_new);
            pe[kbk * 4 + i] = pv;
            ps += pv;
          }
        l_run = l_run * scl + ps;
        u32x4 pw;
        pw[0] = pk2(pe[0], pe[1]);
        pw[1] = pk2(pe[2], pe[3]);
        pw[2] = pk2(pe[4], pe[5]);
        pw[3] = pk2(pe[6], pe[7]);
        const bf16x8 pB = __builtin_bit_cast(bf16x8, pw);
        if (__ballot(scl != 1.f)) {
#pragma unroll
          for (int rt = 0; rt < 16; rt++) O[rt] = O[rt] * scl;
        }
#pragma unroll
        for (int rt = 0; rt < 16; rt++) {
          const s16x4 lo = __builtin_amdgcn_ds_read_tr16_b64_v4i16((lds_s16x4_ptr)(&G[(4 * g + q4) * GS + rt * 16 + 4 * p4]));
          const s16x4 hi = __builtin_amdgcn_ds_read_tr16_b64_v4i16((lds_s16x4_ptr)(&G[(16 + 4 * g + q4) * GS + rt * 16 + 4 * p4]));
          const bf16x8 a = (bf16x8){lo[0], lo[1], lo[2], lo[3], hi[0], hi[1], hi[2], hi[3]};
          O[rt] = mfma16(a, pB, O[rt]);
          if ((rt & 3) == 3) asm volatile("" ::: "memory");
        }
        __builtin_amdgcn_wave_barrier();
        if (ch == 7) {
          float lt = l_run;
          lt = xrow16_sum(lt);
          const float inv = 1.f / lt;
#pragma unroll
          for (int rt = 0; rt < 16; rt++) {
            u32x2 ov;
            ov[0] = pk2(O[rt][0] * inv, O[rt][1] * inv);
            ov[1] = pk2(O[rt][2] * inv, O[rt][3] * inv);
            *(u32x2*)(ql + ((size_t)qloc * 16 + l15) * 256 + rt * 16 + 4 * g) = ov;
          }
        }
        idx_c = idx_n;
        idx_n = idx_nn;
      }
    }
    __syncthreads();
    for (int hh = 0; hh < 4; hh++) {
      const int h = 4 * w + hh;
      bf16x8 bo[8];
#pragma unroll
      for (int ks = 0; ks < 8; ks++) bo[ks] = *(const bf16x8*)(ql + ((size_t)l15 * 16 + h) * 256 + ks * 32 + g * 8);
#pragma unroll
      for (int et = 0; et < 4; et++) {
        f32x4 acc = {0.f, 0.f, 0.f, 0.f};
#pragma unroll
        for (int ks = 0; ks < 8; ks++) {
          bf16x8 a = *(const bf16x8*)(wuv + ((size_t)h * 64 + et * 16 + l15) * 256 + ks * 32 + g * 8);
          acc = mfma16(a, bo[ks], acc);
        }
        u32x2 ov;
        ov[0] = pk2(acc[0], acc[1]);
        ov[1] = pk2(acc[2], acc[3]);
        *(u32x2*)(o + (tb + t0 + l15) * 1024 + h * 64 + et * 16 + 4 * g) = ov;
      }
    }
    __syncthreads();
  }
}

DI void diffattn_phase(const u16* __restrict__ q, const u16* __restrict__ k, const u16* __restrict__ vT,
                       u16* __restrict__ o, const float* __restrict__ rel_bias, const float* __restrict__ lam,
                       const float* __restrict__ subln, int layer_idx, char* smem, int bid, int nb) {
  constexpr int KS = 136, VS = 72;
  u16* Ks = (u16*)smem;
  u16* Vs = Ks + 64 * KS;
  float* exch = (float*)smem;
  constexpr int STG = 64 * KS + 128 * VS;
  float* btab = (float*)(smem + 72 * 1024);
  int* lut = (int*)(smem + 72 * 1024 + 1040);
  float* misc = (float*)(smem + 72 * 1024 + 1040 + 512);
  const int tid = opq_tid8(), lane = tid & 63, w = __builtin_amdgcn_readfirstlane(tid >> 6), l31 = lane & 31, lh = lane >> 5;
  const int qsub = w >> 1, m = w & 1;
  const float lam_init = 0.8f - 0.6f * expf(-0.3f * (float)layer_idx);
  __syncthreads();
  if (tid < 128) lut[tid] = rel_bucket(tid);
  if (w == 0) {
    float p1 = lam[lane] * lam[64 + lane], p2 = lam[128 + lane] * lam[192 + lane];
    p1 = wave_sum(p1);
    p2 = wave_sum(p2);
    if (lane == 0) misc[0] = expf(p1) - expf(p2) + lam_init;
  }
  __syncthreads();
  const float lam_full = misc[0];
  const int xcd = bid & 7, loc = bid >> 3, nbx = nb >> 3;
  const int rph = (S / 128) / nbx;
  const int prow = pi_row(l31);
  for (int rd = 0; rd < 4 * rph; rd++) {
    const int hh = rd / rph, r = rd - hh * rph;
    const int bh = xcd + 8 * hh;
    const int kk = r >> 1;
    const int qb = (r & 1) ? (kk * nbx + loc) : ((S / 128 - 1) - kk * nbx - loc);
    const int b = bh >> 3, h = bh & 7;
    const int q0 = qb * 128, tq0 = q0 + 32 * qsub, t = tq0 + l31;
    const size_t tb = (size_t)b * S;
    __syncthreads();
    for (int i = tid; i < 258; i += 512) {
      const int n = i >> 1, mm = i & 1;
      const int bk = n < 128 ? lut[n] : 31;
      btab[i] = rel_bias[bk * 16 + 2 * h + mm] * LOG2E;
    }
    bf16x8 qf[4];
#pragma unroll
    for (int ks = 0; ks < 4; ks++) qf[ks] = *(const bf16x8*)(q + (tb + t) * 1024 + h * 128 + m * 64 + ks * 16 + lh * 8);
    f32x16 O[4];
#pragma unroll
    for (int et = 0; et < 4; et++)
#pragma unroll
      for (int r = 0; r < 16; r++) O[et][r] = 0.f;
    float m_run = NEGF, l_run = 0.f;
    const int nkt = 2 * qb + 2;
    u32x4 rk[2], rv[2];
    const u16* kp = k + tb * 1024 + h * 128;
    const u16* vp = vT + ((size_t)(b * 8 + h) * 128) * 8192;
#pragma unroll
    for (int i = 0; i < 2; i++) {
      const int id = tid + 512 * i;
      rk[i] = *(const u32x4*)(kp + (size_t)(id >> 4) * 1024 + (id & 15) * 8);
      rv[i] = *(const u32x4*)(vp + (size_t)(id >> 3) * 8192 + (id & 7) * 8);
    }
#pragma unroll
    for (int i = 0; i < 2; i++) {
      const int id = tid + 512 * i;
      *(u32x4*)&Ks[(id >> 4) * KS + (id & 15) * 8] = rk[i];
      *(u32x4*)&Vs[(id >> 3) * VS + (id & 7) * 8] = rv[i];
    }
#pragma unroll
    for (int i = 0; i < 2; i++) {
      const int id = tid + 512 * i;
      rk[i] = *(const u32x4*)(kp + (size_t)(64 + (id >> 4)) * 1024 + (id & 15) * 8);
      rv[i] = *(const u32x4*)(vp + (size_t)(id >> 3) * 8192 + 64 + (id & 7) * 8);
    }
    __syncthreads();
    const float cfar = btab[256 + m];
    for (int kt = 0; kt < nkt; kt++) {
      const u16* Ksc = Ks + (kt & 1) * STG;
      const u16* Vsc = Vs + (kt & 1) * STG;
      if (kt + 1 < nkt) {
        u16* Ksn = Ks + ((kt & 1) ^ 1) * STG;
        u16* Vsn = Vs + ((kt & 1) ^ 1) * STG;
#pragma unroll
        for (int i = 0; i < 2; i++) {
          const int id = tid + 512 * i;
          *(u32x4*)&Ksn[(id >> 4) * KS + (id & 15) * 8] = rk[i];
          *(u32x4*)&Vsn[(id >> 3) * VS + (id & 7) * 8] = rv[i];
        }
        const int k2 = (kt + 2 < nkt) ? kt + 2 : nkt - 1;
#pragma unroll
        for (int i = 0; i < 2; i++) {
          const int id = tid + 512 * i;
          rk[i] = *(const u32x4*)(kp + (size_t)(k2 * 64 + (id >> 4)) * 1024 + (id & 15) * 8);
          rv[i] = *(const u32x4*)(vp + (size_t)(id >> 3) * 8192 + k2 * 64 + (id & 7) * 8);
        }
      }
      const int s_tile = kt * 64;
      const int remk = tq0 + 31 - s_tile;
      const int nblk = remk < 0 ? 0 : (remk >= 32 ? 2 : 1);
#pragma unroll
      for (int kb = 0; kb < 2; kb++) {
        if (kb >= nblk) break;
        const int s0 = s_tile + 32 * kb;
        const bool nearb = (tq0 - (s0 + 31)) < 128;
        const bool first = (kt == 0) && (kb == 0);
        const float mref = first ? 0.f : m_run;
        const float cinit = nearb ? -mref : (cfar - mref);
        f32x16 acc;
#pragma unroll
        for (int r = 0; r < 16; r++) acc[r] = cinit;
#pragma unroll
        for (int ks = 0; ks < 4; ks++) {
          bf16x8 a = *(const bf16x8*)&Ksc[(32 * kb + prow) * KS + m * 64 + ks * 16 + lh * 8];
          acc = mfma32(a, qf[ks], acc);
        }
        bf16x8 vfa[4];
#pragma unroll
        for (int et = 0; et < 4; et++) vfa[et] = *(const bf16x8*)&Vsc[(32 * et + l31) * VS + 32 * kb + 8 * lh];
        __builtin_amdgcn_sched_barrier(0);
        if (nearb) {
#pragma unroll
          for (int r = 0; r < 16; r++) {
            const int key = s0 + 16 * (r >> 3) + 8 * lh + (r & 7);
            const int n = t - key;
            const int nc = n < 0 ? 0 : (n > 128 ? 128 : n);
            const float bv = btab[nc * 2 + m];
            acc[r] = (n < 0) ? NEGF : acc[r] + bv;
          }
        }
        float mx = acc[0];
#pragma unroll
        for (int r = 1; r < 16; r++) mx = fmaxf(mx, acc[r]);
        mx = xhalf_max(mx);
        if (first || __ballot(mx > 8.f)) {
          const float dlt = first ? mx : fmaxf(mx, 0.f);
          const float scl = __builtin_amdgcn_exp2f(-dlt);
#pragma unroll
          for (int r = 0; r < 16; r++) acc[r] -= dlt;
#pragma unroll
          for (int et = 0; et < 4; et++)
#pragma unroll
            for (int r = 0; r < 16; r++) O[et][r] *= scl;
          l_run *= scl;
          m_run = mref + dlt;
        }
        float ps = 0.f;
#pragma unroll
        for (int r = 0; r < 16; r++) {
          const float pv = __builtin_amdgcn_exp2f(acc[r]);
          acc[r] = pv;
          ps += pv;
        }
        l_run += ps;
        bf16x8 vfb[4];
#pragma unroll
        for (int et = 0; et < 4; et++) vfb[et] = *(const bf16x8*)&Vsc[(32 * et + l31) * VS + 32 * kb + 16 + 8 * lh];
        u32x4 pw0, pw1;
        pw0[0] = pk2(acc[0], acc[1]);
        pw0[1] = pk2(acc[2], acc[3]);
        pw0[2] = pk2(acc[4], acc[5]);
        pw0[3] = pk2(acc[6], acc[7]);
        pw1[0] = pk2(acc[8], acc[9]);
        pw1[1] = pk2(acc[10], acc[11]);
        pw1[2] = pk2(acc[12], acc[13]);
        pw1[3] = pk2(acc[14], acc[15]);
        const bf16x8 pB0 = __builtin_bit_cast(bf16x8, pw0), pB1 = __builtin_bit_cast(bf16x8, pw1);
        __builtin_amdgcn_sched_barrier(0);
#pragma unroll
        for (int et = 0; et < 4; et++) O[et] = mfma32(vfa[et], pB0, O[et]);
#pragma unroll
        for (int et = 0; et < 4; et++) O[et] = mfma32(vfb[et], pB1, O[et]);
      }
      __syncthreads();
    }
    float lt = xhalf_sum(l_run);
    const float inv = 1.f / lt;
    if (m == 1) {
#pragma unroll
      for (int et = 0; et < 4; et++)
#pragma unroll
        for (int r = 0; r < 16; r++) {
          const int e = 32 * et + (r & 3) + 8 * (r >> 2) + 4 * lh;
          exch[(qsub * 128 + e) * 32 + l31] = O[et][r] * inv;
        }
    }
    __syncthreads();
    if (m == 0) {
      float ss = 0.f;
#pragma unroll
      for (int et = 0; et < 4; et++)
#pragma unroll
        for (int r = 0; r < 16; r++) {
          const int e = 32 * et + (r & 3) + 8 * (r >> 2) + 4 * lh;
          const float v = O[et][r] * inv - lam_full * exch[(qsub * 128 + e) * 32 + l31];
          O[et][r] = v;
          ss += v * v;
        }
      ss = xhalf_sum(ss);
      const float rs = rsqrtf(ss * (1.f / 128.f) + LN_EPS);
      const float osc = 1.f - lam_init;
#pragma unroll
      for (int et = 0; et < 4; et++)
#pragma unroll
        for (int r4 = 0; r4 < 4; r4++) {
          const int e = 32 * et + 8 * r4 + 4 * lh;
          const f32x4 gv = *(const f32x4*)(subln + e);
          u32x2 ov;
          ov[0] = pk2(O[et][4 * r4 + 0] * rs * gv[0] * osc, O[et][4 * r4 + 1] * rs * gv[1] * osc);
          ov[1] = pk2(O[et][4 * r4 + 2] * rs * gv[2] * osc, O[et][4 * r4 + 3] * rs * gv[3] * osc);
          *(u32x2*)(o + (tb + t) * 1024 + h * 128 + e) = ov;
        }
    }
  }
}

#define XB_TMO      128
#define XB_XCNT(j)  (256  + 64 * (j))
#define XB_XSUB(j)  (1280 + 64 * (j))
#define XB_XGEN(j)  (2304 + 64 * (j))
#define XB_TOP      3328
#define XB_TOPGEN   3392
#define XCD_BAR_WORDS 3456
#define XB_SPIN_CAP (1u << 20)
#define LAS __attribute__((address_space(3)))
DI unsigned xb_ld(unsigned* p) { return __hip_atomic_load(p, __ATOMIC_RELAXED, __HIP_MEMORY_SCOPE_AGENT); }
DI unsigned xb_add(unsigned* p, unsigned v) { return __hip_atomic_fetch_add(p, v, __ATOMIC_RELAXED, __HIP_MEMORY_SCOPE_AGENT); }
DI unsigned xb_xcc_id() { return (unsigned)__builtin_amdgcn_s_getreg((3 << 11) | 20) & 0xFu; }
#define XB_SPIN(cond, bar) do { unsigned _sp = 0; while (cond) { __builtin_amdgcn_s_sleep(1); \
    if ((++_sp & 255u) == 0u) { if (xb_ld(&(bar)[XB_TMO])) break; if (_sp > XB_SPIN_CAP) { atomicAdd(&(bar)[XB_TMO], 1u); break; } } } } while (0)
struct XcdBarrier {
  unsigned* bar;
  unsigned x;
  volatile LAS unsigned* st;
};
DI XcdBarrier xcd_barrier_post(unsigned* bar, volatile LAS unsigned* st) {
  XcdBarrier b;
  b.bar = bar;
  b.x = xb_xcc_id();
  b.st = st;
  if (threadIdx.x == 0) (void)xb_add(&bar[XB_XCNT(b.x)], 1u);
  return b;
}
DI void xcd_barrier_complete(unsigned* bar, unsigned x, unsigned& nloc, unsigned& nx) {
  const unsigned G = gridDim.x * gridDim.y * gridDim.z;
  unsigned sum, cnt, mine, sp = 0u;
  for (;;) {
    sum = 0u; cnt = 0u; mine = 0u;
#pragma unroll
    for (unsigned j = 0; j < 16; ++j) {
      const unsigned c = xb_ld(&bar[XB_XCNT(j)]);
      sum += c;
      cnt += (c > 0u) ? 1u : 0u;
      mine = (j == x) ? c : mine;
    }
    if (sum == G) break;
    __builtin_amdgcn_s_sleep(1);
    if ((++sp & 255u) == 0u) { if (xb_ld(&bar[XB_TMO])) break; if (sp > XB_SPIN_CAP) { atomicAdd(&bar[XB_TMO], 1u); break; } }
  }
  nloc = mine > 0u ? mine : 1u;
  nx = cnt > 0u ? cnt : 1u;
}
DI void xcd_barrier(const XcdBarrier& b0) {
  asm volatile("s_waitcnt vmcnt(0)" ::: "memory");
  __syncthreads();
  if (threadIdx.x == 0) {
    XcdBarrier b = b0;
    b.x = __builtin_amdgcn_readfirstlane(xb_xcc_id());
    unsigned* bar = b.bar;
    asm volatile("" : "+s"(bar));
    __builtin_amdgcn_s_waitcnt(0);
    unsigned nloc = b.st[0], nx = b.st[1];
    if (nloc == 0u) { xcd_barrier_complete(bar, b.x, nloc, nx); b.st[0] = nloc; b.st[1] = nx; }
    const unsigned old = xb_add(&bar[XB_XSUB(b.x)], 1u);
    const unsigned gen = old / nloc;
    if (old + 1u == (gen + 1u) * nloc) {
      __builtin_amdgcn_fence(__ATOMIC_RELEASE, "agent");
      asm volatile("s_waitcnt vmcnt(0)" ::: "memory");
      const unsigned og = xb_add(&bar[XB_TOP], 1u);
      const unsigned tg = og / nx;
      if (og + 1u == (tg + 1u) * nx) xb_add(&bar[XB_TOPGEN], 1u);
      else XB_SPIN(xb_ld(&bar[XB_TOPGEN]) == tg, bar);
      __builtin_amdgcn_fence(__ATOMIC_ACQUIRE, "agent");
      xb_add(&bar[XB_XGEN(b.x)], 1u);
      asm volatile("s_waitcnt vmcnt(0)" ::: "memory");
    } else {
      XB_SPIN(xb_ld(&bar[XB_XGEN(b.x)]) == gen, bar);
      __builtin_amdgcn_fence(__ATOMIC_ACQUIRE, "agent");
      asm volatile("s_waitcnt vmcnt(0)" ::: "memory");
    }
  }
  __syncthreads();
}

#define DECL_WS_PTRS(ws) \
  u16* w_ain = (u16*)(ws + W_AIN); \
  u16* w_uk = (u16*)(ws + W_UK); \
  u16* w_uv = (u16*)(ws + W_UV); \
  u16* w_ao = (u16*)(ws + W_AO); \
  u16* w_bin = (u16*)(ws + W_BIN); \
  u16* w_bo = (u16*)(ws + W_BO); \
  u16* w_w1 = (u16*)(ws + W_W1); \
  u16* w_w2 = (u16*)(ws + W_W2); \
  float* mod = (float*)(ws + WS_MOD); \
  u16* hbuf = (u16*)(ws + WS_H); \
  char* big = ws + WS_BIG; \
  u16* qbuf = (u16*)(big + B_Q); \
  u16* iqbuf = (u16*)(big + B_IQ); \
  u16* ikbuf = (u16*)(big + B_IK); \
  float* iwbuf = (float*)(big + B_IW); \
  float* ckvraw = (float*)(big + B_CKVRAW); \
  u16* ckvn = (u16*)(big + B_CKVN); \
  u16* selbuf = (u16*)(big + B_SEL); \
  u16* kbuf = (u16*)(big + B_K); \
  u16* vtbuf = (u16*)(big + B_VT); \
  u16* obuf = (u16*)(big + B_O); \
  u16* hid = (u16*)big;

__global__ void __launch_bounds__(512, 2) hybrid_fwd(Params p) {
  __shared__ __attribute__((aligned(16))) char smem[2 * LDS_BYTES];
  cg::grid_group grid = cg::this_grid();
  const int bid = blockIdx.x, nb = gridDim.x;
  const int half = __builtin_amdgcn_readfirstlane((int)(threadIdx.x >> 8));
  const int vb = half * nb + bid, nvb = 2 * nb;
  char* smh = smem + half * LDS_BYTES;
  char* ws = p.ws;
  unsigned* bar = (unsigned*)(ws + WS_BAR);
  volatile LAS unsigned* xst = (volatile LAS unsigned*)(smem + 2 * LDS_BYTES - 16);
  if (threadIdx.x < 2) xst[threadIdx.x] = 0u;
  __syncthreads();
  const XcdBarrier xb = xcd_barrier_post(bar, xst);

  {
  DECL_WS_PTRS(ws)
  (void)qbuf; (void)iqbuf; (void)ikbuf; (void)iwbuf; (void)ckvraw; (void)ckvn; (void)selbuf; (void)kbuf; (void)vtbuf; (void)obuf; (void)hid;
  tconv_phase(p.a_w_in, w_ain, 2, 1024, 1864, A_INP, smh, vb, nvb);
  tconv_phase(p.a_w_uk, w_uk, 32, 64, 256, 256, smh, vb, nvb);
  tconv_phase(p.a_w_uv, w_uv, 32, 256, 64, 64, smh, vb, nvb);
  tconv_phase(p.a_w_o, w_ao, 2, 1024, 1024, 1024, smh, vb, nvb);
  tconv_phase(p.b_w_in, w_bin, 2, 1024, 3072, 3072, smh, vb, nvb);
  tconv_phase(p.b_w_o, w_bo, 2, 1024, 1024, 1024, smh, vb, nvb);
  tconv_phase(p.mlp_w1, w_w1, 4, 1024, 4096, 4096, smh, vb, nvb);
  tconv_phase(p.mlp_w2, w_w2, 4, 4096, 1024, 1024, smh, vb, nvb);
  mod_phase(p, mod, smh, vb, nvb);
  grid.sync();
  h0_phase(p.x, mod, hbuf, vb, nvb);
  xcd_barrier(xb);
  }

#pragma unroll 1
  for (int sl = 0; sl < 8; sl++) {
    char* wsl = p.ws;
    asm volatile("" : "+s"(wsl));
    DECL_WS_PTRS(wsl)
    const int i = sl >> 1, j = i >> 1;
    const float* modi = mod + (size_t)i * 4 * 6144;
    const u16* Ares;
    const u16* Wres;
    int Kres, goff;
    if ((sl & 1) == 0) {
      if ((i & 1) == 0) {
        EpiArgs ea{};
        ea.o0 = qbuf; ea.f0 = ckvraw; ea.o1 = iqbuf; ea.o2 = ikbuf; ea.f1 = iwbuf;
        for (int rep = 0; rep < (PROBE_DUP == 4 ? 2 : 1); rep++) gemm8p_phase<EPI_AIN>(hbuf, w_ain + (size_t)j * A_INP * 1024, T, A_INP, 1024, ea, smem, bid, nb);
        xcd_barrier(xb);
        ckvnorm_phase(ckvraw, p.a_kv_norm + j * 256, ckvn, vb, nvb);
        for (int rep = 0; rep < (PROBE_DUP == 2 ? 2 : 1); rep++) indexer_phase(iqbuf, ikbuf, iwbuf, selbuf, smh, vb, nvb);
        xcd_barrier(xb);
        for (int rep = 0; rep < (PROBE_DUP == 3 ? 2 : 1); rep++) sparse_phase(qbuf, ckvn, selbuf, w_uk + (size_t)j * 16 * 256 * 64, w_uv + (size_t)j * 16 * 256 * 64, p.rel_bias,
                     hbuf, obuf, smh, vb, nvb);
        xcd_barrier(xb);
        Wres = w_ao + (size_t)j * 1024 * 1024;
      } else {
        EpiArgs ea{};
        ea.o0 = qbuf; ea.o1 = kbuf; ea.o2 = vtbuf;
        for (int rep = 0; rep < (PROBE_DUP == 4 ? 2 : 1); rep++) gemm8p_phase<EPI_BIN>(hbuf, w_bin + (size_t)j * 3072 * 1024, T, 3072, 1024, ea, smem, bid, nb);
        xcd_barrier(xb);
        for (int rep = 0; rep < (PROBE_DUP == 1 ? 2 : 1); rep++) diffattn_phase(qbuf, kbuf, vtbuf, obuf, p.rel_bias, p.b_lambda + j * 256, p.b_subln + j * 128, i, smem, bid, nb);
        xcd_barrier(xb);
        Wres = w_bo + (size_t)j * 1024 * 1024;
      }
      Ares = obuf; Kres = 1024; goff = 2 * 1024;
    } else {
      EpiArgs ea{};
      ea.o0 = hid;
      for (int rep = 0; rep < (PROBE_DUP == 4 ? 2 : 1); rep++) gemm8p_phase<EPI_SQRELU>(hbuf, w_w1 + (size_t)i * 4096 * 1024, T, 4096, 1024, ea, smem, bid, nb);
      xcd_barrier(xb);
      Ares = hid; Wres = w_w2 + (size_t)i * 4096 * 1024; Kres = 4096; goff = 5 * 1024;
    }
    {
      EpiArgs ea{};
      ea.f0 = p.out;
      ea.xin = (sl == 0) ? p.x : (const float*)p.out;
      ea.g = modi + goff;
      gemm8p_phase<EPI_RES>(Ares, Wres, T, 1024, Kres, ea, smem, bid, nb);
    }
    xcd_barrier(xb);
    {
      const float* modn = ((sl & 1) == 0) ? modi : (i < 3 ? modi + 4 * 6144 : (const float*)nullptr);
      const int sh_off = ((sl & 1) == 0) ? 3 * 1024 : 0;
      ln_phase(p.out, p.ln_g + (size_t)(i * 2 + (sl & 1)) * 1024, p.ln_b + (size_t)(i * 2 + (sl & 1)) * 1024, modn, sh_off,
               hbuf, vb, nvb);
    }
    xcd_barrier(xb);
  }
}

extern "C" void kernel_launch(void* const* d_in, const int* in_sizes, int n_in, void* d_out, int out_size, void* d_ws,
                              size_t ws_size, hipStream_t stream) {
  static int grid_blocks = 0;
  if (!grid_blocks) {
    int dev = 0, cus = 0, per_cu = 0;
    hipGetDevice(&dev);
    hipDeviceGetAttribute(&cus, hipDeviceAttributeMultiprocessorCount, dev);
    hipOccupancyMaxActiveBlocksPerMultiprocessor(&per_cu, hybrid_fwd, 512, 0);
    (void)per_cu;
    grid_blocks = cus;
    if (grid_blocks > 256) grid_blocks = 256;
  }
  Params p{};
  p.x = (const float*)d_in[0];
  p.c = (const float*)d_in[1];
  p.rel_bias = (const float*)d_in[2];
  p.ada_w = (const float*)d_in[3];
  p.ada_b = (const float*)d_in[4];
  p.ln_g = (const float*)d_in[5];
  p.ln_b = (const float*)d_in[6];
  p.a_w_in = (const float*)d_in[7];
  p.a_kv_norm = (const float*)d_in[8];
  p.a_w_uk = (const float*)d_in[9];
  p.a_w_uv = (const float*)d_in[10];
  p.a_w_o = (const float*)d_in[11];
  p.b_w_in = (const float*)d_in[12];
  p.b_lambda = (const float*)d_in[13];
  p.b_subln = (const float*)d_in[14];
  p.b_w_o = (const float*)d_in[15];
  p.mlp_w1 = (const float*)d_in[16];
  p.mlp_w2 = (const float*)d_in[17];
  p.out = (float*)d_out;
  p.ws = (char*)d_ws;
  hipMemsetAsync((char*)d_ws + WS_BAR, 0, XCD_BAR_WORDS * 4, stream);
  void* args[] = {&p};
  hipError_t e = hipLaunchCooperativeKernel((void*)hybrid_fwd, dim3(grid_blocks), dim3(512), args, 0, stream);
  if (e != hipSuccess) fprintf(stderr, "cooperative launch failed: %s (grid %d)\n", hipGetErrorString(e), grid_blocks);
}
```

```cpp
#include <hip/hip_runtime.h>
#include <hip/hip_cooperative_groups.h>
#include <stdint.h>
#include <stdio.h>
namespace cg = cooperative_groups;

typedef unsigned short u16;
typedef short bf16x8 __attribute__((ext_vector_type(8)));
typedef short s16x4 __attribute__((ext_vector_type(4)));
typedef float f32x16 __attribute__((ext_vector_type(16)));
typedef float f32x4 __attribute__((ext_vector_type(4)));
typedef float f32x2 __attribute__((ext_vector_type(2)));
typedef __bf16 bf16x2_t __attribute__((ext_vector_type(2)));
typedef unsigned u32x4 __attribute__((ext_vector_type(4)));
typedef unsigned u32x2 __attribute__((ext_vector_type(2)));
typedef __attribute__((address_space(3))) s16x4* lds_s16x4_ptr;

#define DI __device__ __forceinline__
#ifndef PROBE_DUP
#define PROBE_DUP 0
#endif

constexpr int D = 1024, NBATCH = 4, S = 8192, T = NBATCH * S;
constexpr int A_INP = 2048;
constexpr float DN_ALPHA = 1.6817928305074292f;
constexpr float LOG2E = 1.4426950408889634f;
constexpr float LN_EPS = 1e-5f;
constexpr float NEGF = -1e30f;
constexpr int TOPK = 256;
constexpr int CAP = 704;
constexpr int LDS_BYTES = 72 * 1024;

constexpr size_t MB = 1024 * 1024;
constexpr size_t W_AIN = 0;
constexpr size_t W_UK = W_AIN + (size_t)2 * 2048 * 1024 * 2;
constexpr size_t W_UV = W_UK + (size_t)2 * 16 * 256 * 64 * 2;
constexpr size_t W_AO = W_UV + (size_t)2 * 16 * 256 * 64 * 2;
constexpr size_t W_BIN = W_AO + (size_t)2 * 1024 * 1024 * 2;
constexpr size_t W_BO = W_BIN + (size_t)2 * 3072 * 1024 * 2;
constexpr size_t W_W1 = W_BO + (size_t)2 * 1024 * 1024 * 2;
constexpr size_t W_W2 = W_W1 + (size_t)4 * 4096 * 1024 * 2;
constexpr size_t WS_MOD = W_W2 + (size_t)4 * 4096 * 1024 * 2;
constexpr size_t WS_H = WS_MOD + 1 * MB;
constexpr size_t WS_BIG = WS_H + 64 * MB;
constexpr size_t WS_BAR = WS_BIG + 256 * MB;
constexpr size_t B_Q = 0;
constexpr size_t B_IQ = 64 * MB;
constexpr size_t B_IK = 96 * MB;
constexpr size_t B_IW = 100 * MB;
constexpr size_t B_CKVRAW = 104 * MB;
constexpr size_t B_CKVN = 136 * MB;
constexpr size_t B_SEL = 152 * MB;
constexpr size_t B_K = 64 * MB;
constexpr size_t B_VT = 128 * MB;
constexpr size_t B_O = 192 * MB;

struct Params {
  const float *x, *c, *rel_bias, *ada_w, *ada_b, *ln_g, *ln_b, *a_w_in, *a_kv_norm, *a_w_uk, *a_w_uv, *a_w_o, *b_w_in,
      *b_lambda, *b_subln, *b_w_o, *mlp_w1, *mlp_w2;
  float* out;
  char* ws;
};

DI int opq_tid() {
  int t = threadIdx.x & 255;
  asm volatile("" : "+v"(t));
  return t;
}
DI int opq_tid8() {
  int t = threadIdx.x;
  asm volatile("" : "+v"(t));
  return t;
}
DI unsigned pk2(float lo, float hi) {
  f32x2 v = {lo, hi};
  bf16x2_t b = __builtin_convertvector(v, bf16x2_t);
  return __builtin_bit_cast(unsigned, b);
}
DI u16 f2bf(float x) { return (u16)(pk2(x, 0.f) & 0xffffu); }
DI float wave_sum(float v) {
#pragma unroll
  for (int o = 32; o >= 1; o >>= 1) v += __shfl_xor(v, o);
  return v;
}
DI float xhalf_max(float x) {
  auto t = __builtin_amdgcn_permlane32_swap(__float_as_uint(x), __float_as_uint(x), false, false);
  return fmaxf(__uint_as_float(t[0]), __uint_as_float(t[1]));
}
DI float xhalf_sum(float x) {
  auto t = __builtin_amdgcn_permlane32_swap(__float_as_uint(x), __float_as_uint(x), false, false);
  return __uint_as_float(t[0]) + __uint_as_float(t[1]);
}
DI float xrow16_max(float x) {
  auto s_ = __builtin_amdgcn_permlane16_swap(__float_as_uint(x), __float_as_uint(x), false, false);
  x = fmaxf(__uint_as_float(s_[0]), __uint_as_float(s_[1]));
  return xhalf_max(x);
}
DI float xrow16_sum(float x) {
  auto s_ = __builtin_amdgcn_permlane16_swap(__float_as_uint(x), __float_as_uint(x), false, false);
  x = __uint_as_float(s_[0]) + __uint_as_float(s_[1]);
  return xhalf_sum(x);
}
DI f32x16 mfma32(bf16x8 a, bf16x8 b, f32x16 c) { return __builtin_amdgcn_mfma_f32_32x32x16_bf16(a, b, c, 0, 0, 0); }
DI f32x4 mfma16(bf16x8 a, bf16x8 b, f32x4 c) { return __builtin_amdgcn_mfma_f32_16x16x32_bf16(a, b, c, 0, 0, 0); }
DI int pi_row(int r) { return (r & ~12) | ((r & 4) << 1) | ((r & 8) >> 1); }

DI int rel_bucket(int n) {
  if (n < 16) return n;
  float nf = (float)n;
  int large = 16 + (int)(logf(nf / 16.f) / 2.0794415416798357f * 16.f);
  return large < 31 ? large : 31;
}

DI void tconv_phase(const float* __restrict__ src, u16* __restrict__ dst, int batch, int R, int C, int Cpad, char* smem,
                    int bid, int nb) {
  float* tile = (float*)smem;
  const int tid = opq_tid();
  const int tr = R / 64, tc = Cpad / 64;
  const int ntiles = batch * tr * tc;
  for (int it0 = 0; it0 < ntiles; it0 += nb) {
    const int it = (it0 + bid < ntiles) ? it0 + bid : ntiles - 1;
    const int bi = it / (tr * tc);
    const int rem = it - bi * (tr * tc);
    const int ri = rem / tc, ci = rem - ri * tc;
    const float* s = src + (size_t)bi * R * C;
    u16* d = dst + (size_t)bi * Cpad * R;
    __syncthreads();
#pragma unroll
    for (int k = 0; k < 4; k++) {
      const int r = (tid >> 4) + 16 * k;
      const int cl = (tid & 15) * 4;
      const int cc = ci * 64 + cl;
      f32x4 v = {0.f, 0.f, 0.f, 0.f};
      if (cc < C) v = *(const f32x4*)(s + (size_t)(ri * 64 + r) * C + cc);
      tile[r * 65 + cl + 0] = v[0];
      tile[r * 65 + cl + 1] = v[1];
      tile[r * 65 + cl + 2] = v[2];
      tile[r * 65 + cl + 3] = v[3];
    }
    __syncthreads();
#pragma unroll
    for (int k = 0; k < 2; k++) {
      const int cl = (tid >> 3) + 32 * k;
      const int r8 = (tid & 7) * 8;
      u32x4 o;
      o[0] = pk2(tile[(r8 + 0) * 65 + cl], tile[(r8 + 1) * 65 + cl]);
      o[1] = pk2(tile[(r8 + 2) * 65 + cl], tile[(r8 + 3) * 65 + cl]);
      o[2] = pk2(tile[(r8 + 4) * 65 + cl], tile[(r8 + 5) * 65 + cl]);
      o[3] = pk2(tile[(r8 + 6) * 65 + cl], tile[(r8 + 7) * 65 + cl]);
      *(u32x4*)(d + (size_t)(ci * 64 + cl) * R + ri * 64 + r8) = o;
    }
  }
}

DI void mod_phase(const Params& p, float* mod, char* smem, int bid, int nb) {
  float* sc = (float*)smem;
  float* red = sc + 4096;
  const int tid = opq_tid(), lane = tid & 63, w = __builtin_amdgcn_readfirstlane(tid >> 6);
  __syncthreads();
  for (int i = tid; i < 4096; i += 256) {
    float v = p.c[i];
    sc[i] = v / (1.f + expf(-v));
  }
  __syncthreads();
  for (int it = bid; it < 4 * 384; it += nb) {
    const int l = it / 384, e0 = (it - l * 384) * 16;
    const int ds = lane >> 4, ec = lane & 15;
    const float* wp = p.ada_w + ((size_t)l * 1024 + w * 256 + ds) * 6144 + e0 + ec;
    float a0 = 0, a1 = 0, a2 = 0, a3 = 0;
#pragma unroll 16
    for (int d = 0; d < 64; d++) {
      float wv = wp[(size_t)(4 * d) * 6144];
      int dd = w * 256 + 4 * d + ds;
      a0 += sc[dd] * wv;
      a1 += sc[1024 + dd] * wv;
      a2 += sc[2048 + dd] * wv;
      a3 += sc[3072 + dd] * wv;
    }
    a0 += __shfl_xor(a0, 16); a0 += __shfl_xor(a0, 32);
    a1 += __shfl_xor(a1, 16); a1 += __shfl_xor(a1, 32);
    a2 += __shfl_xor(a2, 16); a2 += __shfl_xor(a2, 32);
    a3 += __shfl_xor(a3, 16); a3 += __shfl_xor(a3, 32);
    if (lane < 16) {
      red[(w * 4 + 0) * 16 + lane] = a0;
      red[(w * 4 + 1) * 16 + lane] = a1;
      red[(w * 4 + 2) * 16 + lane] = a2;
      red[(w * 4 + 3) * 16 + lane] = a3;
    }
    __syncthreads();
    if (tid < 64) {
      const int b = tid >> 4, e = tid & 15;
      float sm = red[(0 * 4 + b) * 16 + e] + red[(1 * 4 + b) * 16 + e] + red[(2 * 4 + b) * 16 + e] + red[(3 * 4 + b) * 16 + e] +
                 p.ada_b[l * 6144 + e0 + e];
      mod[((size_t)l * 4 + b) * 6144 + e0 + e] = sm;
    }
    __syncthreads();
  }
}

DI void h0_phase(const float* __restrict__ x, const float* __restrict__ mod0, u16* __restrict__ h, int bid, int nb) {
  const size_t n8 = (size_t)T * 1024 / 8;
  for (size_t i = (size_t)bid * 256 + opq_tid(); i < n8; i += (size_t)nb * 256) {
    const size_t e = i * 8;
    const int t = (int)(e >> 10), d = (int)(e & 1023), b = t >> 13;
    const float* m = mod0 + (size_t)b * 6144;
    f32x4 v0 = *(const f32x4*)(x + e), v1 = *(const f32x4*)(x + e + 4);
    f32x4 sh0 = *(const f32x4*)(m + d), sh1 = *(const f32x4*)(m + d + 4);
    f32x4 sc0 = *(const f32x4*)(m + 1024 + d), sc1 = *(const f32x4*)(m + 1024 + d + 4);
    v0 = v0 * (1.f + sc0) + sh0;
    v1 = v1 * (1.f + sc1) + sh1;
    u32x4 o;
    o[0] = pk2(v0[0], v0[1]);
    o[1] = pk2(v0[2], v0[3]);
    o[2] = pk2(v1[0], v1[1]);
    o[3] = pk2(v1[2], v1[3]);
    *(u32x4*)(h + e) = o;
  }
}

DI void ln_phase(float* z, const float* __restrict__ g, const float* __restrict__ bt, const float* modn, int sh_off,
                 u16* __restrict__ h, int bid, int nb) {
  const int tid = opq_tid(), lane = tid & 63, w = __builtin_amdgcn_readfirstlane(tid >> 6);
  const int nw = nb * 4;
  for (int row0 = bid * 4 + w; row0 < T; row0 += 4 * nw) {
    f32x4 v[4][4];
#pragma unroll
    for (int rr = 0; rr < 4; rr++) {
      const int row = row0 + rr * nw;
      const f32x4* zp = (const f32x4*)(z + (size_t)(row < T ? row : row0) * 1024);
#pragma unroll
      for (int c = 0; c < 4; c++) v[rr][c] = zp[c * 64 + lane];
    }
#pragma unroll
    for (int rr = 0; rr < 4; rr++) {
      const int row = row0 + rr * nw;
      if (row < T) {
        float s = 0;
#pragma unroll
        for (int c = 0; c < 4; c++) s += v[rr][c][0] + v[rr][c][1] + v[rr][c][2] + v[rr][c][3];
        const float mu = wave_sum(s) * (1.f / 1024.f);
        float q = 0;
#pragma unroll
        for (int c = 0; c < 4; c++) {
          v[rr][c] = v[rr][c] - mu;
          q += v[rr][c][0] * v[rr][c][0] + v[rr][c][1] * v[rr][c][1] + v[rr][c][2] * v[rr][c][2] + v[rr][c][3] * v[rr][c][3];
        }
        const float rstd = rsqrtf(wave_sum(q) * (1.f / 1024.f) + LN_EPS);
        const int b = row >> 13;
        f32x4* zp = (f32x4*)(z + (size_t)row * 1024);
#pragma unroll
        for (int c = 0; c < 4; c++) {
          const int d = c * 256 + lane * 4;
          f32x4 y = v[rr][c] * rstd * *(const f32x4*)(g + d) + *(const f32x4*)(bt + d);
          zp[c * 64 + lane] = y;
          if (modn) {
            const float* m = modn + (size_t)b * 6144 + sh_off;
            f32x4 hv = y * (1.f + *(const f32x4*)(m + 1024 + d)) + *(const f32x4*)(m + d);
            u32x2 o;
            o[0] = pk2(hv[0], hv[1]);
            o[1] = pk2(hv[2], hv[3]);
            *(u32x2*)(h + (size_t)row * 1024 + d) = o;
          }
        }
      }
    }
  }
}

enum { EPI_AIN = 0, EPI_BIN = 1, EPI_RES = 2, EPI_SQRELU = 3 };
struct EpiArgs {
  u16 *o0, *o1, *o2;
  float *f0, *f1;
  const float* xin;
  const float* g;
};

template <int EPI>
DI void epi_store4(const EpiArgs& ea, int row, int col, const float* v, int bidx) {
  if (EPI == EPI_AIN) {
    if (col < 1024) {
      u32x2 o;
      o[0] = pk2(v[0], v[1]);
      o[1] = pk2(v[2], v[3]);
      *(u32x2*)(ea.o0 + (size_t)row * 1024 + col) = o;
    } else if (col < 1280) {
      *(f32x4*)(ea.f0 + (size_t)row * 256 + (col - 1024)) = (f32x4){v[0], v[1], v[2], v[3]};
    } else if (col < 1792) {
      u32x2 o;
      o[0] = pk2(v[0], v[1]);
      o[1] = pk2(v[2], v[3]);
      *(u32x2*)(ea.o1 + (size_t)row * 512 + (col - 1280)) = o;
    } else if (col < 1856) {
      const int d = col - 1792;
      const int sidx = row & 8191;
      const size_t off = (size_t)(row >> 13) * S * 64 +
                         ((size_t)((sidx >> 5) * 4 + (d >> 4)) * 64 + 32 * ((d >> 3) & 1) + (sidx & 31)) * 8 + (d & 7);
      u32x2 o;
      o[0] = pk2(v[0], v[1]);
      o[1] = pk2(v[2], v[3]);
      *(u32x2*)(ea.o2 + off) = o;
    } else if (col < 1864) {
      const float sc = 0.044194173824159216f;
      *(f32x4*)(ea.f1 + (size_t)row * 8 + (col - 1856)) = (f32x4){v[0] * sc, v[1] * sc, v[2] * sc, v[3] * sc};
    }
  } else if (EPI == EPI_BIN) {
    if (col < 1024) {
      const float sc = 0.125f * LOG2E;
      u32x2 o;
      o[0] = pk2(v[0] * sc, v[1] * sc);
      o[1] = pk2(v[2] * sc, v[3] * sc);
      *(u32x2*)(ea.o0 + (size_t)row * 1024 + col) = o;
    } else if (col < 2048) {
      u32x2 o;
      o[0] = pk2(v[0], v[1]);
      o[1] = pk2(v[2], v[3]);
      *(u32x2*)(ea.o1 + (size_t)row * 1024 + (col - 1024)) = o;
    } else {
      const int cv = col - 2048;
#pragma unroll
      for (int q = 0; q < 4; q++) ea.o2[((size_t)bidx * 1024 + cv + q) * 8192 + (row & 8191)] = f2bf(v[q]);
    }
  } else if (EPI == EPI_RES) {
    const f32x4 gg = *(const f32x4*)(ea.g + (size_t)bidx * 6144 + col);
    const size_t o = (size_t)row * 1024 + col;
    const f32x4 xv = *(const f32x4*)(ea.xin + o);
    f32x4 r;
#pragma unroll
    for (int q = 0; q < 4; q++) r[q] = DN_ALPHA * xv[q] + (1.f + gg[q]) * v[q];
    *(f32x4*)(ea.f0 + o) = r;
  } else {
    float r[4];
#pragma unroll
    for (int q = 0; q < 4; q++) {
      r[q] = v[q] > 0.f ? v[q] : 0.f;
      r[q] = r[q] * r[q];
    }
    u32x2 o;
    o[0] = pk2(r[0], r[1]);
    o[1] = pk2(r[2], r[3]);
    *(u32x2*)(ea.o0 + (size_t)row * 4096 + col) = o;
  }
}

template <int EPI>
DI void gemm_phase(const u16* __restrict__ A, const u16* __restrict__ Bt, int M, int N, int K, const EpiArgs& ea,
                   char* smem, int bid, int nb) {
  constexpr int MI = 4, BM = 64 * MI, BN = 256;
  u16* As = (u16*)smem;
  u16* Bs = As + BM * 72;
  const int tid = opq_tid8(), lane = tid & 63, w = __builtin_amdgcn_readfirstlane(tid >> 6), wm = w >> 2, wn = w & 3, l31 = lane & 31, lh = lane >> 5;
  const int ntn = N / BN, ntm = M / BM, nt = ntn * ntm, nk = K / 64;
  const int lr = tid >> 3, lc = (tid & 7) * 8;
  const int xcd = bid & 7, nbx = nb >> 3, cntx = (ntm >> 3) * ntn;
  (void)nt;
  for (int sq = bid >> 3; sq < cntx; sq += nbx) {
    const int tmx = sq / ntn, tn = sq - tmx * ntn;
    const int tm = tmx * 8 + xcd;
    const int m0 = tm * BM, n0 = tn * BN;
    f32x16 acc[MI][2];
#pragma unroll
    for (int i = 0; i < MI; i++)
#pragma unroll
      for (int j = 0; j < 2; j++)
#pragma unroll
        for (int r = 0; r < 16; r++) acc[i][j][r] = 0.f;
    u32x4 ra[4], rb[4];
    const u16* ap = A + (size_t)(m0 + lr) * K + lc;
    const u16* bp = Bt + (size_t)(n0 + lr) * K + lc;
#pragma unroll
    for (int i = 0; i < 4; i++) ra[i] = *(const u32x4*)(ap + (size_t)i * 64 * K);
#pragma unroll
    for (int i = 0; i < 4; i++) rb[i] = *(const u32x4*)(bp + (size_t)i * 64 * K);
    __syncthreads();
#pragma unroll
    for (int i = 0; i < 4; i++) *(u32x4*)&As[(lr + 64 * i) * 72 + lc] = ra[i];
#pragma unroll
    for (int i = 0; i < 4; i++) *(u32x4*)&Bs[(lr + 64 * i) * 72 + lc] = rb[i];
    __syncthreads();
    for (int kt = 0; kt < nk; kt++) {
      if (kt + 1 < nk) {
#pragma unroll
        for (int i = 0; i < 4; i++) ra[i] = *(const u32x4*)(ap + (size_t)i * 64 * K + (kt + 1) * 64);
#pragma unroll
        for (int i = 0; i < 4; i++) rb[i] = *(const u32x4*)(bp + (size_t)i * 64 * K + (kt + 1) * 64);
      }
#pragma unroll
      for (int ks = 0; ks < 4; ks++) {
        bf16x8 af[MI], b0, b1;
#pragma unroll
        for (int i = 0; i < MI; i++) af[i] = *(const bf16x8*)&As[(wm * 32 * MI + 32 * i + l31) * 72 + ks * 16 + lh * 8];
        b0 = *(const bf16x8*)&Bs[(wn * 64 + l31) * 72 + ks * 16 + lh * 8];
        b1 = *(const bf16x8*)&Bs[(wn * 64 + 32 + l31) * 72 + ks * 16 + lh * 8];
#pragma unroll
        for (int i = 0; i < MI; i++) {
          acc[i][0] = mfma32(b0, af[i], acc[i][0]);
          acc[i][1] = mfma32(b1, af[i], acc[i][1]);
        }
      }
      __syncthreads();
      if (kt + 1 < nk) {
#pragma unroll
        for (int i = 0; i < 4; i++) *(u32x4*)&As[(lr + 64 * i) * 72 + lc] = ra[i];
#pragma unroll
        for (int i = 0; i < 4; i++) *(u32x4*)&Bs[(lr + 64 * i) * 72 + lc] = rb[i];
        __syncthreads();
      }
    }
    const int bidx = m0 >> 13;
#pragma unroll
    for (int i = 0; i < MI; i++) {
      const int row = m0 + wm * 32 * MI + 32 * i + l31;
#pragma unroll
      for (int j = 0; j < 2; j++) {
#pragma unroll
        for (int r4 = 0; r4 < 4; r4++) {
          const int col = n0 + wn * 64 + 32 * j + 8 * r4 + 4 * lh;
          float v[4];
#pragma unroll
          for (int q = 0; q < 4; q++) v[q] = acc[i][j][4 * r4 + q];
          epi_store4<EPI>(ea, row, col, v, bidx);
        }
      }
    }
  }
}

DI int g8_lds_byte(int r, int c) {
  int st = (r >> 4) * 2 + (c >> 5), rr = r & 15, cc = c & 31, ob = rr * 64 + cc * 2;
  return st * 1024 + (ob ^ (((ob >> 9) & 1) << 5));
}
DI void g8_stage_rc(int b, int& R, int& C) {
  int st = b / 1024, sb = b % 1024, swz = sb ^ (((sb >> 9) & 1) << 5);
  R = (st >> 1) * 16 + swz / 64;
  C = (st & 1) * 32 + (swz % 64) / 2;
}
typedef __attribute__((address_space(3))) unsigned* lds_u32_ptr;

template <int EPI>
DI void gemm8p_phase(const u16* __restrict__ A, const u16* __restrict__ Bt, int M, int N, int K, const EpiArgs& ea,
                     char* smem, int bid, int nb) {
  constexpr int BK = 64, HALF = 128, HT = HALF * BK;
  u16* shm = (u16*)smem;
  const int tid = opq_tid8(), lane = tid & 63, wid = __builtin_amdgcn_readfirstlane(tid >> 6);
  const int wr = wid >> 2, wc = wid & 3, fr = lane & 15, fq = lane >> 4;
#define G8_SA(b, h) (shm + ((b) * 2 + (h)) * HT)
#define G8_SB(b, h) (shm + (4 + (b) * 2 + (h)) * HT)
  int g8o0, g8o1;
  {
    int r_, c_;
    g8_stage_rc(tid * 16, r_, c_);
    g8o0 = r_ * K + c_;
    g8_stage_rc(tid * 16 + 8192, r_, c_);
    g8o1 = r_ * K + c_;
  }
#define G8_STAGE(P, BASE, br, kt)                                                                                   \
  do {                                                                                                               \
    const u16* _gp = BASE + (size_t)(br) * K + (size_t)(kt) * BK;                                                    \
    asm volatile("" : "+s"(_gp));                \
    __builtin_amdgcn_global_load_lds((const unsigned*)(_gp + (unsigned)g8o0), (lds_u32_ptr)((char*)(P) + tid * 16), 16, 0, 0);        \
    __builtin_amdgcn_global_load_lds((const unsigned*)(_gp + (unsigned)g8o1), (lds_u32_ptr)((char*)(P) + tid * 16 + 8192), 16, 0, 0); \
  } while (0)
  const int g8lane = (fr * 64 + fq * 16) ^ ((fr & 8) << 2);
  const char* g8a = smem + g8lane + wr * 8192;
  const char* g8b = smem + 4 * HT * 2 + g8lane + wc * 4096;
#define G8_LDA(dst, b, h)                                                                                            \
  _Pragma("unroll") for (int m = 0; m < 4; ++m) _Pragma("unroll") for (int k = 0; k < 2; ++k)                        \
      dst[m][k] = *reinterpret_cast<const bf16x8*>(g8a + ((b) * 2 + (h)) * (HT * 2) + m * 2048 + k * 1024)
#define G8_LDB(dst, b, h)                                                                                            \
  _Pragma("unroll") for (int n = 0; n < 2; ++n) _Pragma("unroll") for (int k = 0; k < 2; ++k)                        \
      dst[n][k] = *reinterpret_cast<const bf16x8*>(g8b + ((b) * 2 + (h)) * (HT * 2) + n * 2048 + k * 1024)
#define G8_MMA(ai, bj, At_, Bt_)                                                                                     \
  do {                                                                                                               \
    __builtin_amdgcn_s_setprio(1);                                                                                   \
    _Pragma("unroll") for (int m = 0; m < 4; ++m) _Pragma("unroll") for (int n = 0; n < 2; ++n)                      \
        _Pragma("unroll") for (int k = 0; k < 2; ++k)                                                                \
            acc[ai][bj][m][n] = mfma16(Bt_[n][k], At_[m][k], acc[ai][bj][m][n]);                                     \
    __builtin_amdgcn_s_setprio(0);                                                                                   \
  } while (0)
#define G8_WAIT_V(n) asm volatile("s_waitcnt vmcnt(" #n ")" ::: "memory")
#define G8_WAIT_L(n) asm volatile("s_waitcnt lgkmcnt(" #n ")" ::: "memory")
#define G8_BAR __builtin_amdgcn_s_barrier()
#define G8_SCHED __builtin_amdgcn_sched_barrier(0)
  const int ntn = N / 256, ntm = M / 256, nt = K / BK;
  const int xcd = bid & 7, nbx = nb >> 3, cntx = (ntm >> 3) * ntn;
  for (int sq = bid >> 3; sq < cntx; sq += nbx) {
    const int tmx = sq / ntn, tn = sq - tmx * ntn;
    const int tm = tmx * 8 + xcd;
    const int brow = tm * 256, bcol = tn * 256;
    f32x4 acc[2][2][4][2];
#pragma unroll
    for (int a_ = 0; a_ < 2; a_++)
#pragma unroll
      for (int b_ = 0; b_ < 2; b_++)
#pragma unroll
        for (int m = 0; m < 4; m++)
#pragma unroll
          for (int n = 0; n < 2; n++) acc[a_][b_][m][n] = (f32x4){0.f, 0.f, 0.f, 0.f};
    bf16x8 At[4][2], B0[2][2], B1[2][2];
    asm volatile("s_waitcnt vmcnt(0) lgkmcnt(0)" ::: "memory");
    __syncthreads();
    G8_STAGE(G8_SB(0, 0), Bt, bcol, 0); G8_STAGE(G8_SA(0, 0), A, brow, 0);
    G8_STAGE(G8_SB(0, 1), Bt, bcol + HALF, 0); G8_STAGE(G8_SA(0, 1), A, brow + HALF, 0);
    if (wr == 1) G8_BAR;
    G8_WAIT_V(4); G8_BAR;
    G8_STAGE(G8_SB(1, 0), Bt, bcol, 1); G8_STAGE(G8_SA(1, 0), A, brow, 1); G8_STAGE(G8_SB(1, 1), Bt, bcol + HALF, 1);
    G8_WAIT_V(6); G8_BAR;
    for (int t = 0; t < nt - 2; t += 2) {
      G8_LDB(B0, 0, 0); G8_SCHED; G8_LDA(At, 0, 0); G8_STAGE(G8_SA(1, 1), A, brow + HALF, t + 1);
      G8_WAIT_L(8); G8_BAR; G8_WAIT_L(0); G8_MMA(0, 0, At, B0); G8_BAR; G8_SCHED;
      G8_LDB(B1, 0, 1); G8_STAGE(G8_SB(0, 0), Bt, bcol, t + 2);
      G8_BAR; G8_WAIT_L(0); G8_MMA(0, 1, At, B1); G8_BAR;
      G8_LDA(At, 0, 1); G8_STAGE(G8_SA(0, 0), A, brow, t + 2);
      G8_BAR; G8_WAIT_L(0); G8_MMA(1, 0, At, B0); G8_BAR; G8_SCHED;
      G8_STAGE(G8_SB(0, 1), Bt, bcol + HALF, t + 2);
      G8_WAIT_V(6); G8_BAR; G8_MMA(1, 1, At, B1); G8_BAR;
      G8_LDB(B0, 1, 0); G8_SCHED; G8_LDA(At, 1, 0); G8_STAGE(G8_SA(0, 1), A, brow + HALF, t + 2);
      G8_WAIT_L(8); G8_BAR; G8_WAIT_L(0); G8_MMA(0, 0, At, B0); G8_BAR; G8_SCHED;
      G8_LDB(B1, 1, 1); G8_STAGE(G8_SB(1, 0), Bt, bcol, t + 3);
      G8_BAR; G8_WAIT_L(0); G8_MMA(0, 1, At, B1); G8_BAR;
      G8_LDA(At, 1, 1); G8_STAGE(G8_SA(1, 0), A, brow, t + 3);
      G8_BAR; G8_WAIT_L(0); G8_MMA(1, 0, At, B0); G8_BAR; G8_SCHED;
      G8_STAGE(G8_SB(1, 1), Bt, bcol + HALF, t + 3);
      G8_WAIT_V(6); G8_BAR; G8_MMA(1, 1, At, B1); G8_BAR;
    }
    {
      G8_LDB(B0, 0, 0); G8_LDA(At, 0, 0); G8_STAGE(G8_SA(1, 1), A, brow + HALF, nt - 1);
      G8_BAR; G8_WAIT_L(0); G8_MMA(0, 0, At, B0); G8_BAR;
      G8_LDB(B1, 0, 1); G8_BAR; G8_WAIT_L(0); G8_MMA(0, 1, At, B1); G8_BAR;
      G8_LDA(At, 0, 1); G8_WAIT_V(4); G8_BAR; G8_WAIT_L(0); G8_MMA(1, 0, At, B0); G8_MMA(1, 1, At, B1); G8_BAR;
    }
    {
      G8_LDB(B0, 1, 0); G8_LDA(At, 1, 0); G8_WAIT_V(2); G8_BAR; G8_WAIT_L(0); G8_MMA(0, 0, At, B0); G8_BAR;
      G8_LDB(B1, 1, 1); G8_WAIT_V(0); G8_BAR; G8_WAIT_L(0); G8_MMA(0, 1, At, B1); G8_BAR;
      G8_LDA(At, 1, 1); G8_BAR; G8_WAIT_L(0); G8_MMA(1, 0, At, B0); G8_MMA(1, 1, At, B1); G8_BAR;
    }
    if (wr == 0) G8_BAR;
    const int bidx = brow >> 13;
#pragma unroll
    for (int ai = 0; ai < 2; ai++)
#pragma unroll
      for (int m = 0; m < 4; m++) {
        const int row = brow + ai * HALF + wr * 64 + m * 16 + fr;
#pragma unroll
        for (int bj = 0; bj < 2; bj++)
#pragma unroll
          for (int n = 0; n < 2; n++) {
            const int col = bcol + bj * HALF + wc * 32 + n * 16 + fq * 4;
            float v[4];
#pragma unroll
            for (int q = 0; q < 4; q++) v[q] = acc[ai][bj][m][n][q];
            epi_store4<EPI>(ea, row, col, v, bidx);
          }
      }
  }
#undef G8_SA
#undef G8_SB
#undef G8_STAGE
#undef G8_LDA
#undef G8_LDB
#undef G8_MMA
#undef G8_WAIT_V
#undef G8_WAIT_L
#undef G8_BAR
#undef G8_SCHED
}

DI void ckvnorm_phase(const float* __restrict__ raw, const float* __restrict__ g, u16* __restrict__ outp, int bid,
                      int nb) {
  const int tid = opq_tid(), lane = tid & 63, w = __builtin_amdgcn_readfirstlane(tid >> 6);
  const f32x4 gg = *(const f32x4*)(g + lane * 4);
  for (int row = bid * 4 + w; row < T; row += nb * 4) {
    f32x4 v = *(const f32x4*)(raw + (size_t)row * 256 + lane * 4);
    float ss = v[0] * v[0] + v[1] * v[1] + v[2] * v[2] + v[3] * v[3];
    ss = wave_sum(ss);
    const float r = rsqrtf(ss * (1.f / 256.f) + LN_EPS);
    u32x2 o;
    o[0] = pk2(v[0] * r * gg[0], v[1] * r * gg[1]);
    o[1] = pk2(v[2] * r * gg[2], v[3] * r * gg[3]);
    *(u32x2*)(outp + (size_t)row * 256 + lane * 4) = o;
  }
}

DI unsigned mono_key(float s) {
  unsigned u = __float_as_uint(s);
  return (u & 0x80000000u) ? ~u : (u | 0x80000000u);
}
DI float mono_inv(unsigned k) {
  unsigned u = (k & 0x80000000u) ? (k & 0x7fffffffu) : ~k;
  return __uint_as_float(u);
}
DI float relu_i(float x) {
  int i = __float_as_int(x);
  return __int_as_float(i > 0 ? i : 0);
}
DI int wcount(bool f) { return __popcll(__ballot(f)); }

template <bool EXACT>
DI void compact4(float* vals, u16* idxs, int* cnt, int lane, float* thr_out) {
  constexpr int NPL = CAP / 64;
  unsigned key[4][NPL];
  int n[4];
#pragma unroll
  for (int q = 0; q < 4; q++) n[q] = cnt[q];
#pragma unroll
  for (int q = 0; q < 4; q++)
#pragma unroll
    for (int j = 0; j < NPL; j++) {
      const int e = j * 64 + lane;
      key[q][j] = (e < n[q]) ? mono_key(vals[q * CAP + e]) : 0u;
    }
  unsigned Tk[4] = {0u, 0u, 0u, 0u};
  constexpr int LOWBIT = EXACT ? 0 : 18;
#pragma unroll 1
  for (int bit = 31; bit >= LOWBIT; bit--) {
#pragma unroll
    for (int q = 0; q < 4; q++) {
      const unsigned cand = Tk[q] | (1u << bit);
      int c = 0;
#pragma unroll
      for (int j = 0; j < NPL; j++) c += wcount(key[q][j] >= cand);
      Tk[q] = (c >= TOPK) ? cand : Tk[q];
      if (q == 1) __builtin_amdgcn_sched_barrier(0);
    }
  }
  unsigned I[4] = {0xffffu, 0xffffu, 0xffffu, 0xffffu};
  if (EXACT) {
    bool ties = false;
#pragma unroll
    for (int q = 0; q < 4; q++) {
      int cge = 0;
#pragma unroll
      for (int j = 0; j < NPL; j++) cge += wcount(key[q][j] >= Tk[q]);
      if (n[q] > TOPK && cge != TOPK) ties = true;
      if (q == 1) __builtin_amdgcn_sched_barrier(0);
    }
    if (ties) {
    unsigned ix[4][NPL];
    int need[4];
#pragma unroll
    for (int q = 0; q < 4; q++) {
      int cgt = 0;
#pragma unroll
      for (int j = 0; j < NPL; j++) {
        const int e = j * 64 + lane;
        ix[q][j] = (e < n[q]) ? (unsigned)idxs[q * CAP + e] : 0xffffu;
        cgt += wcount(key[q][j] > Tk[q]);
      }
      need[q] = TOPK - cgt;
      I[q] = 0u;
    }
#pragma unroll 1
    for (int bit = 13; bit >= 0; bit--) {
#pragma unroll
      for (int q = 0; q < 4; q++) {
        const unsigned cand = I[q] | (1u << bit);
        int c = 0;
#pragma unroll
        for (int j = 0; j < NPL; j++) c += wcount(key[q][j] == Tk[q] && ix[q][j] < cand);
        I[q] = (c < need[q]) ? cand : I[q];
        if (q == 1) __builtin_amdgcn_sched_barrier(0);
      }
    }
    }
  }
  const unsigned long long lt = (1ull << lane) - 1ull;
#pragma unroll
  for (int q = 0; q < 4; q++) {
    if (n[q] > TOPK) {
      int base = 0;
#pragma unroll
      for (int j = 0; j < NPL; j++) {
        const int e = j * 64 + lane;
        const bool in = e < n[q];
        const float v = in ? vals[q * CAP + e] : 0.f;
        const unsigned ixv = in ? (unsigned)idxs[q * CAP + e] : 0xffffu;
        const bool keep = (key[q][j] > Tk[q]) || (key[q][j] == Tk[q] && ixv <= I[q]);
        const unsigned long long m = __ballot(keep);
        if (keep) {
          const int pos = base + __popcll(m & lt);
          vals[q * CAP + pos] = v;
          idxs[q * CAP + pos] = (u16)ixv;
        }
        base += __popcll(m);
      }
      if (lane == 0) cnt[q] = base;
      thr_out[q] = mono_inv(Tk[q]);
    }
  }
}

DI void indexer_phase(const u16* __restrict__ iq, const u16* __restrict__ ik, const float* __restrict__ iw,
                      u16* __restrict__ sel, char* smem, int bid, int nb) {
  constexpr int WBYTES = 4 * CAP * 4 + 4 * CAP * 2 + 64;
  const int tid = opq_tid(), lane = tid & 63, w = __builtin_amdgcn_readfirstlane(tid >> 6), l31 = lane & 31, u = lane >> 5;
  float* vals = (float*)(smem + w * WBYTES);
  u16* idxs = (u16*)(smem + w * WBYTES + 4 * CAP * 4);
  int* cnt = (int*)(smem + w * WBYTES + 4 * CAP * 4 + 4 * CAP * 2);
  const int nitems = NBATCH * (S / 16);
  const int nrounds = (nitems + nb - 1) / nb;
  __syncthreads();
  for (int rd = 0; rd < nrounds; rd++) {
    const int it = rd * nb + ((rd & 1) ? (nb - 1 - bid) : bid);
    if (it >= nitems) continue;
    const int b = it & 3, qg = (S / 16 - 1) - (it >> 2);
    const int t0 = qg * 16;
    const int tw = t0 + 4 * w;
    const size_t tb = (size_t)b * S;
    bf16x8 aq[4];
    {
      const int g = l31 >> 3, up = (l31 >> 2) & 1, j = l31 & 3;
      const int ql = 2 * up + (g >> 1), hd = 4 * (g & 1) + j;
      const u16* qp = iq + (tb + tw + ql) * 512 + hd * 64 + u * 8;
#pragma unroll
      for (int ks = 0; ks < 4; ks++) aq[ks] = *(const bf16x8*)(qp + ks * 16);
    }
    float wq[2][8];
#pragma unroll
    for (int qq = 0; qq < 2; qq++) {
      const float* wp = iw + (tb + tw + 2 * u + qq) * 8;
      f32x4 w0 = *(const f32x4*)wp, w1 = *(const f32x4*)(wp + 4);
#pragma unroll
      for (int h = 0; h < 4; h++) {
        wq[qq][h] = w0[h];
        wq[qq][4 + h] = w1[h];
      }
    }
    float thr[2] = {-INFINITY, -INFINITY};
    __builtin_amdgcn_wave_barrier();
    if (lane < 4) cnt[lane] = 0;
    __builtin_amdgcn_wave_barrier();
    const int nkb = (tw + 3) / 32 + 1;
    const u16* kp = ik + tb * 64 + lane * 8;
    bf16x8 ring[4][4];
#pragma unroll
    for (int i = 0; i < 4; i++) {
      const int kbn = (i < nkb) ? i : nkb - 1;
#pragma unroll
      for (int ks = 0; ks < 4; ks++) ring[i][ks] = *(const bf16x8*)(kp + (size_t)(kbn * 4 + ks) * 512);
    }
#pragma unroll 1
    for (int kb0 = 0; kb0 < nkb; kb0 += 4) {
#pragma unroll
      for (int i = 0; i < 4; i++) {
        const int kb = kb0 + i;
        {
          f32x16 acc;
#pragma unroll
          for (int r = 0; r < 16; r++) acc[r] = 0.f;
#pragma unroll
          for (int ks = 0; ks < 4; ks++) acc = mfma32(aq[ks], ring[i][ks], acc);
          {
            const int kbn = (kb + 4 < nkb) ? kb + 4 : nkb - 1;
#pragma unroll
            for (int ks = 0; ks < 4; ks++) ring[i][ks] = *(const bf16x8*)(kp + (size_t)(kbn * 4 + ks) * 512);
          }
          const int key = kb * 32 + l31;
#pragma unroll
          for (int qq = 0; qq < 2; qq++) {
            float s0 = 0.f, s1 = 0.f;
#pragma unroll
            for (int h = 0; h < 8; h += 2) {
              s0 = fmaf(wq[qq][h], relu_i(acc[8 * qq + h]), s0);
              s1 = fmaf(wq[qq][h + 1], relu_i(acc[8 * qq + h + 1]), s1);
            }
            float s = s0 + s1;
            s += 0.0f;
            const int tq = tw + 2 * u + qq;
            if (key <= tq && s >= thr[qq]) {
              const int qs = 2 * u + qq;
              const int pos = atomicAdd(&cnt[qs], 1);
              vals[qs * CAP + pos] = s;
              idxs[qs * CAP + pos] = (u16)key;
            }
          }
        }
      }
      __builtin_amdgcn_wave_barrier();
      const int c0 = cnt[0], c1 = cnt[1], c2 = cnt[2], c3 = cnt[3];
      if (c0 > CAP - 128 || c1 > CAP - 128 || c2 > CAP - 128 || c3 > CAP - 128) {
        float to[4] = {0.f, 0.f, 0.f, 0.f};
        compact4<false>(vals, idxs, cnt, lane, to);
        __builtin_amdgcn_wave_barrier();
        const int d0 = cnt[0], d1 = cnt[1], d2 = cnt[2], d3 = cnt[3];
        if (d0 > CAP - 256 || d1 > CAP - 256 || d2 > CAP - 256 || d3 > CAP - 256) {
          compact4<true>(vals, idxs, cnt, lane, to);
          __builtin_amdgcn_wave_barrier();
        }
        if (c0 > TOPK && u == 0) thr[0] = to[0];
        if (c1 > TOPK && u == 0) thr[1] = to[1];
        if (c2 > TOPK && u == 1) thr[0] = to[2];
        if (c3 > TOPK && u == 1) thr[1] = to[3];
      }
    }
    {
      const int c0 = cnt[0], c1 = cnt[1], c2 = cnt[2], c3 = cnt[3];
      if (c0 > TOPK || c1 > TOPK || c2 > TOPK || c3 > TOPK) {
        float to[4];
        compact4<true>(vals, idxs, cnt, lane, to);
        __builtin_amdgcn_wave_barrier();
      }
    }
#pragma unroll 1
    for (int qs = 0; qs < 4; qs++) {
      const int n = cnt[qs];
      u16* sp = sel + (tb + tw + qs) * 256;
#pragma unroll
      for (int j = 0; j < 4; j++) {
        const int e = j * 64 + lane;
        sp[e] = (e < n) ? idxs[qs * CAP + e] : (u16)0xffffu;
      }
    }
  }
}

DI void sparse_phase(const u16* __restrict__ q, const u16* __restrict__ ckvn, const u16* __restrict__ sel,
                     const u16* __restrict__ wuk, const u16* __restrict__ wuv, const float* __restrict__ rel_bias,
                     u16* scratch, u16* __restrict__ o, char* smem, int bid, int nb) {
  constexpr int GS = 264;
  const int tid = opq_tid(), lane = tid & 63, w = __builtin_amdgcn_readfirstlane(tid >> 6), l15 = lane & 15, g = lane >> 4;
  u16* G = (u16*)smem + (size_t)w * 32 * GS;
  int* lut = (int*)(smem + 4 * 32 * GS * 2);
  float* rb = (float*)(lut + 128);
  __syncthreads();
  if (tid < 128) lut[tid] = rel_bucket(tid);
  for (int i = tid; i < 512; i += 256) rb[i] = rel_bias[i] * LOG2E;
  __syncthreads();
  u16* ql = scratch + (size_t)bid * (16 * 16 * 256);
  const int nitems = NBATCH * (S / 16);
  for (int it = bid; it < nitems; it += nb) {
    const int b = it & 3, qg = it >> 2;
    const int t0 = qg * 16;
    const size_t tb = (size_t)b * S;
    for (int hh = 0; hh < 4; hh++) {
      const int h = 4 * w + hh;
      bf16x8 bq[2];
#pragma unroll
      for (int ks = 0; ks < 2; ks++) bq[ks] = *(const bf16x8*)(q + (tb + t0 + l15) * 1024 + h * 64 + ks * 32 + g * 8);
#pragma unroll 4
      for (int rt = 0; rt < 16; rt++) {
        f32x4 acc = {0.f, 0.f, 0.f, 0.f};
#pragma unroll
        for (int ks = 0; ks < 2; ks++) {
          bf16x8 a = *(const bf16x8*)(wuk + ((size_t)h * 256 + rt * 16 + l15) * 64 + ks * 32 + g * 8);
          acc = mfma16(a, bq[ks], acc);
        }
        u32x2 ov;
        ov[0] = pk2(acc[0] * (0.125f * LOG2E), acc[1] * (0.125f * LOG2E));
        ov[1] = pk2(acc[2] * (0.125f * LOG2E), acc[3] * (0.125f * LOG2E));
        *(u32x2*)(ql + ((size_t)l15 * 16 + h) * 256 + rt * 16 + 4 * g) = ov;
      }
    }
    __syncthreads();
    {
      const u16* selw = sel + (tb + t0 + 4 * w) * 256;
      const int l31 = lane & 31;
      const int q4 = l15 >> 2, p4 = l15 & 3;
      const u16* ckb = ckvn + tb * 256;
      int idx_c = selw[l31];
      int idx_n = selw[32 + l31];
      u32x4 gr[16];
#pragma unroll
      for (int i = 0; i < 16; i++) {
        int id = __shfl(idx_c, (lane >> 5) + 2 * i);
        id = (id == 0xffff) ? 0 : id;
        gr[i] = *(const u32x4*)(ckb + (unsigned)(id * 256 + l31 * 8));
      }
      bf16x8 qb[8];
      float m_run = NEGF, l_run = 0.f;
      f32x4 O[16];
#pragma unroll 1
      for (int st = 0; st < 32; st++) {
        const int qi = st >> 3, ch = st & 7;
        const int qloc = 4 * w + qi;
        const int t = t0 + qloc;
        if (ch == 0) {
#pragma unroll
          for (int ks = 0; ks < 8; ks++) qb[ks] = *(const bf16x8*)(ql + ((size_t)qloc * 16 + l15) * 256 + ks * 32 + g * 8);
          m_run = NEGF;
          l_run = 0.f;
#pragma unroll
          for (int rt = 0; rt < 16; rt++) O[rt] = (f32x4){0.f, 0.f, 0.f, 0.f};
        }
#pragma unroll
        for (int i = 0; i < 16; i++) *(u32x4*)&G[((lane >> 5) + 2 * i) * GS + l31 * 8] = gr[i];
        __builtin_amdgcn_wave_barrier();
        const int stn2 = (st + 2 < 32) ? st + 2 : 31;
        const int idx_nn = selw[stn2 * 32 + l31];
#pragma unroll
        for (int i = 0; i < 16; i++) {
          int id = __shfl(idx_n, (lane >> 5) + 2 * i);
          id = (id == 0xffff) ? 0 : id;
          gr[i] = *(const u32x4*)(ckb + (unsigned)(id * 256 + l31 * 8));
        }
        float lg[2][4];
#pragma unroll
        for (int kbk = 0; kbk < 2; kbk++) {
          f32x4 acc = {0.f, 0.f, 0.f, 0.f};
#pragma unroll
          for (int ks = 0; ks < 8; ks++) {
            bf16x8 a = *(const bf16x8*)&G[(16 * kbk + l15) * GS + ks * 32 + g * 8];
            acc = mfma16(a, qb[ks], acc);
            if (ks == 3) asm volatile("" ::: "memory");
          }
          asm volatile("" ::: "memory");
#pragma unroll
          for (int i = 0; i < 4; i++) {
            const int kid = __shfl(idx_c, 16 * kbk + 4 * g + i);
            float v = NEGF;
            if (kid != 0xffff) {
              int n = t - kid;
              n = n < 0 ? 0 : n;
              const int bk = n < 128 ? lut[n] : 31;
              v = acc[i] + rb[bk * 16 + l15];
            }
            lg[kbk][i] = v;
          }
        }
        float mx = fmaxf(fmaxf(fmaxf(lg[0][0], lg[0][1]), fmaxf(lg[0][2], lg[0][3])),
                         fmaxf(fmaxf(lg[1][0], lg[1][1]), fmaxf(lg[1][2], lg[1][3])));
        mx = xrow16_max(mx);
        const float m_new = fmaxf(m_run, mx);
        const float scl = __builtin_amdgcn_exp2f(m_run - m_new);
        m_run = m_new;
        float ps = 0.f;
        float pe[8];
#pragma unroll
        for (int kbk = 0; kbk < 2; kbk++)
#pragma unroll
          for (int i = 0; i < 4; i++) {
            const float pv = __builtin_amdgcn_exp2f(lg[kbk][i] - m_new);
            pe[kbk * 4 + i] = pv;
            ps += pv;
          }
        l_run = l_run * scl + ps;
        u32x4 pw;
        pw[0] = pk2(pe[0], pe[1]);
        pw[1] = pk2(pe[2], pe[3]);
        pw[2] = pk2(pe[4], pe[5]);
        pw[3] = pk2(pe[6], pe[7]);
        const bf16x8 pB = __builtin_bit_cast(bf16x8, pw);
        if (__ballot(scl != 1.f)) {
#pragma unroll
          for (int rt = 0; rt < 16; rt++) O[rt] = O[rt] * scl;
        }
#pragma unroll
        for (int rt = 0; rt < 16; rt++) {
          const s16x4 lo = __builtin_amdgcn_ds_read_tr16_b64_v4i16((lds_s16x4_ptr)(&G[(4 * g + q4) * GS + rt * 16 + 4 * p4]));
          const s16x4 hi = __builtin_amdgcn_ds_read_tr16_b64_v4i16((lds_s16x4_ptr)(&G[(16 + 4 * g + q4) * GS + rt * 16 + 4 * p4]));
          const bf16x8 a = (bf16x8){lo[0], lo[1], lo[2], lo[3], hi[0], hi[1], hi[2], hi[3]};
          O[rt] = mfma16(a, pB, O[rt]);
          if ((rt & 3) == 3) asm volatile("" ::: "memory");
        }
        __builtin_amdgcn_wave_barrier();
        if (ch == 7) {
          float lt = l_run;
          lt = xrow16_sum(lt);
          const float inv = 1.f / lt;
#pragma unroll
          for (int rt = 0; rt < 16; rt++) {
            u32x2 ov;
            ov[0] = pk2(O[rt][0] * inv, O[rt][1] * inv);
            ov[1] = pk2(O[rt][2] * inv, O[rt][3] * inv);
            *(u32x2*)(ql + ((size_t)qloc * 16 + l15) * 256 + rt * 16 + 4 * g) = ov;
          }
        }
        idx_c = idx_n;
        idx_n = idx_nn;
      }
    }
    __syncthreads();
    for (int hh = 0; hh < 4; hh++) {
      const int h = 4 * w + hh;
      bf16x8 bo[8];
#pragma unroll
      for (int ks = 0; ks < 8; ks++) bo[ks] = *(const bf16x8*)(ql + ((size_t)l15 * 16 + h) * 256 + ks * 32 + g * 8);
#pragma unroll
      for (int et = 0; et < 4; et++) {
        f32x4 acc = {0.f, 0.f, 0.f, 0.f};
#pragma unroll
        for (int ks = 0; ks < 8; ks++) {
          bf16x8 a = *(const bf16x8*)(wuv + ((size_t)h * 64 + et * 16 + l15) * 256 + ks * 32 + g * 8);
          acc = mfma16(a, bo[ks], acc);
        }
        u32x2 ov;
        ov[0] = pk2(acc[0], acc[1]);
        ov[1] = pk2(acc[2], acc[3]);
        *(u32x2*)(o + (tb + t0 + l15) * 1024 + h * 64 + et * 16 + 4 * g) = ov;
      }
    }
    __syncthreads();
  }
}

DI void diffattn_phase(const u16* __restrict__ q, const u16* __restrict__ k, const u16* __restrict__ vT,
                       u16* __restrict__ o, const float* __restrict__ rel_bias, const float* __restrict__ lam,
                       const float* __restrict__ subln, int layer_idx, char* smem, int bid, int nb) {
  constexpr int KS = 136, VS = 72;
  u16* Ks = (u16*)smem;
  u16* Vs = Ks + 64 * KS;
  float* exch = (float*)smem;
  constexpr int STG = 64 * KS + 128 * VS;
  float* btab = (float*)(smem + 72 * 1024);
  int* lut = (int*)(smem + 72 * 1024 + 1040);
  float* misc = (float*)(smem + 72 * 1024 + 1040 + 512);
  const int tid = opq_tid8(), lane = tid & 63, w = __builtin_amdgcn_readfirstlane(tid >> 6), l31 = lane & 31, lh = lane >> 5;
  const int qsub = w >> 1, m = w & 1;
  const float lam_init = 0.8f - 0.6f * expf(-0.3f * (float)layer_idx);
  __syncthreads();
  if (tid < 128) lut[tid] = rel_bucket(tid);
  if (w == 0) {
    float p1 = lam[lane] * lam[64 + lane], p2 = lam[128 + lane] * lam[192 + lane];
    p1 = wave_sum(p1);
    p2 = wave_sum(p2);
    if (lane == 0) misc[0] = expf(p1) - expf(p2) + lam_init;
  }
  __syncthreads();
  const float lam_full = misc[0];
  const int xcd = bid & 7, loc = bid >> 3, nbx = nb >> 3;
  const int rph = (S / 128) / nbx;
  const int prow = pi_row(l31);
  for (int rd = 0; rd < 4 * rph; rd++) {
    const int hh = rd / rph, r = rd - hh * rph;
    const int bh = xcd + 8 * hh;
    const int kk = r >> 1;
    const int qb = (r & 1) ? (kk * nbx + loc) : ((S / 128 - 1) - kk * nbx - loc);
    const int b = bh >> 3, h = bh & 7;
    const int q0 = qb * 128, tq0 = q0 + 32 * qsub, t = tq0 + l31;
    const size_t tb = (size_t)b * S;
    __syncthreads();
    for (int i = tid; i < 258; i += 512) {
      const int n = i >> 1, mm = i & 1;
      const int bk = n < 128 ? lut[n] : 31;
      btab[i] = rel_bias[bk * 16 + 2 * h + mm] * LOG2E;
    }
    bf16x8 qf[4];
#pragma unroll
    for (int ks = 0; ks < 4; ks++) qf[ks] = *(const bf16x8*)(q + (tb + t) * 1024 + h * 128 + m * 64 + ks * 16 + lh * 8);
    f32x16 O[4];
#pragma unroll
    for (int et = 0; et < 4; et++)
#pragma unroll
      for (int r = 0; r < 16; r++) O[et][r] = 0.f;
    float m_run = NEGF, l_run = 0.f;
    const int nkt = 2 * qb + 2;
    u32x4 rk[2], rv[2];
    const u16* kp = k + tb * 1024 + h * 128;
    const u16* vp = vT + ((size_t)(b * 8 + h) * 128) * 8192;
#pragma unroll
    for (int i = 0; i < 2; i++) {
      const int id = tid + 512 * i;
      rk[i] = *(const u32x4*)(kp + (size_t)(id >> 4) * 1024 + (id & 15) * 8);
      rv[i] = *(const u32x4*)(vp + (size_t)(id >> 3) * 8192 + (id & 7) * 8);
    }
#pragma unroll
    for (int i = 0; i < 2; i++) {
      const int id = tid + 512 * i;
      *(u32x4*)&Ks[(id >> 4) * KS + (id & 15) * 8] = rk[i];
      *(u32x4*)&Vs[(id >> 3) * VS + (id & 7) * 8] = rv[i];
    }
#pragma unroll
    for (int i = 0; i < 2; i++) {
      const int id = tid + 512 * i;
      rk[i] = *(const u32x4*)(kp + (size_t)(64 + (id >> 4)) * 1024 + (id & 15) * 8);
      rv[i] = *(const u32x4*)(vp + (size_t)(id >> 3) * 8192 + 64 + (id & 7) * 8);
    }
    __syncthreads();
    const float cfar = btab[256 + m];
    for (int kt = 0; kt < nkt; kt++) {
      const u16* Ksc = Ks + (kt & 1) * STG;
      const u16* Vsc = Vs + (kt & 1) * STG;
      if (kt + 1 < nkt) {
        u16* Ksn = Ks + ((kt & 1) ^ 1) * STG;
        u16* Vsn = Vs + ((kt & 1) ^ 1) * STG;
#pragma unroll
        for (int i = 0; i < 2; i++) {
          const int id = tid + 512 * i;
          *(u32x4*)&Ksn[(id >> 4) * KS + (id & 15) * 8] = rk[i];
          *(u32x4*)&Vsn[(id >> 3) * VS + (id & 7) * 8] = rv[i];
        }
        const int k2 = (kt + 2 < nkt) ? kt + 2 : nkt - 1;
#pragma unroll
        for (int i = 0; i < 2; i++) {
          const int id = tid + 512 * i;
          rk[i] = *(const u32x4*)(kp + (size_t)(k2 * 64 + (id >> 4)) * 1024 + (id & 15) * 8);
          rv[i] = *(const u32x4*)(vp + (size_t)(id >> 3) * 8192 + k2 * 64 + (id & 7) * 8);
        }
      }
      const int s_tile = kt * 64;
      const int remk = tq0 + 31 - s_tile;
      const int nblk = remk < 0 ? 0 : (remk >= 32 ? 2 : 1);
#pragma unroll
      for (int kb = 0; kb < 2; kb++) {
        if (kb >= nblk) break;
        const int s0 = s_tile + 32 * kb;
        const bool nearb = (tq0 - (s0 + 31)) < 128;
        const bool first = (kt == 0) && (kb == 0);
        const float mref = first ? 0.f : m_run;
        const float cinit = nearb ? -mref : (cfar - mref);
        f32x16 acc;
#pragma unroll
        for (int r = 0; r < 16; r++) acc[r] = cinit;
#pragma unroll
        for (int ks = 0; ks < 4; ks++) {
          bf16x8 a = *(const bf16x8*)&Ksc[(32 * kb + prow) * KS + m * 64 + ks * 16 + lh * 8];
          acc = mfma32(a, qf[ks], acc);
        }
        bf16x8 vfa[4];
#pragma unroll
        for (int et = 0; et < 4; et++) vfa[et] = *(const bf16x8*)&Vsc[(32 * et + l31) * VS + 32 * kb + 8 * lh];
        __builtin_amdgcn_sched_barrier(0);
        if (nearb) {
#pragma unroll
          for (int r = 0; r < 16; r++) {
            const int key = s0 + 16 * (r >> 3) + 8 * lh + (r & 7);
            const int n = t - key;
            const int nc = n < 0 ? 0 : (n > 128 ? 128 : n);
            const float bv = btab[nc * 2 + m];
            acc[r] = (n < 0) ? NEGF : acc[r] + bv;
          }
        }
        float mx = acc[0];
#pragma unroll
        for (int r = 1; r < 16; r++) mx = fmaxf(mx, acc[r]);
        mx = xhalf_max(mx);
        if (first || __ballot(mx > 8.f)) {
          const float dlt = first ? mx : fmaxf(mx, 0.f);
          const float scl = __builtin_amdgcn_exp2f(-dlt);
#pragma unroll
          for (int r = 0; r < 16; r++) acc[r] -= dlt;
#pragma unroll
          for (int et = 0; et < 4; et++)
#pragma unroll
            for (int r = 0; r < 16; r++) O[et][r] *= scl;
          l_run *= scl;
          m_run = mref + dlt;
        }
        float ps = 0.f;
#pragma unroll
        for (int r = 0; r < 16; r++) {
          const float pv = __builtin_amdgcn_exp2f(acc[r]);
          acc[r] = pv;
          ps += pv;
        }
        l_run += ps;
        bf16x8 vfb[4];
#pragma unroll
        for (int et = 0; et < 4; et++) vfb[et] = *(const bf16x8*)&Vsc[(32 * et + l31) * VS + 32 * kb + 16 + 8 * lh];
        u32x4 pw0, pw1;
        pw0[0] = pk2(acc[0], acc[1]);
        pw0[1] = pk2(acc[2], acc[3]);
        pw0[2] = pk2(acc[4], acc[5]);
        pw0[3] = pk2(acc[6], acc[7]);
        pw1[0] = pk2(acc[8], acc[9]);
        pw1[1] = pk2(acc[10], acc[11]);
        pw1[2] = pk2(acc[12], acc[13]);
        pw1[3] = pk2(acc[14], acc[15]);
        const bf16x8 pB0 = __builtin_bit_cast(bf16x8, pw0), pB1 = __builtin_bit_cast(bf16x8, pw1);
        __builtin_amdgcn_sched_barrier(0);
#pragma unroll
        for (int et = 0; et < 4; et++) O[et] = mfma32(vfa[et], pB0, O[et]);
#pragma unroll
        for (int et = 0; et < 4; et++) O[et] = mfma32(vfb[et], pB1, O[et]);
      }
      __syncthreads();
    }
    float lt = xhalf_sum(l_run);
    const float inv = 1.f / lt;
    if (m == 1) {
#pragma unroll
      for (int et = 0; et < 4; et++)
#pragma unroll
        for (int r = 0; r < 16; r++) {
          const int e = 32 * et + (r & 3) + 8 * (r >> 2) + 4 * lh;
          exch[(qsub * 128 + e) * 32 + l31] = O[et][r] * inv;
        }
    }
    __syncthreads();
    if (m == 0) {
      float ss = 0.f;
#pragma unroll
      for (int et = 0; et < 4; et++)
#pragma unroll
        for (int r = 0; r < 16; r++) {
          const int e = 32 * et + (r & 3) + 8 * (r >> 2) + 4 * lh;
          const float v = O[et][r] * inv - lam_full * exch[(qsub * 128 + e) * 32 + l31];
          O[et][r] = v;
          ss += v * v;
        }
      ss = xhalf_sum(ss);
      const float rs = rsqrtf(ss * (1.f / 128.f) + LN_EPS);
      const float osc = 1.f - lam_init;
#pragma unroll
      for (int et = 0; et < 4; et++)
#pragma unroll
        for (int r4 = 0; r4 < 4; r4++) {
          const int e = 32 * et + 8 * r4 + 4 * lh;
          const f32x4 gv = *(const f32x4*)(subln + e);
          u32x2 ov;
          ov[0] = pk2(O[et][4 * r4 + 0] * rs * gv[0] * osc, O[et][4 * r4 + 1] * rs * gv[1] * osc);
          ov[1] = pk2(O[et][4 * r4 + 2] * rs * gv[2] * osc, O[et][4 * r4 + 3] * rs * gv[3] * osc);
          *(u32x2*)(o + (tb + t) * 1024 + h * 128 + e) = ov;
        }
    }
  }
}

#define XB_TMO      128
#define XB_XCNT(j)  (256  + 64 * (j))
#define XB_XSUB(j)  (1280 + 64 * (j))
#define XB_XGEN(j)  (2304 + 64 * (j))
#define XB_TOP      3328
#define XB_TOPGEN   3392
#define XCD_BAR_WORDS 3456
#define XB_SPIN_CAP (1u << 20)
#define LAS __attribute__((address_space(3)))
DI unsigned xb_ld(unsigned* p) { return __hip_atomic_load(p, __ATOMIC_RELAXED, __HIP_MEMORY_SCOPE_AGENT); }
DI unsigned xb_add(unsigned* p, unsigned v) { return __hip_atomic_fetch_add(p, v, __ATOMIC_RELAXED, __HIP_MEMORY_SCOPE_AGENT); }
DI unsigned xb_xcc_id() { return (unsigned)__builtin_amdgcn_s_getreg((3 << 11) | 20) & 0xFu; }
#define XB_SPIN(cond, bar) do { unsigned _sp = 0; while (cond) { __builtin_amdgcn_s_sleep(1); \
    if ((++_sp & 255u) == 0u) { if (xb_ld(&(bar)[XB_TMO])) break; if (_sp > XB_SPIN_CAP) { atomicAdd(&(bar)[XB_TMO], 1u); break; } } } } while (0)
struct XcdBarrier {
  unsigned* bar;
  unsigned x;
  volatile LAS unsigned* st;
};
DI XcdBarrier xcd_barrier_post(unsigned* bar, volatile LAS unsigned* st) {
  XcdBarrier b;
  b.bar = bar;
  b.x = xb_xcc_id();
  b.st = st;
  if (threadIdx.x == 0) (void)xb_add(&bar[XB_XCNT(b.x)], 1u);
  return b;
}
DI void xcd_barrier_complete(unsigned* bar, unsigned x, unsigned& nloc, unsigned& nx) {
  const unsigned G = gridDim.x * gridDim.y * gridDim.z;
  unsigned sum, cnt, mine, sp = 0u;
  for (;;) {
    sum = 0u; cnt = 0u; mine = 0u;
#pragma unroll
    for (unsigned j = 0; j < 16; ++j) {
      const unsigned c = xb_ld(&bar[XB_XCNT(j)]);
      sum += c;
      cnt += (c > 0u) ? 1u : 0u;
      mine = (j == x) ? c : mine;
    }
    if (sum == G) break;
    __builtin_amdgcn_s_sleep(1);
    if ((++sp & 255u) == 0u) { if (xb_ld(&bar[XB_TMO])) break; if (sp > XB_SPIN_CAP) { atomicAdd(&bar[XB_TMO], 1u); break; } }
  }
  nloc = mine > 0u ? mine : 1u;
  nx = cnt > 0u ? cnt : 1u;
}
DI void xcd_barrier(const XcdBarrier& b0) {
  asm volatile("s_waitcnt vmcnt(0)" ::: "memory");
  __syncthreads();
  if (threadIdx.x == 0) {
    XcdBarrier b = b0;
    b.x = __builtin_amdgcn_readfirstlane(xb_xcc_id());
    unsigned* bar = b.bar;
    asm volatile("" : "+s"(bar));
    __builtin_amdgcn_s_waitcnt(0);
    unsigned nloc = b.st[0], nx = b.st[1];
    if (nloc == 0u) { xcd_barrier_complete(bar, b.x, nloc, nx); b.st[0] = nloc; b.st[1] = nx; }
    const unsigned old = xb_add(&bar[XB_XSUB(b.x)], 1u);
    const unsigned gen = old / nloc;
    if (old + 1u == (gen + 1u) * nloc) {
      __builtin_amdgcn_fence(__ATOMIC_RELEASE, "agent");
      asm volatile("s_waitcnt vmcnt(0)" ::: "memory");
      const unsigned og = xb_add(&bar[XB_TOP], 1u);
      const unsigned tg = og / nx;
      if (og + 1u == (tg + 1u) * nx) xb_add(&bar[XB_TOPGEN], 1u);
      else XB_SPIN(xb_ld(&bar[XB_TOPGEN]) == tg, bar);
      __builtin_amdgcn_fence(__ATOMIC_ACQUIRE, "agent");
      xb_add(&bar[XB_XGEN(b.x)], 1u);
      asm volatile("s_waitcnt vmcnt(0)" ::: "memory");
    } else {
      XB_SPIN(xb_ld(&bar[XB_XGEN(b.x)]) == gen, bar);
      __builtin_amdgcn_fence(__ATOMIC_ACQUIRE, "agent");
      asm volatile("s_waitcnt vmcnt(0)" ::: "memory");
    }
  }
  __syncthreads();
}

#define DECL_WS_PTRS(ws) \
  u16* w_ain = (u16*)(ws + W_AIN); \
  u16* w_uk = (u16*)(ws + W_UK); \
  u16* w_uv = (u16*)(ws + W_UV); \
  u16* w_ao = (u16*)(ws + W_AO); \
  u16* w_bin = (u16*)(ws + W_BIN); \
  u16* w_bo = (u16*)(ws + W_BO); \
  u16* w_w1 = (u16*)(ws + W_W1); \
  u16* w_w2 = (u16*)(ws + W_W2); \
  float* mod = (float*)(ws + WS_MOD); \
  u16* hbuf = (u16*)(ws + WS_H); \
  char* big = ws + WS_BIG; \
  u16* qbuf = (u16*)(big + B_Q); \
  u16* iqbuf = (u16*)(big + B_IQ); \
  u16* ikbuf = (u16*)(big + B_IK); \
  float* iwbuf = (float*)(big + B_IW); \
  float* ckvraw = (float*)(big + B_CKVRAW); \
  u16* ckvn = (u16*)(big + B_CKVN); \
  u16* selbuf = (u16*)(big + B_SEL); \
  u16* kbuf = (u16*)(big + B_K); \
  u16* vtbuf = (u16*)(big + B_VT); \
  u16* obuf = (u16*)(big + B_O); \
  u16* hid = (u16*)big;

__global__ void __launch_bounds__(512, 2) hybrid_fwd(Params p) {
  __shared__ __attribute__((aligned(16))) char smem[2 * LDS_BYTES];
  cg::grid_group grid = cg::this_grid();
  const int bid = blockIdx.x, nb = gridDim.x;
  const int half = __builtin_amdgcn_readfirstlane((int)(threadIdx.x >> 8));
  const int vb = half * nb + bid, nvb = 2 * nb;
  char* smh = smem + half * LDS_BYTES;
  char* ws = p.ws;
  unsigned* bar = (unsigned*)(ws + WS_BAR);
  volatile LAS unsigned* xst = (volatile LAS unsigned*)(smem + 2 * LDS_BYTES - 16);
  if (threadIdx.x < 2) xst[threadIdx.x] = 0u;
  __syncthreads();
  const XcdBarrier xb = xcd_barrier_post(bar, xst);

  {
  DECL_WS_PTRS(ws)
  (void)qbuf; (void)iqbuf; (void)ikbuf; (void)iwbuf; (void)ckvraw; (void)ckvn; (void)selbuf; (void)kbuf; (void)vtbuf; (void)obuf; (void)hid;
  tconv_phase(p.a_w_in, w_ain, 2, 1024, 1864, A_INP, smh, vb, nvb);
  tconv_phase(p.a_w_uk, w_uk, 32, 64, 256, 256, smh, vb, nvb);
  tconv_phase(p.a_w_uv, w_uv, 32, 256, 64, 64, smh, vb, nvb);
  tconv_phase(p.a_w_o, w_ao, 2, 1024, 1024, 1024, smh, vb, nvb);
  tconv_phase(p.b_w_in, w_bin, 2, 1024, 3072, 3072, smh, vb, nvb);
  tconv_phase(p.b_w_o, w_bo, 2, 1024, 1024, 1024, smh, vb, nvb);
  tconv_phase(p.mlp_w1, w_w1, 4, 1024, 4096, 4096, smh, vb, nvb);
  tconv_phase(p.mlp_w2, w_w2, 4, 4096, 1024, 1024, smh, vb, nvb);
  mod_phase(p, mod, smh, vb, nvb);
  grid.sync();
  h0_phase(p.x, mod, hbuf, vb, nvb);
  xcd_barrier(xb);
  }

#pragma unroll 1
  for (int sl = 0; sl < 8; sl++) {
    char* wsl = p.ws;
    asm volatile("" : "+s"(wsl));
    DECL_WS_PTRS(wsl)
    const int i = sl >> 1, j = i >> 1;
    const float* modi = mod + (size_t)i * 4 * 6144;
    const u16* Ares;
    const u16* Wres;
    int Kres, goff;
    if ((sl & 1) == 0) {
      if ((i & 1) == 0) {
        EpiArgs ea{};
        ea.o0 = qbuf; ea.f0 = ckvraw; ea.o1 = iqbuf; ea.o2 = ikbuf; ea.f1 = iwbuf;
        for (int rep = 0; rep < (PROBE_DUP == 4 ? 2 : 1); rep++) gemm8p_phase<EPI_AIN>(hbuf, w_ain + (size_t)j * A_INP * 1024, T, A_INP, 1024, ea, smem, bid, nb);
        xcd_barrier(xb);
        ckvnorm_phase(ckvraw, p.a_kv_norm + j * 256, ckvn, vb, nvb);
        for (int rep = 0; rep < (PROBE_DUP == 2 ? 2 : 1); rep++) indexer_phase(iqbuf, ikbuf, iwbuf, selbuf, smh, vb, nvb);
        xcd_barrier(xb);
        for (int rep = 0; rep < (PROBE_DUP == 3 ? 2 : 1); rep++) sparse_phase(qbuf, ckvn, selbuf, w_uk + (size_t)j * 16 * 256 * 64, w_uv + (size_t)j * 16 * 256 * 64, p.rel_bias,
                     hbuf, obuf, smh, vb, nvb);
        xcd_barrier(xb);
        Wres = w_ao + (size_t)j * 1024 * 1024;
      } else {
        EpiArgs ea{};
        ea.o0 = qbuf; ea.o1 = kbuf; ea.o2 = vtbuf;
        for (int rep = 0; rep < (PROBE_DUP == 4 ? 2 : 1); rep++) gemm8p_phase<EPI_BIN>(hbuf, w_bin + (size_t)j * 3072 * 1024, T, 3072, 1024, ea, smem, bid, nb);
        xcd_barrier(xb);
        for (int rep = 0; rep < (PROBE_DUP == 1 ? 2 : 1); rep++) diffattn_phase(qbuf, kbuf, vtbuf, obuf, p.rel_bias, p.b_lambda + j * 256, p.b_subln + j * 128, i, smem, bid, nb);
        xcd_barrier(xb);
        Wres = w_bo + (size_t)j * 1024 * 1024;
      }
      Ares = obuf; Kres = 1024; goff = 2 * 1024;
    } else {
      EpiArgs ea{};
      ea.o0 = hid;
      for (int rep = 0; rep < (PROBE_DUP == 4 ? 2 : 1); rep++) gemm8p_phase<EPI_SQRELU>(hbuf, w_w1 + (size_t)i * 4096 * 1024, T, 4096, 1024, ea, smem, bid, nb);
      xcd_barrier(xb);
      Ares = hid; Wres = w_w2 + (size_t)i * 4096 * 1024; Kres = 4096; goff = 5 * 1024;
    }
    {
      EpiArgs ea{};
      ea.f0 = p.out;
      ea.xin = (sl == 0) ? p.x : (const float*)p.out;
      ea.g = modi + goff;
      gemm8p_phase<EPI_RES>(Ares, Wres, T, 1024, Kres, ea, smem, bid, nb);
    }
    xcd_barrier(xb);
    {
      const float* modn = ((sl & 1) == 0) ? modi : (i < 3 ? modi + 4 * 6144 : (const float*)nullptr);
      const int sh_off = ((sl & 1) == 0) ? 3 * 1024 : 0;
      ln_phase(p.out, p.ln_g + (size_t)(i * 2 + (sl & 1)) * 1024, p.ln_b + (size_t)(i * 2 + (sl & 1)) * 1024, modn, sh_off,
               hbuf, vb, nvb);
    }
    xcd_barrier(xb);
  }
}

extern "C" void kernel_launch(void* const* d_in, const int* in_sizes, int n_in, void* d_out, int out_size, void* d_ws,
                              size_t ws_size, hipStream_t stream) {
  static int grid_blocks = 0;
  if (!grid_blocks) {
    int dev = 0, cus = 0, per_cu = 0;
    hipGetDevice(&dev);
    hipDeviceGetAttribute(&cus, hipDeviceAttributeMultiprocessorCount, dev);
    hipOccupancyMaxActiveBlocksPerMultiprocessor(&per_cu, hybrid_fwd, 512, 0);
    (void)per_cu;
    grid_blocks = cus;
    if (grid_blocks > 256) grid_blocks = 256;
  }
  Params p{};
  p.x = (const float*)d_in[0];
  p.c = (const float*)d_in[1];
  p.rel_bias = (const float*)d_in[2];
  p.ada_w = (const float*)d_in[3];
  p.ada_b = (const float*)d_in[4];
  p.ln_g = (const float*)d_in[5];
  p.ln_b = (const float*)d_in[6];
  p.a_w_in = (const float*)d_in[7];
  p.a_kv_norm = (const float*)d_in[8];
  p.a_w_uk = (const float*)d_in[9];
  p.a_w_uv = (const float*)d_in[10];
  p.a_w_o = (const float*)d_in[11];
  p.b_w_in = (const float*)d_in[12];
  p.b_lambda = (const float*)d_in[13];
  p.b_subln = (const float*)d_in[14];
  p.b_w_o = (const float*)d_in[15];
  p.mlp_w1 = (const float*)d_in[16];
  p.mlp_w2 = (const float*)d_in[17];
  p.out = (float*)d_out;
  p.ws = (char*)d_ws;
  hipMemsetAsync((char*)d_ws + WS_BAR, 0, XCD_BAR_WORDS * 4, stream);
  void* args[] = {&p};
  hipError_t e = hipLaunchCooperativeKernel((void*)hybrid_fwd, dim3(grid_blocks), dim3(512), args, 0, stream);
  if (e != hipSuccess) fprintf(stderr, "cooperative launch failed: %s (grid %d)\n", hipGetErrorString(e), grid_blocks);
}
```

```cpp
#include <hip/hip_runtime.h>
#include <hip/hip_cooperative_groups.h>
#include <stdint.h>
#include <stdio.h>
namespace cg = cooperative_groups;

typedef unsigned short u16;
typedef short bf16x8 __attribute__((ext_vector_type(8)));
typedef short s16x4 __attribute__((ext_vector_type(4)));
typedef float f32x16 __attribute__((ext_vector_type(16)));
typedef float f32x4 __attribute__((ext_vector_type(4)));
typedef float f32x2 __attribute__((ext_vector_type(2)));
typedef __bf16 bf16x2_t __attribute__((ext_vector_type(2)));
typedef unsigned u32x4 __attribute__((ext_vector_type(4)));
typedef unsigned u32x2 __attribute__((ext_vector_type(2)));
typedef __attribute__((address_space(3))) s16x4* lds_s16x4_ptr;

#define DI __device__ __forceinline__
#ifndef PROBE_DUP
#define PROBE_DUP 0
#endif

constexpr int D = 1024, NBATCH = 4, S = 8192, T = NBATCH * S;
constexpr int A_INP = 2048;
constexpr float DN_ALPHA = 1.6817928305074292f;
constexpr float LOG2E = 1.4426950408889634f;
constexpr float LN_EPS = 1e-5f;
constexpr float NEGF = -1e30f;
constexpr int TOPK = 256;
constexpr int CAP = 704;
constexpr int LDS_BYTES = 72 * 1024;

constexpr size_t MB = 1024 * 1024;
constexpr size_t W_AIN = 0;
constexpr size_t W_UK = W_AIN + (size_t)2 * 2048 * 1024 * 2;
constexpr size_t W_UV = W_UK + (size_t)2 * 16 * 256 * 64 * 2;
constexpr size_t W_AO = W_UV + (size_t)2 * 16 * 256 * 64 * 2;
constexpr size_t W_BIN = W_AO + (size_t)2 * 1024 * 1024 * 2;
constexpr size_t W_BO = W_BIN + (size_t)2 * 3072 * 1024 * 2;
constexpr size_t W_W1 = W_BO + (size_t)2 * 1024 * 1024 * 2;
constexpr size_t W_W2 = W_W1 + (size_t)4 * 4096 * 1024 * 2;
constexpr size_t WS_MOD = W_W2 + (size_t)4 * 4096 * 1024 * 2;
constexpr size_t WS_H = WS_MOD + 1 * MB;
constexpr size_t WS_BIG = WS_H + 64 * MB;
constexpr size_t WS_BAR = WS_BIG + 256 * MB;
constexpr size_t B_Q = 0;
constexpr size_t B_IQ = 64 * MB;
constexpr size_t B_IK = 96 * MB;
constexpr size_t B_IW = 100 * MB;
constexpr size_t B_CKVRAW = 104 * MB;
constexpr size_t B_CKVN = 136 * MB;
constexpr size_t B_SEL = 152 * MB;
constexpr size_t B_K = 64 * MB;
constexpr size_t B_VT = 128 * MB;
constexpr size_t B_O = 192 * MB;

struct Params {
  const float *x, *c, *rel_bias, *ada_w, *ada_b, *ln_g, *ln_b, *a_w_in, *a_kv_norm, *a_w_uk, *a_w_uv, *a_w_o, *b_w_in,
      *b_lambda, *b_subln, *b_w_o, *mlp_w1, *mlp_w2;
  float* out;
  char* ws;
};

DI int opq_tid() {
  int t = threadIdx.x & 255;
  asm volatile("" : "+v"(t));
  return t;
}
DI int opq_tid8() {
  int t = threadIdx.x;
  asm volatile("" : "+v"(t));
  return t;
}
DI unsigned pk2(float lo, float hi) {
  f32x2 v = {lo, hi};
  bf16x2_t b = __builtin_convertvector(v, bf16x2_t);
  return __builtin_bit_cast(unsigned, b);
}
DI u16 f2bf(float x) { return (u16)(pk2(x, 0.f) & 0xffffu); }
DI float wave_sum(float v) {
#pragma unroll
  for (int o = 32; o >= 1; o >>= 1) v += __shfl_xor(v, o);
  return v;
}
DI float xhalf_max(float x) {
  auto t = __builtin_amdgcn_permlane32_swap(__float_as_uint(x), __float_as_uint(x), false, false);
  return fmaxf(__uint_as_float(t[0]), __uint_as_float(t[1]));
}
DI float xhalf_sum(float x) {
  auto t = __builtin_amdgcn_permlane32_swap(__float_as_uint(x), __float_as_uint(x), false, false);
  return __uint_as_float(t[0]) + __uint_as_float(t[1]);
}
DI float xrow16_max(float x) {
  auto s_ = __builtin_amdgcn_permlane16_swap(__float_as_uint(x), __float_as_uint(x), false, false);
  x = fmaxf(__uint_as_float(s_[0]), __uint_as_float(s_[1]));
  return xhalf_max(x);
}
DI float xrow16_sum(float x) {
  auto s_ = __builtin_amdgcn_permlane16_swap(__float_as_uint(x), __float_as_uint(x), false, false);
  x = __uint_as_float(s_[0]) + __uint_as_float(s_[1]);
  return xhalf_sum(x);
}
DI f32x16 mfma32(bf16x8 a, bf16x8 b, f32x16 c) { return __builtin_amdgcn_mfma_f32_32x32x16_bf16(a, b, c, 0, 0, 0); }
DI f32x4 mfma16(bf16x8 a, bf16x8 b, f32x4 c) { return __builtin_amdgcn_mfma_f32_16x16x32_bf16(a, b, c, 0, 0, 0); }
DI int pi_row(int r) { return (r & ~12) | ((r & 4) << 1) | ((r & 8) >> 1); }

DI int rel_bucket(int n) {
  if (n < 16) return n;
  float nf = (float)n;
  int large = 16 + (int)(logf(nf / 16.f) / 2.0794415416798357f * 16.f);
  return large < 31 ? large : 31;
}

DI void tconv_phase(const float* __restrict__ src, u16* __restrict__ dst, int batch, int R, int C, int Cpad, char* smem,
                    int bid, int nb) {
  float* tile = (float*)smem;
  const int tid = opq_tid();
  const int tr = R / 64, tc = Cpad / 64;
  const int ntiles = batch * tr * tc;
  for (int it0 = 0; it0 < ntiles; it0 += nb) {
    const int it = (it0 + bid < ntiles) ? it0 + bid : ntiles - 1;
    const int bi = it / (tr * tc);
    const int rem = it - bi * (tr * tc);
    const int ri = rem / tc, ci = rem - ri * tc;
    const float* s = src + (size_t)bi * R * C;
    u16* d = dst + (size_t)bi * Cpad * R;
    __syncthreads();
#pragma unroll
    for (int k = 0; k < 4; k++) {
      const int r = (tid >> 4) + 16 * k;
      const int cl = (tid & 15) * 4;
      const int cc = ci * 64 + cl;
      f32x4 v = {0.f, 0.f, 0.f, 0.f};
      if (cc < C) v = *(const f32x4*)(s + (size_t)(ri * 64 + r) * C + cc);
      tile[r * 65 + cl + 0] = v[0];
      tile[r * 65 + cl + 1] = v[1];
      tile[r * 65 + cl + 2] = v[2];
      tile[r * 65 + cl + 3] = v[3];
    }
    __syncthreads();
#pragma unroll
    for (int k = 0; k < 2; k++) {
      const int cl = (tid >> 3) + 32 * k;
      const int r8 = (tid & 7) * 8;
      u32x4 o;
      o[0] = pk2(tile[(r8 + 0) * 65 + cl], tile[(r8 + 1) * 65 + cl]);
      o[1] = pk2(tile[(r8 + 2) * 65 + cl], tile[(r8 + 3) * 65 + cl]);
      o[2] = pk2(tile[(r8 + 4) * 65 + cl], tile[(r8 + 5) * 65 + cl]);
      o[3] = pk2(tile[(r8 + 6) * 65 + cl], tile[(r8 + 7) * 65 + cl]);
      *(u32x4*)(d + (size_t)(ci * 64 + cl) * R + ri * 64 + r8) = o;
    }
  }
}

DI void mod_phase(const Params& p, float* mod, char* smem, int bid, int nb) {
  float* sc = (float*)smem;
  float* red = sc + 4096;
  const int tid = opq_tid(), lane = tid & 63, w = __builtin_amdgcn_readfirstlane(tid >> 6);
  __syncthreads();
  for (int i = tid; i < 4096; i += 256) {
    float v = p.c[i];
    sc[i] = v / (1.f + expf(-v));
  }
  __syncthreads();
  for (int it = bid; it < 4 * 384; it += nb) {
    const int l = it / 384, e0 = (it - l * 384) * 16;
    const int ds = lane >> 4, ec = lane & 15;
    const float* wp = p.ada_w + ((size_t)l * 1024 + w * 256 + ds) * 6144 + e0 + ec;
    float a0 = 0, a1 = 0, a2 = 0, a3 = 0;
#pragma unroll 16
    for (int d = 0; d < 64; d++) {
      float wv = wp[(size_t)(4 * d) * 6144];
      int dd = w * 256 + 4 * d + ds;
      a0 += sc[dd] * wv;
      a1 += sc[1024 + dd] * wv;
      a2 += sc[2048 + dd] * wv;
      a3 += sc[3072 + dd] * wv;
    }
    a0 += __shfl_xor(a0, 16); a0 += __shfl_xor(a0, 32);
    a1 += __shfl_xor(a1, 16); a1 += __shfl_xor(a1, 32);
    a2 += __shfl_xor(a2, 16); a2 += __shfl_xor(a2, 32);
    a3 += __shfl_xor(a3, 16); a3 += __shfl_xor(a3, 32);
    if (lane < 16) {
      red[(w * 4 + 0) * 16 + lane] = a0;
      red[(w * 4 + 1) * 16 + lane] = a1;
      red[(w * 4 + 2) * 16 + lane] = a2;
      red[(w * 4 + 3) * 16 + lane] = a3;
    }
    __syncthreads();
    if (tid < 64) {
      const int b = tid >> 4, e = tid & 15;
      float sm = red[(0 * 4 + b) * 16 + e] + red[(1 * 4 + b) * 16 + e] + red[(2 * 4 + b) * 16 + e] + red[(3 * 4 + b) * 16 + e] +
                 p.ada_b[l * 6144 + e0 + e];
      mod[((size_t)l * 4 + b) * 6144 + e0 + e] = sm;
    }
    __syncthreads();
  }
}

DI void h0_phase(const float* __restrict__ x, const float* __restrict__ mod0, u16* __restrict__ h, int bid, int nb) {
  const size_t n8 = (size_t)T * 1024 / 8;
  for (size_t i = (size_t)bid * 256 + opq_tid(); i < n8; i += (size_t)nb * 256) {
    const size_t e = i * 8;
    const int t = (int)(e >> 10), d = (int)(e & 1023), b = t >> 13;
    const float* m = mod0 + (size_t)b * 6144;
    f32x4 v0 = *(const f32x4*)(x + e), v1 = *(const f32x4*)(x + e + 4);
    f32x4 sh0 = *(const f32x4*)(m + d), sh1 = *(const f32x4*)(m + d + 4);
    f32x4 sc0 = *(const f32x4*)(m + 1024 + d), sc1 = *(const f32x4*)(m + 1024 + d + 4);
    v0 = v0 * (1.f + sc0) + sh0;
    v1 = v1 * (1.f + sc1) + sh1;
    u32x4 o;
    o[0] = pk2(v0[0], v0[1]);
    o[1] = pk2(v0[2], v0[3]);
    o[2] = pk2(v1[0], v1[1]);
    o[3] = pk2(v1[2], v1[3]);
    *(u32x4*)(h + e) = o;
  }
}

DI void ln_phase(float* z, const float* __restrict__ g, const float* __restrict__ bt, const float* modn, int sh_off,
                 u16* __restrict__ h, int bid, int nb) {
  const int tid = opq_tid(), lane = tid & 63, w = __builtin_amdgcn_readfirstlane(tid >> 6);
  const int nw = nb * 4;
  for (int row0 = bid * 4 + w; row0 < T; row0 += 4 * nw) {
    f32x4 v[4][4];
#pragma unroll
    for (int rr = 0; rr < 4; rr++) {
      const int row = row0 + rr * nw;
      const f32x4* zp = (const f32x4*)(z + (size_t)(row < T ? row : row0) * 1024);
#pragma unroll
      for (int c = 0; c < 4; c++) v[rr][c] = zp[c * 64 + lane];
    }
#pragma unroll
    for (int rr = 0; rr < 4; rr++) {
      const int row = row0 + rr * nw;
      if (row < T) {
        float s = 0;
#pragma unroll
        for (int c = 0; c < 4; c++) s += v[rr][c][0] + v[rr][c][1] + v[rr][c][2] + v[rr][c][3];
        const float mu = wave_sum(s) * (1.f / 1024.f);
        float q = 0;
#pragma unroll
        for (int c = 0; c < 4; c++) {
          v[rr][c] = v[rr][c] - mu;
          q += v[rr][c][0] * v[rr][c][0] + v[rr][c][1] * v[rr][c][1] + v[rr][c][2] * v[rr][c][2] + v[rr][c][3] * v[rr][c][3];
        }
        const float rstd = rsqrtf(wave_sum(q) * (1.f / 1024.f) + LN_EPS);
        const int b = row >> 13;
        f32x4* zp = (f32x4*)(z + (size_t)row * 1024);
#pragma unroll
        for (int c = 0; c < 4; c++) {
          const int d = c * 256 + lane * 4;
          f32x4 y = v[rr][c] * rstd * *(const f32x4*)(g + d) + *(const f32x4*)(bt + d);
          zp[c * 64 + lane] = y;
          if (modn) {
            const float* m = modn + (size_t)b * 6144 + sh_off;
            f32x4 hv = y * (1.f + *(const f32x4*)(m + 1024 + d)) + *(const f32x4*)(m + d);
            u32x2 o;
            o[0] = pk2(hv[0], hv[1]);
            o[1] = pk2(hv[2], hv[3]);
            *(u32x2*)(h + (size_t)row * 1024 + d) = o;
          }
        }
      }
    }
  }
}

enum { EPI_AIN = 0, EPI_BIN = 1, EPI_RES = 2, EPI_SQRELU = 3 };
struct EpiArgs {
  u16 *o0, *o1, *o2;
  float *f0, *f1;
  const float* xin;
  const float* g;
};

template <int EPI>
DI void epi_store4(const EpiArgs& ea, int row, int col, const float* v, int bidx) {
  if (EPI == EPI_AIN) {
    if (col < 1024) {
      u32x2 o;
      o[0] = pk2(v[0], v[1]);
      o[1] = pk2(v[2], v[3]);
      *(u32x2*)(ea.o0 + (size_t)row * 1024 + col) = o;
    } else if (col < 1280) {
      *(f32x4*)(ea.f0 + (size_t)row * 256 + (col - 1024)) = (f32x4){v[0], v[1], v[2], v[3]};
    } else if (col < 1792) {
      u32x2 o;
      o[0] = pk2(v[0], v[1]);
      o[1] = pk2(v[2], v[3]);
      *(u32x2*)(ea.o1 + (size_t)row * 512 + (col - 1280)) = o;
    } else if (col < 1856) {
      const int d = col - 1792;
      const int sidx = row & 8191;
      const size_t off = (size_t)(row >> 13) * S * 64 +
                         ((size_t)((sidx >> 5) * 4 + (d >> 4)) * 64 + 32 * ((d >> 3) & 1) + (sidx & 31)) * 8 + (d & 7);
      u32x2 o;
      o[0] = pk2(v[0], v[1]);
      o[1] = pk2(v[2], v[3]);
      *(u32x2*)(ea.o2 + off) = o;
    } else if (col < 1864) {
      const float sc = 0.044194173824159216f;
      *(f32x4*)(ea.f1 + (size_t)row * 8 + (col - 1856)) = (f32x4){v[0] * sc, v[1] * sc, v[2] * sc, v[3] * sc};
    }
  } else if (EPI == EPI_BIN) {
    if (col < 1024) {
      const float sc = 0.125f * LOG2E;
      u32x2 o;
      o[0] = pk2(v[0] * sc, v[1] * sc);
      o[1] = pk2(v[2] * sc, v[3] * sc);
      *(u32x2*)(ea.o0 + (size_t)row * 1024 + col) = o;
    } else if (col < 2048) {
      u32x2 o;
      o[0] = pk2(v[0], v[1]);
      o[1] = pk2(v[2], v[3]);
      *(u32x2*)(ea.o1 + (size_t)row * 1024 + (col - 1024)) = o;
    } else {
      const int cv = col - 2048;
#pragma unroll
      for (int q = 0; q < 4; q++) ea.o2[((size_t)bidx * 1024 + cv + q) * 8192 + (row & 8191)] = f2bf(v[q]);
    }
  } else if (EPI == EPI_RES) {
    const f32x4 gg = *(const f32x4*)(ea.g + (size_t)bidx * 6144 + col);
    const size_t o = (size_t)row * 1024 + col;
    const f32x4 xv = *(const f32x4*)(ea.xin + o);
    f32x4 r;
#pragma unroll
    for (int q = 0; q < 4; q++) r[q] = DN_ALPHA * xv[q] + (1.f + gg[q]) * v[q];
    *(f32x4*)(ea.f0 + o) = r;
  } else {
    float r[4];
#pragma unroll
    for (int q = 0; q < 4; q++) {
      r[q] = v[q] > 0.f ? v[q] : 0.f;
      r[q] = r[q] * r[q];
    }
    u32x2 o;
    o[0] = pk2(r[0], r[1]);
    o[1] = pk2(r[2], r[3]);
    *(u32x2*)(ea.o0 + (size_t)row * 4096 + col) = o;
  }
}

template <int EPI>
DI void gemm_phase(const u16* __restrict__ A, const u16* __restrict__ Bt, int M, int N, int K, const EpiArgs& ea,
                   char* smem, int bid, int nb) {
  constexpr int MI = 4, BM = 64 * MI, BN = 256;
  u16* As = (u16*)smem;
  u16* Bs = As + BM * 72;
  const int tid = opq_tid8(), lane = tid & 63, w = __builtin_amdgcn_readfirstlane(tid >> 6), wm = w >> 2, wn = w & 3, l31 = lane & 31, lh = lane >> 5;
  const int ntn = N / BN, ntm = M / BM, nt = ntn * ntm, nk = K / 64;
  const int lr = tid >> 3, lc = (tid & 7) * 8;
  const int xcd = bid & 7, nbx = nb >> 3, cntx = (ntm >> 3) * ntn;
  (void)nt;
  for (int sq = bid >> 3; sq < cntx; sq += nbx) {
    const int tmx = sq / ntn, tn = sq - tmx * ntn;
    const int tm = tmx * 8 + xcd;
    const int m0 = tm * BM, n0 = tn * BN;
    f32x16 acc[MI][2];
#pragma unroll
    for (int i = 0; i < MI; i++)
#pragma unroll
      for (int j = 0; j < 2; j++)
#pragma unroll
        for (int r = 0; r < 16; r++) acc[i][j][r] = 0.f;
    u32x4 ra[4], rb[4];
    const u16* ap = A + (size_t)(m0 + lr) * K + lc;
    const u16* bp = Bt + (size_t)(n0 + lr) * K + lc;
#pragma unroll
    for (int i = 0; i < 4; i++) ra[i] = *(const u32x4*)(ap + (size_t)i * 64 * K);
#pragma unroll
    for (int i = 0; i < 4; i++) rb[i] = *(const u32x4*)(bp + (size_t)i * 64 * K);
    __syncthreads();
#pragma unroll
    for (int i = 0; i < 4; i++) *(u32x4*)&As[(lr + 64 * i) * 72 + lc] = ra[i];
#pragma unroll
    for (int i = 0; i < 4; i++) *(u32x4*)&Bs[(lr + 64 * i) * 72 + lc] = rb[i];
    __syncthreads();
    for (int kt = 0; kt < nk; kt++) {
      if (kt + 1 < nk) {
#pragma unroll
        for (int i = 0; i < 4; i++) ra[i] = *(const u32x4*)(ap + (size_t)i * 64 * K + (kt + 1) * 64);
#pragma unroll
        for (int i = 0; i < 4; i++) rb[i] = *(const u32x4*)(bp + (size_t)i * 64 * K + (kt + 1) * 64);
      }
#pragma unroll
      for (int ks = 0; ks < 4; ks++) {
        bf16x8 af[MI], b0, b1;
#pragma unroll
        for (int i = 0; i < MI; i++) af[i] = *(const bf16x8*)&As[(wm * 32 * MI + 32 * i + l31) * 72 + ks * 16 + lh * 8];
        b0 = *(const bf16x8*)&Bs[(wn * 64 + l31) * 72 + ks * 16 + lh * 8];
        b1 = *(const bf16x8*)&Bs[(wn * 64 + 32 + l31) * 72 + ks * 16 + lh * 8];
#pragma unroll
        for (int i = 0; i < MI; i++) {
          acc[i][0] = mfma32(b0, af[i], acc[i][0]);
          acc[i][1] = mfma32(b1, af[i], acc[i][1]);
        }
      }
      __syncthreads();
      if (kt + 1 < nk) {
#pragma unroll
        for (int i = 0; i < 4; i++) *(u32x4*)&As[(lr + 64 * i) * 72 + lc] = ra[i];
#pragma unroll
        for (int i = 0; i < 4; i++) *(u32x4*)&Bs[(lr + 64 * i) * 72 + lc] = rb[i];
        __syncthreads();
      }
    }
    const int bidx = m0 >> 13;
#pragma unroll
    for (int i = 0; i < MI; i++) {
      const int row = m0 + wm * 32 * MI + 32 * i + l31;
#pragma unroll
      for (int j = 0; j < 2; j++) {
#pragma unroll
        for (int r4 = 0; r4 < 4; r4++) {
          const int col = n0 + wn * 64 + 32 * j + 8 * r4 + 4 * lh;
          float v[4];
#pragma unroll
          for (int q = 0; q < 4; q++) v[q] = acc[i][j][4 * r4 + q];
          epi_store4<EPI>(ea, row, col, v, bidx);
        }
      }
    }
  }
}

DI int g8_lds_byte(int r, int c) {
  int st = (r >> 4) * 2 + (c >> 5), rr = r & 15, cc = c & 31, ob = rr * 64 + cc * 2;
  return st * 1024 + (ob ^ (((ob >> 9) & 1) << 5));
}
DI void g8_stage_rc(int b, int& R, int& C) {
  int st = b / 1024, sb = b % 1024, swz = sb ^ (((sb >> 9) & 1) << 5);
  R = (st >> 1) * 16 + swz / 64;
  C = (st & 1) * 32 + (swz % 64) / 2;
}
typedef __attribute__((address_space(3))) unsigned* lds_u32_ptr;

template <int EPI>
DI void gemm8p_phase(const u16* __restrict__ A, const u16* __restrict__ Bt, int M, int N, int K, const EpiArgs& ea,
                     char* smem, int bid, int nb) {
  constexpr int BK = 64, HALF = 128, HT = HALF * BK;
  u16* shm = (u16*)smem;
  const int tid = opq_tid8(), lane = tid & 63, wid = __builtin_amdgcn_readfirstlane(tid >> 6);
  const int wr = wid >> 2, wc = wid & 3, fr = lane & 15, fq = lane >> 4;
#define G8_SA(b, h) (shm + ((b) * 2 + (h)) * HT)
#define G8_SB(b, h) (shm + (4 + (b) * 2 + (h)) * HT)
  int g8o0, g8o1;
  {
    int r_, c_;
    g8_stage_rc(tid * 16, r_, c_);
    g8o0 = r_ * K + c_;
    g8_stage_rc(tid * 16 + 8192, r_, c_);
    g8o1 = r_ * K + c_;
  }
#define G8_STAGE(P, BASE, br, kt)                                                                                   \
  do {                                                                                                               \
    const u16* _gp = BASE + (size_t)(br) * K + (size_t)(kt) * BK;                                                    \
    asm volatile("" : "+s"(_gp));                \
    __builtin_amdgcn_global_load_lds((const unsigned*)(_gp + (unsigned)g8o0), (lds_u32_ptr)((char*)(P) + tid * 16), 16, 0, 0);        \
    __builtin_amdgcn_global_load_lds((const unsigned*)(_gp + (unsigned)g8o1), (lds_u32_ptr)((char*)(P) + tid * 16 + 8192), 16, 0, 0); \
  } while (0)
  const int g8lane = (fr * 64 + fq * 16) ^ ((fr & 8) << 2);
  const char* g8a = smem + g8lane + wr * 8192;
  const char* g8b = smem + 4 * HT * 2 + g8lane + wc * 4096;
#define G8_LDA(dst, b, h)                                                                                            \
  _Pragma("unroll") for (int m = 0; m < 4; ++m) _Pragma("unroll") for (int k = 0; k < 2; ++k)                        \
      dst[m][k] = *reinterpret_cast<const bf16x8*>(g8a + ((b) * 2 + (h)) * (HT * 2) + m * 2048 + k * 1024)
#define G8_LDB(dst, b, h)                                                                                            \
  _Pragma("unroll") for (int n = 0; n < 2; ++n) _Pragma("unroll") for (int k = 0; k < 2; ++k)                        \
      dst[n][k] = *reinterpret_cast<const bf16x8*>(g8b + ((b) * 2 + (h)) * (HT * 2) + n * 2048 + k * 1024)
#define G8_MMA(ai, bj, At_, Bt_)                                                                                     \
  do {                                                                                                               \
    __builtin_amdgcn_s_setprio(1);                                                                                   \
    _Pragma("unroll") for (int m = 0; m < 4; ++m) _Pragma("unroll") for (int n = 0; n < 2; ++n)                      \
        _Pragma("unroll") for (int k = 0; k < 2; ++k)                                                                \
            acc[ai][bj][m][n] = mfma16(Bt_[n][k], At_[m][k], acc[ai][bj][m][n]);                                     \
    __builtin_amdgcn_s_setprio(0);                                                                                   \
  } while (0)
#define G8_WAIT_V(n) asm volatile("s_waitcnt vmcnt(" #n ")" ::: "memory")
#define G8_WAIT_L(n) asm volatile("s_waitcnt lgkmcnt(" #n ")" ::: "memory")
#define G8_BAR __builtin_amdgcn_s_barrier()
#define G8_SCHED __builtin_amdgcn_sched_barrier(0)
  const int ntn = N / 256, ntm = M / 256, nt = K / BK;
  const int xcd = bid & 7, nbx = nb >> 3, cntx = (ntm >> 3) * ntn;
  for (int sq = bid >> 3; sq < cntx; sq += nbx) {
    const int tmx = sq / ntn, tn = sq - tmx * ntn;
    const int tm = tmx * 8 + xcd;
    const int brow = tm * 256, bcol = tn * 256;
    f32x4 acc[2][2][4][2];
#pragma unroll
    for (int a_ = 0; a_ < 2; a_++)
#pragma unroll
      for (int b_ = 0; b_ < 2; b_++)
#pragma unroll
        for (int m = 0; m < 4; m++)
#pragma unroll
          for (int n = 0; n < 2; n++) acc[a_][b_][m][n] = (f32x4){0.f, 0.f, 0.f, 0.f};
    bf16x8 At[4][2], B0[2][2], B1[2][2];
    asm volatile("s_waitcnt vmcnt(0) lgkmcnt(0)" ::: "memory");
    __syncthreads();
    G8_STAGE(G8_SB(0, 0), Bt, bcol, 0); G8_STAGE(G8_SA(0, 0), A, brow, 0);
    G8_STAGE(G8_SB(0, 1), Bt, bcol + HALF, 0); G8_STAGE(G8_SA(0, 1), A, brow + HALF, 0);
    if (wr == 1) G8_BAR;
    G8_WAIT_V(4); G8_BAR;
    G8_STAGE(G8_SB(1, 0), Bt, bcol, 1); G8_STAGE(G8_SA(1, 0), A, brow, 1); G8_STAGE(G8_SB(1, 1), Bt, bcol + HALF, 1);
    G8_WAIT_V(6); G8_BAR;
    for (int t = 0; t < nt - 2; t += 2) {
      G8_LDB(B0, 0, 0); G8_SCHED; G8_LDA(At, 0, 0); G8_STAGE(G8_SA(1, 1), A, brow + HALF, t + 1);
      G8_WAIT_L(8); G8_BAR; G8_WAIT_L(0); G8_MMA(0, 0, At, B0); G8_BAR; G8_SCHED;
      G8_LDB(B1, 0, 1); G8_STAGE(G8_SB(0, 0), Bt, bcol, t + 2);
      G8_BAR; G8_WAIT_L(0); G8_MMA(0, 1, At, B1); G8_BAR;
      G8_LDA(At, 0, 1); G8_STAGE(G8_SA(0, 0), A, brow, t + 2);
      G8_BAR; G8_WAIT_L(0); G8_MMA(1, 0, At, B0); G8_BAR; G8_SCHED;
      G8_STAGE(G8_SB(0, 1), Bt, bcol + HALF, t + 2);
      G8_WAIT_V(6); G8_BAR; G8_MMA(1, 1, At, B1); G8_BAR;
      G8_LDB(B0, 1, 0); G8_SCHED; G8_LDA(At, 1, 0); G8_STAGE(G8_SA(0, 1), A, brow + HALF, t + 2);
      G8_WAIT_L(8); G8_BAR; G8_WAIT_L(0); G8_MMA(0, 0, At, B0); G8_BAR; G8_SCHED;
      G8_LDB(B1, 1, 1); G8_STAGE(G8_SB(1, 0), Bt, bcol, t + 3);
      G8_BAR; G8_WAIT_L(0); G8_MMA(0, 1, At, B1); G8_BAR;
      G8_LDA(At, 1, 1); G8_STAGE(G8_SA(1, 0), A, brow, t + 3);
      G8_BAR; G8_WAIT_L(0); G8_MMA(1, 0, At, B0); G8_BAR; G8_SCHED;
      G8_STAGE(G8_SB(1, 1), Bt, bcol + HALF, t + 3);
      G8_WAIT_V(6); G8_BAR; G8_MMA(1, 1, At, B1); G8_BAR;
    }
    {
      G8_LDB(B0, 0, 0); G8_LDA(At, 0, 0); G8_STAGE(G8_SA(1, 1), A, brow + HALF, nt - 1);
      G8_BAR; G8_WAIT_L(0); G8_MMA(0, 0, At, B0); G8_BAR;
      G8_LDB(B1, 0, 1); G8_BAR; G8_WAIT_L(0); G8_MMA(0, 1, At, B1); G8_BAR;
      G8_LDA(At, 0, 1); G8_WAIT_V(4); G8_BAR; G8_WAIT_L(0); G8_MMA(1, 0, At, B0); G8_MMA(1, 1, At, B1); G8_BAR;
    }
    {
      G8_LDB(B0, 1, 0); G8_LDA(At, 1, 0); G8_WAIT_V(2); G8_BAR; G8_WAIT_L(0); G8_MMA(0, 0, At, B0); G8_BAR;
      G8_LDB(B1, 1, 1); G8_WAIT_V(0); G8_BAR; G8_WAIT_L(0); G8_MMA(0, 1, At, B1); G8_BAR;
      G8_LDA(At, 1, 1); G8_BAR; G8_WAIT_L(0); G8_MMA(1, 0, At, B0); G8_MMA(1, 1, At, B1); G8_BAR;
    }
    if (wr == 0) G8_BAR;
    const int bidx = brow >> 13;
#pragma unroll
    for (int ai = 0; ai < 2; ai++)
#pragma unroll
      for (int m = 0; m < 4; m++) {
        const int row = brow + ai * HALF + wr * 64 + m * 16 + fr;
#pragma unroll
        for (int bj = 0; bj < 2; bj++)
#pragma unroll
          for (int n = 0; n < 2; n++) {
            const int col = bcol + bj * HALF + wc * 32 + n * 16 + fq * 4;
            float v[4];
#pragma unroll
            for (int q = 0; q < 4; q++) v[q] = acc[ai][bj][m][n][q];
            epi_store4<EPI>(ea, row, col, v, bidx);
          }
      }
  }
#undef G8_SA
#undef G8_SB
#undef G8_STAGE
#undef G8_LDA
#undef G8_LDB
#undef G8_MMA
#undef G8_WAIT_V
#undef G8_WAIT_L
#undef G8_BAR
#undef G8_SCHED
}

DI void ckvnorm_phase(const float* __restrict__ raw, const float* __restrict__ g, u16* __restrict__ outp, int bid,
                      int nb) {
  const int tid = opq_tid(), lane = tid & 63, w = __builtin_amdgcn_readfirstlane(tid >> 6);
  const f32x4 gg = *(const f32x4*)(g + lane * 4);
  for (int row = bid * 4 + w; row < T; row += nb * 4) {
    f32x4 v = *(const f32x4*)(raw + (size_t)row * 256 + lane * 4);
    float ss = v[0] * v[0] + v[1] * v[1] + v[2] * v[2] + v[3] * v[3];
    ss = wave_sum(ss);
    const float r = rsqrtf(ss * (1.f / 256.f) + LN_EPS);
    u32x2 o;
    o[0] = pk2(v[0] * r * gg[0], v[1] * r * gg[1]);
    o[1] = pk2(v[2] * r * gg[2], v[3] * r * gg[3]);
    *(u32x2*)(outp + (size_t)row * 256 + lane * 4) = o;
  }
}

DI unsigned mono_key(float s) {
  unsigned u = __float_as_uint(s);
  return (u & 0x80000000u) ? ~u : (u | 0x80000000u);
}
DI float mono_inv(unsigned k) {
  unsigned u = (k & 0x80000000u) ? (k & 0x7fffffffu) : ~k;
  return __uint_as_float(u);
}
DI float relu_i(float x) {
  int i = __float_as_int(x);
  return __int_as_float(i > 0 ? i : 0);
}
DI int wcount(bool f) { return __popcll(__ballot(f)); }

template <bool EXACT>
DI void compact4(float* vals, u16* idxs, int* cnt, int lane, float* thr_out) {
  constexpr int NPL = CAP / 64;
  unsigned key[4][NPL];
  int n[4];
#pragma unroll
  for (int q = 0; q < 4; q++) n[q] = cnt[q];
#pragma unroll
  for (int q = 0; q < 4; q++)
#pragma unroll
    for (int j = 0; j < NPL; j++) {
      const int e = j * 64 + lane;
      key[q][j] = (e < n[q]) ? mono_key(vals[q * CAP + e]) : 0u;
    }
  unsigned Tk[4] = {0u, 0u, 0u, 0u};
  constexpr int LOWBIT = EXACT ? 0 : 18;
  int pend = (n[0] > TOPK ? 1 : 0) | (n[1] > TOPK ? 2 : 0) | (n[2] > TOPK ? 4 : 0) | (n[3] > TOPK ? 8 : 0);
#pragma unroll 1
  for (int bit = 31; bit >= LOWBIT; bit--) {
#pragma unroll
    for (int q = 0; q < 4; q++) {
      const unsigned cand = Tk[q] | (1u << bit);
      int c = 0;
#pragma unroll
      for (int j = 0; j < NPL; j++) c += wcount(key[q][j] >= cand);
      Tk[q] = (c >= TOPK) ? cand : Tk[q];
      if (c == TOPK) pend &= ~(1 << q);
      if (q == 1) __builtin_amdgcn_sched_barrier(0);
    }
    if (pend == 0) break;
  }
  unsigned I[4] = {0xffffu, 0xffffu, 0xffffu, 0xffffu};
  if (EXACT) {
    bool ties = false;
#pragma unroll
    for (int q = 0; q < 4; q++) {
      int cge = 0;
#pragma unroll
      for (int j = 0; j < NPL; j++) cge += wcount(key[q][j] >= Tk[q]);
      if (n[q] > TOPK && cge != TOPK) ties = true;
      if (q == 1) __builtin_amdgcn_sched_barrier(0);
    }
    if (ties) {
    unsigned ix[4][NPL];
    int need[4];
#pragma unroll
    for (int q = 0; q < 4; q++) {
      int cgt = 0;
#pragma unroll
      for (int j = 0; j < NPL; j++) {
        const int e = j * 64 + lane;
        ix[q][j] = (e < n[q]) ? (unsigned)idxs[q * CAP + e] : 0xffffu;
        cgt += wcount(key[q][j] > Tk[q]);
      }
      need[q] = TOPK - cgt;
      I[q] = 0u;
    }
#pragma unroll 1
    for (int bit = 13; bit >= 0; bit--) {
#pragma unroll
      for (int q = 0; q < 4; q++) {
        const unsigned cand = I[q] | (1u << bit);
        int c = 0;
#pragma unroll
        for (int j = 0; j < NPL; j++) c += wcount(key[q][j] == Tk[q] && ix[q][j] < cand);
        I[q] = (c < need[q]) ? cand : I[q];
        if (q == 1) __builtin_amdgcn_sched_barrier(0);
      }
    }
    }
  }
  const unsigned long long lt = (1ull << lane) - 1ull;
#pragma unroll
  for (int q = 0; q < 4; q++) {
    if (n[q] > TOPK) {
      int base = 0;
#pragma unroll
      for (int j = 0; j < NPL; j++) {
        const int e = j * 64 + lane;
        const bool in = e < n[q];
        const float v = in ? vals[q * CAP + e] : 0.f;
        const unsigned ixv = in ? (unsigned)idxs[q * CAP + e] : 0xffffu;
        const bool keep = (key[q][j] > Tk[q]) || (key[q][j] == Tk[q] && ixv <= I[q]);
        const unsigned long long m = __ballot(keep);
        if (keep) {
          const int pos = base + __popcll(m & lt);
          vals[q * CAP + pos] = v;
          idxs[q * CAP + pos] = (u16)ixv;
        }
        base += __popcll(m);
      }
      if (lane == 0) cnt[q] = base;
      thr_out[q] = mono_inv(Tk[q]);
    }
  }
}

DI void indexer_phase(const u16* __restrict__ iq, const u16* __restrict__ ik, const float* __restrict__ iw,
                      u16* __restrict__ sel, char* smem, int bid, int nb) {
  constexpr int WBYTES = 4 * CAP * 4 + 4 * CAP * 2 + 64;
  const int tid = opq_tid(), lane = tid & 63, w = __builtin_amdgcn_readfirstlane(tid >> 6), l31 = lane & 31, u = lane >> 5;
  float* vals = (float*)(smem + w * WBYTES);
  u16* idxs = (u16*)(smem + w * WBYTES + 4 * CAP * 4);
  int* cnt = (int*)(smem + w * WBYTES + 4 * CAP * 4 + 4 * CAP * 2);
  const int nitems = NBATCH * (S / 16);
  const int nrounds = (nitems + nb - 1) / nb;
  __syncthreads();
  for (int rd = 0; rd < nrounds; rd++) {
    const int it = rd * nb + ((rd & 1) ? (nb - 1 - bid) : bid);
    if (it >= nitems) continue;
    const int b = it & 3, qg = (S / 16 - 1) - (it >> 2);
    const int t0 = qg * 16;
    const int tw = t0 + 4 * w;
    const size_t tb = (size_t)b * S;
    bf16x8 aq[4];
    {
      const int g = l31 >> 3, up = (l31 >> 2) & 1, j = l31 & 3;
      const int ql = 2 * up + (g >> 1), hd = 4 * (g & 1) + j;
      const u16* qp = iq + (tb + tw + ql) * 512 + hd * 64 + u * 8;
#pragma unroll
      for (int ks = 0; ks < 4; ks++) aq[ks] = *(const bf16x8*)(qp + ks * 16);
    }
    float wq[2][8];
#pragma unroll
    for (int qq = 0; qq < 2; qq++) {
      const float* wp = iw + (tb + tw + 2 * u + qq) * 8;
      f32x4 w0 = *(const f32x4*)wp, w1 = *(const f32x4*)(wp + 4);
#pragma unroll
      for (int h = 0; h < 4; h++) {
        wq[qq][h] = w0[h];
        wq[qq][4 + h] = w1[h];
      }
    }
    float thr[2] = {-INFINITY, -INFINITY};
    __builtin_amdgcn_wave_barrier();
    if (lane < 4) cnt[lane] = 0;
    __builtin_amdgcn_wave_barrier();
    const int nkb = (tw + 3) / 32 + 1;
    const u16* kp = ik + tb * 64 + lane * 8;
    bf16x8 ring[4][4];
#pragma unroll
    for (int i = 0; i < 4; i++) {
      const int kbn = (i < nkb) ? i : nkb - 1;
#pragma unroll
      for (int ks = 0; ks < 4; ks++) ring[i][ks] = *(const bf16x8*)(kp + (size_t)(kbn * 4 + ks) * 512);
    }
#pragma unroll 1
    for (int kb0 = 0; kb0 < nkb; kb0 += 4) {
#pragma unroll
      for (int i = 0; i < 4; i++) {
        const int kb = kb0 + i;
        {
          f32x16 acc;
#pragma unroll
          for (int r = 0; r < 16; r++) acc[r] = 0.f;
#pragma unroll
          for (int ks = 0; ks < 4; ks++) acc = mfma32(aq[ks], ring[i][ks], acc);
          {
            const int kbn = (kb + 4 < nkb) ? kb + 4 : nkb - 1;
#pragma unroll
            for (int ks = 0; ks < 4; ks++) ring[i][ks] = *(const bf16x8*)(kp + (size_t)(kbn * 4 + ks) * 512);
          }
          const int key = kb * 32 + l31;
#pragma unroll
          for (int qq = 0; qq < 2; qq++) {
            float s0 = 0.f, s1 = 0.f;
#pragma unroll
            for (int h = 0; h < 8; h += 2) {
              s0 = fmaf(wq[qq][h], relu_i(acc[8 * qq + h]), s0);
              s1 = fmaf(wq[qq][h + 1], relu_i(acc[8 * qq + h + 1]), s1);
            }
            float s = s0 + s1;
            s += 0.0f;
            const int tq = tw + 2 * u + qq;
            if (key <= tq && s >= thr[qq]) {
              const int qs = 2 * u + qq;
              const int pos = atomicAdd(&cnt[qs], 1);
              vals[qs * CAP + pos] = s;
              idxs[qs * CAP + pos] = (u16)key;
            }
          }
        }
      }
      __builtin_amdgcn_wave_barrier();
      const int c0 = cnt[0], c1 = cnt[1], c2 = cnt[2], c3 = cnt[3];
      if (c0 > CAP - 128 || c1 > CAP - 128 || c2 > CAP - 128 || c3 > CAP - 128) {
        float to[4] = {0.f, 0.f, 0.f, 0.f};
        compact4<false>(vals, idxs, cnt, lane, to);
        __builtin_amdgcn_wave_barrier();
        const int d0 = cnt[0], d1 = cnt[1], d2 = cnt[2], d3 = cnt[3];
        if (d0 > CAP - 256 || d1 > CAP - 256 || d2 > CAP - 256 || d3 > CAP - 256) {
          compact4<true>(vals, idxs, cnt, lane, to);
          __builtin_amdgcn_wave_barrier();
        }
        if (c0 > TOPK && u == 0) thr[0] = to[0];
        if (c1 > TOPK && u == 0) thr[1] = to[1];
        if (c2 > TOPK && u == 1) thr[0] = to[2];
        if (c3 > TOPK && u == 1) thr[1] = to[3];
      }
    }
    {
      const int c0 = cnt[0], c1 = cnt[1], c2 = cnt[2], c3 = cnt[3];
      if (c0 > TOPK || c1 > TOPK || c2 > TOPK || c3 > TOPK) {
        float to[4];
        compact4<true>(vals, idxs, cnt, lane, to);
        __builtin_amdgcn_wave_barrier();
      }
    }
#pragma unroll 1
    for (int qs = 0; qs < 4; qs++) {
      const int n = cnt[qs];
      u16* sp = sel + (tb + tw + qs) * 256;
#pragma unroll
      for (int j = 0; j < 4; j++) {
        const int e = j * 64 + lane;
        sp[e] = (e < n) ? idxs[qs * CAP + e] : (u16)0xffffu;
      }
    }
  }
}

DI void sparse_phase(const u16* __restrict__ q, const u16* __restrict__ ckvn, const u16* __restrict__ sel,
                     const u16* __restrict__ wuk, const u16* __restrict__ wuv, const float* __restrict__ rel_bias,
                     u16* scratch, u16* __restrict__ o, char* smem, int bid, int nb) {
  constexpr int GS = 264;
  const int tid = opq_tid(), lane = tid & 63, w = __builtin_amdgcn_readfirstlane(tid >> 6), l15 = lane & 15, g = lane >> 4;
  u16* G = (u16*)smem + (size_t)w * 32 * GS;
  int* lut = (int*)(smem + 4 * 32 * GS * 2);
  float* rb = (float*)(lut + 128);
  __syncthreads();
  if (tid < 128) lut[tid] = rel_bucket(tid);
  for (int i = tid; i < 512; i += 256) rb[i] = rel_bias[i] * LOG2E;
  __syncthreads();
  u16* ql = scratch + (size_t)bid * (16 * 16 * 256);
  const int nitems = NBATCH * (S / 16);
  for (int it = bid; it < nitems; it += nb) {
    const int b = it & 3, qg = it >> 2;
    const int t0 = qg * 16;
    const size_t tb = (size_t)b * S;
    for (int hh = 0; hh < 4; hh++) {
      const int h = 4 * w + hh;
      bf16x8 bq[2];
#pragma unroll
      for (int ks = 0; ks < 2; ks++) bq[ks] = *(const bf16x8*)(q + (tb + t0 + l15) * 1024 + h * 64 + ks * 32 + g * 8);
#pragma unroll 4
      for (int rt = 0; rt < 16; rt++) {
        f32x4 acc = {0.f, 0.f, 0.f, 0.f};
#pragma unroll
        for (int ks = 0; ks < 2; ks++) {
          bf16x8 a = *(const bf16x8*)(wuk + ((size_t)h * 256 + rt * 16 + l15) * 64 + ks * 32 + g * 8);
          acc = mfma16(a, bq[ks], acc);
        }
        u32x2 ov;
        ov[0] = pk2(acc[0] * (0.125f * LOG2E), acc[1] * (0.125f * LOG2E));
        ov[1] = pk2(acc[2] * (0.125f * LOG2E), acc[3] * (0.125f * LOG2E));
        *(u32x2*)(ql + ((size_t)l15 * 16 + h) * 256 + rt * 16 + 4 * g) = ov;
      }
    }
    __syncthreads();
    {
      const u16* selw = sel + (tb + t0 + 4 * w) * 256;
      const int l31 = lane & 31;
      const int q4 = l15 >> 2, p4 = l15 & 3;
      const u16* ckb = ckvn + tb * 256;
      int idx_c = selw[l31];
      int idx_n = selw[32 + l31];
      u32x4 gr[16];
#pragma unroll
      for (int i = 0; i < 16; i++) {
        int id = __shfl(idx_c, (lane >> 5) + 2 * i);
        id = (id == 0xffff) ? 0 : id;
        gr[i] = *(const u32x4*)(ckb + (unsigned)(id * 256 + l31 * 8));
      }
      bf16x8 qb[8];
      float m_run = NEGF, l_run = 0.f;
      f32x4 O[16];
#pragma unroll 1
      for (int st = 0; st < 32; st++) {
        const int qi = st >> 3, ch = st & 7;
        const int qloc = 4 * w + qi;
        const int t = t0 + qloc;
        if (ch == 0) {
#pragma unroll
          for (int ks = 0; ks < 8; ks++) qb[ks] = *(const bf16x8*)(ql + ((size_t)qloc * 16 + l15) * 256 + ks * 32 + g * 8);
          m_run = NEGF;
          l_run = 0.f;
#pragma unroll
          for (int rt = 0; rt < 16; rt++) O[rt] = (f32x4){0.f, 0.f, 0.f, 0.f};
        }
#pragma unroll
        for (int i = 0; i < 16; i++) *(u32x4*)&G[((lane >> 5) + 2 * i) * GS + l31 * 8] = gr[i];
        __builtin_amdgcn_wave_barrier();
        const int stn2 = (st + 2 < 32) ? st + 2 : 31;
        const int idx_nn = selw[stn2 * 32 + l31];
#pragma unroll
        for (int i = 0; i < 16; i++) {
          int id = __shfl(idx_n, (lane >> 5) + 2 * i);
          id = (id == 0xffff) ? 0 : id;
          gr[i] = *(const u32x4*)(ckb + (unsigned)(id * 256 + l31 * 8));
        }
        float lg[2][4];
#pragma unroll
        for (int kbk = 0; kbk < 2; kbk++) {
          f32x4 acc = {0.f, 0.f, 0.f, 0.f};
#pragma unroll
          for (int ks = 0; ks < 8; ks++) {
            bf16x8 a = *(const bf16x8*)&G[(16 * kbk + l15) * GS + ks * 32 + g * 8];
            acc = mfma16(a, qb[ks], acc);
            if (ks == 3) asm volatile("" ::: "memory");
          }
          asm volatile("" ::: "memory");
#pragma unroll
          for (int i = 0; i < 4; i++) {
            const int kid = __shfl(idx_c, 16 * kbk + 4 * g + i);
            float v = NEGF;
            if (kid != 0xffff) {
              int n = t - kid;
              n = n < 0 ? 0 : n;
              const int bk = n < 128 ? lut[n] : 31;
              v = acc[i] + rb[bk * 16 + l15];
            }
            lg[kbk][i] = v;
          }
        }
        float mx = fmaxf(fmaxf(fmaxf(lg[0][0], lg[0][1]), fmaxf(lg[0][2], lg[0][3])),
                         fmaxf(fmaxf(lg[1][0], lg[1][1]), fmaxf(lg[1][2], lg[1][3])));
        mx = xrow16_max(mx);
        const float m_new = fmaxf(m_run, mx);
        const float scl = __builtin_amdgcn_exp2f(m_run - m_new);
        m_run = m_new;
        float ps = 0.f;
        float pe[8];
#pragma unroll
        for (int kbk = 0; kbk < 2; kbk++)
#pragma unroll
          for (int i = 0; i < 4; i++) {
            const float pv = __builtin_amdgcn_exp2f(lg[kbk][i] - m_new);
            pe[kbk * 4 + i] = pv;
            ps += pv;
          }
        l_run = l_run * scl + ps;
        u32x4 pw;
        pw[0] = pk2(pe[0], pe[1]);
        pw[1] = pk2(pe[2], pe[3]);
        pw[2] = pk2(pe[4], pe[5]);
        pw[3] = pk2(pe[6], pe[7]);
        const bf16x8 pB = __builtin_bit_cast(bf16x8, pw);
        if (__ballot(scl != 1.f)) {
#pragma unroll
          for (int rt = 0; rt < 16; rt++) O[rt] = O[rt] * scl;
        }
#pragma unroll
        for (int rt = 0; rt < 16; rt++) {
          const s16x4 lo = __builtin_amdgcn_ds_read_tr16_b64_v4i16((lds_s16x4_ptr)(&G[(4 * g + q4) * GS + rt * 16 + 4 * p4]));
          const s16x4 hi = __builtin_amdgcn_ds_read_tr16_b64_v4i16((lds_s16x4_ptr)(&G[(16 + 4 * g + q4) * GS + rt * 16 + 4 * p4]));
          const bf16x8 a = (bf16x8){lo[0], lo[1], lo[2], lo[3], hi[0], hi[1], hi[2], hi[3]};
          O[rt] = mfma16(a, pB, O[rt]);
          if ((rt & 3) == 3) asm volatile("" ::: "memory");
        }
        __builtin_amdgcn_wave_barrier();
        if (ch == 7) {
          float lt = l_run;
          lt = xrow16_sum(lt);
          const float inv = 1.f / lt;
#pragma unroll
          for (int rt = 0; rt < 16; rt++) {
            u32x2 ov;
            ov[0] = pk2(O[rt][0] * inv, O[rt][1] * inv);
            ov[1] = pk2(O[rt][2] * inv, O[rt][3] * inv);
            *(u32x2*)(ql + ((size_t)qloc * 16 + l15) * 256 + rt * 16 + 4 * g) = ov;
          }
        }
        idx_c = idx_n;
        idx_n = idx_nn;
      }
    }
    __syncthreads();
    for (int hh = 0; hh < 4; hh++) {
      const int h = 4 * w + hh;
      bf16x8 bo[8];
#pragma unroll
      for (int ks = 0; ks < 8; ks++) bo[ks] = *(const bf16x8*)(ql + ((size_t)l15 * 16 + h) * 256 + ks * 32 + g * 8);
#pragma unroll
      for (int et = 0; et < 4; et++) {
        f32x4 acc = {0.f, 0.f, 0.f, 0.f};
#pragma unroll
        for (int ks = 0; ks < 8; ks++) {
          bf16x8 a = *(const bf16x8*)(wuv + ((size_t)h * 64 + et * 16 + l15) * 256 + ks * 32 + g * 8);
          acc = mfma16(a, bo[ks], acc);
        }
        u32x2 ov;
        ov[0] = pk2(acc[0], acc[1]);
        ov[1] = pk2(acc[2], acc[3]);
        *(u32x2*)(o + (tb + t0 + l15) * 1024 + h * 64 + et * 16 + 4 * g) = ov;
      }
    }
    __syncthreads();
  }
}

DI void diffattn_phase(const u16* __restrict__ q, const u16* __restrict__ k, const u16* __restrict__ vT,
                       u16* __restrict__ o, const float* __restrict__ rel_bias, const float* __restrict__ lam,
                       const float* __restrict__ subln, int layer_idx, char* smem, int bid, int nb) {
  constexpr int KS = 136, VS = 72;
  u16* Ks = (u16*)smem;
  u16* Vs = Ks + 64 * KS;
  float* exch = (float*)smem;
  constexpr int STG = 64 * KS + 128 * VS;
  float* btab = (float*)(smem + 72 * 1024);
  int* lut = (int*)(smem + 72 * 1024 + 1040);
  float* misc = (float*)(smem + 72 * 1024 + 1040 + 512);
  const int tid = opq_tid8(), lane = tid & 63, w = __builtin_amdgcn_readfirstlane(tid >> 6), l31 = lane & 31, lh = lane >> 5;
  const int qsub = w >> 1, m = w & 1;
  const float lam_init = 0.8f - 0.6f * expf(-0.3f * (float)layer_idx);
  __syncthreads();
  if (tid < 128) lut[tid] = rel_bucket(tid);
  if (w == 0) {
    float p1 = lam[lane] * lam[64 + lane], p2 = lam[128 + lane] * lam[192 + lane];
    p1 = wave_sum(p1);
    p2 = wave_sum(p2);
    if (lane == 0) misc[0] = expf(p1) - expf(p2) + lam_init;
  }
  __syncthreads();
  const float lam_full = misc[0];
  const int xcd = bid & 7, loc = bid >> 3, nbx = nb >> 3;
  const int rph = (S / 128) / nbx;
  const int prow = pi_row(l31);
  for (int rd = 0; rd < 4 * rph; rd++) {
    const int hh = rd / rph, r = rd - hh * rph;
    const int bh = xcd + 8 * hh;
    const int kk = r >> 1;
    const int qb = (r & 1) ? (kk * nbx + loc) : ((S / 128 - 1) - kk * nbx - loc);
    const int b = bh >> 3, h = bh & 7;
    const int q0 = qb * 128, tq0 = q0 + 32 * qsub, t = tq0 + l31;
    const size_t tb = (size_t)b * S;
    __syncthreads();
    for (int i = tid; i < 258; i += 512) {
      const int n = i >> 1, mm = i & 1;
      const int bk = n < 128 ? lut[n] : 31;
      btab[i] = rel_bias[bk * 16 + 2 * h + mm] * LOG2E;
    }
    bf16x8 qf[4];
#pragma unroll
    for (int ks = 0; ks < 4; ks++) qf[ks] = *(const bf16x8*)(q + (tb + t) * 1024 + h * 128 + m * 64 + ks * 16 + lh * 8);
    f32x16 O[4];
#pragma unroll
    for (int et = 0; et < 4; et++)
#pragma unroll
      for (int r = 0; r < 16; r++) O[et][r] = 0.f;
    float m_run = NEGF, l_run = 0.f;
    const int nkt = 2 * qb + 2;
    u32x4 rk[2], rv[2];
    const u16* kp = k + tb * 1024 + h * 128;
    const u16* vp = vT + ((size_t)(b * 8 + h) * 128) * 8192;
#pragma unroll
    for (int i = 0; i < 2; i++) {
      const int id = tid + 512 * i;
      rk[i] = *(const u32x4*)(kp + (size_t)(id >> 4) * 1024 + (id & 15) * 8);
      rv[i] = *(const u32x4*)(vp + (size_t)(id >> 3) * 8192 + (id & 7) * 8);
    }
#pragma unroll
    for (int i = 0; i < 2; i++) {
      const int id = tid + 512 * i;
      *(u32x4*)&Ks[(id >> 4) * KS + (id & 15) * 8] = rk[i];
      *(u32x4*)&Vs[(id >> 3) * VS + (id & 7) * 8] = rv[i];
    }
#pragma unroll
    for (int i = 0; i < 2; i++) {
      const int id = tid + 512 * i;
      rk[i] = *(const u32x4*)(kp + (size_t)(64 + (id >> 4)) * 1024 + (id & 15) * 8);
      rv[i] = *(const u32x4*)(vp + (size_t)(id >> 3) * 8192 + 64 + (id & 7) * 8);
    }
    __syncthreads();
    const float cfar = btab[256 + m];
    for (int kt = 0; kt < nkt; kt++) {
      const u16* Ksc = Ks + (kt & 1) * STG;
      const u16* Vsc = Vs + (kt & 1) * STG;
      if (kt + 1 < nkt) {
        u16* Ksn = Ks + ((kt & 1) ^ 1) * STG;
        u16* Vsn = Vs + ((kt & 1) ^ 1) * STG;
#pragma unroll
        for (int i = 0; i < 2; i++) {
          const int id = tid + 512 * i;
          *(u32x4*)&Ksn[(id >> 4) * KS + (id & 15) * 8] = rk[i];
          *(u32x4*)&Vsn[(id >> 3) * VS + (id & 7) * 8] = rv[i];
        }
        const int k2 = (kt + 2 < nkt) ? kt + 2 : nkt - 1;
#pragma unroll
        for (int i = 0; i < 2; i++) {
          const int id = tid + 512 * i;
          rk[i] = *(const u32x4*)(kp + (size_t)(k2 * 64 + (id >> 4)) * 1024 + (id & 15) * 8);
          rv[i] = *(const u32x4*)(vp + (size_t)(id >> 3) * 8192 + k2 * 64 + (id & 7) * 8);
        }
      }
      const int s_tile = kt * 64;
      const int remk = tq0 + 31 - s_tile;
      const int nblk = remk < 0 ? 0 : (remk >= 32 ? 2 : 1);
#pragma unroll
      for (int kb = 0; kb < 2; kb++) {
        if (kb >= nblk) break;
        const int s0 = s_tile + 32 * kb;
        const bool nearb = (tq0 - (s0 + 31)) < 128;
        const bool first = (kt == 0) && (kb == 0);
        const float mref = first ? 0.f : m_run;
        const float cinit = nearb ? -mref : (cfar - mref);
        f32x16 acc;
#pragma unroll
        for (int r = 0; r < 16; r++) acc[r] = cinit;
#pragma unroll
        for (int ks = 0; ks < 4; ks++) {
          bf16x8 a = *(const bf16x8*)&Ksc[(32 * kb + prow) * KS + m * 64 + ks * 16 + lh * 8];
          acc = mfma32(a, qf[ks], acc);
        }
        bf16x8 vfa[4];
#pragma unroll
        for (int et = 0; et < 4; et++) vfa[et] = *(const bf16x8*)&Vsc[(32 * et + l31) * VS + 32 * kb + 8 * lh];
        __builtin_amdgcn_sched_barrier(0);
        if (nearb) {
#pragma unroll
          for (int r = 0; r < 16; r++) {
            const int key = s0 + 16 * (r >> 3) + 8 * lh + (r & 7);
            const int n = t - key;
            const int nc = n < 0 ? 0 : (n > 128 ? 128 : n);
            const float bv = btab[nc * 2 + m];
            acc[r] = (n < 0) ? NEGF : acc[r] + bv;
          }
        }
        float mx = acc[0];
#pragma unroll
        for (int r = 1; r < 16; r++) mx = fmaxf(mx, acc[r]);
        mx = xhalf_max(mx);
        if (first || __ballot(mx > 8.f)) {
          const float dlt = first ? mx : fmaxf(mx, 0.f);
          const float scl = __builtin_amdgcn_exp2f(-dlt);
#pragma unroll
          for (int r = 0; r < 16; r++) acc[r] -= dlt;
#pragma unroll
          for (int et = 0; et < 4; et++)
#pragma unroll
            for (int r = 0; r < 16; r++) O[et][r] *= scl;
          l_run *= scl;
          m_run = mref + dlt;
        }
        float ps = 0.f;
#pragma unroll
        for (int r = 0; r < 16; r++) {
          const float pv = __builtin_amdgcn_exp2f(acc[r]);
          acc[r] = pv;
          ps += pv;
        }
        l_run += ps;
        bf16x8 vfb[4];
#pragma unroll
        for (int et = 0; et < 4; et++) vfb[et] = *(const bf16x8*)&Vsc[(32 * et + l31) * VS + 32 * kb + 16 + 8 * lh];
        u32x4 pw0, pw1;
        pw0[0] = pk2(acc[0], acc[1]);
        pw0[1] = pk2(acc[2], acc[3]);
        pw0[2] = pk2(acc[4], acc[5]);
        pw0[3] = pk2(acc[6], acc[7]);
        pw1[0] = pk2(acc[8], acc[9]);
        pw1[1] = pk2(acc[10], acc[11]);
        pw1[2] = pk2(acc[12], acc[13]);
        pw1[3] = pk2(acc[14], acc[15]);
        const bf16x8 pB0 = __builtin_bit_cast(bf16x8, pw0), pB1 = __builtin_bit_cast(bf16x8, pw1);
        __builtin_amdgcn_sched_barrier(0);
#pragma unroll
        for (int et = 0; et < 4; et++) O[et] = mfma32(vfa[et], pB0, O[et]);
#pragma unroll
        for (int et = 0; et < 4; et++) O[et] = mfma32(vfb[et], pB1, O[et]);
      }
      __syncthreads();
    }
    float lt = xhalf_sum(l_run);
    const float inv = 1.f / lt;
    if (m == 1) {
#pragma unroll
      for (int et = 0; et < 4; et++)
#pragma unroll
        for (int r = 0; r < 16; r++) {
          const int e = 32 * et + (r & 3) + 8 * (r >> 2) + 4 * lh;
          exch[(qsub * 128 + e) * 32 + l31] = O[et][r] * inv;
        }
    }
    __syncthreads();
    if (m == 0) {
      float ss = 0.f;
#pragma unroll
      for (int et = 0; et < 4; et++)
#pragma unroll
        for (int r = 0; r < 16; r++) {
          const int e = 32 * et + (r & 3) + 8 * (r >> 2) + 4 * lh;
          const float v = O[et][r] * inv - lam_full * exch[(qsub * 128 + e) * 32 + l31];
          O[et][r] = v;
          ss += v * v;
        }
      ss = xhalf_sum(ss);
      const float rs = rsqrtf(ss * (1.f / 128.f) + LN_EPS);
      const float osc = 1.f - lam_init;
#pragma unroll
      for (int et = 0; et < 4; et++)
#pragma unroll
        for (int r4 = 0; r4 < 4; r4++) {
          const int e = 32 * et + 8 * r4 + 4 * lh;
          const f32x4 gv = *(const f32x4*)(subln + e);
          u32x2 ov;
          ov[0] = pk2(O[et][4 * r4 + 0] * rs * gv[0] * osc, O[et][4 * r4 + 1] * rs * gv[1] * osc);
          ov[1] = pk2(O[et][4 * r4 + 2] * rs * gv[2] * osc, O[et][4 * r4 + 3] * rs * gv[3] * osc);
          *(u32x2*)(o + (tb + t) * 1024 + h * 128 + e) = ov;
        }
    }
  }
}

#define XB_TMO      128
#define XB_XCNT(j)  (256  + 64 * (j))
#define XB_XSUB(j)  (1280 + 64 * (j))
#define XB_XGEN(j)  (2304 + 64 * (j))
#define XB_TOP      3328
#define XB_TOPGEN   3392
#define XCD_BAR_WORDS 3456
#define XB_SPIN_CAP (1u << 20)
#define LAS __attribute__((address_space(3)))
DI unsigned xb_ld(unsigned* p) { return __hip_atomic_load(p, __ATOMIC_RELAXED, __HIP_MEMORY_SCOPE_AGENT); }
DI unsigned xb_add(unsigned* p, unsigned v) { return __hip_atomic_fetch_add(p, v, __ATOMIC_RELAXED, __HIP_MEMORY_SCOPE_AGENT); }
DI unsigned xb_xcc_id() { return (unsigned)__builtin_amdgcn_s_getreg((3 << 11) | 20) & 0xFu; }
#define XB_SPIN(cond, bar) do { unsigned _sp = 0; while (cond) { __builtin_amdgcn_s_sleep(1); \
    if ((++_sp & 255u) == 0u) { if (xb_ld(&(bar)[XB_TMO])) break; if (_sp > XB_SPIN_CAP) { atomicAdd(&(bar)[XB_TMO], 1u); break; } } } } while (0)
struct XcdBarrier {
  unsigned* bar;
  unsigned x;
  volatile LAS unsigned* st;
};
DI XcdBarrier xcd_barrier_post(unsigned* bar, volatile LAS unsigned* st) {
  XcdBarrier b;
  b.bar = bar;
  b.x = xb_xcc_id();
  b.st = st;
  if (threadIdx.x == 0) (void)xb_add(&bar[XB_XCNT(b.x)], 1u);
  return b;
}
DI void xcd_barrier_complete(unsigned* bar, unsigned x, unsigned& nloc, unsigned& nx) {
  const unsigned G = gridDim.x * gridDim.y * gridDim.z;
  unsigned sum, cnt, mine, sp = 0u;
  for (;;) {
    sum = 0u; cnt = 0u; mine = 0u;
#pragma unroll
    for (unsigned j = 0; j < 16; ++j) {
      const unsigned c = xb_ld(&bar[XB_XCNT(j)]);
      sum += c;
      cnt += (c > 0u) ? 1u : 0u;
      mine = (j == x) ? c : mine;
    }
    if (sum == G) break;
    __builtin_amdgcn_s_sleep(1);
    if ((++sp & 255u) == 0u) { if (xb_ld(&bar[XB_TMO])) break; if (sp > XB_SPIN_CAP) { atomicAdd(&bar[XB_TMO], 1u); break; } }
  }
  nloc = mine > 0u ? mine : 1u;
  nx = cnt > 0u ? cnt : 1u;
}
DI void xcd_barrier(const XcdBarrier& b0) {
  asm volatile("s_waitcnt vmcnt(0)" ::: "memory");
  __syncthreads();
  if (threadIdx.x == 0) {
    XcdBarrier b = b0;
    b.x = __builtin_amdgcn_readfirstlane(xb_xcc_id());
    unsigned* bar = b.bar;
    asm volatile("" : "+s"(bar));
    __builtin_amdgcn_s_waitcnt(0);
    unsigned nloc = b.st[0], nx = b.st[1];
    if (nloc == 0u) { xcd_barrier_complete(bar, b.x, nloc, nx); b.st[0] = nloc; b.st[1] = nx; }
    const unsigned old = xb_add(&bar[XB_XSUB(b.x)], 1u);
    const unsigned gen = old / nloc;
    if (old + 1u == (gen + 1u) * nloc) {
      __builtin_amdgcn_fence(__ATOMIC_RELEASE, "agent");
      asm volatile("s_waitcnt vmcnt(0)" ::: "memory");
      const unsigned og = xb_add(&bar[XB_TOP], 1u);
      const unsigned tg = og / nx;
      if (og + 1u == (tg + 1u) * nx) xb_add(&bar[XB_TOPGEN], 1u);
      else XB_SPIN(xb_ld(&bar[XB_TOPGEN]) == tg, bar);
      __builtin_amdgcn_fence(__ATOMIC_ACQUIRE, "agent");
      xb_add(&bar[XB_XGEN(b.x)], 1u);
      asm volatile("s_waitcnt vmcnt(0)" ::: "memory");
    } else {
      XB_SPIN(xb_ld(&bar[XB_XGEN(b.x)]) == gen, bar);
      __builtin_amdgcn_fence(__ATOMIC_ACQUIRE, "agent");
      asm volatile("s_waitcnt vmcnt(0)" ::: "memory");
    }
  }
  __syncthreads();
}

#define DECL_WS_PTRS(ws) \
  u16* w_ain = (u16*)(ws + W_AIN); \
  u16* w_uk = (u16*)(ws + W_UK); \
  u16* w_uv = (u16*)(ws + W_UV); \
  u16* w_ao = (u16*)(ws + W_AO); \
  u16* w_bin = (u16*)(ws + W_BIN); \
  u16* w_bo = (u16*)(ws + W_BO); \
  u16* w_w1 = (u16*)(ws + W_W1); \
  u16* w_w2 = (u16*)(ws + W_W2); \
  float* mod = (float*)(ws + WS_MOD); \
  u16* hbuf = (u16*)(ws + WS_H); \
  char* big = ws + WS_BIG; \
  u16* qbuf = (u16*)(big + B_Q); \
  u16* iqbuf = (u16*)(big + B_IQ); \
  u16* ikbuf = (u16*)(big + B_IK); \
  float* iwbuf = (float*)(big + B_IW); \
  float* ckvraw = (float*)(big + B_CKVRAW); \
  u16* ckvn = (u16*)(big + B_CKVN); \
  u16* selbuf = (u16*)(big + B_SEL); \
  u16* kbuf = (u16*)(big + B_K); \
  u16* vtbuf = (u16*)(big + B_VT); \
  u16* obuf = (u16*)(big + B_O); \
  u16* hid = (u16*)big;

__global__ void __launch_bounds__(512, 2) hybrid_fwd(Params p) {
  __shared__ __attribute__((aligned(16))) char smem[2 * LDS_BYTES];
  cg::grid_group grid = cg::this_grid();
  const int bid = blockIdx.x, nb = gridDim.x;
  const int half = __builtin_amdgcn_readfirstlane((int)(threadIdx.x >> 8));
  const int vb = half * nb + bid, nvb = 2 * nb;
  char* smh = smem + half * LDS_BYTES;
  char* ws = p.ws;
  unsigned* bar = (unsigned*)(ws + WS_BAR);
  volatile LAS unsigned* xst = (volatile LAS unsigned*)(smem + 2 * LDS_BYTES - 16);
  if (threadIdx.x < 2) xst[threadIdx.x] = 0u;
  __syncthreads();
  const XcdBarrier xb = xcd_barrier_post(bar, xst);

  {
  DECL_WS_PTRS(ws)
  (void)qbuf; (void)iqbuf; (void)ikbuf; (void)iwbuf; (void)ckvraw; (void)ckvn; (void)selbuf; (void)kbuf; (void)vtbuf; (void)obuf; (void)hid;
  tconv_phase(p.a_w_in, w_ain, 2, 1024, 1864, A_INP, smh, vb, nvb);
  tconv_phase(p.a_w_uk, w_uk, 32, 64, 256, 256, smh, vb, nvb);
  tconv_phase(p.a_w_uv, w_uv, 32, 256, 64, 64, smh, vb, nvb);
  tconv_phase(p.a_w_o, w_ao, 2, 1024, 1024, 1024, smh, vb, nvb);
  tconv_phase(p.b_w_in, w_bin, 2, 1024, 3072, 3072, smh, vb, nvb);
  tconv_phase(p.b_w_o, w_bo, 2, 1024, 1024, 1024, smh, vb, nvb);
  tconv_phase(p.mlp_w1, w_w1, 4, 1024, 4096, 4096, smh, vb, nvb);
  tconv_phase(p.mlp_w2, w_w2, 4, 4096, 1024, 1024, smh, vb, nvb);
  mod_phase(p, mod, smh, vb, nvb);
  grid.sync();
  h0_phase(p.x, mod, hbuf, vb, nvb);
  xcd_barrier(xb);
  }

#pragma unroll 1
  for (int sl = 0; sl < 8; sl++) {
    char* wsl = p.ws;
    asm volatile("" : "+s"(wsl));
    DECL_WS_PTRS(wsl)
    const int i = sl >> 1, j = i >> 1;
    const float* modi = mod + (size_t)i * 4 * 6144;
    const u16* Ares;
    const u16* Wres;
    int Kres, goff;
    if ((sl & 1) == 0) {
      if ((i & 1) == 0) {
        EpiArgs ea{};
        ea.o0 = qbuf; ea.f0 = ckvraw; ea.o1 = iqbuf; ea.o2 = ikbuf; ea.f1 = iwbuf;
        for (int rep = 0; rep < (PROBE_DUP == 4 ? 2 : 1); rep++) gemm8p_phase<EPI_AIN>(hbuf, w_ain + (size_t)j * A_INP * 1024, T, A_INP, 1024, ea, smem, bid, nb);
        xcd_barrier(xb);
        ckvnorm_phase(ckvraw, p.a_kv_norm + j * 256, ckvn, vb, nvb);
        for (int rep = 0; rep < (PROBE_DUP == 2 ? 2 : 1); rep++) indexer_phase(iqbuf, ikbuf, iwbuf, selbuf, smh, vb, nvb);
        xcd_barrier(xb);
        for (int rep = 0; rep < (PROBE_DUP == 3 ? 2 : 1); rep++) sparse_phase(qbuf, ckvn, selbuf, w_uk + (size_t)j * 16 * 256 * 64, w_uv + (size_t)j * 16 * 256 * 64, p.rel_bias,
                     hbuf, obuf, smh, vb, nvb);
        xcd_barrier(xb);
        Wres = w_ao + (size_t)j * 1024 * 1024;
      } else {
        EpiArgs ea{};
        ea.o0 = qbuf; ea.o1 = kbuf; ea.o2 = vtbuf;
        for (int rep = 0; rep < (PROBE_DUP == 4 ? 2 : 1); rep++) gemm8p_phase<EPI_BIN>(hbuf, w_bin + (size_t)j * 3072 * 1024, T, 3072, 1024, ea, smem, bid, nb);
        xcd_barrier(xb);
        for (int rep = 0; rep < (PROBE_DUP == 1 ? 2 : 1); rep++) diffattn_phase(qbuf, kbuf, vtbuf, obuf, p.rel_bias, p.b_lambda + j * 256, p.b_subln + j * 128, i, smem, bid, nb);
        xcd_barrier(xb);
        Wres = w_bo + (size_t)j * 1024 * 1024;
      }
      Ares = obuf; Kres = 1024; goff = 2 * 1024;
    } else {
      EpiArgs ea{};
      ea.o0 = hid;
      for (int rep = 0; rep < (PROBE_DUP == 4 ? 2 : 1); rep++) gemm8p_phase<EPI_SQRELU>(hbuf, w_w1 + (size_t)i * 4096 * 1024, T, 4096, 1024, ea, smem, bid, nb);
      xcd_barrier(xb);
      Ares = hid; Wres = w_w2 + (size_t)i * 4096 * 1024; Kres = 4096; goff = 5 * 1024;
    }
    {
      EpiArgs ea{};
      ea.f0 = p.out;
      ea.xin = (sl == 0) ? p.x : (const float*)p.out;
      ea.g = modi + goff;
      gemm8p_phase<EPI_RES>(Ares, Wres, T, 1024, Kres, ea, smem, bid, nb);
    }
    xcd_barrier(xb);
    {
      const float* modn = ((sl & 1) == 0) ? modi : (i < 3 ? modi + 4 * 6144 : (const float*)nullptr);
      const int sh_off = ((sl & 1) == 0) ? 3 * 1024 : 0;
      ln_phase(p.out, p.ln_g + (size_t)(i * 2 + (sl & 1)) * 1024, p.ln_b + (size_t)(i * 2 + (sl & 1)) * 1024, modn, sh_off,
               hbuf, vb, nvb);
    }
    xcd_barrier(xb);
  }
}

extern "C" void kernel_launch(void* const* d_in, const int* in_sizes, int n_in, void* d_out, int out_size, void* d_ws,
                              size_t ws_size, hipStream_t stream) {
  static int grid_blocks = 0;
  if (!grid_blocks) {
    int dev = 0, cus = 0, per_cu = 0;
    hipGetDevice(&dev);
    hipDeviceGetAttribute(&cus, hipDeviceAttributeMultiprocessorCount, dev);
    hipOccupancyMaxActiveBlocksPerMultiprocessor(&per_cu, hybrid_fwd, 512, 0);
    (void)per_cu;
    grid_blocks = cus;
    if (grid_blocks > 256) grid_blocks = 256;
  }
  Params p{};
  p.x = (const float*)d_in[0];
  p.c = (const float*)d_in[1];
  p.rel_bias = (const float*)d_in[2];
  p.ada_w = (const float*)d_in[3];
  p.ada_b = (const float*)d_in[4];
  p.ln_g = (const float*)d_in[5];
  p.ln_b = (const float*)d_in[6];
  p.a_w_in = (const float*)d_in[7];
  p.a_kv_norm = (const float*)d_in[8];
  p.a_w_uk = (const float*)d_in[9];
  p.a_w_uv = (const float*)d_in[10];
  p.a_w_o = (const float*)d_in[11];
  p.b_w_in = (const float*)d_in[12];
  p.b_lambda = (const float*)d_in[13];
  p.b_subln = (const float*)d_in[14];
  p.b_w_o = (const float*)d_in[15];
  p.mlp_w1 = (const float*)d_in[16];
  p.mlp_w2 = (const float*)d_in[17];
  p.out = (float*)d_out;
  p.ws = (char*)d_ws;
  hipMemsetAsync((char*)d_ws + WS_BAR, 0, XCD_BAR_WORDS * 4, stream);
  void* args[] = {&p};
  hipError_t e = hipLaunchCooperativeKernel((void*)hybrid_fwd, dim3(grid_blocks), dim3(512), args, 0, stream);
  if (e != hipSuccess) fprintf(stderr, "cooperative launch failed: %s (grid %d)\n", hipGetErrorString(e), grid_blocks);
}
```
